# Optimizing an MI355X kernel written in HIP

```python
import math
import jax
import jax.numpy as jnp
from jax import lax
import numpy as np


D_MODEL = 1024
BATCH = 8
SEQ = 8192
DEPTH = 2

GRID_W = 64
CTX_LEN = 256
EPS = 1e-6

MIX_WIDTH = 1024
GMLP_CHUNK = 128
GMLP_GROUPS = 4
GMLP_GROUP_DIM = 128
GMLP_WIDTH = GMLP_GROUPS * GMLP_GROUP_DIM
HGRN_HEADS = 4
HGRN_EXPAND = 128
HGRN_HEAD_V = 128
HGRN_WIDTH = HGRN_HEADS * HGRN_HEAD_V
EVEN_IN = 2 * GMLP_WIDTH + 5 * HGRN_WIDTH
GDN_HEADS = 4
GDN_HEAD_DIM = 128
GDN_WIDTH = GDN_HEADS * GDN_HEAD_DIM
GDN_CONV = 5
MLA_HEADS = 8
MLA_NOPE = 64
MLA_ROPE = 32
MLA_V = 64
MLA_Q_RANK = 256
MLA_KV_RANK = 128
MLA_WIDTH = MLA_HEADS * MLA_V
MLA_SCALE = (MLA_NOPE + MLA_ROPE) ** -0.5
ODD_IN = 4 * GDN_WIDTH + 4 * GDN_HEADS + MLA_Q_RANK + MLA_KV_RANK + MLA_ROPE
ROPE_THETA = 10000.0
ATTN_BLOCK = 128
SCAN_CHUNK = 64
N_GROUPS = 4
EXPERTS_PER_GROUP = 8
N_EXPERTS = N_GROUPS * EXPERTS_PER_GROUP
TOP_K = 2
EXPERT_FF = 512
MOE_BLOCK = 256

kernel_name = 'hybrid_gmlp_hgrn2_gdn_mla_hmoe_trunk'


def rms_norm(x, w):
    xf = x.astype(jnp.float32)
    y = xf * lax.rsqrt(jnp.mean(xf * xf, axis=-1, keepdims=True) + EPS)
    return (y * w.astype(jnp.float32)).astype(x.dtype)


def l2_norm(x):
    xf = x.astype(jnp.float32)
    return (xf * lax.rsqrt(jnp.sum(xf * xf, axis=-1, keepdims=True) + EPS)).astype(x.dtype)


def modulate(h, shift, scale):
    return h * (1 + scale) + shift


def to_heads(t, n_heads):
    b, l, _ = t.shape
    return t.reshape(b, l, n_heads, -1).transpose(0, 2, 1, 3)


def from_heads(t):
    b, n, l, d = t.shape
    return t.transpose(0, 2, 1, 3).reshape(b, l, n * d)


def flip(t):
    return jnp.flip(t, axis=2)


def axial_rope(t):
    l = t.shape[1]
    rows = l // GRID_W
    row = jnp.repeat(jnp.arange(rows), GRID_W)
    col = jnp.tile(jnp.arange(GRID_W), rows)
    half = MLA_ROPE // 2
    quarter = half // 2
    freqs = ROPE_THETA ** (-jnp.arange(quarter, dtype=jnp.float32) / quarter)

    def rot(u, pos):
        ang = pos.astype(jnp.float32)[:, None] * freqs
        cos = jnp.cos(ang)[:, None, :].astype(u.dtype)
        sin = jnp.sin(ang)[:, None, :].astype(u.dtype)
        u1, u2 = u[..., :quarter], u[..., quarter:]
        return jnp.concatenate([u1 * cos - u2 * sin, u2 * cos + u1 * sin], axis=-1)

    return jnp.concatenate([rot(t[..., :half], row), rot(t[..., half:], col)], axis=-1)


def short_conv(t, w):
    pad = (GDN_CONV - 1) // 2
    return lax.conv_general_dilated(t, w[:, None, :].astype(t.dtype), window_strides=(1,),
                                    padding=[(pad, pad)], dimension_numbers=('NWC', 'WIO', 'NWC'),
                                    feature_group_count=t.shape[-1])


def gla_chunked(q, k, v, log_f, s0):
    out_dtype = v.dtype
    b, h, l, _ = q.shape
    dv = v.shape[-1]
    n = l // SCAN_CHUNK

    def chunks(t):
        return jnp.moveaxis(t.astype(jnp.float32).reshape(b, h, n, SCAN_CHUNK, t.shape[-1]), 2, 0)

    causal = jnp.tril(jnp.ones((SCAN_CHUNK, SCAN_CHUNK), bool))

    def step(s, inp):
        qc, kc, vc, lf = inp
        g = jnp.cumsum(lf, axis=-2)
        diff = g[..., :, None, :] - g[..., None, :, :]
        decay = jnp.exp(jnp.where(causal[:, :, None], diff, -jnp.inf))
        scores = jnp.einsum('bhid,bhjd,bhijd->bhij', qc, kc, decay)
        o = scores @ vc + (qc * jnp.exp(g)) @ s
        g_last = g[..., -1:, :]
        s_new = jnp.exp(g_last[..., 0, :])[..., None] * s + jnp.einsum('bhjd,bhje->bhde', kc * jnp.exp(g_last - g), vc)
        return s_new, o

    s_fin, o = lax.scan(step, s0.astype(jnp.float32), (chunks(q), chunks(k), chunks(v), chunks(log_f)))
    return jnp.moveaxis(o, 0, 2).reshape(b, h, l, dv).astype(out_dtype), s_fin


def gated_delta_chunked(q, k, v, log_a, beta, s0):
    out_dtype = v.dtype
    b, h, l, dk = q.shape
    dv = v.shape[-1]
    cs = SCAN_CHUNK
    n = l // cs
    qc = q.astype(jnp.float32).reshape(b, h, n, cs, dk)
    kc = k.astype(jnp.float32).reshape(b, h, n, cs, dk)
    vc = v.astype(jnp.float32).reshape(b, h, n, cs, dv)
    bc = beta.astype(jnp.float32).reshape(b, h, n, cs)
    g = jnp.cumsum(log_a.astype(jnp.float32).reshape(b, h, n, cs), axis=-1)
    incl = jnp.tril(jnp.ones((cs, cs), bool))
    strict = jnp.tril(jnp.ones((cs, cs), bool), -1)
    gamma = jnp.exp(jnp.where(incl, g[..., :, None] - g[..., None, :], -jnp.inf))
    kk = jnp.einsum('bhnid,bhnjd->bhnij', kc, kc)
    tri_mat = jnp.where(strict, bc[..., :, None] * kk * gamma, 0.0) + jnp.eye(cs, dtype=jnp.float32)

    def solve(rhs):
        return lax.linalg.triangular_solve(tri_mat, rhs, left_side=True, lower=True)

    u = solve(bc[..., None] * vc)
    w = solve(bc[..., None] * kc * jnp.exp(g)[..., None])
    qk = jnp.where(incl, jnp.einsum('bhnid,bhnjd->bhnij', qc, kc) * gamma, 0.0)
    qg = qc * jnp.exp(g)[..., None]
    kg = kc * jnp.exp(g[..., -1:] - g)[..., None]
    a_last = jnp.exp(g[..., -1])

    def step(s, inp):
        u_c, w_c, qk_c, qg_c, kg_c, a_c = inp
        v_new = u_c - w_c @ s
        o = qg_c @ s + qk_c @ v_new
        s_new = a_c[..., None, None] * s + jnp.swapaxes(kg_c, -1, -2) @ v_new
        return s_new, o

    xs = tuple(jnp.moveaxis(t, 2, 0) for t in (u, w, qk, qg, kg, a_last))
    s_fin, o = lax.scan(step, s0.astype(jnp.float32), xs)
    return jnp.moveaxis(o, 0, 2).reshape(b, h, l, dv).astype(out_dtype), s_fin


def two_way(scan_fn, ctx_fwd, lat_fwd, ctx_bwd, lat_bwd, s0):
    oc_f, sc_f = scan_fn(*ctx_fwd, s0)
    ox_f, _ = scan_fn(*lat_fwd, sc_f)
    oc_b, sc_b = scan_fn(*[flip(t) for t in ctx_bwd], s0)
    ox_b, _ = scan_fn(*[flip(t) for t in lat_bwd], sc_b)
    return oc_f + flip(oc_b), ox_f + flip(ox_b)


def lower_bound(logits, layer):
    return jnp.cumsum(jax.nn.softmax(logits.astype(jnp.float32), axis=0), axis=0)[layer]


def hgrn_gates(f_raw, lb):
    f = lb + (1.0 - lb) * jax.nn.sigmoid(f_raw.astype(jnp.float32))
    return jnp.log(f), 1.0 - f


def chunk_gmlp(p, norm_w, ws, bs):
    b, l, _ = p.shape
    z = jax.nn.gelu(p)
    u = z[..., :GMLP_WIDTH]
    v = rms_norm(z[..., GMLP_WIDTH:], norm_w)
    v = v.reshape(b, l // GMLP_CHUNK, GMLP_CHUNK, GMLP_GROUPS, GMLP_GROUP_DIM)
    s = jnp.einsum('gpq,bnqgc->bnpgc', ws, v) + bs.T[:, :, None]
    return u * s.reshape(b, l, GMLP_WIDTH)


def attend(q, k, v):
    s = jnp.einsum('bhqd,bhkd->bhqk', q, k, preferred_element_type=jnp.float32) * MLA_SCALE
    p = jax.nn.softmax(s, axis=-1)
    return jnp.einsum('bhqk,bhkd->bhqd', p.astype(v.dtype), v)


def blocked_attend(q, k, v):
    b, h, l, d = q.shape
    nb = l // ATTN_BLOCK
    qb = jnp.moveaxis(q.reshape(b, h, nb, ATTN_BLOCK, d), 2, 0)
    ob = lax.map(lambda qq: attend(qq, k, v), qb)
    return jnp.moveaxis(ob, 0, 2).reshape(b, h, l, v.shape[-1])


def mla_queries(cq, norm_w, w_up, qk_w, rotary):
    b, l, _ = cq.shape
    q = (rms_norm(cq, norm_w) @ w_up).reshape(b, l, MLA_HEADS, MLA_NOPE + MLA_ROPE)
    q = rms_norm(q, qk_w)
    if rotary:
        q = jnp.concatenate([q[..., :MLA_NOPE], axial_rope(q[..., MLA_NOPE:])], axis=-1)
    return q.transpose(0, 2, 1, 3)


def mla_keys_values(ckv, k_rope, norm_w, w_up, qk_w, rotary):
    b, l, _ = ckv.shape
    kv = (rms_norm(ckv, norm_w) @ w_up).reshape(b, l, MLA_HEADS, MLA_NOPE + MLA_V)
    k_shared = jnp.broadcast_to(k_rope[:, :, None, :], (b, l, MLA_HEADS, MLA_ROPE))
    k = rms_norm(jnp.concatenate([kv[..., :MLA_NOPE], k_shared], axis=-1), qk_w)
    if rotary:
        k = jnp.concatenate([k[..., :MLA_NOPE], axial_rope(k[..., MLA_NOPE:])], axis=-1)
    return k.transpose(0, 2, 1, 3), kv[..., MLA_NOPE:].transpose(0, 2, 1, 3)


def even_mixer(hx, hc, layer, need_ctx, w_in, w_out, norm_w, ws, bs, lb_logits, out_norm_w):
    b = hx.shape[0]
    px = hx @ w_in
    pc = hc @ w_in
    lb_f = lower_bound(lb_logits[0], layer)
    lb_b = lower_bound(lb_logits[1], layer)
    a_cols = 2 * GMLP_WIDTH

    def hgrn_inputs(p):
        q, i, f_f, f_b, g = jnp.split(p[..., a_cols:], 5, axis=-1)
        logf_f, k_f = hgrn_gates(f_f, lb_f)
        logf_b, k_b = hgrn_gates(f_b, lb_b)
        qh = to_heads(q, HGRN_HEADS)
        ih = to_heads(i, HGRN_HEADS)
        fwd = (qh, to_heads(k_f, HGRN_HEADS), ih, to_heads(logf_f, HGRN_HEADS))
        bwd = (qh, to_heads(k_b, HGRN_HEADS), ih, to_heads(logf_b, HGRN_HEADS))
        return fwd, bwd, g

    cf, cb, gc = hgrn_inputs(pc)
    xf, xb, gx = hgrn_inputs(px)
    s0 = jnp.zeros((b, HGRN_HEADS, HGRN_EXPAND, HGRN_HEAD_V), jnp.float32)
    oc, ox = two_way(gla_chunked, cf, xf, cb, xb, s0)

    def merge(p, o, g):
        rec = rms_norm(o.transpose(0, 2, 1, 3), out_norm_w.reshape(HGRN_HEADS, HGRN_HEAD_V))
        rec = rec.reshape(g.shape) * jax.nn.silu(g)
        mix = chunk_gmlp(p[..., :a_cols], norm_w, ws, bs)
        return jnp.concatenate([mix, rec], axis=-1) @ w_out

    yx = merge(px, ox, gx)
    yc = merge(pc, oc, gc) if need_ctx else None
    return yx, yc


def odd_mixer(hx, hc, need_ctx, w_in, w_out, conv_w, a_log, dt_bias, gdn_norm_w,
              q_norm_w, wq_up, kv_norm_w, wkv_up, qk_q, qk_k):
    b = hx.shape[0]
    wd, nh = GDN_WIDTH, GDN_HEADS
    o_gate = 3 * wd
    o_beta = 4 * wd
    o_decay = o_beta + 2 * nh
    o_cq = o_decay + 2 * nh
    o_ckv = o_cq + MLA_Q_RANK
    o_kr = o_ckv + MLA_KV_RANK
    px = hx @ w_in
    pc = hc @ w_in
    a_neg = -jnp.exp(a_log.astype(jnp.float32)).reshape(2 * nh)
    dt_b = dt_bias.astype(jnp.float32).reshape(2 * nh)

    def gdn_inputs(p):
        qkv = jax.nn.silu(short_conv(p[..., :3 * wd], conv_w))
        q = l2_norm(to_heads(qkv[..., :wd], nh)) * (GDN_HEAD_DIM ** -0.5)
        k = l2_norm(to_heads(qkv[..., wd:2 * wd], nh))
        v = to_heads(qkv[..., 2 * wd:], nh)
        beta = jax.nn.sigmoid(p[..., o_beta:o_decay].astype(jnp.float32)).transpose(0, 2, 1)
        log_a = (a_neg * jax.nn.softplus(p[..., o_decay:o_cq].astype(jnp.float32) + dt_b)).transpose(0, 2, 1)
        fwd = (q, k, v, log_a[:, :nh], beta[:, :nh])
        bwd = (q, k, v, log_a[:, nh:], beta[:, nh:])
        return fwd, bwd

    cf, cb = gdn_inputs(pc)
    xf, xb = gdn_inputs(px)
    s0 = jnp.zeros((b, nh, GDN_HEAD_DIM, GDN_HEAD_DIM), jnp.float32)
    oc, ox = two_way(gated_delta_chunked, cf, xf, cb, xb, s0)

    def gdn_out(o, p):
        z = p[..., o_gate:o_beta]
        return rms_norm(o.transpose(0, 2, 1, 3), gdn_norm_w).reshape(z.shape) * jax.nn.silu(z)

    kx, vx = mla_keys_values(px[..., o_ckv:o_kr], px[..., o_kr:], kv_norm_w, wkv_up, qk_k, True)
    kc, vc = mla_keys_values(pc[..., o_ckv:o_kr], pc[..., o_kr:], kv_norm_w, wkv_up, qk_k, False)
    qx = mla_queries(px[..., o_cq:o_ckv], q_norm_w, wq_up, qk_q, True)
    k_all = jnp.concatenate([kc, kx], axis=2)
    v_all = jnp.concatenate([vc, vx], axis=2)
    att_x = blocked_attend(qx, k_all, v_all)
    yx = jnp.concatenate([gdn_out(ox, px), from_heads(att_x)], axis=-1) @ w_out
    if not need_ctx:
        return yx, None
    qc = mla_queries(pc[..., o_cq:o_ckv], q_norm_w, wq_up, qk_q, False)
    att_c = attend(qc, kc, vc)
    yc = jnp.concatenate([gdn_out(oc, pc), from_heads(att_c)], axis=-1) @ w_out
    return yx, yc


def hier_moe(h, wg_r, bg_r, we_r, be_r, w_gate, w_up, w_down):
    t, d = h.shape
    hf = h.astype(jnp.float32)
    pg = jax.nn.softmax(hf @ wg_r.astype(jnp.float32) + bg_r.astype(jnp.float32), axis=-1)
    pg_top, g_idx = lax.top_k(pg, 1)
    le = (hf @ we_r.astype(jnp.float32) + be_r.astype(jnp.float32)).reshape(t, N_GROUPS, EXPERTS_PER_GROUP)
    le = jnp.take_along_axis(le, g_idx[:, :, None], axis=1)[:, 0]
    pe_top, e_local = lax.top_k(jax.nn.softmax(le, axis=-1), TOP_K)
    wts = pg_top * pe_top / jnp.sum(pe_top, axis=-1, keepdims=True)
    e_idx = g_idx * EXPERTS_PER_GROUP + e_local
    m = t * TOP_K
    e_flat = e_idx.reshape(m)
    w_flat = wts.reshape(m)
    tok_flat = jnp.repeat(jnp.arange(t, dtype=jnp.int32), TOP_K)
    order = jnp.argsort(e_flat, stable=True)
    e_s, tok_s, w_s = e_flat[order], tok_flat[order], w_flat[order]
    counts = jnp.bincount(e_flat, length=N_EXPERTS)
    padded = (counts + MOE_BLOCK - 1) // MOE_BLOCK * MOE_BLOCK
    start = jnp.cumsum(counts) - counts
    pend = jnp.cumsum(padded)
    pstart = pend - padded
    dest = pstart[e_s] + jnp.arange(m, dtype=jnp.int32) - start[e_s]
    n_blk = -(-m // MOE_BLOCK) + N_EXPERTS
    slots = n_blk * MOE_BLOCK
    slot_tok = jnp.full((slots,), t, jnp.int32).at[dest].set(tok_s)
    slot_w = jnp.zeros((slots,), jnp.float32).at[dest].set(w_s)
    blk_e = jnp.minimum(jnp.searchsorted(pend, jnp.arange(n_blk, dtype=jnp.int32) * MOE_BLOCK, side='right'),
                        N_EXPERTS - 1)
    xs = jnp.concatenate([h, jnp.zeros((1, d), h.dtype)], axis=0)[slot_tok].reshape(n_blk, MOE_BLOCK, d)

    def expert(args):
        xb, e = args
        return (jax.nn.silu(xb @ w_gate[e]) * (xb @ w_up[e])) @ w_down[e]

    ys = lax.map(expert, (xs, blk_e)).reshape(slots, d)
    ys = ys * slot_w[:, None].astype(ys.dtype)
    return jax.ops.segment_sum(ys, slot_tok, num_segments=t + 1)[:t]


def setup_inputs(seed: int = 0) -> dict:
    key = jax.random.key(seed)
    ks = iter(jax.random.split(key, 48))
    d = D_MODEL
    ne = (DEPTH + 1) // 2
    no = DEPTH // 2

    def nrm(shape, scale):
        return jax.random.normal(next(ks), shape, jnp.float32) * scale

    dt = jnp.exp(jax.random.uniform(next(ks), (no, 2, GDN_HEADS), jnp.float32,
                                    minval=math.log(1e-3), maxval=math.log(1e-1)))
    a_init = jax.random.uniform(next(ks), (no, 2, GDN_HEADS), jnp.float32, minval=1.0, maxval=16.0)
    return {
        'x': nrm((BATCH, SEQ, d), 1.0),
        'c': nrm((BATCH, d), 1.0),
        'ctx': nrm((BATCH, CTX_LEN, d), 1.0),
        'c_ctx': nrm((d,), 1.0),
        'ada_w': nrm((DEPTH, d, 6 * d), 0.5 * d ** -0.5),
        'ada_b': nrm((DEPTH, 6 * d), 0.01),
        'norm_mix_w': 1.0 + nrm((DEPTH, d), 0.01),
        'norm_ffn_w': 1.0 + nrm((DEPTH, d), 0.01),
        'even_w_in': nrm((ne, d, EVEN_IN), d ** -0.5),
        'even_w_out': nrm((ne, MIX_WIDTH, d), MIX_WIDTH ** -0.5),
        'gmlp_norm_w': 1.0 + nrm((ne, GMLP_WIDTH), 0.01),
        'gmlp_ws': nrm((ne, GMLP_GROUPS, GMLP_CHUNK, GMLP_CHUNK), GMLP_CHUNK ** -0.5),
        'gmlp_bs': 1.0 + nrm((ne, GMLP_GROUPS, GMLP_CHUNK), 0.01),
        'hgrn_lb_logits': nrm((2, DEPTH + 1, HGRN_WIDTH), 0.5),
        'hgrn_norm_w': 1.0 + nrm((ne, HGRN_WIDTH), 0.01),
        'odd_w_in': nrm((no, d, ODD_IN), d ** -0.5),
        'odd_w_out': nrm((no, MIX_WIDTH, d), MIX_WIDTH ** -0.5),
        'gdn_conv_w': nrm((no, GDN_CONV, 3 * GDN_WIDTH), GDN_CONV ** -0.5),
        'gdn_a_log': jnp.log(a_init),
        'gdn_dt_bias': dt + jnp.log(-jnp.expm1(-dt)),
        'gdn_norm_w': 1.0 + nrm((no, GDN_HEAD_DIM), 0.01),
        'mla_q_norm_w': 1.0 + nrm((no, MLA_Q_RANK), 0.01),
        'mla_wq_up': nrm((no, MLA_Q_RANK, MLA_HEADS * (MLA_NOPE + MLA_ROPE)), MLA_Q_RANK ** -0.5),
        'mla_kv_norm_w': 1.0 + nrm((no, MLA_KV_RANK), 0.01),
        'mla_wkv_up': nrm((no, MLA_KV_RANK, MLA_HEADS * (MLA_NOPE + MLA_V)), MLA_KV_RANK ** -0.5),
        'mla_qk_norm_q': 1.0 + nrm((no, MLA_NOPE + MLA_ROPE), 0.01),
        'mla_qk_norm_k': 1.0 + nrm((no, MLA_NOPE + MLA_ROPE), 0.01),
        'router_group_w': nrm((DEPTH, d, N_GROUPS), d ** -0.5),
        'router_group_b': nrm((DEPTH, N_GROUPS), 0.01),
        'router_expert_w': nrm((DEPTH, d, N_EXPERTS), d ** -0.5),
        'router_expert_b': nrm((DEPTH, N_EXPERTS), 0.01),
        'moe_w_gate': nrm((DEPTH, N_EXPERTS, d, EXPERT_FF), d ** -0.5),
        'moe_w_up': nrm((DEPTH, N_EXPERTS, d, EXPERT_FF), d ** -0.5),
        'moe_w_down': nrm((DEPTH, N_EXPERTS, EXPERT_FF, d), EXPERT_FF ** -0.5),
    }


def reference(x, c, ctx, c_ctx, ada_w, ada_b, norm_mix_w, norm_ffn_w,
              even_w_in, even_w_out, gmlp_norm_w, gmlp_ws, gmlp_bs, hgrn_lb_logits, hgrn_norm_w,
              odd_w_in, odd_w_out, gdn_conv_w, gdn_a_log, gdn_dt_bias, gdn_norm_w,
              mla_q_norm_w, mla_wq_up, mla_kv_norm_w, mla_wkv_up, mla_qk_norm_q, mla_qk_norm_k,
              router_group_w, router_group_b, router_expert_w, router_expert_b,
              moe_w_gate, moe_w_up, moe_w_down):
    b, n_lat, d = x.shape
    xc = ctx
    silu_c = jax.nn.silu(c)
    silu_cc = jax.nn.silu(c_ctx)
    for layer in range(DEPTH):
        need_ctx = layer < DEPTH - 1
        j = layer // 2
        mx = jnp.split((silu_c @ ada_w[layer] + ada_b[layer])[:, None, :], 6, axis=-1)
        mc = jnp.split(silu_cc @ ada_w[layer] + ada_b[layer], 6, axis=-1)
        hx = modulate(rms_norm(x, norm_mix_w[layer]), mx[0], mx[1])
        hc = modulate(rms_norm(xc, norm_mix_w[layer]), mc[0], mc[1])
        if layer % 2 == 0:
            yx, yc = even_mixer(hx, hc, layer, need_ctx, even_w_in[j], even_w_out[j], gmlp_norm_w[j],
                                gmlp_ws[j], gmlp_bs[j], hgrn_lb_logits, hgrn_norm_w[j])
        else:
            yx, yc = odd_mixer(hx, hc, need_ctx, odd_w_in[j], odd_w_out[j], gdn_conv_w[j], gdn_a_log[j],
                               gdn_dt_bias[j], gdn_norm_w[j], mla_q_norm_w[j], mla_wq_up[j],
                               mla_kv_norm_w[j], mla_wkv_up[j], mla_qk_norm_q[j], mla_qk_norm_k[j])
        x = x + mx[2] * yx
        moe_params = (router_group_w[layer], router_group_b[layer], router_expert_w[layer],
                      router_expert_b[layer], moe_w_gate[layer], moe_w_up[layer], moe_w_down[layer])
        hx2 = modulate(rms_norm(x, norm_ffn_w[layer]), mx[3], mx[4])
        if need_ctx:
            xc = xc + mc[2] * yc
            hc2 = modulate(rms_norm(xc, norm_ffn_w[layer]), mc[3], mc[4])
            tokens = jnp.concatenate([hx2.reshape(-1, d), hc2.reshape(-1, d)], axis=0)
            y = hier_moe(tokens, *moe_params)
            x = x + mx[5] * y[:b * n_lat].reshape(x.shape)
            xc = xc + mc[5] * y[b * n_lat:].reshape(xc.shape)
        else:
            x = x + mx[5] * hier_moe(hx2.reshape(-1, d), *moe_params).reshape(x.shape)
    return x
```

```cpp
#include <hip/hip_runtime.h>
#include <cstdint>
#include <cstdio>

#define LAS __attribute__((address_space(3)))
typedef unsigned short bf16_t;
typedef float f32x4 __attribute__((ext_vector_type(4)));
typedef unsigned u32x4 __attribute__((ext_vector_type(4)));
typedef unsigned u32x2 __attribute__((ext_vector_type(2)));

constexpr int NB = 8, SEQ = 8192, CTXL = 256, DM = 1024;
constexpr int TL = NB * SEQ, TC = NB * CTXL, TT = TL + TC;
constexpr int EVEN_IN = 3584, ODD_IN = 2480, ODD_PAD = 2560;
constexpr int NTH = 512;
constexpr int LDS_BYTES = 144 * 1024;
constexpr int MAXSLOTS = 151552;
constexpr int MAXTILES = 592;
constexpr float EPS = 1e-6f;

constexpr size_t MiB = 1048576;
constexpr size_t WS_CTRL = 0;
constexpr size_t C_MOE = 16384;
constexpr size_t C_MOD = 65536;
constexpr size_t WS_XC = 1 * MiB;
constexpr size_t WS_WSM = 9 * MiB;
constexpr size_t W_EIN = 0, W_EOUT = 7340032, W_OIN = 9437184, W_OOUT = 14680064, W_WQ = 16777216, W_WKV = 17170432;
constexpr size_t WS_WMOE = 27 * MiB;
constexpr size_t WS_ACT = 123 * MiB;
constexpr size_t WS_PX = 255 * MiB;
constexpr size_t WS_R2 = 717 * MiB;
constexpr size_t WS_END = 1024 * MiB;
constexpr size_t R2_OF0 = 0, R2_OB0 = 66 * MiB;
constexpr size_t R2_H = 0, R2_STOK = 148 * MiB, R2_SW = 149 * MiB, R2_TOKE = 150 * MiB, R2_TOKW = 151 * MiB, R2_TILEE = 152 * MiB;
constexpr size_t R2_K = 0, R2_V = 99 * MiB, R2_OF1 = 165 * MiB, R2_OB1 = 231 * MiB;
constexpr size_t PX_KVRAW = 346030080;

struct Params {
    const float* in[34];
    float* out;
    unsigned char* ws;
    int ph_lo, ph_hi;
};
enum { I_X = 0, I_C, I_CTX, I_CCTX, I_ADAW, I_ADAB, I_NMIX, I_NFFN, I_EWIN, I_EWOUT, I_GNW, I_GWS, I_GBS, I_LB, I_HNW,
       I_OWIN, I_OWOUT, I_CONVW, I_ALOG, I_DTB, I_GDNNW, I_QNW, I_WQ, I_KVNW, I_WKV, I_QKQ, I_QKK, I_RGW, I_RGB, I_REW, I_REB, I_MG, I_MU, I_MD };

__device__ __forceinline__ float bf2f(bf16_t b) { return __uint_as_float(((unsigned)b) << 16); }
__device__ __forceinline__ bf16_t f2bf(float f) { unsigned u = __float_as_uint(f); u += 0x7FFFu + ((u >> 16) & 1u); return (bf16_t)(u >> 16); }
__device__ __forceinline__ unsigned pack2(float a, float b) { return (unsigned)f2bf(a) | ((unsigned)f2bf(b) << 16); }
__device__ __forceinline__ float lo2f(unsigned u) { return __uint_as_float(u << 16); }
__device__ __forceinline__ float hi2f(unsigned u) { return __uint_as_float(u & 0xffff0000u); }
__device__ __forceinline__ float wave_sum(float v) {
#pragma unroll
    for (int o = 32; o >= 1; o >>= 1) v += __shfl_xor(v, o);
    return v;
}
__device__ __forceinline__ unsigned lds_inc(LAS unsigned* p) { return __hip_atomic_fetch_add(p, 1u, __ATOMIC_RELAXED, __HIP_MEMORY_SCOPE_WORKGROUP); }
__device__ __forceinline__ float sigmoid_f(float x) { return 1.f / (1.f + __expf(-x)); }
__device__ __forceinline__ float silu_f(float x) { return x / (1.f + __expf(-x)); }
__device__ __forceinline__ float gelu_tanh_f(float x) {
    const float u = 0.7978845608028654f * (x + 0.044715f * x * x * x);
    const float t = 1.f - 2.f / (__expf(2.f * u) + 1.f);
    return 0.5f * x * (1.f + t);
}
__device__ __forceinline__ float softplus_f(float x) { return x > 20.f ? x : log1pf(__expf(x)); }

#define XB_TMO      128
#define XB_XCNT(j)  (256  + 64 * (j))
#define XB_XSUB(j)  (1280 + 64 * (j))
#define XB_XGEN(j)  (2304 + 64 * (j))
#define XB_TOP      3328
#define XB_TOPGEN   3392
#define XCD_BAR_WORDS 3456
#define XB_SPIN_CAP (1u << 24)
__device__ __forceinline__ unsigned xb_ld(unsigned* p)              { return __hip_atomic_load(p, __ATOMIC_RELAXED, __HIP_MEMORY_SCOPE_AGENT); }
__device__ __forceinline__ unsigned xb_add(unsigned* p, unsigned v) { return __hip_atomic_fetch_add(p, v, __ATOMIC_RELAXED, __HIP_MEMORY_SCOPE_AGENT); }
__device__ __forceinline__ unsigned xb_xcc_id() { return (unsigned)__builtin_amdgcn_s_getreg((3 << 11) | 20) & 0xFu; }
#define XB_SPIN(cond, bar) do { unsigned _sp = 0; while (cond) { __builtin_amdgcn_s_sleep(1); \
    if ((++_sp & 255u) == 0u) { if (xb_ld(&(bar)[XB_TMO])) break; if (_sp > XB_SPIN_CAP) { atomicAdd(&(bar)[XB_TMO], 1u); break; } } } } while (0)
struct XcdBarrier { unsigned* bar; unsigned x; volatile LAS unsigned* st; };
__device__ __forceinline__ XcdBarrier xcd_barrier_post(unsigned* bar, volatile LAS unsigned* st) {
    XcdBarrier b; b.bar = bar; b.x = xb_xcc_id(); b.st = st;
    if (threadIdx.x == 0) (void)xb_add(&bar[XB_XCNT(b.x)], 1u);
    return b;
}
__device__ __forceinline__ void xcd_barrier_complete(unsigned* bar, unsigned x, unsigned& nloc, unsigned& nx) {
    const unsigned G = gridDim.x * gridDim.y * gridDim.z;
    unsigned sum, cnt, mine, sp = 0u;
    for (;;) {
        sum = 0u; cnt = 0u; mine = 0u;
#pragma unroll
        for (unsigned j = 0; j < 16; ++j) { const unsigned c = xb_ld(&bar[XB_XCNT(j)]); sum += c; cnt += (c > 0u) ? 1u : 0u; mine = (j == x) ? c : mine; }
        if (sum == G) break;
        __builtin_amdgcn_s_sleep(1);
        if ((++sp & 255u) == 0u) { if (xb_ld(&bar[XB_TMO])) break; if (sp > XB_SPIN_CAP) { atomicAdd(&bar[XB_TMO], 1u); break; } }
    }
    nloc = mine > 0u ? mine : 1u; nx = cnt > 0u ? cnt : 1u;
}
__device__ __forceinline__ void xcd_barrier(const XcdBarrier& b) {
    asm volatile("s_waitcnt vmcnt(0)" ::: "memory");
    __syncthreads();
    if (threadIdx.x == 0) {
        unsigned* bar = b.bar;
        __builtin_amdgcn_s_waitcnt(0);
        unsigned nloc = b.st[0], nx = b.st[1];
        if (nloc == 0u) { xcd_barrier_complete(bar, b.x, nloc, nx); b.st[0] = nloc; b.st[1] = nx; }
        const unsigned old = xb_add(&bar[XB_XSUB(b.x)], 1u);
        const unsigned gen = old / nloc;
        if (old + 1u == (gen + 1u) * nloc) {
            __builtin_amdgcn_fence(__ATOMIC_RELEASE, "agent");
            asm volatile("s_waitcnt vmcnt(0)" ::: "memory");
            const unsigned og = xb_add(&bar[XB_TOP], 1u);
            const unsigned tg = og / nx;
            if (og + 1u == (tg + 1u) * nx) xb_add(&bar[XB_TOPGEN], 1u);
            else XB_SPIN(xb_ld(&bar[XB_TOPGEN]) == tg, bar);
            __builtin_amdgcn_fence(__ATOMIC_ACQUIRE, "agent");
            xb_add(&bar[XB_XGEN(b.x)], 1u);
            asm volatile("s_waitcnt vmcnt(0)" ::: "memory");
        } else {
            XB_SPIN(xb_ld(&bar[XB_XGEN(b.x)]) == gen, bar);
            __builtin_amdgcn_fence(__ATOMIC_ACQUIRE, "agent");
            asm volatile("s_waitcnt vmcnt(0)" ::: "memory");
        }
    }
    __syncthreads();
}

struct Frame {
    const Params* P;
    unsigned char* ws;
    LAS unsigned char* lds;
    int tid, lane, wave, G, bid;
    float* mod;
    unsigned* ctrl;
};
__device__ __forceinline__ const float* modp(const Frame& F, int layer, int b, int which) { return F.mod + ((size_t)(layer * 9 + b) * 6 + which) * 1024; }

__device__ __forceinline__ void conv_tile(const Frame& F, const float* src, int K, int N, int lds_, bf16_t* dst, int ldd, int kt, int nt, int rm_mode) {
    LAS float* tile = (LAS float*)F.lds;
    const int t = F.tid;
    {
        const int c = t & 63, r0 = t >> 6;
#pragma unroll
        for (int i = 0; i < 8; ++i) { const int rr = r0 + i * 8, k = kt * 64 + rr, n = nt * 64 + c;
            tile[rr * 65 + c] = (k < K && n < N) ? src[(size_t)k * lds_ + n] : 0.f; }
    }
    __syncthreads();
    {
        const int nl = t >> 3, kc = (t & 7) * 8, n = nt * 64 + nl;
        int row = n;
        if (rm_mode == 1) row = (n >> 7) * 256 + (n & 127);
        else if (rm_mode == 2) row = (n >> 7) * 256 + 128 + (n & 127);
        float v[8];
#pragma unroll
        for (int j = 0; j < 8; ++j) v[j] = tile[(kc + j) * 65 + nl];
        u32x4 w; w.x = pack2(v[0], v[1]); w.y = pack2(v[2], v[3]); w.z = pack2(v[4], v[5]); w.w = pack2(v[6], v[7]);
        *(u32x4*)(dst + (size_t)row * ldd + kt * 64 + kc) = w;
    }
    __syncthreads();
}
__device__ __forceinline__ void conv_moe_weights(const Frame& F, int layer, int item0, int stride) {
    const Params& P = *F.P;
    bf16_t* W1 = (bf16_t*)(F.ws + WS_WMOE); bf16_t* W2 = W1 + (size_t)32 * 1024 * 1024;
    for (int it = item0; it < 12288; it += stride) {
        if (it < 8192) {
            const int up = it >= 4096, j = it & 4095, e = j >> 7, r = j & 127, kt = r >> 3, nt = r & 7;
            const float* src = P.in[up ? I_MU : I_MG] + ((size_t)(layer * 32 + e)) * 1024 * 512;
            conv_tile(F, src, 1024, 512, 512, W1 + (size_t)e * 1024 * 1024, 1024, kt, nt, up ? 2 : 1);
        } else {
            const int j = it - 8192, e = j >> 7, r = j & 127, kt = r >> 4, nt = r & 15;
            const float* src = P.in[I_MD] + ((size_t)(layer * 32 + e)) * 512 * 1024;
            conv_tile(F, src, 512, 1024, 1024, W2 + (size_t)e * 1024 * 512, 512, kt, nt, 0);
        }
    }
}
__device__ __forceinline__ void ph_prologue(const Frame& F) {
    const Params& P = *F.P;
    for (int it = F.bid; it < 192; it += F.G) {
        const int l = it / 96, r = it % 96, cb = r >> 3, kp = r & 7;
        LAS float* sc = (LAS float*)F.lds;
        for (int i = F.tid; i < 9 * 128; i += NTH) { const int rr = i >> 7, k = kp * 128 + (i & 127);
            const float cv = rr < 8 ? P.in[I_C][rr * 1024 + k] : P.in[I_CCTX][k]; sc[i] = silu_f(cv); }
        __syncthreads();
        const int n = cb * 512 + F.tid;
        float acc[9];
#pragma unroll
        for (int rr = 0; rr < 9; ++rr) acc[rr] = 0.f;
        const float* w = P.in[I_ADAW] + ((size_t)l * 1024 + kp * 128) * 6144 + n;
        for (int k = 0; k < 128; ++k) { const float wv = w[(size_t)k * 6144];
#pragma unroll
            for (int rr = 0; rr < 9; ++rr) acc[rr] += sc[rr * 128 + k] * wv; }
        const float bias = kp == 0 ? P.in[I_ADAB][l * 6144 + n] : 0.f;
#pragma unroll
        for (int rr = 0; rr < 9; ++rr) atomicAdd(F.mod + (size_t)(l * 9 + rr) * 6144 + n, acc[rr] + bias);
        __syncthreads();
    }
    bf16_t* wsm = (bf16_t*)(F.ws + WS_WSM);
    for (int it = F.bid; it < 2160; it += F.G) {
        int j = it;
        if (j < 896) { conv_tile(F, P.in[I_EWIN], 1024, 3584, 3584, wsm + W_EIN / 2, 1024, j / 56, j % 56, 0); continue; } j -= 896;
        if (j < 256) { conv_tile(F, P.in[I_EWOUT], 1024, 1024, 1024, wsm + W_EOUT / 2, 1024, j >> 4, j & 15, 0); continue; } j -= 256;
        if (j < 640) { conv_tile(F, P.in[I_OWIN], 1024, 2480, 2480, wsm + W_OIN / 2, 1024, j / 40, j % 40, 0); continue; } j -= 640;
        if (j < 256) { conv_tile(F, P.in[I_OWOUT], 1024, 1024, 1024, wsm + W_OOUT / 2, 1024, j >> 4, j & 15, 0); continue; } j -= 256;
        if (j < 48) { conv_tile(F, P.in[I_WQ], 256, 768, 768, wsm + W_WQ / 2, 256, j / 12, j % 12, 0); continue; } j -= 48;
        conv_tile(F, P.in[I_WKV], 128, 1024, 1024, wsm + W_WKV / 2, 256, j >> 4, j & 15, 0);
    }
    conv_moe_weights(F, 0, F.bid, F.G);
}

template <bool ROUTER>
__device__ __forceinline__ void ph_rownorm(const Frame& F, int layer, int nrows, const float* xlat, const float* xctx, const float* nw, int si) {
    const Params& P = *F.P;
    bf16_t* dst = (bf16_t*)(F.ws + WS_ACT);
    LAS unsigned* hist = (LAS unsigned*)F.lds;
    int* tok_e = (int*)(F.ws + WS_R2 + R2_TOKE); float* tok_w = (float*)(F.ws + WS_R2 + R2_TOKW);
    if (ROUTER) { if (F.tid < 64) hist[F.tid] = 0u; __syncthreads();
        int* stok = (int*)(F.ws + WS_R2 + R2_STOK);
        for (int i = F.bid * NTH + F.tid; i < MAXSLOTS; i += F.G * NTH) stok[i] = -1; }
    const float* rgw = P.in[I_RGW] + (size_t)layer * 1024 * 4; const float* rew = P.in[I_REW] + (size_t)layer * 1024 * 32;
    for (int r = F.bid * 8 + F.wave; r < nrows; r += F.G * 8) {
        const float* src = r < TL ? xlat + (size_t)r * 1024 : xctx + (size_t)(r - TL) * 1024;
        const int b = r < TL ? (r >> 13) : 8;
        const float* sh = modp(F, layer, b, si); const float* sc = modp(F, layer, b, si + 1);
        f32x4 v[4]; float ss = 0.f;
#pragma unroll
        for (int j = 0; j < 4; ++j) { v[j] = *(const f32x4*)(src + j * 256 + F.lane * 4); ss += v[j][0] * v[j][0] + v[j][1] * v[j][1] + v[j][2] * v[j][2] + v[j][3] * v[j][3]; }
        ss = wave_sum(ss);
        const float rstd = rsqrtf(ss * (1.f / 1024.f) + EPS);
#pragma unroll
        for (int j = 0; j < 4; ++j) { const int c = j * 256 + F.lane * 4;
            const f32x4 w = *(const f32x4*)(nw + c), s1 = *(const f32x4*)(sc + c), s0 = *(const f32x4*)(sh + c);
            v[j] = (v[j] * rstd * w) * (1.f + s1) + s0;
            u32x2 o; o.x = pack2(v[j][0], v[j][1]); o.y = pack2(v[j][2], v[j][3]);
            *(u32x2*)(dst + (size_t)r * 1024 + c) = o; }
        if (ROUTER) {
            float acc[36];
#pragma unroll
            for (int e = 0; e < 36; ++e) acc[e] = 0.f;
#pragma unroll
            for (int j = 0; j < 4; ++j)
#pragma unroll
                for (int i = 0; i < 4; ++i) { const int c = j * 256 + F.lane * 4 + i; const float h = v[j][i];
                    const f32x4 g = *(const f32x4*)(rgw + (size_t)c * 4);
                    acc[0] += h * g[0]; acc[1] += h * g[1]; acc[2] += h * g[2]; acc[3] += h * g[3];
#pragma unroll
                    for (int q = 0; q < 8; ++q) { const f32x4 w = *(const f32x4*)(rew + (size_t)c * 32 + q * 4);
                        acc[4 + q * 4 + 0] += h * w[0]; acc[4 + q * 4 + 1] += h * w[1]; acc[4 + q * 4 + 2] += h * w[2]; acc[4 + q * 4 + 3] += h * w[3]; } }
#pragma unroll
            for (int e = 0; e < 36; ++e) acc[e] = wave_sum(acc[e]);
            const float* rgb = P.in[I_RGB] + layer * 4; const float* reb = P.in[I_REB] + layer * 32;
            float lg[4];
#pragma unroll
            for (int i = 0; i < 4; ++i) lg[i] = acc[i] + rgb[i];
            int g = 0; float best = lg[0];
#pragma unroll
            for (int i = 1; i < 4; ++i) if (lg[i] > best) { best = lg[i]; g = i; }
            float den = 0.f;
#pragma unroll
            for (int i = 0; i < 4; ++i) den += __expf(lg[i] - best);
            const float pg = 1.f / den;
            float le[8];
#pragma unroll
            for (int i = 0; i < 8; ++i) { const float l0 = acc[4 + i] + reb[i], l1 = acc[12 + i] + reb[8 + i], l2 = acc[20 + i] + reb[16 + i], l3 = acc[28 + i] + reb[24 + i];
                le[i] = g == 0 ? l0 : (g == 1 ? l1 : (g == 2 ? l2 : l3)); }
            int i1 = 0; float b1 = le[0];
#pragma unroll
            for (int i = 1; i < 8; ++i) if (le[i] > b1) { b1 = le[i]; i1 = i; }
            int i2 = -1; float b2 = -3.0e38f;
#pragma unroll
            for (int i = 0; i < 8; ++i) if (i != i1 && le[i] > b2) { b2 = le[i]; i2 = i; }
            const float e2 = __expf(b2 - b1);
            const float w1 = pg / (1.f + e2), w2 = pg * e2 / (1.f + e2);
            const int e0g = g * 8 + i1, e1g = g * 8 + i2;
            if (F.lane == 0) { tok_e[r] = e0g | (e1g << 8); tok_w[2 * r] = w1; tok_w[2 * r + 1] = w2;
                lds_inc(&hist[e0g]); lds_inc(&hist[32 + e1g]); }
        }
    }
    if (ROUTER) { __syncthreads(); unsigned* cnt = (unsigned*)(F.ws + WS_CTRL + C_MOE + layer * 1024);
        if (F.tid < 64 && hist[F.tid]) atomicAdd(&cnt[F.tid], hist[F.tid]); __syncthreads(); }
}

__device__ __forceinline__ void ph_dispatch(const Frame& F, int layer, int ntok) {
    unsigned* cnt = (unsigned*)(F.ws + WS_CTRL + C_MOE + layer * 1024); unsigned* cursor = cnt + 64; unsigned* info = cnt + 128;
    LAS unsigned* base = (LAS unsigned*)F.lds; LAS unsigned* lh = base + 64; LAS unsigned* gb = base + 128; LAS unsigned* lh2 = base + 192; LAS unsigned* pad = base + 256;
    const int* tok_e = (const int*)(F.ws + WS_R2 + R2_TOKE); const float* tok_w = (const float*)(F.ws + WS_R2 + R2_TOKW);
    int* stok = (int*)(F.ws + WS_R2 + R2_STOK); float* sw = (float*)(F.ws + WS_R2 + R2_SW); int* tile_e = (int*)(F.ws + WS_R2 + R2_TILEE);
    if (F.tid < 64) { pad[F.tid] = (__hip_atomic_load(&cnt[F.tid], __ATOMIC_RELAXED, __HIP_MEMORY_SCOPE_AGENT) + 255u) & ~255u; lh[F.tid] = 0u; lh2[F.tid] = 0u; }
    __syncthreads();
    if (F.tid == 0) { unsigned a = 0; for (int i = 0; i < 64; ++i) { base[i] = a; a += pad[i]; } base[320] = a; }
    __syncthreads();
    if (F.bid == 0) {
        for (int i = F.tid; i < MAXTILES; i += NTH) { const unsigned s = (unsigned)i * 256u; int l = -1;
            for (int j = 0; j < 64; ++j) if (s >= base[j] && s < base[j] + pad[j]) l = j;
            tile_e[i] = l; }
        if (F.tid == 0) { info[0] = base[32] / 256u; info[1] = base[320] / 256u; }
    }
    const int per = (ntok + F.G - 1) / F.G, t0 = F.bid * per, t1 = min(ntok, t0 + per);
    for (int t = t0 + F.tid; t < t1; t += NTH) { const int e = tok_e[t]; lds_inc(&lh[e & 255]); lds_inc(&lh[32 + (e >> 8)]); }
    __syncthreads();
    if (F.tid < 64) gb[F.tid] = lh[F.tid] ? __hip_atomic_fetch_add(&cursor[F.tid], lh[F.tid], __ATOMIC_RELAXED, __HIP_MEMORY_SCOPE_AGENT) : 0u;
    __syncthreads();
    for (int t = t0 + F.tid; t < t1; t += NTH) { const int e = tok_e[t];
        const int l0 = e & 255, l1 = 32 + (e >> 8);
        const unsigned p0 = base[l0] + gb[l0] + lds_inc(&lh2[l0]), p1 = base[l1] + gb[l1] + lds_inc(&lh2[l1]);
        stok[p0] = t; sw[p0] = tok_w[2 * t]; stok[p1] = t; sw[p1] = tok_w[2 * t + 1]; }
    __syncthreads();
}

template <class AF, class EP>
__device__ __forceinline__ void gemm_unit_naive(const Frame& F, int K, const AF& arow, const bf16_t* Bt, const EP& E, int pm, int pn) {
    LAS float* As = (LAS float*)F.lds;
    LAS float* Bs = As + 32 * 132;
    const int t = F.tid, ty = t >> 5, tx = t & 31;
    for (int half = 0; half < 2; ++half) {
        float acc[8][8];
#pragma unroll
        for (int i = 0; i < 8; ++i)
#pragma unroll
            for (int j = 0; j < 8; ++j) acc[i][j] = 0.f;
        const bf16_t* ap = arow(half * 128 + (t >> 2));
        const bf16_t* bp = Bt + (size_t)(t >> 1) * K;
        for (int k0 = 0; k0 < K; k0 += 32) {
            { const int r = t >> 2, kq = (t & 3) * 8; u32x4 w = {0u, 0u, 0u, 0u}; if (ap) w = *(const u32x4*)(ap + k0 + kq);
              As[(kq + 0) * 132 + r] = lo2f(w.x); As[(kq + 1) * 132 + r] = hi2f(w.x); As[(kq + 2) * 132 + r] = lo2f(w.y); As[(kq + 3) * 132 + r] = hi2f(w.y);
              As[(kq + 4) * 132 + r] = lo2f(w.z); As[(kq + 5) * 132 + r] = hi2f(w.z); As[(kq + 6) * 132 + r] = lo2f(w.w); As[(kq + 7) * 132 + r] = hi2f(w.w); }
            { const int n = t >> 1, kh = (t & 1) * 16;
#pragma unroll
              for (int q = 0; q < 2; ++q) { const u32x4 w = *(const u32x4*)(bp + k0 + kh + q * 8); const int kk = kh + q * 8;
                Bs[(kk + 0) * 260 + n] = lo2f(w.x); Bs[(kk + 1) * 260 + n] = hi2f(w.x); Bs[(kk + 2) * 260 + n] = lo2f(w.y); Bs[(kk + 3) * 260 + n] = hi2f(w.y);
                Bs[(kk + 4) * 260 + n] = lo2f(w.z); Bs[(kk + 5) * 260 + n] = hi2f(w.z); Bs[(kk + 6) * 260 + n] = lo2f(w.w); Bs[(kk + 7) * 260 + n] = hi2f(w.w); } }
            __syncthreads();
#pragma unroll 4
            for (int k = 0; k < 32; ++k) {
                const f32x4 a0 = *(const LAS f32x4*)(As + k * 132 + ty * 8), a1 = *(const LAS f32x4*)(As + k * 132 + ty * 8 + 4);
                const f32x4 b0 = *(const LAS f32x4*)(Bs + k * 260 + tx * 4), b1 = *(const LAS f32x4*)(Bs + k * 260 + 128 + tx * 4);
#pragma unroll
                for (int i = 0; i < 8; ++i) { const float a = i < 4 ? a0[i & 3] : a1[i & 3];
#pragma unroll
                    for (int j = 0; j < 4; ++j) { acc[i][j] += a * b0[j]; acc[i][4 + j] += a * b1[j]; } }
            }
            __syncthreads();
        }
#pragma unroll
        for (int i = 0; i < 8; ++i) { const f32x4 v0 = {acc[i][0], acc[i][1], acc[i][2], acc[i][3]}, v1 = {acc[i][4], acc[i][5], acc[i][6], acc[i][7]};
            E(pm * 256 + half * 128 + ty * 8 + i, pn, tx * 4, v0, v1); }
    }
}
struct ARowDense { const bf16_t* A; int K; int pm; __device__ __forceinline__ const bf16_t* operator()(int r) const { return A + (size_t)(pm * 256 + r) * K; } };
struct ARowGather { const bf16_t* A; const int* stok; int pm; __device__ __forceinline__ const bf16_t* operator()(int r) const { const int t = stok[pm * 256 + r]; return t < 0 ? nullptr : A + (size_t)t * 1024; } };

template <class EP>
__device__ __forceinline__ void gemm_dense_naive(const Frame& F, const bf16_t* A, const bf16_t* Bt, int M, int N, int K, const EP& E) {
    const int nM = M / 256, nN = N / 256;
    for (int u = F.bid; u < nM * nN; u += F.G) { const int pm = u / nN, pn = u % nN;
        ARowDense ar{A, K, pm}; gemm_unit_naive(F, K, ar, Bt + (size_t)pn * 256 * K, E, pm, pn); }
}

struct EpiStoreBf16 { bf16_t* O; int ldc; int gelu_below;
    __device__ __forceinline__ void operator()(int row, int pn, int cx, f32x4 v0, f32x4 v1) const {
        const int c0 = pn * 256 + cx, c1 = c0 + 128;
        if (c0 < gelu_below) { v0[0] = gelu_tanh_f(v0[0]); v0[1] = gelu_tanh_f(v0[1]); v0[2] = gelu_tanh_f(v0[2]); v0[3] = gelu_tanh_f(v0[3]); }
        if (c1 < gelu_below) { v1[0] = gelu_tanh_f(v1[0]); v1[1] = gelu_tanh_f(v1[1]); v1[2] = gelu_tanh_f(v1[2]); v1[3] = gelu_tanh_f(v1[3]); }
        u32x2 a; a.x = pack2(v0[0], v0[1]); a.y = pack2(v0[2], v0[3]); u32x2 b; b.x = pack2(v1[0], v1[1]); b.y = pack2(v1[2], v1[3]);
        *(u32x2*)(O + (size_t)row * ldc + c0) = a; *(u32x2*)(O + (size_t)row * ldc + c1) = b; } };
struct EpiResidual { const float* srcl; const float* srcc; float* dstl; float* dstc; const float* mod;   int which;
    __device__ __forceinline__ void operator()(int row, int pn, int cx, f32x4 v0, f32x4 v1) const {
        const int b = row < TL ? (row >> 13) : 8; const float* g = mod + ((size_t)b * 6 + which) * 1024;
        const float* s = row < TL ? srcl + (size_t)row * 1024 : srcc + (size_t)(row - TL) * 1024;
        float* d = row < TL ? dstl + (size_t)row * 1024 : dstc + (size_t)(row - TL) * 1024;
        const int c0 = pn * 256 + cx, c1 = c0 + 128;
        *(f32x4*)(d + c0) = *(const f32x4*)(s + c0) + *(const f32x4*)(g + c0) * v0;
        *(f32x4*)(d + c1) = *(const f32x4*)(s + c1) + *(const f32x4*)(g + c1) * v1; } };
struct EpiMoe1 { bf16_t* H;
    __device__ __forceinline__ void operator()(int row, int pn, int cx, f32x4 v0, f32x4 v1) const {
        u32x2 a; a.x = pack2(silu_f(v0[0]) * v1[0], silu_f(v0[1]) * v1[1]); a.y = pack2(silu_f(v0[2]) * v1[2], silu_f(v0[3]) * v1[3]);
        *(u32x2*)(H + (size_t)row * 512 + pn * 128 + cx) = a; } };
struct EpiMoe2 { const int* stok; const float* sw; float* dstl; float* dstc; const float* mod;
    __device__ __forceinline__ void operator()(int row, int pn, int cx, f32x4 v0, f32x4 v1) const {
        const int t = stok[row]; if (t < 0) return; const float w = sw[row];
        const int b = t < TL ? (t >> 13) : 8; const float* g = mod + ((size_t)b * 6 + 5) * 1024;
        float* d = t < TL ? dstl + (size_t)t * 1024 : dstc + (size_t)(t - TL) * 1024;
        const int c0 = pn * 256 + cx, c1 = c0 + 128;
        *(f32x4*)(d + c0) = *(const f32x4*)(d + c0) + *(const f32x4*)(g + c0) * v0 * w;
        *(f32x4*)(d + c1) = *(const f32x4*)(d + c1) + *(const f32x4*)(g + c1) * v1 * w; } };

__device__ __forceinline__ void ph_moe_gemm1(const Frame& F, int layer) {
    const unsigned* info = (const unsigned*)(F.ws + WS_CTRL + C_MOE + layer * 1024) + 128;
    const int ntiles = (int)__hip_atomic_load(&info[1], __ATOMIC_RELAXED, __HIP_MEMORY_SCOPE_AGENT);
    const int* tile_e = (const int*)(F.ws + WS_R2 + R2_TILEE); const int* stok = (const int*)(F.ws + WS_R2 + R2_STOK);
    const bf16_t* W1 = (const bf16_t*)(F.ws + WS_WMOE);
    EpiMoe1 E{(bf16_t*)(F.ws + WS_R2 + R2_H)};
    for (int u = F.bid; u < ntiles * 4; u += F.G) { const int pm = u >> 2, pn = u & 3; const int e = tile_e[pm] & 31;
        ARowGather ar{(const bf16_t*)(F.ws + WS_ACT), stok, pm};
        gemm_unit_naive(F, 1024, ar, W1 + ((size_t)e * 1024 + pn * 256) * 1024, E, pm, pn); }
}
__device__ __forceinline__ void ph_moe_gemm2(const Frame& F, int layer, int k) {
    const unsigned* info = (const unsigned*)(F.ws + WS_CTRL + C_MOE + layer * 1024) + 128;
    const int nk0 = (int)__hip_atomic_load(&info[0], __ATOMIC_RELAXED, __HIP_MEMORY_SCOPE_AGENT), nall = (int)__hip_atomic_load(&info[1], __ATOMIC_RELAXED, __HIP_MEMORY_SCOPE_AGENT);
    const int tlo = k == 0 ? 0 : nk0, thi = k == 0 ? nk0 : nall;
    const int* tile_e = (const int*)(F.ws + WS_R2 + R2_TILEE);
    const bf16_t* W2 = (const bf16_t*)(F.ws + WS_WMOE) + (size_t)32 * 1024 * 1024;
    EpiMoe2 E{(const int*)(F.ws + WS_R2 + R2_STOK), (const float*)(F.ws + WS_R2 + R2_SW), F.P->out, (float*)(F.ws + WS_XC), F.mod + (size_t)layer * 9 * 6144};
    for (int u = F.bid; u < (thi - tlo) * 4; u += F.G) { const int pm = tlo + (u >> 2), pn = u & 3; const int e = tile_e[pm] & 31;
        ARowDense ar{(const bf16_t*)(F.ws + WS_R2 + R2_H), 512, pm};
        gemm_unit_naive(F, 512, ar, W2 + ((size_t)e * 1024 + pn * 256) * 512, E, pm, pn); }
}

__device__ __forceinline__ void ph_gmlp(const Frame& F) {
    const Params& P = *F.P;
    const bf16_t* PX = (const bf16_t*)(F.ws + WS_PX); bf16_t* CAT = (bf16_t*)(F.ws + WS_ACT);
    LAS float* Vs = (LAS float*)F.lds;
    LAS float* Wm = Vs + 128 * 128;
    LAS float* rs = Wm + 128 * 129;
    for (int it = F.bid; it < 528 * 4; it += F.G) {
        const int ch = it >> 2, g = it & 3, row0 = ch * 128;
        for (int q = F.wave; q < 128; q += 8) { const bf16_t* p = PX + (size_t)(row0 + q) * EVEN_IN + 512 + F.lane * 8;
            const u32x4 w = *(const u32x4*)p; float s = 0.f, x;
            x = lo2f(w.x); s += x * x; x = hi2f(w.x); s += x * x; x = lo2f(w.y); s += x * x; x = hi2f(w.y); s += x * x;
            x = lo2f(w.z); s += x * x; x = hi2f(w.z); s += x * x; x = lo2f(w.w); s += x * x; x = hi2f(w.w); s += x * x;
            s = wave_sum(s); if (F.lane == 0) rs[q] = rsqrtf(s * (1.f / 512.f) + EPS); }
        __syncthreads();
        for (int i = F.tid; i < 128 * 128; i += NTH) { const int q = i >> 7, c = i & 127;
            Vs[i] = bf2f(PX[(size_t)(row0 + q) * EVEN_IN + 512 + g * 128 + c]) * rs[q] * P.in[I_GNW][g * 128 + c];
            Wm[q * 129 + c] = P.in[I_GWS][(size_t)g * 16384 + i]; }
        __syncthreads();
        const int ty = F.tid >> 5, tx = F.tid & 31;
        float acc[8][4];
#pragma unroll
        for (int i = 0; i < 8; ++i)
#pragma unroll
            for (int j = 0; j < 4; ++j) acc[i][j] = 0.f;
        for (int q = 0; q < 128; ++q) { const f32x4 v = *(const LAS f32x4*)(Vs + q * 128 + tx * 4);
#pragma unroll
            for (int i = 0; i < 8; ++i) { const float w = Wm[(ty * 8 + i) * 129 + q];
#pragma unroll
                for (int j = 0; j < 4; ++j) acc[i][j] += w * v[j]; } }
#pragma unroll
        for (int i = 0; i < 8; ++i) { const int p = ty * 8 + i; const float bias = P.in[I_GBS][g * 128 + p];
            const size_t t = (size_t)(row0 + p); const int col = g * 128 + tx * 4;
            const u32x2 uu = *(const u32x2*)(PX + t * EVEN_IN + col);
            u32x2 o; o.x = pack2(lo2f(uu.x) * (acc[i][0] + bias), hi2f(uu.x) * (acc[i][1] + bias)); o.y = pack2(lo2f(uu.y) * (acc[i][2] + bias), hi2f(uu.y) * (acc[i][3] + bias));
            *(u32x2*)(CAT + t * 1024 + col) = o; }
        __syncthreads();
    }
}

__device__ __forceinline__ void ph_gla(const Frame& F) {
    const Params& P = *F.P;
    const bf16_t* PX = (const bf16_t*)(F.ws + WS_PX);
    LAS float* qs = (LAS float*)F.lds;
    LAS float* fs = qs + 2048;
    LAS float* vs = fs + 2048;
    LAS float* os = vs + 512;
    for (int it = F.bid; it < 256; it += F.G) {
        const int b = it >> 5, h = (it >> 3) & 3, dir = (it >> 2) & 1, sl = it & 3;
        bf16_t* O = (bf16_t*)(F.ws + WS_R2 + (dir ? R2_OB0 : R2_OF0));
        float lb[4];
        { const int ch = h * 128 + (F.tid & 127); const float* lg = P.in[I_LB] + (size_t)dir * 3 * 512 + ch;
          const float a0 = lg[0], a1 = lg[512], a2 = lg[1024]; const float m = fmaxf(a0, fmaxf(a1, a2));
          const float e0 = __expf(a0 - m), e1 = __expf(a1 - m), e2 = __expf(a2 - m); lb[0] = e0 / (e0 + e1 + e2); }
        float S0[4], S1[4];
#pragma unroll
        for (int j = 0; j < 4; ++j) { S0[j] = 0.f; S1[j] = 0.f; }
        for (int seg = 0; seg < 2; ++seg) {
            const int len = seg == 0 ? CTXL : SEQ; const size_t rbase = seg == 0 ? (size_t)TL + b * CTXL : (size_t)b * SEQ;
            for (int blk = 0; blk < len / 16; ++blk) {
                { const int d = F.tid & 127;
#pragma unroll
                  for (int i = 0; i < 4; ++i) { const int s = (F.tid >> 7) + i * 4; const int tt = blk * 16 + s; const int p = dir ? len - 1 - tt : tt;
                    const bf16_t* row = PX + (rbase + p) * EVEN_IN;
                    qs[s * 128 + d] = bf2f(row[1024 + h * 128 + d]);
                    const float fr = bf2f(row[2048 + dir * 512 + h * 128 + d]);
                    fs[s * 128 + d] = lb[0] + (1.f - lb[0]) * sigmoid_f(fr); }
                  { const int s = F.tid >> 5, e = F.tid & 31; const int tt = blk * 16 + s; const int p = dir ? len - 1 - tt : tt;
                    vs[s * 32 + e] = bf2f(PX[(rbase + p) * EVEN_IN + 1536 + h * 128 + sl * 32 + e]); } }
                __syncthreads();
#pragma unroll 4
                for (int s = 0; s < 16; ++s) {
                    const float f0 = fs[s * 128 + F.lane], f1 = fs[s * 128 + 64 + F.lane], q0 = qs[s * 128 + F.lane], q1 = qs[s * 128 + 64 + F.lane];
                    const float k0 = 1.f - f0, k1 = 1.f - f1;
                    float part[4];
#pragma unroll
                    for (int j = 0; j < 4; ++j) { const float v = vs[s * 32 + F.wave * 4 + j];
                        S0[j] = f0 * S0[j] + k0 * v; S1[j] = f1 * S1[j] + k1 * v; part[j] = q0 * S0[j] + q1 * S1[j]; }
#pragma unroll
                    for (int j = 0; j < 4; ++j) part[j] = wave_sum(part[j]);
                    if (F.lane == 0) { os[s * 32 + F.wave * 4 + 0] = part[0]; os[s * 32 + F.wave * 4 + 1] = part[1]; os[s * 32 + F.wave * 4 + 2] = part[2]; os[s * 32 + F.wave * 4 + 3] = part[3]; }
                }
                __syncthreads();
                { const int s = F.tid >> 5, e = F.tid & 31; const int tt = blk * 16 + s; const int p = dir ? len - 1 - tt : tt;
                  O[(rbase + p) * 512 + h * 128 + sl * 32 + e] = f2bf(os[s * 32 + e]); }
            }
        }
        __syncthreads();
    }
}

__device__ __forceinline__ void ph_merge(const Frame& F, int mode) {
    const Params& P = *F.P;
    const bf16_t* PX = (const bf16_t*)(F.ws + WS_PX); bf16_t* CAT = (bf16_t*)(F.ws + WS_ACT);
    const bf16_t* Of = (const bf16_t*)(F.ws + WS_R2 + (mode ? R2_OF1 : R2_OF0)); const bf16_t* Ob = (const bf16_t*)(F.ws + WS_R2 + (mode ? R2_OB1 : R2_OB0));
    const int nrows = mode ? TL : TT, ldp = mode ? ODD_PAD : EVEN_IN, gcol = mode ? 1536 : 3072, dcol = mode ? 0 : 512;
    const float* nw = mode ? P.in[I_GDNNW] : P.in[I_HNW];
    for (int r = F.bid * 8 + F.wave; r < nrows; r += F.G * 8) {
        const int c = F.lane * 8;
        const u32x4 a = *(const u32x4*)(Of + (size_t)r * 512 + c), bb = *(const u32x4*)(Ob + (size_t)r * 512 + c), gg = *(const u32x4*)(PX + (size_t)r * ldp + gcol + c);
        float o[8] = {lo2f(a.x) + lo2f(bb.x), hi2f(a.x) + hi2f(bb.x), lo2f(a.y) + lo2f(bb.y), hi2f(a.y) + hi2f(bb.y), lo2f(a.z) + lo2f(bb.z), hi2f(a.z) + hi2f(bb.z), lo2f(a.w) + lo2f(bb.w), hi2f(a.w) + hi2f(bb.w)};
        const float g[8] = {lo2f(gg.x), hi2f(gg.x), lo2f(gg.y), hi2f(gg.y), lo2f(gg.z), hi2f(gg.z), lo2f(gg.w), hi2f(gg.w)};
        float ss = 0.f;
#pragma unroll
        for (int i = 0; i < 8; ++i) ss += o[i] * o[i];
        ss += __shfl_xor(ss, 1); ss += __shfl_xor(ss, 2); ss += __shfl_xor(ss, 4); ss += __shfl_xor(ss, 8);
        const float rstd = rsqrtf(ss * (1.f / 128.f) + EPS);
        float y[8];
#pragma unroll
        for (int i = 0; i < 8; ++i) { const float w = mode ? nw[(c & 127) + i] : nw[c + i]; y[i] = o[i] * rstd * w * silu_f(g[i]); }
        u32x4 w; w.x = pack2(y[0], y[1]); w.y = pack2(y[2], y[3]); w.z = pack2(y[4], y[5]); w.w = pack2(y[6], y[7]);
        *(u32x4*)(CAT + (size_t)r * 1024 + dcol + c) = w;
    }
}

__device__ __forceinline__ void ph_mla_norm(const Frame& F) {
    const Params& P = *F.P;
    const bf16_t* PX = (const bf16_t*)(F.ws + WS_PX);
    bf16_t* cqn = (bf16_t*)(F.ws + WS_ACT); bf16_t* ckvn = cqn + (size_t)TL * 256;
    for (int r = F.bid * 8 + F.wave; r < TT; r += F.G * 8) {
        const bf16_t* row = PX + (size_t)r * ODD_PAD;
        if (r < TL) { const u32x2 w = *(const u32x2*)(row + 2064 + F.lane * 4);
            const float x0 = lo2f(w.x), x1 = hi2f(w.x), x2 = lo2f(w.y), x3 = hi2f(w.y);
            const float ss = wave_sum(x0 * x0 + x1 * x1 + x2 * x2 + x3 * x3); const float rstd = rsqrtf(ss * (1.f / 256.f) + EPS);
            const float* nw = P.in[I_QNW] + F.lane * 4;
            u32x2 o; o.x = pack2(x0 * rstd * nw[0], x1 * rstd * nw[1]); o.y = pack2(x2 * rstd * nw[2], x3 * rstd * nw[3]);
            *(u32x2*)(cqn + (size_t)r * 256 + F.lane * 4) = o; }
        { const unsigned w = *(const unsigned*)(row + 2320 + F.lane * 2);
          const float x0 = lo2f(w), x1 = hi2f(w);
          const float ss = wave_sum(x0 * x0 + x1 * x1); const float rstd = rsqrtf(ss * (1.f / 128.f) + EPS);
          const float* nw = P.in[I_KVNW] + F.lane * 2;
          *(unsigned*)(ckvn + (size_t)r * 256 + F.lane * 2) = pack2(x0 * rstd * nw[0], x1 * rstd * nw[1]);
          *(unsigned*)(ckvn + (size_t)r * 256 + 128 + F.lane * 2) = 0u; }
    }
}

__device__ __forceinline__ void ph_mla_final(const Frame& F) {
    const Params& P = *F.P;
    const bf16_t* PX = (const bf16_t*)(F.ws + WS_PX);
    bf16_t* Q = (bf16_t*)(F.ws + WS_WMOE);
    const bf16_t* KVR = (const bf16_t*)(F.ws + WS_PX + PX_KVRAW);
    bf16_t* Kb = (bf16_t*)(F.ws + WS_R2 + R2_K); bf16_t* Vb = (bf16_t*)(F.ws + WS_R2 + R2_V);
    const int hh = F.lane >> 3, sub = F.lane & 7;
    const float freq = __powf(10000.f, -(float)sub * 0.125f);
    const float qscale = 0.10206207261596577f;
    for (int r = F.bid * 8 + F.wave; r < TT; r += F.G * 8) {
        const bool lat = r < TL; const int l = r & (SEQ - 1);
        float ca = 1.f, sa = 0.f, cb = 1.f, sb = 0.f;
        if (lat) { const float pr = (float)(l >> 6), pc = (float)(l & 63); sincosf(pr * freq, &sa, &ca); sincosf(pc * freq, &sb, &cb); }
        { const bf16_t* kv = KVR + (size_t)r * 1024 + hh * 128;
          const u32x4 w = *(const u32x4*)(kv + sub * 8);
          float x[12] = {lo2f(w.x), hi2f(w.x), lo2f(w.y), hi2f(w.y), lo2f(w.z), hi2f(w.z), lo2f(w.w), hi2f(w.w), 0.f, 0.f, 0.f, 0.f};
          const bf16_t* kr = PX + (size_t)r * ODD_PAD + 2448;
          x[8] = bf2f(kr[sub]); x[9] = bf2f(kr[8 + sub]); x[10] = bf2f(kr[16 + sub]); x[11] = bf2f(kr[24 + sub]);
          float ss = 0.f;
#pragma unroll
          for (int i = 0; i < 12; ++i) ss += x[i] * x[i];
          ss += __shfl_xor(ss, 1); ss += __shfl_xor(ss, 2); ss += __shfl_xor(ss, 4);
          const float rstd = rsqrtf(ss * (1.f / 96.f) + EPS);
          const float* nw = P.in[I_QKK];
#pragma unroll
          for (int i = 0; i < 8; ++i) x[i] *= rstd * nw[sub * 8 + i];
          x[8] *= rstd * nw[64 + sub]; x[9] *= rstd * nw[72 + sub]; x[10] *= rstd * nw[80 + sub]; x[11] *= rstd * nw[88 + sub];
          const float a1 = x[8] * ca - x[9] * sa, a2 = x[9] * ca + x[8] * sa, b1 = x[10] * cb - x[11] * sb, b2 = x[11] * cb + x[10] * sb;
          const int bidx = lat ? (r >> 13) : ((r - TL) >> 8); const int s = lat ? (CTXL + l) : ((r - TL) & 255);
          bf16_t* kd = Kb + ((size_t)(bidx * 8 + hh) * (SEQ + CTXL) + s) * 96;
          u32x4 o; o.x = pack2(x[0], x[1]); o.y = pack2(x[2], x[3]); o.z = pack2(x[4], x[5]); o.w = pack2(x[6], x[7]);
          *(u32x4*)(kd + sub * 8) = o;
          kd[64 + sub] = f2bf(a1); kd[72 + sub] = f2bf(a2); kd[80 + sub] = f2bf(b1); kd[88 + sub] = f2bf(b2);
          const u32x4 vv = *(const u32x4*)(kv + 64 + sub * 8);
          *(u32x4*)(Vb + ((size_t)(bidx * 8 + hh) * (SEQ + CTXL) + s) * 64 + sub * 8) = vv; }
        if (lat) { bf16_t* q = Q + (size_t)r * 768 + hh * 96;
          const u32x4 w = *(const u32x4*)(q + sub * 8);
          float x[12] = {lo2f(w.x), hi2f(w.x), lo2f(w.y), hi2f(w.y), lo2f(w.z), hi2f(w.z), lo2f(w.w), hi2f(w.w), bf2f(q[64 + sub]), bf2f(q[72 + sub]), bf2f(q[80 + sub]), bf2f(q[88 + sub])};
          float ss = 0.f;
#pragma unroll
          for (int i = 0; i < 12; ++i) ss += x[i] * x[i];
          ss += __shfl_xor(ss, 1); ss += __shfl_xor(ss, 2); ss += __shfl_xor(ss, 4);
          const float rstd = rsqrtf(ss * (1.f / 96.f) + EPS) * qscale;
          const float* nw = P.in[I_QKQ];
#pragma unroll
          for (int i = 0; i < 8; ++i) x[i] *= rstd * nw[sub * 8 + i];
          x[8] *= rstd * nw[64 + sub]; x[9] *= rstd * nw[72 + sub]; x[10] *= rstd * nw[80 + sub]; x[11] *= rstd * nw[88 + sub];
          const float a1 = x[8] * ca - x[9] * sa, a2 = x[9] * ca + x[8] * sa, b1 = x[10] * cb - x[11] * sb, b2 = x[11] * cb + x[10] * sb;
          u32x4 o; o.x = pack2(x[0], x[1]); o.y = pack2(x[2], x[3]); o.z = pack2(x[4], x[5]); o.w = pack2(x[6], x[7]);
          *(u32x4*)(q + sub * 8) = o;
          q[64 + sub] = f2bf(a1); q[72 + sub] = f2bf(a2); q[80 + sub] = f2bf(b1); q[88 + sub] = f2bf(b2); }
    }
}

__device__ __forceinline__ void ph_attn_naive(const Frame& F) {
    const bf16_t* Q = (const bf16_t*)(F.ws + WS_WMOE);
    const bf16_t* Kb = (const bf16_t*)(F.ws + WS_R2 + R2_K); const bf16_t* Vb = (const bf16_t*)(F.ws + WS_R2 + R2_V);
    bf16_t* CAT = (bf16_t*)(F.ws + WS_ACT);
    LAS float* Ks = (LAS float*)F.lds;
    LAS float* Vs = Ks + 64 * 96;
    constexpr int NK = SEQ + CTXL;
    const int hf = F.tid & 1;
    for (int it = F.bid; it < 8 * 8 * 32; it += F.G) {
        const int b = it >> 8, h = (it >> 5) & 7, qb = it & 31;
        const int l = qb * 256 + (F.tid >> 1); const size_t trow = (size_t)b * SEQ + l;
        float q[48], o[32];
        { const bf16_t* qp = Q + trow * 768 + h * 96 + hf * 48;
#pragma unroll
          for (int i = 0; i < 6; ++i) { const u32x4 w = *(const u32x4*)(qp + i * 8);
            q[i * 8 + 0] = lo2f(w.x); q[i * 8 + 1] = hi2f(w.x); q[i * 8 + 2] = lo2f(w.y); q[i * 8 + 3] = hi2f(w.y); q[i * 8 + 4] = lo2f(w.z); q[i * 8 + 5] = hi2f(w.z); q[i * 8 + 6] = lo2f(w.w); q[i * 8 + 7] = hi2f(w.w); } }
#pragma unroll
        for (int d = 0; d < 32; ++d) o[d] = 0.f;
        float m = -3.0e38f, ls = 0.f;
        const bf16_t* kb = Kb + (size_t)(b * 8 + h) * NK * 96; const bf16_t* vb = Vb + (size_t)(b * 8 + h) * NK * 64;
        for (int kt = 0; kt < NK / 64; ++kt) {
            for (int i = F.tid; i < 64 * 96 / 8; i += NTH) { const u32x4 w = *(const u32x4*)(kb + (size_t)kt * 64 * 96 + i * 8); LAS float* d = Ks + i * 8;
                d[0] = lo2f(w.x); d[1] = hi2f(w.x); d[2] = lo2f(w.y); d[3] = hi2f(w.y); d[4] = lo2f(w.z); d[5] = hi2f(w.z); d[6] = lo2f(w.w); d[7] = hi2f(w.w); }
            { const int i = F.tid; const u32x4 w = *(const u32x4*)(vb + (size_t)kt * 64 * 64 + i * 8); LAS float* d = Vs + i * 8;
                d[0] = lo2f(w.x); d[1] = hi2f(w.x); d[2] = lo2f(w.y); d[3] = hi2f(w.y); d[4] = lo2f(w.z); d[5] = hi2f(w.z); d[6] = lo2f(w.w); d[7] = hi2f(w.w); }
            __syncthreads();
            for (int jb = 0; jb < 16; ++jb) {
                float s[4]; float mx = m;
#pragma unroll
                for (int jj = 0; jj < 4; ++jj) { const LAS float* kr = Ks + (jb * 4 + jj) * 96 + hf * 48; float a = 0.f;
#pragma unroll
                    for (int d = 0; d < 48; d += 4) { const f32x4 kv = *(const LAS f32x4*)(kr + d); a += q[d] * kv[0] + q[d + 1] * kv[1] + q[d + 2] * kv[2] + q[d + 3] * kv[3]; }
                    a += __shfl_xor(a, 1);
                    s[jj] = a; mx = fmaxf(mx, a); }
                const float sc = __expf(m - mx); ls *= sc;
#pragma unroll
                for (int d = 0; d < 32; ++d) o[d] *= sc;
                m = mx;
#pragma unroll
                for (int jj = 0; jj < 4; ++jj) { const float p = __expf(s[jj] - mx); ls += p; const LAS float* vr = Vs + (jb * 4 + jj) * 64 + hf * 32;
#pragma unroll
                    for (int d = 0; d < 32; d += 4) { const f32x4 vv = *(const LAS f32x4*)(vr + d); o[d] += p * vv[0]; o[d + 1] += p * vv[1]; o[d + 2] += p * vv[2]; o[d + 3] += p * vv[3]; } }
            }
            __syncthreads();
        }
        const float inv = 1.f / ls;
        bf16_t* dst = CAT + trow * 1024 + 512 + h * 64 + hf * 32;
#pragma unroll
        for (int i = 0; i < 4; ++i) { u32x4 w; w.x = pack2(o[i * 8] * inv, o[i * 8 + 1] * inv); w.y = pack2(o[i * 8 + 2] * inv, o[i * 8 + 3] * inv); w.z = pack2(o[i * 8 + 4] * inv, o[i * 8 + 5] * inv); w.w = pack2(o[i * 8 + 6] * inv, o[i * 8 + 7] * inv);
            *(u32x4*)(dst + i * 8) = w; }
    }
}

__device__ __forceinline__ void ph_gdn(const Frame& F) {
    const Params& P = *F.P;
    const bf16_t* PX = (const bf16_t*)(F.ws + WS_PX);
    LAS float* rq = (LAS float*)F.lds;
    LAS float* rk = rq + 20 * 128;
    LAS float* rv = rk + 20 * 128;
    LAS float* qc = rv + 20 * 32;
    LAS float* kc = qc + 2048;
    LAS float* vc = kc + 2048;
    LAS float* os = vc + 512;
    LAS float* ba = os + 512;
    for (int it = F.bid; it < 256; it += F.G) {
        const int b = it >> 5, h = (it >> 3) & 3, dir = (it >> 2) & 1, sl = it & 3;
        bf16_t* O = (bf16_t*)(F.ws + WS_R2 + (dir ? R2_OB1 : R2_OF1));
        const float a_neg = -__expf(P.in[I_ALOG][dir * 4 + h]), dtb = P.in[I_DTB][dir * 4 + h];
        float cwq[5], cwk[5], cwv[5];
        { const int d = F.tid & 127;
#pragma unroll
          for (int j = 0; j < 5; ++j) { cwq[j] = P.in[I_CONVW][j * 1536 + h * 128 + d]; cwk[j] = P.in[I_CONVW][j * 1536 + 512 + h * 128 + d]; cwv[j] = P.in[I_CONVW][j * 1536 + 1024 + h * 128 + sl * 32 + (F.tid & 31)]; } }
        float S0[4], S1[4];
#pragma unroll
        for (int j = 0; j < 4; ++j) { S0[j] = 0.f; S1[j] = 0.f; }
        for (int seg = 0; seg < 2; ++seg) {
            const int len = seg == 0 ? CTXL : SEQ; const size_t rbase = seg == 0 ? (size_t)TL + b * CTXL : (size_t)b * SEQ;
            for (int bi = 0; bi < len / 16; ++bi) {
                const int nb = dir ? (len / 16 - 1 - bi) : bi; const int p0 = nb * 16;
                for (int i = F.tid; i < 20 * 128; i += NTH) { const int rr = i >> 7, d = i & 127; const int p = p0 - 2 + rr; float a = 0.f, c = 0.f;
                    if (p >= 0 && p < len) { const bf16_t* row = PX + (rbase + p) * ODD_PAD; a = bf2f(row[h * 128 + d]); c = bf2f(row[512 + h * 128 + d]); }
                    rq[i] = a; rk[i] = c; }
                for (int i = F.tid; i < 20 * 32; i += NTH) { const int rr = i >> 5, e = i & 31; const int p = p0 - 2 + rr; float a = 0.f;
                    if (p >= 0 && p < len) a = bf2f(PX[(rbase + p) * ODD_PAD + 1024 + h * 128 + sl * 32 + e]);
                    rv[i] = a; }
                if (F.tid < 16) { const bf16_t* row = PX + (rbase + p0 + F.tid) * ODD_PAD;
                    ba[F.tid] = sigmoid_f(bf2f(row[2048 + dir * 4 + h]));
                    ba[16 + F.tid] = __expf(a_neg * softplus_f(bf2f(row[2056 + dir * 4 + h]) + dtb)); }
                __syncthreads();
                { const int d = F.tid & 127;
#pragma unroll
                  for (int i = 0; i < 4; ++i) { const int s = (F.tid >> 7) + i * 4; float a = 0.f, c = 0.f;
#pragma unroll
                    for (int j = 0; j < 5; ++j) { a += rq[(s + j) * 128 + d] * cwq[j]; c += rk[(s + j) * 128 + d] * cwk[j]; }
                    qc[s * 128 + d] = silu_f(a); kc[s * 128 + d] = silu_f(c); }
                  { const int s = F.tid >> 5, e = F.tid & 31; float a = 0.f;
#pragma unroll
                    for (int j = 0; j < 5; ++j) a += rv[(s + j) * 32 + e] * cwv[j];
                    vc[s * 32 + e] = silu_f(a); } }
                __syncthreads();
#pragma unroll
                for (int i = 0; i < 2; ++i) { const int s = F.wave * 2 + i;
                    const float q0 = qc[s * 128 + F.lane], q1 = qc[s * 128 + 64 + F.lane], k0 = kc[s * 128 + F.lane], k1 = kc[s * 128 + 64 + F.lane];
                    const float sq = wave_sum(q0 * q0 + q1 * q1), sk = wave_sum(k0 * k0 + k1 * k1);
                    const float rq_ = rsqrtf(sq + EPS) * 0.08838834764831845f, rk_ = rsqrtf(sk + EPS);
                    qc[s * 128 + F.lane] = q0 * rq_; qc[s * 128 + 64 + F.lane] = q1 * rq_; kc[s * 128 + F.lane] = k0 * rk_; kc[s * 128 + 64 + F.lane] = k1 * rk_; }
                __syncthreads();
                for (int ss = 0; ss < 16; ++ss) {
                    const int s = dir ? 15 - ss : ss;
                    const float k0 = kc[s * 128 + F.lane], k1 = kc[s * 128 + 64 + F.lane], q0 = qc[s * 128 + F.lane], q1 = qc[s * 128 + 64 + F.lane];
                    const float beta = ba[s], a = ba[16 + s];
                    float r[4];
#pragma unroll
                    for (int j = 0; j < 4; ++j) r[j] = k0 * S0[j] + k1 * S1[j];
#pragma unroll
                    for (int j = 0; j < 4; ++j) r[j] = wave_sum(r[j]);
                    float part[4];
#pragma unroll
                    for (int j = 0; j < 4; ++j) { const float v = vc[s * 32 + F.wave * 4 + j]; const float u = beta * (v - a * r[j]);
                        S0[j] = a * S0[j] + k0 * u; S1[j] = a * S1[j] + k1 * u; part[j] = q0 * S0[j] + q1 * S1[j]; }
#pragma unroll
                    for (int j = 0; j < 4; ++j) part[j] = wave_sum(part[j]);
                    if (F.lane == 0) { os[s * 32 + F.wave * 4 + 0] = part[0]; os[s * 32 + F.wave * 4 + 1] = part[1]; os[s * 32 + F.wave * 4 + 2] = part[2]; os[s * 32 + F.wave * 4 + 3] = part[3]; }
                }
                __syncthreads();
                { const int s = F.tid >> 5, e = F.tid & 31;
                  O[(rbase + p0 + s) * 512 + h * 128 + sl * 32 + e] = f2bf(os[s * 32 + e]); }
            }
        }
        __syncthreads();
    }
}

constexpr int NPHASES = 26;
__global__ void __launch_bounds__(NTH, 2) fwd(Params P) {
    extern __shared__ __attribute__((aligned(16))) unsigned char lds_raw[];
    Frame F; F.P = &P; F.ws = P.ws; F.lds = (LAS unsigned char*)lds_raw;
    F.tid = threadIdx.x; F.lane = F.tid & 63; F.wave = __builtin_amdgcn_readfirstlane(F.tid >> 6); F.G = gridDim.x; F.bid = blockIdx.x;
    F.mod = (float*)(P.ws + WS_CTRL + C_MOD); F.ctrl = (unsigned*)(P.ws + WS_CTRL);
    volatile LAS unsigned* xbw = (volatile LAS unsigned*)(F.lds + LDS_BYTES - 16);
    if (F.tid < 4) xbw[F.tid] = 0u;
    __syncthreads();
    const int lo = P.ph_lo, hi = P.ph_hi;
    const bool single = (hi - lo) > 1;
    XcdBarrier bar; bar.bar = F.ctrl; bar.x = 0; bar.st = xbw;
    if (single) bar = xcd_barrier_post(F.ctrl, xbw);
#ifndef PH_MASK
#define PH_MASK 0xffffffffu
#endif
#define IN(k) (((PH_MASK >> (k)) & 1u) && lo <= (k) && (k) < hi)
#define SEAM(k) do { if (IN(k) && IN((k) + 1)) xcd_barrier(bar); } while (0)
    bf16_t* wsm = (bf16_t*)(P.ws + WS_WSM);
    bf16_t* ACT = (bf16_t*)(P.ws + WS_ACT); bf16_t* PX = (bf16_t*)(P.ws + WS_PX);
    float* XC = (float*)(P.ws + WS_XC);

    if (IN(0)) { ph_prologue(F); } SEAM(0);
    if (IN(1)) { ph_rownorm<false>(F, 0, TT, P.in[I_X], P.in[I_CTX], P.in[I_NMIX], 0); } SEAM(1);
    if (IN(2)) { EpiStoreBf16 E{PX, EVEN_IN, 1024}; gemm_dense_naive(F, ACT, wsm + W_EIN / 2, TT, EVEN_IN, 1024, E); } SEAM(2);
    if (IN(3)) { ph_gmlp(F); } SEAM(3);
    if (IN(4)) { ph_gla(F); } SEAM(4);
    if (IN(5)) { ph_merge(F, 0); } SEAM(5);
    if (IN(6)) { EpiResidual E{P.in[I_X], P.in[I_CTX], P.out, XC, F.mod, 2}; gemm_dense_naive(F, ACT, wsm + W_EOUT / 2, TT, 1024, 1024, E); } SEAM(6);
    if (IN(7)) { ph_rownorm<true>(F, 0, TT, P.out, XC, P.in[I_NFFN], 3); } SEAM(7);
    if (IN(8)) { ph_dispatch(F, 0, TT); } SEAM(8);
    if (IN(9)) { ph_moe_gemm1(F, 0); } SEAM(9);
    if (IN(10)) { ph_moe_gemm2(F, 0, 0); } SEAM(10);
    if (IN(11)) { ph_moe_gemm2(F, 0, 1); } SEAM(11);
    if (IN(12)) { ph_rownorm<false>(F, 1, TT, P.out, XC, P.in[I_NMIX] + 1024, 0); } SEAM(12);
    if (IN(13)) { EpiStoreBf16 E{PX, ODD_PAD, 0}; gemm_dense_naive(F, ACT, wsm + W_OIN / 2, TT, ODD_PAD, 1024, E); } SEAM(13);
    if (IN(14)) { ph_mla_norm(F); } SEAM(14);
    if (IN(15)) { EpiStoreBf16 E1{(bf16_t*)(P.ws + WS_WMOE), 768, 0}; gemm_dense_naive(F, ACT, wsm + W_WQ / 2, TL, 768, 256, E1);
                  EpiStoreBf16 E2{(bf16_t*)(P.ws + WS_PX + PX_KVRAW), 1024, 0}; gemm_dense_naive(F, ACT + (size_t)TL * 256, wsm + W_WKV / 2, TT, 1024, 256, E2); } SEAM(15);
    if (IN(16)) { ph_mla_final(F); } SEAM(16);
    if (IN(17)) { ph_attn_naive(F); } SEAM(17);
    if (IN(18)) { ph_gdn(F); } SEAM(18);
    if (IN(19)) { ph_merge(F, 1); } SEAM(19);
    if (IN(20)) { EpiResidual E{P.out, P.out, P.out, P.out, F.mod + 9 * 6144, 2}; gemm_dense_naive(F, ACT, wsm + W_OOUT / 2, TL, 1024, 1024, E); } SEAM(20);
    if (IN(21)) { ph_rownorm<true>(F, 1, TL, P.out, XC, P.in[I_NFFN] + 1024, 3); conv_moe_weights(F, 1, F.bid, F.G); } SEAM(21);
    if (IN(22)) { ph_dispatch(F, 1, TL); } SEAM(22);
    if (IN(23)) { ph_moe_gemm1(F, 1); } SEAM(23);
    if (IN(24)) { ph_moe_gemm2(F, 1, 0); } SEAM(24);
    if (IN(25)) { ph_moe_gemm2(F, 1, 1); }
#undef IN
#undef SEAM
}

#ifndef N_LAUNCH_MODE
#define N_LAUNCH_MODE 1
#endif
extern "C" void kernel_launch(void* const* d_in, const int* in_sizes, int n_in, void* d_out, int out_size, void* d_ws, size_t ws_size, hipStream_t stream) {
    static int grid = 0;
    if (grid == 0) {
        if (n_in != 34 || out_size != TL * DM || ws_size < WS_END) { fprintf(stderr, "kernel_launch: unexpected shapes (n_in %d out %d ws %zu)\n", n_in, out_size, ws_size); grid = -1; return; }
        int dev = 0, cus = 0;
        if (hipGetDevice(&dev) != hipSuccess || hipDeviceGetAttribute(&cus, hipDeviceAttributeMultiprocessorCount, dev) != hipSuccess) { grid = -1; return; }
        if (hipFuncSetAttribute((const void*)fwd, hipFuncAttributeMaxDynamicSharedMemorySize, LDS_BYTES) != hipSuccess) { fprintf(stderr, "kernel_launch: hipFuncSetAttribute failed\n"); grid = -1; return; }
        int per_cu = 0;
        (void)hipOccupancyMaxActiveBlocksPerMultiprocessor(&per_cu, (const void*)fwd, NTH, LDS_BYTES);
        (void)hipGetLastError();
        if (per_cu < 1) fprintf(stderr, "kernel_launch: occupancy query says %d\n", per_cu);
        grid = cus;
    }
    if (grid < 0) return;
    (void)hipMemsetAsync(d_ws, 0, MiB, stream);
    Params p{};
    for (int i = 0; i < 34; ++i) p.in[i] = (const float*)d_in[i];
    p.out = (float*)d_out; p.ws = (unsigned char*)d_ws;
#if N_LAUNCH_MODE == 1
    p.ph_lo = 0; p.ph_hi = NPHASES;
    hipLaunchKernelGGL(fwd, dim3(grid), dim3(NTH), LDS_BYTES, stream, p);
#else
    for (int k = 0; k < NPHASES; ++k) { p.ph_lo = k; p.ph_hi = k + 1; hipLaunchKernelGGL(fwd, dim3(grid), dim3(NTH), LDS_BYTES, stream, p); }
#endif
}
```

```cpp
#include <hip/hip_runtime.h>
#include <cstdint>
#include <cstdio>

#define LAS __attribute__((address_space(3)))
typedef unsigned short bf16_t;
typedef float f32x4 __attribute__((ext_vector_type(4)));
typedef unsigned u32x4 __attribute__((ext_vector_type(4)));
typedef unsigned u32x2 __attribute__((ext_vector_type(2)));

constexpr int NB = 8, SEQ = 8192, CTXL = 256, DM = 1024;
constexpr int TL = NB * SEQ, TC = NB * CTXL, TT = TL + TC;
constexpr int EVEN_IN = 3584, ODD_IN = 2480, ODD_PAD = 2560;
constexpr int NTH = 512;
constexpr int LDS_BYTES = 144 * 1024;
constexpr int MAXSLOTS = 151552;
constexpr int MAXTILES = 592;
constexpr float EPS = 1e-6f;

constexpr size_t MiB = 1048576;
constexpr size_t WS_CTRL = 0;
constexpr size_t C_MOE = 16384;
constexpr size_t C_MOD = 65536;
constexpr size_t WS_XC = 1 * MiB;
constexpr size_t WS_WSM = 9 * MiB;
constexpr size_t W_EIN = 0, W_EOUT = 7340032, W_OIN = 9437184, W_OOUT = 14680064, W_WQ = 16777216, W_WKV = 17170432, W_RT = 17694720;
constexpr size_t WS_WMOE = 27 * MiB;
constexpr size_t WS_ACT = 123 * MiB;
constexpr size_t WS_PX = 255 * MiB;
constexpr size_t WS_R2 = 717 * MiB;
constexpr size_t WS_END = 1024 * MiB;
constexpr size_t R2_OF0 = 0, R2_OB0 = 66 * MiB;
constexpr size_t R2_H = 0, R2_STOK = 148 * MiB, R2_SW = 149 * MiB, R2_TOKE = 150 * MiB, R2_TOKW = 151 * MiB, R2_TILEE = 152 * MiB;
constexpr size_t R2_K = 0, R2_V = 99 * MiB, R2_OF1 = 165 * MiB, R2_OB1 = 231 * MiB;
constexpr size_t PX_KVRAW = 346030080;
constexpr size_t WS_GREC = 585 * MiB;
constexpr size_t WS_GOF = 924 * MiB;
constexpr size_t R2_CQN = 170 * MiB;

struct Params {
    const float* in[34];
    float* out;
    unsigned char* ws;
    int ph_lo, ph_hi;
};
enum { I_X = 0, I_C, I_CTX, I_CCTX, I_ADAW, I_ADAB, I_NMIX, I_NFFN, I_EWIN, I_EWOUT, I_GNW, I_GWS, I_GBS, I_LB, I_HNW,
       I_OWIN, I_OWOUT, I_CONVW, I_ALOG, I_DTB, I_GDNNW, I_QNW, I_WQ, I_KVNW, I_WKV, I_QKQ, I_QKK, I_RGW, I_RGB, I_REW, I_REB, I_MG, I_MU, I_MD };

__device__ __forceinline__ float bf2f(bf16_t b) { return __uint_as_float(((unsigned)b) << 16); }
__device__ __forceinline__ bf16_t f2bf(float f) { unsigned u = __float_as_uint(f); u += 0x7FFFu + ((u >> 16) & 1u); return (bf16_t)(u >> 16); }
typedef __bf16 bf16_2v __attribute__((ext_vector_type(2)));
typedef float f32_2v __attribute__((ext_vector_type(2)));
__device__ __forceinline__ unsigned pack2(float a, float b) { f32_2v v = {a, b}; bf16_2v r = __builtin_convertvector(v, bf16_2v); return __builtin_bit_cast(unsigned, r); }
__device__ __forceinline__ float lo2f(unsigned u) { return __uint_as_float(u << 16); }
__device__ __forceinline__ float hi2f(unsigned u) { return __uint_as_float(u & 0xffff0000u); }
template <int CTRL> __device__ __forceinline__ float dppf(float x) { return __builtin_bit_cast(float, __builtin_amdgcn_mov_dpp(__builtin_bit_cast(int, x), CTRL, 0xf, 0xf, true)); }
__device__ __forceinline__ float sum8(float v) { v += dppf<0xB1>(v); v += dppf<0x4E>(v); v += dppf<0x141>(v); return v; }
__device__ __forceinline__ float sum16(float v) { v = sum8(v); v += dppf<0x128>(v); return v; }
__device__ __forceinline__ float wave_sum(float v) {
    v = sum16(v);
    auto s = __builtin_amdgcn_permlane16_swap(__float_as_uint(v), __float_as_uint(v), false, false);
    v = __uint_as_float(s[0]) + __uint_as_float(s[1]);
    auto t = __builtin_amdgcn_permlane32_swap(__float_as_uint(v), __float_as_uint(v), false, false);
    return __uint_as_float(t[0]) + __uint_as_float(t[1]);
}
__device__ __forceinline__ unsigned lds_inc(LAS unsigned* p) { return __hip_atomic_fetch_add(p, 1u, __ATOMIC_RELAXED, __HIP_MEMORY_SCOPE_WORKGROUP); }
__device__ __forceinline__ float sigmoid_f(float x) { return 1.f / (1.f + __expf(-x)); }
__device__ __forceinline__ float silu_f(float x) { return x / (1.f + __expf(-x)); }
__device__ __forceinline__ float gelu_tanh_f(float x) {
    const float u = 0.7978845608028654f * (x + 0.044715f * x * x * x);
    const float t = 1.f - 2.f / (__expf(2.f * u) + 1.f);
    return 0.5f * x * (1.f + t);
}
__device__ __forceinline__ float softplus_f(float x) { return x > 20.f ? x : log1pf(__expf(x)); }

#define XB_TMO      128
#define XB_XCNT(j)  (256  + 64 * (j))
#define XB_XSUB(j)  (1280 + 64 * (j))
#define XB_XGEN(j)  (2304 + 64 * (j))
#define XB_TOP      3328
#define XB_TOPGEN   3392
#define XCD_BAR_WORDS 3456
#define XB_SPIN_CAP (1u << 24)
__device__ __forceinline__ unsigned xb_ld(unsigned* p)              { return __hip_atomic_load(p, __ATOMIC_RELAXED, __HIP_MEMORY_SCOPE_AGENT); }
__device__ __forceinline__ unsigned xb_add(unsigned* p, unsigned v) { return __hip_atomic_fetch_add(p, v, __ATOMIC_RELAXED, __HIP_MEMORY_SCOPE_AGENT); }
__device__ __forceinline__ unsigned xb_xcc_id() { return (unsigned)__builtin_amdgcn_s_getreg((3 << 11) | 20) & 0xFu; }
#define XB_SPIN(cond, bar) do { unsigned _sp = 0; while (cond) { __builtin_amdgcn_s_sleep(1); \
    if ((++_sp & 255u) == 0u) { if (xb_ld(&(bar)[XB_TMO])) break; if (_sp > XB_SPIN_CAP) { atomicAdd(&(bar)[XB_TMO], 1u); break; } } } } while (0)
struct XcdBarrier { unsigned* bar; unsigned x; volatile LAS unsigned* st; };
__device__ __forceinline__ XcdBarrier xcd_barrier_post(unsigned* bar, volatile LAS unsigned* st) {
    XcdBarrier b; b.bar = bar; b.x = xb_xcc_id(); b.st = st;
    if (threadIdx.x == 0) (void)xb_add(&bar[XB_XCNT(b.x)], 1u);
    return b;
}
__device__ __forceinline__ void xcd_barrier_complete(unsigned* bar, unsigned x, unsigned& nloc, unsigned& nx) {
    const unsigned G = gridDim.x * gridDim.y * gridDim.z;
    unsigned sum, cnt, mine, sp = 0u;
    for (;;) {
        sum = 0u; cnt = 0u; mine = 0u;
#pragma unroll
        for (unsigned j = 0; j < 16; ++j) { const unsigned c = xb_ld(&bar[XB_XCNT(j)]); sum += c; cnt += (c > 0u) ? 1u : 0u; mine = (j == x) ? c : mine; }
        if (sum == G) break;
        __builtin_amdgcn_s_sleep(1);
        if ((++sp & 255u) == 0u) { if (xb_ld(&bar[XB_TMO])) break; if (sp > XB_SPIN_CAP) { atomicAdd(&bar[XB_TMO], 1u); break; } }
    }
    nloc = mine > 0u ? mine : 1u; nx = cnt > 0u ? cnt : 1u;
}
__device__ __forceinline__ void xcd_barrier(const XcdBarrier& b) {
    asm volatile("s_waitcnt vmcnt(0)" ::: "memory");
    __syncthreads();
    if (threadIdx.x == 0) {
        unsigned* bar = b.bar;
        __builtin_amdgcn_s_waitcnt(0);
        unsigned nloc = b.st[0], nx = b.st[1];
        if (nloc == 0u) { xcd_barrier_complete(bar, b.x, nloc, nx); b.st[0] = nloc; b.st[1] = nx; }
        const unsigned old = xb_add(&bar[XB_XSUB(b.x)], 1u);
        const unsigned gen = old / nloc;
        if (old + 1u == (gen + 1u) * nloc) {
            __builtin_amdgcn_fence(__ATOMIC_RELEASE, "agent");
            asm volatile("s_waitcnt vmcnt(0)" ::: "memory");
            const unsigned og = xb_add(&bar[XB_TOP], 1u);
            const unsigned tg = og / nx;
            if (og + 1u == (tg + 1u) * nx) xb_add(&bar[XB_TOPGEN], 1u);
            else XB_SPIN(xb_ld(&bar[XB_TOPGEN]) == tg, bar);
            __builtin_amdgcn_fence(__ATOMIC_ACQUIRE, "agent");
            xb_add(&bar[XB_XGEN(b.x)], 1u);
            asm volatile("s_waitcnt vmcnt(0)" ::: "memory");
        } else {
            XB_SPIN(xb_ld(&bar[XB_XGEN(b.x)]) == gen, bar);
            __builtin_amdgcn_fence(__ATOMIC_ACQUIRE, "agent");
            asm volatile("s_waitcnt vmcnt(0)" ::: "memory");
        }
    }
    __syncthreads();
}

struct Frame {
    const Params* P;
    unsigned char* ws;
    LAS unsigned char* lds;
    int tid, lane, wave, G, bid;
    float* mod;
    unsigned* ctrl;
};
__device__ __forceinline__ const float* modp(const Frame& F, int layer, int b, int which) { return F.mod + ((size_t)(layer * 9 + b) * 6 + which) * 1024; }

__device__ __forceinline__ void conv_tile(const Frame& F, const float* src, int K, int N, int lds_, bf16_t* dst, int ldd, int kt, int nt, int rm_mode) {
    LAS float* tile = (LAS float*)F.lds;
    const int t = F.tid;
    {
        const int c = t & 63, r0 = t >> 6;
#pragma unroll
        for (int i = 0; i < 8; ++i) { const int rr = r0 + i * 8, k = kt * 64 + rr, n = nt * 64 + c;
            tile[rr * 65 + c] = (k < K && n < N) ? src[(size_t)k * lds_ + n] : 0.f; }
    }
    __syncthreads();
    {
        const int nl = t >> 3, kc = (t & 7) * 8, n = nt * 64 + nl;
        int row = n;
        if (rm_mode == 1) row = (n >> 7) * 256 + (n & 127);
        else if (rm_mode == 2) row = (n >> 7) * 256 + 128 + (n & 127);
        float v[8];
#pragma unroll
        for (int j = 0; j < 8; ++j) v[j] = tile[(kc + j) * 65 + nl];
        u32x4 w; w.x = pack2(v[0], v[1]); w.y = pack2(v[2], v[3]); w.z = pack2(v[4], v[5]); w.w = pack2(v[6], v[7]);
        *(u32x4*)(dst + (size_t)row * ldd + kt * 64 + kc) = w;
    }
    __syncthreads();
}
__device__ __forceinline__ void conv_moe_weights(const Frame& F, int layer, int item0, int stride) {
    const Params& P = *F.P;
    bf16_t* W1 = (bf16_t*)(F.ws + WS_WMOE); bf16_t* W2 = W1 + (size_t)32 * 1024 * 1024;
    for (int it = item0; it < 12288; it += stride) {
        if (it < 8192) {
            const int up = it >= 4096, j = it & 4095, e = j >> 7, r = j & 127, kt = r >> 3, nt = r & 7;
            const float* src = P.in[up ? I_MU : I_MG] + ((size_t)(layer * 32 + e)) * 1024 * 512;
            conv_tile(F, src, 1024, 512, 512, W1 + (size_t)e * 1024 * 1024, 1024, kt, nt, up ? 2 : 1);
        } else {
            const int j = it - 8192, e = j >> 7, r = j & 127, kt = r >> 4, nt = r & 15;
            const float* src = P.in[I_MD] + ((size_t)(layer * 32 + e)) * 512 * 1024;
            conv_tile(F, src, 512, 1024, 1024, W2 + (size_t)e * 1024 * 512, 512, kt, nt, 0);
        }
    }
}
__device__ __forceinline__ void ph_prologue(const Frame& F) {
    const Params& P = *F.P;
    for (int it = F.bid; it < 24; it += F.G) {
        const int l = it / 12, cb = it % 12;
        LAS float* sc = (LAS float*)F.lds;
        for (int i = F.tid; i < 9 * 1024; i += NTH) { const int rr = i >> 10, k = i & 1023;
            const float cv = rr < 8 ? P.in[I_C][rr * 1024 + k] : P.in[I_CCTX][k]; sc[i] = silu_f(cv); }
        __syncthreads();
        const int n = cb * 512 + F.tid;
        float acc[9];
#pragma unroll
        for (int rr = 0; rr < 9; ++rr) acc[rr] = 0.f;
        const float* w = P.in[I_ADAW] + (size_t)l * 1024 * 6144 + n;
#pragma unroll 8
        for (int k = 0; k < 1024; ++k) { const float wv = w[(size_t)k * 6144];
#pragma unroll
            for (int rr = 0; rr < 9; ++rr) acc[rr] += sc[rr * 1024 + k] * wv; }
        const float bias = P.in[I_ADAB][l * 6144 + n];
#pragma unroll
        for (int rr = 0; rr < 9; ++rr) F.mod[(size_t)(l * 9 + rr) * 6144 + n] = acc[rr] + bias;
        __syncthreads();
    }
    bf16_t* wsm = (bf16_t*)(F.ws + WS_WSM);
    for (int it = F.bid; it < 2160; it += F.G) {
        int j = it;
        if (j < 896) { conv_tile(F, P.in[I_EWIN], 1024, 3584, 3584, wsm + W_EIN / 2, 1024, j / 56, j % 56, 0); continue; } j -= 896;
        if (j < 256) { conv_tile(F, P.in[I_EWOUT], 1024, 1024, 1024, wsm + W_EOUT / 2, 1024, j >> 4, j & 15, 0); continue; } j -= 256;
        if (j < 640) { conv_tile(F, P.in[I_OWIN], 1024, 2480, 2480, wsm + W_OIN / 2, 1024, j / 40, j % 40, 0); continue; } j -= 640;
        if (j < 256) { conv_tile(F, P.in[I_OWOUT], 1024, 1024, 1024, wsm + W_OOUT / 2, 1024, j >> 4, j & 15, 0); continue; } j -= 256;
        if (j < 48) { conv_tile(F, P.in[I_WQ], 256, 768, 768, wsm + W_WQ / 2, 256, j / 12, j % 12, 0); continue; } j -= 48;
        conv_tile(F, P.in[I_WKV], 128, 1024, 1024, wsm + W_WKV / 2, 256, j >> 4, j & 15, 0);
    }
    for (int i = F.bid * NTH + F.tid; i < 2 * 48 * 1024; i += F.G * NTH) { const int l = i / (48 * 1024), r = i % (48 * 1024), n = r >> 10, k = r & 1023;
        float w = 0.f; if (n < 4) w = P.in[I_RGW][((size_t)l * 1024 + k) * 4 + n]; else if (n < 36) w = P.in[I_REW][((size_t)l * 1024 + k) * 32 + (n - 4)];
        const bf16_t h = f2bf(w); wsm[W_RT / 2 + (size_t)l * 2 * 48 * 1024 + r] = h; wsm[W_RT / 2 + (size_t)l * 2 * 48 * 1024 + 48 * 1024 + r] = f2bf(w - bf2f(h)); }
    conv_moe_weights(F, 0, F.bid, F.G);
}

__device__ __forceinline__ void ph_rownorm(const Frame& F, int layer, int nrows, const float* xlat, const float* xctx, const float* nw, int si) {
    bf16_t* dst = (bf16_t*)(F.ws + WS_ACT);
    for (int r = F.bid * 8 + F.wave; r < nrows; r += F.G * 8) {
        const float* src = r < TL ? xlat + (size_t)r * 1024 : xctx + (size_t)(r - TL) * 1024;
        const int b = r < TL ? (r >> 13) : 8;
        const float* sh = modp(F, layer, b, si); const float* sc = modp(F, layer, b, si + 1);
        f32x4 v[4]; float ss = 0.f;
#pragma unroll
        for (int j = 0; j < 4; ++j) { v[j] = *(const f32x4*)(src + j * 256 + F.lane * 4); ss += v[j][0] * v[j][0] + v[j][1] * v[j][1] + v[j][2] * v[j][2] + v[j][3] * v[j][3]; }
        ss = wave_sum(ss);
        const float rstd = rsqrtf(ss * (1.f / 1024.f) + EPS);
#pragma unroll
        for (int j = 0; j < 4; ++j) { const int c = j * 256 + F.lane * 4;
            const f32x4 w = *(const f32x4*)(nw + c), s1 = *(const f32x4*)(sc + c), s0 = *(const f32x4*)(sh + c);
            v[j] = (v[j] * rstd * w) * (1.f + s1) + s0;
            u32x2 o; o.x = pack2(v[j][0], v[j][1]); o.y = pack2(v[j][2], v[j][3]);
            *(u32x2*)(dst + (size_t)r * 1024 + c) = o; }
    }
}
typedef short s16x8r __attribute__((ext_vector_type(8)));
__device__ __forceinline__ void ph_router(const Frame& F, int layer, int nrows, const float* xlat, const float* xctx, const float* nw, int si) {
    const Params& P = *F.P;
    bf16_t* dst = (bf16_t*)(F.ws + WS_ACT);
    LAS unsigned* hist = (LAS unsigned*)F.lds;
    LAS float* lg = (LAS float*)(F.lds + 256) + F.wave * (16 * 48);
    int* tok_e = (int*)(F.ws + WS_R2 + R2_TOKE); float* tok_w = (float*)(F.ws + WS_R2 + R2_TOKW);
    if (F.tid < 64) hist[F.tid] = 0u;
    __syncthreads();
    { int* stok = (int*)(F.ws + WS_R2 + R2_STOK);
      for (int i = F.bid * NTH + F.tid; i < MAXSLOTS; i += F.G * NTH) stok[i] = -1; }
    const bf16_t* Wh = (const bf16_t*)(F.ws + WS_WSM) + W_RT / 2 + (size_t)layer * 2 * 48 * 1024; const bf16_t* Wl = Wh + 48 * 1024;
    const int lr = F.lane & 15, kq = F.lane >> 4;
    const float* rgb = P.in[I_RGB] + layer * 4; const float* reb = P.in[I_REB] + layer * 32;
    for (int g = F.bid * 8 + F.wave; g < nrows / 16; g += F.G * 8) {
        const int r0 = g * 16;
        const float* src0 = r0 < TL ? xlat + (size_t)r0 * 1024 : xctx + (size_t)(r0 - TL) * 1024;
        const int b = r0 < TL ? (r0 >> 13) : 8;
        const float* sh = modp(F, layer, b, si); const float* sc = modp(F, layer, b, si + 1);
        float myrstd = 0.f;
#pragma unroll 4
        for (int rr = 0; rr < 16; ++rr) { const float* src = src0 + (size_t)rr * 1024; float ss = 0.f;
#pragma unroll
            for (int j = 0; j < 4; ++j) { const f32x4 v = *(const f32x4*)(src + j * 256 + F.lane * 4); ss += v[0] * v[0] + v[1] * v[1] + v[2] * v[2] + v[3] * v[3]; }
            ss = wave_sum(ss);
            const float rs = rsqrtf(ss * (1.f / 1024.f) + EPS); myrstd = (lr == rr) ? rs : myrstd; }
        f32x4 acc[3];
#pragma unroll
        for (int nb = 0; nb < 3; ++nb) acc[nb] = (f32x4){0.f, 0.f, 0.f, 0.f};
        const float* xr = src0 + (size_t)lr * 1024 + kq * 8;
        bf16_t* dr = dst + (size_t)(r0 + lr) * 1024 + kq * 8;
#pragma unroll 2
        for (int ks = 0; ks < 32; ++ks) { const int c = ks * 32 + kq * 8;
            const f32x4 x0 = *(const f32x4*)(xr + ks * 32), x1 = *(const f32x4*)(xr + ks * 32 + 4);
            const f32x4 w0 = *(const f32x4*)(nw + c), w1 = *(const f32x4*)(nw + c + 4), a0 = *(const f32x4*)(sc + c), a1 = *(const f32x4*)(sc + c + 4), b0 = *(const f32x4*)(sh + c), b1 = *(const f32x4*)(sh + c + 4);
            const f32x4 h0 = (x0 * myrstd * w0) * (1.f + a0) + b0, h1 = (x1 * myrstd * w1) * (1.f + a1) + b1;
            u32x4 hi; hi.x = pack2(h0[0], h0[1]); hi.y = pack2(h0[2], h0[3]); hi.z = pack2(h1[0], h1[1]); hi.w = pack2(h1[2], h1[3]);
            *(u32x4*)(dr + ks * 32) = hi;
            u32x4 lo; lo.x = pack2(h0[0] - lo2f(hi.x), h0[1] - hi2f(hi.x)); lo.y = pack2(h0[2] - lo2f(hi.y), h0[3] - hi2f(hi.y));
            lo.z = pack2(h1[0] - lo2f(hi.z), h1[1] - hi2f(hi.z)); lo.w = pack2(h1[2] - lo2f(hi.w), h1[3] - hi2f(hi.w));
            const s16x8r ah = __builtin_bit_cast(s16x8r, hi), al = __builtin_bit_cast(s16x8r, lo);
#pragma unroll
            for (int nb = 0; nb < 3; ++nb) { const s16x8r bh = *(const s16x8r*)(Wh + (size_t)(nb * 16 + lr) * 1024 + c), bl = *(const s16x8r*)(Wl + (size_t)(nb * 16 + lr) * 1024 + c);
                acc[nb] = __builtin_amdgcn_mfma_f32_16x16x32_bf16(ah, bh, acc[nb], 0, 0, 0);
                acc[nb] = __builtin_amdgcn_mfma_f32_16x16x32_bf16(al, bh, acc[nb], 0, 0, 0);
                acc[nb] = __builtin_amdgcn_mfma_f32_16x16x32_bf16(ah, bl, acc[nb], 0, 0, 0); } }
#pragma unroll
        for (int nb = 0; nb < 3; ++nb)
#pragma unroll
            for (int rg = 0; rg < 4; ++rg) lg[(4 * kq + rg) * 48 + nb * 16 + lr] = acc[nb][rg];
        asm volatile("s_waitcnt lgkmcnt(0)" ::: "memory");
        __builtin_amdgcn_wave_barrier();
        if (F.lane < 16) {
            const LAS float* L = lg + F.lane * 48;
            float lgv[4];
#pragma unroll
            for (int i = 0; i < 4; ++i) lgv[i] = L[i] + rgb[i];
            int gi = 0; float best = lgv[0];
#pragma unroll
            for (int i = 1; i < 4; ++i) if (lgv[i] > best) { best = lgv[i]; gi = i; }
            float den = 0.f;
#pragma unroll
            for (int i = 0; i < 4; ++i) den += __expf(lgv[i] - best);
            const float pg = 1.f / den;
            float le[8];
#pragma unroll
            for (int i = 0; i < 8; ++i) le[i] = L[4 + gi * 8 + i] + reb[gi * 8 + i];
            int i1 = 0; float b1 = le[0];
#pragma unroll
            for (int i = 1; i < 8; ++i) if (le[i] > b1) { b1 = le[i]; i1 = i; }
            int i2 = -1; float b2 = -3.0e38f;
#pragma unroll
            for (int i = 0; i < 8; ++i) if (i != i1 && le[i] > b2) { b2 = le[i]; i2 = i; }
            const float e2 = __expf(b2 - b1);
            const float w1 = pg / (1.f + e2), w2 = pg * e2 / (1.f + e2);
            const int e0g = gi * 8 + i1, e1g = gi * 8 + i2; const int r = r0 + F.lane;
            tok_e[r] = e0g | (e1g << 8); tok_w[2 * r] = w1; tok_w[2 * r + 1] = w2;
            lds_inc(&hist[e0g]); lds_inc(&hist[32 + e1g]);
        }
        __builtin_amdgcn_wave_barrier();
    }
    __syncthreads();
    unsigned* cnt = (unsigned*)(F.ws + WS_CTRL + C_MOE + layer * 1024);
    if (F.tid < 64 && hist[F.tid]) atomicAdd(&cnt[F.tid], hist[F.tid]);
    __syncthreads();
}

__device__ __forceinline__ void ph_dispatch(const Frame& F, int layer, int ntok) {
    unsigned* cnt = (unsigned*)(F.ws + WS_CTRL + C_MOE + layer * 1024); unsigned* cursor = cnt + 64; unsigned* info = cnt + 128;
    LAS unsigned* base = (LAS unsigned*)F.lds; LAS unsigned* lh = base + 64; LAS unsigned* gb = base + 128; LAS unsigned* lh2 = base + 192; LAS unsigned* pad = base + 256;
    const int* tok_e = (const int*)(F.ws + WS_R2 + R2_TOKE); const float* tok_w = (const float*)(F.ws + WS_R2 + R2_TOKW);
    int* stok = (int*)(F.ws + WS_R2 + R2_STOK); float* sw = (float*)(F.ws + WS_R2 + R2_SW); int* tile_e = (int*)(F.ws + WS_R2 + R2_TILEE);
    if (F.tid < 64) { pad[F.tid] = (__hip_atomic_load(&cnt[F.tid], __ATOMIC_RELAXED, __HIP_MEMORY_SCOPE_AGENT) + 255u) & ~255u; lh[F.tid] = 0u; lh2[F.tid] = 0u; }
    __syncthreads();
    if (F.tid == 0) { unsigned a = 0; for (int i = 0; i < 64; ++i) { base[i] = a; a += pad[i]; } base[320] = a; }
    __syncthreads();
    if (F.bid == 0) {
        for (int i = F.tid; i < MAXTILES; i += NTH) { const unsigned s = (unsigned)i * 256u; int l = -1;
            for (int j = 0; j < 64; ++j) if (s >= base[j] && s < base[j] + pad[j]) l = j;
            tile_e[i] = l; }
        if (F.tid == 0) { info[0] = base[32] / 256u; info[1] = base[320] / 256u; }
    }
    const int per = (ntok + F.G - 1) / F.G, t0 = F.bid * per, t1 = min(ntok, t0 + per);
    for (int t = t0 + F.tid; t < t1; t += NTH) { const int e = tok_e[t]; lds_inc(&lh[e & 255]); lds_inc(&lh[32 + (e >> 8)]); }
    __syncthreads();
    if (F.tid < 64) gb[F.tid] = lh[F.tid] ? __hip_atomic_fetch_add(&cursor[F.tid], lh[F.tid], __ATOMIC_RELAXED, __HIP_MEMORY_SCOPE_AGENT) : 0u;
    __syncthreads();
    for (int t = t0 + F.tid; t < t1; t += NTH) { const int e = tok_e[t];
        const int l0 = e & 255, l1 = 32 + (e >> 8);
        const unsigned p0 = base[l0] + gb[l0] + lds_inc(&lh2[l0]), p1 = base[l1] + gb[l1] + lds_inc(&lh2[l1]);
        stok[p0] = t; sw[p0] = tok_w[2 * t]; stok[p1] = t; sw[p1] = tok_w[2 * t + 1]; }
    __syncthreads();
}

template <class AF, class EP>
__device__ __forceinline__ void gemm_unit_naive(const Frame& F, int K, const AF& arow, const bf16_t* Bt, const EP& E, int pm, int pn) {
    LAS float* As = (LAS float*)F.lds;
    LAS float* Bs = As + 32 * 132;
    const int t = F.tid, ty = t >> 5, tx = t & 31;
    for (int half = 0; half < 2; ++half) {
        float acc[8][8];
#pragma unroll
        for (int i = 0; i < 8; ++i)
#pragma unroll
            for (int j = 0; j < 8; ++j) acc[i][j] = 0.f;
        const bf16_t* ap = arow(half * 128 + (t >> 2));
        const bf16_t* bp = Bt + (size_t)(t >> 1) * K;
        for (int k0 = 0; k0 < K; k0 += 32) {
            { const int r = t >> 2, kq = (t & 3) * 8; u32x4 w = {0u, 0u, 0u, 0u}; if (ap) w = *(const u32x4*)(ap + k0 + kq);
              As[(kq + 0) * 132 + r] = lo2f(w.x); As[(kq + 1) * 132 + r] = hi2f(w.x); As[(kq + 2) * 132 + r] = lo2f(w.y); As[(kq + 3) * 132 + r] = hi2f(w.y);
              As[(kq + 4) * 132 + r] = lo2f(w.z); As[(kq + 5) * 132 + r] = hi2f(w.z); As[(kq + 6) * 132 + r] = lo2f(w.w); As[(kq + 7) * 132 + r] = hi2f(w.w); }
            { const int n = t >> 1, kh = (t & 1) * 16;
#pragma unroll
              for (int q = 0; q < 2; ++q) { const u32x4 w = *(const u32x4*)(bp + k0 + kh + q * 8); const int kk = kh + q * 8;
                Bs[(kk + 0) * 260 + n] = lo2f(w.x); Bs[(kk + 1) * 260 + n] = hi2f(w.x); Bs[(kk + 2) * 260 + n] = lo2f(w.y); Bs[(kk + 3) * 260 + n] = hi2f(w.y);
                Bs[(kk + 4) * 260 + n] = lo2f(w.z); Bs[(kk + 5) * 260 + n] = hi2f(w.z); Bs[(kk + 6) * 260 + n] = lo2f(w.w); Bs[(kk + 7) * 260 + n] = hi2f(w.w); } }
            __syncthreads();
#pragma unroll 4
            for (int k = 0; k < 32; ++k) {
                const f32x4 a0 = *(const LAS f32x4*)(As + k * 132 + ty * 8), a1 = *(const LAS f32x4*)(As + k * 132 + ty * 8 + 4);
                const f32x4 b0 = *(const LAS f32x4*)(Bs + k * 260 + tx * 4), b1 = *(const LAS f32x4*)(Bs + k * 260 + 128 + tx * 4);
#pragma unroll
                for (int i = 0; i < 8; ++i) { const float a = i < 4 ? a0[i & 3] : a1[i & 3];
#pragma unroll
                    for (int j = 0; j < 4; ++j) { acc[i][j] += a * b0[j]; acc[i][4 + j] += a * b1[j]; } }
            }
            __syncthreads();
        }
#pragma unroll
        for (int i = 0; i < 8; ++i) { const f32x4 v0 = {acc[i][0], acc[i][1], acc[i][2], acc[i][3]}, v1 = {acc[i][4], acc[i][5], acc[i][6], acc[i][7]};
            E(pm * 256 + half * 128 + ty * 8 + i, pn, tx * 4, v0, v1); }
    }
}
struct ARowDense { const bf16_t* A; int K; int pm; __device__ __forceinline__ const bf16_t* operator()(int r) const { return A + (size_t)(pm * 256 + r) * K; } };
struct ARowGather { const bf16_t* A; const int* stok; int pm; __device__ __forceinline__ const bf16_t* operator()(int r) const { const int t = stok[pm * 256 + r]; return t < 0 ? nullptr : A + (size_t)t * 1024; } };

template <class EP>
__device__ __forceinline__ void gemm_dense_naive(const Frame& F, const bf16_t* A, const bf16_t* Bt, int M, int N, int K, const EP& E) {
    const int nM = M / 256, nN = N / 256;
    for (int u = F.bid; u < nM * nN; u += F.G) { const int pm = u / nN, pn = u % nN;
        ARowDense ar{A, K, pm}; gemm_unit_naive(F, K, ar, Bt + (size_t)pn * 256 * K, E, pm, pn); }
}

namespace pg8 {
typedef short bf16x8 __attribute__((ext_vector_type(8)));
constexpr int BM = 256, BK = 64, HALF = 128, HTB = HALF * BK * 2, STAGE_BYTES = 8 * HTB, NXCD = 8, WGM = 8;
__device__ __forceinline__ int lds_byte(int r, int c) { const int st = (r >> 4) * 2 + (c >> 5), rr = r & 15, cc = c & 31, ob = rr * 64 + cc * 2; return st * 1024 + (ob ^ (((ob >> 9) & 1) << 5)); }
__device__ __forceinline__ void stage_rc(int b, int& R, int& C) { const int st = b / 1024, sb = b % 1024, swz = sb ^ (((sb >> 9) & 1) << 5); R = (st >> 1) * 16 + swz / 64; C = (st & 1) * 32 + (swz % 64) / 2; }
struct Unit { int pm, pn; };
struct ProbDense {
    const char* A; const char* Bt; int K, nM, nN, nwg, G, c;
    __device__ __forceinline__ void init(const bf16_t* A_, const bf16_t* Bt_, int M, int N, int K_, int G_, int c_) { A = (const char*)A_; Bt = (const char*)Bt_; K = K_; nM = M / BM; nN = N / BM; nwg = nM * nN; G = G_; c = c_; }
    __device__ __forceinline__ bool next(int i, Unit& u) const {
        const long L = (long)i * G + c; if (L >= nwg) return false;
        int wgid = (int)L; { const int q = nwg / NXCD, r = nwg % NXCD, xcd = wgid % NXCD, off = wgid / NXCD; wgid = (xcd < r ? xcd * (q + 1) : r * (q + 1) + (xcd - r) * q) + off; }
        const int nig = WGM * nN, gid = wgid / nig, fm = gid * WGM, gsz = (nM - fm) < WGM ? (nM - fm) : WGM;
        u.pm = fm + ((wgid % nig) % gsz); u.pn = (wgid % nig) / gsz; return true;
    }
    __device__ __forceinline__ const char* bptr(const Unit& u) const { return Bt + (size_t)u.pn * 256 * K * 2; }
    __device__ __forceinline__ unsigned aoff(const Unit& u, int r) const { return (unsigned)(u.pm * 256 + r) * (unsigned)(K * 2); }
};
struct ProbMoe1 {
    const char* A; const int* stok; const int* tile_e; const char* W; int K, ntiles, G, c;
    __device__ __forceinline__ bool next(int i, Unit& u) const { const int L = i * G + c; if (L >= ntiles * 4) return false; u.pm = L >> 2; u.pn = L & 3; return true; }
    __device__ __forceinline__ const char* bptr(const Unit& u) const { return W + ((size_t)(tile_e[u.pm] & 31) * 1024 + u.pn * 256) * 2048; }
    __device__ __forceinline__ unsigned aoff(const Unit& u, int r) const { const int t = stok[u.pm * 256 + r]; return t < 0 ? 0u : (unsigned)t * 2048u; }
};
struct ProbMoe2 {
    const char* A; const int* tile_e; const char* W; int K, tlo, thi, G, c;
    __device__ __forceinline__ bool next(int i, Unit& u) const { const int L = i * G + c; if (L >= (thi - tlo) * 4) return false; u.pm = tlo + (L >> 2); u.pn = L & 3; return true; }
    __device__ __forceinline__ const char* bptr(const Unit& u) const { return W + ((size_t)(tile_e[u.pm] & 31) * 1024 + u.pn * 256) * 1024; }
    __device__ __forceinline__ unsigned aoff(const Unit& u, int r) const { return (unsigned)(u.pm * 256 + r) * 1024u; }
};

template <class Prob, class Epi>
__device__ __forceinline__ void gemm_phase(LAS unsigned char* lds, const Prob& S, const Epi& E) {
    const int tid = threadIdx.x, wid = __builtin_amdgcn_readfirstlane(tid >> 6), lane = tid & 63, wr = wid >> 2, wc = wid & 3, fr = lane & 15, fq = lane >> 4;
    const int K = S.K, nt = K / BK;
    int RA[2]; unsigned cb2[2], voffB[2];
#pragma unroll
    for (int i = 0; i < 2; ++i) { int R, C; stage_rc(tid * 16 + i * 8192, R, C); RA[i] = R; cb2[i] = (unsigned)C * 2u; voffB[i] = (unsigned)(R * K + C) * 2u; }
    const size_t kstep = (size_t)(BK * 2);
    const size_t hstepB = (size_t)HALF * K * 2;
    const unsigned ldsw = (unsigned)wid * 1024u;
    const int aoff = lds_byte(wr * 64 + fr, fq * 8), boff = lds_byte(wc * 32 + fr, fq * 8);
#define PG8_SA(b, h) (((b) * 2 + (h)) * HTB)
#define PG8_SB(b, h) ((4 + (b) * 2 + (h)) * HTB)
#define PG8_STAGE(bufoff, gbase, voff) do { _Pragma("unroll") for (int _i = 0; _i < 2; ++_i) \
        __builtin_amdgcn_global_load_lds((const unsigned*)((const char*)(gbase) + (voff)[_i]), (LAS unsigned*)(lds + (bufoff) + ldsw + _i * 8192), 16, 0, 0); } while (0)
#define PG8_LDA(dst, b, h) do { _Pragma("unroll") for (int m = 0; m < 4; ++m) _Pragma("unroll") for (int k = 0; k < 2; ++k) dst[m][k] = *(const LAS bf16x8*)(lds + PG8_SA(b, h) + aoff + m * 2048 + k * 1024); } while (0)
#define PG8_LDB(dst, b, h) do { _Pragma("unroll") for (int n = 0; n < 2; ++n) _Pragma("unroll") for (int k = 0; k < 2; ++k) dst[n][k] = *(const LAS bf16x8*)(lds + PG8_SB(b, h) + boff + n * 2048 + k * 1024); } while (0)
#define PG8_MMA(ai, bj, At, Bt) do { __builtin_amdgcn_s_setprio(1); _Pragma("unroll") for (int m = 0; m < 4; ++m) _Pragma("unroll") for (int n = 0; n < 2; ++n) _Pragma("unroll") for (int k = 0; k < 2; ++k) \
        acc[ai][bj][m][n] = __builtin_amdgcn_mfma_f32_16x16x32_bf16(Bt[n][k], At[m][k], acc[ai][bj][m][n], 0, 0, 0); __builtin_amdgcn_s_setprio(0); } while (0)
#define PG8_WAIT_V(n) asm volatile("s_waitcnt vmcnt(" #n ")" ::: "memory")
#define PG8_WAIT_L(n) asm volatile("s_waitcnt lgkmcnt(" #n ")" ::: "memory")
#define PG8_BAR __builtin_amdgcn_s_barrier()
#define PG8_SCHED __builtin_amdgcn_sched_barrier(0)
    Unit cur, nxt; int ui = 0;
    if (!S.next(0, cur)) return;
    f32x4 acc[2][2][4][2];
#pragma unroll
    for (int a = 0; a < 2; ++a)
#pragma unroll
        for (int b = 0; b < 2; ++b)
#pragma unroll
            for (int m = 0; m < 4; ++m)
#pragma unroll
                for (int n = 0; n < 2; ++n) acc[a][b][m][n] = (f32x4){0.f, 0.f, 0.f, 0.f};
    bf16x8 At[4][2], B0[2][2], B1[2][2];
    unsigned oc0[2], oc1[2], on0[2], on1[2];
#pragma unroll
    for (int i = 0; i < 2; ++i) { oc0[i] = S.aoff(cur, RA[i]) + cb2[i]; oc1[i] = S.aoff(cur, 128 + RA[i]) + cb2[i]; }
    const char* cB = S.bptr(cur);
    const char* const Ab = S.A;
    PG8_STAGE(PG8_SB(0, 0), cB, voffB); PG8_STAGE(PG8_SA(0, 0), Ab, oc0); PG8_STAGE(PG8_SB(0, 1), cB + hstepB, voffB); PG8_STAGE(PG8_SA(0, 1), Ab, oc1);
    if (wr == 1) PG8_BAR;
    PG8_WAIT_V(4); PG8_BAR;
    PG8_STAGE(PG8_SB(1, 0), cB + kstep, voffB); PG8_STAGE(PG8_SA(1, 0), Ab + kstep, oc0); PG8_STAGE(PG8_SB(1, 1), cB + hstepB + kstep, voffB);
    PG8_WAIT_V(6); PG8_BAR;
    for (;;) {
        const bool has_next = S.next(ui + 1, nxt);
        const char* nB = has_next ? S.bptr(nxt) : cB;
#pragma unroll
        for (int i = 0; i < 2; ++i) { on0[i] = has_next ? S.aoff(nxt, RA[i]) + cb2[i] : oc0[i]; on1[i] = has_next ? S.aoff(nxt, 128 + RA[i]) + cb2[i] : oc1[i]; }
        for (int t = 0; t < nt; t += 2) {
            const bool last = (t == nt - 2);
            const char* a1 = Ab + (size_t)(t + 1) * kstep;
            const char* a2 = last ? Ab : Ab + (size_t)(t + 2) * kstep; const char* b2 = last ? nB : cB + (size_t)(t + 2) * kstep;
            const char* a3 = a2 + kstep; const char* b3 = b2 + kstep;
            unsigned o20[2], o21[2];
#pragma unroll
            for (int i = 0; i < 2; ++i) { o20[i] = last ? on0[i] : oc0[i]; o21[i] = last ? on1[i] : oc1[i]; }
            PG8_LDB(B0, 0, 0); PG8_SCHED; PG8_LDA(At, 0, 0); PG8_STAGE(PG8_SA(1, 1), a1, oc1);
            PG8_WAIT_L(8); PG8_BAR; PG8_WAIT_L(0); PG8_MMA(0, 0, At, B0); PG8_BAR; PG8_SCHED;
            PG8_LDB(B1, 0, 1); PG8_STAGE(PG8_SB(0, 0), b2, voffB);
            PG8_BAR; PG8_WAIT_L(0); PG8_MMA(0, 1, At, B1); PG8_BAR;
            PG8_LDA(At, 0, 1); PG8_STAGE(PG8_SA(0, 0), a2, o20);
            PG8_BAR; PG8_WAIT_L(0); PG8_MMA(1, 0, At, B0); PG8_BAR; PG8_SCHED;
            PG8_STAGE(PG8_SB(0, 1), b2 + hstepB, voffB);
            PG8_WAIT_V(6); PG8_BAR; PG8_MMA(1, 1, At, B1); PG8_BAR;
            PG8_LDB(B0, 1, 0); PG8_SCHED; PG8_LDA(At, 1, 0); PG8_STAGE(PG8_SA(0, 1), a2, o21);
            PG8_WAIT_L(8); PG8_BAR; PG8_WAIT_L(0); PG8_MMA(0, 0, At, B0); PG8_BAR; PG8_SCHED;
            PG8_LDB(B1, 1, 1); PG8_STAGE(PG8_SB(1, 0), b3, voffB);
            PG8_BAR; PG8_WAIT_L(0); PG8_MMA(0, 1, At, B1); PG8_BAR;
            PG8_LDA(At, 1, 1); PG8_STAGE(PG8_SA(1, 0), a3, o20);
            PG8_BAR; PG8_WAIT_L(0); PG8_MMA(1, 0, At, B0); PG8_BAR; PG8_SCHED;
            PG8_STAGE(PG8_SB(1, 1), b3 + hstepB, voffB);
            PG8_WAIT_V(6); PG8_BAR; PG8_MMA(1, 1, At, B1); PG8_BAR;
        }
#pragma unroll
        for (int ai = 0; ai < 2; ++ai)
#pragma unroll
            for (int m = 0; m < 4; ++m)
#pragma unroll
                for (int n = 0; n < 2; ++n) E(cur.pm * BM + ai * HALF + wr * 64 + m * 16 + fr, cur.pn, wc * 32 + n * 16 + fq * 4, acc[ai][0][m][n], acc[ai][1][m][n]);
        if (!has_next) break;
#pragma unroll
        for (int a = 0; a < 2; ++a)
#pragma unroll
            for (int b = 0; b < 2; ++b)
#pragma unroll
                for (int m = 0; m < 4; ++m)
#pragma unroll
                    for (int n = 0; n < 2; ++n) acc[a][b][m][n] = (f32x4){0.f, 0.f, 0.f, 0.f};
        cur = nxt; cB = nB; ++ui;
#pragma unroll
        for (int i = 0; i < 2; ++i) { oc0[i] = on0[i]; oc1[i] = on1[i]; }
    }
    PG8_WAIT_V(0);
    if (wr == 0) PG8_BAR;
    PG8_BAR;
#undef PG8_SA
#undef PG8_SB
#undef PG8_STAGE
#undef PG8_LDA
#undef PG8_LDB
#undef PG8_MMA
#undef PG8_WAIT_V
#undef PG8_WAIT_L
#undef PG8_BAR
#undef PG8_SCHED
}
}

struct EpiStoreBf16 { bf16_t* O; int ldc; int gelu_below;
    __device__ __forceinline__ void operator()(int row, int pn, int cx, f32x4 v0, f32x4 v1) const {
        const int c0 = pn * 256 + cx, c1 = c0 + 128;
        if (c0 < gelu_below) { v0[0] = gelu_tanh_f(v0[0]); v0[1] = gelu_tanh_f(v0[1]); v0[2] = gelu_tanh_f(v0[2]); v0[3] = gelu_tanh_f(v0[3]); }
        if (c1 < gelu_below) { v1[0] = gelu_tanh_f(v1[0]); v1[1] = gelu_tanh_f(v1[1]); v1[2] = gelu_tanh_f(v1[2]); v1[3] = gelu_tanh_f(v1[3]); }
        u32x2 a; a.x = pack2(v0[0], v0[1]); a.y = pack2(v0[2], v0[3]); u32x2 b; b.x = pack2(v1[0], v1[1]); b.y = pack2(v1[2], v1[3]);
        *(u32x2*)(O + (size_t)row * ldc + c0) = a; *(u32x2*)(O + (size_t)row * ldc + c1) = b; } };
struct EpiResidual { const float* srcl; const float* srcc; float* dstl; float* dstc; const float* mod;   int which;
    __device__ __forceinline__ void operator()(int row, int pn, int cx, f32x4 v0, f32x4 v1) const {
        const int b = row < TL ? (row >> 13) : 8; const float* g = mod + ((size_t)b * 6 + which) * 1024;
        const float* s = row < TL ? srcl + (size_t)row * 1024 : srcc + (size_t)(row - TL) * 1024;
        float* d = row < TL ? dstl + (size_t)row * 1024 : dstc + (size_t)(row - TL) * 1024;
        const int c0 = pn * 256 + cx, c1 = c0 + 128;
        *(f32x4*)(d + c0) = *(const f32x4*)(s + c0) + *(const f32x4*)(g + c0) * v0;
        *(f32x4*)(d + c1) = *(const f32x4*)(s + c1) + *(const f32x4*)(g + c1) * v1; } };
struct EpiMoe1 { bf16_t* H;
    __device__ __forceinline__ void operator()(int row, int pn, int cx, f32x4 v0, f32x4 v1) const {
        u32x2 a; a.x = pack2(silu_f(v0[0]) * v1[0], silu_f(v0[1]) * v1[1]); a.y = pack2(silu_f(v0[2]) * v1[2], silu_f(v0[3]) * v1[3]);
        *(u32x2*)(H + (size_t)row * 512 + pn * 128 + cx) = a; } };
struct EpiMoe2 { const int* stok; const float* sw; float* dstl; float* dstc; const float* mod;
    __device__ __forceinline__ void operator()(int row, int pn, int cx, f32x4 v0, f32x4 v1) const {
        const int t = stok[row]; if (t < 0) return; const float w = sw[row];
        const int b = t < TL ? (t >> 13) : 8; const float* g = mod + ((size_t)b * 6 + 5) * 1024;
        float* d = t < TL ? dstl + (size_t)t * 1024 : dstc + (size_t)(t - TL) * 1024;
        const int c0 = pn * 256 + cx, c1 = c0 + 128;
        *(f32x4*)(d + c0) = *(const f32x4*)(d + c0) + *(const f32x4*)(g + c0) * v0 * w;
        *(f32x4*)(d + c1) = *(const f32x4*)(d + c1) + *(const f32x4*)(g + c1) * v1 * w; } };

#ifndef FAST_GEMM
#define FAST_GEMM 1
#endif
template <class EP>
__device__ __forceinline__ void gemm_dense(const Frame& F, const bf16_t* A, const bf16_t* Bt, int M, int N, int K, const EP& E) {
#if FAST_GEMM
    pg8::ProbDense S; S.init(A, Bt, M, N, K, F.G, F.bid); pg8::gemm_phase(F.lds, S, E);
#else
    gemm_dense_naive(F, A, Bt, M, N, K, E);
#endif
}
__device__ __forceinline__ void ph_moe_gemm1(const Frame& F, int layer) {
    const unsigned* info = (const unsigned*)(F.ws + WS_CTRL + C_MOE + layer * 1024) + 128;
    const int ntiles = (int)__hip_atomic_load(&info[1], __ATOMIC_RELAXED, __HIP_MEMORY_SCOPE_AGENT);
    const int* tile_e = (const int*)(F.ws + WS_R2 + R2_TILEE); const int* stok = (const int*)(F.ws + WS_R2 + R2_STOK);
    const bf16_t* W1 = (const bf16_t*)(F.ws + WS_WMOE);
    EpiMoe1 E{(bf16_t*)(F.ws + WS_R2 + R2_H)};
#if FAST_GEMM
    pg8::ProbMoe1 S{(const char*)(F.ws + WS_ACT), stok, tile_e, (const char*)W1, 1024, ntiles, F.G, F.bid};
    pg8::gemm_phase(F.lds, S, E);
#else
    for (int u = F.bid; u < ntiles * 4; u += F.G) { const int pm = u >> 2, pn = u & 3; const int e = tile_e[pm] & 31;
        ARowGather ar{(const bf16_t*)(F.ws + WS_ACT), stok, pm};
        gemm_unit_naive(F, 1024, ar, W1 + ((size_t)e * 1024 + pn * 256) * 1024, E, pm, pn); }
#endif
}
__device__ __forceinline__ void ph_moe_gemm2(const Frame& F, int layer, int k) {
    const unsigned* info = (const unsigned*)(F.ws + WS_CTRL + C_MOE + layer * 1024) + 128;
    const int nk0 = (int)__hip_atomic_load(&info[0], __ATOMIC_RELAXED, __HIP_MEMORY_SCOPE_AGENT), nall = (int)__hip_atomic_load(&info[1], __ATOMIC_RELAXED, __HIP_MEMORY_SCOPE_AGENT);
    const int tlo = k == 0 ? 0 : nk0, thi = k == 0 ? nk0 : nall;
    const int* tile_e = (const int*)(F.ws + WS_R2 + R2_TILEE);
    const bf16_t* W2 = (const bf16_t*)(F.ws + WS_WMOE) + (size_t)32 * 1024 * 1024;
    EpiMoe2 E{(const int*)(F.ws + WS_R2 + R2_STOK), (const float*)(F.ws + WS_R2 + R2_SW), F.P->out, (float*)(F.ws + WS_XC), F.mod + (size_t)layer * 9 * 6144};
#if FAST_GEMM
    pg8::ProbMoe2 S{(const char*)(F.ws + WS_R2 + R2_H), tile_e, (const char*)W2, 512, tlo, thi, F.G, F.bid};
    pg8::gemm_phase(F.lds, S, E);
#else
    for (int u = F.bid; u < (thi - tlo) * 4; u += F.G) { const int pm = tlo + (u >> 2), pn = u & 3; const int e = tile_e[pm] & 31;
        ARowDense ar{(const bf16_t*)(F.ws + WS_R2 + R2_H), 512, pm};
        gemm_unit_naive(F, 512, ar, W2 + ((size_t)e * 1024 + pn * 256) * 512, E, pm, pn); }
#endif
}

__device__ __forceinline__ void ph_gmlp(const Frame& F) {
    const Params& P = *F.P;
    const bf16_t* PX = (const bf16_t*)(F.ws + WS_PX); bf16_t* CAT = (bf16_t*)(F.ws + WS_ACT);
    LAS float* Vs = (LAS float*)F.lds;
    LAS float* Wm = Vs + 128 * 128;
    LAS float* rs = Wm + 128 * 129;
    for (int it = F.bid; it < 528 * 4; it += F.G) {
        const int ch = it >> 2, g = it & 3, row0 = ch * 128;
        for (int q = F.wave; q < 128; q += 8) { const bf16_t* p = PX + (size_t)(row0 + q) * EVEN_IN + 512 + F.lane * 8;
            const u32x4 w = *(const u32x4*)p; float s = 0.f, x;
            x = lo2f(w.x); s += x * x; x = hi2f(w.x); s += x * x; x = lo2f(w.y); s += x * x; x = hi2f(w.y); s += x * x;
            x = lo2f(w.z); s += x * x; x = hi2f(w.z); s += x * x; x = lo2f(w.w); s += x * x; x = hi2f(w.w); s += x * x;
            s = wave_sum(s); if (F.lane == 0) rs[q] = rsqrtf(s * (1.f / 512.f) + EPS); }
        __syncthreads();
        for (int i = F.tid; i < 128 * 128; i += NTH) { const int q = i >> 7, c = i & 127;
            Vs[i] = bf2f(PX[(size_t)(row0 + q) * EVEN_IN + 512 + g * 128 + c]) * rs[q] * P.in[I_GNW][g * 128 + c];
            Wm[q * 129 + c] = P.in[I_GWS][(size_t)g * 16384 + i]; }
        __syncthreads();
        const int ty = F.tid >> 5, tx = F.tid & 31;
        float acc[8][4];
#pragma unroll
        for (int i = 0; i < 8; ++i)
#pragma unroll
            for (int j = 0; j < 4; ++j) acc[i][j] = 0.f;
        for (int q = 0; q < 128; ++q) { const f32x4 v = *(const LAS f32x4*)(Vs + q * 128 + tx * 4);
#pragma unroll
            for (int i = 0; i < 8; ++i) { const float w = Wm[(ty * 8 + i) * 129 + q];
#pragma unroll
                for (int j = 0; j < 4; ++j) acc[i][j] += w * v[j]; } }
#pragma unroll
        for (int i = 0; i < 8; ++i) { const int p = ty * 8 + i; const float bias = P.in[I_GBS][g * 128 + p];
            const size_t t = (size_t)(row0 + p); const int col = g * 128 + tx * 4;
            const u32x2 uu = *(const u32x2*)(PX + t * EVEN_IN + col);
            u32x2 o; o.x = pack2(lo2f(uu.x) * (acc[i][0] + bias), hi2f(uu.x) * (acc[i][1] + bias)); o.y = pack2(lo2f(uu.y) * (acc[i][2] + bias), hi2f(uu.y) * (acc[i][3] + bias));
            *(u32x2*)(CAT + t * 1024 + col) = o; }
        __syncthreads();
    }
}

__device__ __forceinline__ void ph_gla(const Frame& F) {
    const Params& P = *F.P;
    const bf16_t* PX = (const bf16_t*)(F.ws + WS_PX);
    LAS float* qs = (LAS float*)F.lds;
    LAS float* fs = qs + 4096;
    LAS float* vs = fs + 4096;
    LAS float* os = vs + 1024;
    const int dg = F.lane & 15, el = F.wave * 4 + (F.lane >> 4);
    const int prow = F.tid >> 4, pd0 = (F.tid & 15) * 8;
    const int vrow = F.tid >> 2, ve0 = (F.tid & 3) * 8;
    for (int it = F.bid; it < 256; it += F.G) {
        const int b = it >> 5, h = (it >> 3) & 3, dir = (it >> 2) & 1, sl = it & 3;
        bf16_t* O = (bf16_t*)(F.ws + WS_R2 + (dir ? R2_OB0 : R2_OF0));
        float lb8[8];
#pragma unroll
        for (int i = 0; i < 8; ++i) { const int ch = h * 128 + pd0 + i; const float* lg = P.in[I_LB] + (size_t)dir * 3 * 512 + ch;
            const float a0 = lg[0], a1 = lg[512], a2 = lg[1024]; const float m = fmaxf(a0, fmaxf(a1, a2));
            const float e0 = __expf(a0 - m), e1 = __expf(a1 - m), e2 = __expf(a2 - m); lb8[i] = e0 / (e0 + e1 + e2); }
        float S[8];
#pragma unroll
        for (int i = 0; i < 8; ++i) S[i] = 0.f;
        u32x4 rq, rf, rv = {0u, 0u, 0u, 0u};
        auto rowof = [&](int nb, int s) -> size_t { const bool c = nb < 8; const int len = c ? CTXL : SEQ; const int tt = (c ? nb : nb - 8) * 32 + s; const int p = dir ? len - 1 - tt : tt;
            return (c ? (size_t)TL + b * CTXL : (size_t)b * SEQ) + p; };
        { const bf16_t* row = PX + rowof(0, prow) * EVEN_IN; rq = *(const u32x4*)(row + 1024 + h * 128 + pd0); rf = *(const u32x4*)(row + 2048 + dir * 512 + h * 128 + pd0);
          if (F.tid < 128) rv = *(const u32x4*)(PX + rowof(0, vrow) * EVEN_IN + 1536 + h * 128 + sl * 32 + ve0); }
        for (int nb = 0; nb < 264; ++nb) {
            __syncthreads();
            { LAS float* qd = qs + prow * 128 + pd0; LAS float* fd = fs + prow * 128 + pd0;
              const float q8[8] = {lo2f(rq.x), hi2f(rq.x), lo2f(rq.y), hi2f(rq.y), lo2f(rq.z), hi2f(rq.z), lo2f(rq.w), hi2f(rq.w)};
              const float f8[8] = {lo2f(rf.x), hi2f(rf.x), lo2f(rf.y), hi2f(rf.y), lo2f(rf.z), hi2f(rf.z), lo2f(rf.w), hi2f(rf.w)};
              f32x4 o0, o1, g0, g1;
#pragma unroll
              for (int i = 0; i < 4; ++i) { o0[i] = q8[i]; o1[i] = q8[4 + i]; g0[i] = lb8[i] + (1.f - lb8[i]) * sigmoid_f(f8[i]); g1[i] = lb8[4 + i] + (1.f - lb8[4 + i]) * sigmoid_f(f8[4 + i]); }
              *(LAS f32x4*)qd = o0; *(LAS f32x4*)(qd + 4) = o1; *(LAS f32x4*)fd = g0; *(LAS f32x4*)(fd + 4) = g1;
              if (F.tid < 128) { LAS float* vd = vs + vrow * 32 + ve0;
                  *(LAS f32x4*)vd = (f32x4){lo2f(rv.x), hi2f(rv.x), lo2f(rv.y), hi2f(rv.y)}; *(LAS f32x4*)(vd + 4) = (f32x4){lo2f(rv.z), hi2f(rv.z), lo2f(rv.w), hi2f(rv.w)}; } }
            __syncthreads();
            if (nb + 1 < 264) { const bf16_t* row = PX + rowof(nb + 1, prow) * EVEN_IN; rq = *(const u32x4*)(row + 1024 + h * 128 + pd0); rf = *(const u32x4*)(row + 2048 + dir * 512 + h * 128 + pd0);
                if (F.tid < 128) rv = *(const u32x4*)(PX + rowof(nb + 1, vrow) * EVEN_IN + 1536 + h * 128 + sl * 32 + ve0); }
#pragma unroll 4
            for (int st = 0; st < 32; ++st) {
                const f32x4 fa = *(const LAS f32x4*)(fs + st * 128 + dg * 8), fb = *(const LAS f32x4*)(fs + st * 128 + dg * 8 + 4);
                const f32x4 qa = *(const LAS f32x4*)(qs + st * 128 + dg * 8), qb = *(const LAS f32x4*)(qs + st * 128 + dg * 8 + 4);
                const float v = vs[st * 32 + el];
                float p0 = 0.f, p1 = 0.f;
#pragma unroll
                for (int i = 0; i < 4; ++i) { S[i] = fa[i] * S[i] + (1.f - fa[i]) * v; p0 += qa[i] * S[i]; S[4 + i] = fb[i] * S[4 + i] + (1.f - fb[i]) * v; p1 += qb[i] * S[4 + i]; }
                const float o = sum16(p0 + p1);
                if (dg == 0) os[st * 32 + el] = o;
            }
            __syncthreads();
            { const int s = F.tid >> 4, e2 = (F.tid & 15) * 2;
              *(unsigned*)(O + rowof(nb, s) * 512 + h * 128 + sl * 32 + e2) = pack2(os[s * 32 + e2], os[s * 32 + e2 + 1]); }
        }
        __syncthreads();
    }
}

__device__ __forceinline__ void ph_merge(const Frame& F, int mode) {
    const Params& P = *F.P;
    const bf16_t* PX = (const bf16_t*)(F.ws + WS_PX); bf16_t* CAT = (bf16_t*)(F.ws + WS_ACT);
    const bf16_t* Of = (const bf16_t*)(mode ? F.ws + WS_GOF : F.ws + WS_R2 + R2_OF0); const bf16_t* Ob = (const bf16_t*)(mode ? F.ws + WS_WMOE : F.ws + WS_R2 + R2_OB0);
    const int nrows = mode ? TL : TT, ldp = mode ? ODD_PAD : EVEN_IN, gcol = mode ? 1536 : 3072, dcol = mode ? 0 : 512;
    const float* nw = mode ? P.in[I_GDNNW] : P.in[I_HNW];
    for (int r = F.bid * 8 + F.wave; r < nrows; r += F.G * 8) {
        const int c = F.lane * 8;
        const u32x4 a = *(const u32x4*)(Of + (size_t)r * 512 + c), bb = *(const u32x4*)(Ob + (size_t)r * 512 + c), gg = *(const u32x4*)(PX + (size_t)r * ldp + gcol + c);
        float o[8] = {lo2f(a.x) + lo2f(bb.x), hi2f(a.x) + hi2f(bb.x), lo2f(a.y) + lo2f(bb.y), hi2f(a.y) + hi2f(bb.y), lo2f(a.z) + lo2f(bb.z), hi2f(a.z) + hi2f(bb.z), lo2f(a.w) + lo2f(bb.w), hi2f(a.w) + hi2f(bb.w)};
        const float g[8] = {lo2f(gg.x), hi2f(gg.x), lo2f(gg.y), hi2f(gg.y), lo2f(gg.z), hi2f(gg.z), lo2f(gg.w), hi2f(gg.w)};
        float ss = 0.f;
#pragma unroll
        for (int i = 0; i < 8; ++i) ss += o[i] * o[i];
        ss = sum16(ss);
        const float rstd = rsqrtf(ss * (1.f / 128.f) + EPS);
        float y[8];
#pragma unroll
        for (int i = 0; i < 8; ++i) { const float w = mode ? nw[(c & 127) + i] : nw[c + i]; y[i] = o[i] * rstd * w * silu_f(g[i]); }
        u32x4 w; w.x = pack2(y[0], y[1]); w.y = pack2(y[2], y[3]); w.z = pack2(y[4], y[5]); w.w = pack2(y[6], y[7]);
        *(u32x4*)(CAT + (size_t)r * 1024 + dcol + c) = w;
    }
}

__device__ __forceinline__ void ph_mla_norm(const Frame& F) {
    const Params& P = *F.P;
    const bf16_t* PX = (const bf16_t*)(F.ws + WS_PX);
    bf16_t* cqn = (bf16_t*)(F.ws + WS_R2 + R2_CQN); bf16_t* ckvn = cqn + (size_t)TL * 256;
    for (int r = F.bid * 8 + F.wave; r < TT; r += F.G * 8) {
        const bf16_t* row = PX + (size_t)r * ODD_PAD;
        if (r < TL) { const u32x2 w = *(const u32x2*)(row + 2064 + F.lane * 4);
            const float x0 = lo2f(w.x), x1 = hi2f(w.x), x2 = lo2f(w.y), x3 = hi2f(w.y);
            const float ss = wave_sum(x0 * x0 + x1 * x1 + x2 * x2 + x3 * x3); const float rstd = rsqrtf(ss * (1.f / 256.f) + EPS);
            const float* nw = P.in[I_QNW] + F.lane * 4;
            u32x2 o; o.x = pack2(x0 * rstd * nw[0], x1 * rstd * nw[1]); o.y = pack2(x2 * rstd * nw[2], x3 * rstd * nw[3]);
            *(u32x2*)(cqn + (size_t)r * 256 + F.lane * 4) = o; }
        { const unsigned w = *(const unsigned*)(row + 2320 + F.lane * 2);
          const float x0 = lo2f(w), x1 = hi2f(w);
          const float ss = wave_sum(x0 * x0 + x1 * x1); const float rstd = rsqrtf(ss * (1.f / 128.f) + EPS);
          const float* nw = P.in[I_KVNW] + F.lane * 2;
          *(unsigned*)(ckvn + (size_t)r * 256 + F.lane * 2) = pack2(x0 * rstd * nw[0], x1 * rstd * nw[1]);
          *(unsigned*)(ckvn + (size_t)r * 256 + 128 + F.lane * 2) = 0u; }
    }
}

__device__ __forceinline__ void ph_mla_final(const Frame& F) {
    const Params& P = *F.P;
    const bf16_t* PX = (const bf16_t*)(F.ws + WS_PX);
    bf16_t* Q = (bf16_t*)(F.ws + WS_WMOE);
    const bf16_t* KVR = (const bf16_t*)(F.ws + WS_PX + PX_KVRAW);
    bf16_t* Kb = (bf16_t*)(F.ws + WS_R2 + R2_K); bf16_t* Vb = (bf16_t*)(F.ws + WS_R2 + R2_V);
    const int hh = F.lane >> 3, sub = F.lane & 7;
    const float freq = __powf(10000.f, -(float)sub * 0.125f);
    const float qscale = 0.10206207261596577f * 1.4426950408889634f;
    for (int r = F.bid * 8 + F.wave; r < TT; r += F.G * 8) {
        const bool lat = r < TL; const int l = r & (SEQ - 1);
        float ca = 1.f, sa = 0.f, cb = 1.f, sb = 0.f;
        if (lat) { const float pr = (float)(l >> 6), pc = (float)(l & 63); sincosf(pr * freq, &sa, &ca); sincosf(pc * freq, &sb, &cb); }
        { const bf16_t* kv = KVR + (size_t)r * 1024 + hh * 128;
          const u32x4 w = *(const u32x4*)(kv + sub * 8);
          float x[12] = {lo2f(w.x), hi2f(w.x), lo2f(w.y), hi2f(w.y), lo2f(w.z), hi2f(w.z), lo2f(w.w), hi2f(w.w), 0.f, 0.f, 0.f, 0.f};
          const bf16_t* kr = PX + (size_t)r * ODD_PAD + 2448;
          x[8] = bf2f(kr[sub]); x[9] = bf2f(kr[8 + sub]); x[10] = bf2f(kr[16 + sub]); x[11] = bf2f(kr[24 + sub]);
          float ss = 0.f;
#pragma unroll
          for (int i = 0; i < 12; ++i) ss += x[i] * x[i];
          ss = sum8(ss);
          const float rstd = rsqrtf(ss * (1.f / 96.f) + EPS);
          const float* nw = P.in[I_QKK];
#pragma unroll
          for (int i = 0; i < 8; ++i) x[i] *= rstd * nw[sub * 8 + i];
          x[8] *= rstd * nw[64 + sub]; x[9] *= rstd * nw[72 + sub]; x[10] *= rstd * nw[80 + sub]; x[11] *= rstd * nw[88 + sub];
          const float a1 = x[8] * ca - x[9] * sa, a2 = x[9] * ca + x[8] * sa, b1 = x[10] * cb - x[11] * sb, b2 = x[11] * cb + x[10] * sb;
          const int bidx = lat ? (r >> 13) : ((r - TL) >> 8); const int s = lat ? (CTXL + l) : ((r - TL) & 255);
          bf16_t* kd = Kb + ((size_t)(bidx * 8 + hh) * (SEQ + CTXL) + s) * 96;
          u32x4 o; o.x = pack2(x[0], x[1]); o.y = pack2(x[2], x[3]); o.z = pack2(x[4], x[5]); o.w = pack2(x[6], x[7]);
          *(u32x4*)(kd + sub * 8) = o;
          kd[64 + sub] = f2bf(a1); kd[72 + sub] = f2bf(a2); kd[80 + sub] = f2bf(b1); kd[88 + sub] = f2bf(b2);
          const u32x4 vv = *(const u32x4*)(kv + 64 + sub * 8);
          *(u32x4*)(Vb + ((size_t)(bidx * 8 + hh) * (SEQ + CTXL) + s) * 64 + sub * 8) = vv; }
        if (lat) { bf16_t* q = Q + (size_t)r * 768 + hh * 96;
          const u32x4 w = *(const u32x4*)(q + sub * 8);
          float x[12] = {lo2f(w.x), hi2f(w.x), lo2f(w.y), hi2f(w.y), lo2f(w.z), hi2f(w.z), lo2f(w.w), hi2f(w.w), bf2f(q[64 + sub]), bf2f(q[72 + sub]), bf2f(q[80 + sub]), bf2f(q[88 + sub])};
          float ss = 0.f;
#pragma unroll
          for (int i = 0; i < 12; ++i) ss += x[i] * x[i];
          ss = sum8(ss);
          const float rstd = rsqrtf(ss * (1.f / 96.f) + EPS) * qscale;
          const float* nw = P.in[I_QKQ];
#pragma unroll
          for (int i = 0; i < 8; ++i) x[i] *= rstd * nw[sub * 8 + i];
          x[8] *= rstd * nw[64 + sub]; x[9] *= rstd * nw[72 + sub]; x[10] *= rstd * nw[80 + sub]; x[11] *= rstd * nw[88 + sub];
          const float a1 = x[8] * ca - x[9] * sa, a2 = x[9] * ca + x[8] * sa, b1 = x[10] * cb - x[11] * sb, b2 = x[11] * cb + x[10] * sb;
          u32x4 o; o.x = pack2(x[0], x[1]); o.y = pack2(x[2], x[3]); o.z = pack2(x[4], x[5]); o.w = pack2(x[6], x[7]);
          *(u32x4*)(q + sub * 8) = o;
          q[64 + sub] = f2bf(a1); q[72 + sub] = f2bf(a2); q[80 + sub] = f2bf(b1); q[88 + sub] = f2bf(b2); }
    }
}

__device__ __forceinline__ void ph_attn_naive(const Frame& F) {
    const bf16_t* Q = (const bf16_t*)(F.ws + WS_WMOE);
    const bf16_t* Kb = (const bf16_t*)(F.ws + WS_R2 + R2_K); const bf16_t* Vb = (const bf16_t*)(F.ws + WS_R2 + R2_V);
    bf16_t* CAT = (bf16_t*)(F.ws + WS_ACT);
    LAS float* Ks = (LAS float*)F.lds;
    LAS float* Vs = Ks + 64 * 96;
    constexpr int NK = SEQ + CTXL;
    const int hf = F.tid & 1;
    for (int it = F.bid; it < 8 * 8 * 32; it += F.G) {
        const int b = it >> 8, h = (it >> 5) & 7, qb = it & 31;
        const int l = qb * 256 + (F.tid >> 1); const size_t trow = (size_t)b * SEQ + l;
        float q[48], o[32];
        { const bf16_t* qp = Q + trow * 768 + h * 96 + hf * 48;
#pragma unroll
          for (int i = 0; i < 6; ++i) { const u32x4 w = *(const u32x4*)(qp + i * 8);
            q[i * 8 + 0] = lo2f(w.x); q[i * 8 + 1] = hi2f(w.x); q[i * 8 + 2] = lo2f(w.y); q[i * 8 + 3] = hi2f(w.y); q[i * 8 + 4] = lo2f(w.z); q[i * 8 + 5] = hi2f(w.z); q[i * 8 + 6] = lo2f(w.w); q[i * 8 + 7] = hi2f(w.w); } }
#pragma unroll
        for (int d = 0; d < 32; ++d) o[d] = 0.f;
        float m = -3.0e38f, ls = 0.f;
        const bf16_t* kb = Kb + (size_t)(b * 8 + h) * NK * 96; const bf16_t* vb = Vb + (size_t)(b * 8 + h) * NK * 64;
        for (int kt = 0; kt < NK / 64; ++kt) {
            for (int i = F.tid; i < 64 * 96 / 8; i += NTH) { const u32x4 w = *(const u32x4*)(kb + (size_t)kt * 64 * 96 + i * 8); LAS float* d = Ks + i * 8;
                d[0] = lo2f(w.x); d[1] = hi2f(w.x); d[2] = lo2f(w.y); d[3] = hi2f(w.y); d[4] = lo2f(w.z); d[5] = hi2f(w.z); d[6] = lo2f(w.w); d[7] = hi2f(w.w); }
            { const int i = F.tid; const u32x4 w = *(const u32x4*)(vb + (size_t)kt * 64 * 64 + i * 8); LAS float* d = Vs + i * 8;
                d[0] = lo2f(w.x); d[1] = hi2f(w.x); d[2] = lo2f(w.y); d[3] = hi2f(w.y); d[4] = lo2f(w.z); d[5] = hi2f(w.z); d[6] = lo2f(w.w); d[7] = hi2f(w.w); }
            __syncthreads();
            for (int jb = 0; jb < 16; ++jb) {
                float s[4]; float mx = m;
#pragma unroll
                for (int jj = 0; jj < 4; ++jj) { const LAS float* kr = Ks + (jb * 4 + jj) * 96 + hf * 48; float a = 0.f;
#pragma unroll
                    for (int d = 0; d < 48; d += 4) { const f32x4 kv = *(const LAS f32x4*)(kr + d); a += q[d] * kv[0] + q[d + 1] * kv[1] + q[d + 2] * kv[2] + q[d + 3] * kv[3]; }
                    a += __shfl_xor(a, 1);
                    s[jj] = a; mx = fmaxf(mx, a); }
                const float sc = exp2f(m - mx); ls *= sc;
#pragma unroll
                for (int d = 0; d < 32; ++d) o[d] *= sc;
                m = mx;
#pragma unroll
                for (int jj = 0; jj < 4; ++jj) { const float p = exp2f(s[jj] - mx); ls += p; const LAS float* vr = Vs + (jb * 4 + jj) * 64 + hf * 32;
#pragma unroll
                    for (int d = 0; d < 32; d += 4) { const f32x4 vv = *(const LAS f32x4*)(vr + d); o[d] += p * vv[0]; o[d + 1] += p * vv[1]; o[d + 2] += p * vv[2]; o[d + 3] += p * vv[3]; } }
            }
            __syncthreads();
        }
        const float inv = 1.f / ls;
        bf16_t* dst = CAT + trow * 1024 + 512 + h * 64 + hf * 32;
#pragma unroll
        for (int i = 0; i < 4; ++i) { u32x4 w; w.x = pack2(o[i * 8] * inv, o[i * 8 + 1] * inv); w.y = pack2(o[i * 8 + 2] * inv, o[i * 8 + 3] * inv); w.z = pack2(o[i * 8 + 4] * inv, o[i * 8 + 5] * inv); w.w = pack2(o[i * 8 + 6] * inv, o[i * 8 + 7] * inv);
            *(u32x4*)(dst + i * 8) = w; }
    }
}

typedef float f32x16 __attribute__((ext_vector_type(16)));
typedef short s16x8 __attribute__((ext_vector_type(8)));
__device__ __forceinline__ void ph_attn(const Frame& F) {
    constexpr int NK = SEQ + CTXL, NT = NK / 64;
    constexpr int KROWB = 208, VROWB = 136, KBYTES = 64 * KROWB, VBYTES = 64 * VROWB, BUFB = KBYTES + VBYTES;
    const bf16_t* Q = (const bf16_t*)(F.ws + WS_WMOE);
    const bf16_t* Kb = (const bf16_t*)(F.ws + WS_R2 + R2_K); const bf16_t* Vb = (const bf16_t*)(F.ws + WS_R2 + R2_V);
    bf16_t* CAT = (bf16_t*)(F.ws + WS_ACT);
    const int l31 = F.lane & 31, hh = F.lane >> 5;
    const int vcu = (F.G % 8 == 0) ? (F.bid % 8) * (F.G / 8) + F.bid / 8 : F.bid;
    const int kc0 = F.tid, kc1 = F.tid + 512;
    const unsigned kd0 = (unsigned)((kc0 / 12) * KROWB + (kc0 % 12) * 16), kd1 = (unsigned)((kc1 / 12) * KROWB + (kc1 % 12) * 16);
    const unsigned vd = (unsigned)(((F.tid & 7) * 8) * VROWB + (F.tid >> 3) * 2);
    for (int u = vcu; u < 2048; u += F.G) {
        const int bh = u >> 5, qblk = u & 31, b = bh >> 3, h = bh & 7;
        const size_t trow = (size_t)b * SEQ + qblk * 256 + F.wave * 32 + l31;
        s16x8 qf[6];
        { const bf16_t* qp = Q + trow * 768 + h * 96 + hh * 8;
#pragma unroll
          for (int ds = 0; ds < 6; ++ds) qf[ds] = *(const s16x8*)(qp + ds * 16); }
        f32x16 o0, o1;
#pragma unroll
        for (int i = 0; i < 16; ++i) { o0[i] = 0.f; o1[i] = 0.f; }
        float m = -1.0e30f, lsum = 0.f;
        const bf16_t* kg = Kb + (size_t)bh * NK * 96; const bf16_t* vg = Vb + (size_t)bh * NK * 64;
        u32x4 kr0, kr1 = {0u, 0u, 0u, 0u}, vr;
        kr0 = *(const u32x4*)(kg + (size_t)kc0 * 8); if (kc1 < 768) kr1 = *(const u32x4*)(kg + (size_t)kc1 * 8); vr = *(const u32x4*)(vg + (size_t)F.tid * 8);
        __syncthreads();
        for (int t = 0; t < NT; ++t) {
            { LAS unsigned char* kbuf = F.lds + (t & 1) * BUFB; LAS unsigned char* vbuf = kbuf + KBYTES;
              *(LAS u32x4*)(kbuf + kd0) = kr0; if (kc1 < 768) *(LAS u32x4*)(kbuf + kd1) = kr1;
              LAS unsigned short* vp = (LAS unsigned short*)(vbuf + vd);
              vp[0 * (VROWB / 2)] = (unsigned short)(vr.x & 0xffffu); vp[1 * (VROWB / 2)] = (unsigned short)(vr.x >> 16);
              vp[2 * (VROWB / 2)] = (unsigned short)(vr.y & 0xffffu); vp[3 * (VROWB / 2)] = (unsigned short)(vr.y >> 16);
              vp[4 * (VROWB / 2)] = (unsigned short)(vr.z & 0xffffu); vp[5 * (VROWB / 2)] = (unsigned short)(vr.z >> 16);
              vp[6 * (VROWB / 2)] = (unsigned short)(vr.w & 0xffffu); vp[7 * (VROWB / 2)] = (unsigned short)(vr.w >> 16); }
            __syncthreads();
            if (t + 1 < NT) { const bf16_t* kt = kg + (size_t)(t + 1) * 64 * 96; const bf16_t* vt = vg + (size_t)(t + 1) * 64 * 64;
                kr0 = *(const u32x4*)(kt + (size_t)kc0 * 8); if (kc1 < 768) kr1 = *(const u32x4*)(kt + (size_t)kc1 * 8); vr = *(const u32x4*)(vt + (size_t)F.tid * 8); }
            const LAS unsigned char* kbuf = F.lds + (t & 1) * BUFB; const LAS unsigned char* vbuf = kbuf + KBYTES;
            f32x16 s0, s1;
#pragma unroll
            for (int i = 0; i < 16; ++i) { s0[i] = 0.f; s1[i] = 0.f; }
#pragma unroll
            for (int ds = 0; ds < 6; ++ds) {
                const s16x8 a0 = *(const LAS s16x8*)(kbuf + l31 * KROWB + ds * 32 + hh * 16);
                const s16x8 a1 = *(const LAS s16x8*)(kbuf + (32 + l31) * KROWB + ds * 32 + hh * 16);
                s0 = __builtin_amdgcn_mfma_f32_32x32x16_bf16(a0, qf[ds], s0, 0, 0, 0);
                s1 = __builtin_amdgcn_mfma_f32_32x32x16_bf16(a1, qf[ds], s1, 0, 0, 0);
            }
            float mx = s0[0];
#pragma unroll
            for (int i = 1; i < 16; ++i) mx = fmaxf(mx, s0[i]);
#pragma unroll
            for (int i = 0; i < 16; ++i) mx = fmaxf(mx, s1[i]);
            mx = fmaxf(mx, __shfl_xor(mx, 32));
            const float mn = fmaxf(m, mx); const float alpha = __builtin_amdgcn_exp2f(m - mn); m = mn;
            float ps = 0.f;
#pragma unroll
            for (int i = 0; i < 16; ++i) { s0[i] = __builtin_amdgcn_exp2f(s0[i] - mn); s1[i] = __builtin_amdgcn_exp2f(s1[i] - mn); ps += s0[i] + s1[i]; }
            lsum = lsum * alpha + ps;
#pragma unroll
            for (int i = 0; i < 16; ++i) { o0[i] *= alpha; o1[i] *= alpha; }
#pragma unroll
            for (int kb = 0; kb < 2; ++kb)
#pragma unroll
                for (int st = 0; st < 2; ++st) {
                    u32x4 pw;
                    if (kb == 0) { pw.x = pack2(s0[8 * st + 0], s0[8 * st + 1]); pw.y = pack2(s0[8 * st + 2], s0[8 * st + 3]); pw.z = pack2(s0[8 * st + 4], s0[8 * st + 5]); pw.w = pack2(s0[8 * st + 6], s0[8 * st + 7]); }
                    else         { pw.x = pack2(s1[8 * st + 0], s1[8 * st + 1]); pw.y = pack2(s1[8 * st + 2], s1[8 * st + 3]); pw.z = pack2(s1[8 * st + 4], s1[8 * st + 5]); pw.w = pack2(s1[8 * st + 6], s1[8 * st + 7]); }
                    const s16x8 pf = __builtin_bit_cast(s16x8, pw);
                    const int kof = (kb * 32 + 16 * st + 4 * hh) * 2;
                    u32x4 va; u32x2 t0, t1;
                    t0 = *(const LAS u32x2*)(vbuf + l31 * VROWB + kof); t1 = *(const LAS u32x2*)(vbuf + l31 * VROWB + kof + 16);
                    va.x = t0.x; va.y = t0.y; va.z = t1.x; va.w = t1.y;
                    o0 = __builtin_amdgcn_mfma_f32_32x32x16_bf16(__builtin_bit_cast(s16x8, va), pf, o0, 0, 0, 0);
                    t0 = *(const LAS u32x2*)(vbuf + (32 + l31) * VROWB + kof); t1 = *(const LAS u32x2*)(vbuf + (32 + l31) * VROWB + kof + 16);
                    va.x = t0.x; va.y = t0.y; va.z = t1.x; va.w = t1.y;
                    o1 = __builtin_amdgcn_mfma_f32_32x32x16_bf16(__builtin_bit_cast(s16x8, va), pf, o1, 0, 0, 0);
                }
        }
        const float ltot = lsum + __shfl_xor(lsum, 32); const float inv = 1.f / ltot;
        bf16_t* dst = CAT + trow * 1024 + 512 + h * 64 + hh * 4;
#pragma unroll
        for (int g = 0; g < 4; ++g) { u32x2 w;
            w.x = pack2(o0[4 * g] * inv, o0[4 * g + 1] * inv); w.y = pack2(o0[4 * g + 2] * inv, o0[4 * g + 3] * inv); *(u32x2*)(dst + g * 8) = w;
            w.x = pack2(o1[4 * g] * inv, o1[4 * g + 1] * inv); w.y = pack2(o1[4 * g + 2] * inv, o1[4 * g + 3] * inv); *(u32x2*)(dst + 32 + g * 8) = w; }
    }
    __syncthreads();
}

__device__ __forceinline__ void ph_gdn(const Frame& F) {
    const Params& P = *F.P;
    const bf16_t* PX = (const bf16_t*)(F.ws + WS_PX);
    LAS bf16_t* rq = (LAS bf16_t*)F.lds;
    LAS bf16_t* rk = rq + 36 * 128;
    LAS bf16_t* rv = rk + 36 * 128;
    LAS float* qc = (LAS float*)(F.lds + 24576);
    LAS float* kc = qc + 4096;
    LAS float* vc = kc + 4096;
    LAS float* os = vc + 1024;
    LAS float* ba = os + 1024;
    const int dg = F.lane & 15, el = F.wave * 4 + (F.lane >> 4);
    for (int it = F.bid; it < 256; it += F.G) {
        const int b = it >> 5, h = (it >> 3) & 3, dir = (it >> 2) & 1, sl = it & 3;
        bf16_t* O = dir ? (bf16_t*)(F.ws + WS_WMOE) : (bf16_t*)(F.ws + WS_GOF);
        const float a_neg = -__expf(P.in[I_ALOG][dir * 4 + h]), dtb = P.in[I_DTB][dir * 4 + h];
        float cwq[5], cwk[5], cwv[5];
        { const int d = F.tid & 127;
#pragma unroll
          for (int j = 0; j < 5; ++j) { cwq[j] = P.in[I_CONVW][j * 1536 + h * 128 + d]; cwk[j] = P.in[I_CONVW][j * 1536 + 512 + h * 128 + d]; cwv[j] = P.in[I_CONVW][j * 1536 + 1024 + h * 128 + sl * 32 + (F.tid & 31)]; } }
        float S[8];
#pragma unroll
        for (int i = 0; i < 8; ++i) S[i] = 0.f;
        u32x4 pr0, pr1, pr2; float pbeta = 0.f, pdec = 0.f;
        auto blk_geom = [&](int bi, int& len, size_t& rbase, int& p0) { const bool c = bi < 8; len = c ? CTXL : SEQ; rbase = c ? (size_t)TL + b * CTXL : (size_t)b * SEQ;
            const int nbk = len / 32, k = c ? bi : bi - 8; p0 = (dir ? (nbk - 1 - k) : k) * 32; };
        auto fetch = [&](int bi, int id) -> u32x4 { int len, p0; size_t rbase; blk_geom(bi, len, rbase, p0);
            u32x4 z = {0u, 0u, 0u, 0u}; if (id >= 1296) return z;
            int arr = 0, j = id; if (j >= 1152) { arr = 2; j -= 1152; } else if (j >= 576) { arr = 1; j -= 576; }
            const int rr = arr == 2 ? (j >> 2) : (j >> 4), part = arr == 2 ? (j & 3) : (j & 15); const int p = p0 - 2 + rr;
            if (p < 0 || p >= len) return z;
            const bf16_t* row = PX + (rbase + p) * ODD_PAD + (arr == 0 ? h * 128 : (arr == 1 ? 512 + h * 128 : 1024 + h * 128 + sl * 32)) + part * 8;
            return *(const u32x4*)row; };
        auto stash = [&](int id, u32x4 w) { if (id >= 1296) return; int arr = 0, j = id; if (j >= 1152) { arr = 2; j -= 1152; } else if (j >= 576) { arr = 1; j -= 576; }
            LAS bf16_t* d = arr == 0 ? rq + j * 8 : (arr == 1 ? rk + j * 8 : rv + j * 8); *(LAS u32x4*)d = w; };
        auto fetch_all = [&](int bi) { pr0 = fetch(bi, F.tid); pr1 = fetch(bi, F.tid + 512); pr2 = fetch(bi, F.tid + 1024);
            if (F.tid < 32) { int len, p0; size_t rbase; blk_geom(bi, len, rbase, p0); const bf16_t* row = PX + (rbase + p0 + F.tid) * ODD_PAD;
                pbeta = bf2f(row[2048 + dir * 4 + h]); pdec = bf2f(row[2056 + dir * 4 + h]); } };
        fetch_all(0);
        for (int bi = 0; bi < 264; ++bi) {
            __syncthreads();
            stash(F.tid, pr0); stash(F.tid + 512, pr1); stash(F.tid + 1024, pr2);
            if (F.tid < 32) { ba[F.tid] = sigmoid_f(pbeta); ba[32 + F.tid] = __expf(a_neg * softplus_f(pdec + dtb)); }
            __syncthreads();
            if (bi + 1 < 264) fetch_all(bi + 1);
            { const int d = F.tid & 127;
#pragma unroll
              for (int i = 0; i < 8; ++i) { const int s = (F.tid >> 7) + i * 4; float a = 0.f, c = 0.f;
#pragma unroll
                for (int j = 0; j < 5; ++j) { a += bf2f(rq[(s + j) * 128 + d]) * cwq[j]; c += bf2f(rk[(s + j) * 128 + d]) * cwk[j]; }
                qc[s * 128 + d] = silu_f(a); kc[s * 128 + d] = silu_f(c); }
#pragma unroll
              for (int i = 0; i < 2; ++i) { const int s = (F.tid >> 5) + i * 16, e = F.tid & 31; float a = 0.f;
#pragma unroll
                for (int j = 0; j < 5; ++j) a += bf2f(rv[(s + j) * 32 + e]) * cwv[j];
                vc[s * 32 + e] = silu_f(a); } }
            __syncthreads();
            { const int s = F.wave * 4 + (F.lane >> 4);
              LAS float* qp = qc + s * 128 + dg * 8; LAS float* kp = kc + s * 128 + dg * 8;
              f32x4 q0 = *(LAS f32x4*)qp, q1 = *(LAS f32x4*)(qp + 4), k0 = *(LAS f32x4*)kp, k1 = *(LAS f32x4*)(kp + 4);
              float sq = 0.f, sk = 0.f;
#pragma unroll
              for (int i = 0; i < 4; ++i) { sq += q0[i] * q0[i] + q1[i] * q1[i]; sk += k0[i] * k0[i] + k1[i] * k1[i]; }
              sq = sum16(sq); sk = sum16(sk);
              const float rq_ = rsqrtf(sq + EPS) * 0.08838834764831845f, rk_ = rsqrtf(sk + EPS);
              *(LAS f32x4*)qp = q0 * rq_; *(LAS f32x4*)(qp + 4) = q1 * rq_; *(LAS f32x4*)kp = k0 * rk_; *(LAS f32x4*)(kp + 4) = k1 * rk_; }
            __syncthreads();
#pragma unroll 2
            for (int ss = 0; ss < 32; ++ss) {
                const int st = dir ? 31 - ss : ss;
                const f32x4 ka = *(const LAS f32x4*)(kc + st * 128 + dg * 8), kb = *(const LAS f32x4*)(kc + st * 128 + dg * 8 + 4);
                const f32x4 qa = *(const LAS f32x4*)(qc + st * 128 + dg * 8), qb = *(const LAS f32x4*)(qc + st * 128 + dg * 8 + 4);
                const float v = vc[st * 32 + el], beta = ba[st], a = ba[32 + st];
                float r0 = 0.f, r1 = 0.f;
#pragma unroll
                for (int i = 0; i < 4; ++i) { r0 += ka[i] * S[i]; r1 += kb[i] * S[4 + i]; }
                const float r = sum16(r0 + r1);
                const float u = beta * (v - a * r);
                float p0 = 0.f, p1 = 0.f;
#pragma unroll
                for (int i = 0; i < 4; ++i) { S[i] = a * S[i] + ka[i] * u; p0 += qa[i] * S[i]; S[4 + i] = a * S[4 + i] + kb[i] * u; p1 += qb[i] * S[4 + i]; }
                const float o = sum16(p0 + p1);
                if (dg == 0) os[st * 32 + el] = o;
            }
            __syncthreads();
            { int len, p0; size_t rbase; blk_geom(bi, len, rbase, p0);
              const int s = F.tid >> 4, e2 = (F.tid & 15) * 2;
              *(unsigned*)(O + (rbase + p0 + s) * 512 + h * 128 + sl * 32 + e2) = pack2(os[s * 32 + e2], os[s * 32 + e2 + 1]); }
        }
        __syncthreads();
    }
}

constexpr int GR_KN = 0, GR_QN = 16384, GR_VT = 32768, GR_T = 49152, GR_QK = 65536, GR_SC = 81920, GR_BYTES = 83968;
__device__ __forceinline__ s16x8 pack8(const f32x16& x, int s8) {
    u32x4 p; p.x = pack2(x[s8 + 0], x[s8 + 1]); p.y = pack2(x[s8 + 2], x[s8 + 3]); p.z = pack2(x[s8 + 4], x[s8 + 5]); p.w = pack2(x[s8 + 6], x[s8 + 7]);
    return __builtin_bit_cast(s16x8, p);
}
__device__ __forceinline__ s16x8 ld2x64(const LAS unsigned char* p) {
    const u32x2 a = *(const LAS u32x2*)p, b = *(const LAS u32x2*)(p + 16); u32x4 v; v.x = a.x; v.y = a.y; v.z = b.x; v.w = b.y; return __builtin_bit_cast(s16x8, v);
}
__device__ __forceinline__ void st2x64(LAS unsigned char* p, u32x4 v) { u32x2 a, b; a.x = v.x; a.y = v.y; b.x = v.z; b.y = v.w; *(LAS u32x2*)p = a; *(LAS u32x2*)(p + 8) = b; }
__device__ __forceinline__ u32x4 ld2x64n(const LAS unsigned char* p) { const u32x2 a = *(const LAS u32x2*)p, b = *(const LAS u32x2*)(p + 8); u32x4 v; v.x = a.x; v.y = a.y; v.z = b.x; v.w = b.y; return v; }
__device__ __forceinline__ void gdn_unit_geom(int b, int ck, size_t& rbase, int& len, int& p0) {
    if (ck < 4) { rbase = (size_t)TL + b * CTXL; len = CTXL; p0 = ck * 64; } else { rbase = (size_t)b * SEQ; len = SEQ; p0 = (ck - 4) * 64; }
}
__device__ __forceinline__ void ph_gdn_prep(const Frame& F) {
    const Params& P = *F.P;
    const bf16_t* PX = (const bf16_t*)(F.ws + WS_PX);
    LAS unsigned char* L = F.lds;
    LAS bf16_t* RAW = (LAS bf16_t*)L;
    LAS unsigned char* KNI = L; LAS unsigned char* QNI = L + 16896;
    LAS float* qf = (LAS float*)(L + 52224);
    LAS float* kf = qf + 8192;
    LAS unsigned char* VTI = L + 52224 + 65536;
    LAS float* SCL = (LAS float*)(L + 52224 + 65536 + 17408);
    const int l31 = F.lane & 31, hh = F.lane >> 5;
    for (int u = F.bid; u < 4224; u += F.G) {
        const int b = u / 528, h = (u % 528) / 132, ck = u % 132;
        size_t rbase; int len, p0; gdn_unit_geom(b, ck, rbase, len, p0);
        unsigned char* rec = F.ws + WS_GREC + (size_t)u * GR_BYTES;
        for (int c = F.tid; c < 68 * 48; c += NTH) { const int rr = c / 48, part = c % 48; const int p = p0 - 2 + rr; u32x4 w = {0u, 0u, 0u, 0u};
            if (p >= 0 && p < len) w = *(const u32x4*)(PX + (rbase + p) * ODD_PAD + (part >> 4) * 512 + h * 128 + (part & 15) * 8);
            *(LAS u32x4*)(RAW + rr * 384 + part * 8) = w; }
        if (F.tid < 64) { const bf16_t* row = PX + (rbase + p0 + F.tid) * ODD_PAD;
            const float an_f = -__expf(P.in[I_ALOG][h]), an_b = -__expf(P.in[I_ALOG][4 + h]);
            SCL[256 + F.tid] = sigmoid_f(bf2f(row[2048 + h])); SCL[320 + F.tid] = sigmoid_f(bf2f(row[2052 + h]));
            SCL[F.tid] = an_f * softplus_f(bf2f(row[2056 + h]) + P.in[I_DTB][h]); SCL[64 + F.tid] = an_b * softplus_f(bf2f(row[2060 + h]) + P.in[I_DTB][4 + h]); }
        __syncthreads();
        { const int d = F.tid & 127, rg = F.tid >> 7;
          float cq[5], ckk[5], cv[5];
#pragma unroll
          for (int j = 0; j < 5; ++j) { cq[j] = P.in[I_CONVW][j * 1536 + h * 128 + d]; ckk[j] = P.in[I_CONVW][j * 1536 + 512 + h * 128 + d]; cv[j] = P.in[I_CONVW][j * 1536 + 1024 + h * 128 + d]; }
#pragma unroll 4
          for (int ii = 0; ii < 16; ++ii) { const int i = rg * 16 + ii; float a = 0.f, c = 0.f, e = 0.f;
#pragma unroll
              for (int j = 0; j < 5; ++j) { const LAS bf16_t* rr = RAW + (i + j) * 384 + d; a += bf2f(rr[0]) * cq[j]; c += bf2f(rr[128]) * ckk[j]; e += bf2f(rr[256]) * cv[j]; }
              qf[i * 128 + d] = silu_f(a); kf[i * 128 + d] = silu_f(c);
              *(LAS bf16_t*)(VTI + d * 136 + i * 2) = f2bf(silu_f(e)); } }
        if (F.tid < 64) { float gf = 0.f, gb = 0.f;
            for (int j = 0; j < 64; ++j) { gf += (j <= F.tid) ? SCL[j] : 0.f; gb += (j >= F.tid) ? SCL[64 + j] : 0.f; }
            SCL[128 + F.tid] = gf; SCL[192 + F.tid] = gb; }
        __syncthreads();
#pragma unroll
        for (int rr = 0; rr < 8; ++rr) { const int i = F.wave * 8 + rr;
            const float q0 = qf[i * 128 + F.lane], q1 = qf[i * 128 + 64 + F.lane], k0 = kf[i * 128 + F.lane], k1 = kf[i * 128 + 64 + F.lane];
            const float sq = wave_sum(q0 * q0 + q1 * q1), sk = wave_sum(k0 * k0 + k1 * k1);
            const float rq_ = rsqrtf(sq + EPS) * 0.08838834764831845f, rk_ = rsqrtf(sk + EPS);
            *(LAS bf16_t*)(QNI + i * 264 + F.lane * 2) = f2bf(q0 * rq_); *(LAS bf16_t*)(QNI + i * 264 + 128 + F.lane * 2) = f2bf(q1 * rq_);
            *(LAS bf16_t*)(KNI + i * 264 + F.lane * 2) = f2bf(k0 * rk_); *(LAS bf16_t*)(KNI + i * 264 + 128 + F.lane * 2) = f2bf(k1 * rk_); }
        __syncthreads();
        { const int mq = F.wave >> 2, ib = (F.wave >> 1) & 1, jb = F.wave & 1;
          const LAS unsigned char* Ai = (mq ? QNI : KNI) + (32 * ib + l31) * 264 + hh * 16; const LAS unsigned char* Bi = KNI + (32 * jb + l31) * 264 + hh * 16;
          f32x16 acc;
#pragma unroll
          for (int r = 0; r < 16; ++r) acc[r] = 0.f;
#pragma unroll
          for (int ds = 0; ds < 8; ++ds) acc = __builtin_amdgcn_mfma_f32_32x32x16_bf16(__builtin_bit_cast(s16x8, ld2x64n(Ai + ds * 32)), __builtin_bit_cast(s16x8, ld2x64n(Bi + ds * 32)), acc, 0, 0, 0);
          __syncthreads();
          const int j = 32 * jb + l31; const float gfj = SCL[128 + j], gbj = SCL[192 + j];
          bf16_t* qkf = (bf16_t*)(rec + GR_QK); bf16_t* qkb = qkf + 4096;
#pragma unroll
          for (int r = 0; r < 16; ++r) { const int i = 32 * ib + (r & 3) + 8 * (r >> 2) + 4 * hh;
              const float ef = __expf(fminf(SCL[128 + i] - gfj, 0.f)), eb = __expf(fminf(SCL[192 + i] - gbj, 0.f));
              if (mq == 0) { qf[i * 64 + j] = (j < i) ? SCL[256 + i] * acc[r] * ef : 0.f; kf[(63 - i) * 64 + (63 - j)] = (j > i) ? SCL[320 + i] * acc[r] * eb : 0.f; }
              else { qkf[i * 64 + j] = f2bf((j <= i) ? acc[r] * ef : 0.f); qkb[i * 64 + j] = f2bf((j >= i) ? acc[r] * eb : 0.f); } } }
        __syncthreads();
        if (F.wave < 2) {
            const LAS float* Am = F.wave == 0 ? qf : kf; LAS float* Tl = (F.wave == 0 ? qf : kf) + 4096; const int c = F.lane;
            for (int i = 0; i < 64; ++i) Tl[i * 64 + c] = 0.f;
            for (int i = 0; i < 64; ++i) { float a0 = (c == i) ? 1.f : 0.f, a1 = 0.f;
                const int ng = (i + 3) >> 2;
                for (int jg = 0; jg < ng; ++jg) { const f32x4 m = *(const LAS f32x4*)(Am + i * 64 + jg * 4);
                    a0 -= m[0] * Tl[(jg * 4 + 0) * 64 + c]; a1 -= m[1] * Tl[(jg * 4 + 1) * 64 + c]; a0 -= m[2] * Tl[(jg * 4 + 2) * 64 + c]; a1 -= m[3] * Tl[(jg * 4 + 3) * 64 + c]; }
                Tl[i * 64 + c] = a0 + a1; }
            bf16_t* Tg = (bf16_t*)(rec + GR_T) + (F.wave ? 4096 : 0);
            for (int i = 0; i < 64; ++i) { const bf16_t v = f2bf(Tl[i * 64 + c]); if (F.wave == 0) Tg[i * 64 + c] = v; else Tg[(63 - i) * 64 + (63 - c)] = v; }
        } else {
            const int t6 = F.tid - 128;
            for (int c = t6; c < 3072; c += 384) {
                u32x4 w; if (c < 2048) { const int cc = c & 1023, row = cc >> 4, part = cc & 15; w = ld2x64n((c < 1024 ? KNI : QNI) + row * 264 + part * 16); }
                else { const int cc = c - 2048, row = cc >> 3, part = cc & 7; w = ld2x64n(VTI + row * 136 + part * 16); }
                *(u32x4*)(rec + (size_t)c * 16) = w; }
            if (t6 < 64) { float* sc = (float*)(rec + GR_SC); const int i = t6;
                const float gf = SCL[128 + i], gb = SCL[192 + i], glf = SCL[128 + 63], glb = SCL[192 + 0];
                sc[i] = SCL[256 + i]; sc[64 + i] = __expf(gf); sc[128 + i] = __expf(glf - gf);
                sc[192 + i] = SCL[320 + i]; sc[256 + i] = __expf(gb); sc[320 + i] = __expf(glb - gb);
                if (i == 0) { sc[384] = __expf(glf); sc[385] = __expf(glb); } }
        }
        __syncthreads();
    }
}

__device__ __forceinline__ void ph_gdn_scan(const Frame& F) {
    LAS unsigned char* L = F.lds;
    LAS unsigned char* KNI = L;
    LAS unsigned char* QNI = L + 16896;
    LAS unsigned char* VTI = L + 33792;
    LAS unsigned char* KTI = L + 51200;
    LAS unsigned char* TI = L + 68608;
    LAS unsigned char* QKI = L + 77312;
    LAS float* SC = (LAS float*)(L + 86016);
    const int l31 = F.lane & 31, hh = F.lane >> 5, w = F.wave;
    for (int it = F.bid; it < 64; it += F.G) {
        const int b = it >> 3, h = (it >> 1) & 3, dir = it & 1;
        bf16_t* O = dir ? (bf16_t*)(F.ws + WS_WMOE) : (bf16_t*)(F.ws + WS_GOF);
        f32x16 S0, S1, S2, S3;
#pragma unroll
        for (int r = 0; r < 16; ++r) { S0[r] = 0.f; S1[r] = 0.f; S2[r] = 0.f; S3[r] = 0.f; }
        u32x4 pre[16]; float psc = 0.f;
        const int t4 = F.tid - 256;
        auto ckof = [&](int n) -> int { return dir ? (n < 4 ? 3 - n : 135 - n) : n; };
        auto fetch = [&](int n) { const unsigned char* rec = F.ws + WS_GREC + (size_t)((b * 4 + h) * 132 + ckof(n)) * GR_BYTES;
#pragma unroll
            for (int k = 0; k < 12; ++k) pre[k] = *(const u32x4*)(rec + (size_t)(t4 + 256 * k) * 16);
#pragma unroll
            for (int k = 0; k < 2; ++k) { pre[12 + k] = *(const u32x4*)(rec + GR_T + dir * 8192 + (t4 + 256 * k) * 16); pre[14 + k] = *(const u32x4*)(rec + GR_QK + dir * 8192 + (t4 + 256 * k) * 16); }
            if (t4 < 193) psc = ((const float*)(rec + GR_SC))[t4 < 192 ? dir * 192 + t4 : 384 + dir]; };
        if (w >= 4) {
            fetch(0);
            for (int n = 0; n < 132; ++n) {
                __syncthreads();
#pragma unroll
                for (int k = 0; k < 4; ++k) { const int c = t4 + 256 * k, row = c >> 4, part = c & 15; st2x64(KNI + row * 264 + part * 16, pre[k]);
                    LAS unsigned short* kt = (LAS unsigned short*)(KTI + (part * 8) * 136 + row * 2); const u32x4 v = pre[k];
                    kt[0 * 68] = (unsigned short)(v.x & 0xffffu); kt[1 * 68] = (unsigned short)(v.x >> 16); kt[2 * 68] = (unsigned short)(v.y & 0xffffu); kt[3 * 68] = (unsigned short)(v.y >> 16);
                    kt[4 * 68] = (unsigned short)(v.z & 0xffffu); kt[5 * 68] = (unsigned short)(v.z >> 16); kt[6 * 68] = (unsigned short)(v.w & 0xffffu); kt[7 * 68] = (unsigned short)(v.w >> 16); }
#pragma unroll
                for (int k = 4; k < 8; ++k) { const int c = t4 + 256 * (k - 4), row = c >> 4, part = c & 15; st2x64(QNI + row * 264 + part * 16, pre[k]); }
#pragma unroll
                for (int k = 8; k < 12; ++k) { const int c = t4 + 256 * (k - 8), row = c >> 3, part = c & 7; st2x64(VTI + row * 136 + part * 16, pre[k]); }
#pragma unroll
                for (int k = 0; k < 2; ++k) { const int c = t4 + 256 * k, row = c >> 3, part = c & 7; st2x64(TI + row * 136 + part * 16, pre[12 + k]); st2x64(QKI + row * 136 + part * 16, pre[14 + k]); }
                if (t4 < 193) SC[t4] = psc;
                __syncthreads();
                if (n + 1 < 132) fetch(n + 1);
            }
        } else
        for (int n = 0; n < 132; ++n) {
            __syncthreads();
            __syncthreads();
            {
                size_t rbase; int len, p0; gdn_unit_geom(b, ckof(n), rbase, len, p0);
                const float alast = SC[192];
                f32x16 P0, P1;
#pragma unroll
                for (int r = 0; r < 16; ++r) { P0[r] = 0.f; P1[r] = 0.f; }
#pragma unroll
                for (int r = 0; r < 4; ++r)
#pragma unroll
                    for (int s = 0; s < 2; ++s) { const s16x8 sb = pack8(r == 0 ? S0 : (r == 1 ? S1 : (r == 2 ? S2 : S3)), 8 * s);
                        const int co = (32 * r + 16 * s + 4 * hh) * 2;
                        P0 = __builtin_amdgcn_mfma_f32_32x32x16_bf16(ld2x64(KNI + l31 * 264 + co), sb, P0, 0, 0, 0);
                        P1 = __builtin_amdgcn_mfma_f32_32x32x16_bf16(ld2x64(KNI + (32 + l31) * 264 + co), sb, P1, 0, 0, 0); }
#pragma unroll
                for (int gq = 0; gq < 4; ++gq) {
#pragma unroll
                    for (int ib = 0; ib < 2; ++ib) { const int i0 = 32 * ib + 8 * gq + 4 * hh;
                        const f32x4 be = *(const LAS f32x4*)(SC + i0), eg = *(const LAS f32x4*)(SC + 64 + i0);
                        const u32x2 vv = *(const LAS u32x2*)(VTI + (32 * w + l31) * 136 + i0 * 2);
                        const float v0 = lo2f(vv.x), v1 = hi2f(vv.x), v2 = lo2f(vv.y), v3 = hi2f(vv.y);
                        if (ib == 0) { P0[4 * gq + 0] = be[0] * (v0 - eg[0] * P0[4 * gq + 0]); P0[4 * gq + 1] = be[1] * (v1 - eg[1] * P0[4 * gq + 1]); P0[4 * gq + 2] = be[2] * (v2 - eg[2] * P0[4 * gq + 2]); P0[4 * gq + 3] = be[3] * (v3 - eg[3] * P0[4 * gq + 3]); }
                        else         { P1[4 * gq + 0] = be[0] * (v0 - eg[0] * P1[4 * gq + 0]); P1[4 * gq + 1] = be[1] * (v1 - eg[1] * P1[4 * gq + 1]); P1[4 * gq + 2] = be[2] * (v2 - eg[2] * P1[4 * gq + 2]); P1[4 * gq + 3] = be[3] * (v3 - eg[3] * P1[4 * gq + 3]); } } }
                f32x16 V0, V1;
#pragma unroll
                for (int r = 0; r < 16; ++r) { V0[r] = 0.f; V1[r] = 0.f; }
#pragma unroll
                for (int jb = 0; jb < 2; ++jb)
#pragma unroll
                    for (int s = 0; s < 2; ++s) { const s16x8 pb = pack8(jb == 0 ? P0 : P1, 8 * s); const int co = (32 * jb + 16 * s + 4 * hh) * 2;
                        V0 = __builtin_amdgcn_mfma_f32_32x32x16_bf16(ld2x64(TI + l31 * 136 + co), pb, V0, 0, 0, 0);
                        V1 = __builtin_amdgcn_mfma_f32_32x32x16_bf16(ld2x64(TI + (32 + l31) * 136 + co), pb, V1, 0, 0, 0); }
                f32x16 T0, T1;
#pragma unroll
                for (int r = 0; r < 16; ++r) { T0[r] = 0.f; T1[r] = 0.f; }
#pragma unroll
                for (int r = 0; r < 4; ++r)
#pragma unroll
                    for (int s = 0; s < 2; ++s) { const s16x8 sa = pack8(r == 0 ? S0 : (r == 1 ? S1 : (r == 2 ? S2 : S3)), 8 * s);
                        const int co = (32 * r + 16 * s + 4 * hh) * 2;
                        T0 = __builtin_amdgcn_mfma_f32_32x32x16_bf16(sa, ld2x64(QNI + l31 * 264 + co), T0, 0, 0, 0);
                        T1 = __builtin_amdgcn_mfma_f32_32x32x16_bf16(sa, ld2x64(QNI + (32 + l31) * 264 + co), T1, 0, 0, 0); }
                { const float e0 = SC[64 + l31], e1 = SC[64 + 32 + l31];
#pragma unroll
                  for (int r = 0; r < 16; ++r) { T0[r] *= e0; T1[r] *= e1; } }
#pragma unroll
                for (int jb = 0; jb < 2; ++jb)
#pragma unroll
                    for (int s = 0; s < 2; ++s) { const s16x8 va = pack8(jb == 0 ? V0 : V1, 8 * s); const int co = (32 * jb + 16 * s + 4 * hh) * 2;
                        T0 = __builtin_amdgcn_mfma_f32_32x32x16_bf16(va, ld2x64(QKI + l31 * 136 + co), T0, 0, 0, 0);
                        T1 = __builtin_amdgcn_mfma_f32_32x32x16_bf16(va, ld2x64(QKI + (32 + l31) * 136 + co), T1, 0, 0, 0); }
                { bf16_t* o0 = O + (rbase + p0 + l31) * 512 + h * 128 + 32 * w + 4 * hh; bf16_t* o1 = o0 + (size_t)32 * 512;
#pragma unroll
                  for (int gq = 0; gq < 4; ++gq) { u32x2 x; x.x = pack2(T0[4 * gq], T0[4 * gq + 1]); x.y = pack2(T0[4 * gq + 2], T0[4 * gq + 3]); *(u32x2*)(o0 + gq * 8) = x;
                      x.x = pack2(T1[4 * gq], T1[4 * gq + 1]); x.y = pack2(T1[4 * gq + 2], T1[4 * gq + 3]); *(u32x2*)(o1 + gq * 8) = x; } }
#pragma unroll
                for (int gq = 0; gq < 4; ++gq) { const f32x4 c0 = *(const LAS f32x4*)(SC + 128 + 8 * gq + 4 * hh), c1 = *(const LAS f32x4*)(SC + 128 + 32 + 8 * gq + 4 * hh);
#pragma unroll
                    for (int q = 0; q < 4; ++q) { V0[4 * gq + q] *= c0[q]; V1[4 * gq + q] *= c1[q]; } }
#pragma unroll
                for (int r = 0; r < 16; ++r) { S0[r] *= alast; S1[r] *= alast; S2[r] *= alast; S3[r] *= alast; }
#pragma unroll
                for (int ib = 0; ib < 2; ++ib)
#pragma unroll
                    for (int s = 0; s < 2; ++s) { const s16x8 vb = pack8(ib == 0 ? V0 : V1, 8 * s); const int co = (32 * ib + 16 * s + 4 * hh) * 2;
                        S0 = __builtin_amdgcn_mfma_f32_32x32x16_bf16(ld2x64(KTI + (l31) * 136 + co), vb, S0, 0, 0, 0);
                        S1 = __builtin_amdgcn_mfma_f32_32x32x16_bf16(ld2x64(KTI + (32 + l31) * 136 + co), vb, S1, 0, 0, 0);
                        S2 = __builtin_amdgcn_mfma_f32_32x32x16_bf16(ld2x64(KTI + (64 + l31) * 136 + co), vb, S2, 0, 0, 0);
                        S3 = __builtin_amdgcn_mfma_f32_32x32x16_bf16(ld2x64(KTI + (96 + l31) * 136 + co), vb, S3, 0, 0, 0); }
            }
        }
        __syncthreads();
    }
}

#ifndef FAST_ATTN
#define FAST_ATTN 1
#endif
constexpr int NPHASES = 27;
__global__ void __launch_bounds__(NTH, 2) fwd(Params P) {
    extern __shared__ __attribute__((aligned(16))) unsigned char lds_raw[];
    Frame F; F.P = &P; F.ws = P.ws; F.lds = (LAS unsigned char*)lds_raw;
    F.tid = threadIdx.x; F.lane = F.tid & 63; F.wave = __builtin_amdgcn_readfirstlane(F.tid >> 6); F.G = gridDim.x; F.bid = blockIdx.x;
    F.mod = (float*)(P.ws + WS_CTRL + C_MOD); F.ctrl = (unsigned*)(P.ws + WS_CTRL);
    volatile LAS unsigned* xbw = (volatile LAS unsigned*)(F.lds + LDS_BYTES - 16);
    if (F.tid < 4) xbw[F.tid] = 0u;
    __syncthreads();
    const int lo = P.ph_lo, hi = P.ph_hi;
    const bool single = (hi - lo) > 1;
    XcdBarrier bar; bar.bar = F.ctrl; bar.x = 0; bar.st = xbw;
    if (single) bar = xcd_barrier_post(F.ctrl, xbw);
#ifndef PH_MASK
#define PH_MASK 0xffffffffu
#endif
#define IN(k) (((PH_MASK >> (k)) & 1u) && lo <= (k) && (k) < hi)
#define SEAM(k) do { if (IN(k) && IN((k) + 1)) xcd_barrier(bar); } while (0)
#ifndef DUP_MASK
#define DUP_MASK 0u
#endif
#define DUP(k) ((DUP_MASK >> (k)) & 1u)
    bf16_t* wsm = (bf16_t*)(P.ws + WS_WSM);
    bf16_t* ACT = (bf16_t*)(P.ws + WS_ACT); bf16_t* PX = (bf16_t*)(P.ws + WS_PX);
    float* XC = (float*)(P.ws + WS_XC);

    if (IN(0)) { ph_prologue(F); if (DUP(0)) { __syncthreads(); conv_moe_weights(F, 0, F.bid, F.G); } } SEAM(0);
    if (IN(1)) { ph_rownorm(F, 0, TT, P.in[I_X], P.in[I_CTX], P.in[I_NMIX], 0); if (DUP(1)) ph_rownorm(F, 0, TT, P.in[I_X], P.in[I_CTX], P.in[I_NMIX], 0); } SEAM(1);
    if (IN(2)) { EpiStoreBf16 E{PX, EVEN_IN, 1024}; gemm_dense(F, ACT, wsm + W_EIN / 2, TT, EVEN_IN, 1024, E); if (DUP(2)) gemm_dense(F, ACT, wsm + W_EIN / 2, TT, EVEN_IN, 1024, E); } SEAM(2);
    if (IN(3)) { ph_gmlp(F); if (DUP(3)) { __syncthreads(); ph_gmlp(F); } } SEAM(3);
    if (IN(4)) { ph_gla(F); if (DUP(4)) { __syncthreads(); ph_gla(F); } } SEAM(4);
    if (IN(5)) { ph_merge(F, 0); if (DUP(5)) ph_merge(F, 0); } SEAM(5);
    if (IN(6)) { EpiResidual E{P.in[I_X], P.in[I_CTX], P.out, XC, F.mod, 2}; gemm_dense(F, ACT, wsm + W_EOUT / 2, TT, 1024, 1024, E); } SEAM(6);
    if (IN(7)) { ph_router(F, 0, TT, P.out, XC, P.in[I_NFFN], 3); } SEAM(7);
    if (IN(8)) { ph_dispatch(F, 0, TT); } SEAM(8);
    if (IN(9)) { ph_moe_gemm1(F, 0); if (DUP(9)) ph_moe_gemm1(F, 0); } SEAM(9);
    if (IN(10)) { ph_moe_gemm2(F, 0, 0); } SEAM(10);
    if (IN(11)) { ph_moe_gemm2(F, 0, 1); } SEAM(11);
    if (IN(12)) { ph_rownorm(F, 1, TT, P.out, XC, P.in[I_NMIX] + 1024, 0);
#ifdef DBG_ZERO
        { u32x4 z = {0u, 0u, 0u, 0u}; u32x4* p = (u32x4*)(P.ws + WS_GREC); const size_t n = (size_t)(990 - 585) * MiB / 16;
          for (size_t i = (size_t)F.bid * NTH + F.tid; i < n; i += (size_t)F.G * NTH) p[i] = z;
          u32x4* q = (u32x4*)(P.ws + WS_WMOE); const size_t m = (size_t)66 * MiB / 16;
          for (size_t i = (size_t)F.bid * NTH + F.tid; i < m; i += (size_t)F.G * NTH) q[i] = z; }
#endif
    } SEAM(12);
    if (IN(13)) { EpiStoreBf16 E{PX, ODD_PAD, 0}; gemm_dense(F, ACT, wsm + W_OIN / 2, TT, ODD_PAD, 1024, E); if (DUP(13)) gemm_dense(F, ACT, wsm + W_OIN / 2, TT, ODD_PAD, 1024, E); } SEAM(13);
#ifndef CHUNKED_GDN
#define CHUNKED_GDN 1
#endif
    if (IN(14)) { if (CHUNKED_GDN) ph_gdn_prep(F); } SEAM(14);
    if (IN(15)) { if (CHUNKED_GDN) ph_gdn_scan(F); else ph_gdn(F); } SEAM(15);
    if (IN(16)) { ph_merge(F, 1); } SEAM(16);
    if (IN(17)) { ph_mla_norm(F); } SEAM(17);
    if (IN(18)) { const bf16_t* cqn = (const bf16_t*)(P.ws + WS_R2 + R2_CQN);
                  EpiStoreBf16 E1{(bf16_t*)(P.ws + WS_WMOE), 768, 0}; gemm_dense(F, cqn, wsm + W_WQ / 2, TL, 768, 256, E1);
                  EpiStoreBf16 E2{(bf16_t*)(P.ws + WS_PX + PX_KVRAW), 1024, 0}; gemm_dense(F, cqn + (size_t)TL * 256, wsm + W_WKV / 2, TT, 1024, 256, E2); } SEAM(18);
    if (IN(19)) { ph_mla_final(F); } SEAM(19);
    if (IN(20)) { if (FAST_ATTN) ph_attn(F); else ph_attn_naive(F); if (DUP(20)) { __syncthreads(); ph_attn(F); } } SEAM(20);
    if (IN(21)) { EpiResidual E{P.out, P.out, P.out, P.out, F.mod + 9 * 6144, 2}; gemm_dense(F, ACT, wsm + W_OOUT / 2, TL, 1024, 1024, E); } SEAM(21);
    if (IN(22)) { ph_router(F, 1, TL, P.out, XC, P.in[I_NFFN] + 1024, 3); conv_moe_weights(F, 1, F.bid, F.G); } SEAM(22);
    if (IN(23)) { ph_dispatch(F, 1, TL); } SEAM(23);
    if (IN(24)) { ph_moe_gemm1(F, 1); if (DUP(24)) ph_moe_gemm1(F, 1); } SEAM(24);
    if (IN(25)) { ph_moe_gemm2(F, 1, 0); } SEAM(25);
    if (IN(26)) { ph_moe_gemm2(F, 1, 1); }
#undef IN
#undef SEAM
}

#ifndef N_LAUNCH_MODE
#define N_LAUNCH_MODE 1
#endif
extern "C" void kernel_launch(void* const* d_in, const int* in_sizes, int n_in, void* d_out, int out_size, void* d_ws, size_t ws_size, hipStream_t stream) {
    static int grid = 0;
    if (grid == 0) {
        if (n_in != 34 || out_size != TL * DM || ws_size < WS_END) { fprintf(stderr, "kernel_launch: unexpected shapes (n_in %d out %d ws %zu)\n", n_in, out_size, ws_size); grid = -1; return; }
        int dev = 0, cus = 0;
        if (hipGetDevice(&dev) != hipSuccess || hipDeviceGetAttribute(&cus, hipDeviceAttributeMultiprocessorCount, dev) != hipSuccess) { grid = -1; return; }
        if (hipFuncSetAttribute((const void*)fwd, hipFuncAttributeMaxDynamicSharedMemorySize, LDS_BYTES) != hipSuccess) { fprintf(stderr, "kernel_launch: hipFuncSetAttribute failed\n"); grid = -1; return; }
        int per_cu = 0;
        (void)hipOccupancyMaxActiveBlocksPerMultiprocessor(&per_cu, (const void*)fwd, NTH, LDS_BYTES);
        (void)hipGetLastError();
        if (per_cu < 1) fprintf(stderr, "kernel_launch: occupancy query says %d\n", per_cu);
        grid = cus;
    }
    if (grid < 0) return;
    (void)hipMemsetAsync(d_ws, 0, MiB, stream);
    Params p{};
    for (int i = 0; i < 34; ++i) p.in[i] = (const float*)d_in[i];
    p.out = (float*)d_out; p.ws = (unsigned char*)d_ws;
#if N_LAUNCH_MODE == 1
    p.ph_lo = 0; p.ph_hi = NPHASES;
    hipLaunchKernelGGL(fwd, dim3(grid), dim3(NTH), LDS_BYTES, stream, p);
#else
    for (int k = 0; k < NPHASES; ++k) { p.ph_lo = k; p.ph_hi = k + 1; hipLaunchKernelGGL(fwd, dim3(grid), dim3(NTH), LDS_BYTES, stream, p); }
#endif
}
```

```cpp
#include <hip/hip_runtime.h>
#include <cstdint>
#include <cstdio>

#define LAS __attribute__((address_space(3)))
typedef unsigned short bf16_t;
typedef float f32x4 __attribute__((ext_vector_type(4)));
typedef unsigned u32x4 __attribute__((ext_vector_type(4)));
typedef unsigned u32x2 __attribute__((ext_vector_type(2)));

constexpr int NB = 8, SEQ = 8192, CTXL = 256, DM = 1024;
constexpr int TL = NB * SEQ, TC = NB * CTXL, TT = TL + TC;
constexpr int EVEN_IN = 3584, ODD_IN = 2480, ODD_PAD = 2560;
constexpr int NTH = 512;
constexpr int LDS_BYTES = 144 * 1024;
constexpr int MAXSLOTS = 151552;
constexpr int MAXTILES = 592;
constexpr float EPS = 1e-6f;

constexpr size_t MiB = 1048576;
constexpr size_t WS_CTRL = 0;
constexpr size_t C_MOE = 16384;
constexpr size_t C_MOD = 65536;
constexpr size_t WS_XC = 1 * MiB;
constexpr size_t WS_WSM = 9 * MiB;
constexpr size_t W_EIN = 0, W_EOUT = 7340032, W_OIN = 9437184, W_OOUT = 14680064, W_WQ = 16777216, W_WKV = 17170432, W_RT = 17694720;
constexpr size_t WS_WMOE = 27 * MiB;
constexpr size_t WS_ACT = 123 * MiB;
constexpr size_t WS_PX = 255 * MiB;
constexpr size_t WS_R2 = 717 * MiB;
constexpr size_t WS_END = 1024 * MiB;
constexpr size_t R2_OF0 = 0, R2_OB0 = 66 * MiB;
constexpr size_t R2_H = 0, R2_STOK = 148 * MiB, R2_SW = 149 * MiB, R2_TOKE = 150 * MiB, R2_TOKW = 151 * MiB, R2_TILEE = 152 * MiB;
constexpr size_t R2_K = 0, R2_V = 99 * MiB, R2_OF1 = 165 * MiB, R2_OB1 = 231 * MiB;
constexpr size_t PX_KVRAW = 346030080;
constexpr size_t WS_GREC = 585 * MiB;
constexpr size_t WS_GOF = 924 * MiB;
constexpr size_t R2_CQN = 170 * MiB;
constexpr size_t R2_MODP = 200 * MiB;

struct Params {
    const float* in[34];
    float* out;
    unsigned char* ws;
    int ph_lo, ph_hi;
};
enum { I_X = 0, I_C, I_CTX, I_CCTX, I_ADAW, I_ADAB, I_NMIX, I_NFFN, I_EWIN, I_EWOUT, I_GNW, I_GWS, I_GBS, I_LB, I_HNW,
       I_OWIN, I_OWOUT, I_CONVW, I_ALOG, I_DTB, I_GDNNW, I_QNW, I_WQ, I_KVNW, I_WKV, I_QKQ, I_QKK, I_RGW, I_RGB, I_REW, I_REB, I_MG, I_MU, I_MD };

__device__ __forceinline__ float bf2f(bf16_t b) { return __uint_as_float(((unsigned)b) << 16); }
__device__ __forceinline__ bf16_t f2bf(float f) { unsigned u = __float_as_uint(f); u += 0x7FFFu + ((u >> 16) & 1u); return (bf16_t)(u >> 16); }
typedef __bf16 bf16_2v __attribute__((ext_vector_type(2)));
typedef float f32_2v __attribute__((ext_vector_type(2)));
__device__ __forceinline__ unsigned pack2(float a, float b) { f32_2v v = {a, b}; bf16_2v r = __builtin_convertvector(v, bf16_2v); return __builtin_bit_cast(unsigned, r); }
__device__ __forceinline__ float lo2f(unsigned u) { return __uint_as_float(u << 16); }
__device__ __forceinline__ float hi2f(unsigned u) { return __uint_as_float(u & 0xffff0000u); }
template <int CTRL> __device__ __forceinline__ float dppf(float x) { return __builtin_bit_cast(float, __builtin_amdgcn_mov_dpp(__builtin_bit_cast(int, x), CTRL, 0xf, 0xf, true)); }
__device__ __forceinline__ float sum8(float v) { v += dppf<0xB1>(v); v += dppf<0x4E>(v); v += dppf<0x141>(v); return v; }
__device__ __forceinline__ float sum16(float v) { v = sum8(v); v += dppf<0x128>(v); return v; }
__device__ __forceinline__ float wave_sum(float v) {
    v = sum16(v);
    auto s = __builtin_amdgcn_permlane16_swap(__float_as_uint(v), __float_as_uint(v), false, false);
    v = __uint_as_float(s[0]) + __uint_as_float(s[1]);
    auto t = __builtin_amdgcn_permlane32_swap(__float_as_uint(v), __float_as_uint(v), false, false);
    return __uint_as_float(t[0]) + __uint_as_float(t[1]);
}
__device__ __forceinline__ unsigned lds_inc(LAS unsigned* p) { return __hip_atomic_fetch_add(p, 1u, __ATOMIC_RELAXED, __HIP_MEMORY_SCOPE_WORKGROUP); }
__device__ __forceinline__ float sigmoid_f(float x) { return 1.f / (1.f + __expf(-x)); }
__device__ __forceinline__ float silu_f(float x) { return x / (1.f + __expf(-x)); }
__device__ __forceinline__ float gelu_tanh_f(float x) {
    const float u = 0.7978845608028654f * (x + 0.044715f * x * x * x);
    const float t = 1.f - 2.f / (__expf(2.f * u) + 1.f);
    return 0.5f * x * (1.f + t);
}
__device__ __forceinline__ float softplus_f(float x) { return x > 20.f ? x : log1pf(__expf(x)); }

#define XB_TMO      128
#define XB_XCNT(j)  (256  + 64 * (j))
#define XB_XSUB(j)  (1280 + 64 * (j))
#define XB_XGEN(j)  (2304 + 64 * (j))
#define XB_TOP      3328
#define XB_TOPGEN   3392
#define XCD_BAR_WORDS 3456
#define XB_SPIN_CAP (1u << 24)
__device__ __forceinline__ unsigned xb_ld(unsigned* p)              { return __hip_atomic_load(p, __ATOMIC_RELAXED, __HIP_MEMORY_SCOPE_AGENT); }
__device__ __forceinline__ unsigned xb_add(unsigned* p, unsigned v) { return __hip_atomic_fetch_add(p, v, __ATOMIC_RELAXED, __HIP_MEMORY_SCOPE_AGENT); }
__device__ __forceinline__ unsigned xb_xcc_id() { return (unsigned)__builtin_amdgcn_s_getreg((3 << 11) | 20) & 0xFu; }
#define XB_SPIN(cond, bar) do { unsigned _sp = 0; while (cond) { __builtin_amdgcn_s_sleep(1); \
    if ((++_sp & 255u) == 0u) { if (xb_ld(&(bar)[XB_TMO])) break; if (_sp > XB_SPIN_CAP) { atomicAdd(&(bar)[XB_TMO], 1u); break; } } } } while (0)
struct XcdBarrier { unsigned* bar; unsigned x; volatile LAS unsigned* st; };
__device__ __forceinline__ XcdBarrier xcd_barrier_post(unsigned* bar, volatile LAS unsigned* st) {
    XcdBarrier b; b.bar = bar; b.x = xb_xcc_id(); b.st = st;
    if (threadIdx.x == 0) (void)xb_add(&bar[XB_XCNT(b.x)], 1u);
    return b;
}
__device__ __forceinline__ void xcd_barrier_complete(unsigned* bar, unsigned x, unsigned& nloc, unsigned& nx) {
    const unsigned G = gridDim.x * gridDim.y * gridDim.z;
    unsigned sum, cnt, mine, sp = 0u;
    for (;;) {
        sum = 0u; cnt = 0u; mine = 0u;
#pragma unroll
        for (unsigned j = 0; j < 16; ++j) { const unsigned c = xb_ld(&bar[XB_XCNT(j)]); sum += c; cnt += (c > 0u) ? 1u : 0u; mine = (j == x) ? c : mine; }
        if (sum == G) break;
        __builtin_amdgcn_s_sleep(1);
        if ((++sp & 255u) == 0u) { if (xb_ld(&bar[XB_TMO])) break; if (sp > XB_SPIN_CAP) { atomicAdd(&bar[XB_TMO], 1u); break; } }
    }
    nloc = mine > 0u ? mine : 1u; nx = cnt > 0u ? cnt : 1u;
}
__device__ __forceinline__ void xcd_barrier(const XcdBarrier& b) {
    asm volatile("s_waitcnt vmcnt(0)" ::: "memory");
    __syncthreads();
    if (threadIdx.x == 0) {
        unsigned* bar = b.bar;
        __builtin_amdgcn_s_waitcnt(0);
        unsigned nloc = b.st[0], nx = b.st[1];
        if (nloc == 0u) { xcd_barrier_complete(bar, b.x, nloc, nx); b.st[0] = nloc; b.st[1] = nx; }
        const unsigned old = xb_add(&bar[XB_XSUB(b.x)], 1u);
        const unsigned gen = old / nloc;
        if (old + 1u == (gen + 1u) * nloc) {
            __builtin_amdgcn_fence(__ATOMIC_RELEASE, "agent");
            asm volatile("s_waitcnt vmcnt(0)" ::: "memory");
            const unsigned og = xb_add(&bar[XB_TOP], 1u);
            const unsigned tg = og / nx;
            if (og + 1u == (tg + 1u) * nx) xb_add(&bar[XB_TOPGEN], 1u);
            else XB_SPIN(xb_ld(&bar[XB_TOPGEN]) == tg, bar);
            __builtin_amdgcn_fence(__ATOMIC_ACQUIRE, "agent");
            xb_add(&bar[XB_XGEN(b.x)], 1u);
            asm volatile("s_waitcnt vmcnt(0)" ::: "memory");
        } else {
            XB_SPIN(xb_ld(&bar[XB_XGEN(b.x)]) == gen, bar);
            __builtin_amdgcn_fence(__ATOMIC_ACQUIRE, "agent");
            asm volatile("s_waitcnt vmcnt(0)" ::: "memory");
        }
    }
    __syncthreads();
}

struct Frame {
    const Params* P;
    unsigned char* ws;
    LAS unsigned char* lds;
    int tid, lane, wave, G, bid;
    float* mod;
    unsigned* ctrl;
};
__device__ __forceinline__ const float* modp(const Frame& F, int layer, int b, int which) { return F.mod + ((size_t)(layer * 9 + b) * 6 + which) * 1024; }

__device__ __forceinline__ void conv_tile(const Frame& F, const float* src, int K, int N, int lds_, bf16_t* dst, int ldd, int kt, int nt, int rm_mode) {
    LAS float* tile = (LAS float*)F.lds;
    const int t = F.tid;
    {
        const int c = t & 63, r0 = t >> 6;
#pragma unroll
        for (int i = 0; i < 8; ++i) { const int rr = r0 + i * 8, k = kt * 64 + rr, n = nt * 64 + c;
            tile[rr * 65 + c] = (k < K && n < N) ? src[(size_t)k * lds_ + n] : 0.f; }
    }
    __syncthreads();
    {
        const int nl = t >> 3, kc = (t & 7) * 8, n = nt * 64 + nl;
        int row = n;
        if (rm_mode == 1) row = (n >> 7) * 256 + (n & 127);
        else if (rm_mode == 2) row = (n >> 7) * 256 + 128 + (n & 127);
        float v[8];
#pragma unroll
        for (int j = 0; j < 8; ++j) v[j] = tile[(kc + j) * 65 + nl];
        u32x4 w; w.x = pack2(v[0], v[1]); w.y = pack2(v[2], v[3]); w.z = pack2(v[4], v[5]); w.w = pack2(v[6], v[7]);
        *(u32x4*)(dst + (size_t)row * ldd + kt * 64 + kc) = w;
    }
    __syncthreads();
}
__device__ __forceinline__ void conv_moe_weights(const Frame& F, int layer, int item0, int stride) {
    const Params& P = *F.P;
    bf16_t* W1 = (bf16_t*)(F.ws + WS_WMOE); bf16_t* W2 = W1 + (size_t)32 * 1024 * 1024;
    for (int it = item0; it < 12288; it += stride) {
        if (it < 8192) {
            const int up = it >= 4096, j = it & 4095, e = j >> 7, r = j & 127, kt = r >> 3, nt = r & 7;
            const float* src = P.in[up ? I_MU : I_MG] + ((size_t)(layer * 32 + e)) * 1024 * 512;
            conv_tile(F, src, 1024, 512, 512, W1 + (size_t)e * 1024 * 1024, 1024, kt, nt, up ? 2 : 1);
        } else {
            const int j = it - 8192, e = j >> 7, r = j & 127, kt = r >> 4, nt = r & 15;
            const float* src = P.in[I_MD] + ((size_t)(layer * 32 + e)) * 512 * 1024;
            conv_tile(F, src, 512, 1024, 1024, W2 + (size_t)e * 1024 * 512, 512, kt, nt, 0);
        }
    }
}
__device__ __forceinline__ void mod_reduce(const Frame& F) {
    const float* mp = (const float*)(F.ws + WS_R2 + R2_MODP);
    for (int i = F.bid * NTH + F.tid; i < 18 * 6144; i += F.G * NTH) { float a = F.P->in[I_ADAB][(i / (9 * 6144)) * 6144 + (i % 6144)];
#pragma unroll
        for (int kp = 0; kp < 8; ++kp) a += mp[(size_t)kp * 18 * 6144 + i];
        F.mod[i] = a; }
}
__device__ __forceinline__ void ph_prologue(const Frame& F) {
    const Params& P = *F.P;
    float* modp_ = (float*)(F.ws + WS_R2 + R2_MODP);
    for (int it = F.bid; it < 192; it += F.G) {
        const int l = it / 96, r = it % 96, cb = r >> 3, kp = r & 7;
        LAS float* sc = (LAS float*)F.lds;
        for (int i = F.tid; i < 9 * 128; i += NTH) { const int rr = i >> 7, k = kp * 128 + (i & 127);
            const float cv = rr < 8 ? P.in[I_C][rr * 1024 + k] : P.in[I_CCTX][k]; sc[i] = silu_f(cv); }
        __syncthreads();
        const int n = cb * 512 + F.tid;
        float acc[9];
#pragma unroll
        for (int rr = 0; rr < 9; ++rr) acc[rr] = 0.f;
        const float* w = P.in[I_ADAW] + ((size_t)l * 1024 + kp * 128) * 6144 + n;
#pragma unroll 8
        for (int k = 0; k < 128; ++k) { const float wv = w[(size_t)k * 6144];
#pragma unroll
            for (int rr = 0; rr < 9; ++rr) acc[rr] += sc[rr * 128 + k] * wv; }
#pragma unroll
        for (int rr = 0; rr < 9; ++rr) modp_[((size_t)kp * 18 + l * 9 + rr) * 6144 + n] = acc[rr];
        __syncthreads();
    }
    bf16_t* wsm = (bf16_t*)(F.ws + WS_WSM);
    for (int it = F.bid; it < 2160; it += F.G) {
        int j = it;
        if (j < 896) { conv_tile(F, P.in[I_EWIN], 1024, 3584, 3584, wsm + W_EIN / 2, 1024, j / 56, j % 56, 0); continue; } j -= 896;
        if (j < 256) { conv_tile(F, P.in[I_EWOUT], 1024, 1024, 1024, wsm + W_EOUT / 2, 1024, j >> 4, j & 15, 0); continue; } j -= 256;
        if (j < 640) { conv_tile(F, P.in[I_OWIN], 1024, 2480, 2480, wsm + W_OIN / 2, 1024, j / 40, j % 40, 0); continue; } j -= 640;
        if (j < 256) { conv_tile(F, P.in[I_OWOUT], 1024, 1024, 1024, wsm + W_OOUT / 2, 1024, j >> 4, j & 15, 0); continue; } j -= 256;
        if (j < 48) { conv_tile(F, P.in[I_WQ], 256, 768, 768, wsm + W_WQ / 2, 256, j / 12, j % 12, 0); continue; } j -= 48;
        conv_tile(F, P.in[I_WKV], 128, 1024, 1024, wsm + W_WKV / 2, 256, j >> 4, j & 15, 0);
    }
    for (int i = F.bid * NTH + F.tid; i < 2 * 48 * 1024; i += F.G * NTH) { const int l = i / (48 * 1024), r = i % (48 * 1024), n = r >> 10, k = r & 1023;
        float w = 0.f; if (n < 4) w = P.in[I_RGW][((size_t)l * 1024 + k) * 4 + n]; else if (n < 36) w = P.in[I_REW][((size_t)l * 1024 + k) * 32 + (n - 4)];
        const bf16_t h = f2bf(w); wsm[W_RT / 2 + (size_t)l * 2 * 48 * 1024 + r] = h; wsm[W_RT / 2 + (size_t)l * 2 * 48 * 1024 + 48 * 1024 + r] = f2bf(w - bf2f(h)); }
    conv_moe_weights(F, 0, F.bid, F.G);
}

__device__ __forceinline__ void ph_rownorm(const Frame& F, int layer, int nrows, const float* xlat, const float* xctx, const float* nw, int si) {
    bf16_t* dst = (bf16_t*)(F.ws + WS_ACT);
    for (int r = F.bid * 8 + F.wave; r < nrows; r += F.G * 8) {
        const float* src = r < TL ? xlat + (size_t)r * 1024 : xctx + (size_t)(r - TL) * 1024;
        const int b = r < TL ? (r >> 13) : 8;
        const float* sh = modp(F, layer, b, si); const float* sc = modp(F, layer, b, si + 1);
        f32x4 v[4]; float ss = 0.f;
#pragma unroll
        for (int j = 0; j < 4; ++j) { v[j] = *(const f32x4*)(src + j * 256 + F.lane * 4); ss += v[j][0] * v[j][0] + v[j][1] * v[j][1] + v[j][2] * v[j][2] + v[j][3] * v[j][3]; }
        ss = wave_sum(ss);
        const float rstd = rsqrtf(ss * (1.f / 1024.f) + EPS);
#pragma unroll
        for (int j = 0; j < 4; ++j) { const int c = j * 256 + F.lane * 4;
            const f32x4 w = *(const f32x4*)(nw + c), s1 = *(const f32x4*)(sc + c), s0 = *(const f32x4*)(sh + c);
            v[j] = (v[j] * rstd * w) * (1.f + s1) + s0;
            u32x2 o; o.x = pack2(v[j][0], v[j][1]); o.y = pack2(v[j][2], v[j][3]);
            *(u32x2*)(dst + (size_t)r * 1024 + c) = o; }
    }
}
typedef short s16x8r __attribute__((ext_vector_type(8)));
__device__ __forceinline__ void ph_router(const Frame& F, int layer, int nrows, const float* xlat, const float* xctx, const float* nw, int si) {
    const Params& P = *F.P;
    bf16_t* dst = (bf16_t*)(F.ws + WS_ACT);
    LAS unsigned* hist = (LAS unsigned*)F.lds;
    LAS float* lg = (LAS float*)(F.lds + 256) + F.wave * (16 * 48);
    int* tok_e = (int*)(F.ws + WS_R2 + R2_TOKE); float* tok_w = (float*)(F.ws + WS_R2 + R2_TOKW);
    if (F.tid < 64) hist[F.tid] = 0u;
    __syncthreads();
    { int* stok = (int*)(F.ws + WS_R2 + R2_STOK);
      for (int i = F.bid * NTH + F.tid; i < MAXSLOTS; i += F.G * NTH) stok[i] = -1; }
    const bf16_t* Wh = (const bf16_t*)(F.ws + WS_WSM) + W_RT / 2 + (size_t)layer * 2 * 48 * 1024; const bf16_t* Wl = Wh + 48 * 1024;
    const int lr = F.lane & 15, kq = F.lane >> 4;
    const float* rgb = P.in[I_RGB] + layer * 4; const float* reb = P.in[I_REB] + layer * 32;
    for (int g = F.bid * 8 + F.wave; g < nrows / 16; g += F.G * 8) {
        const int r0 = g * 16;
        const float* src0 = r0 < TL ? xlat + (size_t)r0 * 1024 : xctx + (size_t)(r0 - TL) * 1024;
        const int b = r0 < TL ? (r0 >> 13) : 8;
        const float* sh = modp(F, layer, b, si); const float* sc = modp(F, layer, b, si + 1);
        float myrstd = 0.f;
#pragma unroll 4
        for (int rr = 0; rr < 16; ++rr) { const float* src = src0 + (size_t)rr * 1024; float ss = 0.f;
#pragma unroll
            for (int j = 0; j < 4; ++j) { const f32x4 v = *(const f32x4*)(src + j * 256 + F.lane * 4); ss += v[0] * v[0] + v[1] * v[1] + v[2] * v[2] + v[3] * v[3]; }
            ss = wave_sum(ss);
            const float rs = rsqrtf(ss * (1.f / 1024.f) + EPS); myrstd = (lr == rr) ? rs : myrstd; }
        f32x4 acc[3];
#pragma unroll
        for (int nb = 0; nb < 3; ++nb) acc[nb] = (f32x4){0.f, 0.f, 0.f, 0.f};
        const float* xr = src0 + (size_t)lr * 1024 + kq * 8;
        bf16_t* dr = dst + (size_t)(r0 + lr) * 1024 + kq * 8;
#pragma unroll 2
        for (int ks = 0; ks < 32; ++ks) { const int c = ks * 32 + kq * 8;
            const f32x4 x0 = *(const f32x4*)(xr + ks * 32), x1 = *(const f32x4*)(xr + ks * 32 + 4);
            const f32x4 w0 = *(const f32x4*)(nw + c), w1 = *(const f32x4*)(nw + c + 4), a0 = *(const f32x4*)(sc + c), a1 = *(const f32x4*)(sc + c + 4), b0 = *(const f32x4*)(sh + c), b1 = *(const f32x4*)(sh + c + 4);
            const f32x4 h0 = (x0 * myrstd * w0) * (1.f + a0) + b0, h1 = (x1 * myrstd * w1) * (1.f + a1) + b1;
            u32x4 hi; hi.x = pack2(h0[0], h0[1]); hi.y = pack2(h0[2], h0[3]); hi.z = pack2(h1[0], h1[1]); hi.w = pack2(h1[2], h1[3]);
            *(u32x4*)(dr + ks * 32) = hi;
            u32x4 lo; lo.x = pack2(h0[0] - lo2f(hi.x), h0[1] - hi2f(hi.x)); lo.y = pack2(h0[2] - lo2f(hi.y), h0[3] - hi2f(hi.y));
            lo.z = pack2(h1[0] - lo2f(hi.z), h1[1] - hi2f(hi.z)); lo.w = pack2(h1[2] - lo2f(hi.w), h1[3] - hi2f(hi.w));
            const s16x8r ah = __builtin_bit_cast(s16x8r, hi), al = __builtin_bit_cast(s16x8r, lo);
#pragma unroll
            for (int nb = 0; nb < 3; ++nb) { const s16x8r bh = *(const s16x8r*)(Wh + (size_t)(nb * 16 + lr) * 1024 + c), bl = *(const s16x8r*)(Wl + (size_t)(nb * 16 + lr) * 1024 + c);
                acc[nb] = __builtin_amdgcn_mfma_f32_16x16x32_bf16(ah, bh, acc[nb], 0, 0, 0);
                acc[nb] = __builtin_amdgcn_mfma_f32_16x16x32_bf16(al, bh, acc[nb], 0, 0, 0);
                acc[nb] = __builtin_amdgcn_mfma_f32_16x16x32_bf16(ah, bl, acc[nb], 0, 0, 0); } }
#pragma unroll
        for (int nb = 0; nb < 3; ++nb)
#pragma unroll
            for (int rg = 0; rg < 4; ++rg) lg[(4 * kq + rg) * 48 + nb * 16 + lr] = acc[nb][rg];
        asm volatile("s_waitcnt lgkmcnt(0)" ::: "memory");
        __builtin_amdgcn_wave_barrier();
        if (F.lane < 16) {
            const LAS float* L = lg + F.lane * 48;
            float lgv[4];
#pragma unroll
            for (int i = 0; i < 4; ++i) lgv[i] = L[i] + rgb[i];
            int gi = 0; float best = lgv[0];
#pragma unroll
            for (int i = 1; i < 4; ++i) if (lgv[i] > best) { best = lgv[i]; gi = i; }
            float den = 0.f;
#pragma unroll
            for (int i = 0; i < 4; ++i) den += __expf(lgv[i] - best);
            const float pg = 1.f / den;
            float le[8];
#pragma unroll
            for (int i = 0; i < 8; ++i) le[i] = L[4 + gi * 8 + i] + reb[gi * 8 + i];
            int i1 = 0; float b1 = le[0];
#pragma unroll
            for (int i = 1; i < 8; ++i) if (le[i] > b1) { b1 = le[i]; i1 = i; }
            int i2 = -1; float b2 = -3.0e38f;
#pragma unroll
            for (int i = 0; i < 8; ++i) if (i != i1 && le[i] > b2) { b2 = le[i]; i2 = i; }
            const float e2 = __expf(b2 - b1);
            const float w1 = pg / (1.f + e2), w2 = pg * e2 / (1.f + e2);
            const int e0g = gi * 8 + i1, e1g = gi * 8 + i2; const int r = r0 + F.lane;
            tok_e[r] = e0g | (e1g << 8); tok_w[2 * r] = w1; tok_w[2 * r + 1] = w2;
            lds_inc(&hist[e0g]); lds_inc(&hist[32 + e1g]);
        }
        __builtin_amdgcn_wave_barrier();
    }
    __syncthreads();
    unsigned* cnt = (unsigned*)(F.ws + WS_CTRL + C_MOE + layer * 1024);
    if (F.tid < 64 && hist[F.tid]) atomicAdd(&cnt[F.tid], hist[F.tid]);
    __syncthreads();
}

__device__ __forceinline__ void ph_dispatch(const Frame& F, int layer, int ntok) {
    unsigned* cnt = (unsigned*)(F.ws + WS_CTRL + C_MOE + layer * 1024); unsigned* cursor = cnt + 64; unsigned* info = cnt + 128;
    LAS unsigned* base = (LAS unsigned*)F.lds; LAS unsigned* lh = base + 64; LAS unsigned* gb = base + 128; LAS unsigned* lh2 = base + 192; LAS unsigned* pad = base + 256;
    const int* tok_e = (const int*)(F.ws + WS_R2 + R2_TOKE); const float* tok_w = (const float*)(F.ws + WS_R2 + R2_TOKW);
    int* stok = (int*)(F.ws + WS_R2 + R2_STOK); float* sw = (float*)(F.ws + WS_R2 + R2_SW); int* tile_e = (int*)(F.ws + WS_R2 + R2_TILEE);
    if (F.tid < 64) { pad[F.tid] = (__hip_atomic_load(&cnt[F.tid], __ATOMIC_RELAXED, __HIP_MEMORY_SCOPE_AGENT) + 255u) & ~255u; lh[F.tid] = 0u; lh2[F.tid] = 0u; }
    __syncthreads();
    if (F.tid == 0) { unsigned a = 0; for (int i = 0; i < 64; ++i) { base[i] = a; a += pad[i]; } base[320] = a; }
    __syncthreads();
    if (F.bid == 0) {
        for (int i = F.tid; i < MAXTILES; i += NTH) { const unsigned s = (unsigned)i * 256u; int l = -1;
            for (int j = 0; j < 64; ++j) if (s >= base[j] && s < base[j] + pad[j]) l = j;
            tile_e[i] = l; }
        if (F.tid == 0) { info[0] = base[32] / 256u; info[1] = base[320] / 256u; }
    }
    const int per = (ntok + F.G - 1) / F.G, t0 = F.bid * per, t1 = min(ntok, t0 + per);
    for (int t = t0 + F.tid; t < t1; t += NTH) { const int e = tok_e[t]; lds_inc(&lh[e & 255]); lds_inc(&lh[32 + (e >> 8)]); }
    __syncthreads();
    if (F.tid < 64) gb[F.tid] = lh[F.tid] ? __hip_atomic_fetch_add(&cursor[F.tid], lh[F.tid], __ATOMIC_RELAXED, __HIP_MEMORY_SCOPE_AGENT) : 0u;
    __syncthreads();
    for (int t = t0 + F.tid; t < t1; t += NTH) { const int e = tok_e[t];
        const int l0 = e & 255, l1 = 32 + (e >> 8);
        const unsigned p0 = base[l0] + gb[l0] + lds_inc(&lh2[l0]), p1 = base[l1] + gb[l1] + lds_inc(&lh2[l1]);
        stok[p0] = t; sw[p0] = tok_w[2 * t]; stok[p1] = t; sw[p1] = tok_w[2 * t + 1]; }
    __syncthreads();
}

template <class AF, class EP>
__device__ __forceinline__ void gemm_unit_naive(const Frame& F, int K, const AF& arow, const bf16_t* Bt, const EP& E, int pm, int pn) {
    LAS float* As = (LAS float*)F.lds;
    LAS float* Bs = As + 32 * 132;
    const int t = F.tid, ty = t >> 5, tx = t & 31;
    for (int half = 0; half < 2; ++half) {
        float acc[8][8];
#pragma unroll
        for (int i = 0; i < 8; ++i)
#pragma unroll
            for (int j = 0; j < 8; ++j) acc[i][j] = 0.f;
        const bf16_t* ap = arow(half * 128 + (t >> 2));
        const bf16_t* bp = Bt + (size_t)(t >> 1) * K;
        for (int k0 = 0; k0 < K; k0 += 32) {
            { const int r = t >> 2, kq = (t & 3) * 8; u32x4 w = {0u, 0u, 0u, 0u}; if (ap) w = *(const u32x4*)(ap + k0 + kq);
              As[(kq + 0) * 132 + r] = lo2f(w.x); As[(kq + 1) * 132 + r] = hi2f(w.x); As[(kq + 2) * 132 + r] = lo2f(w.y); As[(kq + 3) * 132 + r] = hi2f(w.y);
              As[(kq + 4) * 132 + r] = lo2f(w.z); As[(kq + 5) * 132 + r] = hi2f(w.z); As[(kq + 6) * 132 + r] = lo2f(w.w); As[(kq + 7) * 132 + r] = hi2f(w.w); }
            { const int n = t >> 1, kh = (t & 1) * 16;
#pragma unroll
              for (int q = 0; q < 2; ++q) { const u32x4 w = *(const u32x4*)(bp + k0 + kh + q * 8); const int kk = kh + q * 8;
                Bs[(kk + 0) * 260 + n] = lo2f(w.x); Bs[(kk + 1) * 260 + n] = hi2f(w.x); Bs[(kk + 2) * 260 + n] = lo2f(w.y); Bs[(kk + 3) * 260 + n] = hi2f(w.y);
                Bs[(kk + 4) * 260 + n] = lo2f(w.z); Bs[(kk + 5) * 260 + n] = hi2f(w.z); Bs[(kk + 6) * 260 + n] = lo2f(w.w); Bs[(kk + 7) * 260 + n] = hi2f(w.w); } }
            __syncthreads();
#pragma unroll 4
            for (int k = 0; k < 32; ++k) {
                const f32x4 a0 = *(const LAS f32x4*)(As + k * 132 + ty * 8), a1 = *(const LAS f32x4*)(As + k * 132 + ty * 8 + 4);
                const f32x4 b0 = *(const LAS f32x4*)(Bs + k * 260 + tx * 4), b1 = *(const LAS f32x4*)(Bs + k * 260 + 128 + tx * 4);
#pragma unroll
                for (int i = 0; i < 8; ++i) { const float a = i < 4 ? a0[i & 3] : a1[i & 3];
#pragma unroll
                    for (int j = 0; j < 4; ++j) { acc[i][j] += a * b0[j]; acc[i][4 + j] += a * b1[j]; } }
            }
            __syncthreads();
        }
#pragma unroll
        for (int i = 0; i < 8; ++i) { const f32x4 v0 = {acc[i][0], acc[i][1], acc[i][2], acc[i][3]}, v1 = {acc[i][4], acc[i][5], acc[i][6], acc[i][7]};
            E(pm * 256 + half * 128 + ty * 8 + i, pn, tx * 4, v0, v1); }
    }
}
struct ARowDense { const bf16_t* A; int K; int pm; __device__ __forceinline__ const bf16_t* operator()(int r) const { return A + (size_t)(pm * 256 + r) * K; } };
struct ARowGather { const bf16_t* A; const int* stok; int pm; __device__ __forceinline__ const bf16_t* operator()(int r) const { const int t = stok[pm * 256 + r]; return t < 0 ? nullptr : A + (size_t)t * 1024; } };

template <class EP>
__device__ __forceinline__ void gemm_dense_naive(const Frame& F, const bf16_t* A, const bf16_t* Bt, int M, int N, int K, const EP& E) {
    const int nM = M / 256, nN = N / 256;
    for (int u = F.bid; u < nM * nN; u += F.G) { const int pm = u / nN, pn = u % nN;
        ARowDense ar{A, K, pm}; gemm_unit_naive(F, K, ar, Bt + (size_t)pn * 256 * K, E, pm, pn); }
}

namespace pg8 {
typedef short bf16x8 __attribute__((ext_vector_type(8)));
constexpr int BM = 256, BK = 64, HALF = 128, HTB = HALF * BK * 2, STAGE_BYTES = 8 * HTB, NXCD = 8, WGM = 8;
__device__ __forceinline__ int lds_byte(int r, int c) { const int st = (r >> 4) * 2 + (c >> 5), rr = r & 15, cc = c & 31, ob = rr * 64 + cc * 2; return st * 1024 + (ob ^ (((ob >> 9) & 1) << 5)); }
__device__ __forceinline__ void stage_rc(int b, int& R, int& C) { const int st = b / 1024, sb = b % 1024, swz = sb ^ (((sb >> 9) & 1) << 5); R = (st >> 1) * 16 + swz / 64; C = (st & 1) * 32 + (swz % 64) / 2; }
struct Unit { int pm, pn; };
struct ProbDense {
    const char* A; const char* Bt; int K, nM, nN, nwg, G, c;
    __device__ __forceinline__ void init(const bf16_t* A_, const bf16_t* Bt_, int M, int N, int K_, int G_, int c_) { A = (const char*)A_; Bt = (const char*)Bt_; K = K_; nM = M / BM; nN = N / BM; nwg = nM * nN; G = G_; c = c_; }
    __device__ __forceinline__ bool next(int i, Unit& u) const {
        const long L = (long)i * G + c; if (L >= nwg) return false;
        int wgid = (int)L; { const int q = nwg / NXCD, r = nwg % NXCD, xcd = wgid % NXCD, off = wgid / NXCD; wgid = (xcd < r ? xcd * (q + 1) : r * (q + 1) + (xcd - r) * q) + off; }
        const int nig = WGM * nN, gid = wgid / nig, fm = gid * WGM, gsz = (nM - fm) < WGM ? (nM - fm) : WGM;
        u.pm = fm + ((wgid % nig) % gsz); u.pn = (wgid % nig) / gsz; return true;
    }
    __device__ __forceinline__ const char* bptr(const Unit& u) const { return Bt + (size_t)u.pn * 256 * K * 2; }
    __device__ __forceinline__ unsigned aoff(const Unit& u, int r) const { return (unsigned)(u.pm * 256 + r) * (unsigned)(K * 2); }
};
struct ProbMoe1 {
    const char* A; const int* stok; const int* tile_e; const char* W; int K, ntiles, G, c;
    __device__ __forceinline__ bool next(int i, Unit& u) const { const int L = i * G + c; if (L >= ntiles * 4) return false; u.pm = L >> 2; u.pn = L & 3; return true; }
    __device__ __forceinline__ const char* bptr(const Unit& u) const { return W + ((size_t)(tile_e[u.pm] & 31) * 1024 + u.pn * 256) * 2048; }
    __device__ __forceinline__ unsigned aoff(const Unit& u, int r) const { const int t = stok[u.pm * 256 + r]; return t < 0 ? 0u : (unsigned)t * 2048u; }
};
struct ProbMoe2 {
    const char* A; const int* tile_e; const char* W; int K, tlo, thi, G, c;
    __device__ __forceinline__ bool next(int i, Unit& u) const { const int L = i * G + c; if (L >= (thi - tlo) * 4) return false; u.pm = tlo + (L >> 2); u.pn = L & 3; return true; }
    __device__ __forceinline__ const char* bptr(const Unit& u) const { return W + ((size_t)(tile_e[u.pm] & 31) * 1024 + u.pn * 256) * 1024; }
    __device__ __forceinline__ unsigned aoff(const Unit& u, int r) const { return (unsigned)(u.pm * 256 + r) * 1024u; }
};

template <class Prob, class Epi>
__device__ __forceinline__ void gemm_phase(LAS unsigned char* lds, const Prob& S, const Epi& E) {
    const int tid = threadIdx.x, wid = __builtin_amdgcn_readfirstlane(tid >> 6), lane = tid & 63, wr = wid >> 2, wc = wid & 3, fr = lane & 15, fq = lane >> 4;
    const int K = S.K, nt = K / BK;
    int RA[2]; unsigned cb2[2], voffB[2];
#pragma unroll
    for (int i = 0; i < 2; ++i) { int R, C; stage_rc(tid * 16 + i * 8192, R, C); RA[i] = R; cb2[i] = (unsigned)C * 2u; voffB[i] = (unsigned)(R * K + C) * 2u; }
    const size_t kstep = (size_t)(BK * 2);
    const size_t hstepB = (size_t)HALF * K * 2;
    const unsigned ldsw = (unsigned)wid * 1024u;
    const int aoff = lds_byte(wr * 64 + fr, fq * 8), boff = lds_byte(wc * 32 + fr, fq * 8);
#define PG8_SA(b, h) (((b) * 2 + (h)) * HTB)
#define PG8_SB(b, h) ((4 + (b) * 2 + (h)) * HTB)
#define PG8_STAGE(bufoff, gbase, voff) do { _Pragma("unroll") for (int _i = 0; _i < 2; ++_i) \
        __builtin_amdgcn_global_load_lds((const unsigned*)((const char*)(gbase) + (voff)[_i]), (LAS unsigned*)(lds + (bufoff) + ldsw + _i * 8192), 16, 0, 0); } while (0)
#define PG8_LDA(dst, b, h) do { _Pragma("unroll") for (int m = 0; m < 4; ++m) _Pragma("unroll") for (int k = 0; k < 2; ++k) dst[m][k] = *(const LAS bf16x8*)(lds + PG8_SA(b, h) + aoff + m * 2048 + k * 1024); } while (0)
#define PG8_LDB(dst, b, h) do { _Pragma("unroll") for (int n = 0; n < 2; ++n) _Pragma("unroll") for (int k = 0; k < 2; ++k) dst[n][k] = *(const LAS bf16x8*)(lds + PG8_SB(b, h) + boff + n * 2048 + k * 1024); } while (0)
#define PG8_MMA(ai, bj, At, Bt) do { __builtin_amdgcn_s_setprio(1); _Pragma("unroll") for (int m = 0; m < 4; ++m) _Pragma("unroll") for (int n = 0; n < 2; ++n) _Pragma("unroll") for (int k = 0; k < 2; ++k) \
        acc[ai][bj][m][n] = __builtin_amdgcn_mfma_f32_16x16x32_bf16(Bt[n][k], At[m][k], acc[ai][bj][m][n], 0, 0, 0); __builtin_amdgcn_s_setprio(0); } while (0)
#define PG8_WAIT_V(n) asm volatile("s_waitcnt vmcnt(" #n ")" ::: "memory")
#define PG8_WAIT_L(n) asm volatile("s_waitcnt lgkmcnt(" #n ")" ::: "memory")
#define PG8_BAR __builtin_amdgcn_s_barrier()
#define PG8_SCHED __builtin_amdgcn_sched_barrier(0)
    Unit cur, nxt; int ui = 0;
    if (!S.next(0, cur)) return;
    f32x4 acc[2][2][4][2];
#pragma unroll
    for (int a = 0; a < 2; ++a)
#pragma unroll
        for (int b = 0; b < 2; ++b)
#pragma unroll
            for (int m = 0; m < 4; ++m)
#pragma unroll
                for (int n = 0; n < 2; ++n) acc[a][b][m][n] = (f32x4){0.f, 0.f, 0.f, 0.f};
    bf16x8 At[4][2], B0[2][2], B1[2][2];
    unsigned oc0[2], oc1[2], on0[2], on1[2];
#pragma unroll
    for (int i = 0; i < 2; ++i) { oc0[i] = S.aoff(cur, RA[i]) + cb2[i]; oc1[i] = S.aoff(cur, 128 + RA[i]) + cb2[i]; }
    const char* cB = S.bptr(cur);
    const char* const Ab = S.A;
    PG8_STAGE(PG8_SB(0, 0), cB, voffB); PG8_STAGE(PG8_SA(0, 0), Ab, oc0); PG8_STAGE(PG8_SB(0, 1), cB + hstepB, voffB); PG8_STAGE(PG8_SA(0, 1), Ab, oc1);
    if (wr == 1) PG8_BAR;
    PG8_WAIT_V(4); PG8_BAR;
    PG8_STAGE(PG8_SB(1, 0), cB + kstep, voffB); PG8_STAGE(PG8_SA(1, 0), Ab + kstep, oc0); PG8_STAGE(PG8_SB(1, 1), cB + hstepB + kstep, voffB);
    PG8_WAIT_V(6); PG8_BAR;
    for (;;) {
        const bool has_next = S.next(ui + 1, nxt);
        const char* nB = has_next ? S.bptr(nxt) : cB;
#pragma unroll
        for (int i = 0; i < 2; ++i) { on0[i] = has_next ? S.aoff(nxt, RA[i]) + cb2[i] : oc0[i]; on1[i] = has_next ? S.aoff(nxt, 128 + RA[i]) + cb2[i] : oc1[i]; }
        for (int t = 0; t < nt; t += 2) {
            const bool last = (t == nt - 2);
            const char* a1 = Ab + (size_t)(t + 1) * kstep;
            const char* a2 = last ? Ab : Ab + (size_t)(t + 2) * kstep; const char* b2 = last ? nB : cB + (size_t)(t + 2) * kstep;
            const char* a3 = a2 + kstep; const char* b3 = b2 + kstep;
            unsigned o20[2], o21[2];
#pragma unroll
            for (int i = 0; i < 2; ++i) { o20[i] = last ? on0[i] : oc0[i]; o21[i] = last ? on1[i] : oc1[i]; }
            PG8_LDB(B0, 0, 0); PG8_SCHED; PG8_LDA(At, 0, 0); PG8_STAGE(PG8_SA(1, 1), a1, oc1);
            PG8_WAIT_L(8); PG8_BAR; PG8_WAIT_L(0); PG8_MMA(0, 0, At, B0); PG8_BAR; PG8_SCHED;
            PG8_LDB(B1, 0, 1); PG8_STAGE(PG8_SB(0, 0), b2, voffB);
            PG8_BAR; PG8_WAIT_L(0); PG8_MMA(0, 1, At, B1); PG8_BAR;
            PG8_LDA(At, 0, 1); PG8_STAGE(PG8_SA(0, 0), a2, o20);
            PG8_BAR; PG8_WAIT_L(0); PG8_MMA(1, 0, At, B0); PG8_BAR; PG8_SCHED;
            PG8_STAGE(PG8_SB(0, 1), b2 + hstepB, voffB);
            PG8_WAIT_V(6); PG8_BAR; PG8_MMA(1, 1, At, B1); PG8_BAR;
            PG8_LDB(B0, 1, 0); PG8_SCHED; PG8_LDA(At, 1, 0); PG8_STAGE(PG8_SA(0, 1), a2, o21);
            PG8_WAIT_L(8); PG8_BAR; PG8_WAIT_L(0); PG8_MMA(0, 0, At, B0); PG8_BAR; PG8_SCHED;
            PG8_LDB(B1, 1, 1); PG8_STAGE(PG8_SB(1, 0), b3, voffB);
            PG8_BAR; PG8_WAIT_L(0); PG8_MMA(0, 1, At, B1); PG8_BAR;
            PG8_LDA(At, 1, 1); PG8_STAGE(PG8_SA(1, 0), a3, o20);
            PG8_BAR; PG8_WAIT_L(0); PG8_MMA(1, 0, At, B0); PG8_BAR; PG8_SCHED;
            PG8_STAGE(PG8_SB(1, 1), b3 + hstepB, voffB);
            PG8_WAIT_V(6); PG8_BAR; PG8_MMA(1, 1, At, B1); PG8_BAR;
        }
#pragma unroll
        for (int ai = 0; ai < 2; ++ai)
#pragma unroll
            for (int m = 0; m < 4; ++m)
#pragma unroll
                for (int n = 0; n < 2; ++n) E(cur.pm * BM + ai * HALF + wr * 64 + m * 16 + fr, cur.pn, wc * 32 + n * 16 + fq * 4, acc[ai][0][m][n], acc[ai][1][m][n]);
        if (!has_next) break;
#pragma unroll
        for (int a = 0; a < 2; ++a)
#pragma unroll
            for (int b = 0; b < 2; ++b)
#pragma unroll
                for (int m = 0; m < 4; ++m)
#pragma unroll
                    for (int n = 0; n < 2; ++n) acc[a][b][m][n] = (f32x4){0.f, 0.f, 0.f, 0.f};
        cur = nxt; cB = nB; ++ui;
#pragma unroll
        for (int i = 0; i < 2; ++i) { oc0[i] = on0[i]; oc1[i] = on1[i]; }
    }
    PG8_WAIT_V(0);
    if (wr == 0) PG8_BAR;
    PG8_BAR;
#undef PG8_SA
#undef PG8_SB
#undef PG8_STAGE
#undef PG8_LDA
#undef PG8_LDB
#undef PG8_MMA
#undef PG8_WAIT_V
#undef PG8_WAIT_L
#undef PG8_BAR
#undef PG8_SCHED
}
}

struct EpiStoreBf16 { bf16_t* O; int ldc; int gelu_below;
    __device__ __forceinline__ void operator()(int row, int pn, int cx, f32x4 v0, f32x4 v1) const {
        const int c0 = pn * 256 + cx, c1 = c0 + 128;
        if (c0 < gelu_below) { v0[0] = gelu_tanh_f(v0[0]); v0[1] = gelu_tanh_f(v0[1]); v0[2] = gelu_tanh_f(v0[2]); v0[3] = gelu_tanh_f(v0[3]); }
        if (c1 < gelu_below) { v1[0] = gelu_tanh_f(v1[0]); v1[1] = gelu_tanh_f(v1[1]); v1[2] = gelu_tanh_f(v1[2]); v1[3] = gelu_tanh_f(v1[3]); }
        u32x2 a; a.x = pack2(v0[0], v0[1]); a.y = pack2(v0[2], v0[3]); u32x2 b; b.x = pack2(v1[0], v1[1]); b.y = pack2(v1[2], v1[3]);
        *(u32x2*)(O + (size_t)row * ldc + c0) = a; *(u32x2*)(O + (size_t)row * ldc + c1) = b; } };
struct EpiResidual { const float* srcl; const float* srcc; float* dstl; float* dstc; const float* mod;   int which;
    __device__ __forceinline__ void operator()(int row, int pn, int cx, f32x4 v0, f32x4 v1) const {
        const int b = row < TL ? (row >> 13) : 8; const float* g = mod + ((size_t)b * 6 + which) * 1024;
        const float* s = row < TL ? srcl + (size_t)row * 1024 : srcc + (size_t)(row - TL) * 1024;
        float* d = row < TL ? dstl + (size_t)row * 1024 : dstc + (size_t)(row - TL) * 1024;
        const int c0 = pn * 256 + cx, c1 = c0 + 128;
        *(f32x4*)(d + c0) = *(const f32x4*)(s + c0) + *(const f32x4*)(g + c0) * v0;
        *(f32x4*)(d + c1) = *(const f32x4*)(s + c1) + *(const f32x4*)(g + c1) * v1; } };
struct EpiMoe1 { bf16_t* H;
    __device__ __forceinline__ void operator()(int row, int pn, int cx, f32x4 v0, f32x4 v1) const {
        u32x2 a; a.x = pack2(silu_f(v0[0]) * v1[0], silu_f(v0[1]) * v1[1]); a.y = pack2(silu_f(v0[2]) * v1[2], silu_f(v0[3]) * v1[3]);
        *(u32x2*)(H + (size_t)row * 512 + pn * 128 + cx) = a; } };
struct EpiMoe2 { const int* stok; const float* sw; float* dstl; float* dstc; const float* mod;
    __device__ __forceinline__ void operator()(int row, int pn, int cx, f32x4 v0, f32x4 v1) const {
        const int t = stok[row]; if (t < 0) return; const float w = sw[row];
        const int b = t < TL ? (t >> 13) : 8; const float* g = mod + ((size_t)b * 6 + 5) * 1024;
        float* d = t < TL ? dstl + (size_t)t * 1024 : dstc + (size_t)(t - TL) * 1024;
        const int c0 = pn * 256 + cx, c1 = c0 + 128;
        *(f32x4*)(d + c0) = *(const f32x4*)(d + c0) + *(const f32x4*)(g + c0) * v0 * w;
        *(f32x4*)(d + c1) = *(const f32x4*)(d + c1) + *(const f32x4*)(g + c1) * v1 * w; } };

#ifndef FAST_GEMM
#define FAST_GEMM 1
#endif
template <class EP>
__device__ __forceinline__ void gemm_dense(const Frame& F, const bf16_t* A, const bf16_t* Bt, int M, int N, int K, const EP& E) {
#if FAST_GEMM
    pg8::ProbDense S; S.init(A, Bt, M, N, K, F.G, F.bid); pg8::gemm_phase(F.lds, S, E);
#else
    gemm_dense_naive(F, A, Bt, M, N, K, E);
#endif
}
__device__ __forceinline__ void ph_moe_gemm1(const Frame& F, int layer) {
    const unsigned* info = (const unsigned*)(F.ws + WS_CTRL + C_MOE + layer * 1024) + 128;
    const int ntiles = (int)__hip_atomic_load(&info[1], __ATOMIC_RELAXED, __HIP_MEMORY_SCOPE_AGENT);
    const int* tile_e = (const int*)(F.ws + WS_R2 + R2_TILEE); const int* stok = (const int*)(F.ws + WS_R2 + R2_STOK);
    const bf16_t* W1 = (const bf16_t*)(F.ws + WS_WMOE);
    EpiMoe1 E{(bf16_t*)(F.ws + WS_R2 + R2_H)};
#if FAST_GEMM
    pg8::ProbMoe1 S{(const char*)(F.ws + WS_ACT), stok, tile_e, (const char*)W1, 1024, ntiles, F.G, F.bid};
    pg8::gemm_phase(F.lds, S, E);
#else
    for (int u = F.bid; u < ntiles * 4; u += F.G) { const int pm = u >> 2, pn = u & 3; const int e = tile_e[pm] & 31;
        ARowGather ar{(const bf16_t*)(F.ws + WS_ACT), stok, pm};
        gemm_unit_naive(F, 1024, ar, W1 + ((size_t)e * 1024 + pn * 256) * 1024, E, pm, pn); }
#endif
}
__device__ __forceinline__ void ph_moe_gemm2(const Frame& F, int layer, int k) {
    const unsigned* info = (const unsigned*)(F.ws + WS_CTRL + C_MOE + layer * 1024) + 128;
    const int nk0 = (int)__hip_atomic_load(&info[0], __ATOMIC_RELAXED, __HIP_MEMORY_SCOPE_AGENT), nall = (int)__hip_atomic_load(&info[1], __ATOMIC_RELAXED, __HIP_MEMORY_SCOPE_AGENT);
    const int tlo = k == 0 ? 0 : nk0, thi = k == 0 ? nk0 : nall;
    const int* tile_e = (const int*)(F.ws + WS_R2 + R2_TILEE);
    const bf16_t* W2 = (const bf16_t*)(F.ws + WS_WMOE) + (size_t)32 * 1024 * 1024;
    EpiMoe2 E{(const int*)(F.ws + WS_R2 + R2_STOK), (const float*)(F.ws + WS_R2 + R2_SW), F.P->out, (float*)(F.ws + WS_XC), F.mod + (size_t)layer * 9 * 6144};
#if FAST_GEMM
    pg8::ProbMoe2 S{(const char*)(F.ws + WS_R2 + R2_H), tile_e, (const char*)W2, 512, tlo, thi, F.G, F.bid};
    pg8::gemm_phase(F.lds, S, E);
#else
    for (int u = F.bid; u < (thi - tlo) * 4; u += F.G) { const int pm = tlo + (u >> 2), pn = u & 3; const int e = tile_e[pm] & 31;
        ARowDense ar{(const bf16_t*)(F.ws + WS_R2 + R2_H), 512, pm};
        gemm_unit_naive(F, 512, ar, W2 + ((size_t)e * 1024 + pn * 256) * 512, E, pm, pn); }
#endif
}

__device__ __forceinline__ void ph_gmlp(const Frame& F) {
    const Params& P = *F.P;
    const bf16_t* PX = (const bf16_t*)(F.ws + WS_PX); bf16_t* CAT = (bf16_t*)(F.ws + WS_ACT);
    LAS float* Vs = (LAS float*)F.lds;
    LAS float* Wm = Vs + 128 * 128;
    LAS float* rs = Wm + 128 * 129;
    for (int it = F.bid; it < 528 * 4; it += F.G) {
        const int ch = it >> 2, g = it & 3, row0 = ch * 128;
        for (int q = F.wave; q < 128; q += 8) { const bf16_t* p = PX + (size_t)(row0 + q) * EVEN_IN + 512 + F.lane * 8;
            const u32x4 w = *(const u32x4*)p; float s = 0.f, x;
            x = lo2f(w.x); s += x * x; x = hi2f(w.x); s += x * x; x = lo2f(w.y); s += x * x; x = hi2f(w.y); s += x * x;
            x = lo2f(w.z); s += x * x; x = hi2f(w.z); s += x * x; x = lo2f(w.w); s += x * x; x = hi2f(w.w); s += x * x;
            s = wave_sum(s); if (F.lane == 0) rs[q] = rsqrtf(s * (1.f / 512.f) + EPS); }
        __syncthreads();
        for (int i = F.tid; i < 128 * 128; i += NTH) { const int q = i >> 7, c = i & 127;
            Vs[i] = bf2f(PX[(size_t)(row0 + q) * EVEN_IN + 512 + g * 128 + c]) * rs[q] * P.in[I_GNW][g * 128 + c];
            Wm[q * 129 + c] = P.in[I_GWS][(size_t)g * 16384 + i]; }
        __syncthreads();
        const int ty = F.tid >> 5, tx = F.tid & 31;
        float acc[8][4];
#pragma unroll
        for (int i = 0; i < 8; ++i)
#pragma unroll
            for (int j = 0; j < 4; ++j) acc[i][j] = 0.f;
        for (int q = 0; q < 128; ++q) { const f32x4 v = *(const LAS f32x4*)(Vs + q * 128 + tx * 4);
#pragma unroll
            for (int i = 0; i < 8; ++i) { const float w = Wm[(ty * 8 + i) * 129 + q];
#pragma unroll
                for (int j = 0; j < 4; ++j) acc[i][j] += w * v[j]; } }
#pragma unroll
        for (int i = 0; i < 8; ++i) { const int p = ty * 8 + i; const float bias = P.in[I_GBS][g * 128 + p];
            const size_t t = (size_t)(row0 + p); const int col = g * 128 + tx * 4;
            const u32x2 uu = *(const u32x2*)(PX + t * EVEN_IN + col);
            u32x2 o; o.x = pack2(lo2f(uu.x) * (acc[i][0] + bias), hi2f(uu.x) * (acc[i][1] + bias)); o.y = pack2(lo2f(uu.y) * (acc[i][2] + bias), hi2f(uu.y) * (acc[i][3] + bias));
            *(u32x2*)(CAT + t * 1024 + col) = o; }
        __syncthreads();
    }
}

__device__ __forceinline__ void ph_gla(const Frame& F) {
    const Params& P = *F.P;
    const bf16_t* PX = (const bf16_t*)(F.ws + WS_PX);
    LAS float* qs = (LAS float*)F.lds;
    LAS float* fs = qs + 4096;
    LAS float* vs = fs + 4096;
    LAS float* os = vs + 1024;
    const int dg = F.lane & 15, el = F.wave * 4 + (F.lane >> 4);
    const int prow = F.tid >> 4, pd0 = (F.tid & 15) * 8;
    const int vrow = F.tid >> 2, ve0 = (F.tid & 3) * 8;
    for (int it = F.bid; it < 256; it += F.G) {
        const int b = it >> 5, h = (it >> 3) & 3, dir = (it >> 2) & 1, sl = it & 3;
        bf16_t* O = (bf16_t*)(F.ws + WS_R2 + (dir ? R2_OB0 : R2_OF0));
        float lb8[8];
#pragma unroll
        for (int i = 0; i < 8; ++i) { const int ch = h * 128 + pd0 + i; const float* lg = P.in[I_LB] + (size_t)dir * 3 * 512 + ch;
            const float a0 = lg[0], a1 = lg[512], a2 = lg[1024]; const float m = fmaxf(a0, fmaxf(a1, a2));
            const float e0 = __expf(a0 - m), e1 = __expf(a1 - m), e2 = __expf(a2 - m); lb8[i] = e0 / (e0 + e1 + e2); }
        float S[8];
#pragma unroll
        for (int i = 0; i < 8; ++i) S[i] = 0.f;
        u32x4 rq, rf, rv = {0u, 0u, 0u, 0u};
        auto rowof = [&](int nb, int s) -> size_t { const bool c = nb < 8; const int len = c ? CTXL : SEQ; const int tt = (c ? nb : nb - 8) * 32 + s; const int p = dir ? len - 1 - tt : tt;
            return (c ? (size_t)TL + b * CTXL : (size_t)b * SEQ) + p; };
        { const bf16_t* row = PX + rowof(0, prow) * EVEN_IN; rq = *(const u32x4*)(row + 1024 + h * 128 + pd0); rf = *(const u32x4*)(row + 2048 + dir * 512 + h * 128 + pd0);
          if (F.tid < 128) rv = *(const u32x4*)(PX + rowof(0, vrow) * EVEN_IN + 1536 + h * 128 + sl * 32 + ve0); }
        for (int nb = 0; nb < 264; ++nb) {
            __syncthreads();
            { LAS float* qd = qs + prow * 128 + pd0; LAS float* fd = fs + prow * 128 + pd0;
              const float q8[8] = {lo2f(rq.x), hi2f(rq.x), lo2f(rq.y), hi2f(rq.y), lo2f(rq.z), hi2f(rq.z), lo2f(rq.w), hi2f(rq.w)};
              const float f8[8] = {lo2f(rf.x), hi2f(rf.x), lo2f(rf.y), hi2f(rf.y), lo2f(rf.z), hi2f(rf.z), lo2f(rf.w), hi2f(rf.w)};
              f32x4 o0, o1, g0, g1;
#pragma unroll
              for (int i = 0; i < 4; ++i) { o0[i] = q8[i]; o1[i] = q8[4 + i]; g0[i] = lb8[i] + (1.f - lb8[i]) * sigmoid_f(f8[i]); g1[i] = lb8[4 + i] + (1.f - lb8[4 + i]) * sigmoid_f(f8[4 + i]); }
              *(LAS f32x4*)qd = o0; *(LAS f32x4*)(qd + 4) = o1; *(LAS f32x4*)fd = g0; *(LAS f32x4*)(fd + 4) = g1;
              if (F.tid < 128) { LAS float* vd = vs + vrow * 32 + ve0;
                  *(LAS f32x4*)vd = (f32x4){lo2f(rv.x), hi2f(rv.x), lo2f(rv.y), hi2f(rv.y)}; *(LAS f32x4*)(vd + 4) = (f32x4){lo2f(rv.z), hi2f(rv.z), lo2f(rv.w), hi2f(rv.w)}; } }
            __syncthreads();
            if (nb + 1 < 264) { const bf16_t* row = PX + rowof(nb + 1, prow) * EVEN_IN; rq = *(const u32x4*)(row + 1024 + h * 128 + pd0); rf = *(const u32x4*)(row + 2048 + dir * 512 + h * 128 + pd0);
                if (F.tid < 128) rv = *(const u32x4*)(PX + rowof(nb + 1, vrow) * EVEN_IN + 1536 + h * 128 + sl * 32 + ve0); }
#pragma unroll 4
            for (int st = 0; st < 32; ++st) {
                const f32x4 fa = *(const LAS f32x4*)(fs + st * 128 + dg * 8), fb = *(const LAS f32x4*)(fs + st * 128 + dg * 8 + 4);
                const f32x4 qa = *(const LAS f32x4*)(qs + st * 128 + dg * 8), qb = *(const LAS f32x4*)(qs + st * 128 + dg * 8 + 4);
                const float v = vs[st * 32 + el];
                float p0 = 0.f, p1 = 0.f;
#pragma unroll
                for (int i = 0; i < 4; ++i) { S[i] = fa[i] * S[i] + (1.f - fa[i]) * v; p0 += qa[i] * S[i]; S[4 + i] = fb[i] * S[4 + i] + (1.f - fb[i]) * v; p1 += qb[i] * S[4 + i]; }
                const float o = sum16(p0 + p1);
                if (dg == 0) os[st * 32 + el] = o;
            }
            __syncthreads();
            { const int s = F.tid >> 4, e2 = (F.tid & 15) * 2;
              *(unsigned*)(O + rowof(nb, s) * 512 + h * 128 + sl * 32 + e2) = pack2(os[s * 32 + e2], os[s * 32 + e2 + 1]); }
        }
        __syncthreads();
    }
}

__device__ __forceinline__ void ph_merge(const Frame& F, int mode) {
    const Params& P = *F.P;
    const bf16_t* PX = (const bf16_t*)(F.ws + WS_PX); bf16_t* CAT = (bf16_t*)(F.ws + WS_ACT);
    const bf16_t* Of = (const bf16_t*)(mode ? F.ws + WS_GOF : F.ws + WS_R2 + R2_OF0); const bf16_t* Ob = (const bf16_t*)(mode ? F.ws + WS_WMOE : F.ws + WS_R2 + R2_OB0);
    const int nrows = mode ? TL : TT, ldp = mode ? ODD_PAD : EVEN_IN, gcol = mode ? 1536 : 3072, dcol = mode ? 0 : 512;
    const float* nw = mode ? P.in[I_GDNNW] : P.in[I_HNW];
    for (int r = F.bid * 8 + F.wave; r < nrows; r += F.G * 8) {
        const int c = F.lane * 8;
        const u32x4 a = *(const u32x4*)(Of + (size_t)r * 512 + c), bb = *(const u32x4*)(Ob + (size_t)r * 512 + c), gg = *(const u32x4*)(PX + (size_t)r * ldp + gcol + c);
        float o[8] = {lo2f(a.x) + lo2f(bb.x), hi2f(a.x) + hi2f(bb.x), lo2f(a.y) + lo2f(bb.y), hi2f(a.y) + hi2f(bb.y), lo2f(a.z) + lo2f(bb.z), hi2f(a.z) + hi2f(bb.z), lo2f(a.w) + lo2f(bb.w), hi2f(a.w) + hi2f(bb.w)};
        const float g[8] = {lo2f(gg.x), hi2f(gg.x), lo2f(gg.y), hi2f(gg.y), lo2f(gg.z), hi2f(gg.z), lo2f(gg.w), hi2f(gg.w)};
        float ss = 0.f;
#pragma unroll
        for (int i = 0; i < 8; ++i) ss += o[i] * o[i];
        ss = sum16(ss);
        const float rstd = rsqrtf(ss * (1.f / 128.f) + EPS);
        float y[8];
#pragma unroll
        for (int i = 0; i < 8; ++i) { const float w = mode ? nw[(c & 127) + i] : nw[c + i]; y[i] = o[i] * rstd * w * silu_f(g[i]); }
        u32x4 w; w.x = pack2(y[0], y[1]); w.y = pack2(y[2], y[3]); w.z = pack2(y[4], y[5]); w.w = pack2(y[6], y[7]);
        *(u32x4*)(CAT + (size_t)r * 1024 + dcol + c) = w;
    }
}

__device__ __forceinline__ void ph_mla_norm(const Frame& F) {
    const Params& P = *F.P;
    const bf16_t* PX = (const bf16_t*)(F.ws + WS_PX);
    bf16_t* cqn = (bf16_t*)(F.ws + WS_R2 + R2_CQN); bf16_t* ckvn = cqn + (size_t)TL * 256;
    for (int r = F.bid * 8 + F.wave; r < TT; r += F.G * 8) {
        const bf16_t* row = PX + (size_t)r * ODD_PAD;
        if (r < TL) { const u32x2 w = *(const u32x2*)(row + 2064 + F.lane * 4);
            const float x0 = lo2f(w.x), x1 = hi2f(w.x), x2 = lo2f(w.y), x3 = hi2f(w.y);
            const float ss = wave_sum(x0 * x0 + x1 * x1 + x2 * x2 + x3 * x3); const float rstd = rsqrtf(ss * (1.f / 256.f) + EPS);
            const float* nw = P.in[I_QNW] + F.lane * 4;
            u32x2 o; o.x = pack2(x0 * rstd * nw[0], x1 * rstd * nw[1]); o.y = pack2(x2 * rstd * nw[2], x3 * rstd * nw[3]);
            *(u32x2*)(cqn + (size_t)r * 256 + F.lane * 4) = o; }
        { const unsigned w = *(const unsigned*)(row + 2320 + F.lane * 2);
          const float x0 = lo2f(w), x1 = hi2f(w);
          const float ss = wave_sum(x0 * x0 + x1 * x1); const float rstd = rsqrtf(ss * (1.f / 128.f) + EPS);
          const float* nw = P.in[I_KVNW] + F.lane * 2;
          *(unsigned*)(ckvn + (size_t)r * 256 + F.lane * 2) = pack2(x0 * rstd * nw[0], x1 * rstd * nw[1]);
          *(unsigned*)(ckvn + (size_t)r * 256 + 128 + F.lane * 2) = 0u; }
    }
}

__device__ __forceinline__ void ph_mla_final(const Frame& F) {
    const Params& P = *F.P;
    const bf16_t* PX = (const bf16_t*)(F.ws + WS_PX);
    bf16_t* Q = (bf16_t*)(F.ws + WS_WMOE);
    const bf16_t* KVR = (const bf16_t*)(F.ws + WS_PX + PX_KVRAW);
    bf16_t* Kb = (bf16_t*)(F.ws + WS_R2 + R2_K); bf16_t* Vb = (bf16_t*)(F.ws + WS_R2 + R2_V);
    const int hh = F.lane >> 3, sub = F.lane & 7;
    const float freq = __powf(10000.f, -(float)sub * 0.125f);
    const float qscale = 0.10206207261596577f * 1.4426950408889634f;
    for (int r = F.bid * 8 + F.wave; r < TT; r += F.G * 8) {
        const bool lat = r < TL; const int l = r & (SEQ - 1);
        float ca = 1.f, sa = 0.f, cb = 1.f, sb = 0.f;
        if (lat) { const float pr = (float)(l >> 6), pc = (float)(l & 63); sincosf(pr * freq, &sa, &ca); sincosf(pc * freq, &sb, &cb); }
        { const bf16_t* kv = KVR + (size_t)r * 1024 + hh * 128;
          const u32x4 w = *(const u32x4*)(kv + sub * 8);
          float x[12] = {lo2f(w.x), hi2f(w.x), lo2f(w.y), hi2f(w.y), lo2f(w.z), hi2f(w.z), lo2f(w.w), hi2f(w.w), 0.f, 0.f, 0.f, 0.f};
          const bf16_t* kr = PX + (size_t)r * ODD_PAD + 2448;
          x[8] = bf2f(kr[sub]); x[9] = bf2f(kr[8 + sub]); x[10] = bf2f(kr[16 + sub]); x[11] = bf2f(kr[24 + sub]);
          float ss = 0.f;
#pragma unroll
          for (int i = 0; i < 12; ++i) ss += x[i] * x[i];
          ss = sum8(ss);
          const float rstd = rsqrtf(ss * (1.f / 96.f) + EPS);
          const float* nw = P.in[I_QKK];
#pragma unroll
          for (int i = 0; i < 8; ++i) x[i] *= rstd * nw[sub * 8 + i];
          x[8] *= rstd * nw[64 + sub]; x[9] *= rstd * nw[72 + sub]; x[10] *= rstd * nw[80 + sub]; x[11] *= rstd * nw[88 + sub];
          const float a1 = x[8] * ca - x[9] * sa, a2 = x[9] * ca + x[8] * sa, b1 = x[10] * cb - x[11] * sb, b2 = x[11] * cb + x[10] * sb;
          const int bidx = lat ? (r >> 13) : ((r - TL) >> 8); const int s = lat ? (CTXL + l) : ((r - TL) & 255);
          bf16_t* kd = Kb + ((size_t)(bidx * 8 + hh) * (SEQ + CTXL) + s) * 96;
          u32x4 o; o.x = pack2(x[0], x[1]); o.y = pack2(x[2], x[3]); o.z = pack2(x[4], x[5]); o.w = pack2(x[6], x[7]);
          *(u32x4*)(kd + sub * 8) = o;
          kd[64 + sub] = f2bf(a1); kd[72 + sub] = f2bf(a2); kd[80 + sub] = f2bf(b1); kd[88 + sub] = f2bf(b2);
          const u32x4 vv = *(const u32x4*)(kv + 64 + sub * 8);
          *(u32x4*)(Vb + ((size_t)(bidx * 8 + hh) * (SEQ + CTXL) + s) * 64 + sub * 8) = vv; }
        if (lat) { bf16_t* q = Q + (size_t)r * 768 + hh * 96;
          const u32x4 w = *(const u32x4*)(q + sub * 8);
          float x[12] = {lo2f(w.x), hi2f(w.x), lo2f(w.y), hi2f(w.y), lo2f(w.z), hi2f(w.z), lo2f(w.w), hi2f(w.w), bf2f(q[64 + sub]), bf2f(q[72 + sub]), bf2f(q[80 + sub]), bf2f(q[88 + sub])};
          float ss = 0.f;
#pragma unroll
          for (int i = 0; i < 12; ++i) ss += x[i] * x[i];
          ss = sum8(ss);
          const float rstd = rsqrtf(ss * (1.f / 96.f) + EPS) * qscale;
          const float* nw = P.in[I_QKQ];
#pragma unroll
          for (int i = 0; i < 8; ++i) x[i] *= rstd * nw[sub * 8 + i];
          x[8] *= rstd * nw[64 + sub]; x[9] *= rstd * nw[72 + sub]; x[10] *= rstd * nw[80 + sub]; x[11] *= rstd * nw[88 + sub];
          const float a1 = x[8] * ca - x[9] * sa, a2 = x[9] * ca + x[8] * sa, b1 = x[10] * cb - x[11] * sb, b2 = x[11] * cb + x[10] * sb;
          u32x4 o; o.x = pack2(x[0], x[1]); o.y = pack2(x[2], x[3]); o.z = pack2(x[4], x[5]); o.w = pack2(x[6], x[7]);
          *(u32x4*)(q + sub * 8) = o;
          q[64 + sub] = f2bf(a1); q[72 + sub] = f2bf(a2); q[80 + sub] = f2bf(b1); q[88 + sub] = f2bf(b2); }
    }
}

__device__ __forceinline__ void ph_attn_naive(const Frame& F) {
    const bf16_t* Q = (const bf16_t*)(F.ws + WS_WMOE);
    const bf16_t* Kb = (const bf16_t*)(F.ws + WS_R2 + R2_K); const bf16_t* Vb = (const bf16_t*)(F.ws + WS_R2 + R2_V);
    bf16_t* CAT = (bf16_t*)(F.ws + WS_ACT);
    LAS float* Ks = (LAS float*)F.lds;
    LAS float* Vs = Ks + 64 * 96;
    constexpr int NK = SEQ + CTXL;
    const int hf = F.tid & 1;
    for (int it = F.bid; it < 8 * 8 * 32; it += F.G) {
        const int b = it >> 8, h = (it >> 5) & 7, qb = it & 31;
        const int l = qb * 256 + (F.tid >> 1); const size_t trow = (size_t)b * SEQ + l;
        float q[48], o[32];
        { const bf16_t* qp = Q + trow * 768 + h * 96 + hf * 48;
#pragma unroll
          for (int i = 0; i < 6; ++i) { const u32x4 w = *(const u32x4*)(qp + i * 8);
            q[i * 8 + 0] = lo2f(w.x); q[i * 8 + 1] = hi2f(w.x); q[i * 8 + 2] = lo2f(w.y); q[i * 8 + 3] = hi2f(w.y); q[i * 8 + 4] = lo2f(w.z); q[i * 8 + 5] = hi2f(w.z); q[i * 8 + 6] = lo2f(w.w); q[i * 8 + 7] = hi2f(w.w); } }
#pragma unroll
        for (int d = 0; d < 32; ++d) o[d] = 0.f;
        float m = -3.0e38f, ls = 0.f;
        const bf16_t* kb = Kb + (size_t)(b * 8 + h) * NK * 96; const bf16_t* vb = Vb + (size_t)(b * 8 + h) * NK * 64;
        for (int kt = 0; kt < NK / 64; ++kt) {
            for (int i = F.tid; i < 64 * 96 / 8; i += NTH) { const u32x4 w = *(const u32x4*)(kb + (size_t)kt * 64 * 96 + i * 8); LAS float* d = Ks + i * 8;
                d[0] = lo2f(w.x); d[1] = hi2f(w.x); d[2] = lo2f(w.y); d[3] = hi2f(w.y); d[4] = lo2f(w.z); d[5] = hi2f(w.z); d[6] = lo2f(w.w); d[7] = hi2f(w.w); }
            { const int i = F.tid; const u32x4 w = *(const u32x4*)(vb + (size_t)kt * 64 * 64 + i * 8); LAS float* d = Vs + i * 8;
                d[0] = lo2f(w.x); d[1] = hi2f(w.x); d[2] = lo2f(w.y); d[3] = hi2f(w.y); d[4] = lo2f(w.z); d[5] = hi2f(w.z); d[6] = lo2f(w.w); d[7] = hi2f(w.w); }
            __syncthreads();
            for (int jb = 0; jb < 16; ++jb) {
                float s[4]; float mx = m;
#pragma unroll
                for (int jj = 0; jj < 4; ++jj) { const LAS float* kr = Ks + (jb * 4 + jj) * 96 + hf * 48; float a = 0.f;
#pragma unroll
                    for (int d = 0; d < 48; d += 4) { const f32x4 kv = *(const LAS f32x4*)(kr + d); a += q[d] * kv[0] + q[d + 1] * kv[1] + q[d + 2] * kv[2] + q[d + 3] * kv[3]; }
                    a += __shfl_xor(a, 1);
                    s[jj] = a; mx = fmaxf(mx, a); }
                const float sc = exp2f(m - mx); ls *= sc;
#pragma unroll
                for (int d = 0; d < 32; ++d) o[d] *= sc;
                m = mx;
#pragma unroll
                for (int jj = 0; jj < 4; ++jj) { const float p = exp2f(s[jj] - mx); ls += p; const LAS float* vr = Vs + (jb * 4 + jj) * 64 + hf * 32;
#pragma unroll
                    for (int d = 0; d < 32; d += 4) { const f32x4 vv = *(const LAS f32x4*)(vr + d); o[d] += p * vv[0]; o[d + 1] += p * vv[1]; o[d + 2] += p * vv[2]; o[d + 3] += p * vv[3]; } }
            }
            __syncthreads();
        }
        const float inv = 1.f / ls;
        bf16_t* dst = CAT + trow * 1024 + 512 + h * 64 + hf * 32;
#pragma unroll
        for (int i = 0; i < 4; ++i) { u32x4 w; w.x = pack2(o[i * 8] * inv, o[i * 8 + 1] * inv); w.y = pack2(o[i * 8 + 2] * inv, o[i * 8 + 3] * inv); w.z = pack2(o[i * 8 + 4] * inv, o[i * 8 + 5] * inv); w.w = pack2(o[i * 8 + 6] * inv, o[i * 8 + 7] * inv);
            *(u32x4*)(dst + i * 8) = w; }
    }
}

typedef float f32x16 __attribute__((ext_vector_type(16)));
typedef short s16x8 __attribute__((ext_vector_type(8)));
__device__ __forceinline__ void ph_attn(const Frame& F) {
    constexpr int NK = SEQ + CTXL, NT = NK / 64;
    constexpr int KROWB = 208, VROWB = 144, KBYTES = 64 * KROWB, VBYTES = 64 * VROWB, BUFB = KBYTES + VBYTES;
    const bf16_t* Q = (const bf16_t*)(F.ws + WS_WMOE);
    const bf16_t* Kb = (const bf16_t*)(F.ws + WS_R2 + R2_K); const bf16_t* Vb = (const bf16_t*)(F.ws + WS_R2 + R2_V);
    bf16_t* CAT = (bf16_t*)(F.ws + WS_ACT);
    const int l31 = F.lane & 31, hh = F.lane >> 5;
    const int vcu = (F.G % 8 == 0) ? (F.bid % 8) * (F.G / 8) + F.bid / 8 : F.bid;
    const int kc0 = F.tid, kc1 = F.tid + 512;
    const unsigned kd0 = (unsigned)((kc0 / 12) * KROWB + (kc0 % 12) * 16), kd1 = (unsigned)((kc1 / 12) * KROWB + (kc1 % 12) * 16);
    const int vkey = F.tid >> 3, vpos = (vkey & ~12) | ((vkey & 4) << 1) | ((vkey & 8) >> 1);
    const unsigned vd = (unsigned)(((F.tid & 7) * 8) * VROWB + vpos * 2);
    for (int u = vcu; u < 2048; u += F.G) {
        const int bh = u >> 5, qblk = u & 31, b = bh >> 3, h = bh & 7;
        const size_t trow = (size_t)b * SEQ + qblk * 256 + F.wave * 32 + l31;
        s16x8 qf[6];
        { const bf16_t* qp = Q + trow * 768 + h * 96 + hh * 8;
#pragma unroll
          for (int ds = 0; ds < 6; ++ds) qf[ds] = *(const s16x8*)(qp + ds * 16); }
        f32x16 o0, o1;
#pragma unroll
        for (int i = 0; i < 16; ++i) { o0[i] = 0.f; o1[i] = 0.f; }
        float m = -1.0e30f, lsum = 0.f;
        const bf16_t* kg = Kb + (size_t)bh * NK * 96; const bf16_t* vg = Vb + (size_t)bh * NK * 64;
        u32x4 kr0, kr1 = {0u, 0u, 0u, 0u}, vr;
        kr0 = *(const u32x4*)(kg + (size_t)kc0 * 8); if (kc1 < 768) kr1 = *(const u32x4*)(kg + (size_t)kc1 * 8); vr = *(const u32x4*)(vg + (size_t)F.tid * 8);
        __syncthreads();
        for (int t = 0; t < NT; ++t) {
            { LAS unsigned char* kbuf = F.lds + (t & 1) * BUFB; LAS unsigned char* vbuf = kbuf + KBYTES;
              *(LAS u32x4*)(kbuf + kd0) = kr0; if (kc1 < 768) *(LAS u32x4*)(kbuf + kd1) = kr1;
              LAS unsigned short* vp = (LAS unsigned short*)(vbuf + vd);
              vp[0 * (VROWB / 2)] = (unsigned short)(vr.x & 0xffffu); vp[1 * (VROWB / 2)] = (unsigned short)(vr.x >> 16);
              vp[2 * (VROWB / 2)] = (unsigned short)(vr.y & 0xffffu); vp[3 * (VROWB / 2)] = (unsigned short)(vr.y >> 16);
              vp[4 * (VROWB / 2)] = (unsigned short)(vr.z & 0xffffu); vp[5 * (VROWB / 2)] = (unsigned short)(vr.z >> 16);
              vp[6 * (VROWB / 2)] = (unsigned short)(vr.w & 0xffffu); vp[7 * (VROWB / 2)] = (unsigned short)(vr.w >> 16); }
            __syncthreads();
            if (t + 1 < NT) { const bf16_t* kt = kg + (size_t)(t + 1) * 64 * 96; const bf16_t* vt = vg + (size_t)(t + 1) * 64 * 64;
                kr0 = *(const u32x4*)(kt + (size_t)kc0 * 8); if (kc1 < 768) kr1 = *(const u32x4*)(kt + (size_t)kc1 * 8); vr = *(const u32x4*)(vt + (size_t)F.tid * 8); }
            const LAS unsigned char* kbuf = F.lds + (t & 1) * BUFB; const LAS unsigned char* vbuf = kbuf + KBYTES;
            f32x16 s0, s1;
#pragma unroll
            for (int i = 0; i < 16; ++i) { s0[i] = 0.f; s1[i] = 0.f; }
#pragma unroll
            for (int ds = 0; ds < 6; ++ds) {
                const s16x8 a0 = *(const LAS s16x8*)(kbuf + l31 * KROWB + ds * 32 + hh * 16);
                const s16x8 a1 = *(const LAS s16x8*)(kbuf + (32 + l31) * KROWB + ds * 32 + hh * 16);
                s0 = __builtin_amdgcn_mfma_f32_32x32x16_bf16(a0, qf[ds], s0, 0, 0, 0);
                s1 = __builtin_amdgcn_mfma_f32_32x32x16_bf16(a1, qf[ds], s1, 0, 0, 0);
            }
            float mx = s0[0];
#pragma unroll
            for (int i = 1; i < 16; ++i) mx = fmaxf(mx, s0[i]);
#pragma unroll
            for (int i = 0; i < 16; ++i) mx = fmaxf(mx, s1[i]);
            mx = fmaxf(mx, __shfl_xor(mx, 32));
            const float mn = fmaxf(m, mx); const float alpha = __builtin_amdgcn_exp2f(m - mn); m = mn;
            float ps = 0.f;
#pragma unroll
            for (int i = 0; i < 16; ++i) { s0[i] = __builtin_amdgcn_exp2f(s0[i] - mn); s1[i] = __builtin_amdgcn_exp2f(s1[i] - mn); ps += s0[i] + s1[i]; }
            lsum = lsum * alpha + ps;
#pragma unroll
            for (int i = 0; i < 16; ++i) { o0[i] *= alpha; o1[i] *= alpha; }
#pragma unroll
            for (int kb = 0; kb < 2; ++kb)
#pragma unroll
                for (int st = 0; st < 2; ++st) {
                    u32x4 pw;
                    if (kb == 0) { pw.x = pack2(s0[8 * st + 0], s0[8 * st + 1]); pw.y = pack2(s0[8 * st + 2], s0[8 * st + 3]); pw.z = pack2(s0[8 * st + 4], s0[8 * st + 5]); pw.w = pack2(s0[8 * st + 6], s0[8 * st + 7]); }
                    else         { pw.x = pack2(s1[8 * st + 0], s1[8 * st + 1]); pw.y = pack2(s1[8 * st + 2], s1[8 * st + 3]); pw.z = pack2(s1[8 * st + 4], s1[8 * st + 5]); pw.w = pack2(s1[8 * st + 6], s1[8 * st + 7]); }
                    const s16x8 pf = __builtin_bit_cast(s16x8, pw);
                    const int kof = (kb * 32 + 16 * st + 8 * hh) * 2;
                    o0 = __builtin_amdgcn_mfma_f32_32x32x16_bf16(*(const LAS s16x8*)(vbuf + l31 * VROWB + kof), pf, o0, 0, 0, 0);
                    o1 = __builtin_amdgcn_mfma_f32_32x32x16_bf16(*(const LAS s16x8*)(vbuf + (32 + l31) * VROWB + kof), pf, o1, 0, 0, 0);
                }
        }
        const float ltot = lsum + __shfl_xor(lsum, 32); const float inv = 1.f / ltot;
        bf16_t* dst = CAT + trow * 1024 + 512 + h * 64 + hh * 4;
#pragma unroll
        for (int g = 0; g < 4; ++g) { u32x2 w;
            w.x = pack2(o0[4 * g] * inv, o0[4 * g + 1] * inv); w.y = pack2(o0[4 * g + 2] * inv, o0[4 * g + 3] * inv); *(u32x2*)(dst + g * 8) = w;
            w.x = pack2(o1[4 * g] * inv, o1[4 * g + 1] * inv); w.y = pack2(o1[4 * g + 2] * inv, o1[4 * g + 3] * inv); *(u32x2*)(dst + 32 + g * 8) = w; }
    }
    __syncthreads();
}

__device__ __forceinline__ void ph_gdn(const Frame& F) {
    const Params& P = *F.P;
    const bf16_t* PX = (const bf16_t*)(F.ws + WS_PX);
    LAS bf16_t* rq = (LAS bf16_t*)F.lds;
    LAS bf16_t* rk = rq + 36 * 128;
    LAS bf16_t* rv = rk + 36 * 128;
    LAS float* qc = (LAS float*)(F.lds + 24576);
    LAS float* kc = qc + 4096;
    LAS float* vc = kc + 4096;
    LAS float* os = vc + 1024;
    LAS float* ba = os + 1024;
    const int dg = F.lane & 15, el = F.wave * 4 + (F.lane >> 4);
    for (int it = F.bid; it < 256; it += F.G) {
        const int b = it >> 5, h = (it >> 3) & 3, dir = (it >> 2) & 1, sl = it & 3;
        bf16_t* O = dir ? (bf16_t*)(F.ws + WS_WMOE) : (bf16_t*)(F.ws + WS_GOF);
        const float a_neg = -__expf(P.in[I_ALOG][dir * 4 + h]), dtb = P.in[I_DTB][dir * 4 + h];
        float cwq[5], cwk[5], cwv[5];
        { const int d = F.tid & 127;
#pragma unroll
          for (int j = 0; j < 5; ++j) { cwq[j] = P.in[I_CONVW][j * 1536 + h * 128 + d]; cwk[j] = P.in[I_CONVW][j * 1536 + 512 + h * 128 + d]; cwv[j] = P.in[I_CONVW][j * 1536 + 1024 + h * 128 + sl * 32 + (F.tid & 31)]; } }
        float S[8];
#pragma unroll
        for (int i = 0; i < 8; ++i) S[i] = 0.f;
        u32x4 pr0, pr1, pr2; float pbeta = 0.f, pdec = 0.f;
        auto blk_geom = [&](int bi, int& len, size_t& rbase, int& p0) { const bool c = bi < 8; len = c ? CTXL : SEQ; rbase = c ? (size_t)TL + b * CTXL : (size_t)b * SEQ;
            const int nbk = len / 32, k = c ? bi : bi - 8; p0 = (dir ? (nbk - 1 - k) : k) * 32; };
        auto fetch = [&](int bi, int id) -> u32x4 { int len, p0; size_t rbase; blk_geom(bi, len, rbase, p0);
            u32x4 z = {0u, 0u, 0u, 0u}; if (id >= 1296) return z;
            int arr = 0, j = id; if (j >= 1152) { arr = 2; j -= 1152; } else if (j >= 576) { arr = 1; j -= 576; }
            const int rr = arr == 2 ? (j >> 2) : (j >> 4), part = arr == 2 ? (j & 3) : (j & 15); const int p = p0 - 2 + rr;
            if (p < 0 || p >= len) return z;
            const bf16_t* row = PX + (rbase + p) * ODD_PAD + (arr == 0 ? h * 128 : (arr == 1 ? 512 + h * 128 : 1024 + h * 128 + sl * 32)) + part * 8;
            return *(const u32x4*)row; };
        auto stash = [&](int id, u32x4 w) { if (id >= 1296) return; int arr = 0, j = id; if (j >= 1152) { arr = 2; j -= 1152; } else if (j >= 576) { arr = 1; j -= 576; }
            LAS bf16_t* d = arr == 0 ? rq + j * 8 : (arr == 1 ? rk + j * 8 : rv + j * 8); *(LAS u32x4*)d = w; };
        auto fetch_all = [&](int bi) { pr0 = fetch(bi, F.tid); pr1 = fetch(bi, F.tid + 512); pr2 = fetch(bi, F.tid + 1024);
            if (F.tid < 32) { int len, p0; size_t rbase; blk_geom(bi, len, rbase, p0); const bf16_t* row = PX + (rbase + p0 + F.tid) * ODD_PAD;
                pbeta = bf2f(row[2048 + dir * 4 + h]); pdec = bf2f(row[2056 + dir * 4 + h]); } };
        fetch_all(0);
        for (int bi = 0; bi < 264; ++bi) {
            __syncthreads();
            stash(F.tid, pr0); stash(F.tid + 512, pr1); stash(F.tid + 1024, pr2);
            if (F.tid < 32) { ba[F.tid] = sigmoid_f(pbeta); ba[32 + F.tid] = __expf(a_neg * softplus_f(pdec + dtb)); }
            __syncthreads();
            if (bi + 1 < 264) fetch_all(bi + 1);
            { const int d = F.tid & 127;
#pragma unroll
              for (int i = 0; i < 8; ++i) { const int s = (F.tid >> 7) + i * 4; float a = 0.f, c = 0.f;
#pragma unroll
                for (int j = 0; j < 5; ++j) { a += bf2f(rq[(s + j) * 128 + d]) * cwq[j]; c += bf2f(rk[(s + j) * 128 + d]) * cwk[j]; }
                qc[s * 128 + d] = silu_f(a); kc[s * 128 + d] = silu_f(c); }
#pragma unroll
              for (int i = 0; i < 2; ++i) { const int s = (F.tid >> 5) + i * 16, e = F.tid & 31; float a = 0.f;
#pragma unroll
                for (int j = 0; j < 5; ++j) a += bf2f(rv[(s + j) * 32 + e]) * cwv[j];
                vc[s * 32 + e] = silu_f(a); } }
            __syncthreads();
            { const int s = F.wave * 4 + (F.lane >> 4);
              LAS float* qp = qc + s * 128 + dg * 8; LAS float* kp = kc + s * 128 + dg * 8;
              f32x4 q0 = *(LAS f32x4*)qp, q1 = *(LAS f32x4*)(qp + 4), k0 = *(LAS f32x4*)kp, k1 = *(LAS f32x4*)(kp + 4);
              float sq = 0.f, sk = 0.f;
#pragma unroll
              for (int i = 0; i < 4; ++i) { sq += q0[i] * q0[i] + q1[i] * q1[i]; sk += k0[i] * k0[i] + k1[i] * k1[i]; }
              sq = sum16(sq); sk = sum16(sk);
              const float rq_ = rsqrtf(sq + EPS) * 0.08838834764831845f, rk_ = rsqrtf(sk + EPS);
              *(LAS f32x4*)qp = q0 * rq_; *(LAS f32x4*)(qp + 4) = q1 * rq_; *(LAS f32x4*)kp = k0 * rk_; *(LAS f32x4*)(kp + 4) = k1 * rk_; }
            __syncthreads();
#pragma unroll 2
            for (int ss = 0; ss < 32; ++ss) {
                const int st = dir ? 31 - ss : ss;
                const f32x4 ka = *(const LAS f32x4*)(kc + st * 128 + dg * 8), kb = *(const LAS f32x4*)(kc + st * 128 + dg * 8 + 4);
                const f32x4 qa = *(const LAS f32x4*)(qc + st * 128 + dg * 8), qb = *(const LAS f32x4*)(qc + st * 128 + dg * 8 + 4);
                const float v = vc[st * 32 + el], beta = ba[st], a = ba[32 + st];
                float r0 = 0.f, r1 = 0.f;
#pragma unroll
                for (int i = 0; i < 4; ++i) { r0 += ka[i] * S[i]; r1 += kb[i] * S[4 + i]; }
                const float r = sum16(r0 + r1);
                const float u = beta * (v - a * r);
                float p0 = 0.f, p1 = 0.f;
#pragma unroll
                for (int i = 0; i < 4; ++i) { S[i] = a * S[i] + ka[i] * u; p0 += qa[i] * S[i]; S[4 + i] = a * S[4 + i] + kb[i] * u; p1 += qb[i] * S[4 + i]; }
                const float o = sum16(p0 + p1);
                if (dg == 0) os[st * 32 + el] = o;
            }
            __syncthreads();
            { int len, p0; size_t rbase; blk_geom(bi, len, rbase, p0);
              const int s = F.tid >> 4, e2 = (F.tid & 15) * 2;
              *(unsigned*)(O + (rbase + p0 + s) * 512 + h * 128 + sl * 32 + e2) = pack2(os[s * 32 + e2], os[s * 32 + e2 + 1]); }
        }
        __syncthreads();
    }
}

constexpr int GR_KN = 0, GR_QN = 16384, GR_VT = 32768, GR_T = 49152, GR_QK = 65536, GR_SC = 81920, GR_BYTES = 83968;
__device__ __forceinline__ s16x8 pack8(const f32x16& x, int s8) {
    u32x4 p; p.x = pack2(x[s8 + 0], x[s8 + 1]); p.y = pack2(x[s8 + 2], x[s8 + 3]); p.z = pack2(x[s8 + 4], x[s8 + 5]); p.w = pack2(x[s8 + 6], x[s8 + 7]);
    return __builtin_bit_cast(s16x8, p);
}
__device__ __forceinline__ s16x8 ld2x64(const LAS unsigned char* p) {
    const u32x2 a = *(const LAS u32x2*)p, b = *(const LAS u32x2*)(p + 16); u32x4 v; v.x = a.x; v.y = a.y; v.z = b.x; v.w = b.y; return __builtin_bit_cast(s16x8, v);
}
__device__ __forceinline__ void st2x64(LAS unsigned char* p, u32x4 v) { u32x2 a, b; a.x = v.x; a.y = v.y; b.x = v.z; b.y = v.w; *(LAS u32x2*)p = a; *(LAS u32x2*)(p + 8) = b; }
__device__ __forceinline__ u32x4 ld2x64n(const LAS unsigned char* p) { const u32x2 a = *(const LAS u32x2*)p, b = *(const LAS u32x2*)(p + 8); u32x4 v; v.x = a.x; v.y = a.y; v.z = b.x; v.w = b.y; return v; }
__device__ __forceinline__ void gdn_unit_geom(int b, int ck, size_t& rbase, int& len, int& p0) {
    if (ck < 4) { rbase = (size_t)TL + b * CTXL; len = CTXL; p0 = ck * 64; } else { rbase = (size_t)b * SEQ; len = SEQ; p0 = (ck - 4) * 64; }
}
__device__ __forceinline__ void ph_gdn_prep(const Frame& F) {
    const Params& P = *F.P;
    const bf16_t* PX = (const bf16_t*)(F.ws + WS_PX);
    LAS unsigned char* L = F.lds;
    LAS bf16_t* RAW = (LAS bf16_t*)L;
    LAS unsigned char* KNI = L; LAS unsigned char* QNI = L + 16896;
    LAS float* qf = (LAS float*)(L + 52224);
    LAS float* kf = qf + 8192;
    LAS unsigned char* VTI = L + 52224 + 65536;
    LAS float* SCL = (LAS float*)(L + 52224 + 65536 + 17408);
    const int l31 = F.lane & 31, hh = F.lane >> 5;
    for (int u = F.bid; u < 4224; u += F.G) {
        const int b = u / 528, h = (u % 528) / 132, ck = u % 132;
        size_t rbase; int len, p0; gdn_unit_geom(b, ck, rbase, len, p0);
        unsigned char* rec = F.ws + WS_GREC + (size_t)u * GR_BYTES;
        for (int c = F.tid; c < 68 * 48; c += NTH) { const int rr = c / 48, part = c % 48; const int p = p0 - 2 + rr; u32x4 w = {0u, 0u, 0u, 0u};
            if (p >= 0 && p < len) w = *(const u32x4*)(PX + (rbase + p) * ODD_PAD + (part >> 4) * 512 + h * 128 + (part & 15) * 8);
            *(LAS u32x4*)(RAW + rr * 384 + part * 8) = w; }
        if (F.tid < 64) { const bf16_t* row = PX + (rbase + p0 + F.tid) * ODD_PAD;
            const float an_f = -__expf(P.in[I_ALOG][h]), an_b = -__expf(P.in[I_ALOG][4 + h]);
            SCL[256 + F.tid] = sigmoid_f(bf2f(row[2048 + h])); SCL[320 + F.tid] = sigmoid_f(bf2f(row[2052 + h]));
            SCL[F.tid] = an_f * softplus_f(bf2f(row[2056 + h]) + P.in[I_DTB][h]); SCL[64 + F.tid] = an_b * softplus_f(bf2f(row[2060 + h]) + P.in[I_DTB][4 + h]); }
        __syncthreads();
        { const int d = F.tid & 127, rg = F.tid >> 7;
          float cq[5], ckk[5], cv[5];
#pragma unroll
          for (int j = 0; j < 5; ++j) { cq[j] = P.in[I_CONVW][j * 1536 + h * 128 + d]; ckk[j] = P.in[I_CONVW][j * 1536 + 512 + h * 128 + d]; cv[j] = P.in[I_CONVW][j * 1536 + 1024 + h * 128 + d]; }
#pragma unroll 4
          for (int ii = 0; ii < 16; ++ii) { const int i = rg * 16 + ii; float a = 0.f, c = 0.f, e = 0.f;
#pragma unroll
              for (int j = 0; j < 5; ++j) { const LAS bf16_t* rr = RAW + (i + j) * 384 + d; a += bf2f(rr[0]) * cq[j]; c += bf2f(rr[128]) * ckk[j]; e += bf2f(rr[256]) * cv[j]; }
              qf[i * 128 + d] = silu_f(a); kf[i * 128 + d] = silu_f(c);
              *(LAS bf16_t*)(VTI + d * 136 + i * 2) = f2bf(silu_f(e)); } }
        if (F.tid < 64) { float gf = 0.f, gb = 0.f;
            for (int j = 0; j < 64; ++j) { gf += (j <= F.tid) ? SCL[j] : 0.f; gb += (j >= F.tid) ? SCL[64 + j] : 0.f; }
            SCL[128 + F.tid] = gf; SCL[192 + F.tid] = gb; }
        __syncthreads();
#pragma unroll
        for (int rr = 0; rr < 8; ++rr) { const int i = F.wave * 8 + rr;
            const float q0 = qf[i * 128 + F.lane], q1 = qf[i * 128 + 64 + F.lane], k0 = kf[i * 128 + F.lane], k1 = kf[i * 128 + 64 + F.lane];
            const float sq = wave_sum(q0 * q0 + q1 * q1), sk = wave_sum(k0 * k0 + k1 * k1);
            const float rq_ = rsqrtf(sq + EPS) * 0.08838834764831845f, rk_ = rsqrtf(sk + EPS);
            *(LAS bf16_t*)(QNI + i * 264 + F.lane * 2) = f2bf(q0 * rq_); *(LAS bf16_t*)(QNI + i * 264 + 128 + F.lane * 2) = f2bf(q1 * rq_);
            *(LAS bf16_t*)(KNI + i * 264 + F.lane * 2) = f2bf(k0 * rk_); *(LAS bf16_t*)(KNI + i * 264 + 128 + F.lane * 2) = f2bf(k1 * rk_); }
        __syncthreads();
        { const int mq = F.wave >> 2, ib = (F.wave >> 1) & 1, jb = F.wave & 1;
          const LAS unsigned char* Ai = (mq ? QNI : KNI) + (32 * ib + l31) * 264 + hh * 16; const LAS unsigned char* Bi = KNI + (32 * jb + l31) * 264 + hh * 16;
          f32x16 acc;
#pragma unroll
          for (int r = 0; r < 16; ++r) acc[r] = 0.f;
#pragma unroll
          for (int ds = 0; ds < 8; ++ds) acc = __builtin_amdgcn_mfma_f32_32x32x16_bf16(__builtin_bit_cast(s16x8, ld2x64n(Ai + ds * 32)), __builtin_bit_cast(s16x8, ld2x64n(Bi + ds * 32)), acc, 0, 0, 0);
          __syncthreads();
          const int j = 32 * jb + l31; const float gfj = SCL[128 + j], gbj = SCL[192 + j];
          bf16_t* qkf = (bf16_t*)(rec + GR_QK); bf16_t* qkb = qkf + 4096;
#pragma unroll
          for (int r = 0; r < 16; ++r) { const int i = 32 * ib + (r & 3) + 8 * (r >> 2) + 4 * hh;
              const float ef = __expf(fminf(SCL[128 + i] - gfj, 0.f)), eb = __expf(fminf(SCL[192 + i] - gbj, 0.f));
              if (mq == 0) { qf[i * 64 + j] = (j < i) ? SCL[256 + i] * acc[r] * ef : 0.f; kf[(63 - i) * 64 + (63 - j)] = (j > i) ? SCL[320 + i] * acc[r] * eb : 0.f; }
              else { qkf[i * 64 + j] = f2bf((j <= i) ? acc[r] * ef : 0.f); qkb[i * 64 + j] = f2bf((j >= i) ? acc[r] * eb : 0.f); } } }
        __syncthreads();
        if (F.wave < 2) {
            const LAS float* Am = F.wave == 0 ? qf : kf; LAS float* Tl = (F.wave == 0 ? qf : kf) + 4096; const int c = F.lane;
            for (int i = 0; i < 64; ++i) Tl[i * 64 + c] = 0.f;
#pragma unroll
            for (int rb = 0; rb < 4; ++rb) {
#pragma unroll 1
                for (int ii = 0; ii < 16; ++ii) { const int i = rb * 16 + ii; float a0 = (c == i) ? 1.f : 0.f, a1 = 0.f;
#pragma unroll
                    for (int jg = 0; jg < 4 * (rb + 1); ++jg) { const f32x4 m = *(const LAS f32x4*)(Am + i * 64 + jg * 4);
                        a0 -= m[0] * Tl[(jg * 4 + 0) * 64 + c]; a1 -= m[1] * Tl[(jg * 4 + 1) * 64 + c]; a0 -= m[2] * Tl[(jg * 4 + 2) * 64 + c]; a1 -= m[3] * Tl[(jg * 4 + 3) * 64 + c]; }
                    Tl[i * 64 + c] = a0 + a1; } }
            bf16_t* Tg = (bf16_t*)(rec + GR_T) + (F.wave ? 4096 : 0);
            for (int i = 0; i < 64; ++i) { const bf16_t v = f2bf(Tl[i * 64 + c]); if (F.wave == 0) Tg[i * 64 + c] = v; else Tg[(63 - i) * 64 + (63 - c)] = v; }
        } else {
            const int t6 = F.tid - 128;
            for (int c = t6; c < 3072; c += 384) {
                u32x4 w; if (c < 2048) { const int cc = c & 1023, row = cc >> 4, part = cc & 15; w = ld2x64n((c < 1024 ? KNI : QNI) + row * 264 + part * 16); }
                else { const int cc = c - 2048, row = cc >> 3, part = cc & 7; w = ld2x64n(VTI + row * 136 + part * 16); }
                *(u32x4*)(rec + (size_t)c * 16) = w; }
            if (t6 < 64) { float* sc = (float*)(rec + GR_SC); const int i = t6;
                const float gf = SCL[128 + i], gb = SCL[192 + i], glf = SCL[128 + 63], glb = SCL[192 + 0];
                sc[i] = SCL[256 + i]; sc[64 + i] = __expf(gf); sc[128 + i] = __expf(glf - gf);
                sc[192 + i] = SCL[320 + i]; sc[256 + i] = __expf(gb); sc[320 + i] = __expf(glb - gb);
                if (i == 0) { sc[384] = __expf(glf); sc[385] = __expf(glb); } }
        }
        __syncthreads();
    }
}

__device__ __forceinline__ void ph_gdn_scan(const Frame& F) {
    LAS unsigned char* L = F.lds;
    LAS unsigned char* KNI = L;
    LAS unsigned char* QNI = L + 16896;
    LAS unsigned char* VTI = L + 33792;
    LAS unsigned char* KTI = L + 51200;
    LAS unsigned char* TI = L + 68608;
    LAS unsigned char* QKI = L + 77312;
    LAS float* SC = (LAS float*)(L + 86016);
    const int l31 = F.lane & 31, hh = F.lane >> 5, w = F.wave;
    for (int it = F.bid; it < 64; it += F.G) {
        const int b = it >> 3, h = (it >> 1) & 3, dir = it & 1;
        bf16_t* O = dir ? (bf16_t*)(F.ws + WS_WMOE) : (bf16_t*)(F.ws + WS_GOF);
        f32x16 S0, S1, S2, S3;
#pragma unroll
        for (int r = 0; r < 16; ++r) { S0[r] = 0.f; S1[r] = 0.f; S2[r] = 0.f; S3[r] = 0.f; }
        u32x4 pre[16]; float psc = 0.f;
        const int t4 = F.tid - 256;
        auto ckof = [&](int n) -> int { return dir ? (n < 4 ? 3 - n : 135 - n) : n; };
        auto fetch = [&](int n) { const unsigned char* rec = F.ws + WS_GREC + (size_t)((b * 4 + h) * 132 + ckof(n)) * GR_BYTES;
#pragma unroll
            for (int k = 0; k < 12; ++k) pre[k] = *(const u32x4*)(rec + (size_t)(t4 + 256 * k) * 16);
#pragma unroll
            for (int k = 0; k < 2; ++k) { pre[12 + k] = *(const u32x4*)(rec + GR_T + dir * 8192 + (t4 + 256 * k) * 16); pre[14 + k] = *(const u32x4*)(rec + GR_QK + dir * 8192 + (t4 + 256 * k) * 16); }
            if (t4 < 193) psc = ((const float*)(rec + GR_SC))[t4 < 192 ? dir * 192 + t4 : 384 + dir]; };
        if (w >= 4) {
            fetch(0);
            for (int n = 0; n < 132; ++n) {
                __syncthreads();
#pragma unroll
                for (int k = 0; k < 4; ++k) { const int c = t4 + 256 * k, row = c >> 4, part = c & 15; st2x64(KNI + row * 264 + part * 16, pre[k]);
                    LAS unsigned short* kt = (LAS unsigned short*)(KTI + (part * 8) * 136 + row * 2); const u32x4 v = pre[k];
                    kt[0 * 68] = (unsigned short)(v.x & 0xffffu); kt[1 * 68] = (unsigned short)(v.x >> 16); kt[2 * 68] = (unsigned short)(v.y & 0xffffu); kt[3 * 68] = (unsigned short)(v.y >> 16);
                    kt[4 * 68] = (unsigned short)(v.z & 0xffffu); kt[5 * 68] = (unsigned short)(v.z >> 16); kt[6 * 68] = (unsigned short)(v.w & 0xffffu); kt[7 * 68] = (unsigned short)(v.w >> 16); }
#pragma unroll
                for (int k = 4; k < 8; ++k) { const int c = t4 + 256 * (k - 4), row = c >> 4, part = c & 15; st2x64(QNI + row * 264 + part * 16, pre[k]); }
#pragma unroll
                for (int k = 8; k < 12; ++k) { const int c = t4 + 256 * (k - 8), row = c >> 3, part = c & 7; st2x64(VTI + row * 136 + part * 16, pre[k]); }
#pragma unroll
                for (int k = 0; k < 2; ++k) { const int c = t4 + 256 * k, row = c >> 3, part = c & 7; st2x64(TI + row * 136 + part * 16, pre[12 + k]); st2x64(QKI + row * 136 + part * 16, pre[14 + k]); }
                if (t4 < 193) SC[t4] = psc;
                __syncthreads();
                if (n + 1 < 132) fetch(n + 1);
            }
        } else
        for (int n = 0; n < 132; ++n) {
            __syncthreads();
            __syncthreads();
            {
                size_t rbase; int len, p0; gdn_unit_geom(b, ckof(n), rbase, len, p0);
                const float alast = SC[192];
                f32x16 P0, P1;
#pragma unroll
                for (int r = 0; r < 16; ++r) { P0[r] = 0.f; P1[r] = 0.f; }
#pragma unroll
                for (int hq = 0; hq < 2; ++hq) { s16x8 fa[4], fb[4];
#pragma unroll
                  for (int q4 = 0; q4 < 4; ++q4) { const int q = hq * 4 + q4; const int co = (32 * (q >> 1) + 16 * (q & 1) + 4 * hh) * 2; fa[q4] = ld2x64(KNI + l31 * 264 + co); fb[q4] = ld2x64(KNI + (32 + l31) * 264 + co); }
#pragma unroll
                  for (int q4 = 0; q4 < 4; ++q4) { const int q = hq * 4 + q4; const int r = q >> 1; const s16x8 sb = pack8(r == 0 ? S0 : (r == 1 ? S1 : (r == 2 ? S2 : S3)), 8 * (q & 1));
                      P0 = __builtin_amdgcn_mfma_f32_32x32x16_bf16(fa[q4], sb, P0, 0, 0, 0); P1 = __builtin_amdgcn_mfma_f32_32x32x16_bf16(fb[q4], sb, P1, 0, 0, 0); } }
#pragma unroll
                for (int gq = 0; gq < 4; ++gq) {
#pragma unroll
                    for (int ib = 0; ib < 2; ++ib) { const int i0 = 32 * ib + 8 * gq + 4 * hh;
                        const f32x4 be = *(const LAS f32x4*)(SC + i0), eg = *(const LAS f32x4*)(SC + 64 + i0);
                        const u32x2 vv = *(const LAS u32x2*)(VTI + (32 * w + l31) * 136 + i0 * 2);
                        const float v0 = lo2f(vv.x), v1 = hi2f(vv.x), v2 = lo2f(vv.y), v3 = hi2f(vv.y);
                        if (ib == 0) { P0[4 * gq + 0] = be[0] * (v0 - eg[0] * P0[4 * gq + 0]); P0[4 * gq + 1] = be[1] * (v1 - eg[1] * P0[4 * gq + 1]); P0[4 * gq + 2] = be[2] * (v2 - eg[2] * P0[4 * gq + 2]); P0[4 * gq + 3] = be[3] * (v3 - eg[3] * P0[4 * gq + 3]); }
                        else         { P1[4 * gq + 0] = be[0] * (v0 - eg[0] * P1[4 * gq + 0]); P1[4 * gq + 1] = be[1] * (v1 - eg[1] * P1[4 * gq + 1]); P1[4 * gq + 2] = be[2] * (v2 - eg[2] * P1[4 * gq + 2]); P1[4 * gq + 3] = be[3] * (v3 - eg[3] * P1[4 * gq + 3]); } } }
                f32x16 V0, V1;
#pragma unroll
                for (int r = 0; r < 16; ++r) { V0[r] = 0.f; V1[r] = 0.f; }
#pragma unroll
                for (int jb = 0; jb < 2; ++jb)
#pragma unroll
                    for (int s = 0; s < 2; ++s) { const s16x8 pb = pack8(jb == 0 ? P0 : P1, 8 * s); const int co = (32 * jb + 16 * s + 4 * hh) * 2;
                        V0 = __builtin_amdgcn_mfma_f32_32x32x16_bf16(ld2x64(TI + l31 * 136 + co), pb, V0, 0, 0, 0);
                        V1 = __builtin_amdgcn_mfma_f32_32x32x16_bf16(ld2x64(TI + (32 + l31) * 136 + co), pb, V1, 0, 0, 0); }
                f32x16 T0, T1;
#pragma unroll
                for (int r = 0; r < 16; ++r) { T0[r] = 0.f; T1[r] = 0.f; }
#pragma unroll
                for (int r = 0; r < 4; ++r)
#pragma unroll
                    for (int s = 0; s < 2; ++s) { const s16x8 sa = pack8(r == 0 ? S0 : (r == 1 ? S1 : (r == 2 ? S2 : S3)), 8 * s);
                        const int co = (32 * r + 16 * s + 4 * hh) * 2;
                        T0 = __builtin_amdgcn_mfma_f32_32x32x16_bf16(sa, ld2x64(QNI + l31 * 264 + co), T0, 0, 0, 0);
                        T1 = __builtin_amdgcn_mfma_f32_32x32x16_bf16(sa, ld2x64(QNI + (32 + l31) * 264 + co), T1, 0, 0, 0); }
                { const float e0 = SC[64 + l31], e1 = SC[64 + 32 + l31];
#pragma unroll
                  for (int r = 0; r < 16; ++r) { T0[r] *= e0; T1[r] *= e1; } }
#pragma unroll
                for (int jb = 0; jb < 2; ++jb)
#pragma unroll
                    for (int s = 0; s < 2; ++s) { const s16x8 va = pack8(jb == 0 ? V0 : V1, 8 * s); const int co = (32 * jb + 16 * s + 4 * hh) * 2;
                        T0 = __builtin_amdgcn_mfma_f32_32x32x16_bf16(va, ld2x64(QKI + l31 * 136 + co), T0, 0, 0, 0);
                        T1 = __builtin_amdgcn_mfma_f32_32x32x16_bf16(va, ld2x64(QKI + (32 + l31) * 136 + co), T1, 0, 0, 0); }
                { bf16_t* o0 = O + (rbase + p0 + l31) * 512 + h * 128 + 32 * w + 4 * hh; bf16_t* o1 = o0 + (size_t)32 * 512;
#pragma unroll
                  for (int gq = 0; gq < 4; ++gq) { u32x2 x; x.x = pack2(T0[4 * gq], T0[4 * gq + 1]); x.y = pack2(T0[4 * gq + 2], T0[4 * gq + 3]); *(u32x2*)(o0 + gq * 8) = x;
                      x.x = pack2(T1[4 * gq], T1[4 * gq + 1]); x.y = pack2(T1[4 * gq + 2], T1[4 * gq + 3]); *(u32x2*)(o1 + gq * 8) = x; } }
#pragma unroll
                for (int gq = 0; gq < 4; ++gq) { const f32x4 c0 = *(const LAS f32x4*)(SC + 128 + 8 * gq + 4 * hh), c1 = *(const LAS f32x4*)(SC + 128 + 32 + 8 * gq + 4 * hh);
#pragma unroll
                    for (int q = 0; q < 4; ++q) { V0[4 * gq + q] *= c0[q]; V1[4 * gq + q] *= c1[q]; } }
#pragma unroll
                for (int r = 0; r < 16; ++r) { S0[r] *= alast; S1[r] *= alast; S2[r] *= alast; S3[r] *= alast; }
#pragma unroll
                for (int hq = 0; hq < 2; ++hq) { s16x8 fk[8];
#pragma unroll
                  for (int q2 = 0; q2 < 2; ++q2) { const int q = hq * 2 + q2; const int co = (32 * (q >> 1) + 16 * (q & 1) + 4 * hh) * 2;
#pragma unroll
                      for (int r = 0; r < 4; ++r) fk[q2 * 4 + r] = ld2x64(KTI + (32 * r + l31) * 136 + co); }
#pragma unroll
                  for (int q2 = 0; q2 < 2; ++q2) { const int q = hq * 2 + q2; const s16x8 vb = pack8((q >> 1) == 0 ? V0 : V1, 8 * (q & 1));
                      S0 = __builtin_amdgcn_mfma_f32_32x32x16_bf16(fk[q2 * 4 + 0], vb, S0, 0, 0, 0); S1 = __builtin_amdgcn_mfma_f32_32x32x16_bf16(fk[q2 * 4 + 1], vb, S1, 0, 0, 0);
                      S2 = __builtin_amdgcn_mfma_f32_32x32x16_bf16(fk[q2 * 4 + 2], vb, S2, 0, 0, 0); S3 = __builtin_amdgcn_mfma_f32_32x32x16_bf16(fk[q2 * 4 + 3], vb, S3, 0, 0, 0); } }
            }
        }
        __syncthreads();
    }
}

#ifndef FAST_ATTN
#define FAST_ATTN 1
#endif
constexpr int NPHASES = 27;
__global__ void __launch_bounds__(NTH, 2) fwd(Params P) {
    extern __shared__ __attribute__((aligned(16))) unsigned char lds_raw[];
    Frame F; F.P = &P; F.ws = P.ws; F.lds = (LAS unsigned char*)lds_raw;
    F.tid = threadIdx.x; F.lane = F.tid & 63; F.wave = __builtin_amdgcn_readfirstlane(F.tid >> 6); F.G = gridDim.x; F.bid = blockIdx.x;
    F.mod = (float*)(P.ws + WS_CTRL + C_MOD); F.ctrl = (unsigned*)(P.ws + WS_CTRL);
    volatile LAS unsigned* xbw = (volatile LAS unsigned*)(F.lds + LDS_BYTES - 16);
    if (F.tid < 4) xbw[F.tid] = 0u;
    __syncthreads();
    const int lo = P.ph_lo, hi = P.ph_hi;
    const bool single = (hi - lo) > 1;
    XcdBarrier bar; bar.bar = F.ctrl; bar.x = 0; bar.st = xbw;
    if (single) bar = xcd_barrier_post(F.ctrl, xbw);
#ifndef PH_MASK
#define PH_MASK 0xffffffffu
#endif
#define IN(k) (((PH_MASK >> (k)) & 1u) && lo <= (k) && (k) < hi)
#define SEAM(k) do { if (IN(k) && IN((k) + 1)) xcd_barrier(bar); } while (0)
#ifndef DUP_MASK
#define DUP_MASK 0u
#endif
#define DUP(k) ((DUP_MASK >> (k)) & 1u)
    bf16_t* wsm = (bf16_t*)(P.ws + WS_WSM);
    bf16_t* ACT = (bf16_t*)(P.ws + WS_ACT); bf16_t* PX = (bf16_t*)(P.ws + WS_PX);
    float* XC = (float*)(P.ws + WS_XC);

    if (IN(0)) { ph_prologue(F); if (DUP(0)) { __syncthreads(); conv_moe_weights(F, 0, F.bid, F.G); } xcd_barrier(bar); mod_reduce(F); } SEAM(0);
    if (IN(1)) { ph_rownorm(F, 0, TT, P.in[I_X], P.in[I_CTX], P.in[I_NMIX], 0); if (DUP(1)) ph_rownorm(F, 0, TT, P.in[I_X], P.in[I_CTX], P.in[I_NMIX], 0); } SEAM(1);
    if (IN(2)) { EpiStoreBf16 E{PX, EVEN_IN, 1024}; gemm_dense(F, ACT, wsm + W_EIN / 2, TT, EVEN_IN, 1024, E); if (DUP(2)) gemm_dense(F, ACT, wsm + W_EIN / 2, TT, EVEN_IN, 1024, E); } SEAM(2);
    if (IN(3)) { ph_gmlp(F); if (DUP(3)) { __syncthreads(); ph_gmlp(F); } } SEAM(3);
    if (IN(4)) { ph_gla(F); if (DUP(4)) { __syncthreads(); ph_gla(F); } } SEAM(4);
    if (IN(5)) { ph_merge(F, 0); if (DUP(5)) ph_merge(F, 0); } SEAM(5);
    if (IN(6)) { EpiResidual E{P.in[I_X], P.in[I_CTX], P.out, XC, F.mod, 2}; gemm_dense(F, ACT, wsm + W_EOUT / 2, TT, 1024, 1024, E); } SEAM(6);
    if (IN(7)) { ph_router(F, 0, TT, P.out, XC, P.in[I_NFFN], 3); } SEAM(7);
    if (IN(8)) { ph_dispatch(F, 0, TT); } SEAM(8);
    if (IN(9)) { ph_moe_gemm1(F, 0); if (DUP(9)) ph_moe_gemm1(F, 0); } SEAM(9);
    if (IN(10)) { ph_moe_gemm2(F, 0, 0); } SEAM(10);
    if (IN(11)) { ph_moe_gemm2(F, 0, 1); } SEAM(11);
    if (IN(12)) { ph_rownorm(F, 1, TT, P.out, XC, P.in[I_NMIX] + 1024, 0);
#ifdef DBG_ZERO
        { u32x4 z = {0u, 0u, 0u, 0u}; u32x4* p = (u32x4*)(P.ws + WS_GREC); const size_t n = (size_t)(990 - 585) * MiB / 16;
          for (size_t i = (size_t)F.bid * NTH + F.tid; i < n; i += (size_t)F.G * NTH) p[i] = z;
          u32x4* q = (u32x4*)(P.ws + WS_WMOE); const size_t m = (size_t)66 * MiB / 16;
          for (size_t i = (size_t)F.bid * NTH + F.tid; i < m; i += (size_t)F.G * NTH) q[i] = z; }
#endif
    } SEAM(12);
    if (IN(13)) { EpiStoreBf16 E{PX, ODD_PAD, 0}; gemm_dense(F, ACT, wsm + W_OIN / 2, TT, ODD_PAD, 1024, E); if (DUP(13)) gemm_dense(F, ACT, wsm + W_OIN / 2, TT, ODD_PAD, 1024, E); } SEAM(13);
#ifndef CHUNKED_GDN
#define CHUNKED_GDN 1
#endif
    if (IN(14)) { if (CHUNKED_GDN) ph_gdn_prep(F); } SEAM(14);
    if (IN(15)) { if (CHUNKED_GDN) ph_gdn_scan(F); else ph_gdn(F); } SEAM(15);
    if (IN(16)) { ph_merge(F, 1); } SEAM(16);
    if (IN(17)) { ph_mla_norm(F); } SEAM(17);
    if (IN(18)) { const bf16_t* cqn = (const bf16_t*)(P.ws + WS_R2 + R2_CQN);
                  EpiStoreBf16 E1{(bf16_t*)(P.ws + WS_WMOE), 768, 0}; gemm_dense(F, cqn, wsm + W_WQ / 2, TL, 768, 256, E1);
                  EpiStoreBf16 E2{(bf16_t*)(P.ws + WS_PX + PX_KVRAW), 1024, 0}; gemm_dense(F, cqn + (size_t)TL * 256, wsm + W_WKV / 2, TT, 1024, 256, E2); } SEAM(18);
    if (IN(19)) { ph_mla_final(F); } SEAM(19);
    if (IN(20)) { if (FAST_ATTN) ph_attn(F); else ph_attn_naive(F); if (DUP(20)) { __syncthreads(); ph_attn(F); } } SEAM(20);
    if (IN(21)) { EpiResidual E{P.out, P.out, P.out, P.out, F.mod + 9 * 6144, 2}; gemm_dense(F, ACT, wsm + W_OOUT / 2, TL, 1024, 1024, E); } SEAM(21);
    if (IN(22)) { ph_router(F, 1, TL, P.out, XC, P.in[I_NFFN] + 1024, 3); conv_moe_weights(F, 1, F.bid, F.G); } SEAM(22);
    if (IN(23)) { ph_dispatch(F, 1, TL); } SEAM(23);
    if (IN(24)) { ph_moe_gemm1(F, 1); if (DUP(24)) ph_moe_gemm1(F, 1); } SEAM(24);
    if (IN(25)) { ph_moe_gemm2(F, 1, 0); } SEAM(25);
    if (IN(26)) { ph_moe_gemm2(F, 1, 1); }
#undef IN
#undef SEAM
}

#ifndef N_LAUNCH_MODE
#define N_LAUNCH_MODE 1
#endif
extern "C" void kernel_launch(void* const* d_in, const int* in_sizes, int n_in, void* d_out, int out_size, void* d_ws, size_t ws_size, hipStream_t stream) {
    static int grid = 0;
    if (grid == 0) {
        if (n_in != 34 || out_size != TL * DM || ws_size < WS_END) { fprintf(stderr, "kernel_launch: unexpected shapes (n_in %d out %d ws %zu)\n", n_in, out_size, ws_size); grid = -1; return; }
        int dev = 0, cus = 0;
        if (hipGetDevice(&dev) != hipSuccess || hipDeviceGetAttribute(&cus, hipDeviceAttributeMultiprocessorCount, dev) != hipSuccess) { grid = -1; return; }
        if (hipFuncSetAttribute((const void*)fwd, hipFuncAttributeMaxDynamicSharedMemorySize, LDS_BYTES) != hipSuccess) { fprintf(stderr, "kernel_launch: hipFuncSetAttribute failed\n"); grid = -1; return; }
        int per_cu = 0;
        (void)hipOccupancyMaxActiveBlocksPerMultiprocessor(&per_cu, (const void*)fwd, NTH, LDS_BYTES);
        (void)hipGetLastError();
        if (per_cu < 1) fprintf(stderr, "kernel_launch: occupancy query says %d\n", per_cu);
        grid = cus;
    }
    if (grid < 0) return;
    (void)hipMemsetAsync(d_ws, 0, MiB, stream);
    Params p{};
    for (int i = 0; i < 34; ++i) p.in[i] = (const float*)d_in[i];
    p.out = (float*)d_out; p.ws = (unsigned char*)d_ws;
#if N_LAUNCH_MODE == 1
    p.ph_lo = 0; p.ph_hi = NPHASES;
    hipLaunchKernelGGL(fwd, dim3(grid), dim3(NTH), LDS_BYTES, stream, p);
#else
    for (int k = 0; k < NPHASES; ++k) { p.ph_lo = k; p.ph_hi = k + 1; hipLaunchKernelGGL(fwd, dim3(grid), dim3(NTH), LDS_BYTES, stream, p); }
#endif
}
```

```cpp
#include <hip/hip_runtime.h>
#include <cstdint>
#include <cstdio>

#define LAS __attribute__((address_space(3)))
typedef unsigned short bf16_t;
typedef float f32x4 __attribute__((ext_vector_type(4)));
typedef unsigned u32x4 __attribute__((ext_vector_type(4)));
typedef unsigned u32x2 __attribute__((ext_vector_type(2)));

constexpr int NB = 8, SEQ = 8192, CTXL = 256, DM = 1024;
constexpr int TL = NB * SEQ, TC = NB * CTXL, TT = TL + TC;
constexpr int EVEN_IN = 3584, ODD_IN = 2480, ODD_PAD = 2560;
constexpr int NTH = 512;
constexpr int LDS_BYTES = 144 * 1024;
constexpr int MAXSLOTS = 151552;
constexpr int MAXTILES = 592;
constexpr float EPS = 1e-6f;

constexpr size_t MiB = 1048576;
constexpr size_t WS_CTRL = 0;
constexpr size_t C_MOE = 16384;
constexpr size_t C_MOD = 65536;
constexpr size_t WS_XC = 1 * MiB;
constexpr size_t WS_WSM = 9 * MiB;
constexpr size_t W_EIN = 0, W_EOUT = 7340032, W_OIN = 9437184, W_OOUT = 14680064, W_WQ = 16777216, W_WKV = 17170432, W_RT = 17694720;
constexpr size_t WS_WMOE = 27 * MiB;
constexpr size_t WS_ACT = 123 * MiB;
constexpr size_t WS_PX = 255 * MiB;
constexpr size_t WS_R2 = 717 * MiB;
constexpr size_t WS_END = 1024 * MiB;
constexpr size_t R2_OF0 = 0, R2_OB0 = 66 * MiB;
constexpr size_t R2_H = 0, R2_STOK = 148 * MiB, R2_SW = 149 * MiB, R2_TOKE = 150 * MiB, R2_TOKW = 151 * MiB, R2_TILEE = 152 * MiB;
constexpr size_t R2_K = 0, R2_V = 99 * MiB, R2_OF1 = 165 * MiB, R2_OB1 = 231 * MiB;
constexpr size_t PX_KVRAW = 346030080;
constexpr size_t WS_GREC = 585 * MiB;
constexpr size_t WS_GOF = 924 * MiB;
constexpr size_t R2_CQN = 0;
constexpr size_t R2_MODP = 200 * MiB;

struct Params {
    const float* in[34];
    float* out;
    unsigned char* ws;
    int ph_lo, ph_hi;
};
enum { I_X = 0, I_C, I_CTX, I_CCTX, I_ADAW, I_ADAB, I_NMIX, I_NFFN, I_EWIN, I_EWOUT, I_GNW, I_GWS, I_GBS, I_LB, I_HNW,
       I_OWIN, I_OWOUT, I_CONVW, I_ALOG, I_DTB, I_GDNNW, I_QNW, I_WQ, I_KVNW, I_WKV, I_QKQ, I_QKK, I_RGW, I_RGB, I_REW, I_REB, I_MG, I_MU, I_MD };

__device__ __forceinline__ float bf2f(bf16_t b) { return __uint_as_float(((unsigned)b) << 16); }
__device__ __forceinline__ bf16_t f2bf(float f) { unsigned u = __float_as_uint(f); u += 0x7FFFu + ((u >> 16) & 1u); return (bf16_t)(u >> 16); }
typedef __bf16 bf16_2v __attribute__((ext_vector_type(2)));
typedef float f32_2v __attribute__((ext_vector_type(2)));
__device__ __forceinline__ unsigned pack2(float a, float b) { f32_2v v = {a, b}; bf16_2v r = __builtin_convertvector(v, bf16_2v); return __builtin_bit_cast(unsigned, r); }
__device__ __forceinline__ float lo2f(unsigned u) { return __uint_as_float(u << 16); }
__device__ __forceinline__ float hi2f(unsigned u) { return __uint_as_float(u & 0xffff0000u); }
template <int CTRL> __device__ __forceinline__ float dppf(float x) { return __builtin_bit_cast(float, __builtin_amdgcn_mov_dpp(__builtin_bit_cast(int, x), CTRL, 0xf, 0xf, true)); }
__device__ __forceinline__ float sum8(float v) { v += dppf<0xB1>(v); v += dppf<0x4E>(v); v += dppf<0x141>(v); return v; }
__device__ __forceinline__ float sum16(float v) { v = sum8(v); v += dppf<0x128>(v); return v; }
__device__ __forceinline__ float wave_sum(float v) {
    v = sum16(v);
    auto s = __builtin_amdgcn_permlane16_swap(__float_as_uint(v), __float_as_uint(v), false, false);
    v = __uint_as_float(s[0]) + __uint_as_float(s[1]);
    auto t = __builtin_amdgcn_permlane32_swap(__float_as_uint(v), __float_as_uint(v), false, false);
    return __uint_as_float(t[0]) + __uint_as_float(t[1]);
}
__device__ __forceinline__ unsigned lds_inc(LAS unsigned* p) { return __hip_atomic_fetch_add(p, 1u, __ATOMIC_RELAXED, __HIP_MEMORY_SCOPE_WORKGROUP); }
__device__ __forceinline__ float sigmoid_f(float x) { return 1.f / (1.f + __expf(-x)); }
__device__ __forceinline__ float silu_f(float x) { return x / (1.f + __expf(-x)); }
__device__ __forceinline__ float gelu_tanh_f(float x) {
    const float u = 0.7978845608028654f * (x + 0.044715f * x * x * x);
    const float t = 1.f - 2.f / (__expf(2.f * u) + 1.f);
    return 0.5f * x * (1.f + t);
}
__device__ __forceinline__ float softplus_f(float x) { return x > 20.f ? x : log1pf(__expf(x)); }

#define XB_TMO      128
#define XB_XCNT(j)  (256  + 64 * (j))
#define XB_XSUB(j)  (1280 + 64 * (j))
#define XB_XGEN(j)  (2304 + 64 * (j))
#define XB_TOP      3328
#define XB_TOPGEN   3392
#define XCD_BAR_WORDS 3456
#define XB_SPIN_CAP (1u << 24)
__device__ __forceinline__ unsigned xb_ld(unsigned* p)              { return __hip_atomic_load(p, __ATOMIC_RELAXED, __HIP_MEMORY_SCOPE_AGENT); }
__device__ __forceinline__ unsigned xb_add(unsigned* p, unsigned v) { return __hip_atomic_fetch_add(p, v, __ATOMIC_RELAXED, __HIP_MEMORY_SCOPE_AGENT); }
__device__ __forceinline__ unsigned xb_xcc_id() { return (unsigned)__builtin_amdgcn_s_getreg((3 << 11) | 20) & 0xFu; }
#define XB_SPIN(cond, bar) do { unsigned _sp = 0; while (cond) { __builtin_amdgcn_s_sleep(1); \
    if ((++_sp & 255u) == 0u) { if (xb_ld(&(bar)[XB_TMO])) break; if (_sp > XB_SPIN_CAP) { atomicAdd(&(bar)[XB_TMO], 1u); break; } } } } while (0)
struct XcdBarrier { unsigned* bar; unsigned x; volatile LAS unsigned* st; };
__device__ __forceinline__ XcdBarrier xcd_barrier_post(unsigned* bar, volatile LAS unsigned* st) {
    XcdBarrier b; b.bar = bar; b.x = xb_xcc_id(); b.st = st;
    if (threadIdx.x == 0) (void)xb_add(&bar[XB_XCNT(b.x)], 1u);
    return b;
}
__device__ __forceinline__ void xcd_barrier_complete(unsigned* bar, unsigned x, unsigned& nloc, unsigned& nx) {
    const unsigned G = gridDim.x * gridDim.y * gridDim.z;
    unsigned sum, cnt, mine, sp = 0u;
    for (;;) {
        sum = 0u; cnt = 0u; mine = 0u;
#pragma unroll
        for (unsigned j = 0; j < 16; ++j) { const unsigned c = xb_ld(&bar[XB_XCNT(j)]); sum += c; cnt += (c > 0u) ? 1u : 0u; mine = (j == x) ? c : mine; }
        if (sum == G) break;
        __builtin_amdgcn_s_sleep(1);
        if ((++sp & 255u) == 0u) { if (xb_ld(&bar[XB_TMO])) break; if (sp > XB_SPIN_CAP) { atomicAdd(&bar[XB_TMO], 1u); break; } }
    }
    nloc = mine > 0u ? mine : 1u; nx = cnt > 0u ? cnt : 1u;
}
__device__ __forceinline__ void xcd_barrier(const XcdBarrier& b) {
    asm volatile("s_waitcnt vmcnt(0)" ::: "memory");
    __syncthreads();
    if (threadIdx.x == 0) {
        unsigned* bar = b.bar;
        __builtin_amdgcn_s_waitcnt(0);
        unsigned nloc = b.st[0], nx = b.st[1];
        if (nloc == 0u) { xcd_barrier_complete(bar, b.x, nloc, nx); b.st[0] = nloc; b.st[1] = nx; }
        const unsigned old = xb_add(&bar[XB_XSUB(b.x)], 1u);
        const unsigned gen = old / nloc;
        if (old + 1u == (gen + 1u) * nloc) {
            __builtin_amdgcn_fence(__ATOMIC_RELEASE, "agent");
            asm volatile("s_waitcnt vmcnt(0)" ::: "memory");
            const unsigned og = xb_add(&bar[XB_TOP], 1u);
            const unsigned tg = og / nx;
            if (og + 1u == (tg + 1u) * nx) xb_add(&bar[XB_TOPGEN], 1u);
            else XB_SPIN(xb_ld(&bar[XB_TOPGEN]) == tg, bar);
            __builtin_amdgcn_fence(__ATOMIC_ACQUIRE, "agent");
            xb_add(&bar[XB_XGEN(b.x)], 1u);
            asm volatile("s_waitcnt vmcnt(0)" ::: "memory");
        } else {
            XB_SPIN(xb_ld(&bar[XB_XGEN(b.x)]) == gen, bar);
            __builtin_amdgcn_fence(__ATOMIC_ACQUIRE, "agent");
            asm volatile("s_waitcnt vmcnt(0)" ::: "memory");
        }
    }
    __syncthreads();
}

struct Frame {
    const Params* P;
    unsigned char* ws;
    LAS unsigned char* lds;
    int tid, lane, wave, G, bid;
    float* mod;
    unsigned* ctrl;
};
__device__ __forceinline__ const float* modp(const Frame& F, int layer, int b, int which) { return F.mod + ((size_t)(layer * 9 + b) * 6 + which) * 1024; }

__device__ __forceinline__ void conv_tile(const Frame& F, const float* src, int K, int N, int lds_, bf16_t* dst, int ldd, int kt, int nt, int rm_mode) {
    LAS float* tile = (LAS float*)F.lds;
    const int t = F.tid;
    {
        const int c = t & 63, r0 = t >> 6;
#pragma unroll
        for (int i = 0; i < 8; ++i) { const int rr = r0 + i * 8, k = kt * 64 + rr, n = nt * 64 + c;
            tile[rr * 65 + c] = (k < K && n < N) ? src[(size_t)k * lds_ + n] : 0.f; }
    }
    __syncthreads();
    {
        const int nl = t >> 3, kc = (t & 7) * 8, n = nt * 64 + nl;
        int row = n;
        if (rm_mode == 1) row = (n >> 7) * 256 + (n & 127);
        else if (rm_mode == 2) row = (n >> 7) * 256 + 128 + (n & 127);
        float v[8];
#pragma unroll
        for (int j = 0; j < 8; ++j) v[j] = tile[(kc + j) * 65 + nl];
        u32x4 w; w.x = pack2(v[0], v[1]); w.y = pack2(v[2], v[3]); w.z = pack2(v[4], v[5]); w.w = pack2(v[6], v[7]);
        *(u32x4*)(dst + (size_t)row * ldd + kt * 64 + kc) = w;
    }
    __syncthreads();
}
__device__ __forceinline__ void conv_moe_weights(const Frame& F, int layer, int item0, int stride) {
    const Params& P = *F.P;
    bf16_t* W1 = (bf16_t*)(F.ws + WS_WMOE); bf16_t* W2 = W1 + (size_t)32 * 1024 * 1024;
    for (int it = item0; it < 12288; it += stride) {
        if (it < 8192) {
            const int up = it >= 4096, j = it & 4095, e = j >> 7, r = j & 127, kt = r >> 3, nt = r & 7;
            const float* src = P.in[up ? I_MU : I_MG] + ((size_t)(layer * 32 + e)) * 1024 * 512;
            conv_tile(F, src, 1024, 512, 512, W1 + (size_t)e * 1024 * 1024, 1024, kt, nt, up ? 2 : 1);
        } else {
            const int j = it - 8192, e = j >> 7, r = j & 127, kt = r >> 4, nt = r & 15;
            const float* src = P.in[I_MD] + ((size_t)(layer * 32 + e)) * 512 * 1024;
            conv_tile(F, src, 512, 1024, 1024, W2 + (size_t)e * 1024 * 512, 512, kt, nt, 0);
        }
    }
}
__device__ __forceinline__ void mod_reduce(const Frame& F) {
    const float* mp = (const float*)(F.ws + WS_R2 + R2_MODP);
    for (int i = F.bid * NTH + F.tid; i < 18 * 6144; i += F.G * NTH) { float a = F.P->in[I_ADAB][(i / (9 * 6144)) * 6144 + (i % 6144)];
#pragma unroll
        for (int kp = 0; kp < 8; ++kp) a += mp[(size_t)kp * 18 * 6144 + i];
        F.mod[i] = a; }
}
__device__ __forceinline__ void ph_prologue(const Frame& F) {
    const Params& P = *F.P;
    float* modp_ = (float*)(F.ws + WS_R2 + R2_MODP);
    for (int it = F.bid; it < 192; it += F.G) {
        const int l = it / 96, r = it % 96, cb = r >> 3, kp = r & 7;
        LAS float* sc = (LAS float*)F.lds;
        for (int i = F.tid; i < 9 * 128; i += NTH) { const int rr = i >> 7, k = kp * 128 + (i & 127);
            const float cv = rr < 8 ? P.in[I_C][rr * 1024 + k] : P.in[I_CCTX][k]; sc[i] = silu_f(cv); }
        __syncthreads();
        const int n = cb * 512 + F.tid;
        float acc[9];
#pragma unroll
        for (int rr = 0; rr < 9; ++rr) acc[rr] = 0.f;
        const float* w = P.in[I_ADAW] + ((size_t)l * 1024 + kp * 128) * 6144 + n;
#pragma unroll 8
        for (int k = 0; k < 128; ++k) { const float wv = w[(size_t)k * 6144];
#pragma unroll
            for (int rr = 0; rr < 9; ++rr) acc[rr] += sc[rr * 128 + k] * wv; }
#pragma unroll
        for (int rr = 0; rr < 9; ++rr) modp_[((size_t)kp * 18 + l * 9 + rr) * 6144 + n] = acc[rr];
        __syncthreads();
    }
    bf16_t* wsm = (bf16_t*)(F.ws + WS_WSM);
    for (int it = F.bid; it < 2160; it += F.G) {
        int j = it;
        if (j < 896) { conv_tile(F, P.in[I_EWIN], 1024, 3584, 3584, wsm + W_EIN / 2, 1024, j / 56, j % 56, 0); continue; } j -= 896;
        if (j < 256) { conv_tile(F, P.in[I_EWOUT], 1024, 1024, 1024, wsm + W_EOUT / 2, 1024, j >> 4, j & 15, 0); continue; } j -= 256;
        if (j < 640) { conv_tile(F, P.in[I_OWIN], 1024, 2480, 2480, wsm + W_OIN / 2, 1024, j / 40, j % 40, 0); continue; } j -= 640;
        if (j < 256) { conv_tile(F, P.in[I_OWOUT], 1024, 1024, 1024, wsm + W_OOUT / 2, 1024, j >> 4, j & 15, 0); continue; } j -= 256;
        if (j < 48) { conv_tile(F, P.in[I_WQ], 256, 768, 768, wsm + W_WQ / 2, 256, j / 12, j % 12, 0); continue; } j -= 48;
        conv_tile(F, P.in[I_WKV], 128, 1024, 1024, wsm + W_WKV / 2, 256, j >> 4, j & 15, 0);
    }
    for (int i = F.bid * NTH + F.tid; i < 2 * 48 * 1024; i += F.G * NTH) { const int l = i / (48 * 1024), r = i % (48 * 1024), n = r >> 10, k = r & 1023;
        float w = 0.f; if (n < 4) w = P.in[I_RGW][((size_t)l * 1024 + k) * 4 + n]; else if (n < 36) w = P.in[I_REW][((size_t)l * 1024 + k) * 32 + (n - 4)];
        const bf16_t h = f2bf(w); wsm[W_RT / 2 + (size_t)l * 2 * 48 * 1024 + r] = h; wsm[W_RT / 2 + (size_t)l * 2 * 48 * 1024 + 48 * 1024 + r] = f2bf(w - bf2f(h)); }
    conv_moe_weights(F, 0, F.bid, F.G);
}

__device__ __forceinline__ void ph_rownorm(const Frame& F, int layer, int nrows, const float* xlat, const float* xctx, const float* nw, int si) {
    bf16_t* dst = (bf16_t*)(F.ws + WS_ACT);
    for (int r = F.bid * 8 + F.wave; r < nrows; r += F.G * 8) {
        const float* src = r < TL ? xlat + (size_t)r * 1024 : xctx + (size_t)(r - TL) * 1024;
        const int b = r < TL ? (r >> 13) : 8;
        const float* sh = modp(F, layer, b, si); const float* sc = modp(F, layer, b, si + 1);
        f32x4 v[4]; float ss = 0.f;
#pragma unroll
        for (int j = 0; j < 4; ++j) { v[j] = *(const f32x4*)(src + j * 256 + F.lane * 4); ss += v[j][0] * v[j][0] + v[j][1] * v[j][1] + v[j][2] * v[j][2] + v[j][3] * v[j][3]; }
        ss = wave_sum(ss);
        const float rstd = rsqrtf(ss * (1.f / 1024.f) + EPS);
#pragma unroll
        for (int j = 0; j < 4; ++j) { const int c = j * 256 + F.lane * 4;
            const f32x4 w = *(const f32x4*)(nw + c), s1 = *(const f32x4*)(sc + c), s0 = *(const f32x4*)(sh + c);
            v[j] = (v[j] * rstd * w) * (1.f + s1) + s0;
            u32x2 o; o.x = pack2(v[j][0], v[j][1]); o.y = pack2(v[j][2], v[j][3]);
            *(u32x2*)(dst + (size_t)r * 1024 + c) = o; }
    }
}
typedef short s16x8r __attribute__((ext_vector_type(8)));
__device__ __forceinline__ void ph_router(const Frame& F, int layer, int nrows, const float* xlat, const float* xctx, const float* nw, int si) {
    const Params& P = *F.P;
    bf16_t* dst = (bf16_t*)(F.ws + WS_ACT);
    LAS unsigned* hist = (LAS unsigned*)F.lds;
    LAS float* lg = (LAS float*)(F.lds + 256) + F.wave * (16 * 48);
    int* tok_e = (int*)(F.ws + WS_R2 + R2_TOKE); float* tok_w = (float*)(F.ws + WS_R2 + R2_TOKW);
    if (F.tid < 64) hist[F.tid] = 0u;
    __syncthreads();
    { int* stok = (int*)(F.ws + WS_R2 + R2_STOK);
      for (int i = F.bid * NTH + F.tid; i < MAXSLOTS; i += F.G * NTH) stok[i] = -1; }
    const bf16_t* Wh = (const bf16_t*)(F.ws + WS_WSM) + W_RT / 2 + (size_t)layer * 2 * 48 * 1024; const bf16_t* Wl = Wh + 48 * 1024;
    const int lr = F.lane & 15, kq = F.lane >> 4;
    const float* rgb = P.in[I_RGB] + layer * 4; const float* reb = P.in[I_REB] + layer * 32;
    for (int g = F.bid * 8 + F.wave; g < nrows / 16; g += F.G * 8) {
        const int r0 = g * 16;
        const float* src0 = r0 < TL ? xlat + (size_t)r0 * 1024 : xctx + (size_t)(r0 - TL) * 1024;
        const int b = r0 < TL ? (r0 >> 13) : 8;
        const float* sh = modp(F, layer, b, si); const float* sc = modp(F, layer, b, si + 1);
        float myrstd = 0.f;
#pragma unroll 4
        for (int rr = 0; rr < 16; ++rr) { const float* src = src0 + (size_t)rr * 1024; float ss = 0.f;
#pragma unroll
            for (int j = 0; j < 4; ++j) { const f32x4 v = *(const f32x4*)(src + j * 256 + F.lane * 4); ss += v[0] * v[0] + v[1] * v[1] + v[2] * v[2] + v[3] * v[3]; }
            ss = wave_sum(ss);
            const float rs = rsqrtf(ss * (1.f / 1024.f) + EPS); myrstd = (lr == rr) ? rs : myrstd; }
        f32x4 acc[3];
#pragma unroll
        for (int nb = 0; nb < 3; ++nb) acc[nb] = (f32x4){0.f, 0.f, 0.f, 0.f};
        const float* xr = src0 + (size_t)lr * 1024 + kq * 8;
        bf16_t* dr = dst + (size_t)(r0 + lr) * 1024 + kq * 8;
#pragma unroll 2
        for (int ks = 0; ks < 32; ++ks) { const int c = ks * 32 + kq * 8;
            const f32x4 x0 = *(const f32x4*)(xr + ks * 32), x1 = *(const f32x4*)(xr + ks * 32 + 4);
            const f32x4 w0 = *(const f32x4*)(nw + c), w1 = *(const f32x4*)(nw + c + 4), a0 = *(const f32x4*)(sc + c), a1 = *(const f32x4*)(sc + c + 4), b0 = *(const f32x4*)(sh + c), b1 = *(const f32x4*)(sh + c + 4);
            const f32x4 h0 = (x0 * myrstd * w0) * (1.f + a0) + b0, h1 = (x1 * myrstd * w1) * (1.f + a1) + b1;
            u32x4 hi; hi.x = pack2(h0[0], h0[1]); hi.y = pack2(h0[2], h0[3]); hi.z = pack2(h1[0], h1[1]); hi.w = pack2(h1[2], h1[3]);
            *(u32x4*)(dr + ks * 32) = hi;
            u32x4 lo; lo.x = pack2(h0[0] - lo2f(hi.x), h0[1] - hi2f(hi.x)); lo.y = pack2(h0[2] - lo2f(hi.y), h0[3] - hi2f(hi.y));
            lo.z = pack2(h1[0] - lo2f(hi.z), h1[1] - hi2f(hi.z)); lo.w = pack2(h1[2] - lo2f(hi.w), h1[3] - hi2f(hi.w));
            const s16x8r ah = __builtin_bit_cast(s16x8r, hi), al = __builtin_bit_cast(s16x8r, lo);
#pragma unroll
            for (int nb = 0; nb < 3; ++nb) { const s16x8r bh = *(const s16x8r*)(Wh + (size_t)(nb * 16 + lr) * 1024 + c), bl = *(const s16x8r*)(Wl + (size_t)(nb * 16 + lr) * 1024 + c);
                acc[nb] = __builtin_amdgcn_mfma_f32_16x16x32_bf16(ah, bh, acc[nb], 0, 0, 0);
                acc[nb] = __builtin_amdgcn_mfma_f32_16x16x32_bf16(al, bh, acc[nb], 0, 0, 0);
                acc[nb] = __builtin_amdgcn_mfma_f32_16x16x32_bf16(ah, bl, acc[nb], 0, 0, 0); } }
#pragma unroll
        for (int nb = 0; nb < 3; ++nb)
#pragma unroll
            for (int rg = 0; rg < 4; ++rg) lg[(4 * kq + rg) * 48 + nb * 16 + lr] = acc[nb][rg];
        asm volatile("s_waitcnt lgkmcnt(0)" ::: "memory");
        __builtin_amdgcn_wave_barrier();
        if (F.lane < 16) {
            const LAS float* L = lg + F.lane * 48;
            float lgv[4];
#pragma unroll
            for (int i = 0; i < 4; ++i) lgv[i] = L[i] + rgb[i];
            int gi = 0; float best = lgv[0];
#pragma unroll
            for (int i = 1; i < 4; ++i) if (lgv[i] > best) { best = lgv[i]; gi = i; }
            float den = 0.f;
#pragma unroll
            for (int i = 0; i < 4; ++i) den += __expf(lgv[i] - best);
            const float pg = 1.f / den;
            float le[8];
#pragma unroll
            for (int i = 0; i < 8; ++i) le[i] = L[4 + gi * 8 + i] + reb[gi * 8 + i];
            int i1 = 0; float b1 = le[0];
#pragma unroll
            for (int i = 1; i < 8; ++i) if (le[i] > b1) { b1 = le[i]; i1 = i; }
            int i2 = -1; float b2 = -3.0e38f;
#pragma unroll
            for (int i = 0; i < 8; ++i) if (i != i1 && le[i] > b2) { b2 = le[i]; i2 = i; }
            const float e2 = __expf(b2 - b1);
            const float w1 = pg / (1.f + e2), w2 = pg * e2 / (1.f + e2);
            const int e0g = gi * 8 + i1, e1g = gi * 8 + i2; const int r = r0 + F.lane;
            tok_e[r] = e0g | (e1g << 8); tok_w[2 * r] = w1; tok_w[2 * r + 1] = w2;
            lds_inc(&hist[e0g]); lds_inc(&hist[32 + e1g]);
        }
        __builtin_amdgcn_wave_barrier();
    }
    __syncthreads();
    unsigned* cnt = (unsigned*)(F.ws + WS_CTRL + C_MOE + layer * 1024);
    if (F.tid < 64 && hist[F.tid]) atomicAdd(&cnt[F.tid], hist[F.tid]);
    __syncthreads();
}

__device__ __forceinline__ void ph_dispatch(const Frame& F, int layer, int ntok) {
    unsigned* cnt = (unsigned*)(F.ws + WS_CTRL + C_MOE + layer * 1024); unsigned* cursor = cnt + 64; unsigned* info = cnt + 128;
    LAS unsigned* base = (LAS unsigned*)F.lds; LAS unsigned* lh = base + 64; LAS unsigned* gb = base + 128; LAS unsigned* lh2 = base + 192; LAS unsigned* pad = base + 256;
    const int* tok_e = (const int*)(F.ws + WS_R2 + R2_TOKE); const float* tok_w = (const float*)(F.ws + WS_R2 + R2_TOKW);
    int* stok = (int*)(F.ws + WS_R2 + R2_STOK); float* sw = (float*)(F.ws + WS_R2 + R2_SW); int* tile_e = (int*)(F.ws + WS_R2 + R2_TILEE);
    if (F.tid < 64) { pad[F.tid] = (__hip_atomic_load(&cnt[F.tid], __ATOMIC_RELAXED, __HIP_MEMORY_SCOPE_AGENT) + 255u) & ~255u; lh[F.tid] = 0u; lh2[F.tid] = 0u; }
    __syncthreads();
    if (F.tid == 0) { unsigned a = 0; for (int i = 0; i < 64; ++i) { base[i] = a; a += pad[i]; } base[320] = a; }
    __syncthreads();
    if (F.bid == 0) {
        for (int i = F.tid; i < MAXTILES; i += NTH) { const unsigned s = (unsigned)i * 256u; int l = -1;
            for (int j = 0; j < 64; ++j) if (s >= base[j] && s < base[j] + pad[j]) l = j;
            tile_e[i] = l; }
        if (F.tid == 0) { info[0] = base[32] / 256u; info[1] = base[320] / 256u; }
    }
    const int per = (ntok + F.G - 1) / F.G, t0 = F.bid * per, t1 = min(ntok, t0 + per);
    for (int t = t0 + F.tid; t < t1; t += NTH) { const int e = tok_e[t]; lds_inc(&lh[e & 255]); lds_inc(&lh[32 + (e >> 8)]); }
    __syncthreads();
    if (F.tid < 64) gb[F.tid] = lh[F.tid] ? __hip_atomic_fetch_add(&cursor[F.tid], lh[F.tid], __ATOMIC_RELAXED, __HIP_MEMORY_SCOPE_AGENT) : 0u;
    __syncthreads();
    for (int t = t0 + F.tid; t < t1; t += NTH) { const int e = tok_e[t];
        const int l0 = e & 255, l1 = 32 + (e >> 8);
        const unsigned p0 = base[l0] + gb[l0] + lds_inc(&lh2[l0]), p1 = base[l1] + gb[l1] + lds_inc(&lh2[l1]);
        stok[p0] = t; sw[p0] = tok_w[2 * t]; stok[p1] = t; sw[p1] = tok_w[2 * t + 1]; }
    __syncthreads();
}

template <class AF, class EP>
__device__ __forceinline__ void gemm_unit_naive(const Frame& F, int K, const AF& arow, const bf16_t* Bt, const EP& E, int pm, int pn) {
    LAS float* As = (LAS float*)F.lds;
    LAS float* Bs = As + 32 * 132;
    const int t = F.tid, ty = t >> 5, tx = t & 31;
    for (int half = 0; half < 2; ++half) {
        float acc[8][8];
#pragma unroll
        for (int i = 0; i < 8; ++i)
#pragma unroll
            for (int j = 0; j < 8; ++j) acc[i][j] = 0.f;
        const bf16_t* ap = arow(half * 128 + (t >> 2));
        const bf16_t* bp = Bt + (size_t)(t >> 1) * K;
        for (int k0 = 0; k0 < K; k0 += 32) {
            { const int r = t >> 2, kq = (t & 3) * 8; u32x4 w = {0u, 0u, 0u, 0u}; if (ap) w = *(const u32x4*)(ap + k0 + kq);
              As[(kq + 0) * 132 + r] = lo2f(w.x); As[(kq + 1) * 132 + r] = hi2f(w.x); As[(kq + 2) * 132 + r] = lo2f(w.y); As[(kq + 3) * 132 + r] = hi2f(w.y);
              As[(kq + 4) * 132 + r] = lo2f(w.z); As[(kq + 5) * 132 + r] = hi2f(w.z); As[(kq + 6) * 132 + r] = lo2f(w.w); As[(kq + 7) * 132 + r] = hi2f(w.w); }
            { const int n = t >> 1, kh = (t & 1) * 16;
#pragma unroll
              for (int q = 0; q < 2; ++q) { const u32x4 w = *(const u32x4*)(bp + k0 + kh + q * 8); const int kk = kh + q * 8;
                Bs[(kk + 0) * 260 + n] = lo2f(w.x); Bs[(kk + 1) * 260 + n] = hi2f(w.x); Bs[(kk + 2) * 260 + n] = lo2f(w.y); Bs[(kk + 3) * 260 + n] = hi2f(w.y);
                Bs[(kk + 4) * 260 + n] = lo2f(w.z); Bs[(kk + 5) * 260 + n] = hi2f(w.z); Bs[(kk + 6) * 260 + n] = lo2f(w.w); Bs[(kk + 7) * 260 + n] = hi2f(w.w); } }
            __syncthreads();
#pragma unroll 4
            for (int k = 0; k < 32; ++k) {
                const f32x4 a0 = *(const LAS f32x4*)(As + k * 132 + ty * 8), a1 = *(const LAS f32x4*)(As + k * 132 + ty * 8 + 4);
                const f32x4 b0 = *(const LAS f32x4*)(Bs + k * 260 + tx * 4), b1 = *(const LAS f32x4*)(Bs + k * 260 + 128 + tx * 4);
#pragma unroll
                for (int i = 0; i < 8; ++i) { const float a = i < 4 ? a0[i & 3] : a1[i & 3];
#pragma unroll
                    for (int j = 0; j < 4; ++j) { acc[i][j] += a * b0[j]; acc[i][4 + j] += a * b1[j]; } }
            }
            __syncthreads();
        }
#pragma unroll
        for (int i = 0; i < 8; ++i) { const f32x4 v0 = {acc[i][0], acc[i][1], acc[i][2], acc[i][3]}, v1 = {acc[i][4], acc[i][5], acc[i][6], acc[i][7]};
            E(pm * 256 + half * 128 + ty * 8 + i, pn, tx * 4, v0, v1); }
    }
}
struct ARowDense { const bf16_t* A; int K; int pm; __device__ __forceinline__ const bf16_t* operator()(int r) const { return A + (size_t)(pm * 256 + r) * K; } };
struct ARowGather { const bf16_t* A; const int* stok; int pm; __device__ __forceinline__ const bf16_t* operator()(int r) const { const int t = stok[pm * 256 + r]; return t < 0 ? nullptr : A + (size_t)t * 1024; } };

template <class EP>
__device__ __forceinline__ void gemm_dense_naive(const Frame& F, const bf16_t* A, const bf16_t* Bt, int M, int N, int K, const EP& E) {
    const int nM = M / 256, nN = N / 256;
    for (int u = F.bid; u < nM * nN; u += F.G) { const int pm = u / nN, pn = u % nN;
        ARowDense ar{A, K, pm}; gemm_unit_naive(F, K, ar, Bt + (size_t)pn * 256 * K, E, pm, pn); }
}

namespace pg8 {
typedef short bf16x8 __attribute__((ext_vector_type(8)));
constexpr int BM = 256, BK = 64, HALF = 128, HTB = HALF * BK * 2, STAGE_BYTES = 8 * HTB, NXCD = 8, WGM = 8;
__device__ __forceinline__ int lds_byte(int r, int c) { const int st = (r >> 4) * 2 + (c >> 5), rr = r & 15, cc = c & 31, ob = rr * 64 + cc * 2; return st * 1024 + (ob ^ (((ob >> 9) & 1) << 5)); }
__device__ __forceinline__ void stage_rc(int b, int& R, int& C) { const int st = b / 1024, sb = b % 1024, swz = sb ^ (((sb >> 9) & 1) << 5); R = (st >> 1) * 16 + swz / 64; C = (st & 1) * 32 + (swz % 64) / 2; }
struct Unit { int pm, pn; };
struct ProbDense {
    const char* A; const char* Bt; int K, nM, nN, nwg, G, c;
    __device__ __forceinline__ void init(const bf16_t* A_, const bf16_t* Bt_, int M, int N, int K_, int G_, int c_) { A = (const char*)A_; Bt = (const char*)Bt_; K = K_; nM = M / BM; nN = N / BM; nwg = nM * nN; G = G_; c = c_; }
    __device__ __forceinline__ bool next(int i, Unit& u) const {
        const long L = (long)i * G + c; if (L >= nwg) return false;
        int wgid = (int)L; { const int q = nwg / NXCD, r = nwg % NXCD, xcd = wgid % NXCD, off = wgid / NXCD; wgid = (xcd < r ? xcd * (q + 1) : r * (q + 1) + (xcd - r) * q) + off; }
        const int nig = WGM * nN, gid = wgid / nig, fm = gid * WGM, gsz = (nM - fm) < WGM ? (nM - fm) : WGM;
        u.pm = fm + ((wgid % nig) % gsz); u.pn = (wgid % nig) / gsz; return true;
    }
    __device__ __forceinline__ const char* bptr(const Unit& u) const { return Bt + (size_t)u.pn * 256 * K * 2; }
    __device__ __forceinline__ unsigned aoff(const Unit& u, int r) const { return (unsigned)(u.pm * 256 + r) * (unsigned)(K * 2); }
};
struct ProbMoe1 {
    const char* A; const int* stok; const int* tile_e; const char* W; int K, ntiles, G, c;
    __device__ __forceinline__ bool next(int i, Unit& u) const { const int L = i * G + c; if (L >= ntiles * 4) return false; u.pm = L >> 2; u.pn = L & 3; return true; }
    __device__ __forceinline__ const char* bptr(const Unit& u) const { return W + ((size_t)(tile_e[u.pm] & 31) * 1024 + u.pn * 256) * 2048; }
    __device__ __forceinline__ unsigned aoff(const Unit& u, int r) const { const int t = stok[u.pm * 256 + r]; return t < 0 ? 0u : (unsigned)t * 2048u; }
};
struct ProbMoe2 {
    const char* A; const int* tile_e; const char* W; int K, tlo, thi, G, c;
    __device__ __forceinline__ bool next(int i, Unit& u) const { const int L = i * G + c; if (L >= (thi - tlo) * 4) return false; u.pm = tlo + (L >> 2); u.pn = L & 3; return true; }
    __device__ __forceinline__ const char* bptr(const Unit& u) const { return W + ((size_t)(tile_e[u.pm] & 31) * 1024 + u.pn * 256) * 1024; }
    __device__ __forceinline__ unsigned aoff(const Unit& u, int r) const { return (unsigned)(u.pm * 256 + r) * 1024u; }
};

template <class Prob, class Epi>
__device__ __forceinline__ void gemm_phase(LAS unsigned char* lds, const Prob& S, const Epi& E) {
    const int tid = threadIdx.x, wid = __builtin_amdgcn_readfirstlane(tid >> 6), lane = tid & 63, wr = wid >> 2, wc = wid & 3, fr = lane & 15, fq = lane >> 4;
    const int K = S.K, nt = K / BK;
    int RA[2]; unsigned cb2[2], voffB[2];
#pragma unroll
    for (int i = 0; i < 2; ++i) { int R, C; stage_rc(tid * 16 + i * 8192, R, C); RA[i] = R; cb2[i] = (unsigned)C * 2u; voffB[i] = (unsigned)(R * K + C) * 2u; }
    const size_t kstep = (size_t)(BK * 2);
    const size_t hstepB = (size_t)HALF * K * 2;
    const unsigned ldsw = (unsigned)wid * 1024u;
    const int aoff = lds_byte(wr * 64 + fr, fq * 8), boff = lds_byte(wc * 32 + fr, fq * 8);
#define PG8_SA(b, h) (((b) * 2 + (h)) * HTB)
#define PG8_SB(b, h) ((4 + (b) * 2 + (h)) * HTB)
#define PG8_STAGE(bufoff, gbase, voff) do { _Pragma("unroll") for (int _i = 0; _i < 2; ++_i) \
        __builtin_amdgcn_global_load_lds((const unsigned*)((const char*)(gbase) + (voff)[_i]), (LAS unsigned*)(lds + (bufoff) + ldsw + _i * 8192), 16, 0, 0); } while (0)
#define PG8_LDA(dst, b, h) do { _Pragma("unroll") for (int m = 0; m < 4; ++m) _Pragma("unroll") for (int k = 0; k < 2; ++k) dst[m][k] = *(const LAS bf16x8*)(lds + PG8_SA(b, h) + aoff + m * 2048 + k * 1024); } while (0)
#define PG8_LDB(dst, b, h) do { _Pragma("unroll") for (int n = 0; n < 2; ++n) _Pragma("unroll") for (int k = 0; k < 2; ++k) dst[n][k] = *(const LAS bf16x8*)(lds + PG8_SB(b, h) + boff + n * 2048 + k * 1024); } while (0)
#define PG8_MMA(ai, bj, At, Bt) do { __builtin_amdgcn_s_setprio(1); _Pragma("unroll") for (int m = 0; m < 4; ++m) _Pragma("unroll") for (int n = 0; n < 2; ++n) _Pragma("unroll") for (int k = 0; k < 2; ++k) \
        acc[ai][bj][m][n] = __builtin_amdgcn_mfma_f32_16x16x32_bf16(Bt[n][k], At[m][k], acc[ai][bj][m][n], 0, 0, 0); __builtin_amdgcn_s_setprio(0); } while (0)
#define PG8_WAIT_V(n) asm volatile("s_waitcnt vmcnt(" #n ")" ::: "memory")
#define PG8_WAIT_L(n) asm volatile("s_waitcnt lgkmcnt(" #n ")" ::: "memory")
#define PG8_BAR __builtin_amdgcn_s_barrier()
#define PG8_SCHED __builtin_amdgcn_sched_barrier(0)
    Unit cur, nxt; int ui = 0;
    if (!S.next(0, cur)) return;
    f32x4 acc[2][2][4][2];
#pragma unroll
    for (int a = 0; a < 2; ++a)
#pragma unroll
        for (int b = 0; b < 2; ++b)
#pragma unroll
            for (int m = 0; m < 4; ++m)
#pragma unroll
                for (int n = 0; n < 2; ++n) acc[a][b][m][n] = (f32x4){0.f, 0.f, 0.f, 0.f};
    bf16x8 At[4][2], B0[2][2], B1[2][2];
    unsigned oc0[2], oc1[2], on0[2], on1[2];
#pragma unroll
    for (int i = 0; i < 2; ++i) { oc0[i] = S.aoff(cur, RA[i]) + cb2[i]; oc1[i] = S.aoff(cur, 128 + RA[i]) + cb2[i]; }
    const char* cB = S.bptr(cur);
    const char* const Ab = S.A;
    PG8_STAGE(PG8_SB(0, 0), cB, voffB); PG8_STAGE(PG8_SA(0, 0), Ab, oc0); PG8_STAGE(PG8_SB(0, 1), cB + hstepB, voffB); PG8_STAGE(PG8_SA(0, 1), Ab, oc1);
    if (wr == 1) PG8_BAR;
    PG8_WAIT_V(4); PG8_BAR;
    PG8_STAGE(PG8_SB(1, 0), cB + kstep, voffB); PG8_STAGE(PG8_SA(1, 0), Ab + kstep, oc0); PG8_STAGE(PG8_SB(1, 1), cB + hstepB + kstep, voffB);
    PG8_WAIT_V(6); PG8_BAR;
    for (;;) {
        const bool has_next = S.next(ui + 1, nxt);
        const char* nB = has_next ? S.bptr(nxt) : cB;
#pragma unroll
        for (int i = 0; i < 2; ++i) { on0[i] = has_next ? S.aoff(nxt, RA[i]) + cb2[i] : oc0[i]; on1[i] = has_next ? S.aoff(nxt, 128 + RA[i]) + cb2[i] : oc1[i]; }
        for (int t = 0; t < nt; t += 2) {
            const bool last = (t == nt - 2);
            const char* a1 = Ab + (size_t)(t + 1) * kstep;
            const char* a2 = last ? Ab : Ab + (size_t)(t + 2) * kstep; const char* b2 = last ? nB : cB + (size_t)(t + 2) * kstep;
            const char* a3 = a2 + kstep; const char* b3 = b2 + kstep;
            unsigned o20[2], o21[2];
#pragma unroll
            for (int i = 0; i < 2; ++i) { o20[i] = last ? on0[i] : oc0[i]; o21[i] = last ? on1[i] : oc1[i]; }
            PG8_LDB(B0, 0, 0); PG8_SCHED; PG8_LDA(At, 0, 0); PG8_STAGE(PG8_SA(1, 1), a1, oc1);
            PG8_WAIT_L(8); PG8_BAR; PG8_WAIT_L(0); PG8_MMA(0, 0, At, B0); PG8_BAR; PG8_SCHED;
            PG8_LDB(B1, 0, 1); PG8_STAGE(PG8_SB(0, 0), b2, voffB);
            PG8_BAR; PG8_WAIT_L(0); PG8_MMA(0, 1, At, B1); PG8_BAR;
            PG8_LDA(At, 0, 1); PG8_STAGE(PG8_SA(0, 0), a2, o20);
            PG8_BAR; PG8_WAIT_L(0); PG8_MMA(1, 0, At, B0); PG8_BAR; PG8_SCHED;
            PG8_STAGE(PG8_SB(0, 1), b2 + hstepB, voffB);
            PG8_WAIT_V(6); PG8_BAR; PG8_MMA(1, 1, At, B1); PG8_BAR;
            PG8_LDB(B0, 1, 0); PG8_SCHED; PG8_LDA(At, 1, 0); PG8_STAGE(PG8_SA(0, 1), a2, o21);
            PG8_WAIT_L(8); PG8_BAR; PG8_WAIT_L(0); PG8_MMA(0, 0, At, B0); PG8_BAR; PG8_SCHED;
            PG8_LDB(B1, 1, 1); PG8_STAGE(PG8_SB(1, 0), b3, voffB);
            PG8_BAR; PG8_WAIT_L(0); PG8_MMA(0, 1, At, B1); PG8_BAR;
            PG8_LDA(At, 1, 1); PG8_STAGE(PG8_SA(1, 0), a3, o20);
            PG8_BAR; PG8_WAIT_L(0); PG8_MMA(1, 0, At, B0); PG8_BAR; PG8_SCHED;
            PG8_STAGE(PG8_SB(1, 1), b3 + hstepB, voffB);
            PG8_WAIT_V(6); PG8_BAR; PG8_MMA(1, 1, At, B1); PG8_BAR;
        }
#pragma unroll
        for (int ai = 0; ai < 2; ++ai)
#pragma unroll
            for (int m = 0; m < 4; ++m)
#pragma unroll
                for (int n = 0; n < 2; ++n) E(cur.pm * BM + ai * HALF + wr * 64 + m * 16 + fr, cur.pn, wc * 32 + n * 16 + fq * 4, acc[ai][0][m][n], acc[ai][1][m][n]);
        if (!has_next) break;
#pragma unroll
        for (int a = 0; a < 2; ++a)
#pragma unroll
            for (int b = 0; b < 2; ++b)
#pragma unroll
                for (int m = 0; m < 4; ++m)
#pragma unroll
                    for (int n = 0; n < 2; ++n) acc[a][b][m][n] = (f32x4){0.f, 0.f, 0.f, 0.f};
        cur = nxt; cB = nB; ++ui;
#pragma unroll
        for (int i = 0; i < 2; ++i) { oc0[i] = on0[i]; oc1[i] = on1[i]; }
    }
    PG8_WAIT_V(0);
    if (wr == 0) PG8_BAR;
    PG8_BAR;
#undef PG8_SA
#undef PG8_SB
#undef PG8_STAGE
#undef PG8_LDA
#undef PG8_LDB
#undef PG8_MMA
#undef PG8_WAIT_V
#undef PG8_WAIT_L
#undef PG8_BAR
#undef PG8_SCHED
}
}

struct EpiStoreBf16 { bf16_t* O; int ldc; int gelu_below;
    __device__ __forceinline__ void operator()(int row, int pn, int cx, f32x4 v0, f32x4 v1) const {
        const int c0 = pn * 256 + cx, c1 = c0 + 128;
        if (c0 < gelu_below) { v0[0] = gelu_tanh_f(v0[0]); v0[1] = gelu_tanh_f(v0[1]); v0[2] = gelu_tanh_f(v0[2]); v0[3] = gelu_tanh_f(v0[3]); }
        if (c1 < gelu_below) { v1[0] = gelu_tanh_f(v1[0]); v1[1] = gelu_tanh_f(v1[1]); v1[2] = gelu_tanh_f(v1[2]); v1[3] = gelu_tanh_f(v1[3]); }
        u32x2 a; a.x = pack2(v0[0], v0[1]); a.y = pack2(v0[2], v0[3]); u32x2 b; b.x = pack2(v1[0], v1[1]); b.y = pack2(v1[2], v1[3]);
        *(u32x2*)(O + (size_t)row * ldc + c0) = a; *(u32x2*)(O + (size_t)row * ldc + c1) = b; } };
struct EpiResidual { const float* srcl; const float* srcc; float* dstl; float* dstc; const float* mod;   int which;
    __device__ __forceinline__ void operator()(int row, int pn, int cx, f32x4 v0, f32x4 v1) const {
        const int b = row < TL ? (row >> 13) : 8; const float* g = mod + ((size_t)b * 6 + which) * 1024;
        const float* s = row < TL ? srcl + (size_t)row * 1024 : srcc + (size_t)(row - TL) * 1024;
        float* d = row < TL ? dstl + (size_t)row * 1024 : dstc + (size_t)(row - TL) * 1024;
        const int c0 = pn * 256 + cx, c1 = c0 + 128;
        *(f32x4*)(d + c0) = *(const f32x4*)(s + c0) + *(const f32x4*)(g + c0) * v0;
        *(f32x4*)(d + c1) = *(const f32x4*)(s + c1) + *(const f32x4*)(g + c1) * v1; } };
struct EpiMoe1 { bf16_t* H;
    __device__ __forceinline__ void operator()(int row, int pn, int cx, f32x4 v0, f32x4 v1) const {
        u32x2 a; a.x = pack2(silu_f(v0[0]) * v1[0], silu_f(v0[1]) * v1[1]); a.y = pack2(silu_f(v0[2]) * v1[2], silu_f(v0[3]) * v1[3]);
        *(u32x2*)(H + (size_t)row * 512 + pn * 128 + cx) = a; } };
struct EpiMoe2 { const int* stok; const float* sw; float* dstl; float* dstc; const float* mod;
    __device__ __forceinline__ void operator()(int row, int pn, int cx, f32x4 v0, f32x4 v1) const {
        const int t = stok[row]; if (t < 0) return; const float w = sw[row];
        const int b = t < TL ? (t >> 13) : 8; const float* g = mod + ((size_t)b * 6 + 5) * 1024;
        float* d = t < TL ? dstl + (size_t)t * 1024 : dstc + (size_t)(t - TL) * 1024;
        const int c0 = pn * 256 + cx, c1 = c0 + 128;
        *(f32x4*)(d + c0) = *(const f32x4*)(d + c0) + *(const f32x4*)(g + c0) * v0 * w;
        *(f32x4*)(d + c1) = *(const f32x4*)(d + c1) + *(const f32x4*)(g + c1) * v1 * w; } };

#ifndef FAST_GEMM
#define FAST_GEMM 1
#endif
template <class EP>
__device__ __forceinline__ void gemm_dense(const Frame& F, const bf16_t* A, const bf16_t* Bt, int M, int N, int K, const EP& E) {
#if FAST_GEMM
    pg8::ProbDense S; S.init(A, Bt, M, N, K, F.G, F.bid); pg8::gemm_phase(F.lds, S, E);
#else
    gemm_dense_naive(F, A, Bt, M, N, K, E);
#endif
}
__device__ __forceinline__ void ph_moe_gemm1(const Frame& F, int layer) {
    const unsigned* info = (const unsigned*)(F.ws + WS_CTRL + C_MOE + layer * 1024) + 128;
    const int ntiles = (int)__hip_atomic_load(&info[1], __ATOMIC_RELAXED, __HIP_MEMORY_SCOPE_AGENT);
    const int* tile_e = (const int*)(F.ws + WS_R2 + R2_TILEE); const int* stok = (const int*)(F.ws + WS_R2 + R2_STOK);
    const bf16_t* W1 = (const bf16_t*)(F.ws + WS_WMOE);
    EpiMoe1 E{(bf16_t*)(F.ws + WS_R2 + R2_H)};
#if FAST_GEMM
    pg8::ProbMoe1 S{(const char*)(F.ws + WS_ACT), stok, tile_e, (const char*)W1, 1024, ntiles, F.G, F.bid};
    pg8::gemm_phase(F.lds, S, E);
#else
    for (int u = F.bid; u < ntiles * 4; u += F.G) { const int pm = u >> 2, pn = u & 3; const int e = tile_e[pm] & 31;
        ARowGather ar{(const bf16_t*)(F.ws + WS_ACT), stok, pm};
        gemm_unit_naive(F, 1024, ar, W1 + ((size_t)e * 1024 + pn * 256) * 1024, E, pm, pn); }
#endif
}
__device__ __forceinline__ void ph_moe_gemm2(const Frame& F, int layer, int k) {
    const unsigned* info = (const unsigned*)(F.ws + WS_CTRL + C_MOE + layer * 1024) + 128;
    const int nk0 = (int)__hip_atomic_load(&info[0], __ATOMIC_RELAXED, __HIP_MEMORY_SCOPE_AGENT), nall = (int)__hip_atomic_load(&info[1], __ATOMIC_RELAXED, __HIP_MEMORY_SCOPE_AGENT);
    const int tlo = k == 0 ? 0 : nk0, thi = k == 0 ? nk0 : nall;
    const int* tile_e = (const int*)(F.ws + WS_R2 + R2_TILEE);
    const bf16_t* W2 = (const bf16_t*)(F.ws + WS_WMOE) + (size_t)32 * 1024 * 1024;
    EpiMoe2 E{(const int*)(F.ws + WS_R2 + R2_STOK), (const float*)(F.ws + WS_R2 + R2_SW), F.P->out, (float*)(F.ws + WS_XC), F.mod + (size_t)layer * 9 * 6144};
#if FAST_GEMM
    pg8::ProbMoe2 S{(const char*)(F.ws + WS_R2 + R2_H), tile_e, (const char*)W2, 512, tlo, thi, F.G, F.bid};
    pg8::gemm_phase(F.lds, S, E);
#else
    for (int u = F.bid; u < (thi - tlo) * 4; u += F.G) { const int pm = tlo + (u >> 2), pn = u & 3; const int e = tile_e[pm] & 31;
        ARowDense ar{(const bf16_t*)(F.ws + WS_R2 + R2_H), 512, pm};
        gemm_unit_naive(F, 512, ar, W2 + ((size_t)e * 1024 + pn * 256) * 512, E, pm, pn); }
#endif
}

__device__ __forceinline__ void ph_gmlp(const Frame& F) {
    const Params& P = *F.P;
    const bf16_t* PX = (const bf16_t*)(F.ws + WS_PX); bf16_t* CAT = (bf16_t*)(F.ws + WS_ACT);
    LAS float* Vs = (LAS float*)F.lds;
    LAS float* Wm = Vs + 128 * 128;
    LAS float* rs = Wm + 128 * 129;
    for (int it = F.bid; it < 528 * 4; it += F.G) {
        const int ch = it >> 2, g = it & 3, row0 = ch * 128;
        for (int q = F.wave; q < 128; q += 8) { const bf16_t* p = PX + (size_t)(row0 + q) * EVEN_IN + 512 + F.lane * 8;
            const u32x4 w = *(const u32x4*)p; float s = 0.f, x;
            x = lo2f(w.x); s += x * x; x = hi2f(w.x); s += x * x; x = lo2f(w.y); s += x * x; x = hi2f(w.y); s += x * x;
            x = lo2f(w.z); s += x * x; x = hi2f(w.z); s += x * x; x = lo2f(w.w); s += x * x; x = hi2f(w.w); s += x * x;
            s = wave_sum(s); if (F.lane == 0) rs[q] = rsqrtf(s * (1.f / 512.f) + EPS); }
        __syncthreads();
        for (int i = F.tid; i < 128 * 128; i += NTH) { const int q = i >> 7, c = i & 127;
            Vs[i] = bf2f(PX[(size_t)(row0 + q) * EVEN_IN + 512 + g * 128 + c]) * rs[q] * P.in[I_GNW][g * 128 + c];
            Wm[q * 129 + c] = P.in[I_GWS][(size_t)g * 16384 + i]; }
        __syncthreads();
        const int ty = F.tid >> 5, tx = F.tid & 31;
        float acc[8][4];
#pragma unroll
        for (int i = 0; i < 8; ++i)
#pragma unroll
            for (int j = 0; j < 4; ++j) acc[i][j] = 0.f;
        for (int q = 0; q < 128; ++q) { const f32x4 v = *(const LAS f32x4*)(Vs + q * 128 + tx * 4);
#pragma unroll
            for (int i = 0; i < 8; ++i) { const float w = Wm[(ty * 8 + i) * 129 + q];
#pragma unroll
                for (int j = 0; j < 4; ++j) acc[i][j] += w * v[j]; } }
#pragma unroll
        for (int i = 0; i < 8; ++i) { const int p = ty * 8 + i; const float bias = P.in[I_GBS][g * 128 + p];
            const size_t t = (size_t)(row0 + p); const int col = g * 128 + tx * 4;
            const u32x2 uu = *(const u32x2*)(PX + t * EVEN_IN + col);
            u32x2 o; o.x = pack2(lo2f(uu.x) * (acc[i][0] + bias), hi2f(uu.x) * (acc[i][1] + bias)); o.y = pack2(lo2f(uu.y) * (acc[i][2] + bias), hi2f(uu.y) * (acc[i][3] + bias));
            *(u32x2*)(CAT + t * 1024 + col) = o; }
        __syncthreads();
    }
}

__device__ __forceinline__ void ph_gla(const Frame& F) {
    const Params& P = *F.P;
    const bf16_t* PX = (const bf16_t*)(F.ws + WS_PX);
    LAS float* qs = (LAS float*)F.lds;
    LAS float* fs = qs + 8192;
    LAS float* vs = fs + 8192;
    LAS float* os = vs + 2048;
    const int dg = F.lane & 15, el = F.wave * 4 + (F.lane >> 4);
    const int prow = F.tid >> 4, pd0 = (F.tid & 15) * 8;
    const int vrow = F.tid >> 2, ve0 = (F.tid & 3) * 8;
    for (int it = F.bid; it < 256; it += F.G) {
        const int b = it >> 5, h = (it >> 3) & 3, dir = (it >> 2) & 1, sl = it & 3;
        bf16_t* O = (bf16_t*)(F.ws + WS_R2 + (dir ? R2_OB0 : R2_OF0));
        float lb8[8];
#pragma unroll
        for (int i = 0; i < 8; ++i) { const int ch = h * 128 + pd0 + i; const float* lg = P.in[I_LB] + (size_t)dir * 3 * 512 + ch;
            const float a0 = lg[0], a1 = lg[512], a2 = lg[1024]; const float m = fmaxf(a0, fmaxf(a1, a2));
            const float e0 = __expf(a0 - m), e1 = __expf(a1 - m), e2 = __expf(a2 - m); lb8[i] = e0 / (e0 + e1 + e2); }
        float S[8];
#pragma unroll
        for (int i = 0; i < 8; ++i) S[i] = 0.f;
        u32x4 rq0, rq1, rf0, rf1, rv = {0u, 0u, 0u, 0u};
        auto rowof = [&](int nb, int s) -> size_t { const bool c = nb < 4; const int len = c ? CTXL : SEQ; const int tt = (c ? nb : nb - 4) * 64 + s; const int p = dir ? len - 1 - tt : tt;
            return (c ? (size_t)TL + b * CTXL : (size_t)b * SEQ) + p; };
        auto fetch = [&](int nb) { const bf16_t* r0 = PX + rowof(nb, prow) * EVEN_IN; const bf16_t* r1 = PX + rowof(nb, prow + 32) * EVEN_IN;
            rq0 = *(const u32x4*)(r0 + 1024 + h * 128 + pd0); rf0 = *(const u32x4*)(r0 + 2048 + dir * 512 + h * 128 + pd0);
            rq1 = *(const u32x4*)(r1 + 1024 + h * 128 + pd0); rf1 = *(const u32x4*)(r1 + 2048 + dir * 512 + h * 128 + pd0);
            if (F.tid < 256) rv = *(const u32x4*)(PX + rowof(nb, vrow) * EVEN_IN + 1536 + h * 128 + sl * 32 + ve0); };
        auto put = [&](int row, u32x4 q, u32x4 f) { LAS float* qd = qs + row * 128 + pd0; LAS float* fd = fs + row * 128 + pd0;
            const float q8[8] = {lo2f(q.x), hi2f(q.x), lo2f(q.y), hi2f(q.y), lo2f(q.z), hi2f(q.z), lo2f(q.w), hi2f(q.w)};
            const float f8[8] = {lo2f(f.x), hi2f(f.x), lo2f(f.y), hi2f(f.y), lo2f(f.z), hi2f(f.z), lo2f(f.w), hi2f(f.w)};
            f32x4 o0, o1, g0, g1;
#pragma unroll
            for (int i = 0; i < 4; ++i) { o0[i] = q8[i]; o1[i] = q8[4 + i]; g0[i] = lb8[i] + (1.f - lb8[i]) * sigmoid_f(f8[i]); g1[i] = lb8[4 + i] + (1.f - lb8[4 + i]) * sigmoid_f(f8[4 + i]); }
            *(LAS f32x4*)qd = o0; *(LAS f32x4*)(qd + 4) = o1; *(LAS f32x4*)fd = g0; *(LAS f32x4*)(fd + 4) = g1; };
        fetch(0);
        for (int nb = 0; nb < 132; ++nb) {
            __syncthreads();
            put(prow, rq0, rf0); put(prow + 32, rq1, rf1);
            if (F.tid < 256) { LAS float* vd = vs + vrow * 32 + ve0;
                *(LAS f32x4*)vd = (f32x4){lo2f(rv.x), hi2f(rv.x), lo2f(rv.y), hi2f(rv.y)}; *(LAS f32x4*)(vd + 4) = (f32x4){lo2f(rv.z), hi2f(rv.z), lo2f(rv.w), hi2f(rv.w)}; }
            __syncthreads();
            if (nb + 1 < 132) fetch(nb + 1);
#pragma unroll 4
            for (int st = 0; st < 64; ++st) {
                const f32x4 fa = *(const LAS f32x4*)(fs + st * 128 + dg * 8), fb = *(const LAS f32x4*)(fs + st * 128 + dg * 8 + 4);
                const f32x4 qa = *(const LAS f32x4*)(qs + st * 128 + dg * 8), qb = *(const LAS f32x4*)(qs + st * 128 + dg * 8 + 4);
                const float v = vs[st * 32 + el];
                float p0 = 0.f, p1 = 0.f;
#pragma unroll
                for (int i = 0; i < 4; ++i) { S[i] = fa[i] * S[i] + (1.f - fa[i]) * v; p0 += qa[i] * S[i]; S[4 + i] = fb[i] * S[4 + i] + (1.f - fb[i]) * v; p1 += qb[i] * S[4 + i]; }
                const float o = sum16(p0 + p1);
                if (dg == 0) os[st * 32 + el] = o;
            }
            __syncthreads();
#pragma unroll
            for (int k = 0; k < 2; ++k) { const int s = (F.tid >> 4) + 32 * k, e2 = (F.tid & 15) * 2;
              *(unsigned*)(O + rowof(nb, s) * 512 + h * 128 + sl * 32 + e2) = pack2(os[s * 32 + e2], os[s * 32 + e2 + 1]); }
        }
        __syncthreads();
    }
}

__device__ __forceinline__ void ph_merge(const Frame& F, int mode) {
    const Params& P = *F.P;
    const bf16_t* PX = (const bf16_t*)(F.ws + WS_PX); bf16_t* CAT = (bf16_t*)(F.ws + WS_ACT);
    const bf16_t* Of = (const bf16_t*)(mode ? F.ws + WS_GOF : F.ws + WS_R2 + R2_OF0); const bf16_t* Ob = (const bf16_t*)(mode ? F.ws + WS_WMOE : F.ws + WS_R2 + R2_OB0);
    const int nrows = mode ? TL : TT, ldp = mode ? ODD_PAD : EVEN_IN, gcol = mode ? 1536 : 3072, dcol = mode ? 0 : 512;
    const float* nw = mode ? P.in[I_GDNNW] : P.in[I_HNW];
    for (int r = F.bid * 8 + F.wave; r < nrows; r += F.G * 8) {
        const int c = F.lane * 8;
        const u32x4 a = *(const u32x4*)(Of + (size_t)r * 512 + c), bb = *(const u32x4*)(Ob + (size_t)r * 512 + c), gg = *(const u32x4*)(PX + (size_t)r * ldp + gcol + c);
        float o[8] = {lo2f(a.x) + lo2f(bb.x), hi2f(a.x) + hi2f(bb.x), lo2f(a.y) + lo2f(bb.y), hi2f(a.y) + hi2f(bb.y), lo2f(a.z) + lo2f(bb.z), hi2f(a.z) + hi2f(bb.z), lo2f(a.w) + lo2f(bb.w), hi2f(a.w) + hi2f(bb.w)};
        const float g[8] = {lo2f(gg.x), hi2f(gg.x), lo2f(gg.y), hi2f(gg.y), lo2f(gg.z), hi2f(gg.z), lo2f(gg.w), hi2f(gg.w)};
        float ss = 0.f;
#pragma unroll
        for (int i = 0; i < 8; ++i) ss += o[i] * o[i];
        ss = sum16(ss);
        const float rstd = rsqrtf(ss * (1.f / 128.f) + EPS);
        float y[8];
#pragma unroll
        for (int i = 0; i < 8; ++i) { const float w = mode ? nw[(c & 127) + i] : nw[c + i]; y[i] = o[i] * rstd * w * silu_f(g[i]); }
        u32x4 w; w.x = pack2(y[0], y[1]); w.y = pack2(y[2], y[3]); w.z = pack2(y[4], y[5]); w.w = pack2(y[6], y[7]);
        *(u32x4*)(CAT + (size_t)r * 1024 + dcol + c) = w;
    }
}

__device__ __forceinline__ void ph_mla_norm(const Frame& F) {
    const Params& P = *F.P;
    const bf16_t* PX = (const bf16_t*)(F.ws + WS_PX);
    bf16_t* cqn = (bf16_t*)(F.ws + WS_R2 + R2_CQN); bf16_t* ckvn = cqn + (size_t)TL * 256;
    for (int r = F.bid * 8 + F.wave; r < TT; r += F.G * 8) {
        const bf16_t* row = PX + (size_t)r * ODD_PAD;
        if (r < TL) { const u32x2 w = *(const u32x2*)(row + 2064 + F.lane * 4);
            const float x0 = lo2f(w.x), x1 = hi2f(w.x), x2 = lo2f(w.y), x3 = hi2f(w.y);
            const float ss = wave_sum(x0 * x0 + x1 * x1 + x2 * x2 + x3 * x3); const float rstd = rsqrtf(ss * (1.f / 256.f) + EPS);
            const float* nw = P.in[I_QNW] + F.lane * 4;
            u32x2 o; o.x = pack2(x0 * rstd * nw[0], x1 * rstd * nw[1]); o.y = pack2(x2 * rstd * nw[2], x3 * rstd * nw[3]);
            *(u32x2*)(cqn + (size_t)r * 256 + F.lane * 4) = o; }
        { const unsigned w = *(const unsigned*)(row + 2320 + F.lane * 2);
          const float x0 = lo2f(w), x1 = hi2f(w);
          const float ss = wave_sum(x0 * x0 + x1 * x1); const float rstd = rsqrtf(ss * (1.f / 128.f) + EPS);
          const float* nw = P.in[I_KVNW] + F.lane * 2;
          *(unsigned*)(ckvn + (size_t)r * 256 + F.lane * 2) = pack2(x0 * rstd * nw[0], x1 * rstd * nw[1]);
          *(unsigned*)(ckvn + (size_t)r * 256 + 128 + F.lane * 2) = 0u; }
    }
}

__device__ __forceinline__ void ph_mla_final(const Frame& F) {
    const Params& P = *F.P;
    const bf16_t* PX = (const bf16_t*)(F.ws + WS_PX);
    bf16_t* Q = (bf16_t*)(F.ws + WS_WMOE);
    const bf16_t* KVR = (const bf16_t*)(F.ws + WS_PX + PX_KVRAW);
    bf16_t* Kb = (bf16_t*)(F.ws + WS_R2 + R2_K); bf16_t* Vb = (bf16_t*)(F.ws + WS_R2 + R2_V);
    const int hh = F.lane >> 3, sub = F.lane & 7;
    const float freq = __powf(10000.f, -(float)sub * 0.125f);
    const float qscale = 0.10206207261596577f * 1.4426950408889634f;
    for (int r = F.bid * 8 + F.wave; r < TT; r += F.G * 8) {
        const bool lat = r < TL; const int l = r & (SEQ - 1);
        float ca = 1.f, sa = 0.f, cb = 1.f, sb = 0.f;
        if (lat) { const float pr = (float)(l >> 6), pc = (float)(l & 63); sincosf(pr * freq, &sa, &ca); sincosf(pc * freq, &sb, &cb); }
        { const bf16_t* kv = KVR + (size_t)r * 1024 + hh * 128;
          const u32x4 w = *(const u32x4*)(kv + sub * 8);
          float x[12] = {lo2f(w.x), hi2f(w.x), lo2f(w.y), hi2f(w.y), lo2f(w.z), hi2f(w.z), lo2f(w.w), hi2f(w.w), 0.f, 0.f, 0.f, 0.f};
          const bf16_t* kr = PX + (size_t)r * ODD_PAD + 2448;
          x[8] = bf2f(kr[sub]); x[9] = bf2f(kr[8 + sub]); x[10] = bf2f(kr[16 + sub]); x[11] = bf2f(kr[24 + sub]);
          float ss = 0.f;
#pragma unroll
          for (int i = 0; i < 12; ++i) ss += x[i] * x[i];
          ss = sum8(ss);
          const float rstd = rsqrtf(ss * (1.f / 96.f) + EPS);
          const float* nw = P.in[I_QKK];
#pragma unroll
          for (int i = 0; i < 8; ++i) x[i] *= rstd * nw[sub * 8 + i];
          x[8] *= rstd * nw[64 + sub]; x[9] *= rstd * nw[72 + sub]; x[10] *= rstd * nw[80 + sub]; x[11] *= rstd * nw[88 + sub];
          const float a1 = x[8] * ca - x[9] * sa, a2 = x[9] * ca + x[8] * sa, b1 = x[10] * cb - x[11] * sb, b2 = x[11] * cb + x[10] * sb;
          const int bidx = lat ? (r >> 13) : ((r - TL) >> 8); const int s = lat ? (CTXL + l) : ((r - TL) & 255);
          bf16_t* kd = Kb + ((size_t)(bidx * 8 + hh) * (SEQ + CTXL) + s) * 96;
          u32x4 o; o.x = pack2(x[0], x[1]); o.y = pack2(x[2], x[3]); o.z = pack2(x[4], x[5]); o.w = pack2(x[6], x[7]);
          *(u32x4*)(kd + sub * 8) = o;
          kd[64 + sub] = f2bf(a1); kd[72 + sub] = f2bf(a2); kd[80 + sub] = f2bf(b1); kd[88 + sub] = f2bf(b2);
          const u32x4 vv = *(const u32x4*)(kv + 64 + sub * 8);
          *(u32x4*)(Vb + ((size_t)(bidx * 8 + hh) * (SEQ + CTXL) + s) * 64 + sub * 8) = vv; }
        if (lat) { bf16_t* q = Q + (size_t)r * 768 + hh * 96;
          const u32x4 w = *(const u32x4*)(q + sub * 8);
          float x[12] = {lo2f(w.x), hi2f(w.x), lo2f(w.y), hi2f(w.y), lo2f(w.z), hi2f(w.z), lo2f(w.w), hi2f(w.w), bf2f(q[64 + sub]), bf2f(q[72 + sub]), bf2f(q[80 + sub]), bf2f(q[88 + sub])};
          float ss = 0.f;
#pragma unroll
          for (int i = 0; i < 12; ++i) ss += x[i] * x[i];
          ss = sum8(ss);
          const float rstd = rsqrtf(ss * (1.f / 96.f) + EPS) * qscale;
          const float* nw = P.in[I_QKQ];
#pragma unroll
          for (int i = 0; i < 8; ++i) x[i] *= rstd * nw[sub * 8 + i];
          x[8] *= rstd * nw[64 + sub]; x[9] *= rstd * nw[72 + sub]; x[10] *= rstd * nw[80 + sub]; x[11] *= rstd * nw[88 + sub];
          const float a1 = x[8] * ca - x[9] * sa, a2 = x[9] * ca + x[8] * sa, b1 = x[10] * cb - x[11] * sb, b2 = x[11] * cb + x[10] * sb;
          u32x4 o; o.x = pack2(x[0], x[1]); o.y = pack2(x[2], x[3]); o.z = pack2(x[4], x[5]); o.w = pack2(x[6], x[7]);
          *(u32x4*)(q + sub * 8) = o;
          q[64 + sub] = f2bf(a1); q[72 + sub] = f2bf(a2); q[80 + sub] = f2bf(b1); q[88 + sub] = f2bf(b2); }
    }
}

__device__ __forceinline__ void ph_attn_naive(const Frame& F) {
    const bf16_t* Q = (const bf16_t*)(F.ws + WS_WMOE);
    const bf16_t* Kb = (const bf16_t*)(F.ws + WS_R2 + R2_K); const bf16_t* Vb = (const bf16_t*)(F.ws + WS_R2 + R2_V);
    bf16_t* CAT = (bf16_t*)(F.ws + WS_ACT);
    LAS float* Ks = (LAS float*)F.lds;
    LAS float* Vs = Ks + 64 * 96;
    constexpr int NK = SEQ + CTXL;
    const int hf = F.tid & 1;
    for (int it = F.bid; it < 8 * 8 * 32; it += F.G) {
        const int b = it >> 8, h = (it >> 5) & 7, qb = it & 31;
        const int l = qb * 256 + (F.tid >> 1); const size_t trow = (size_t)b * SEQ + l;
        float q[48], o[32];
        { const bf16_t* qp = Q + trow * 768 + h * 96 + hf * 48;
#pragma unroll
          for (int i = 0; i < 6; ++i) { const u32x4 w = *(const u32x4*)(qp + i * 8);
            q[i * 8 + 0] = lo2f(w.x); q[i * 8 + 1] = hi2f(w.x); q[i * 8 + 2] = lo2f(w.y); q[i * 8 + 3] = hi2f(w.y); q[i * 8 + 4] = lo2f(w.z); q[i * 8 + 5] = hi2f(w.z); q[i * 8 + 6] = lo2f(w.w); q[i * 8 + 7] = hi2f(w.w); } }
#pragma unroll
        for (int d = 0; d < 32; ++d) o[d] = 0.f;
        float m = -3.0e38f, ls = 0.f;
        const bf16_t* kb = Kb + (size_t)(b * 8 + h) * NK * 96; const bf16_t* vb = Vb + (size_t)(b * 8 + h) * NK * 64;
        for (int kt = 0; kt < NK / 64; ++kt) {
            for (int i = F.tid; i < 64 * 96 / 8; i += NTH) { const u32x4 w = *(const u32x4*)(kb + (size_t)kt * 64 * 96 + i * 8); LAS float* d = Ks + i * 8;
                d[0] = lo2f(w.x); d[1] = hi2f(w.x); d[2] = lo2f(w.y); d[3] = hi2f(w.y); d[4] = lo2f(w.z); d[5] = hi2f(w.z); d[6] = lo2f(w.w); d[7] = hi2f(w.w); }
            { const int i = F.tid; const u32x4 w = *(const u32x4*)(vb + (size_t)kt * 64 * 64 + i * 8); LAS float* d = Vs + i * 8;
                d[0] = lo2f(w.x); d[1] = hi2f(w.x); d[2] = lo2f(w.y); d[3] = hi2f(w.y); d[4] = lo2f(w.z); d[5] = hi2f(w.z); d[6] = lo2f(w.w); d[7] = hi2f(w.w); }
            __syncthreads();
            for (int jb = 0; jb < 16; ++jb) {
                float s[4]; float mx = m;
#pragma unroll
                for (int jj = 0; jj < 4; ++jj) { const LAS float* kr = Ks + (jb * 4 + jj) * 96 + hf * 48; float a = 0.f;
#pragma unroll
                    for (int d = 0; d < 48; d += 4) { const f32x4 kv = *(const LAS f32x4*)(kr + d); a += q[d] * kv[0] + q[d + 1] * kv[1] + q[d + 2] * kv[2] + q[d + 3] * kv[3]; }
                    a += __shfl_xor(a, 1);
                    s[jj] = a; mx = fmaxf(mx, a); }
                const float sc = exp2f(m - mx); ls *= sc;
#pragma unroll
                for (int d = 0; d < 32; ++d) o[d] *= sc;
                m = mx;
#pragma unroll
                for (int jj = 0; jj < 4; ++jj) { const float p = exp2f(s[jj] - mx); ls += p; const LAS float* vr = Vs + (jb * 4 + jj) * 64 + hf * 32;
#pragma unroll
                    for (int d = 0; d < 32; d += 4) { const f32x4 vv = *(const LAS f32x4*)(vr + d); o[d] += p * vv[0]; o[d + 1] += p * vv[1]; o[d + 2] += p * vv[2]; o[d + 3] += p * vv[3]; } }
            }
            __syncthreads();
        }
        const float inv = 1.f / ls;
        bf16_t* dst = CAT + trow * 1024 + 512 + h * 64 + hf * 32;
#pragma unroll
        for (int i = 0; i < 4; ++i) { u32x4 w; w.x = pack2(o[i * 8] * inv, o[i * 8 + 1] * inv); w.y = pack2(o[i * 8 + 2] * inv, o[i * 8 + 3] * inv); w.z = pack2(o[i * 8 + 4] * inv, o[i * 8 + 5] * inv); w.w = pack2(o[i * 8 + 6] * inv, o[i * 8 + 7] * inv);
            *(u32x4*)(dst + i * 8) = w; }
    }
}

typedef float f32x16 __attribute__((ext_vector_type(16)));
typedef short s16x8 __attribute__((ext_vector_type(8)));
__device__ __forceinline__ void ph_attn(const Frame& F) {
    constexpr int NK = SEQ + CTXL, NT = NK / 64;
    constexpr int KROWB = 208, VROWB = 144, KBYTES = 64 * KROWB, VBYTES = 64 * VROWB, BUFB = KBYTES + VBYTES;
    const bf16_t* Q = (const bf16_t*)(F.ws + WS_WMOE);
    const bf16_t* Kb = (const bf16_t*)(F.ws + WS_R2 + R2_K); const bf16_t* Vb = (const bf16_t*)(F.ws + WS_R2 + R2_V);
    bf16_t* CAT = (bf16_t*)(F.ws + WS_ACT);
    const int l31 = F.lane & 31, hh = F.lane >> 5;
    const int vcu = (F.G % 8 == 0) ? (F.bid % 8) * (F.G / 8) + F.bid / 8 : F.bid;
    const int kc0 = F.tid, kc1 = F.tid + 512;
    const unsigned kd0 = (unsigned)((kc0 / 12) * KROWB + (kc0 % 12) * 16), kd1 = (unsigned)((kc1 / 12) * KROWB + (kc1 % 12) * 16);
    const int vkey = F.tid >> 3, vpos = (vkey & ~12) | ((vkey & 4) << 1) | ((vkey & 8) >> 1);
    const unsigned vd = (unsigned)(((F.tid & 7) * 8) * VROWB + vpos * 2);
    for (int u = vcu; u < 2048; u += F.G) {
        const int bh = u >> 5, qblk = u & 31, b = bh >> 3, h = bh & 7;
        const size_t trow = (size_t)b * SEQ + qblk * 256 + F.wave * 32 + l31;
        s16x8 qf[6];
        { const bf16_t* qp = Q + trow * 768 + h * 96 + hh * 8;
#pragma unroll
          for (int ds = 0; ds < 6; ++ds) qf[ds] = *(const s16x8*)(qp + ds * 16); }
        f32x16 o0, o1;
#pragma unroll
        for (int i = 0; i < 16; ++i) { o0[i] = 0.f; o1[i] = 0.f; }
        float m = -1.0e30f, lsum = 0.f;
        const bf16_t* kg = Kb + (size_t)bh * NK * 96; const bf16_t* vg = Vb + (size_t)bh * NK * 64;
        u32x4 kr0, kr1 = {0u, 0u, 0u, 0u}, vr;
        kr0 = *(const u32x4*)(kg + (size_t)kc0 * 8); if (kc1 < 768) kr1 = *(const u32x4*)(kg + (size_t)kc1 * 8); vr = *(const u32x4*)(vg + (size_t)F.tid * 8);
        __syncthreads();
        for (int t = 0; t < NT; ++t) {
            { LAS unsigned char* kbuf = F.lds + (t & 1) * BUFB; LAS unsigned char* vbuf = kbuf + KBYTES;
              *(LAS u32x4*)(kbuf + kd0) = kr0; if (kc1 < 768) *(LAS u32x4*)(kbuf + kd1) = kr1;
              LAS unsigned short* vp = (LAS unsigned short*)(vbuf + vd);
              vp[0 * (VROWB / 2)] = (unsigned short)(vr.x & 0xffffu); vp[1 * (VROWB / 2)] = (unsigned short)(vr.x >> 16);
              vp[2 * (VROWB / 2)] = (unsigned short)(vr.y & 0xffffu); vp[3 * (VROWB / 2)] = (unsigned short)(vr.y >> 16);
              vp[4 * (VROWB / 2)] = (unsigned short)(vr.z & 0xffffu); vp[5 * (VROWB / 2)] = (unsigned short)(vr.z >> 16);
              vp[6 * (VROWB / 2)] = (unsigned short)(vr.w & 0xffffu); vp[7 * (VROWB / 2)] = (unsigned short)(vr.w >> 16); }
            __syncthreads();
            if (t + 1 < NT) { const bf16_t* kt = kg + (size_t)(t + 1) * 64 * 96; const bf16_t* vt = vg + (size_t)(t + 1) * 64 * 64;
                kr0 = *(const u32x4*)(kt + (size_t)kc0 * 8); if (kc1 < 768) kr1 = *(const u32x4*)(kt + (size_t)kc1 * 8); vr = *(const u32x4*)(vt + (size_t)F.tid * 8); }
            const LAS unsigned char* kbuf = F.lds + (t & 1) * BUFB; const LAS unsigned char* vbuf = kbuf + KBYTES;
            f32x16 s0, s1;
#pragma unroll
            for (int i = 0; i < 16; ++i) { s0[i] = 0.f; s1[i] = 0.f; }
#pragma unroll
            for (int ds = 0; ds < 6; ++ds) {
                const s16x8 a0 = *(const LAS s16x8*)(kbuf + l31 * KROWB + ds * 32 + hh * 16);
                const s16x8 a1 = *(const LAS s16x8*)(kbuf + (32 + l31) * KROWB + ds * 32 + hh * 16);
                s0 = __builtin_amdgcn_mfma_f32_32x32x16_bf16(a0, qf[ds], s0, 0, 0, 0);
                s1 = __builtin_amdgcn_mfma_f32_32x32x16_bf16(a1, qf[ds], s1, 0, 0, 0);
            }
            float mx = s0[0];
#pragma unroll
            for (int i = 1; i < 16; ++i) mx = fmaxf(mx, s0[i]);
#pragma unroll
            for (int i = 0; i < 16; ++i) mx = fmaxf(mx, s1[i]);
            mx = fmaxf(mx, __shfl_xor(mx, 32));
            const float mn = fmaxf(m, mx); const bool moved = __any(mn > m); const float alpha = __builtin_amdgcn_exp2f(m - mn); m = mn;
            float ps = 0.f;
#pragma unroll
            for (int i = 0; i < 16; ++i) { s0[i] = __builtin_amdgcn_exp2f(s0[i] - mn); s1[i] = __builtin_amdgcn_exp2f(s1[i] - mn); ps += s0[i] + s1[i]; }
            lsum = lsum * alpha + ps;
            if (moved) {
#pragma unroll
                for (int i = 0; i < 16; ++i) { o0[i] *= alpha; o1[i] *= alpha; } }
#pragma unroll
            for (int kb = 0; kb < 2; ++kb)
#pragma unroll
                for (int st = 0; st < 2; ++st) {
                    u32x4 pw;
                    if (kb == 0) { pw.x = pack2(s0[8 * st + 0], s0[8 * st + 1]); pw.y = pack2(s0[8 * st + 2], s0[8 * st + 3]); pw.z = pack2(s0[8 * st + 4], s0[8 * st + 5]); pw.w = pack2(s0[8 * st + 6], s0[8 * st + 7]); }
                    else         { pw.x = pack2(s1[8 * st + 0], s1[8 * st + 1]); pw.y = pack2(s1[8 * st + 2], s1[8 * st + 3]); pw.z = pack2(s1[8 * st + 4], s1[8 * st + 5]); pw.w = pack2(s1[8 * st + 6], s1[8 * st + 7]); }
                    const s16x8 pf = __builtin_bit_cast(s16x8, pw);
                    const int kof = (kb * 32 + 16 * st + 8 * hh) * 2;
                    o0 = __builtin_amdgcn_mfma_f32_32x32x16_bf16(*(const LAS s16x8*)(vbuf + l31 * VROWB + kof), pf, o0, 0, 0, 0);
                    o1 = __builtin_amdgcn_mfma_f32_32x32x16_bf16(*(const LAS s16x8*)(vbuf + (32 + l31) * VROWB + kof), pf, o1, 0, 0, 0);
                }
        }
        const float ltot = lsum + __shfl_xor(lsum, 32); const float inv = 1.f / ltot;
        bf16_t* dst = CAT + trow * 1024 + 512 + h * 64 + hh * 4;
#pragma unroll
        for (int g = 0; g < 4; ++g) { u32x2 w;
            w.x = pack2(o0[4 * g] * inv, o0[4 * g + 1] * inv); w.y = pack2(o0[4 * g + 2] * inv, o0[4 * g + 3] * inv); *(u32x2*)(dst + g * 8) = w;
            w.x = pack2(o1[4 * g] * inv, o1[4 * g + 1] * inv); w.y = pack2(o1[4 * g + 2] * inv, o1[4 * g + 3] * inv); *(u32x2*)(dst + 32 + g * 8) = w; }
    }
    __syncthreads();
}

__device__ __forceinline__ void ph_gdn(const Frame& F) {
    const Params& P = *F.P;
    const bf16_t* PX = (const bf16_t*)(F.ws + WS_PX);
    LAS bf16_t* rq = (LAS bf16_t*)F.lds;
    LAS bf16_t* rk = rq + 36 * 128;
    LAS bf16_t* rv = rk + 36 * 128;
    LAS float* qc = (LAS float*)(F.lds + 24576);
    LAS float* kc = qc + 4096;
    LAS float* vc = kc + 4096;
    LAS float* os = vc + 1024;
    LAS float* ba = os + 1024;
    const int dg = F.lane & 15, el = F.wave * 4 + (F.lane >> 4);
    for (int it = F.bid; it < 256; it += F.G) {
        const int b = it >> 5, h = (it >> 3) & 3, dir = (it >> 2) & 1, sl = it & 3;
        bf16_t* O = dir ? (bf16_t*)(F.ws + WS_WMOE) : (bf16_t*)(F.ws + WS_GOF);
        const float a_neg = -__expf(P.in[I_ALOG][dir * 4 + h]), dtb = P.in[I_DTB][dir * 4 + h];
        float cwq[5], cwk[5], cwv[5];
        { const int d = F.tid & 127;
#pragma unroll
          for (int j = 0; j < 5; ++j) { cwq[j] = P.in[I_CONVW][j * 1536 + h * 128 + d]; cwk[j] = P.in[I_CONVW][j * 1536 + 512 + h * 128 + d]; cwv[j] = P.in[I_CONVW][j * 1536 + 1024 + h * 128 + sl * 32 + (F.tid & 31)]; } }
        float S[8];
#pragma unroll
        for (int i = 0; i < 8; ++i) S[i] = 0.f;
        u32x4 pr0, pr1, pr2; float pbeta = 0.f, pdec = 0.f;
        auto blk_geom = [&](int bi, int& len, size_t& rbase, int& p0) { const bool c = bi < 8; len = c ? CTXL : SEQ; rbase = c ? (size_t)TL + b * CTXL : (size_t)b * SEQ;
            const int nbk = len / 32, k = c ? bi : bi - 8; p0 = (dir ? (nbk - 1 - k) : k) * 32; };
        auto fetch = [&](int bi, int id) -> u32x4 { int len, p0; size_t rbase; blk_geom(bi, len, rbase, p0);
            u32x4 z = {0u, 0u, 0u, 0u}; if (id >= 1296) return z;
            int arr = 0, j = id; if (j >= 1152) { arr = 2; j -= 1152; } else if (j >= 576) { arr = 1; j -= 576; }
            const int rr = arr == 2 ? (j >> 2) : (j >> 4), part = arr == 2 ? (j & 3) : (j & 15); const int p = p0 - 2 + rr;
            if (p < 0 || p >= len) return z;
            const bf16_t* row = PX + (rbase + p) * ODD_PAD + (arr == 0 ? h * 128 : (arr == 1 ? 512 + h * 128 : 1024 + h * 128 + sl * 32)) + part * 8;
            return *(const u32x4*)row; };
        auto stash = [&](int id, u32x4 w) { if (id >= 1296) return; int arr = 0, j = id; if (j >= 1152) { arr = 2; j -= 1152; } else if (j >= 576) { arr = 1; j -= 576; }
            LAS bf16_t* d = arr == 0 ? rq + j * 8 : (arr == 1 ? rk + j * 8 : rv + j * 8); *(LAS u32x4*)d = w; };
        auto fetch_all = [&](int bi) { pr0 = fetch(bi, F.tid); pr1 = fetch(bi, F.tid + 512); pr2 = fetch(bi, F.tid + 1024);
            if (F.tid < 32) { int len, p0; size_t rbase; blk_geom(bi, len, rbase, p0); const bf16_t* row = PX + (rbase + p0 + F.tid) * ODD_PAD;
                pbeta = bf2f(row[2048 + dir * 4 + h]); pdec = bf2f(row[2056 + dir * 4 + h]); } };
        fetch_all(0);
        for (int bi = 0; bi < 264; ++bi) {
            __syncthreads();
            stash(F.tid, pr0); stash(F.tid + 512, pr1); stash(F.tid + 1024, pr2);
            if (F.tid < 32) { ba[F.tid] = sigmoid_f(pbeta); ba[32 + F.tid] = __expf(a_neg * softplus_f(pdec + dtb)); }
            __syncthreads();
            if (bi + 1 < 264) fetch_all(bi + 1);
            { const int d = F.tid & 127;
#pragma unroll
              for (int i = 0; i < 8; ++i) { const int s = (F.tid >> 7) + i * 4; float a = 0.f, c = 0.f;
#pragma unroll
                for (int j = 0; j < 5; ++j) { a += bf2f(rq[(s + j) * 128 + d]) * cwq[j]; c += bf2f(rk[(s + j) * 128 + d]) * cwk[j]; }
                qc[s * 128 + d] = silu_f(a); kc[s * 128 + d] = silu_f(c); }
#pragma unroll
              for (int i = 0; i < 2; ++i) { const int s = (F.tid >> 5) + i * 16, e = F.tid & 31; float a = 0.f;
#pragma unroll
                for (int j = 0; j < 5; ++j) a += bf2f(rv[(s + j) * 32 + e]) * cwv[j];
                vc[s * 32 + e] = silu_f(a); } }
            __syncthreads();
            { const int s = F.wave * 4 + (F.lane >> 4);
              LAS float* qp = qc + s * 128 + dg * 8; LAS float* kp = kc + s * 128 + dg * 8;
              f32x4 q0 = *(LAS f32x4*)qp, q1 = *(LAS f32x4*)(qp + 4), k0 = *(LAS f32x4*)kp, k1 = *(LAS f32x4*)(kp + 4);
              float sq = 0.f, sk = 0.f;
#pragma unroll
              for (int i = 0; i < 4; ++i) { sq += q0[i] * q0[i] + q1[i] * q1[i]; sk += k0[i] * k0[i] + k1[i] * k1[i]; }
              sq = sum16(sq); sk = sum16(sk);
              const float rq_ = rsqrtf(sq + EPS) * 0.08838834764831845f, rk_ = rsqrtf(sk + EPS);
              *(LAS f32x4*)qp = q0 * rq_; *(LAS f32x4*)(qp + 4) = q1 * rq_; *(LAS f32x4*)kp = k0 * rk_; *(LAS f32x4*)(kp + 4) = k1 * rk_; }
            __syncthreads();
#pragma unroll 2
            for (int ss = 0; ss < 32; ++ss) {
                const int st = dir ? 31 - ss : ss;
                const f32x4 ka = *(const LAS f32x4*)(kc + st * 128 + dg * 8), kb = *(const LAS f32x4*)(kc + st * 128 + dg * 8 + 4);
                const f32x4 qa = *(const LAS f32x4*)(qc + st * 128 + dg * 8), qb = *(const LAS f32x4*)(qc + st * 128 + dg * 8 + 4);
                const float v = vc[st * 32 + el], beta = ba[st], a = ba[32 + st];
                float r0 = 0.f, r1 = 0.f;
#pragma unroll
                for (int i = 0; i < 4; ++i) { r0 += ka[i] * S[i]; r1 += kb[i] * S[4 + i]; }
                const float r = sum16(r0 + r1);
                const float u = beta * (v - a * r);
                float p0 = 0.f, p1 = 0.f;
#pragma unroll
                for (int i = 0; i < 4; ++i) { S[i] = a * S[i] + ka[i] * u; p0 += qa[i] * S[i]; S[4 + i] = a * S[4 + i] + kb[i] * u; p1 += qb[i] * S[4 + i]; }
                const float o = sum16(p0 + p1);
                if (dg == 0) os[st * 32 + el] = o;
            }
            __syncthreads();
            { int len, p0; size_t rbase; blk_geom(bi, len, rbase, p0);
              const int s = F.tid >> 4, e2 = (F.tid & 15) * 2;
              *(unsigned*)(O + (rbase + p0 + s) * 512 + h * 128 + sl * 32 + e2) = pack2(os[s * 32 + e2], os[s * 32 + e2 + 1]); }
        }
        __syncthreads();
    }
}

constexpr int GR_KN = 0, GR_QN = 16384, GR_VT = 32768, GR_T = 49152, GR_QK = 65536, GR_SC = 81920, GR_BYTES = 83968;
__device__ __forceinline__ s16x8 pack8(const f32x16& x, int s8) {
    u32x4 p; p.x = pack2(x[s8 + 0], x[s8 + 1]); p.y = pack2(x[s8 + 2], x[s8 + 3]); p.z = pack2(x[s8 + 4], x[s8 + 5]); p.w = pack2(x[s8 + 6], x[s8 + 7]);
    return __builtin_bit_cast(s16x8, p);
}
__device__ __forceinline__ s16x8 ld2x64(const LAS unsigned char* p) {
    const u32x2 a = *(const LAS u32x2*)p, b = *(const LAS u32x2*)(p + 16); u32x4 v; v.x = a.x; v.y = a.y; v.z = b.x; v.w = b.y; return __builtin_bit_cast(s16x8, v);
}
__device__ __forceinline__ void st2x64(LAS unsigned char* p, u32x4 v) { u32x2 a, b; a.x = v.x; a.y = v.y; b.x = v.z; b.y = v.w; *(LAS u32x2*)p = a; *(LAS u32x2*)(p + 8) = b; }
__device__ __forceinline__ u32x4 ld2x64n(const LAS unsigned char* p) { const u32x2 a = *(const LAS u32x2*)p, b = *(const LAS u32x2*)(p + 8); u32x4 v; v.x = a.x; v.y = a.y; v.z = b.x; v.w = b.y; return v; }
__device__ __forceinline__ void gdn_unit_geom(int b, int ck, size_t& rbase, int& len, int& p0) {
    if (ck < 4) { rbase = (size_t)TL + b * CTXL; len = CTXL; p0 = ck * 64; } else { rbase = (size_t)b * SEQ; len = SEQ; p0 = (ck - 4) * 64; }
}
__device__ __forceinline__ void ph_gdn_prep(const Frame& F) {
    const Params& P = *F.P;
    const bf16_t* PX = (const bf16_t*)(F.ws + WS_PX);
    LAS unsigned char* L = F.lds;
    LAS bf16_t* RAW = (LAS bf16_t*)L;
    LAS unsigned char* KNI = L; LAS unsigned char* QNI = L + 16896;
    LAS float* qf = (LAS float*)(L + 52224);
    LAS float* kf = qf + 8192;
    LAS unsigned char* VTI = L + 52224 + 65536;
    LAS float* SCL = (LAS float*)(L + 52224 + 65536 + 17408);
    const int l31 = F.lane & 31, hh = F.lane >> 5;
    for (int u = F.bid; u < 4224; u += F.G) {
        const int b = u / 528, h = (u % 528) / 132, ck = u % 132;
        size_t rbase; int len, p0; gdn_unit_geom(b, ck, rbase, len, p0);
        unsigned char* rec = F.ws + WS_GREC + (size_t)u * GR_BYTES;
        for (int c = F.tid; c < 68 * 48; c += NTH) { const int rr = c / 48, part = c % 48; const int p = p0 - 2 + rr; u32x4 w = {0u, 0u, 0u, 0u};
            if (p >= 0 && p < len) w = *(const u32x4*)(PX + (rbase + p) * ODD_PAD + (part >> 4) * 512 + h * 128 + (part & 15) * 8);
            *(LAS u32x4*)(RAW + rr * 384 + part * 8) = w; }
        if (F.tid < 64) { const bf16_t* row = PX + (rbase + p0 + F.tid) * ODD_PAD;
            const float an_f = -__expf(P.in[I_ALOG][h]), an_b = -__expf(P.in[I_ALOG][4 + h]);
            SCL[256 + F.tid] = sigmoid_f(bf2f(row[2048 + h])); SCL[320 + F.tid] = sigmoid_f(bf2f(row[2052 + h]));
            SCL[F.tid] = an_f * softplus_f(bf2f(row[2056 + h]) + P.in[I_DTB][h]); SCL[64 + F.tid] = an_b * softplus_f(bf2f(row[2060 + h]) + P.in[I_DTB][4 + h]); }
        __syncthreads();
        { const int d = F.tid & 127, rg = F.tid >> 7;
          float cq[5], ckk[5], cv[5];
#pragma unroll
          for (int j = 0; j < 5; ++j) { cq[j] = P.in[I_CONVW][j * 1536 + h * 128 + d]; ckk[j] = P.in[I_CONVW][j * 1536 + 512 + h * 128 + d]; cv[j] = P.in[I_CONVW][j * 1536 + 1024 + h * 128 + d]; }
#pragma unroll 4
          for (int ii = 0; ii < 16; ++ii) { const int i = rg * 16 + ii; float a = 0.f, c = 0.f, e = 0.f;
#pragma unroll
              for (int j = 0; j < 5; ++j) { const LAS bf16_t* rr = RAW + (i + j) * 384 + d; a += bf2f(rr[0]) * cq[j]; c += bf2f(rr[128]) * ckk[j]; e += bf2f(rr[256]) * cv[j]; }
              qf[i * 128 + d] = silu_f(a); kf[i * 128 + d] = silu_f(c);
              *(LAS bf16_t*)(VTI + d * 136 + i * 2) = f2bf(silu_f(e)); } }
        if (F.tid < 64) { float gf = 0.f, gb = 0.f;
            for (int j = 0; j < 64; ++j) { gf += (j <= F.tid) ? SCL[j] : 0.f; gb += (j >= F.tid) ? SCL[64 + j] : 0.f; }
            SCL[128 + F.tid] = gf; SCL[192 + F.tid] = gb; }
        __syncthreads();
#pragma unroll
        for (int rr = 0; rr < 8; ++rr) { const int i = F.wave * 8 + rr;
            const float q0 = qf[i * 128 + F.lane], q1 = qf[i * 128 + 64 + F.lane], k0 = kf[i * 128 + F.lane], k1 = kf[i * 128 + 64 + F.lane];
            const float sq = wave_sum(q0 * q0 + q1 * q1), sk = wave_sum(k0 * k0 + k1 * k1);
            const float rq_ = rsqrtf(sq + EPS) * 0.08838834764831845f, rk_ = rsqrtf(sk + EPS);
            *(LAS bf16_t*)(QNI + i * 264 + F.lane * 2) = f2bf(q0 * rq_); *(LAS bf16_t*)(QNI + i * 264 + 128 + F.lane * 2) = f2bf(q1 * rq_);
            *(LAS bf16_t*)(KNI + i * 264 + F.lane * 2) = f2bf(k0 * rk_); *(LAS bf16_t*)(KNI + i * 264 + 128 + F.lane * 2) = f2bf(k1 * rk_); }
        __syncthreads();
        { const int mq = F.wave >> 2, ib = (F.wave >> 1) & 1, jb = F.wave & 1;
          const LAS unsigned char* Ai = (mq ? QNI : KNI) + (32 * ib + l31) * 264 + hh * 16; const LAS unsigned char* Bi = KNI + (32 * jb + l31) * 264 + hh * 16;
          f32x16 acc;
#pragma unroll
          for (int r = 0; r < 16; ++r) acc[r] = 0.f;
#pragma unroll
          for (int ds = 0; ds < 8; ++ds) acc = __builtin_amdgcn_mfma_f32_32x32x16_bf16(__builtin_bit_cast(s16x8, ld2x64n(Ai + ds * 32)), __builtin_bit_cast(s16x8, ld2x64n(Bi + ds * 32)), acc, 0, 0, 0);
          __syncthreads();
          const int j = 32 * jb + l31; const float gfj = SCL[128 + j], gbj = SCL[192 + j];
          bf16_t* qkf = (bf16_t*)(rec + GR_QK); bf16_t* qkb = qkf + 4096;
#pragma unroll
          for (int r = 0; r < 16; ++r) { const int i = 32 * ib + (r & 3) + 8 * (r >> 2) + 4 * hh;
              const float ef = __expf(fminf(SCL[128 + i] - gfj, 0.f)), eb = __expf(fminf(SCL[192 + i] - gbj, 0.f));
              if (mq == 0) { qf[i * 64 + j] = (j < i) ? SCL[256 + i] * acc[r] * ef : 0.f; kf[(63 - i) * 64 + (63 - j)] = (j > i) ? SCL[320 + i] * acc[r] * eb : 0.f; }
              else { qkf[i * 64 + j] = f2bf((j <= i) ? acc[r] * ef : 0.f); qkb[i * 64 + j] = f2bf((j >= i) ? acc[r] * eb : 0.f); } } }
        __syncthreads();
        if (F.wave < 2) {
            const LAS float* Am = F.wave == 0 ? qf : kf; LAS float* Tl = (F.wave == 0 ? qf : kf) + 4096; const int c = F.lane;
            for (int i = 0; i < 64; ++i) Tl[i * 64 + c] = 0.f;
#pragma unroll
            for (int rb = 0; rb < 4; ++rb) {
#pragma unroll 1
                for (int ii = 0; ii < 16; ++ii) { const int i = rb * 16 + ii; float a0 = (c == i) ? 1.f : 0.f, a1 = 0.f;
#pragma unroll
                    for (int jg = 0; jg < 4 * (rb + 1); ++jg) { const f32x4 m = *(const LAS f32x4*)(Am + i * 64 + jg * 4);
                        a0 -= m[0] * Tl[(jg * 4 + 0) * 64 + c]; a1 -= m[1] * Tl[(jg * 4 + 1) * 64 + c]; a0 -= m[2] * Tl[(jg * 4 + 2) * 64 + c]; a1 -= m[3] * Tl[(jg * 4 + 3) * 64 + c]; }
                    Tl[i * 64 + c] = a0 + a1; } }
            bf16_t* Tg = (bf16_t*)(rec + GR_T) + (F.wave ? 4096 : 0);
            for (int i = 0; i < 64; ++i) { const bf16_t v = f2bf(Tl[i * 64 + c]); if (F.wave == 0) Tg[i * 64 + c] = v; else Tg[(63 - i) * 64 + (63 - c)] = v; }
        } else {
            const int t6 = F.tid - 128;
            for (int c = t6; c < 3072; c += 384) {
                u32x4 w; if (c < 2048) { const int cc = c & 1023, row = cc >> 4, part = cc & 15; w = ld2x64n((c < 1024 ? KNI : QNI) + row * 264 + part * 16); }
                else { const int cc = c - 2048, row = cc >> 3, part = cc & 7; w = ld2x64n(VTI + row * 136 + part * 16); }
                *(u32x4*)(rec + (size_t)c * 16) = w; }
            if (t6 < 64) { float* sc = (float*)(rec + GR_SC); const int i = t6;
                const float gf = SCL[128 + i], gb = SCL[192 + i], glf = SCL[128 + 63], glb = SCL[192 + 0];
                sc[i] = SCL[256 + i]; sc[64 + i] = __expf(gf); sc[128 + i] = __expf(glf - gf);
                sc[192 + i] = SCL[320 + i]; sc[256 + i] = __expf(gb); sc[320 + i] = __expf(glb - gb);
                if (i == 0) { sc[384] = __expf(glf); sc[385] = __expf(glb); } }
        }
        __syncthreads();
    }
}

__device__ __forceinline__ void ph_gdn_scan(const Frame& F) {
    LAS unsigned char* L = F.lds;
    LAS unsigned char* KNI = L;
    LAS unsigned char* QNI = L + 16896;
    LAS unsigned char* VTI = L + 33792;
    LAS unsigned char* KTI = L + 51200;
    LAS unsigned char* TI = L + 68608;
    LAS unsigned char* QKI = L + 77312;
    LAS float* SC = (LAS float*)(L + 86016);
    const int l31 = F.lane & 31, hh = F.lane >> 5, w = F.wave;
    for (int it = F.bid; it < 64; it += F.G) {
        const int b = it >> 3, h = (it >> 1) & 3, dir = it & 1;
        bf16_t* O = dir ? (bf16_t*)(F.ws + WS_WMOE) : (bf16_t*)(F.ws + WS_GOF);
        f32x16 S0, S1, S2, S3;
#pragma unroll
        for (int r = 0; r < 16; ++r) { S0[r] = 0.f; S1[r] = 0.f; S2[r] = 0.f; S3[r] = 0.f; }
        u32x4 pre[16]; float psc = 0.f;
        const int t4 = F.tid - 256;
        auto ckof = [&](int n) -> int { return dir ? (n < 4 ? 3 - n : 135 - n) : n; };
        auto fetch = [&](int n) { const unsigned char* rec = F.ws + WS_GREC + (size_t)((b * 4 + h) * 132 + ckof(n)) * GR_BYTES;
#pragma unroll
            for (int k = 0; k < 12; ++k) pre[k] = *(const u32x4*)(rec + (size_t)(t4 + 256 * k) * 16);
#pragma unroll
            for (int k = 0; k < 2; ++k) { pre[12 + k] = *(const u32x4*)(rec + GR_T + dir * 8192 + (t4 + 256 * k) * 16); pre[14 + k] = *(const u32x4*)(rec + GR_QK + dir * 8192 + (t4 + 256 * k) * 16); }
            if (t4 < 193) psc = ((const float*)(rec + GR_SC))[t4 < 192 ? dir * 192 + t4 : 384 + dir]; };
        if (w >= 4) {
            fetch(0);
            for (int n = 0; n < 132; ++n) {
                __syncthreads();
#pragma unroll
                for (int k = 0; k < 4; ++k) { const int c = t4 + 256 * k, row = c >> 4, part = c & 15; st2x64(KNI + row * 264 + part * 16, pre[k]);
                    LAS unsigned short* kt = (LAS unsigned short*)(KTI + (part * 8) * 136 + row * 2); const u32x4 v = pre[k];
                    kt[0 * 68] = (unsigned short)(v.x & 0xffffu); kt[1 * 68] = (unsigned short)(v.x >> 16); kt[2 * 68] = (unsigned short)(v.y & 0xffffu); kt[3 * 68] = (unsigned short)(v.y >> 16);
                    kt[4 * 68] = (unsigned short)(v.z & 0xffffu); kt[5 * 68] = (unsigned short)(v.z >> 16); kt[6 * 68] = (unsigned short)(v.w & 0xffffu); kt[7 * 68] = (unsigned short)(v.w >> 16); }
#pragma unroll
                for (int k = 4; k < 8; ++k) { const int c = t4 + 256 * (k - 4), row = c >> 4, part = c & 15; st2x64(QNI + row * 264 + part * 16, pre[k]); }
#pragma unroll
                for (int k = 8; k < 12; ++k) { const int c = t4 + 256 * (k - 8), row = c >> 3, part = c & 7; st2x64(VTI + row * 136 + part * 16, pre[k]); }
#pragma unroll
                for (int k = 0; k < 2; ++k) { const int c = t4 + 256 * k, row = c >> 3, part = c & 7; st2x64(TI + row * 136 + part * 16, pre[12 + k]); st2x64(QKI + row * 136 + part * 16, pre[14 + k]); }
                if (t4 < 193) SC[t4] = psc;
                __syncthreads();
                if (n + 1 < 132) fetch(n + 1);
            }
        } else
        for (int n = 0; n < 132; ++n) {
            __syncthreads();
            __syncthreads();
            {
                size_t rbase; int len, p0; gdn_unit_geom(b, ckof(n), rbase, len, p0);
                const float alast = SC[192];
                f32x16 P0, P1;
#pragma unroll
                for (int r = 0; r < 16; ++r) { P0[r] = 0.f; P1[r] = 0.f; }
#pragma unroll
                for (int hq = 0; hq < 2; ++hq) { s16x8 fa[4], fb[4];
#pragma unroll
                  for (int q4 = 0; q4 < 4; ++q4) { const int q = hq * 4 + q4; const int co = (32 * (q >> 1) + 16 * (q & 1) + 4 * hh) * 2; fa[q4] = ld2x64(KNI + l31 * 264 + co); fb[q4] = ld2x64(KNI + (32 + l31) * 264 + co); }
#pragma unroll
                  for (int q4 = 0; q4 < 4; ++q4) { const int q = hq * 4 + q4; const int r = q >> 1; const s16x8 sb = pack8(r == 0 ? S0 : (r == 1 ? S1 : (r == 2 ? S2 : S3)), 8 * (q & 1));
                      P0 = __builtin_amdgcn_mfma_f32_32x32x16_bf16(fa[q4], sb, P0, 0, 0, 0); P1 = __builtin_amdgcn_mfma_f32_32x32x16_bf16(fb[q4], sb, P1, 0, 0, 0); } }
#pragma unroll
                for (int gq = 0; gq < 4; ++gq) {
#pragma unroll
                    for (int ib = 0; ib < 2; ++ib) { const int i0 = 32 * ib + 8 * gq + 4 * hh;
                        const f32x4 be = *(const LAS f32x4*)(SC + i0), eg = *(const LAS f32x4*)(SC + 64 + i0);
                        const u32x2 vv = *(const LAS u32x2*)(VTI + (32 * w + l31) * 136 + i0 * 2);
                        const float v0 = lo2f(vv.x), v1 = hi2f(vv.x), v2 = lo2f(vv.y), v3 = hi2f(vv.y);
                        if (ib == 0) { P0[4 * gq + 0] = be[0] * (v0 - eg[0] * P0[4 * gq + 0]); P0[4 * gq + 1] = be[1] * (v1 - eg[1] * P0[4 * gq + 1]); P0[4 * gq + 2] = be[2] * (v2 - eg[2] * P0[4 * gq + 2]); P0[4 * gq + 3] = be[3] * (v3 - eg[3] * P0[4 * gq + 3]); }
                        else         { P1[4 * gq + 0] = be[0] * (v0 - eg[0] * P1[4 * gq + 0]); P1[4 * gq + 1] = be[1] * (v1 - eg[1] * P1[4 * gq + 1]); P1[4 * gq + 2] = be[2] * (v2 - eg[2] * P1[4 * gq + 2]); P1[4 * gq + 3] = be[3] * (v3 - eg[3] * P1[4 * gq + 3]); } } }
                f32x16 V0, V1;
#pragma unroll
                for (int r = 0; r < 16; ++r) { V0[r] = 0.f; V1[r] = 0.f; }
#pragma unroll
                for (int jb = 0; jb < 2; ++jb)
#pragma unroll
                    for (int s = 0; s < 2; ++s) { const s16x8 pb = pack8(jb == 0 ? P0 : P1, 8 * s); const int co = (32 * jb + 16 * s + 4 * hh) * 2;
                        V0 = __builtin_amdgcn_mfma_f32_32x32x16_bf16(ld2x64(TI + l31 * 136 + co), pb, V0, 0, 0, 0);
                        V1 = __builtin_amdgcn_mfma_f32_32x32x16_bf16(ld2x64(TI + (32 + l31) * 136 + co), pb, V1, 0, 0, 0); }
                f32x16 T0, T1;
#pragma unroll
                for (int r = 0; r < 16; ++r) { T0[r] = 0.f; T1[r] = 0.f; }
#pragma unroll
                for (int r = 0; r < 4; ++r)
#pragma unroll
                    for (int s = 0; s < 2; ++s) { const s16x8 sa = pack8(r == 0 ? S0 : (r == 1 ? S1 : (r == 2 ? S2 : S3)), 8 * s);
                        const int co = (32 * r + 16 * s + 4 * hh) * 2;
                        T0 = __builtin_amdgcn_mfma_f32_32x32x16_bf16(sa, ld2x64(QNI + l31 * 264 + co), T0, 0, 0, 0);
                        T1 = __builtin_amdgcn_mfma_f32_32x32x16_bf16(sa, ld2x64(QNI + (32 + l31) * 264 + co), T1, 0, 0, 0); }
                { const float e0 = SC[64 + l31], e1 = SC[64 + 32 + l31];
#pragma unroll
                  for (int r = 0; r < 16; ++r) { T0[r] *= e0; T1[r] *= e1; } }
#pragma unroll
                for (int jb = 0; jb < 2; ++jb)
#pragma unroll
                    for (int s = 0; s < 2; ++s) { const s16x8 va = pack8(jb == 0 ? V0 : V1, 8 * s); const int co = (32 * jb + 16 * s + 4 * hh) * 2;
                        T0 = __builtin_amdgcn_mfma_f32_32x32x16_bf16(va, ld2x64(QKI + l31 * 136 + co), T0, 0, 0, 0);
                        T1 = __builtin_amdgcn_mfma_f32_32x32x16_bf16(va, ld2x64(QKI + (32 + l31) * 136 + co), T1, 0, 0, 0); }
                { bf16_t* o0 = O + (rbase + p0 + l31) * 512 + h * 128 + 32 * w + 4 * hh; bf16_t* o1 = o0 + (size_t)32 * 512;
#pragma unroll
                  for (int gq = 0; gq < 4; ++gq) { u32x2 x; x.x = pack2(T0[4 * gq], T0[4 * gq + 1]); x.y = pack2(T0[4 * gq + 2], T0[4 * gq + 3]); *(u32x2*)(o0 + gq * 8) = x;
                      x.x = pack2(T1[4 * gq], T1[4 * gq + 1]); x.y = pack2(T1[4 * gq + 2], T1[4 * gq + 3]); *(u32x2*)(o1 + gq * 8) = x; } }
#pragma unroll
                for (int gq = 0; gq < 4; ++gq) { const f32x4 c0 = *(const LAS f32x4*)(SC + 128 + 8 * gq + 4 * hh), c1 = *(const LAS f32x4*)(SC + 128 + 32 + 8 * gq + 4 * hh);
#pragma unroll
                    for (int q = 0; q < 4; ++q) { V0[4 * gq + q] *= c0[q]; V1[4 * gq + q] *= c1[q]; } }
#pragma unroll
                for (int r = 0; r < 16; ++r) { S0[r] *= alast; S1[r] *= alast; S2[r] *= alast; S3[r] *= alast; }
#pragma unroll
                for (int hq = 0; hq < 2; ++hq) { s16x8 fk[8];
#pragma unroll
                  for (int q2 = 0; q2 < 2; ++q2) { const int q = hq * 2 + q2; const int co = (32 * (q >> 1) + 16 * (q & 1) + 4 * hh) * 2;
#pragma unroll
                      for (int r = 0; r < 4; ++r) fk[q2 * 4 + r] = ld2x64(KTI + (32 * r + l31) * 136 + co); }
#pragma unroll
                  for (int q2 = 0; q2 < 2; ++q2) { const int q = hq * 2 + q2; const s16x8 vb = pack8((q >> 1) == 0 ? V0 : V1, 8 * (q & 1));
                      S0 = __builtin_amdgcn_mfma_f32_32x32x16_bf16(fk[q2 * 4 + 0], vb, S0, 0, 0, 0); S1 = __builtin_amdgcn_mfma_f32_32x32x16_bf16(fk[q2 * 4 + 1], vb, S1, 0, 0, 0);
                      S2 = __builtin_amdgcn_mfma_f32_32x32x16_bf16(fk[q2 * 4 + 2], vb, S2, 0, 0, 0); S3 = __builtin_amdgcn_mfma_f32_32x32x16_bf16(fk[q2 * 4 + 3], vb, S3, 0, 0, 0); } }
            }
        }
        __syncthreads();
    }
}

#ifndef FAST_ATTN
#define FAST_ATTN 1
#endif
constexpr int NPHASES = 27;
__global__ void __launch_bounds__(NTH, 2) fwd(Params P) {
    extern __shared__ __attribute__((aligned(16))) unsigned char lds_raw[];
    Frame F; F.P = &P; F.ws = P.ws; F.lds = (LAS unsigned char*)lds_raw;
    F.tid = threadIdx.x; F.lane = F.tid & 63; F.wave = __builtin_amdgcn_readfirstlane(F.tid >> 6); F.G = gridDim.x; F.bid = blockIdx.x;
    F.mod = (float*)(P.ws + WS_CTRL + C_MOD); F.ctrl = (unsigned*)(P.ws + WS_CTRL);
    volatile LAS unsigned* xbw = (volatile LAS unsigned*)(F.lds + LDS_BYTES - 16);
    if (F.tid < 4) xbw[F.tid] = 0u;
    __syncthreads();
    const int lo = P.ph_lo, hi = P.ph_hi;
    const bool single = (hi - lo) > 1;
    XcdBarrier bar; bar.bar = F.ctrl; bar.x = 0; bar.st = xbw;
    if (single) bar = xcd_barrier_post(F.ctrl, xbw);
#ifndef PH_MASK
#define PH_MASK 0xffffffffu
#endif
#define IN(k) (((PH_MASK >> (k)) & 1u) && lo <= (k) && (k) < hi)
#define SEAM(k) do { if (IN(k) && IN((k) + 1)) xcd_barrier(bar); } while (0)
#ifndef DUP_MASK
#define DUP_MASK 0u
#endif
#define DUP(k) ((DUP_MASK >> (k)) & 1u)
    bf16_t* wsm = (bf16_t*)(P.ws + WS_WSM);
    bf16_t* ACT = (bf16_t*)(P.ws + WS_ACT); bf16_t* PX = (bf16_t*)(P.ws + WS_PX);
    float* XC = (float*)(P.ws + WS_XC);

    if (IN(0)) { ph_prologue(F); if (DUP(0)) { __syncthreads(); conv_moe_weights(F, 0, F.bid, F.G); } xcd_barrier(bar); mod_reduce(F); } SEAM(0);
    if (IN(1)) { ph_rownorm(F, 0, TT, P.in[I_X], P.in[I_CTX], P.in[I_NMIX], 0); if (DUP(1)) ph_rownorm(F, 0, TT, P.in[I_X], P.in[I_CTX], P.in[I_NMIX], 0); } SEAM(1);
    if (IN(2)) { EpiStoreBf16 E{PX, EVEN_IN, 1024}; gemm_dense(F, ACT, wsm + W_EIN / 2, TT, EVEN_IN, 1024, E); if (DUP(2)) gemm_dense(F, ACT, wsm + W_EIN / 2, TT, EVEN_IN, 1024, E); } SEAM(2);
    if (IN(3)) { ph_gmlp(F); if (DUP(3)) { __syncthreads(); ph_gmlp(F); } } SEAM(3);
    if (IN(4)) { ph_gla(F); if (DUP(4)) { __syncthreads(); ph_gla(F); } } SEAM(4);
    if (IN(5)) { ph_merge(F, 0); if (DUP(5)) ph_merge(F, 0); } SEAM(5);
    if (IN(6)) { EpiResidual E{P.in[I_X], P.in[I_CTX], P.out, XC, F.mod, 2}; gemm_dense(F, ACT, wsm + W_EOUT / 2, TT, 1024, 1024, E); } SEAM(6);
    if (IN(7)) { ph_router(F, 0, TT, P.out, XC, P.in[I_NFFN], 3); } SEAM(7);
    if (IN(8)) { ph_dispatch(F, 0, TT); } SEAM(8);
    if (IN(9)) { ph_moe_gemm1(F, 0); if (DUP(9)) ph_moe_gemm1(F, 0); } SEAM(9);
    if (IN(10)) { ph_moe_gemm2(F, 0, 0); } SEAM(10);
    if (IN(11)) { ph_moe_gemm2(F, 0, 1); } SEAM(11);
    if (IN(12)) { ph_rownorm(F, 1, TT, P.out, XC, P.in[I_NMIX] + 1024, 0);
#ifdef DBG_ZERO
        { u32x4 z = {0u, 0u, 0u, 0u}; u32x4* p = (u32x4*)(P.ws + WS_GREC); const size_t n = (size_t)(990 - 585) * MiB / 16;
          for (size_t i = (size_t)F.bid * NTH + F.tid; i < n; i += (size_t)F.G * NTH) p[i] = z;
          u32x4* q = (u32x4*)(P.ws + WS_WMOE); const size_t m = (size_t)66 * MiB / 16;
          for (size_t i = (size_t)F.bid * NTH + F.tid; i < m; i += (size_t)F.G * NTH) q[i] = z; }
#endif
    } SEAM(12);
    if (IN(13)) { EpiStoreBf16 E{PX, ODD_PAD, 0}; gemm_dense(F, ACT, wsm + W_OIN / 2, TT, ODD_PAD, 1024, E); if (DUP(13)) gemm_dense(F, ACT, wsm + W_OIN / 2, TT, ODD_PAD, 1024, E); } SEAM(13);
#ifndef CHUNKED_GDN
#define CHUNKED_GDN 1
#endif
    if (IN(14)) { if (CHUNKED_GDN) ph_gdn_prep(F); } SEAM(14);
    if (IN(15)) { if (CHUNKED_GDN) ph_gdn_scan(F); else ph_gdn(F); } SEAM(15);
    if (IN(16)) { ph_merge(F, 1); ph_mla_norm(F); } SEAM(16);
    if (IN(17)) { }
    if (IN(18)) { const bf16_t* cqn = (const bf16_t*)(P.ws + WS_R2 + R2_CQN);
                  EpiStoreBf16 E1{(bf16_t*)(P.ws + WS_WMOE), 768, 0}; gemm_dense(F, cqn, wsm + W_WQ / 2, TL, 768, 256, E1);
                  EpiStoreBf16 E2{(bf16_t*)(P.ws + WS_PX + PX_KVRAW), 1024, 0}; gemm_dense(F, cqn + (size_t)TL * 256, wsm + W_WKV / 2, TT, 1024, 256, E2); } SEAM(18);
    if (IN(19)) { ph_mla_final(F); } SEAM(19);
    if (IN(20)) { if (FAST_ATTN) ph_attn(F); else ph_attn_naive(F); if (DUP(20)) { __syncthreads(); ph_attn(F); } } SEAM(20);
    if (IN(21)) { EpiResidual E{P.out, P.out, P.out, P.out, F.mod + 9 * 6144, 2}; gemm_dense(F, ACT, wsm + W_OOUT / 2, TL, 1024, 1024, E); } SEAM(21);
    if (IN(22)) { ph_router(F, 1, TL, P.out, XC, P.in[I_NFFN] + 1024, 3); conv_moe_weights(F, 1, F.bid, F.G); } SEAM(22);
    if (IN(23)) { ph_dispatch(F, 1, TL); } SEAM(23);
    if (IN(24)) { ph_moe_gemm1(F, 1); if (DUP(24)) ph_moe_gemm1(F, 1); } SEAM(24);
    if (IN(25)) { ph_moe_gemm2(F, 1, 0); } SEAM(25);
    if (IN(26)) { ph_moe_gemm2(F, 1, 1); }
#undef IN
#undef SEAM
}

#ifndef N_LAUNCH_MODE
#define N_LAUNCH_MODE 1
#endif
extern "C" void kernel_launch(void* const* d_in, const int* in_sizes, int n_in, void* d_out, int out_size, void* d_ws, size_t ws_size, hipStream_t stream) {
    static int grid = 0;
    if (grid == 0) {
        if (n_in != 34 || out_size != TL * DM || ws_size < WS_END) { fprintf(stderr, "kernel_launch: unexpected shapes (n_in %d out %d ws %zu)\n", n_in, out_size, ws_size); grid = -1; return; }
        int dev = 0, cus = 0;
        if (hipGetDevice(&dev) != hipSuccess || hipDeviceGetAttribute(&cus, hipDeviceAttributeMultiprocessorCount, dev) != hipSuccess) { grid = -1; return; }
        if (hipFuncSetAttribute((const void*)fwd, hipFuncAttributeMaxDynamicSharedMemorySize, LDS_BYTES) != hipSuccess) { fprintf(stderr, "kernel_launch: hipFuncSetAttribute failed\n"); grid = -1; return; }
        int per_cu = 0;
        (void)hipOccupancyMaxActiveBlocksPerMultiprocessor(&per_cu, (const void*)fwd, NTH, LDS_BYTES);
        (void)hipGetLastError();
        if (per_cu < 1) fprintf(stderr, "kernel_launch: occupancy query says %d\n", per_cu);
        grid = cus;
    }
    if (grid < 0) return;
    (void)hipMemsetAsync(d_ws, 0, MiB, stream);
    Params p{};
    for (int i = 0; i < 34; ++i) p.in[i] = (const float*)d_in[i];
    p.out = (float*)d_out; p.ws = (unsigned char*)d_ws;
#if N_LAUNCH_MODE == 1
    p.ph_lo = 0; p.ph_hi = NPHASES;
    hipLaunchKernelGGL(fwd, dim3(grid), dim3(NTH), LDS_BYTES, stream, p);
#else
    for (int k = 0; k < NPHASES; ++k) { p.ph_lo = k; p.ph_hi = k + 1; hipLaunchKernelGGL(fwd, dim3(grid), dim3(NTH), LDS_BYTES, stream, p); }
#endif
}
```

```cpp
#include <hip/hip_runtime.h>
#include <cstdint>
#include <cstdio>

#define LAS __attribute__((address_space(3)))
typedef unsigned short bf16_t;
typedef float f32x4 __attribute__((ext_vector_type(4)));
typedef unsigned u32x4 __attribute__((ext_vector_type(4)));
typedef unsigned u32x2 __attribute__((ext_vector_type(2)));
typedef float f32x16 __attribute__((ext_vector_type(16)));
typedef short s16x8 __attribute__((ext_vector_type(8)));

constexpr int NB = 8, SEQ = 8192, CTXL = 256, DM = 1024;
constexpr int TL = NB * SEQ, TC = NB * CTXL, TT = TL + TC;
constexpr int EVEN_IN = 3584, ODD_IN = 2480, ODD_PAD = 2560;
constexpr int NTH = 512;
constexpr int LDS_BYTES = 144 * 1024;
constexpr int MAXSLOTS = 151552;
constexpr int MAXTILES = 592;
constexpr float EPS = 1e-6f;

constexpr size_t MiB = 1048576;
constexpr size_t WS_CTRL = 0;
constexpr size_t C_MOE = 16384;
constexpr size_t C_MOD = 65536;
constexpr size_t WS_XC = 1 * MiB;
constexpr size_t WS_WSM = 9 * MiB;
constexpr size_t W_EIN = 0, W_EOUT = 7340032, W_OIN = 9437184, W_OOUT = 14680064, W_WQ = 16777216, W_WKV = 17170432, W_RT = 17694720;
constexpr size_t WS_WMOE = 27 * MiB;
constexpr size_t WS_ACT = 123 * MiB;
constexpr size_t WS_PX = 255 * MiB;
constexpr size_t WS_R2 = 717 * MiB;
constexpr size_t WS_END = 1024 * MiB;
constexpr size_t R2_OF0 = 0, R2_OB0 = 66 * MiB;
constexpr size_t R2_H = 0, R2_STOK = 148 * MiB, R2_SW = 149 * MiB, R2_TOKE = 150 * MiB, R2_TOKW = 151 * MiB, R2_TILEE = 152 * MiB;
constexpr size_t R2_K = 0, R2_V = 99 * MiB, R2_OF1 = 165 * MiB, R2_OB1 = 231 * MiB;
constexpr size_t PX_KVRAW = 346030080;
constexpr size_t WS_GREC = 585 * MiB;
constexpr size_t WS_GOF = 924 * MiB;
constexpr size_t R2_CQN = 0;
constexpr size_t R2_MODP = 200 * MiB;

struct Params {
    const float* in[34];
    float* out;
    unsigned char* ws;
    int ph_lo, ph_hi;
};
enum { I_X = 0, I_C, I_CTX, I_CCTX, I_ADAW, I_ADAB, I_NMIX, I_NFFN, I_EWIN, I_EWOUT, I_GNW, I_GWS, I_GBS, I_LB, I_HNW,
       I_OWIN, I_OWOUT, I_CONVW, I_ALOG, I_DTB, I_GDNNW, I_QNW, I_WQ, I_KVNW, I_WKV, I_QKQ, I_QKK, I_RGW, I_RGB, I_REW, I_REB, I_MG, I_MU, I_MD };

__device__ __forceinline__ float bf2f(bf16_t b) { return __uint_as_float(((unsigned)b) << 16); }
__device__ __forceinline__ bf16_t f2bf(float f) { unsigned u = __float_as_uint(f); u += 0x7FFFu + ((u >> 16) & 1u); return (bf16_t)(u >> 16); }
typedef __bf16 bf16_2v __attribute__((ext_vector_type(2)));
typedef float f32_2v __attribute__((ext_vector_type(2)));
__device__ __forceinline__ unsigned pack2(float a, float b) { f32_2v v = {a, b}; bf16_2v r = __builtin_convertvector(v, bf16_2v); return __builtin_bit_cast(unsigned, r); }
__device__ __forceinline__ float lo2f(unsigned u) { return __uint_as_float(u << 16); }
__device__ __forceinline__ float hi2f(unsigned u) { return __uint_as_float(u & 0xffff0000u); }
template <int CTRL> __device__ __forceinline__ float dppf(float x) { return __builtin_bit_cast(float, __builtin_amdgcn_mov_dpp(__builtin_bit_cast(int, x), CTRL, 0xf, 0xf, true)); }
__device__ __forceinline__ float sum8(float v) { v += dppf<0xB1>(v); v += dppf<0x4E>(v); v += dppf<0x141>(v); return v; }
__device__ __forceinline__ float sum16(float v) { v = sum8(v); v += dppf<0x128>(v); return v; }
__device__ __forceinline__ float wave_sum(float v) {
    v = sum16(v);
    auto s = __builtin_amdgcn_permlane16_swap(__float_as_uint(v), __float_as_uint(v), false, false);
    v = __uint_as_float(s[0]) + __uint_as_float(s[1]);
    auto t = __builtin_amdgcn_permlane32_swap(__float_as_uint(v), __float_as_uint(v), false, false);
    return __uint_as_float(t[0]) + __uint_as_float(t[1]);
}
__device__ __forceinline__ unsigned lds_inc(LAS unsigned* p) { return __hip_atomic_fetch_add(p, 1u, __ATOMIC_RELAXED, __HIP_MEMORY_SCOPE_WORKGROUP); }
__device__ __forceinline__ float sigmoid_f(float x) { return 1.f / (1.f + __expf(-x)); }
__device__ __forceinline__ float silu_f(float x) { return x / (1.f + __expf(-x)); }
__device__ __forceinline__ float gelu_tanh_f(float x) {
    const float u = 0.7978845608028654f * (x + 0.044715f * x * x * x);
    const float t = 1.f - 2.f / (__expf(2.f * u) + 1.f);
    return 0.5f * x * (1.f + t);
}
__device__ __forceinline__ float softplus_f(float x) { return x > 20.f ? x : log1pf(__expf(x)); }

#define XB_TMO      128
#define XB_XCNT(j)  (256  + 64 * (j))
#define XB_XSUB(j)  (1280 + 64 * (j))
#define XB_XGEN(j)  (2304 + 64 * (j))
#define XB_TOP      3328
#define XB_TOPGEN   3392
#define XCD_BAR_WORDS 3456
#define XB_SPIN_CAP (1u << 24)
__device__ __forceinline__ unsigned xb_ld(unsigned* p)              { return __hip_atomic_load(p, __ATOMIC_RELAXED, __HIP_MEMORY_SCOPE_AGENT); }
__device__ __forceinline__ unsigned xb_add(unsigned* p, unsigned v) { return __hip_atomic_fetch_add(p, v, __ATOMIC_RELAXED, __HIP_MEMORY_SCOPE_AGENT); }
__device__ __forceinline__ unsigned xb_xcc_id() { return (unsigned)__builtin_amdgcn_s_getreg((3 << 11) | 20) & 0xFu; }
#define XB_SPIN(cond, bar) do { unsigned _sp = 0; while (cond) { __builtin_amdgcn_s_sleep(1); \
    if ((++_sp & 255u) == 0u) { if (xb_ld(&(bar)[XB_TMO])) break; if (_sp > XB_SPIN_CAP) { atomicAdd(&(bar)[XB_TMO], 1u); break; } } } } while (0)
struct XcdBarrier { unsigned* bar; unsigned x; volatile LAS unsigned* st; };
__device__ __forceinline__ XcdBarrier xcd_barrier_post(unsigned* bar, volatile LAS unsigned* st) {
    XcdBarrier b; b.bar = bar; b.x = xb_xcc_id(); b.st = st;
    if (threadIdx.x == 0) (void)xb_add(&bar[XB_XCNT(b.x)], 1u);
    return b;
}
__device__ __forceinline__ void xcd_barrier_complete(unsigned* bar, unsigned x, unsigned& nloc, unsigned& nx) {
    const unsigned G = gridDim.x * gridDim.y * gridDim.z;
    unsigned sum, cnt, mine, sp = 0u;
    for (;;) {
        sum = 0u; cnt = 0u; mine = 0u;
#pragma unroll
        for (unsigned j = 0; j < 16; ++j) { const unsigned c = xb_ld(&bar[XB_XCNT(j)]); sum += c; cnt += (c > 0u) ? 1u : 0u; mine = (j == x) ? c : mine; }
        if (sum == G) break;
        __builtin_amdgcn_s_sleep(1);
        if ((++sp & 255u) == 0u) { if (xb_ld(&bar[XB_TMO])) break; if (sp > XB_SPIN_CAP) { atomicAdd(&bar[XB_TMO], 1u); break; } }
    }
    nloc = mine > 0u ? mine : 1u; nx = cnt > 0u ? cnt : 1u;
}
__device__ __forceinline__ void xcd_barrier(const XcdBarrier& b) {
    asm volatile("s_waitcnt vmcnt(0)" ::: "memory");
    __syncthreads();
    if (threadIdx.x == 0) {
        unsigned* bar = b.bar;
        __builtin_amdgcn_s_waitcnt(0);
        unsigned nloc = b.st[0], nx = b.st[1];
        if (nloc == 0u) { xcd_barrier_complete(bar, b.x, nloc, nx); b.st[0] = nloc; b.st[1] = nx; }
        const unsigned old = xb_add(&bar[XB_XSUB(b.x)], 1u);
        const unsigned gen = old / nloc;
        if (old + 1u == (gen + 1u) * nloc) {
            __builtin_amdgcn_fence(__ATOMIC_RELEASE, "agent");
            asm volatile("s_waitcnt vmcnt(0)" ::: "memory");
            const unsigned og = xb_add(&bar[XB_TOP], 1u);
            const unsigned tg = og / nx;
            if (og + 1u == (tg + 1u) * nx) xb_add(&bar[XB_TOPGEN], 1u);
            else XB_SPIN(xb_ld(&bar[XB_TOPGEN]) == tg, bar);
            __builtin_amdgcn_fence(__ATOMIC_ACQUIRE, "agent");
            xb_add(&bar[XB_XGEN(b.x)], 1u);
            asm volatile("s_waitcnt vmcnt(0)" ::: "memory");
        } else {
            XB_SPIN(xb_ld(&bar[XB_XGEN(b.x)]) == gen, bar);
            __builtin_amdgcn_fence(__ATOMIC_ACQUIRE, "agent");
            asm volatile("s_waitcnt vmcnt(0)" ::: "memory");
        }
    }
    __syncthreads();
}

struct Frame {
    const Params* P;
    unsigned char* ws;
    LAS unsigned char* lds;
    int tid, lane, wave, G, bid;
    float* mod;
    unsigned* ctrl;
};
__device__ __forceinline__ const float* modp(const Frame& F, int layer, int b, int which) { return F.mod + ((size_t)(layer * 9 + b) * 6 + which) * 1024; }

__device__ __forceinline__ void conv_tile(const Frame& F, const float* src, int K, int N, int lds_, bf16_t* dst, int ldd, int kt, int nt, int rm_mode) {
    LAS float* tile = (LAS float*)F.lds;
    const int t = F.tid;
    {
        const int c = t & 63, r0 = t >> 6;
#pragma unroll
        for (int i = 0; i < 8; ++i) { const int rr = r0 + i * 8, k = kt * 64 + rr, n = nt * 64 + c;
            tile[rr * 65 + c] = (k < K && n < N) ? src[(size_t)k * lds_ + n] : 0.f; }
    }
    __syncthreads();
    {
        const int nl = t >> 3, kc = (t & 7) * 8, n = nt * 64 + nl;
        int row = n;
        if (rm_mode == 1) row = (n >> 7) * 256 + (n & 127);
        else if (rm_mode == 2) row = (n >> 7) * 256 + 128 + (n & 127);
        float v[8];
#pragma unroll
        for (int j = 0; j < 8; ++j) v[j] = tile[(kc + j) * 65 + nl];
        u32x4 w; w.x = pack2(v[0], v[1]); w.y = pack2(v[2], v[3]); w.z = pack2(v[4], v[5]); w.w = pack2(v[6], v[7]);
        *(u32x4*)(dst + (size_t)row * ldd + kt * 64 + kc) = w;
    }
    __syncthreads();
}
__device__ __forceinline__ void conv_moe_weights(const Frame& F, int layer, int item0, int stride) {
    const Params& P = *F.P;
    bf16_t* W1 = (bf16_t*)(F.ws + WS_WMOE); bf16_t* W2 = W1 + (size_t)32 * 1024 * 1024;
    for (int it = item0; it < 12288; it += stride) {
        if (it < 8192) {
            const int up = it >= 4096, j = it & 4095, e = j >> 7, r = j & 127, kt = r >> 3, nt = r & 7;
            const float* src = P.in[up ? I_MU : I_MG] + ((size_t)(layer * 32 + e)) * 1024 * 512;
            conv_tile(F, src, 1024, 512, 512, W1 + (size_t)e * 1024 * 1024, 1024, kt, nt, up ? 2 : 1);
        } else {
            const int j = it - 8192, e = j >> 7, r = j & 127, kt = r >> 4, nt = r & 15;
            const float* src = P.in[I_MD] + ((size_t)(layer * 32 + e)) * 512 * 1024;
            conv_tile(F, src, 512, 1024, 1024, W2 + (size_t)e * 1024 * 512, 512, kt, nt, 0);
        }
    }
}
__device__ __forceinline__ void mod_reduce(const Frame& F) {
    const float* mp = (const float*)(F.ws + WS_R2 + R2_MODP);
    for (int i = F.bid * NTH + F.tid; i < 18 * 6144; i += F.G * NTH) { float a = F.P->in[I_ADAB][(i / (9 * 6144)) * 6144 + (i % 6144)];
#pragma unroll
        for (int kp = 0; kp < 8; ++kp) a += mp[(size_t)kp * 18 * 6144 + i];
        F.mod[i] = a; }
}
__device__ __forceinline__ void ph_prologue(const Frame& F) {
    const Params& P = *F.P;
    float* modp_ = (float*)(F.ws + WS_R2 + R2_MODP);
    for (int it = F.bid; it < 192; it += F.G) {
        const int l = it / 96, r = it % 96, cb = r >> 3, kp = r & 7;
        LAS float* sc = (LAS float*)F.lds;
        for (int i = F.tid; i < 9 * 128; i += NTH) { const int rr = i >> 7, k = kp * 128 + (i & 127);
            const float cv = rr < 8 ? P.in[I_C][rr * 1024 + k] : P.in[I_CCTX][k]; sc[i] = silu_f(cv); }
        __syncthreads();
        const int n = cb * 512 + F.tid;
        float acc[9];
#pragma unroll
        for (int rr = 0; rr < 9; ++rr) acc[rr] = 0.f;
        const float* w = P.in[I_ADAW] + ((size_t)l * 1024 + kp * 128) * 6144 + n;
#pragma unroll 8
        for (int k = 0; k < 128; ++k) { const float wv = w[(size_t)k * 6144];
#pragma unroll
            for (int rr = 0; rr < 9; ++rr) acc[rr] += sc[rr * 128 + k] * wv; }
#pragma unroll
        for (int rr = 0; rr < 9; ++rr) modp_[((size_t)kp * 18 + l * 9 + rr) * 6144 + n] = acc[rr];
        __syncthreads();
    }
    bf16_t* wsm = (bf16_t*)(F.ws + WS_WSM);
    for (int it = F.bid; it < 2160; it += F.G) {
        int j = it;
        if (j < 896) { conv_tile(F, P.in[I_EWIN], 1024, 3584, 3584, wsm + W_EIN / 2, 1024, j / 56, j % 56, 0); continue; } j -= 896;
        if (j < 256) { conv_tile(F, P.in[I_EWOUT], 1024, 1024, 1024, wsm + W_EOUT / 2, 1024, j >> 4, j & 15, 0); continue; } j -= 256;
        if (j < 640) { conv_tile(F, P.in[I_OWIN], 1024, 2480, 2480, wsm + W_OIN / 2, 1024, j / 40, j % 40, 0); continue; } j -= 640;
        if (j < 256) { conv_tile(F, P.in[I_OWOUT], 1024, 1024, 1024, wsm + W_OOUT / 2, 1024, j >> 4, j & 15, 0); continue; } j -= 256;
        if (j < 48) { conv_tile(F, P.in[I_WQ], 256, 768, 768, wsm + W_WQ / 2, 256, j / 12, j % 12, 0); continue; } j -= 48;
        conv_tile(F, P.in[I_WKV], 128, 1024, 1024, wsm + W_WKV / 2, 256, j >> 4, j & 15, 0);
    }
    for (int i = F.bid * NTH + F.tid; i < 2 * 48 * 1024; i += F.G * NTH) { const int l = i / (48 * 1024), r = i % (48 * 1024), n = r >> 10, k = r & 1023;
        float w = 0.f; if (n < 4) w = P.in[I_RGW][((size_t)l * 1024 + k) * 4 + n]; else if (n < 36) w = P.in[I_REW][((size_t)l * 1024 + k) * 32 + (n - 4)];
        const bf16_t h = f2bf(w); wsm[W_RT / 2 + (size_t)l * 2 * 48 * 1024 + r] = h; wsm[W_RT / 2 + (size_t)l * 2 * 48 * 1024 + 48 * 1024 + r] = f2bf(w - bf2f(h)); }
    conv_moe_weights(F, 0, F.bid, F.G);
}

__device__ __forceinline__ void ph_rownorm(const Frame& F, int layer, int nrows, const float* xlat, const float* xctx, const float* nw, int si) {
    bf16_t* dst = (bf16_t*)(F.ws + WS_ACT);
    for (int r = F.bid * 8 + F.wave; r < nrows; r += F.G * 8) {
        const float* src = r < TL ? xlat + (size_t)r * 1024 : xctx + (size_t)(r - TL) * 1024;
        const int b = r < TL ? (r >> 13) : 8;
        const float* sh = modp(F, layer, b, si); const float* sc = modp(F, layer, b, si + 1);
        f32x4 v[4]; float ss = 0.f;
#pragma unroll
        for (int j = 0; j < 4; ++j) { v[j] = *(const f32x4*)(src + j * 256 + F.lane * 4); ss += v[j][0] * v[j][0] + v[j][1] * v[j][1] + v[j][2] * v[j][2] + v[j][3] * v[j][3]; }
        ss = wave_sum(ss);
        const float rstd = rsqrtf(ss * (1.f / 1024.f) + EPS);
#pragma unroll
        for (int j = 0; j < 4; ++j) { const int c = j * 256 + F.lane * 4;
            const f32x4 w = *(const f32x4*)(nw + c), s1 = *(const f32x4*)(sc + c), s0 = *(const f32x4*)(sh + c);
            v[j] = (v[j] * rstd * w) * (1.f + s1) + s0;
            u32x2 o; o.x = pack2(v[j][0], v[j][1]); o.y = pack2(v[j][2], v[j][3]);
            *(u32x2*)(dst + (size_t)r * 1024 + c) = o; }
    }
}
typedef short s16x8r __attribute__((ext_vector_type(8)));
__device__ __forceinline__ void ph_router(const Frame& F, int layer, int nrows, const float* xlat, const float* xctx, const float* nw, int si) {
    const Params& P = *F.P;
    bf16_t* dst = (bf16_t*)(F.ws + WS_ACT);
    LAS unsigned* hist = (LAS unsigned*)F.lds;
    LAS float* lg = (LAS float*)(F.lds + 256) + F.wave * (16 * 48);
    int* tok_e = (int*)(F.ws + WS_R2 + R2_TOKE); float* tok_w = (float*)(F.ws + WS_R2 + R2_TOKW);
    if (F.tid < 64) hist[F.tid] = 0u;
    __syncthreads();
    { int* stok = (int*)(F.ws + WS_R2 + R2_STOK);
      for (int i = F.bid * NTH + F.tid; i < MAXSLOTS; i += F.G * NTH) stok[i] = -1; }
    const bf16_t* Wh = (const bf16_t*)(F.ws + WS_WSM) + W_RT / 2 + (size_t)layer * 2 * 48 * 1024; const bf16_t* Wl = Wh + 48 * 1024;
    const int lr = F.lane & 15, kq = F.lane >> 4;
    const float* rgb = P.in[I_RGB] + layer * 4; const float* reb = P.in[I_REB] + layer * 32;
    for (int g = F.bid * 8 + F.wave; g < nrows / 16; g += F.G * 8) {
        const int r0 = g * 16;
        const float* src0 = r0 < TL ? xlat + (size_t)r0 * 1024 : xctx + (size_t)(r0 - TL) * 1024;
        const int b = r0 < TL ? (r0 >> 13) : 8;
        const float* sh = modp(F, layer, b, si); const float* sc = modp(F, layer, b, si + 1);
        float myrstd = 0.f;
#pragma unroll 4
        for (int rr = 0; rr < 16; ++rr) { const float* src = src0 + (size_t)rr * 1024; float ss = 0.f;
#pragma unroll
            for (int j = 0; j < 4; ++j) { const f32x4 v = *(const f32x4*)(src + j * 256 + F.lane * 4); ss += v[0] * v[0] + v[1] * v[1] + v[2] * v[2] + v[3] * v[3]; }
            ss = wave_sum(ss);
            const float rs = rsqrtf(ss * (1.f / 1024.f) + EPS); myrstd = (lr == rr) ? rs : myrstd; }
        f32x4 acc[3];
#pragma unroll
        for (int nb = 0; nb < 3; ++nb) acc[nb] = (f32x4){0.f, 0.f, 0.f, 0.f};
        const float* xr = src0 + (size_t)lr * 1024 + kq * 8;
        bf16_t* dr = dst + (size_t)(r0 + lr) * 1024 + kq * 8;
#pragma unroll 2
        for (int ks = 0; ks < 32; ++ks) { const int c = ks * 32 + kq * 8;
            const f32x4 x0 = *(const f32x4*)(xr + ks * 32), x1 = *(const f32x4*)(xr + ks * 32 + 4);
            const f32x4 w0 = *(const f32x4*)(nw + c), w1 = *(const f32x4*)(nw + c + 4), a0 = *(const f32x4*)(sc + c), a1 = *(const f32x4*)(sc + c + 4), b0 = *(const f32x4*)(sh + c), b1 = *(const f32x4*)(sh + c + 4);
            const f32x4 h0 = (x0 * myrstd * w0) * (1.f + a0) + b0, h1 = (x1 * myrstd * w1) * (1.f + a1) + b1;
            u32x4 hi; hi.x = pack2(h0[0], h0[1]); hi.y = pack2(h0[2], h0[3]); hi.z = pack2(h1[0], h1[1]); hi.w = pack2(h1[2], h1[3]);
            *(u32x4*)(dr + ks * 32) = hi;
            u32x4 lo; lo.x = pack2(h0[0] - lo2f(hi.x), h0[1] - hi2f(hi.x)); lo.y = pack2(h0[2] - lo2f(hi.y), h0[3] - hi2f(hi.y));
            lo.z = pack2(h1[0] - lo2f(hi.z), h1[1] - hi2f(hi.z)); lo.w = pack2(h1[2] - lo2f(hi.w), h1[3] - hi2f(hi.w));
            const s16x8r ah = __builtin_bit_cast(s16x8r, hi), al = __builtin_bit_cast(s16x8r, lo);
#pragma unroll
            for (int nb = 0; nb < 3; ++nb) { const s16x8r bh = *(const s16x8r*)(Wh + (size_t)(nb * 16 + lr) * 1024 + c), bl = *(const s16x8r*)(Wl + (size_t)(nb * 16 + lr) * 1024 + c);
                acc[nb] = __builtin_amdgcn_mfma_f32_16x16x32_bf16(ah, bh, acc[nb], 0, 0, 0);
                acc[nb] = __builtin_amdgcn_mfma_f32_16x16x32_bf16(al, bh, acc[nb], 0, 0, 0);
                acc[nb] = __builtin_amdgcn_mfma_f32_16x16x32_bf16(ah, bl, acc[nb], 0, 0, 0); } }
#pragma unroll
        for (int nb = 0; nb < 3; ++nb)
#pragma unroll
            for (int rg = 0; rg < 4; ++rg) lg[(4 * kq + rg) * 48 + nb * 16 + lr] = acc[nb][rg];
        asm volatile("s_waitcnt lgkmcnt(0)" ::: "memory");
        __builtin_amdgcn_wave_barrier();
        if (F.lane < 16) {
            const LAS float* L = lg + F.lane * 48;
            float lgv[4];
#pragma unroll
            for (int i = 0; i < 4; ++i) lgv[i] = L[i] + rgb[i];
            int gi = 0; float best = lgv[0];
#pragma unroll
            for (int i = 1; i < 4; ++i) if (lgv[i] > best) { best = lgv[i]; gi = i; }
            float den = 0.f;
#pragma unroll
            for (int i = 0; i < 4; ++i) den += __expf(lgv[i] - best);
            const float pg = 1.f / den;
            float le[8];
#pragma unroll
            for (int i = 0; i < 8; ++i) le[i] = L[4 + gi * 8 + i] + reb[gi * 8 + i];
            int i1 = 0; float b1 = le[0];
#pragma unroll
            for (int i = 1; i < 8; ++i) if (le[i] > b1) { b1 = le[i]; i1 = i; }
            int i2 = -1; float b2 = -3.0e38f;
#pragma unroll
            for (int i = 0; i < 8; ++i) if (i != i1 && le[i] > b2) { b2 = le[i]; i2 = i; }
            const float e2 = __expf(b2 - b1);
            const float w1 = pg / (1.f + e2), w2 = pg * e2 / (1.f + e2);
            const int e0g = gi * 8 + i1, e1g = gi * 8 + i2; const int r = r0 + F.lane;
            tok_e[r] = e0g | (e1g << 8); tok_w[2 * r] = w1; tok_w[2 * r + 1] = w2;
            lds_inc(&hist[e0g]); lds_inc(&hist[32 + e1g]);
        }
        __builtin_amdgcn_wave_barrier();
    }
    __syncthreads();
    unsigned* cnt = (unsigned*)(F.ws + WS_CTRL + C_MOE + layer * 1024);
    if (F.tid < 64 && hist[F.tid]) atomicAdd(&cnt[F.tid], hist[F.tid]);
    __syncthreads();
}

__device__ __forceinline__ void ph_dispatch(const Frame& F, int layer, int ntok) {
    unsigned* cnt = (unsigned*)(F.ws + WS_CTRL + C_MOE + layer * 1024); unsigned* cursor = cnt + 64; unsigned* info = cnt + 128;
    LAS unsigned* base = (LAS unsigned*)F.lds; LAS unsigned* lh = base + 64; LAS unsigned* gb = base + 128; LAS unsigned* lh2 = base + 192; LAS unsigned* pad = base + 256;
    const int* tok_e = (const int*)(F.ws + WS_R2 + R2_TOKE); const float* tok_w = (const float*)(F.ws + WS_R2 + R2_TOKW);
    int* stok = (int*)(F.ws + WS_R2 + R2_STOK); float* sw = (float*)(F.ws + WS_R2 + R2_SW); int* tile_e = (int*)(F.ws + WS_R2 + R2_TILEE);
    if (F.tid < 64) { pad[F.tid] = (__hip_atomic_load(&cnt[F.tid], __ATOMIC_RELAXED, __HIP_MEMORY_SCOPE_AGENT) + 255u) & ~255u; lh[F.tid] = 0u; lh2[F.tid] = 0u; }
    __syncthreads();
    if (F.tid == 0) { unsigned a = 0; for (int i = 0; i < 64; ++i) { base[i] = a; a += pad[i]; } base[320] = a; }
    __syncthreads();
    if (F.bid == 0) {
        for (int i = F.tid; i < MAXTILES; i += NTH) { const unsigned s = (unsigned)i * 256u; int l = -1;
            for (int j = 0; j < 64; ++j) if (s >= base[j] && s < base[j] + pad[j]) l = j;
            tile_e[i] = l; }
        if (F.tid == 0) { info[0] = base[32] / 256u; info[1] = base[320] / 256u; }
    }
    const int per = (ntok + F.G - 1) / F.G, t0 = F.bid * per, t1 = min(ntok, t0 + per);
    for (int t = t0 + F.tid; t < t1; t += NTH) { const int e = tok_e[t]; lds_inc(&lh[e & 255]); lds_inc(&lh[32 + (e >> 8)]); }
    __syncthreads();
    if (F.tid < 64) gb[F.tid] = lh[F.tid] ? __hip_atomic_fetch_add(&cursor[F.tid], lh[F.tid], __ATOMIC_RELAXED, __HIP_MEMORY_SCOPE_AGENT) : 0u;
    __syncthreads();
    for (int t = t0 + F.tid; t < t1; t += NTH) { const int e = tok_e[t];
        const int l0 = e & 255, l1 = 32 + (e >> 8);
        const unsigned p0 = base[l0] + gb[l0] + lds_inc(&lh2[l0]), p1 = base[l1] + gb[l1] + lds_inc(&lh2[l1]);
        stok[p0] = t; sw[p0] = tok_w[2 * t]; stok[p1] = t; sw[p1] = tok_w[2 * t + 1]; }
    __syncthreads();
}

template <class AF, class EP>
__device__ __forceinline__ void gemm_unit_naive(const Frame& F, int K, const AF& arow, const bf16_t* Bt, const EP& E, int pm, int pn) {
    LAS float* As = (LAS float*)F.lds;
    LAS float* Bs = As + 32 * 132;
    const int t = F.tid, ty = t >> 5, tx = t & 31;
    for (int half = 0; half < 2; ++half) {
        float acc[8][8];
#pragma unroll
        for (int i = 0; i < 8; ++i)
#pragma unroll
            for (int j = 0; j < 8; ++j) acc[i][j] = 0.f;
        const bf16_t* ap = arow(half * 128 + (t >> 2));
        const bf16_t* bp = Bt + (size_t)(t >> 1) * K;
        for (int k0 = 0; k0 < K; k0 += 32) {
            { const int r = t >> 2, kq = (t & 3) * 8; u32x4 w = {0u, 0u, 0u, 0u}; if (ap) w = *(const u32x4*)(ap + k0 + kq);
              As[(kq + 0) * 132 + r] = lo2f(w.x); As[(kq + 1) * 132 + r] = hi2f(w.x); As[(kq + 2) * 132 + r] = lo2f(w.y); As[(kq + 3) * 132 + r] = hi2f(w.y);
              As[(kq + 4) * 132 + r] = lo2f(w.z); As[(kq + 5) * 132 + r] = hi2f(w.z); As[(kq + 6) * 132 + r] = lo2f(w.w); As[(kq + 7) * 132 + r] = hi2f(w.w); }
            { const int n = t >> 1, kh = (t & 1) * 16;
#pragma unroll
              for (int q = 0; q < 2; ++q) { const u32x4 w = *(const u32x4*)(bp + k0 + kh + q * 8); const int kk = kh + q * 8;
                Bs[(kk + 0) * 260 + n] = lo2f(w.x); Bs[(kk + 1) * 260 + n] = hi2f(w.x); Bs[(kk + 2) * 260 + n] = lo2f(w.y); Bs[(kk + 3) * 260 + n] = hi2f(w.y);
                Bs[(kk + 4) * 260 + n] = lo2f(w.z); Bs[(kk + 5) * 260 + n] = hi2f(w.z); Bs[(kk + 6) * 260 + n] = lo2f(w.w); Bs[(kk + 7) * 260 + n] = hi2f(w.w); } }
            __syncthreads();
#pragma unroll 4
            for (int k = 0; k < 32; ++k) {
                const f32x4 a0 = *(const LAS f32x4*)(As + k * 132 + ty * 8), a1 = *(const LAS f32x4*)(As + k * 132 + ty * 8 + 4);
                const f32x4 b0 = *(const LAS f32x4*)(Bs + k * 260 + tx * 4), b1 = *(const LAS f32x4*)(Bs + k * 260 + 128 + tx * 4);
#pragma unroll
                for (int i = 0; i < 8; ++i) { const float a = i < 4 ? a0[i & 3] : a1[i & 3];
#pragma unroll
                    for (int j = 0; j < 4; ++j) { acc[i][j] += a * b0[j]; acc[i][4 + j] += a * b1[j]; } }
            }
            __syncthreads();
        }
#pragma unroll
        for (int i = 0; i < 8; ++i) { const f32x4 v0 = {acc[i][0], acc[i][1], acc[i][2], acc[i][3]}, v1 = {acc[i][4], acc[i][5], acc[i][6], acc[i][7]};
            E(pm * 256 + half * 128 + ty * 8 + i, pn, tx * 4, v0, v1); }
    }
}
struct ARowDense { const bf16_t* A; int K; int pm; __device__ __forceinline__ const bf16_t* operator()(int r) const { return A + (size_t)(pm * 256 + r) * K; } };
struct ARowGather { const bf16_t* A; const int* stok; int pm; __device__ __forceinline__ const bf16_t* operator()(int r) const { const int t = stok[pm * 256 + r]; return t < 0 ? nullptr : A + (size_t)t * 1024; } };

template <class EP>
__device__ __forceinline__ void gemm_dense_naive(const Frame& F, const bf16_t* A, const bf16_t* Bt, int M, int N, int K, const EP& E) {
    const int nM = M / 256, nN = N / 256;
    for (int u = F.bid; u < nM * nN; u += F.G) { const int pm = u / nN, pn = u % nN;
        ARowDense ar{A, K, pm}; gemm_unit_naive(F, K, ar, Bt + (size_t)pn * 256 * K, E, pm, pn); }
}

namespace pg8 {
typedef short bf16x8 __attribute__((ext_vector_type(8)));
constexpr int BM = 256, BK = 64, HALF = 128, HTB = HALF * BK * 2, STAGE_BYTES = 8 * HTB, NXCD = 8, WGM = 8;
__device__ __forceinline__ int lds_byte(int r, int c) { const int st = (r >> 4) * 2 + (c >> 5), rr = r & 15, cc = c & 31, ob = rr * 64 + cc * 2; return st * 1024 + (ob ^ (((ob >> 9) & 1) << 5)); }
__device__ __forceinline__ void stage_rc(int b, int& R, int& C) { const int st = b / 1024, sb = b % 1024, swz = sb ^ (((sb >> 9) & 1) << 5); R = (st >> 1) * 16 + swz / 64; C = (st & 1) * 32 + (swz % 64) / 2; }
struct Unit { int pm, pn; };
struct ProbDense {
    const char* A; const char* Bt; int K, nM, nN, nwg, G, c;
    __device__ __forceinline__ void init(const bf16_t* A_, const bf16_t* Bt_, int M, int N, int K_, int G_, int c_) { A = (const char*)A_; Bt = (const char*)Bt_; K = K_; nM = M / BM; nN = N / BM; nwg = nM * nN; G = G_; c = c_; }
    __device__ __forceinline__ bool next(int i, Unit& u) const {
        const long L = (long)i * G + c; if (L >= nwg) return false;
        int wgid = (int)L; { const int q = nwg / NXCD, r = nwg % NXCD, xcd = wgid % NXCD, off = wgid / NXCD; wgid = (xcd < r ? xcd * (q + 1) : r * (q + 1) + (xcd - r) * q) + off; }
        const int nig = WGM * nN, gid = wgid / nig, fm = gid * WGM, gsz = (nM - fm) < WGM ? (nM - fm) : WGM;
        u.pm = fm + ((wgid % nig) % gsz); u.pn = (wgid % nig) / gsz; return true;
    }
    __device__ __forceinline__ const char* bptr(const Unit& u) const { return Bt + (size_t)u.pn * 256 * K * 2; }
    __device__ __forceinline__ unsigned aoff(const Unit& u, int r) const { return (unsigned)(u.pm * 256 + r) * (unsigned)(K * 2); }
};
struct ProbMoe1 {
    const char* A; const int* stok; const int* tile_e; const char* W; int K, ntiles, G, c;
    __device__ __forceinline__ bool next(int i, Unit& u) const { const int L = i * G + c; if (L >= ntiles * 4) return false; u.pm = L >> 2; u.pn = L & 3; return true; }
    __device__ __forceinline__ const char* bptr(const Unit& u) const { return W + ((size_t)(tile_e[u.pm] & 31) * 1024 + u.pn * 256) * 2048; }
    __device__ __forceinline__ unsigned aoff(const Unit& u, int r) const { const int t = stok[u.pm * 256 + r]; return t < 0 ? 0u : (unsigned)t * 2048u; }
};
struct ProbMoe2 {
    const char* A; const int* tile_e; const char* W; int K, tlo, thi, G, c;
    __device__ __forceinline__ bool next(int i, Unit& u) const { const int L = i * G + c; if (L >= (thi - tlo) * 4) return false; u.pm = tlo + (L >> 2); u.pn = L & 3; return true; }
    __device__ __forceinline__ const char* bptr(const Unit& u) const { return W + ((size_t)(tile_e[u.pm] & 31) * 1024 + u.pn * 256) * 1024; }
    __device__ __forceinline__ unsigned aoff(const Unit& u, int r) const { return (unsigned)(u.pm * 256 + r) * 1024u; }
};

template <class Prob, class Epi>
__device__ __forceinline__ void gemm_phase(LAS unsigned char* lds, const Prob& S, const Epi& E) {
    const int tid = threadIdx.x, wid = __builtin_amdgcn_readfirstlane(tid >> 6), lane = tid & 63, wr = wid >> 2, wc = wid & 3, fr = lane & 15, fq = lane >> 4;
    const int K = S.K, nt = K / BK;
    int RA[2]; unsigned cb2[2], voffB[2];
#pragma unroll
    for (int i = 0; i < 2; ++i) { int R, C; stage_rc(tid * 16 + i * 8192, R, C); RA[i] = R; cb2[i] = (unsigned)C * 2u; voffB[i] = (unsigned)(R * K + C) * 2u; }
    const size_t kstep = (size_t)(BK * 2);
    const size_t hstepB = (size_t)HALF * K * 2;
    const unsigned ldsw = (unsigned)wid * 1024u;
    const int aoff = lds_byte(wr * 64 + fr, fq * 8), boff = lds_byte(wc * 32 + fr, fq * 8);
#define PG8_SA(b, h) (((b) * 2 + (h)) * HTB)
#define PG8_SB(b, h) ((4 + (b) * 2 + (h)) * HTB)
#define PG8_STAGE(bufoff, gbase, voff) do { _Pragma("unroll") for (int _i = 0; _i < 2; ++_i) \
        __builtin_amdgcn_global_load_lds((const unsigned*)((const char*)(gbase) + (voff)[_i]), (LAS unsigned*)(lds + (bufoff) + ldsw + _i * 8192), 16, 0, 0); } while (0)
#define PG8_LDA(dst, b, h) do { _Pragma("unroll") for (int m = 0; m < 4; ++m) _Pragma("unroll") for (int k = 0; k < 2; ++k) dst[m][k] = *(const LAS bf16x8*)(lds + PG8_SA(b, h) + aoff + m * 2048 + k * 1024); } while (0)
#define PG8_LDB(dst, b, h) do { _Pragma("unroll") for (int n = 0; n < 2; ++n) _Pragma("unroll") for (int k = 0; k < 2; ++k) dst[n][k] = *(const LAS bf16x8*)(lds + PG8_SB(b, h) + boff + n * 2048 + k * 1024); } while (0)
#define PG8_MMA(ai, bj, At, Bt) do { __builtin_amdgcn_s_setprio(1); _Pragma("unroll") for (int m = 0; m < 4; ++m) _Pragma("unroll") for (int n = 0; n < 2; ++n) _Pragma("unroll") for (int k = 0; k < 2; ++k) \
        acc[ai][bj][m][n] = __builtin_amdgcn_mfma_f32_16x16x32_bf16(Bt[n][k], At[m][k], acc[ai][bj][m][n], 0, 0, 0); __builtin_amdgcn_s_setprio(0); } while (0)
#define PG8_WAIT_V(n) asm volatile("s_waitcnt vmcnt(" #n ")" ::: "memory")
#define PG8_WAIT_L(n) asm volatile("s_waitcnt lgkmcnt(" #n ")" ::: "memory")
#define PG8_BAR __builtin_amdgcn_s_barrier()
#define PG8_SCHED __builtin_amdgcn_sched_barrier(0)
    Unit cur, nxt; int ui = 0;
    if (!S.next(0, cur)) return;
    f32x4 acc[2][2][4][2];
#pragma unroll
    for (int a = 0; a < 2; ++a)
#pragma unroll
        for (int b = 0; b < 2; ++b)
#pragma unroll
            for (int m = 0; m < 4; ++m)
#pragma unroll
                for (int n = 0; n < 2; ++n) acc[a][b][m][n] = (f32x4){0.f, 0.f, 0.f, 0.f};
    bf16x8 At[4][2], B0[2][2], B1[2][2];
    unsigned oc0[2], oc1[2], on0[2], on1[2];
#pragma unroll
    for (int i = 0; i < 2; ++i) { oc0[i] = S.aoff(cur, RA[i]) + cb2[i]; oc1[i] = S.aoff(cur, 128 + RA[i]) + cb2[i]; }
    const char* cB = S.bptr(cur);
    const char* const Ab = S.A;
    PG8_STAGE(PG8_SB(0, 0), cB, voffB); PG8_STAGE(PG8_SA(0, 0), Ab, oc0); PG8_STAGE(PG8_SB(0, 1), cB + hstepB, voffB); PG8_STAGE(PG8_SA(0, 1), Ab, oc1);
    if (wr == 1) PG8_BAR;
    PG8_WAIT_V(4); PG8_BAR;
    PG8_STAGE(PG8_SB(1, 0), cB + kstep, voffB); PG8_STAGE(PG8_SA(1, 0), Ab + kstep, oc0); PG8_STAGE(PG8_SB(1, 1), cB + hstepB + kstep, voffB);
    PG8_WAIT_V(6); PG8_BAR;
    for (;;) {
        const bool has_next = S.next(ui + 1, nxt);
        const char* nB = has_next ? S.bptr(nxt) : cB;
#pragma unroll
        for (int i = 0; i < 2; ++i) { on0[i] = has_next ? S.aoff(nxt, RA[i]) + cb2[i] : oc0[i]; on1[i] = has_next ? S.aoff(nxt, 128 + RA[i]) + cb2[i] : oc1[i]; }
        for (int t = 0; t < nt; t += 2) {
            const bool last = (t == nt - 2);
            const char* a1 = Ab + (size_t)(t + 1) * kstep;
            const char* a2 = last ? Ab : Ab + (size_t)(t + 2) * kstep; const char* b2 = last ? nB : cB + (size_t)(t + 2) * kstep;
            const char* a3 = a2 + kstep; const char* b3 = b2 + kstep;
            unsigned o20[2], o21[2];
#pragma unroll
            for (int i = 0; i < 2; ++i) { o20[i] = last ? on0[i] : oc0[i]; o21[i] = last ? on1[i] : oc1[i]; }
            PG8_LDB(B0, 0, 0); PG8_SCHED; PG8_LDA(At, 0, 0); PG8_STAGE(PG8_SA(1, 1), a1, oc1);
            PG8_WAIT_L(8); PG8_BAR; PG8_WAIT_L(0); PG8_MMA(0, 0, At, B0); PG8_BAR; PG8_SCHED;
            PG8_LDB(B1, 0, 1); PG8_STAGE(PG8_SB(0, 0), b2, voffB);
            PG8_BAR; PG8_WAIT_L(0); PG8_MMA(0, 1, At, B1); PG8_BAR;
            PG8_LDA(At, 0, 1); PG8_STAGE(PG8_SA(0, 0), a2, o20);
            PG8_BAR; PG8_WAIT_L(0); PG8_MMA(1, 0, At, B0); PG8_BAR; PG8_SCHED;
            PG8_STAGE(PG8_SB(0, 1), b2 + hstepB, voffB);
            PG8_WAIT_V(6); PG8_BAR; PG8_MMA(1, 1, At, B1); PG8_BAR;
            PG8_LDB(B0, 1, 0); PG8_SCHED; PG8_LDA(At, 1, 0); PG8_STAGE(PG8_SA(0, 1), a2, o21);
            PG8_WAIT_L(8); PG8_BAR; PG8_WAIT_L(0); PG8_MMA(0, 0, At, B0); PG8_BAR; PG8_SCHED;
            PG8_LDB(B1, 1, 1); PG8_STAGE(PG8_SB(1, 0), b3, voffB);
            PG8_BAR; PG8_WAIT_L(0); PG8_MMA(0, 1, At, B1); PG8_BAR;
            PG8_LDA(At, 1, 1); PG8_STAGE(PG8_SA(1, 0), a3, o20);
            PG8_BAR; PG8_WAIT_L(0); PG8_MMA(1, 0, At, B0); PG8_BAR; PG8_SCHED;
            PG8_STAGE(PG8_SB(1, 1), b3 + hstepB, voffB);
            PG8_WAIT_V(6); PG8_BAR; PG8_MMA(1, 1, At, B1); PG8_BAR;
        }
#pragma unroll
        for (int ai = 0; ai < 2; ++ai)
#pragma unroll
            for (int m = 0; m < 4; ++m)
#pragma unroll
                for (int n = 0; n < 2; ++n) E(cur.pm * BM + ai * HALF + wr * 64 + m * 16 + fr, cur.pn, wc * 32 + n * 16 + fq * 4, acc[ai][0][m][n], acc[ai][1][m][n]);
        if (!has_next) break;
#pragma unroll
        for (int a = 0; a < 2; ++a)
#pragma unroll
            for (int b = 0; b < 2; ++b)
#pragma unroll
                for (int m = 0; m < 4; ++m)
#pragma unroll
                    for (int n = 0; n < 2; ++n) acc[a][b][m][n] = (f32x4){0.f, 0.f, 0.f, 0.f};
        cur = nxt; cB = nB; ++ui;
#pragma unroll
        for (int i = 0; i < 2; ++i) { oc0[i] = on0[i]; oc1[i] = on1[i]; }
    }
    PG8_WAIT_V(0);
    if (wr == 0) PG8_BAR;
    PG8_BAR;
#undef PG8_SA
#undef PG8_SB
#undef PG8_STAGE
#undef PG8_LDA
#undef PG8_LDB
#undef PG8_MMA
#undef PG8_WAIT_V
#undef PG8_WAIT_L
#undef PG8_BAR
#undef PG8_SCHED
}
}

struct EpiStoreBf16 { bf16_t* O; int ldc; int gelu_below;
    __device__ __forceinline__ void operator()(int row, int pn, int cx, f32x4 v0, f32x4 v1) const {
        const int c0 = pn * 256 + cx, c1 = c0 + 128;
        if (c0 < gelu_below) { v0[0] = gelu_tanh_f(v0[0]); v0[1] = gelu_tanh_f(v0[1]); v0[2] = gelu_tanh_f(v0[2]); v0[3] = gelu_tanh_f(v0[3]); }
        if (c1 < gelu_below) { v1[0] = gelu_tanh_f(v1[0]); v1[1] = gelu_tanh_f(v1[1]); v1[2] = gelu_tanh_f(v1[2]); v1[3] = gelu_tanh_f(v1[3]); }
        u32x2 a; a.x = pack2(v0[0], v0[1]); a.y = pack2(v0[2], v0[3]); u32x2 b; b.x = pack2(v1[0], v1[1]); b.y = pack2(v1[2], v1[3]);
        *(u32x2*)(O + (size_t)row * ldc + c0) = a; *(u32x2*)(O + (size_t)row * ldc + c1) = b; } };
struct EpiResidual { const float* srcl; const float* srcc; float* dstl; float* dstc; const float* mod;   int which;
    __device__ __forceinline__ void operator()(int row, int pn, int cx, f32x4 v0, f32x4 v1) const {
        const int b = row < TL ? (row >> 13) : 8; const float* g = mod + ((size_t)b * 6 + which) * 1024;
        const float* s = row < TL ? srcl + (size_t)row * 1024 : srcc + (size_t)(row - TL) * 1024;
        float* d = row < TL ? dstl + (size_t)row * 1024 : dstc + (size_t)(row - TL) * 1024;
        const int c0 = pn * 256 + cx, c1 = c0 + 128;
        *(f32x4*)(d + c0) = *(const f32x4*)(s + c0) + *(const f32x4*)(g + c0) * v0;
        *(f32x4*)(d + c1) = *(const f32x4*)(s + c1) + *(const f32x4*)(g + c1) * v1; } };
struct EpiMoe1 { bf16_t* H;
    __device__ __forceinline__ void operator()(int row, int pn, int cx, f32x4 v0, f32x4 v1) const {
        u32x2 a; a.x = pack2(silu_f(v0[0]) * v1[0], silu_f(v0[1]) * v1[1]); a.y = pack2(silu_f(v0[2]) * v1[2], silu_f(v0[3]) * v1[3]);
        *(u32x2*)(H + (size_t)row * 512 + pn * 128 + cx) = a; } };
struct EpiMoe2 { const int* stok; const float* sw; float* dstl; float* dstc; const float* mod;
    __device__ __forceinline__ void operator()(int row, int pn, int cx, f32x4 v0, f32x4 v1) const {
        const int t = stok[row]; if (t < 0) return; const float w = sw[row];
        const int b = t < TL ? (t >> 13) : 8; const float* g = mod + ((size_t)b * 6 + 5) * 1024;
        float* d = t < TL ? dstl + (size_t)t * 1024 : dstc + (size_t)(t - TL) * 1024;
        const int c0 = pn * 256 + cx, c1 = c0 + 128;
        *(f32x4*)(d + c0) = *(const f32x4*)(d + c0) + *(const f32x4*)(g + c0) * v0 * w;
        *(f32x4*)(d + c1) = *(const f32x4*)(d + c1) + *(const f32x4*)(g + c1) * v1 * w; } };

#ifndef FAST_GEMM
#define FAST_GEMM 1
#endif
template <class EP>
__device__ __forceinline__ void gemm_dense(const Frame& F, const bf16_t* A, const bf16_t* Bt, int M, int N, int K, const EP& E) {
#if FAST_GEMM
    pg8::ProbDense S; S.init(A, Bt, M, N, K, F.G, F.bid); pg8::gemm_phase(F.lds, S, E);
#else
    gemm_dense_naive(F, A, Bt, M, N, K, E);
#endif
}
__device__ __forceinline__ void ph_moe_gemm1(const Frame& F, int layer) {
    const unsigned* info = (const unsigned*)(F.ws + WS_CTRL + C_MOE + layer * 1024) + 128;
    const int ntiles = (int)__hip_atomic_load(&info[1], __ATOMIC_RELAXED, __HIP_MEMORY_SCOPE_AGENT);
    const int* tile_e = (const int*)(F.ws + WS_R2 + R2_TILEE); const int* stok = (const int*)(F.ws + WS_R2 + R2_STOK);
    const bf16_t* W1 = (const bf16_t*)(F.ws + WS_WMOE);
    EpiMoe1 E{(bf16_t*)(F.ws + WS_R2 + R2_H)};
#if FAST_GEMM
    pg8::ProbMoe1 S{(const char*)(F.ws + WS_ACT), stok, tile_e, (const char*)W1, 1024, ntiles, F.G, F.bid};
    pg8::gemm_phase(F.lds, S, E);
#else
    for (int u = F.bid; u < ntiles * 4; u += F.G) { const int pm = u >> 2, pn = u & 3; const int e = tile_e[pm] & 31;
        ARowGather ar{(const bf16_t*)(F.ws + WS_ACT), stok, pm};
        gemm_unit_naive(F, 1024, ar, W1 + ((size_t)e * 1024 + pn * 256) * 1024, E, pm, pn); }
#endif
}
__device__ __forceinline__ void ph_moe_gemm2(const Frame& F, int layer, int k) {
    const unsigned* info = (const unsigned*)(F.ws + WS_CTRL + C_MOE + layer * 1024) + 128;
    const int nk0 = (int)__hip_atomic_load(&info[0], __ATOMIC_RELAXED, __HIP_MEMORY_SCOPE_AGENT), nall = (int)__hip_atomic_load(&info[1], __ATOMIC_RELAXED, __HIP_MEMORY_SCOPE_AGENT);
    const int tlo = k == 0 ? 0 : nk0, thi = k == 0 ? nk0 : nall;
    const int* tile_e = (const int*)(F.ws + WS_R2 + R2_TILEE);
    const bf16_t* W2 = (const bf16_t*)(F.ws + WS_WMOE) + (size_t)32 * 1024 * 1024;
    EpiMoe2 E{(const int*)(F.ws + WS_R2 + R2_STOK), (const float*)(F.ws + WS_R2 + R2_SW), F.P->out, (float*)(F.ws + WS_XC), F.mod + (size_t)layer * 9 * 6144};
#if FAST_GEMM
    pg8::ProbMoe2 S{(const char*)(F.ws + WS_R2 + R2_H), tile_e, (const char*)W2, 512, tlo, thi, F.G, F.bid};
    pg8::gemm_phase(F.lds, S, E);
#else
    for (int u = F.bid; u < (thi - tlo) * 4; u += F.G) { const int pm = tlo + (u >> 2), pn = u & 3; const int e = tile_e[pm] & 31;
        ARowDense ar{(const bf16_t*)(F.ws + WS_R2 + R2_H), 512, pm};
        gemm_unit_naive(F, 512, ar, W2 + ((size_t)e * 1024 + pn * 256) * 512, E, pm, pn); }
#endif
}

__device__ __forceinline__ void ph_gmlp(const Frame& F) {
    const Params& P = *F.P;
    const bf16_t* PX = (const bf16_t*)(F.ws + WS_PX); bf16_t* CAT = (bf16_t*)(F.ws + WS_ACT);
    LAS float* Vs = (LAS float*)F.lds;
    LAS float* Wm = Vs + 128 * 128;
    LAS float* rs = Wm + 128 * 129;
    for (int it = F.bid; it < 528 * 4; it += F.G) {
        const int ch = it >> 2, g = it & 3, row0 = ch * 128;
        for (int q = F.wave; q < 128; q += 8) { const bf16_t* p = PX + (size_t)(row0 + q) * EVEN_IN + 512 + F.lane * 8;
            const u32x4 w = *(const u32x4*)p; float s = 0.f, x;
            x = lo2f(w.x); s += x * x; x = hi2f(w.x); s += x * x; x = lo2f(w.y); s += x * x; x = hi2f(w.y); s += x * x;
            x = lo2f(w.z); s += x * x; x = hi2f(w.z); s += x * x; x = lo2f(w.w); s += x * x; x = hi2f(w.w); s += x * x;
            s = wave_sum(s); if (F.lane == 0) rs[q] = rsqrtf(s * (1.f / 512.f) + EPS); }
        __syncthreads();
        for (int i = F.tid; i < 128 * 128; i += NTH) { const int q = i >> 7, c = i & 127;
            Vs[i] = bf2f(PX[(size_t)(row0 + q) * EVEN_IN + 512 + g * 128 + c]) * rs[q] * P.in[I_GNW][g * 128 + c];
            Wm[q * 129 + c] = P.in[I_GWS][(size_t)g * 16384 + i]; }
        __syncthreads();
        const int ty = F.tid >> 5, tx = F.tid & 31;
        float acc[8][4];
#pragma unroll
        for (int i = 0; i < 8; ++i)
#pragma unroll
            for (int j = 0; j < 4; ++j) acc[i][j] = 0.f;
        for (int q = 0; q < 128; ++q) { const f32x4 v = *(const LAS f32x4*)(Vs + q * 128 + tx * 4);
#pragma unroll
            for (int i = 0; i < 8; ++i) { const float w = Wm[(ty * 8 + i) * 129 + q];
#pragma unroll
                for (int j = 0; j < 4; ++j) acc[i][j] += w * v[j]; } }
#pragma unroll
        for (int i = 0; i < 8; ++i) { const int p = ty * 8 + i; const float bias = P.in[I_GBS][g * 128 + p];
            const size_t t = (size_t)(row0 + p); const int col = g * 128 + tx * 4;
            const u32x2 uu = *(const u32x2*)(PX + t * EVEN_IN + col);
            u32x2 o; o.x = pack2(lo2f(uu.x) * (acc[i][0] + bias), hi2f(uu.x) * (acc[i][1] + bias)); o.y = pack2(lo2f(uu.y) * (acc[i][2] + bias), hi2f(uu.y) * (acc[i][3] + bias));
            *(u32x2*)(CAT + t * 1024 + col) = o; }
        __syncthreads();
    }
}

__device__ __forceinline__ void ph_gmlp_mfma(const Frame& F) {
    const Params& P = *F.P;
    const bf16_t* PX = (const bf16_t*)(F.ws + WS_PX); bf16_t* CAT = (bf16_t*)(F.ws + WS_ACT);
    LAS unsigned char* VT = F.lds;
    LAS unsigned char* WB = F.lds + 34816;
    LAS float* rs = (LAS float*)(F.lds + 69632);
    const int l31 = F.lane & 31, hh = F.lane >> 5;
    for (int it = F.bid; it < 528 * 4; it += F.G) {
        const int ch = it >> 2, g = it & 3, row0 = ch * 128;
        for (int q = F.wave; q < 128; q += 8) { const bf16_t* p = PX + (size_t)(row0 + q) * EVEN_IN + 512 + F.lane * 8;
            const u32x4 w = *(const u32x4*)p; float s = 0.f, x;
            x = lo2f(w.x); s += x * x; x = hi2f(w.x); s += x * x; x = lo2f(w.y); s += x * x; x = hi2f(w.y); s += x * x;
            x = lo2f(w.z); s += x * x; x = hi2f(w.z); s += x * x; x = lo2f(w.w); s += x * x; x = hi2f(w.w); s += x * x;
            s = wave_sum(s); if (F.lane == 0) rs[q] = rsqrtf(s * (1.f / 512.f) + EPS); }
#pragma unroll
        for (int k = 0; k < 4; ++k) { const int c = F.tid + 512 * k, p = c >> 4, part = c & 15;
            const float* src = P.in[I_GWS] + (size_t)g * 16384 + p * 128 + part * 8; const f32x4 a = *(const f32x4*)src, b = *(const f32x4*)(src + 4);
            u32x4 w; w.x = pack2(a[0], a[1]); w.y = pack2(a[2], a[3]); w.z = pack2(b[0], b[1]); w.w = pack2(b[2], b[3]);
            *(LAS u32x4*)(WB + p * 272 + part * 16) = w; }
        __syncthreads();
#pragma unroll
        for (int k = 0; k < 4; ++k) { const int c = F.tid + 512 * k, q = c >> 4, c0 = (c & 15) * 8;
            const u32x4 w = *(const u32x4*)(PX + (size_t)(row0 + q) * EVEN_IN + 512 + g * 128 + c0); const float r = rs[q];
            const float* nw = P.in[I_GNW] + g * 128 + c0; const f32x4 n0 = *(const f32x4*)nw, n1 = *(const f32x4*)(nw + 4);
            LAS unsigned short* d = (LAS unsigned short*)(VT + c0 * 272 + q * 2);
            d[0 * 136] = f2bf(lo2f(w.x) * r * n0[0]); d[1 * 136] = f2bf(hi2f(w.x) * r * n0[1]); d[2 * 136] = f2bf(lo2f(w.y) * r * n0[2]); d[3 * 136] = f2bf(hi2f(w.y) * r * n0[3]);
            d[4 * 136] = f2bf(lo2f(w.z) * r * n1[0]); d[5 * 136] = f2bf(hi2f(w.z) * r * n1[1]); d[6 * 136] = f2bf(lo2f(w.w) * r * n1[2]); d[7 * 136] = f2bf(hi2f(w.w) * r * n1[3]); }
        __syncthreads();
        const int pb = F.wave >> 1, cb0 = (F.wave & 1) * 2;
        f32x16 a0, a1;
#pragma unroll
        for (int r = 0; r < 16; ++r) { a0[r] = 0.f; a1[r] = 0.f; }
#pragma unroll
        for (int ks = 0; ks < 8; ++ks) { const s16x8 wa = *(const LAS s16x8*)(WB + (32 * pb + l31) * 272 + ks * 32 + hh * 16);
            a0 = __builtin_amdgcn_mfma_f32_32x32x16_bf16(wa, *(const LAS s16x8*)(VT + (32 * cb0 + l31) * 272 + ks * 32 + hh * 16), a0, 0, 0, 0);
            a1 = __builtin_amdgcn_mfma_f32_32x32x16_bf16(wa, *(const LAS s16x8*)(VT + (32 * (cb0 + 1) + l31) * 272 + ks * 32 + hh * 16), a1, 0, 0, 0); }
#pragma unroll
        for (int r = 0; r < 16; ++r) { const int p = 32 * pb + (r & 3) + 8 * (r >> 2) + 4 * hh; const float bias = P.in[I_GBS][g * 128 + p];
            const size_t t = (size_t)(row0 + p); const int c0 = g * 128 + 32 * cb0 + l31, c1 = c0 + 32;
            CAT[t * 1024 + c0] = f2bf(bf2f(PX[t * EVEN_IN + c0]) * (a0[r] + bias));
            CAT[t * 1024 + c1] = f2bf(bf2f(PX[t * EVEN_IN + c1]) * (a1[r] + bias)); }
        __syncthreads();
    }
}

__device__ __forceinline__ void ph_gla(const Frame& F) {
    const Params& P = *F.P;
    const bf16_t* PX = (const bf16_t*)(F.ws + WS_PX);
    LAS float* qs = (LAS float*)F.lds;
    LAS float* fs = qs + 8192;
    LAS float* vs = fs + 8192;
    LAS float* os = vs + 2048;
    const int dg = F.lane & 15, el = F.wave * 4 + (F.lane >> 4);
    const int prow = F.tid >> 4, pd0 = (F.tid & 15) * 8;
    const int vrow = F.tid >> 2, ve0 = (F.tid & 3) * 8;
    for (int it = F.bid; it < 256; it += F.G) {
        const int b = it >> 5, h = (it >> 3) & 3, dir = (it >> 2) & 1, sl = it & 3;
        bf16_t* O = (bf16_t*)(F.ws + WS_R2 + (dir ? R2_OB0 : R2_OF0));
        float lb8[8];
#pragma unroll
        for (int i = 0; i < 8; ++i) { const int ch = h * 128 + pd0 + i; const float* lg = P.in[I_LB] + (size_t)dir * 3 * 512 + ch;
            const float a0 = lg[0], a1 = lg[512], a2 = lg[1024]; const float m = fmaxf(a0, fmaxf(a1, a2));
            const float e0 = __expf(a0 - m), e1 = __expf(a1 - m), e2 = __expf(a2 - m); lb8[i] = e0 / (e0 + e1 + e2); }
        float S[8];
#pragma unroll
        for (int i = 0; i < 8; ++i) S[i] = 0.f;
        u32x4 rq0, rq1, rf0, rf1, rv = {0u, 0u, 0u, 0u};
        auto rowof = [&](int nb, int s) -> size_t { const bool c = nb < 4; const int len = c ? CTXL : SEQ; const int tt = (c ? nb : nb - 4) * 64 + s; const int p = dir ? len - 1 - tt : tt;
            return (c ? (size_t)TL + b * CTXL : (size_t)b * SEQ) + p; };
        auto fetch = [&](int nb) { const bf16_t* r0 = PX + rowof(nb, prow) * EVEN_IN; const bf16_t* r1 = PX + rowof(nb, prow + 32) * EVEN_IN;
            rq0 = *(const u32x4*)(r0 + 1024 + h * 128 + pd0); rf0 = *(const u32x4*)(r0 + 2048 + dir * 512 + h * 128 + pd0);
            rq1 = *(const u32x4*)(r1 + 1024 + h * 128 + pd0); rf1 = *(const u32x4*)(r1 + 2048 + dir * 512 + h * 128 + pd0);
            if (F.tid < 256) rv = *(const u32x4*)(PX + rowof(nb, vrow) * EVEN_IN + 1536 + h * 128 + sl * 32 + ve0); };
        auto put = [&](int row, u32x4 q, u32x4 f) { LAS float* qd = qs + row * 128 + pd0; LAS float* fd = fs + row * 128 + pd0;
            const float q8[8] = {lo2f(q.x), hi2f(q.x), lo2f(q.y), hi2f(q.y), lo2f(q.z), hi2f(q.z), lo2f(q.w), hi2f(q.w)};
            const float f8[8] = {lo2f(f.x), hi2f(f.x), lo2f(f.y), hi2f(f.y), lo2f(f.z), hi2f(f.z), lo2f(f.w), hi2f(f.w)};
            f32x4 o0, o1, g0, g1;
#pragma unroll
            for (int i = 0; i < 4; ++i) { o0[i] = q8[i]; o1[i] = q8[4 + i]; g0[i] = lb8[i] + (1.f - lb8[i]) * sigmoid_f(f8[i]); g1[i] = lb8[4 + i] + (1.f - lb8[4 + i]) * sigmoid_f(f8[4 + i]); }
            *(LAS f32x4*)qd = o0; *(LAS f32x4*)(qd + 4) = o1; *(LAS f32x4*)fd = g0; *(LAS f32x4*)(fd + 4) = g1; };
        fetch(0);
        for (int nb = 0; nb < 132; ++nb) {
            __syncthreads();
            put(prow, rq0, rf0); put(prow + 32, rq1, rf1);
            if (F.tid < 256) { LAS float* vd = vs + vrow * 32 + ve0;
                *(LAS f32x4*)vd = (f32x4){lo2f(rv.x), hi2f(rv.x), lo2f(rv.y), hi2f(rv.y)}; *(LAS f32x4*)(vd + 4) = (f32x4){lo2f(rv.z), hi2f(rv.z), lo2f(rv.w), hi2f(rv.w)}; }
            __syncthreads();
            if (nb + 1 < 132) fetch(nb + 1);
#pragma unroll 4
            for (int st = 0; st < 64; ++st) {
                const f32x4 fa = *(const LAS f32x4*)(fs + st * 128 + dg * 8), fb = *(const LAS f32x4*)(fs + st * 128 + dg * 8 + 4);
                const f32x4 qa = *(const LAS f32x4*)(qs + st * 128 + dg * 8), qb = *(const LAS f32x4*)(qs + st * 128 + dg * 8 + 4);
                const float v = vs[st * 32 + el];
                float p0 = 0.f, p1 = 0.f;
#pragma unroll
                for (int i = 0; i < 4; ++i) { S[i] = fa[i] * (S[i] - v) + v; p0 += qa[i] * S[i]; S[4 + i] = fb[i] * (S[4 + i] - v) + v; p1 += qb[i] * S[4 + i]; }
                const float o = sum16(p0 + p1);
                if (dg == 0) os[st * 32 + el] = o;
            }
            __syncthreads();
#pragma unroll
            for (int k = 0; k < 2; ++k) { const int s = (F.tid >> 4) + 32 * k, e2 = (F.tid & 15) * 2;
              *(unsigned*)(O + rowof(nb, s) * 512 + h * 128 + sl * 32 + e2) = pack2(os[s * 32 + e2], os[s * 32 + e2 + 1]); }
        }
        __syncthreads();
    }
}

__device__ __forceinline__ void ph_merge(const Frame& F, int mode) {
    const Params& P = *F.P;
    const bf16_t* PX = (const bf16_t*)(F.ws + WS_PX); bf16_t* CAT = (bf16_t*)(F.ws + WS_ACT);
    const bf16_t* Of = (const bf16_t*)(mode ? F.ws + WS_GOF : F.ws + WS_R2 + R2_OF0); const bf16_t* Ob = (const bf16_t*)(mode ? F.ws + WS_WMOE : F.ws + WS_R2 + R2_OB0);
    const int nrows = mode ? TL : TT, ldp = mode ? ODD_PAD : EVEN_IN, gcol = mode ? 1536 : 3072, dcol = mode ? 0 : 512;
    const float* nw = mode ? P.in[I_GDNNW] : P.in[I_HNW];
    for (int r = F.bid * 8 + F.wave; r < nrows; r += F.G * 8) {
        const int c = F.lane * 8;
        const u32x4 a = *(const u32x4*)(Of + (size_t)r * 512 + c), bb = *(const u32x4*)(Ob + (size_t)r * 512 + c), gg = *(const u32x4*)(PX + (size_t)r * ldp + gcol + c);
        float o[8] = {lo2f(a.x) + lo2f(bb.x), hi2f(a.x) + hi2f(bb.x), lo2f(a.y) + lo2f(bb.y), hi2f(a.y) + hi2f(bb.y), lo2f(a.z) + lo2f(bb.z), hi2f(a.z) + hi2f(bb.z), lo2f(a.w) + lo2f(bb.w), hi2f(a.w) + hi2f(bb.w)};
        const float g[8] = {lo2f(gg.x), hi2f(gg.x), lo2f(gg.y), hi2f(gg.y), lo2f(gg.z), hi2f(gg.z), lo2f(gg.w), hi2f(gg.w)};
        float ss = 0.f;
#pragma unroll
        for (int i = 0; i < 8; ++i) ss += o[i] * o[i];
        ss = sum16(ss);
        const float rstd = rsqrtf(ss * (1.f / 128.f) + EPS);
        float y[8];
#pragma unroll
        for (int i = 0; i < 8; ++i) { const float w = mode ? nw[(c & 127) + i] : nw[c + i]; y[i] = o[i] * rstd * w * silu_f(g[i]); }
        u32x4 w; w.x = pack2(y[0], y[1]); w.y = pack2(y[2], y[3]); w.z = pack2(y[4], y[5]); w.w = pack2(y[6], y[7]);
        *(u32x4*)(CAT + (size_t)r * 1024 + dcol + c) = w;
    }
}

__device__ __forceinline__ void ph_mla_norm(const Frame& F) {
    const Params& P = *F.P;
    const bf16_t* PX = (const bf16_t*)(F.ws + WS_PX);
    bf16_t* cqn = (bf16_t*)(F.ws + WS_R2 + R2_CQN); bf16_t* ckvn = cqn + (size_t)TL * 256;
    for (int r = F.bid * 8 + F.wave; r < TT; r += F.G * 8) {
        const bf16_t* row = PX + (size_t)r * ODD_PAD;
        if (r < TL) { const u32x2 w = *(const u32x2*)(row + 2064 + F.lane * 4);
            const float x0 = lo2f(w.x), x1 = hi2f(w.x), x2 = lo2f(w.y), x3 = hi2f(w.y);
            const float ss = wave_sum(x0 * x0 + x1 * x1 + x2 * x2 + x3 * x3); const float rstd = rsqrtf(ss * (1.f / 256.f) + EPS);
            const float* nw = P.in[I_QNW] + F.lane * 4;
            u32x2 o; o.x = pack2(x0 * rstd * nw[0], x1 * rstd * nw[1]); o.y = pack2(x2 * rstd * nw[2], x3 * rstd * nw[3]);
            *(u32x2*)(cqn + (size_t)r * 256 + F.lane * 4) = o; }
        { const unsigned w = *(const unsigned*)(row + 2320 + F.lane * 2);
          const float x0 = lo2f(w), x1 = hi2f(w);
          const float ss = wave_sum(x0 * x0 + x1 * x1); const float rstd = rsqrtf(ss * (1.f / 128.f) + EPS);
          const float* nw = P.in[I_KVNW] + F.lane * 2;
          *(unsigned*)(ckvn + (size_t)r * 256 + F.lane * 2) = pack2(x0 * rstd * nw[0], x1 * rstd * nw[1]);
          *(unsigned*)(ckvn + (size_t)r * 256 + 128 + F.lane * 2) = 0u; }
    }
}

__device__ __forceinline__ void ph_mla_final(const Frame& F) {
    const Params& P = *F.P;
    const bf16_t* PX = (const bf16_t*)(F.ws + WS_PX);
    bf16_t* Q = (bf16_t*)(F.ws + WS_WMOE);
    const bf16_t* KVR = (const bf16_t*)(F.ws + WS_PX + PX_KVRAW);
    bf16_t* Kb = (bf16_t*)(F.ws + WS_R2 + R2_K); bf16_t* Vb = (bf16_t*)(F.ws + WS_R2 + R2_V);
    const int hh = F.lane >> 3, sub = F.lane & 7;
    const float freq = __powf(10000.f, -(float)sub * 0.125f);
    const float qscale = 0.10206207261596577f * 1.4426950408889634f;
    for (int r = F.bid * 8 + F.wave; r < TT; r += F.G * 8) {
        const bool lat = r < TL; const int l = r & (SEQ - 1);
        float ca = 1.f, sa = 0.f, cb = 1.f, sb = 0.f;
        if (lat) { const float pr = (float)(l >> 6), pc = (float)(l & 63); sincosf(pr * freq, &sa, &ca); sincosf(pc * freq, &sb, &cb); }
        { const bf16_t* kv = KVR + (size_t)r * 1024 + hh * 128;
          const u32x4 w = *(const u32x4*)(kv + sub * 8);
          float x[12] = {lo2f(w.x), hi2f(w.x), lo2f(w.y), hi2f(w.y), lo2f(w.z), hi2f(w.z), lo2f(w.w), hi2f(w.w), 0.f, 0.f, 0.f, 0.f};
          const bf16_t* kr = PX + (size_t)r * ODD_PAD + 2448;
          x[8] = bf2f(kr[sub]); x[9] = bf2f(kr[8 + sub]); x[10] = bf2f(kr[16 + sub]); x[11] = bf2f(kr[24 + sub]);
          float ss = 0.f;
#pragma unroll
          for (int i = 0; i < 12; ++i) ss += x[i] * x[i];
          ss = sum8(ss);
          const float rstd = rsqrtf(ss * (1.f / 96.f) + EPS);
          const float* nw = P.in[I_QKK];
#pragma unroll
          for (int i = 0; i < 8; ++i) x[i] *= rstd * nw[sub * 8 + i];
          x[8] *= rstd * nw[64 + sub]; x[9] *= rstd * nw[72 + sub]; x[10] *= rstd * nw[80 + sub]; x[11] *= rstd * nw[88 + sub];
          const float a1 = x[8] * ca - x[9] * sa, a2 = x[9] * ca + x[8] * sa, b1 = x[10] * cb - x[11] * sb, b2 = x[11] * cb + x[10] * sb;
          const int bidx = lat ? (r >> 13) : ((r - TL) >> 8); const int s = lat ? (CTXL + l) : ((r - TL) & 255);
          bf16_t* kd = Kb + ((size_t)(bidx * 8 + hh) * (SEQ + CTXL) + s) * 96;
          u32x4 o; o.x = pack2(x[0], x[1]); o.y = pack2(x[2], x[3]); o.z = pack2(x[4], x[5]); o.w = pack2(x[6], x[7]);
          *(u32x4*)(kd + sub * 8) = o;
          kd[64 + sub] = f2bf(a1); kd[72 + sub] = f2bf(a2); kd[80 + sub] = f2bf(b1); kd[88 + sub] = f2bf(b2);
          const u32x4 vv = *(const u32x4*)(kv + 64 + sub * 8);
          *(u32x4*)(Vb + ((size_t)(bidx * 8 + hh) * (SEQ + CTXL) + s) * 64 + sub * 8) = vv; }
        if (lat) { bf16_t* q = Q + (size_t)r * 768 + hh * 96;
          const u32x4 w = *(const u32x4*)(q + sub * 8);
          float x[12] = {lo2f(w.x), hi2f(w.x), lo2f(w.y), hi2f(w.y), lo2f(w.z), hi2f(w.z), lo2f(w.w), hi2f(w.w), bf2f(q[64 + sub]), bf2f(q[72 + sub]), bf2f(q[80 + sub]), bf2f(q[88 + sub])};
          float ss = 0.f;
#pragma unroll
          for (int i = 0; i < 12; ++i) ss += x[i] * x[i];
          ss = sum8(ss);
          const float rstd = rsqrtf(ss * (1.f / 96.f) + EPS) * qscale;
          const float* nw = P.in[I_QKQ];
#pragma unroll
          for (int i = 0; i < 8; ++i) x[i] *= rstd * nw[sub * 8 + i];
          x[8] *= rstd * nw[64 + sub]; x[9] *= rstd * nw[72 + sub]; x[10] *= rstd * nw[80 + sub]; x[11] *= rstd * nw[88 + sub];
          const float a1 = x[8] * ca - x[9] * sa, a2 = x[9] * ca + x[8] * sa, b1 = x[10] * cb - x[11] * sb, b2 = x[11] * cb + x[10] * sb;
          u32x4 o; o.x = pack2(x[0], x[1]); o.y = pack2(x[2], x[3]); o.z = pack2(x[4], x[5]); o.w = pack2(x[6], x[7]);
          *(u32x4*)(q + sub * 8) = o;
          q[64 + sub] = f2bf(a1); q[72 + sub] = f2bf(a2); q[80 + sub] = f2bf(b1); q[88 + sub] = f2bf(b2); }
    }
}

__device__ __forceinline__ void ph_attn_naive(const Frame& F) {
    const bf16_t* Q = (const bf16_t*)(F.ws + WS_WMOE);
    const bf16_t* Kb = (const bf16_t*)(F.ws + WS_R2 + R2_K); const bf16_t* Vb = (const bf16_t*)(F.ws + WS_R2 + R2_V);
    bf16_t* CAT = (bf16_t*)(F.ws + WS_ACT);
    LAS float* Ks = (LAS float*)F.lds;
    LAS float* Vs = Ks + 64 * 96;
    constexpr int NK = SEQ + CTXL;
    const int hf = F.tid & 1;
    for (int it = F.bid; it < 8 * 8 * 32; it += F.G) {
        const int b = it >> 8, h = (it >> 5) & 7, qb = it & 31;
        const int l = qb * 256 + (F.tid >> 1); const size_t trow = (size_t)b * SEQ + l;
        float q[48], o[32];
        { const bf16_t* qp = Q + trow * 768 + h * 96 + hf * 48;
#pragma unroll
          for (int i = 0; i < 6; ++i) { const u32x4 w = *(const u32x4*)(qp + i * 8);
            q[i * 8 + 0] = lo2f(w.x); q[i * 8 + 1] = hi2f(w.x); q[i * 8 + 2] = lo2f(w.y); q[i * 8 + 3] = hi2f(w.y); q[i * 8 + 4] = lo2f(w.z); q[i * 8 + 5] = hi2f(w.z); q[i * 8 + 6] = lo2f(w.w); q[i * 8 + 7] = hi2f(w.w); } }
#pragma unroll
        for (int d = 0; d < 32; ++d) o[d] = 0.f;
        float m = -3.0e38f, ls = 0.f;
        const bf16_t* kb = Kb + (size_t)(b * 8 + h) * NK * 96; const bf16_t* vb = Vb + (size_t)(b * 8 + h) * NK * 64;
        for (int kt = 0; kt < NK / 64; ++kt) {
            for (int i = F.tid; i < 64 * 96 / 8; i += NTH) { const u32x4 w = *(const u32x4*)(kb + (size_t)kt * 64 * 96 + i * 8); LAS float* d = Ks + i * 8;
                d[0] = lo2f(w.x); d[1] = hi2f(w.x); d[2] = lo2f(w.y); d[3] = hi2f(w.y); d[4] = lo2f(w.z); d[5] = hi2f(w.z); d[6] = lo2f(w.w); d[7] = hi2f(w.w); }
            { const int i = F.tid; const u32x4 w = *(const u32x4*)(vb + (size_t)kt * 64 * 64 + i * 8); LAS float* d = Vs + i * 8;
                d[0] = lo2f(w.x); d[1] = hi2f(w.x); d[2] = lo2f(w.y); d[3] = hi2f(w.y); d[4] = lo2f(w.z); d[5] = hi2f(w.z); d[6] = lo2f(w.w); d[7] = hi2f(w.w); }
            __syncthreads();
            for (int jb = 0; jb < 16; ++jb) {
                float s[4]; float mx = m;
#pragma unroll
                for (int jj = 0; jj < 4; ++jj) { const LAS float* kr = Ks + (jb * 4 + jj) * 96 + hf * 48; float a = 0.f;
#pragma unroll
                    for (int d = 0; d < 48; d += 4) { const f32x4 kv = *(const LAS f32x4*)(kr + d); a += q[d] * kv[0] + q[d + 1] * kv[1] + q[d + 2] * kv[2] + q[d + 3] * kv[3]; }
                    a += __shfl_xor(a, 1);
                    s[jj] = a; mx = fmaxf(mx, a); }
                const float sc = exp2f(m - mx); ls *= sc;
#pragma unroll
                for (int d = 0; d < 32; ++d) o[d] *= sc;
                m = mx;
#pragma unroll
                for (int jj = 0; jj < 4; ++jj) { const float p = exp2f(s[jj] - mx); ls += p; const LAS float* vr = Vs + (jb * 4 + jj) * 64 + hf * 32;
#pragma unroll
                    for (int d = 0; d < 32; d += 4) { const f32x4 vv = *(const LAS f32x4*)(vr + d); o[d] += p * vv[0]; o[d + 1] += p * vv[1]; o[d + 2] += p * vv[2]; o[d + 3] += p * vv[3]; } }
            }
            __syncthreads();
        }
        const float inv = 1.f / ls;
        bf16_t* dst = CAT + trow * 1024 + 512 + h * 64 + hf * 32;
#pragma unroll
        for (int i = 0; i < 4; ++i) { u32x4 w; w.x = pack2(o[i * 8] * inv, o[i * 8 + 1] * inv); w.y = pack2(o[i * 8 + 2] * inv, o[i * 8 + 3] * inv); w.z = pack2(o[i * 8 + 4] * inv, o[i * 8 + 5] * inv); w.w = pack2(o[i * 8 + 6] * inv, o[i * 8 + 7] * inv);
            *(u32x4*)(dst + i * 8) = w; }
    }
}

__device__ __forceinline__ void ph_attn(const Frame& F) {
    constexpr int NK = SEQ + CTXL, NT = NK / 64;
    constexpr int KROWB = 208, VROWB = 144, KBYTES = 64 * KROWB, VBYTES = 64 * VROWB, BUFB = KBYTES + VBYTES;
    const bf16_t* Q = (const bf16_t*)(F.ws + WS_WMOE);
    const bf16_t* Kb = (const bf16_t*)(F.ws + WS_R2 + R2_K); const bf16_t* Vb = (const bf16_t*)(F.ws + WS_R2 + R2_V);
    bf16_t* CAT = (bf16_t*)(F.ws + WS_ACT);
    const int l31 = F.lane & 31, hh = F.lane >> 5;
    const int vcu = (F.G % 8 == 0) ? (F.bid % 8) * (F.G / 8) + F.bid / 8 : F.bid;
    const int kc0 = F.tid, kc1 = F.tid + 512;
    const unsigned kd0 = (unsigned)((kc0 / 12) * KROWB + (kc0 % 12) * 16), kd1 = (unsigned)((kc1 / 12) * KROWB + (kc1 % 12) * 16);
    const int vkey = F.tid >> 3, vpos = (vkey & ~12) | ((vkey & 4) << 1) | ((vkey & 8) >> 1);
    const unsigned vd = (unsigned)(((F.tid & 7) * 8) * VROWB + vpos * 2);
    for (int u = vcu; u < 2048; u += F.G) {
        const int bh = u >> 5, qblk = u & 31, b = bh >> 3, h = bh & 7;
        const size_t trow = (size_t)b * SEQ + qblk * 256 + F.wave * 32 + l31;
        s16x8 qf[6];
        { const bf16_t* qp = Q + trow * 768 + h * 96 + hh * 8;
#pragma unroll
          for (int ds = 0; ds < 6; ++ds) qf[ds] = *(const s16x8*)(qp + ds * 16); }
        f32x16 o0, o1;
#pragma unroll
        for (int i = 0; i < 16; ++i) { o0[i] = 0.f; o1[i] = 0.f; }
        float m = -1.0e30f, lsum = 0.f;
        const bf16_t* kg = Kb + (size_t)bh * NK * 96; const bf16_t* vg = Vb + (size_t)bh * NK * 64;
        u32x4 kr0, kr1 = {0u, 0u, 0u, 0u}, vr;
        kr0 = *(const u32x4*)(kg + (size_t)kc0 * 8); if (kc1 < 768) kr1 = *(const u32x4*)(kg + (size_t)kc1 * 8); vr = *(const u32x4*)(vg + (size_t)F.tid * 8);
        __syncthreads();
        for (int t = 0; t < NT; ++t) {
            { LAS unsigned char* kbuf = F.lds + (t & 1) * BUFB; LAS unsigned char* vbuf = kbuf + KBYTES;
              *(LAS u32x4*)(kbuf + kd0) = kr0; if (kc1 < 768) *(LAS u32x4*)(kbuf + kd1) = kr1;
              LAS unsigned short* vp = (LAS unsigned short*)(vbuf + vd);
              vp[0 * (VROWB / 2)] = (unsigned short)(vr.x & 0xffffu); vp[1 * (VROWB / 2)] = (unsigned short)(vr.x >> 16);
              vp[2 * (VROWB / 2)] = (unsigned short)(vr.y & 0xffffu); vp[3 * (VROWB / 2)] = (unsigned short)(vr.y >> 16);
              vp[4 * (VROWB / 2)] = (unsigned short)(vr.z & 0xffffu); vp[5 * (VROWB / 2)] = (unsigned short)(vr.z >> 16);
              vp[6 * (VROWB / 2)] = (unsigned short)(vr.w & 0xffffu); vp[7 * (VROWB / 2)] = (unsigned short)(vr.w >> 16); }
            __syncthreads();
            if (t + 1 < NT) { const bf16_t* kt = kg + (size_t)(t + 1) * 64 * 96; const bf16_t* vt = vg + (size_t)(t + 1) * 64 * 64;
                kr0 = *(const u32x4*)(kt + (size_t)kc0 * 8); if (kc1 < 768) kr1 = *(const u32x4*)(kt + (size_t)kc1 * 8); vr = *(const u32x4*)(vt + (size_t)F.tid * 8); }
            const LAS unsigned char* kbuf = F.lds + (t & 1) * BUFB; const LAS unsigned char* vbuf = kbuf + KBYTES;
            f32x16 s0, s1;
#pragma unroll
            for (int i = 0; i < 16; ++i) { s0[i] = 0.f; s1[i] = 0.f; }
#pragma unroll
            for (int ds = 0; ds < 6; ++ds) {
                const s16x8 a0 = *(const LAS s16x8*)(kbuf + l31 * KROWB + ds * 32 + hh * 16);
                const s16x8 a1 = *(const LAS s16x8*)(kbuf + (32 + l31) * KROWB + ds * 32 + hh * 16);
                s0 = __builtin_amdgcn_mfma_f32_32x32x16_bf16(a0, qf[ds], s0, 0, 0, 0);
                s1 = __builtin_amdgcn_mfma_f32_32x32x16_bf16(a1, qf[ds], s1, 0, 0, 0);
            }
            float mx = s0[0];
#pragma unroll
            for (int i = 1; i < 16; ++i) mx = fmaxf(mx, s0[i]);
#pragma unroll
            for (int i = 0; i < 16; ++i) mx = fmaxf(mx, s1[i]);
            mx = fmaxf(mx, __shfl_xor(mx, 32));
            const float mn = fmaxf(m, mx); const bool moved = __any(mn > m); const float alpha = __builtin_amdgcn_exp2f(m - mn); m = mn;
            float ps = 0.f;
#pragma unroll
            for (int i = 0; i < 16; ++i) { s0[i] = __builtin_amdgcn_exp2f(s0[i] - mn); s1[i] = __builtin_amdgcn_exp2f(s1[i] - mn); ps += s0[i] + s1[i]; }
            lsum = lsum * alpha + ps;
            if (moved) {
#pragma unroll
                for (int i = 0; i < 16; ++i) { o0[i] *= alpha; o1[i] *= alpha; } }
#pragma unroll
            for (int kb = 0; kb < 2; ++kb)
#pragma unroll
                for (int st = 0; st < 2; ++st) {
                    u32x4 pw;
                    if (kb == 0) { pw.x = pack2(s0[8 * st + 0], s0[8 * st + 1]); pw.y = pack2(s0[8 * st + 2], s0[8 * st + 3]); pw.z = pack2(s0[8 * st + 4], s0[8 * st + 5]); pw.w = pack2(s0[8 * st + 6], s0[8 * st + 7]); }
                    else         { pw.x = pack2(s1[8 * st + 0], s1[8 * st + 1]); pw.y = pack2(s1[8 * st + 2], s1[8 * st + 3]); pw.z = pack2(s1[8 * st + 4], s1[8 * st + 5]); pw.w = pack2(s1[8 * st + 6], s1[8 * st + 7]); }
                    const s16x8 pf = __builtin_bit_cast(s16x8, pw);
                    const int kof = (kb * 32 + 16 * st + 8 * hh) * 2;
                    o0 = __builtin_amdgcn_mfma_f32_32x32x16_bf16(*(const LAS s16x8*)(vbuf + l31 * VROWB + kof), pf, o0, 0, 0, 0);
                    o1 = __builtin_amdgcn_mfma_f32_32x32x16_bf16(*(const LAS s16x8*)(vbuf + (32 + l31) * VROWB + kof), pf, o1, 0, 0, 0);
                }
        }
        const float ltot = lsum + __shfl_xor(lsum, 32); const float inv = 1.f / ltot;
        bf16_t* dst = CAT + trow * 1024 + 512 + h * 64 + hh * 4;
#pragma unroll
        for (int g = 0; g < 4; ++g) { u32x2 w;
            w.x = pack2(o0[4 * g] * inv, o0[4 * g + 1] * inv); w.y = pack2(o0[4 * g + 2] * inv, o0[4 * g + 3] * inv); *(u32x2*)(dst + g * 8) = w;
            w.x = pack2(o1[4 * g] * inv, o1[4 * g + 1] * inv); w.y = pack2(o1[4 * g + 2] * inv, o1[4 * g + 3] * inv); *(u32x2*)(dst + 32 + g * 8) = w; }
    }
    __syncthreads();
}

__device__ __forceinline__ void ph_gdn(const Frame& F) {
    const Params& P = *F.P;
    const bf16_t* PX = (const bf16_t*)(F.ws + WS_PX);
    LAS bf16_t* rq = (LAS bf16_t*)F.lds;
    LAS bf16_t* rk = rq + 36 * 128;
    LAS bf16_t* rv = rk + 36 * 128;
    LAS float* qc = (LAS float*)(F.lds + 24576);
    LAS float* kc = qc + 4096;
    LAS float* vc = kc + 4096;
    LAS float* os = vc + 1024;
    LAS float* ba = os + 1024;
    const int dg = F.lane & 15, el = F.wave * 4 + (F.lane >> 4);
    for (int it = F.bid; it < 256; it += F.G) {
        const int b = it >> 5, h = (it >> 3) & 3, dir = (it >> 2) & 1, sl = it & 3;
        bf16_t* O = dir ? (bf16_t*)(F.ws + WS_WMOE) : (bf16_t*)(F.ws + WS_GOF);
        const float a_neg = -__expf(P.in[I_ALOG][dir * 4 + h]), dtb = P.in[I_DTB][dir * 4 + h];
        float cwq[5], cwk[5], cwv[5];
        { const int d = F.tid & 127;
#pragma unroll
          for (int j = 0; j < 5; ++j) { cwq[j] = P.in[I_CONVW][j * 1536 + h * 128 + d]; cwk[j] = P.in[I_CONVW][j * 1536 + 512 + h * 128 + d]; cwv[j] = P.in[I_CONVW][j * 1536 + 1024 + h * 128 + sl * 32 + (F.tid & 31)]; } }
        float S[8];
#pragma unroll
        for (int i = 0; i < 8; ++i) S[i] = 0.f;
        u32x4 pr0, pr1, pr2; float pbeta = 0.f, pdec = 0.f;
        auto blk_geom = [&](int bi, int& len, size_t& rbase, int& p0) { const bool c = bi < 8; len = c ? CTXL : SEQ; rbase = c ? (size_t)TL + b * CTXL : (size_t)b * SEQ;
            const int nbk = len / 32, k = c ? bi : bi - 8; p0 = (dir ? (nbk - 1 - k) : k) * 32; };
        auto fetch = [&](int bi, int id) -> u32x4 { int len, p0; size_t rbase; blk_geom(bi, len, rbase, p0);
            u32x4 z = {0u, 0u, 0u, 0u}; if (id >= 1296) return z;
            int arr = 0, j = id; if (j >= 1152) { arr = 2; j -= 1152; } else if (j >= 576) { arr = 1; j -= 576; }
            const int rr = arr == 2 ? (j >> 2) : (j >> 4), part = arr == 2 ? (j & 3) : (j & 15); const int p = p0 - 2 + rr;
            if (p < 0 || p >= len) return z;
            const bf16_t* row = PX + (rbase + p) * ODD_PAD + (arr == 0 ? h * 128 : (arr == 1 ? 512 + h * 128 : 1024 + h * 128 + sl * 32)) + part * 8;
            return *(const u32x4*)row; };
        auto stash = [&](int id, u32x4 w) { if (id >= 1296) return; int arr = 0, j = id; if (j >= 1152) { arr = 2; j -= 1152; } else if (j >= 576) { arr = 1; j -= 576; }
            LAS bf16_t* d = arr == 0 ? rq + j * 8 : (arr == 1 ? rk + j * 8 : rv + j * 8); *(LAS u32x4*)d = w; };
        auto fetch_all = [&](int bi) { pr0 = fetch(bi, F.tid); pr1 = fetch(bi, F.tid + 512); pr2 = fetch(bi, F.tid + 1024);
            if (F.tid < 32) { int len, p0; size_t rbase; blk_geom(bi, len, rbase, p0); const bf16_t* row = PX + (rbase + p0 + F.tid) * ODD_PAD;
                pbeta = bf2f(row[2048 + dir * 4 + h]); pdec = bf2f(row[2056 + dir * 4 + h]); } };
        fetch_all(0);
        for (int bi = 0; bi < 264; ++bi) {
            __syncthreads();
            stash(F.tid, pr0); stash(F.tid + 512, pr1); stash(F.tid + 1024, pr2);
            if (F.tid < 32) { ba[F.tid] = sigmoid_f(pbeta); ba[32 + F.tid] = __expf(a_neg * softplus_f(pdec + dtb)); }
            __syncthreads();
            if (bi + 1 < 264) fetch_all(bi + 1);
            { const int d = F.tid & 127;
#pragma unroll
              for (int i = 0; i < 8; ++i) { const int s = (F.tid >> 7) + i * 4; float a = 0.f, c = 0.f;
#pragma unroll
                for (int j = 0; j < 5; ++j) { a += bf2f(rq[(s + j) * 128 + d]) * cwq[j]; c += bf2f(rk[(s + j) * 128 + d]) * cwk[j]; }
                qc[s * 128 + d] = silu_f(a); kc[s * 128 + d] = silu_f(c); }
#pragma unroll
              for (int i = 0; i < 2; ++i) { const int s = (F.tid >> 5) + i * 16, e = F.tid & 31; float a = 0.f;
#pragma unroll
                for (int j = 0; j < 5; ++j) a += bf2f(rv[(s + j) * 32 + e]) * cwv[j];
                vc[s * 32 + e] = silu_f(a); } }
            __syncthreads();
            { const int s = F.wave * 4 + (F.lane >> 4);
              LAS float* qp = qc + s * 128 + dg * 8; LAS float* kp = kc + s * 128 + dg * 8;
              f32x4 q0 = *(LAS f32x4*)qp, q1 = *(LAS f32x4*)(qp + 4), k0 = *(LAS f32x4*)kp, k1 = *(LAS f32x4*)(kp + 4);
              float sq = 0.f, sk = 0.f;
#pragma unroll
              for (int i = 0; i < 4; ++i) { sq += q0[i] * q0[i] + q1[i] * q1[i]; sk += k0[i] * k0[i] + k1[i] * k1[i]; }
              sq = sum16(sq); sk = sum16(sk);
              const float rq_ = rsqrtf(sq + EPS) * 0.08838834764831845f, rk_ = rsqrtf(sk + EPS);
              *(LAS f32x4*)qp = q0 * rq_; *(LAS f32x4*)(qp + 4) = q1 * rq_; *(LAS f32x4*)kp = k0 * rk_; *(LAS f32x4*)(kp + 4) = k1 * rk_; }
            __syncthreads();
#pragma unroll 2
            for (int ss = 0; ss < 32; ++ss) {
                const int st = dir ? 31 - ss : ss;
                const f32x4 ka = *(const LAS f32x4*)(kc + st * 128 + dg * 8), kb = *(const LAS f32x4*)(kc + st * 128 + dg * 8 + 4);
                const f32x4 qa = *(const LAS f32x4*)(qc + st * 128 + dg * 8), qb = *(const LAS f32x4*)(qc + st * 128 + dg * 8 + 4);
                const float v = vc[st * 32 + el], beta = ba[st], a = ba[32 + st];
                float r0 = 0.f, r1 = 0.f;
#pragma unroll
                for (int i = 0; i < 4; ++i) { r0 += ka[i] * S[i]; r1 += kb[i] * S[4 + i]; }
                const float r = sum16(r0 + r1);
                const float u = beta * (v - a * r);
                float p0 = 0.f, p1 = 0.f;
#pragma unroll
                for (int i = 0; i < 4; ++i) { S[i] = a * S[i] + ka[i] * u; p0 += qa[i] * S[i]; S[4 + i] = a * S[4 + i] + kb[i] * u; p1 += qb[i] * S[4 + i]; }
                const float o = sum16(p0 + p1);
                if (dg == 0) os[st * 32 + el] = o;
            }
            __syncthreads();
            { int len, p0; size_t rbase; blk_geom(bi, len, rbase, p0);
              const int s = F.tid >> 4, e2 = (F.tid & 15) * 2;
              *(unsigned*)(O + (rbase + p0 + s) * 512 + h * 128 + sl * 32 + e2) = pack2(os[s * 32 + e2], os[s * 32 + e2 + 1]); }
        }
        __syncthreads();
    }
}

constexpr int GR_KN = 0, GR_QN = 16384, GR_VT = 32768, GR_T = 49152, GR_QK = 65536, GR_SC = 81920, GR_BYTES = 83968;
__device__ __forceinline__ s16x8 pack8(const f32x16& x, int s8) {
    u32x4 p; p.x = pack2(x[s8 + 0], x[s8 + 1]); p.y = pack2(x[s8 + 2], x[s8 + 3]); p.z = pack2(x[s8 + 4], x[s8 + 5]); p.w = pack2(x[s8 + 6], x[s8 + 7]);
    return __builtin_bit_cast(s16x8, p);
}
__device__ __forceinline__ s16x8 ld2x64(const LAS unsigned char* p) {
    const u32x2 a = *(const LAS u32x2*)p, b = *(const LAS u32x2*)(p + 16); u32x4 v; v.x = a.x; v.y = a.y; v.z = b.x; v.w = b.y; return __builtin_bit_cast(s16x8, v);
}
__device__ __forceinline__ void st2x64(LAS unsigned char* p, u32x4 v) { u32x2 a, b; a.x = v.x; a.y = v.y; b.x = v.z; b.y = v.w; *(LAS u32x2*)p = a; *(LAS u32x2*)(p + 8) = b; }
__device__ __forceinline__ u32x4 ld2x64n(const LAS unsigned char* p) { const u32x2 a = *(const LAS u32x2*)p, b = *(const LAS u32x2*)(p + 8); u32x4 v; v.x = a.x; v.y = a.y; v.z = b.x; v.w = b.y; return v; }
__device__ __forceinline__ void gdn_unit_geom(int b, int ck, size_t& rbase, int& len, int& p0) {
    if (ck < 4) { rbase = (size_t)TL + b * CTXL; len = CTXL; p0 = ck * 64; } else { rbase = (size_t)b * SEQ; len = SEQ; p0 = (ck - 4) * 64; }
}
__device__ __forceinline__ void ph_gdn_prep(const Frame& F) {
    const Params& P = *F.P;
    const bf16_t* PX = (const bf16_t*)(F.ws + WS_PX);
    LAS unsigned char* L = F.lds;
    LAS bf16_t* RAW = (LAS bf16_t*)L;
    LAS unsigned char* KNI = L; LAS unsigned char* QNI = L + 16896;
    LAS float* qf = (LAS float*)(L + 52224);
    LAS float* kf = qf + 8192;
    LAS unsigned char* VTI = L + 52224 + 65536;
    LAS float* SCL = (LAS float*)(L + 52224 + 65536 + 17408);
    const int l31 = F.lane & 31, hh = F.lane >> 5;
    for (int u = F.bid; u < 4224; u += F.G) {
        const int b = u / 528, h = (u % 528) / 132, ck = u % 132;
        size_t rbase; int len, p0; gdn_unit_geom(b, ck, rbase, len, p0);
        unsigned char* rec = F.ws + WS_GREC + (size_t)u * GR_BYTES;
        for (int c = F.tid; c < 68 * 48; c += NTH) { const int rr = c / 48, part = c % 48; const int p = p0 - 2 + rr; u32x4 w = {0u, 0u, 0u, 0u};
            if (p >= 0 && p < len) w = *(const u32x4*)(PX + (rbase + p) * ODD_PAD + (part >> 4) * 512 + h * 128 + (part & 15) * 8);
            *(LAS u32x4*)(RAW + rr * 384 + part * 8) = w; }
        if (F.tid < 64) { const bf16_t* row = PX + (rbase + p0 + F.tid) * ODD_PAD;
            const float an_f = -__expf(P.in[I_ALOG][h]), an_b = -__expf(P.in[I_ALOG][4 + h]);
            SCL[256 + F.tid] = sigmoid_f(bf2f(row[2048 + h])); SCL[320 + F.tid] = sigmoid_f(bf2f(row[2052 + h]));
            SCL[F.tid] = an_f * softplus_f(bf2f(row[2056 + h]) + P.in[I_DTB][h]); SCL[64 + F.tid] = an_b * softplus_f(bf2f(row[2060 + h]) + P.in[I_DTB][4 + h]); }
        __syncthreads();
        { const int d = F.tid & 127, rg = F.tid >> 7;
          float cq[5], ckk[5], cv[5];
#pragma unroll
          for (int j = 0; j < 5; ++j) { cq[j] = P.in[I_CONVW][j * 1536 + h * 128 + d]; ckk[j] = P.in[I_CONVW][j * 1536 + 512 + h * 128 + d]; cv[j] = P.in[I_CONVW][j * 1536 + 1024 + h * 128 + d]; }
#pragma unroll 4
          for (int ii = 0; ii < 16; ++ii) { const int i = rg * 16 + ii; float a = 0.f, c = 0.f, e = 0.f;
#pragma unroll
              for (int j = 0; j < 5; ++j) { const LAS bf16_t* rr = RAW + (i + j) * 384 + d; a += bf2f(rr[0]) * cq[j]; c += bf2f(rr[128]) * ckk[j]; e += bf2f(rr[256]) * cv[j]; }
              qf[i * 128 + d] = silu_f(a); kf[i * 128 + d] = silu_f(c);
              *(LAS bf16_t*)(VTI + d * 136 + i * 2) = f2bf(silu_f(e)); } }
        if (F.tid < 64) { float gf = 0.f, gb = 0.f;
            for (int j = 0; j < 64; ++j) { gf += (j <= F.tid) ? SCL[j] : 0.f; gb += (j >= F.tid) ? SCL[64 + j] : 0.f; }
            SCL[128 + F.tid] = gf; SCL[192 + F.tid] = gb; }
        __syncthreads();
#pragma unroll
        for (int rr = 0; rr < 8; ++rr) { const int i = F.wave * 8 + rr;
            const float q0 = qf[i * 128 + F.lane], q1 = qf[i * 128 + 64 + F.lane], k0 = kf[i * 128 + F.lane], k1 = kf[i * 128 + 64 + F.lane];
            const float sq = wave_sum(q0 * q0 + q1 * q1), sk = wave_sum(k0 * k0 + k1 * k1);
            const float rq_ = rsqrtf(sq + EPS) * 0.08838834764831845f, rk_ = rsqrtf(sk + EPS);
            *(LAS bf16_t*)(QNI + i * 264 + F.lane * 2) = f2bf(q0 * rq_); *(LAS bf16_t*)(QNI + i * 264 + 128 + F.lane * 2) = f2bf(q1 * rq_);
            *(LAS bf16_t*)(KNI + i * 264 + F.lane * 2) = f2bf(k0 * rk_); *(LAS bf16_t*)(KNI + i * 264 + 128 + F.lane * 2) = f2bf(k1 * rk_); }
        __syncthreads();
        { const int mq = F.wave >> 2, ib = (F.wave >> 1) & 1, jb = F.wave & 1;
          const LAS unsigned char* Ai = (mq ? QNI : KNI) + (32 * ib + l31) * 264 + hh * 16; const LAS unsigned char* Bi = KNI + (32 * jb + l31) * 264 + hh * 16;
          f32x16 acc;
#pragma unroll
          for (int r = 0; r < 16; ++r) acc[r] = 0.f;
#pragma unroll
          for (int ds = 0; ds < 8; ++ds) acc = __builtin_amdgcn_mfma_f32_32x32x16_bf16(__builtin_bit_cast(s16x8, ld2x64n(Ai + ds * 32)), __builtin_bit_cast(s16x8, ld2x64n(Bi + ds * 32)), acc, 0, 0, 0);
          __syncthreads();
          const int j = 32 * jb + l31; const float gfj = SCL[128 + j], gbj = SCL[192 + j];
          bf16_t* qkf = (bf16_t*)(rec + GR_QK); bf16_t* qkb = qkf + 4096;
#pragma unroll
          for (int r = 0; r < 16; ++r) { const int i = 32 * ib + (r & 3) + 8 * (r >> 2) + 4 * hh;
              const float ef = __expf(fminf(SCL[128 + i] - gfj, 0.f)), eb = __expf(fminf(SCL[192 + i] - gbj, 0.f));
              if (mq == 0) { qf[i * 64 + j] = (j < i) ? SCL[256 + i] * acc[r] * ef : 0.f; kf[(63 - i) * 64 + (63 - j)] = (j > i) ? SCL[320 + i] * acc[r] * eb : 0.f; }
              else { qkf[i * 64 + j] = f2bf((j <= i) ? acc[r] * ef : 0.f); qkb[i * 64 + j] = f2bf((j >= i) ? acc[r] * eb : 0.f); } } }
        __syncthreads();
        if (F.wave < 2) {
            const LAS float* Am = F.wave == 0 ? qf : kf; LAS float* Tl = (F.wave == 0 ? qf : kf) + 4096; const int c = F.lane;
            for (int i = 0; i < 64; ++i) Tl[i * 64 + c] = 0.f;
#pragma unroll
            for (int rb = 0; rb < 4; ++rb) {
#pragma unroll 1
                for (int ii = 0; ii < 16; ++ii) { const int i = rb * 16 + ii; float a0 = (c == i) ? 1.f : 0.f, a1 = 0.f;
#pragma unroll
                    for (int jg = 0; jg < 4 * (rb + 1); ++jg) { const f32x4 m = *(const LAS f32x4*)(Am + i * 64 + jg * 4);
                        a0 -= m[0] * Tl[(jg * 4 + 0) * 64 + c]; a1 -= m[1] * Tl[(jg * 4 + 1) * 64 + c]; a0 -= m[2] * Tl[(jg * 4 + 2) * 64 + c]; a1 -= m[3] * Tl[(jg * 4 + 3) * 64 + c]; }
                    Tl[i * 64 + c] = a0 + a1; } }
            bf16_t* Tg = (bf16_t*)(rec + GR_T) + (F.wave ? 4096 : 0);
            for (int i = 0; i < 64; ++i) { const bf16_t v = f2bf(Tl[i * 64 + c]); if (F.wave == 0) Tg[i * 64 + c] = v; else Tg[(63 - i) * 64 + (63 - c)] = v; }
        } else {
            const int t6 = F.tid - 128;
            for (int c = t6; c < 3072; c += 384) {
                u32x4 w; if (c < 2048) { const int cc = c & 1023, row = cc >> 4, part = cc & 15; w = ld2x64n((c < 1024 ? KNI : QNI) + row * 264 + part * 16); }
                else { const int cc = c - 2048, row = cc >> 3, part = cc & 7; w = ld2x64n(VTI + row * 136 + part * 16); }
                *(u32x4*)(rec + (size_t)c * 16) = w; }
            if (t6 < 64) { float* sc = (float*)(rec + GR_SC); const int i = t6;
                const float gf = SCL[128 + i], gb = SCL[192 + i], glf = SCL[128 + 63], glb = SCL[192 + 0];
                sc[i] = SCL[256 + i]; sc[64 + i] = __expf(gf); sc[128 + i] = __expf(glf - gf);
                sc[192 + i] = SCL[320 + i]; sc[256 + i] = __expf(gb); sc[320 + i] = __expf(glb - gb);
                if (i == 0) { sc[384] = __expf(glf); sc[385] = __expf(glb); } }
        }
        __syncthreads();
    }
}

__device__ __forceinline__ void ph_gdn_scan(const Frame& F) {
    LAS unsigned char* L = F.lds;
    LAS unsigned char* KNI = L;
    LAS unsigned char* QNI = L + 16896;
    LAS unsigned char* VTI = L + 33792;
    LAS unsigned char* KTI = L + 51200;
    LAS unsigned char* TI = L + 68608;
    LAS unsigned char* QKI = L + 77312;
    LAS float* SC = (LAS float*)(L + 86016);
    const int l31 = F.lane & 31, hh = F.lane >> 5, w = F.wave;
    for (int it = F.bid; it < 64; it += F.G) {
        const int b = it >> 3, h = (it >> 1) & 3, dir = it & 1;
        bf16_t* O = dir ? (bf16_t*)(F.ws + WS_WMOE) : (bf16_t*)(F.ws + WS_GOF);
        f32x16 S0, S1, S2, S3;
#pragma unroll
        for (int r = 0; r < 16; ++r) { S0[r] = 0.f; S1[r] = 0.f; S2[r] = 0.f; S3[r] = 0.f; }
        u32x4 pre[16]; float psc = 0.f;
        const int t4 = F.tid - 256;
        auto ckof = [&](int n) -> int { return dir ? (n < 4 ? 3 - n : 135 - n) : n; };
        auto fetch = [&](int n) { const unsigned char* rec = F.ws + WS_GREC + (size_t)((b * 4 + h) * 132 + ckof(n)) * GR_BYTES;
#pragma unroll
            for (int k = 0; k < 12; ++k) pre[k] = *(const u32x4*)(rec + (size_t)(t4 + 256 * k) * 16);
#pragma unroll
            for (int k = 0; k < 2; ++k) { pre[12 + k] = *(const u32x4*)(rec + GR_T + dir * 8192 + (t4 + 256 * k) * 16); pre[14 + k] = *(const u32x4*)(rec + GR_QK + dir * 8192 + (t4 + 256 * k) * 16); }
            if (t4 < 193) psc = ((const float*)(rec + GR_SC))[t4 < 192 ? dir * 192 + t4 : 384 + dir]; };
        if (w >= 4) {
            fetch(0);
            for (int n = 0; n < 132; ++n) {
                __syncthreads();
#pragma unroll
                for (int k = 0; k < 4; ++k) { const int c = t4 + 256 * k, row = c >> 4, part = c & 15; st2x64(KNI + row * 264 + part * 16, pre[k]);
                    LAS unsigned short* kt = (LAS unsigned short*)(KTI + (part * 8) * 136 + row * 2); const u32x4 v = pre[k];
                    kt[0 * 68] = (unsigned short)(v.x & 0xffffu); kt[1 * 68] = (unsigned short)(v.x >> 16); kt[2 * 68] = (unsigned short)(v.y & 0xffffu); kt[3 * 68] = (unsigned short)(v.y >> 16);
                    kt[4 * 68] = (unsigned short)(v.z & 0xffffu); kt[5 * 68] = (unsigned short)(v.z >> 16); kt[6 * 68] = (unsigned short)(v.w & 0xffffu); kt[7 * 68] = (unsigned short)(v.w >> 16); }
#pragma unroll
                for (int k = 4; k < 8; ++k) { const int c = t4 + 256 * (k - 4), row = c >> 4, part = c & 15; st2x64(QNI + row * 264 + part * 16, pre[k]); }
#pragma unroll
                for (int k = 8; k < 12; ++k) { const int c = t4 + 256 * (k - 8), row = c >> 3, part = c & 7; st2x64(VTI + row * 136 + part * 16, pre[k]); }
#pragma unroll
                for (int k = 0; k < 2; ++k) { const int c = t4 + 256 * k, row = c >> 3, part = c & 7; st2x64(TI + row * 136 + part * 16, pre[12 + k]); st2x64(QKI + row * 136 + part * 16, pre[14 + k]); }
                if (t4 < 193) SC[t4] = psc;
                __syncthreads();
                if (n + 1 < 132) fetch(n + 1);
            }
        } else
        for (int n = 0; n < 132; ++n) {
            __syncthreads();
            __syncthreads();
            {
                size_t rbase; int len, p0; gdn_unit_geom(b, ckof(n), rbase, len, p0);
                const float alast = SC[192];
                f32x16 P0, P1;
#pragma unroll
                for (int r = 0; r < 16; ++r) { P0[r] = 0.f; P1[r] = 0.f; }
#pragma unroll
                for (int hq = 0; hq < 2; ++hq) { s16x8 fa[4], fb[4];
#pragma unroll
                  for (int q4 = 0; q4 < 4; ++q4) { const int q = hq * 4 + q4; const int co = (32 * (q >> 1) + 16 * (q & 1) + 4 * hh) * 2; fa[q4] = ld2x64(KNI + l31 * 264 + co); fb[q4] = ld2x64(KNI + (32 + l31) * 264 + co); }
#pragma unroll
                  for (int q4 = 0; q4 < 4; ++q4) { const int q = hq * 4 + q4; const int r = q >> 1; const s16x8 sb = pack8(r == 0 ? S0 : (r == 1 ? S1 : (r == 2 ? S2 : S3)), 8 * (q & 1));
                      P0 = __builtin_amdgcn_mfma_f32_32x32x16_bf16(fa[q4], sb, P0, 0, 0, 0); P1 = __builtin_amdgcn_mfma_f32_32x32x16_bf16(fb[q4], sb, P1, 0, 0, 0); } }
#pragma unroll
                for (int gq = 0; gq < 4; ++gq) {
#pragma unroll
                    for (int ib = 0; ib < 2; ++ib) { const int i0 = 32 * ib + 8 * gq + 4 * hh;
                        const f32x4 be = *(const LAS f32x4*)(SC + i0), eg = *(const LAS f32x4*)(SC + 64 + i0);
                        const u32x2 vv = *(const LAS u32x2*)(VTI + (32 * w + l31) * 136 + i0 * 2);
                        const float v0 = lo2f(vv.x), v1 = hi2f(vv.x), v2 = lo2f(vv.y), v3 = hi2f(vv.y);
                        if (ib == 0) { P0[4 * gq + 0] = be[0] * (v0 - eg[0] * P0[4 * gq + 0]); P0[4 * gq + 1] = be[1] * (v1 - eg[1] * P0[4 * gq + 1]); P0[4 * gq + 2] = be[2] * (v2 - eg[2] * P0[4 * gq + 2]); P0[4 * gq + 3] = be[3] * (v3 - eg[3] * P0[4 * gq + 3]); }
                        else         { P1[4 * gq + 0] = be[0] * (v0 - eg[0] * P1[4 * gq + 0]); P1[4 * gq + 1] = be[1] * (v1 - eg[1] * P1[4 * gq + 1]); P1[4 * gq + 2] = be[2] * (v2 - eg[2] * P1[4 * gq + 2]); P1[4 * gq + 3] = be[3] * (v3 - eg[3] * P1[4 * gq + 3]); } } }
                f32x16 V0, V1;
#pragma unroll
                for (int r = 0; r < 16; ++r) { V0[r] = 0.f; V1[r] = 0.f; }
#pragma unroll
                for (int jb = 0; jb < 2; ++jb)
#pragma unroll
                    for (int s = 0; s < 2; ++s) { const s16x8 pb = pack8(jb == 0 ? P0 : P1, 8 * s); const int co = (32 * jb + 16 * s + 4 * hh) * 2;
                        V0 = __builtin_amdgcn_mfma_f32_32x32x16_bf16(ld2x64(TI + l31 * 136 + co), pb, V0, 0, 0, 0);
                        V1 = __builtin_amdgcn_mfma_f32_32x32x16_bf16(ld2x64(TI + (32 + l31) * 136 + co), pb, V1, 0, 0, 0); }
                f32x16 T0, T1;
#pragma unroll
                for (int r = 0; r < 16; ++r) { T0[r] = 0.f; T1[r] = 0.f; }
#pragma unroll
                for (int r = 0; r < 4; ++r)
#pragma unroll
                    for (int s = 0; s < 2; ++s) { const s16x8 sa = pack8(r == 0 ? S0 : (r == 1 ? S1 : (r == 2 ? S2 : S3)), 8 * s);
                        const int co = (32 * r + 16 * s + 4 * hh) * 2;
                        T0 = __builtin_amdgcn_mfma_f32_32x32x16_bf16(sa, ld2x64(QNI + l31 * 264 + co), T0, 0, 0, 0);
                        T1 = __builtin_amdgcn_mfma_f32_32x32x16_bf16(sa, ld2x64(QNI + (32 + l31) * 264 + co), T1, 0, 0, 0); }
                { const float e0 = SC[64 + l31], e1 = SC[64 + 32 + l31];
#pragma unroll
                  for (int r = 0; r < 16; ++r) { T0[r] *= e0; T1[r] *= e1; } }
#pragma unroll
                for (int jb = 0; jb < 2; ++jb)
#pragma unroll
                    for (int s = 0; s < 2; ++s) { const s16x8 va = pack8(jb == 0 ? V0 : V1, 8 * s); const int co = (32 * jb + 16 * s + 4 * hh) * 2;
                        T0 = __builtin_amdgcn_mfma_f32_32x32x16_bf16(va, ld2x64(QKI + l31 * 136 + co), T0, 0, 0, 0);
                        T1 = __builtin_amdgcn_mfma_f32_32x32x16_bf16(va, ld2x64(QKI + (32 + l31) * 136 + co), T1, 0, 0, 0); }
                { bf16_t* o0 = O + (rbase + p0 + l31) * 512 + h * 128 + 32 * w + 4 * hh; bf16_t* o1 = o0 + (size_t)32 * 512;
#pragma unroll
                  for (int gq = 0; gq < 4; ++gq) { u32x2 x; x.x = pack2(T0[4 * gq], T0[4 * gq + 1]); x.y = pack2(T0[4 * gq + 2], T0[4 * gq + 3]); *(u32x2*)(o0 + gq * 8) = x;
                      x.x = pack2(T1[4 * gq], T1[4 * gq + 1]); x.y = pack2(T1[4 * gq + 2], T1[4 * gq + 3]); *(u32x2*)(o1 + gq * 8) = x; } }
#pragma unroll
                for (int gq = 0; gq < 4; ++gq) { const f32x4 c0 = *(const LAS f32x4*)(SC + 128 + 8 * gq + 4 * hh), c1 = *(const LAS f32x4*)(SC + 128 + 32 + 8 * gq + 4 * hh);
#pragma unroll
                    for (int q = 0; q < 4; ++q) { V0[4 * gq + q] *= c0[q]; V1[4 * gq + q] *= c1[q]; } }
#pragma unroll
                for (int r = 0; r < 16; ++r) { S0[r] *= alast; S1[r] *= alast; S2[r] *= alast; S3[r] *= alast; }
#pragma unroll
                for (int hq = 0; hq < 2; ++hq) { s16x8 fk[8];
#pragma unroll
                  for (int q2 = 0; q2 < 2; ++q2) { const int q = hq * 2 + q2; const int co = (32 * (q >> 1) + 16 * (q & 1) + 4 * hh) * 2;
#pragma unroll
                      for (int r = 0; r < 4; ++r) fk[q2 * 4 + r] = ld2x64(KTI + (32 * r + l31) * 136 + co); }
#pragma unroll
                  for (int q2 = 0; q2 < 2; ++q2) { const int q = hq * 2 + q2; const s16x8 vb = pack8((q >> 1) == 0 ? V0 : V1, 8 * (q & 1));
                      S0 = __builtin_amdgcn_mfma_f32_32x32x16_bf16(fk[q2 * 4 + 0], vb, S0, 0, 0, 0); S1 = __builtin_amdgcn_mfma_f32_32x32x16_bf16(fk[q2 * 4 + 1], vb, S1, 0, 0, 0);
                      S2 = __builtin_amdgcn_mfma_f32_32x32x16_bf16(fk[q2 * 4 + 2], vb, S2, 0, 0, 0); S3 = __builtin_amdgcn_mfma_f32_32x32x16_bf16(fk[q2 * 4 + 3], vb, S3, 0, 0, 0); } }
            }
        }
        __syncthreads();
    }
}

#ifndef FAST_ATTN
#define FAST_ATTN 1
#endif
constexpr int NPHASES = 27;
__global__ void __launch_bounds__(NTH, 2) fwd(Params P) {
    extern __shared__ __attribute__((aligned(16))) unsigned char lds_raw[];
    Frame F; F.P = &P; F.ws = P.ws; F.lds = (LAS unsigned char*)lds_raw;
    F.tid = threadIdx.x; F.lane = F.tid & 63; F.wave = __builtin_amdgcn_readfirstlane(F.tid >> 6); F.G = gridDim.x; F.bid = blockIdx.x;
    F.mod = (float*)(P.ws + WS_CTRL + C_MOD); F.ctrl = (unsigned*)(P.ws + WS_CTRL);
    volatile LAS unsigned* xbw = (volatile LAS unsigned*)(F.lds + LDS_BYTES - 16);
    if (F.tid < 4) xbw[F.tid] = 0u;
    __syncthreads();
    const int lo = P.ph_lo, hi = P.ph_hi;
    const bool single = (hi - lo) > 1;
    XcdBarrier bar; bar.bar = F.ctrl; bar.x = 0; bar.st = xbw;
    if (single) bar = xcd_barrier_post(F.ctrl, xbw);
#ifndef PH_MASK
#define PH_MASK 0xffffffffu
#endif
#define IN(k) (((PH_MASK >> (k)) & 1u) && lo <= (k) && (k) < hi)
#define SEAM(k) do { if (IN(k) && IN((k) + 1)) xcd_barrier(bar); } while (0)
#ifndef DUP_MASK
#define DUP_MASK 0u
#endif
#define DUP(k) ((DUP_MASK >> (k)) & 1u)
    bf16_t* wsm = (bf16_t*)(P.ws + WS_WSM);
    bf16_t* ACT = (bf16_t*)(P.ws + WS_ACT); bf16_t* PX = (bf16_t*)(P.ws + WS_PX);
    float* XC = (float*)(P.ws + WS_XC);

    if (IN(0)) { ph_prologue(F); if (DUP(0)) { __syncthreads(); conv_moe_weights(F, 0, F.bid, F.G); } xcd_barrier(bar); mod_reduce(F); } SEAM(0);
    if (IN(1)) { ph_rownorm(F, 0, TT, P.in[I_X], P.in[I_CTX], P.in[I_NMIX], 0); if (DUP(1)) ph_rownorm(F, 0, TT, P.in[I_X], P.in[I_CTX], P.in[I_NMIX], 0); } SEAM(1);
    if (IN(2)) { EpiStoreBf16 E{PX, EVEN_IN, 1024}; gemm_dense(F, ACT, wsm + W_EIN / 2, TT, EVEN_IN, 1024, E); if (DUP(2)) gemm_dense(F, ACT, wsm + W_EIN / 2, TT, EVEN_IN, 1024, E); } SEAM(2);
    if (IN(3)) { ph_gmlp_mfma(F); __syncthreads(); }
    if (IN(4)) { ph_gla(F); if (DUP(4)) { __syncthreads(); ph_gla(F); } } SEAM(4);
    if (IN(5)) { ph_merge(F, 0); if (DUP(5)) ph_merge(F, 0); } SEAM(5);
    if (IN(6)) { EpiResidual E{P.in[I_X], P.in[I_CTX], P.out, XC, F.mod, 2}; gemm_dense(F, ACT, wsm + W_EOUT / 2, TT, 1024, 1024, E); } SEAM(6);
    if (IN(7)) { ph_router(F, 0, TT, P.out, XC, P.in[I_NFFN], 3); } SEAM(7);
    if (IN(8)) { ph_dispatch(F, 0, TT); } SEAM(8);
    if (IN(9)) { ph_moe_gemm1(F, 0); if (DUP(9)) ph_moe_gemm1(F, 0); } SEAM(9);
    if (IN(10)) { ph_moe_gemm2(F, 0, 0); } SEAM(10);
    if (IN(11)) { ph_moe_gemm2(F, 0, 1); } SEAM(11);
    if (IN(12)) { ph_rownorm(F, 1, TT, P.out, XC, P.in[I_NMIX] + 1024, 0);
#ifdef DBG_ZERO
        { u32x4 z = {0u, 0u, 0u, 0u}; u32x4* p = (u32x4*)(P.ws + WS_GREC); const size_t n = (size_t)(990 - 585) * MiB / 16;
          for (size_t i = (size_t)F.bid * NTH + F.tid; i < n; i += (size_t)F.G * NTH) p[i] = z;
          u32x4* q = (u32x4*)(P.ws + WS_WMOE); const size_t m = (size_t)66 * MiB / 16;
          for (size_t i = (size_t)F.bid * NTH + F.tid; i < m; i += (size_t)F.G * NTH) q[i] = z; }
#endif
    } SEAM(12);
    if (IN(13)) { EpiStoreBf16 E{PX, ODD_PAD, 0}; gemm_dense(F, ACT, wsm + W_OIN / 2, TT, ODD_PAD, 1024, E); if (DUP(13)) gemm_dense(F, ACT, wsm + W_OIN / 2, TT, ODD_PAD, 1024, E); } SEAM(13);
#ifndef CHUNKED_GDN
#define CHUNKED_GDN 1
#endif
    if (IN(14)) { if (CHUNKED_GDN) ph_gdn_prep(F); } SEAM(14);
    if (IN(15)) { if (CHUNKED_GDN) ph_gdn_scan(F); else ph_gdn(F); } SEAM(15);
    if (IN(16)) { ph_merge(F, 1); ph_mla_norm(F); } SEAM(16);
    if (IN(17)) { }
    if (IN(18)) { const bf16_t* cqn = (const bf16_t*)(P.ws + WS_R2 + R2_CQN);
                  EpiStoreBf16 E1{(bf16_t*)(P.ws + WS_WMOE), 768, 0}; gemm_dense(F, cqn, wsm + W_WQ / 2, TL, 768, 256, E1);
                  EpiStoreBf16 E2{(bf16_t*)(P.ws + WS_PX + PX_KVRAW), 1024, 0}; gemm_dense(F, cqn + (size_t)TL * 256, wsm + W_WKV / 2, TT, 1024, 256, E2); } SEAM(18);
    if (IN(19)) { ph_mla_final(F); } SEAM(19);
    if (IN(20)) { if (FAST_ATTN) ph_attn(F); else ph_attn_naive(F); if (DUP(20)) { __syncthreads(); ph_attn(F); } } SEAM(20);
    if (IN(21)) { EpiResidual E{P.out, P.out, P.out, P.out, F.mod + 9 * 6144, 2}; gemm_dense(F, ACT, wsm + W_OOUT / 2, TL, 1024, 1024, E); } SEAM(21);
    if (IN(22)) { ph_router(F, 1, TL, P.out, XC, P.in[I_NFFN] + 1024, 3); conv_moe_weights(F, 1, F.bid, F.G); } SEAM(22);
    if (IN(23)) { ph_dispatch(F, 1, TL); } SEAM(23);
    if (IN(24)) { ph_moe_gemm1(F, 1); if (DUP(24)) ph_moe_gemm1(F, 1); } SEAM(24);
    if (IN(25)) { ph_moe_gemm2(F, 1, 0); } SEAM(25);
    if (IN(26)) { ph_moe_gemm2(F, 1, 1); }
#undef IN
#undef SEAM
}

#ifndef N_LAUNCH_MODE
#define N_LAUNCH_MODE 1
#endif
extern "C" void kernel_launch(void* const* d_in, const int* in_sizes, int n_in, void* d_out, int out_size, void* d_ws, size_t ws_size, hipStream_t stream) {
    static int grid = 0;
    if (grid == 0) {
        if (n_in != 34 || out_size != TL * DM || ws_size < WS_END) { fprintf(stderr, "kernel_launch: unexpected shapes (n_in %d out %d ws %zu)\n", n_in, out_size, ws_size); grid = -1; return; }
        int dev = 0, cus = 0;
        if (hipGetDevice(&dev) != hipSuccess || hipDeviceGetAttribute(&cus, hipDeviceAttributeMultiprocessorCount, dev) != hipSuccess) { grid = -1; return; }
        if (hipFuncSetAttribute((const void*)fwd, hipFuncAttributeMaxDynamicSharedMemorySize, LDS_BYTES) != hipSuccess) { fprintf(stderr, "kernel_launch: hipFuncSetAttribute failed\n"); grid = -1; return; }
        int per_cu = 0;
        (void)hipOccupancyMaxActiveBlocksPerMultiprocessor(&per_cu, (const void*)fwd, NTH, LDS_BYTES);
        (void)hipGetLastError();
        if (per_cu < 1) fprintf(stderr, "kernel_launch: occupancy query says %d\n", per_cu);
        grid = cus;
    }
    if (grid < 0) return;
    (void)hipMemsetAsync(d_ws, 0, MiB, stream);
    Params p{};
    for (int i = 0; i < 34; ++i) p.in[i] = (const float*)d_in[i];
    p.out = (float*)d_out; p.ws = (unsigned char*)d_ws;
#if N_LAUNCH_MODE == 1
    p.ph_lo = 0; p.ph_hi = NPHASES;
    hipLaunchKernelGGL(fwd, dim3(grid), dim3(NTH), LDS_BYTES, stream, p);
#else
    for (int k = 0; k < NPHASES; ++k) { p.ph_lo = k; p.ph_hi = k + 1; hipLaunchKernelGGL(fwd, dim3(grid), dim3(NTH), LDS_BYTES, stream, p); }
#endif
}
```

```cpp
#include <hip/hip_runtime.h>
#include <cstdint>
#include <cstdio>

#define LAS __attribute__((address_space(3)))
typedef unsigned short bf16_t;
typedef float f32x4 __attribute__((ext_vector_type(4)));
typedef unsigned u32x4 __attribute__((ext_vector_type(4)));
typedef unsigned u32x2 __attribute__((ext_vector_type(2)));
typedef float f32x16 __attribute__((ext_vector_type(16)));
typedef short s16x8 __attribute__((ext_vector_type(8)));

constexpr int NB = 8, SEQ = 8192, CTXL = 256, DM = 1024;
constexpr int TL = NB * SEQ, TC = NB * CTXL, TT = TL + TC;
constexpr int EVEN_IN = 3584, ODD_IN = 2480, ODD_PAD = 2560;
constexpr int NTH = 512;
constexpr int LDS_BYTES = 144 * 1024;
constexpr int MAXSLOTS = 151552;
constexpr int MAXTILES = 592;
constexpr float EPS = 1e-6f;

constexpr size_t MiB = 1048576;
constexpr size_t WS_CTRL = 0;
constexpr size_t C_MOE = 16384;
constexpr size_t C_MOD = 65536;
constexpr size_t WS_XC = 1 * MiB;
constexpr size_t WS_WSM = 9 * MiB;
constexpr size_t W_EIN = 0, W_EOUT = 7340032, W_OIN = 9437184, W_OOUT = 14680064, W_WQ = 16777216, W_WKV = 17170432, W_RT = 17694720;
constexpr size_t WS_WMOE = 27 * MiB;
constexpr size_t WS_ACT = 123 * MiB;
constexpr size_t WS_PX = 255 * MiB;
constexpr size_t WS_R2 = 717 * MiB;
constexpr size_t WS_END = 1024 * MiB;
constexpr size_t R2_OF0 = 0, R2_OB0 = 66 * MiB;
constexpr size_t R2_H = 0, R2_STOK = 148 * MiB, R2_SW = 149 * MiB, R2_TOKE = 150 * MiB, R2_TOKW = 151 * MiB, R2_TILEE = 152 * MiB;
constexpr size_t R2_K = 0, R2_V = 99 * MiB, R2_OF1 = 165 * MiB, R2_OB1 = 231 * MiB;
constexpr size_t PX_KVRAW = 346030080;
constexpr size_t WS_GREC = 585 * MiB;
constexpr size_t WS_GOF = 924 * MiB;
constexpr size_t R2_CQN = 0;
constexpr size_t R2_MODP = 200 * MiB;

struct Params {
    const float* in[34];
    float* out;
    unsigned char* ws;
    int ph_lo, ph_hi;
};
enum { I_X = 0, I_C, I_CTX, I_CCTX, I_ADAW, I_ADAB, I_NMIX, I_NFFN, I_EWIN, I_EWOUT, I_GNW, I_GWS, I_GBS, I_LB, I_HNW,
       I_OWIN, I_OWOUT, I_CONVW, I_ALOG, I_DTB, I_GDNNW, I_QNW, I_WQ, I_KVNW, I_WKV, I_QKQ, I_QKK, I_RGW, I_RGB, I_REW, I_REB, I_MG, I_MU, I_MD };

__device__ __forceinline__ float bf2f(bf16_t b) { return __uint_as_float(((unsigned)b) << 16); }
__device__ __forceinline__ bf16_t f2bf(float f) { unsigned u = __float_as_uint(f); u += 0x7FFFu + ((u >> 16) & 1u); return (bf16_t)(u >> 16); }
typedef __bf16 bf16_2v __attribute__((ext_vector_type(2)));
typedef float f32_2v __attribute__((ext_vector_type(2)));
__device__ __forceinline__ unsigned pack2(float a, float b) { f32_2v v = {a, b}; bf16_2v r = __builtin_convertvector(v, bf16_2v); return __builtin_bit_cast(unsigned, r); }
__device__ __forceinline__ float lo2f(unsigned u) { return __uint_as_float(u << 16); }
__device__ __forceinline__ float hi2f(unsigned u) { return __uint_as_float(u & 0xffff0000u); }
template <int CTRL> __device__ __forceinline__ float dppf(float x) { return __builtin_bit_cast(float, __builtin_amdgcn_mov_dpp(__builtin_bit_cast(int, x), CTRL, 0xf, 0xf, true)); }
__device__ __forceinline__ float sum8(float v) { v += dppf<0xB1>(v); v += dppf<0x4E>(v); v += dppf<0x141>(v); return v; }
__device__ __forceinline__ float sum16(float v) { v = sum8(v); v += dppf<0x128>(v); return v; }
__device__ __forceinline__ float wave_sum(float v) {
    v = sum16(v);
    auto s = __builtin_amdgcn_permlane16_swap(__float_as_uint(v), __float_as_uint(v), false, false);
    v = __uint_as_float(s[0]) + __uint_as_float(s[1]);
    auto t = __builtin_amdgcn_permlane32_swap(__float_as_uint(v), __float_as_uint(v), false, false);
    return __uint_as_float(t[0]) + __uint_as_float(t[1]);
}
__device__ __forceinline__ unsigned lds_inc(LAS unsigned* p) { return __hip_atomic_fetch_add(p, 1u, __ATOMIC_RELAXED, __HIP_MEMORY_SCOPE_WORKGROUP); }
__device__ __forceinline__ float sigmoid_f(float x) { return 1.f / (1.f + __expf(-x)); }
__device__ __forceinline__ float silu_f(float x) { return x / (1.f + __expf(-x)); }
__device__ __forceinline__ float gelu_tanh_f(float x) {
    const float u = 0.7978845608028654f * (x + 0.044715f * x * x * x);
    const float t = 1.f - 2.f / (__expf(2.f * u) + 1.f);
    return 0.5f * x * (1.f + t);
}
__device__ __forceinline__ float softplus_f(float x) { return x > 20.f ? x : log1pf(__expf(x)); }

#define XB_TMO      128
#define XB_XCNT(j)  (256  + 64 * (j))
#define XB_XSUB(j)  (1280 + 64 * (j))
#define XB_XGEN(j)  (2304 + 64 * (j))
#define XB_TOP      3328
#define XB_TOPGEN   3392
#define XCD_BAR_WORDS 3456
#define XB_SPIN_CAP (1u << 24)
__device__ __forceinline__ unsigned xb_ld(unsigned* p)              { return __hip_atomic_load(p, __ATOMIC_RELAXED, __HIP_MEMORY_SCOPE_AGENT); }
__device__ __forceinline__ unsigned xb_add(unsigned* p, unsigned v) { return __hip_atomic_fetch_add(p, v, __ATOMIC_RELAXED, __HIP_MEMORY_SCOPE_AGENT); }
__device__ __forceinline__ unsigned xb_xcc_id() { return (unsigned)__builtin_amdgcn_s_getreg((3 << 11) | 20) & 0xFu; }
#define XB_SPIN(cond, bar) do { unsigned _sp = 0; while (cond) { __builtin_amdgcn_s_sleep(1); \
    if ((++_sp & 255u) == 0u) { if (xb_ld(&(bar)[XB_TMO])) break; if (_sp > XB_SPIN_CAP) { atomicAdd(&(bar)[XB_TMO], 1u); break; } } } } while (0)
struct XcdBarrier { unsigned* bar; unsigned x; volatile LAS unsigned* st; };
__device__ __forceinline__ XcdBarrier xcd_barrier_post(unsigned* bar, volatile LAS unsigned* st) {
    XcdBarrier b; b.bar = bar; b.x = xb_xcc_id(); b.st = st;
    if (threadIdx.x == 0) (void)xb_add(&bar[XB_XCNT(b.x)], 1u);
    return b;
}
__device__ __forceinline__ void xcd_barrier_complete(unsigned* bar, unsigned x, unsigned& nloc, unsigned& nx) {
    const unsigned G = gridDim.x * gridDim.y * gridDim.z;
    unsigned sum, cnt, mine, sp = 0u;
    for (;;) {
        sum = 0u; cnt = 0u; mine = 0u;
#pragma unroll
        for (unsigned j = 0; j < 16; ++j) { const unsigned c = xb_ld(&bar[XB_XCNT(j)]); sum += c; cnt += (c > 0u) ? 1u : 0u; mine = (j == x) ? c : mine; }
        if (sum == G) break;
        __builtin_amdgcn_s_sleep(1);
        if ((++sp & 255u) == 0u) { if (xb_ld(&bar[XB_TMO])) break; if (sp > XB_SPIN_CAP) { atomicAdd(&bar[XB_TMO], 1u); break; } }
    }
    nloc = mine > 0u ? mine : 1u; nx = cnt > 0u ? cnt : 1u;
}
__device__ __forceinline__ void xcd_barrier(const XcdBarrier& b) {
    asm volatile("s_waitcnt vmcnt(0)" ::: "memory");
    __syncthreads();
    if (threadIdx.x == 0) {
        unsigned* bar = b.bar;
        __builtin_amdgcn_s_waitcnt(0);
        unsigned nloc = b.st[0], nx = b.st[1];
        if (nloc == 0u) { xcd_barrier_complete(bar, b.x, nloc, nx); b.st[0] = nloc; b.st[1] = nx; }
        const unsigned old = xb_add(&bar[XB_XSUB(b.x)], 1u);
        const unsigned gen = old / nloc;
        if (old + 1u == (gen + 1u) * nloc) {
            __builtin_amdgcn_fence(__ATOMIC_RELEASE, "agent");
            asm volatile("s_waitcnt vmcnt(0)" ::: "memory");
            const unsigned og = xb_add(&bar[XB_TOP], 1u);
            const unsigned tg = og / nx;
            if (og + 1u == (tg + 1u) * nx) xb_add(&bar[XB_TOPGEN], 1u);
            else XB_SPIN(xb_ld(&bar[XB_TOPGEN]) == tg, bar);
            __builtin_amdgcn_fence(__ATOMIC_ACQUIRE, "agent");
            xb_add(&bar[XB_XGEN(b.x)], 1u);
            asm volatile("s_waitcnt vmcnt(0)" ::: "memory");
        } else {
            XB_SPIN(xb_ld(&bar[XB_XGEN(b.x)]) == gen, bar);
            __builtin_amdgcn_fence(__ATOMIC_ACQUIRE, "agent");
            asm volatile("s_waitcnt vmcnt(0)" ::: "memory");
        }
    }
    __syncthreads();
}

struct Frame {
    const Params* P;
    unsigned char* ws;
    LAS unsigned char* lds;
    int tid, lane, wave, G, bid;
    float* mod;
    unsigned* ctrl;
};
__device__ __forceinline__ int gtid(const Frame& F) { int t = F.tid; asm volatile("" : "+v"(t)); return F.bid * NTH + t; }
__device__ __forceinline__ const float* modp(const Frame& F, int layer, int b, int which) { return F.mod + ((size_t)(layer * 9 + b) * 6 + which) * 1024; }

__device__ __forceinline__ void conv_tile(const Frame& F, const float* src, int K, int N, int lds_, bf16_t* dst, int ldd, int kt, int nt, int rm_mode) {
    LAS float* tile = (LAS float*)F.lds;
    const int t = F.tid;
    {
        const int c = t & 63, r0 = t >> 6;
#pragma unroll
        for (int i = 0; i < 8; ++i) { const int rr = r0 + i * 8, k = kt * 64 + rr, n = nt * 64 + c;
            tile[rr * 65 + c] = (k < K && n < N) ? src[(size_t)k * lds_ + n] : 0.f; }
    }
    __syncthreads();
    {
        const int nl = t >> 3, kc = (t & 7) * 8, n = nt * 64 + nl;
        int row = n;
        if (rm_mode == 1) row = (n >> 7) * 256 + (n & 127);
        else if (rm_mode == 2) row = (n >> 7) * 256 + 128 + (n & 127);
        float v[8];
#pragma unroll
        for (int j = 0; j < 8; ++j) v[j] = tile[(kc + j) * 65 + nl];
        u32x4 w; w.x = pack2(v[0], v[1]); w.y = pack2(v[2], v[3]); w.z = pack2(v[4], v[5]); w.w = pack2(v[6], v[7]);
        *(u32x4*)(dst + (size_t)row * ldd + kt * 64 + kc) = w;
    }
    __syncthreads();
}
__device__ __forceinline__ void conv_moe_weights(const Frame& F, int layer, int item0, int stride) {
    const Params& P = *F.P;
    bf16_t* W1 = (bf16_t*)(F.ws + WS_WMOE); bf16_t* W2 = W1 + (size_t)32 * 1024 * 1024;
    for (int it = item0; it < 12288; it += stride) {
        if (it < 8192) {
            const int up = it >= 4096, j = it & 4095, e = j >> 7, r = j & 127, kt = r >> 3, nt = r & 7;
            const float* src = P.in[up ? I_MU : I_MG] + ((size_t)(layer * 32 + e)) * 1024 * 512;
            conv_tile(F, src, 1024, 512, 512, W1 + (size_t)e * 1024 * 1024, 1024, kt, nt, up ? 2 : 1);
        } else {
            const int j = it - 8192, e = j >> 7, r = j & 127, kt = r >> 4, nt = r & 15;
            const float* src = P.in[I_MD] + ((size_t)(layer * 32 + e)) * 512 * 1024;
            conv_tile(F, src, 512, 1024, 1024, W2 + (size_t)e * 1024 * 512, 512, kt, nt, 0);
        }
    }
}
__device__ __forceinline__ void mod_reduce(const Frame& F) {
    const float* mp = (const float*)(F.ws + WS_R2 + R2_MODP);
    for (int i = gtid(F); i < 18 * 6144; i += F.G * NTH) { float a = F.P->in[I_ADAB][(i / (9 * 6144)) * 6144 + (i % 6144)];
#pragma unroll
        for (int kp = 0; kp < 8; ++kp) a += mp[(size_t)kp * 18 * 6144 + i];
        F.mod[i] = a; }
}
__device__ __forceinline__ void ph_prologue(const Frame& F) {
    const Params& P = *F.P;
    float* modp_ = (float*)(F.ws + WS_R2 + R2_MODP);
    for (int it = F.bid; it < 192; it += F.G) {
        const int l = it / 96, r = it % 96, cb = r >> 3, kp = r & 7;
        LAS float* sc = (LAS float*)F.lds;
        for (int i = F.tid; i < 9 * 128; i += NTH) { const int rr = i >> 7, k = kp * 128 + (i & 127);
            const float cv = rr < 8 ? P.in[I_C][rr * 1024 + k] : P.in[I_CCTX][k]; sc[i] = silu_f(cv); }
        __syncthreads();
        const int n = cb * 512 + F.tid;
        float acc[9];
#pragma unroll
        for (int rr = 0; rr < 9; ++rr) acc[rr] = 0.f;
        const float* w = P.in[I_ADAW] + ((size_t)l * 1024 + kp * 128) * 6144 + n;
#pragma unroll 8
        for (int k = 0; k < 128; ++k) { const float wv = w[(size_t)k * 6144];
#pragma unroll
            for (int rr = 0; rr < 9; ++rr) acc[rr] += sc[rr * 128 + k] * wv; }
#pragma unroll
        for (int rr = 0; rr < 9; ++rr) modp_[((size_t)kp * 18 + l * 9 + rr) * 6144 + n] = acc[rr];
        __syncthreads();
    }
    bf16_t* wsm = (bf16_t*)(F.ws + WS_WSM);
    for (int it = F.bid; it < 2160; it += F.G) {
        int j = it;
        if (j < 896) { conv_tile(F, P.in[I_EWIN], 1024, 3584, 3584, wsm + W_EIN / 2, 1024, j / 56, j % 56, 0); continue; } j -= 896;
        if (j < 256) { conv_tile(F, P.in[I_EWOUT], 1024, 1024, 1024, wsm + W_EOUT / 2, 1024, j >> 4, j & 15, 0); continue; } j -= 256;
        if (j < 640) { conv_tile(F, P.in[I_OWIN], 1024, 2480, 2480, wsm + W_OIN / 2, 1024, j / 40, j % 40, 0); continue; } j -= 640;
        if (j < 256) { conv_tile(F, P.in[I_OWOUT], 1024, 1024, 1024, wsm + W_OOUT / 2, 1024, j >> 4, j & 15, 0); continue; } j -= 256;
        if (j < 48) { conv_tile(F, P.in[I_WQ], 256, 768, 768, wsm + W_WQ / 2, 256, j / 12, j % 12, 0); continue; } j -= 48;
        conv_tile(F, P.in[I_WKV], 128, 1024, 1024, wsm + W_WKV / 2, 256, j >> 4, j & 15, 0);
    }
    for (int i = gtid(F); i < 2 * 48 * 1024; i += F.G * NTH) { const int l = i / (48 * 1024), r = i % (48 * 1024), n = r >> 10, k = r & 1023;
        float w = 0.f; if (n < 4) w = P.in[I_RGW][((size_t)l * 1024 + k) * 4 + n]; else if (n < 36) w = P.in[I_REW][((size_t)l * 1024 + k) * 32 + (n - 4)];
        const bf16_t h = f2bf(w); wsm[W_RT / 2 + (size_t)l * 2 * 48 * 1024 + r] = h; wsm[W_RT / 2 + (size_t)l * 2 * 48 * 1024 + 48 * 1024 + r] = f2bf(w - bf2f(h)); }
    conv_moe_weights(F, 0, F.bid, F.G);
}

__device__ __forceinline__ void ph_rownorm(const Frame& F, int layer, int nrows, const float* xlat, const float* xctx, const float* nw, int si) {
    bf16_t* dst = (bf16_t*)(F.ws + WS_ACT);
    for (int r = F.bid * 8 + F.wave; r < nrows; r += F.G * 8) {
        const float* src = r < TL ? xlat + (size_t)r * 1024 : xctx + (size_t)(r - TL) * 1024;
        const int b = r < TL ? (r >> 13) : 8;
        const float* sh = modp(F, layer, b, si); const float* sc = modp(F, layer, b, si + 1);
        f32x4 v[4]; float ss = 0.f;
#pragma unroll
        for (int j = 0; j < 4; ++j) { v[j] = *(const f32x4*)(src + j * 256 + F.lane * 4); ss += v[j][0] * v[j][0] + v[j][1] * v[j][1] + v[j][2] * v[j][2] + v[j][3] * v[j][3]; }
        ss = wave_sum(ss);
        const float rstd = rsqrtf(ss * (1.f / 1024.f) + EPS);
#pragma unroll
        for (int j = 0; j < 4; ++j) { const int c = j * 256 + F.lane * 4;
            const f32x4 w = *(const f32x4*)(nw + c), s1 = *(const f32x4*)(sc + c), s0 = *(const f32x4*)(sh + c);
            v[j] = (v[j] * rstd * w) * (1.f + s1) + s0;
            u32x2 o; o.x = pack2(v[j][0], v[j][1]); o.y = pack2(v[j][2], v[j][3]);
            *(u32x2*)(dst + (size_t)r * 1024 + c) = o; }
    }
}
typedef short s16x8r __attribute__((ext_vector_type(8)));
__device__ __forceinline__ void ph_router(const Frame& F, int layer, int nrows, const float* xlat, const float* xctx, const float* nw, int si) {
    const Params& P = *F.P;
    bf16_t* dst = (bf16_t*)(F.ws + WS_ACT);
    LAS unsigned* hist = (LAS unsigned*)F.lds;
    LAS float* lg = (LAS float*)(F.lds + 256) + F.wave * (16 * 48);
    int* tok_e = (int*)(F.ws + WS_R2 + R2_TOKE); float* tok_w = (float*)(F.ws + WS_R2 + R2_TOKW);
    if (F.tid < 64) hist[F.tid] = 0u;
    __syncthreads();
    { int* stok = (int*)(F.ws + WS_R2 + R2_STOK);
      for (int i = gtid(F); i < MAXSLOTS; i += F.G * NTH) stok[i] = -1; }
    const bf16_t* Wh = (const bf16_t*)(F.ws + WS_WSM) + W_RT / 2 + (size_t)layer * 2 * 48 * 1024; const bf16_t* Wl = Wh + 48 * 1024;
    const int lr = F.lane & 15, kq = F.lane >> 4;
    const float* rgb = P.in[I_RGB] + layer * 4; const float* reb = P.in[I_REB] + layer * 32;
    for (int g = F.bid * 8 + F.wave; g < nrows / 16; g += F.G * 8) {
        const int r0 = g * 16;
        const float* src0 = r0 < TL ? xlat + (size_t)r0 * 1024 : xctx + (size_t)(r0 - TL) * 1024;
        const int b = r0 < TL ? (r0 >> 13) : 8;
        const float* sh = modp(F, layer, b, si); const float* sc = modp(F, layer, b, si + 1);
        float myrstd = 0.f;
#pragma unroll 4
        for (int rr = 0; rr < 16; ++rr) { const float* src = src0 + (size_t)rr * 1024; float ss = 0.f;
#pragma unroll
            for (int j = 0; j < 4; ++j) { const f32x4 v = *(const f32x4*)(src + j * 256 + F.lane * 4); ss += v[0] * v[0] + v[1] * v[1] + v[2] * v[2] + v[3] * v[3]; }
            ss = wave_sum(ss);
            const float rs = rsqrtf(ss * (1.f / 1024.f) + EPS); myrstd = (lr == rr) ? rs : myrstd; }
        f32x4 acc[3];
#pragma unroll
        for (int nb = 0; nb < 3; ++nb) acc[nb] = (f32x4){0.f, 0.f, 0.f, 0.f};
        const float* xr = src0 + (size_t)lr * 1024 + kq * 8;
        bf16_t* dr = dst + (size_t)(r0 + lr) * 1024 + kq * 8;
#pragma unroll 2
        for (int ks = 0; ks < 32; ++ks) { const int c = ks * 32 + kq * 8;
            const f32x4 x0 = *(const f32x4*)(xr + ks * 32), x1 = *(const f32x4*)(xr + ks * 32 + 4);
            const f32x4 w0 = *(const f32x4*)(nw + c), w1 = *(const f32x4*)(nw + c + 4), a0 = *(const f32x4*)(sc + c), a1 = *(const f32x4*)(sc + c + 4), b0 = *(const f32x4*)(sh + c), b1 = *(const f32x4*)(sh + c + 4);
            const f32x4 h0 = (x0 * myrstd * w0) * (1.f + a0) + b0, h1 = (x1 * myrstd * w1) * (1.f + a1) + b1;
            u32x4 hi; hi.x = pack2(h0[0], h0[1]); hi.y = pack2(h0[2], h0[3]); hi.z = pack2(h1[0], h1[1]); hi.w = pack2(h1[2], h1[3]);
            *(u32x4*)(dr + ks * 32) = hi;
            u32x4 lo; lo.x = pack2(h0[0] - lo2f(hi.x), h0[1] - hi2f(hi.x)); lo.y = pack2(h0[2] - lo2f(hi.y), h0[3] - hi2f(hi.y));
            lo.z = pack2(h1[0] - lo2f(hi.z), h1[1] - hi2f(hi.z)); lo.w = pack2(h1[2] - lo2f(hi.w), h1[3] - hi2f(hi.w));
            const s16x8r ah = __builtin_bit_cast(s16x8r, hi), al = __builtin_bit_cast(s16x8r, lo);
#pragma unroll
            for (int nb = 0; nb < 3; ++nb) { const s16x8r bh = *(const s16x8r*)(Wh + (size_t)(nb * 16 + lr) * 1024 + c), bl = *(const s16x8r*)(Wl + (size_t)(nb * 16 + lr) * 1024 + c);
                acc[nb] = __builtin_amdgcn_mfma_f32_16x16x32_bf16(ah, bh, acc[nb], 0, 0, 0);
                acc[nb] = __builtin_amdgcn_mfma_f32_16x16x32_bf16(al, bh, acc[nb], 0, 0, 0);
                acc[nb] = __builtin_amdgcn_mfma_f32_16x16x32_bf16(ah, bl, acc[nb], 0, 0, 0); } }
#pragma unroll
        for (int nb = 0; nb < 3; ++nb)
#pragma unroll
            for (int rg = 0; rg < 4; ++rg) lg[(4 * kq + rg) * 48 + nb * 16 + lr] = acc[nb][rg];
        asm volatile("s_waitcnt lgkmcnt(0)" ::: "memory");
        __builtin_amdgcn_wave_barrier();
        if (F.lane < 16) {
            const LAS float* L = lg + F.lane * 48;
            float lgv[4];
#pragma unroll
            for (int i = 0; i < 4; ++i) lgv[i] = L[i] + rgb[i];
            int gi = 0; float best = lgv[0];
#pragma unroll
            for (int i = 1; i < 4; ++i) if (lgv[i] > best) { best = lgv[i]; gi = i; }
            float den = 0.f;
#pragma unroll
            for (int i = 0; i < 4; ++i) den += __expf(lgv[i] - best);
            const float pg = 1.f / den;
            float le[8];
#pragma unroll
            for (int i = 0; i < 8; ++i) le[i] = L[4 + gi * 8 + i] + reb[gi * 8 + i];
            int i1 = 0; float b1 = le[0];
#pragma unroll
            for (int i = 1; i < 8; ++i) if (le[i] > b1) { b1 = le[i]; i1 = i; }
            int i2 = -1; float b2 = -3.0e38f;
#pragma unroll
            for (int i = 0; i < 8; ++i) if (i != i1 && le[i] > b2) { b2 = le[i]; i2 = i; }
            const float e2 = __expf(b2 - b1);
            const float w1 = pg / (1.f + e2), w2 = pg * e2 / (1.f + e2);
            const int e0g = gi * 8 + i1, e1g = gi * 8 + i2; const int r = r0 + F.lane;
            tok_e[r] = e0g | (e1g << 8); tok_w[2 * r] = w1; tok_w[2 * r + 1] = w2;
            lds_inc(&hist[e0g]); lds_inc(&hist[32 + e1g]);
        }
        __builtin_amdgcn_wave_barrier();
    }
    __syncthreads();
    unsigned* cnt = (unsigned*)(F.ws + WS_CTRL + C_MOE + layer * 1024);
    if (F.tid < 64 && hist[F.tid]) atomicAdd(&cnt[F.tid], hist[F.tid]);
    __syncthreads();
}

__device__ __forceinline__ void ph_dispatch(const Frame& F, int layer, int ntok) {
    unsigned* cnt = (unsigned*)(F.ws + WS_CTRL + C_MOE + layer * 1024); unsigned* cursor = cnt + 64; unsigned* info = cnt + 128;
    LAS unsigned* base = (LAS unsigned*)F.lds; LAS unsigned* lh = base + 64; LAS unsigned* gb = base + 128; LAS unsigned* lh2 = base + 192; LAS unsigned* pad = base + 256;
    const int* tok_e = (const int*)(F.ws + WS_R2 + R2_TOKE); const float* tok_w = (const float*)(F.ws + WS_R2 + R2_TOKW);
    int* stok = (int*)(F.ws + WS_R2 + R2_STOK); float* sw = (float*)(F.ws + WS_R2 + R2_SW); int* tile_e = (int*)(F.ws + WS_R2 + R2_TILEE);
    if (F.tid < 64) { pad[F.tid] = (__hip_atomic_load(&cnt[F.tid], __ATOMIC_RELAXED, __HIP_MEMORY_SCOPE_AGENT) + 255u) & ~255u; lh[F.tid] = 0u; lh2[F.tid] = 0u; }
    __syncthreads();
    if (F.tid == 0) { unsigned a = 0; for (int i = 0; i < 64; ++i) { base[i] = a; a += pad[i]; } base[320] = a; }
    __syncthreads();
    if (F.bid == 0) {
        for (int i = F.tid; i < MAXTILES; i += NTH) { const unsigned s = (unsigned)i * 256u; int l = -1;
            for (int j = 0; j < 64; ++j) if (s >= base[j] && s < base[j] + pad[j]) l = j;
            tile_e[i] = l; }
        if (F.tid == 0) { info[0] = base[32] / 256u; info[1] = base[320] / 256u; }
    }
    const int per = (ntok + F.G - 1) / F.G, t0 = F.bid * per, t1 = min(ntok, t0 + per);
    for (int t = t0 + F.tid; t < t1; t += NTH) { const int e = tok_e[t]; lds_inc(&lh[e & 255]); lds_inc(&lh[32 + (e >> 8)]); }
    __syncthreads();
    if (F.tid < 64) gb[F.tid] = lh[F.tid] ? __hip_atomic_fetch_add(&cursor[F.tid], lh[F.tid], __ATOMIC_RELAXED, __HIP_MEMORY_SCOPE_AGENT) : 0u;
    __syncthreads();
    for (int t = t0 + F.tid; t < t1; t += NTH) { const int e = tok_e[t];
        const int l0 = e & 255, l1 = 32 + (e >> 8);
        const unsigned p0 = base[l0] + gb[l0] + lds_inc(&lh2[l0]), p1 = base[l1] + gb[l1] + lds_inc(&lh2[l1]);
        stok[p0] = t; sw[p0] = tok_w[2 * t]; stok[p1] = t; sw[p1] = tok_w[2 * t + 1]; }
    __syncthreads();
}

template <class AF, class EP>
__device__ __forceinline__ void gemm_unit_naive(const Frame& F, int K, const AF& arow, const bf16_t* Bt, const EP& E, int pm, int pn) {
    LAS float* As = (LAS float*)F.lds;
    LAS float* Bs = As + 32 * 132;
    const int t = F.tid, ty = t >> 5, tx = t & 31;
    for (int half = 0; half < 2; ++half) {
        float acc[8][8];
#pragma unroll
        for (int i = 0; i < 8; ++i)
#pragma unroll
            for (int j = 0; j < 8; ++j) acc[i][j] = 0.f;
        const bf16_t* ap = arow(half * 128 + (t >> 2));
        const bf16_t* bp = Bt + (size_t)(t >> 1) * K;
        for (int k0 = 0; k0 < K; k0 += 32) {
            { const int r = t >> 2, kq = (t & 3) * 8; u32x4 w = {0u, 0u, 0u, 0u}; if (ap) w = *(const u32x4*)(ap + k0 + kq);
              As[(kq + 0) * 132 + r] = lo2f(w.x); As[(kq + 1) * 132 + r] = hi2f(w.x); As[(kq + 2) * 132 + r] = lo2f(w.y); As[(kq + 3) * 132 + r] = hi2f(w.y);
              As[(kq + 4) * 132 + r] = lo2f(w.z); As[(kq + 5) * 132 + r] = hi2f(w.z); As[(kq + 6) * 132 + r] = lo2f(w.w); As[(kq + 7) * 132 + r] = hi2f(w.w); }
            { const int n = t >> 1, kh = (t & 1) * 16;
#pragma unroll
              for (int q = 0; q < 2; ++q) { const u32x4 w = *(const u32x4*)(bp + k0 + kh + q * 8); const int kk = kh + q * 8;
                Bs[(kk + 0) * 260 + n] = lo2f(w.x); Bs[(kk + 1) * 260 + n] = hi2f(w.x); Bs[(kk + 2) * 260 + n] = lo2f(w.y); Bs[(kk + 3) * 260 + n] = hi2f(w.y);
                Bs[(kk + 4) * 260 + n] = lo2f(w.z); Bs[(kk + 5) * 260 + n] = hi2f(w.z); Bs[(kk + 6) * 260 + n] = lo2f(w.w); Bs[(kk + 7) * 260 + n] = hi2f(w.w); } }
            __syncthreads();
#pragma unroll 4
            for (int k = 0; k < 32; ++k) {
                const f32x4 a0 = *(const LAS f32x4*)(As + k * 132 + ty * 8), a1 = *(const LAS f32x4*)(As + k * 132 + ty * 8 + 4);
                const f32x4 b0 = *(const LAS f32x4*)(Bs + k * 260 + tx * 4), b1 = *(const LAS f32x4*)(Bs + k * 260 + 128 + tx * 4);
#pragma unroll
                for (int i = 0; i < 8; ++i) { const float a = i < 4 ? a0[i & 3] : a1[i & 3];
#pragma unroll
                    for (int j = 0; j < 4; ++j) { acc[i][j] += a * b0[j]; acc[i][4 + j] += a * b1[j]; } }
            }
            __syncthreads();
        }
#pragma unroll
        for (int i = 0; i < 8; ++i) { const f32x4 v0 = {acc[i][0], acc[i][1], acc[i][2], acc[i][3]}, v1 = {acc[i][4], acc[i][5], acc[i][6], acc[i][7]};
            E(pm * 256 + half * 128 + ty * 8 + i, pn, tx * 4, v0, v1); }
    }
}
struct ARowDense { const bf16_t* A; int K; int pm; __device__ __forceinline__ const bf16_t* operator()(int r) const { return A + (size_t)(pm * 256 + r) * K; } };
struct ARowGather { const bf16_t* A; const int* stok; int pm; __device__ __forceinline__ const bf16_t* operator()(int r) const { const int t = stok[pm * 256 + r]; return t < 0 ? nullptr : A + (size_t)t * 1024; } };

template <class EP>
__device__ __forceinline__ void gemm_dense_naive(const Frame& F, const bf16_t* A, const bf16_t* Bt, int M, int N, int K, const EP& E) {
    const int nM = M / 256, nN = N / 256;
    for (int u = F.bid; u < nM * nN; u += F.G) { const int pm = u / nN, pn = u % nN;
        ARowDense ar{A, K, pm}; gemm_unit_naive(F, K, ar, Bt + (size_t)pn * 256 * K, E, pm, pn); }
}

namespace pg8 {
typedef short bf16x8 __attribute__((ext_vector_type(8)));
constexpr int BM = 256, BK = 64, HALF = 128, HTB = HALF * BK * 2, STAGE_BYTES = 8 * HTB, NXCD = 8, WGM = 8;
__device__ __forceinline__ int lds_byte(int r, int c) { const int st = (r >> 4) * 2 + (c >> 5), rr = r & 15, cc = c & 31, ob = rr * 64 + cc * 2; return st * 1024 + (ob ^ (((ob >> 9) & 1) << 5)); }
__device__ __forceinline__ void stage_rc(int b, int& R, int& C) { const int st = b / 1024, sb = b % 1024, swz = sb ^ (((sb >> 9) & 1) << 5); R = (st >> 1) * 16 + swz / 64; C = (st & 1) * 32 + (swz % 64) / 2; }
struct Unit { int pm, pn; };
struct ProbDense {
    const char* A; const char* Bt; int K, nM, nN, nwg, G, c;
    __device__ __forceinline__ void init(const bf16_t* A_, const bf16_t* Bt_, int M, int N, int K_, int G_, int c_) { A = (const char*)A_; Bt = (const char*)Bt_; K = K_; nM = M / BM; nN = N / BM; nwg = nM * nN; G = G_; c = c_; }
    __device__ __forceinline__ bool next(int i, Unit& u) const {
        const long L = (long)i * G + c; if (L >= nwg) return false;
        int wgid = (int)L; { const int q = nwg / NXCD, r = nwg % NXCD, xcd = wgid % NXCD, off = wgid / NXCD; wgid = (xcd < r ? xcd * (q + 1) : r * (q + 1) + (xcd - r) * q) + off; }
        const int nig = WGM * nN, gid = wgid / nig, fm = gid * WGM, gsz = (nM - fm) < WGM ? (nM - fm) : WGM;
        u.pm = fm + ((wgid % nig) % gsz); u.pn = (wgid % nig) / gsz; return true;
    }
    __device__ __forceinline__ const char* bptr(const Unit& u) const { return Bt + (size_t)u.pn * 256 * K * 2; }
    __device__ __forceinline__ unsigned aoff(const Unit& u, int r) const { return (unsigned)(u.pm * 256 + r) * (unsigned)(K * 2); }
};
struct ProbMoe1 {
    const char* A; const int* stok; const int* tile_e; const char* W; int K, ntiles, G, c;
    __device__ __forceinline__ bool next(int i, Unit& u) const { const int L = i * G + c; if (L >= ntiles * 4) return false; u.pm = L >> 2; u.pn = L & 3; return true; }
    __device__ __forceinline__ const char* bptr(const Unit& u) const { return W + ((size_t)(tile_e[u.pm] & 31) * 1024 + u.pn * 256) * 2048; }
    __device__ __forceinline__ unsigned aoff(const Unit& u, int r) const { const int t = stok[u.pm * 256 + r]; return t < 0 ? 0u : (unsigned)t * 2048u; }
};
struct ProbMoe2 {
    const char* A; const int* tile_e; const char* W; int K, tlo, thi, G, c;
    __device__ __forceinline__ bool next(int i, Unit& u) const { const int L = i * G + c; if (L >= (thi - tlo) * 4) return false; u.pm = tlo + (L >> 2); u.pn = L & 3; return true; }
    __device__ __forceinline__ const char* bptr(const Unit& u) const { return W + ((size_t)(tile_e[u.pm] & 31) * 1024 + u.pn * 256) * 1024; }
    __device__ __forceinline__ unsigned aoff(const Unit& u, int r) const { return (unsigned)(u.pm * 256 + r) * 1024u; }
};

template <class Prob, class Epi>
__device__ __forceinline__ void gemm_phase(LAS unsigned char* lds, const Prob& S, const Epi& E) {
    const int tid = threadIdx.x, wid = __builtin_amdgcn_readfirstlane(tid >> 6), lane = tid & 63, wr = wid >> 2, wc = wid & 3, fr = lane & 15, fq = lane >> 4;
    const int K = S.K, nt = K / BK;
    int RA[2]; unsigned cb2[2], voffB[2];
#pragma unroll
    for (int i = 0; i < 2; ++i) { int R, C; stage_rc(tid * 16 + i * 8192, R, C); RA[i] = R; cb2[i] = (unsigned)C * 2u; voffB[i] = (unsigned)(R * K + C) * 2u; }
    const size_t kstep = (size_t)(BK * 2);
    const size_t hstepB = (size_t)HALF * K * 2;
    const unsigned ldsw = (unsigned)wid * 1024u;
    const int aoff = lds_byte(wr * 64 + fr, fq * 8), boff = lds_byte(wc * 32 + fr, fq * 8);
#define PG8_SA(b, h) (((b) * 2 + (h)) * HTB)
#define PG8_SB(b, h) ((4 + (b) * 2 + (h)) * HTB)
#define PG8_STAGE(bufoff, gbase, voff) do { _Pragma("unroll") for (int _i = 0; _i < 2; ++_i) \
        __builtin_amdgcn_global_load_lds((const unsigned*)((const char*)(gbase) + (voff)[_i]), (LAS unsigned*)(lds + (bufoff) + ldsw + _i * 8192), 16, 0, 0); } while (0)
#define PG8_LDA(dst, b, h) do { _Pragma("unroll") for (int m = 0; m < 4; ++m) _Pragma("unroll") for (int k = 0; k < 2; ++k) dst[m][k] = *(const LAS bf16x8*)(lds + PG8_SA(b, h) + aoff + m * 2048 + k * 1024); } while (0)
#define PG8_LDB(dst, b, h) do { _Pragma("unroll") for (int n = 0; n < 2; ++n) _Pragma("unroll") for (int k = 0; k < 2; ++k) dst[n][k] = *(const LAS bf16x8*)(lds + PG8_SB(b, h) + boff + n * 2048 + k * 1024); } while (0)
#define PG8_MMA(ai, bj, At, Bt) do { __builtin_amdgcn_s_setprio(1); _Pragma("unroll") for (int m = 0; m < 4; ++m) _Pragma("unroll") for (int n = 0; n < 2; ++n) _Pragma("unroll") for (int k = 0; k < 2; ++k) \
        acc[ai][bj][m][n] = __builtin_amdgcn_mfma_f32_16x16x32_bf16(Bt[n][k], At[m][k], acc[ai][bj][m][n], 0, 0, 0); __builtin_amdgcn_s_setprio(0); } while (0)
#define PG8_WAIT_V(n) asm volatile("s_waitcnt vmcnt(" #n ")" ::: "memory")
#define PG8_WAIT_L(n) asm volatile("s_waitcnt lgkmcnt(" #n ")" ::: "memory")
#define PG8_BAR __builtin_amdgcn_s_barrier()
#define PG8_SCHED __builtin_amdgcn_sched_barrier(0)
    Unit cur, nxt; int ui = 0;
    if (!S.next(0, cur)) return;
    f32x4 acc[2][2][4][2];
#pragma unroll
    for (int a = 0; a < 2; ++a)
#pragma unroll
        for (int b = 0; b < 2; ++b)
#pragma unroll
            for (int m = 0; m < 4; ++m)
#pragma unroll
                for (int n = 0; n < 2; ++n) acc[a][b][m][n] = (f32x4){0.f, 0.f, 0.f, 0.f};
    bf16x8 At[4][2], B0[2][2], B1[2][2];
    unsigned oc0[2], oc1[2], on0[2], on1[2];
#pragma unroll
    for (int i = 0; i < 2; ++i) { oc0[i] = S.aoff(cur, RA[i]) + cb2[i]; oc1[i] = S.aoff(cur, 128 + RA[i]) + cb2[i]; }
    const char* cB = S.bptr(cur);
    const char* const Ab = S.A;
    PG8_STAGE(PG8_SB(0, 0), cB, voffB); PG8_STAGE(PG8_SA(0, 0), Ab, oc0); PG8_STAGE(PG8_SB(0, 1), cB + hstepB, voffB); PG8_STAGE(PG8_SA(0, 1), Ab, oc1);
    if (wr == 1) PG8_BAR;
    PG8_WAIT_V(4); PG8_BAR;
    PG8_STAGE(PG8_SB(1, 0), cB + kstep, voffB); PG8_STAGE(PG8_SA(1, 0), Ab + kstep, oc0); PG8_STAGE(PG8_SB(1, 1), cB + hstepB + kstep, voffB);
    PG8_WAIT_V(6); PG8_BAR;
    for (;;) {
        const bool has_next = S.next(ui + 1, nxt);
        const char* nB = has_next ? S.bptr(nxt) : cB;
#pragma unroll
        for (int i = 0; i < 2; ++i) { on0[i] = has_next ? S.aoff(nxt, RA[i]) + cb2[i] : oc0[i]; on1[i] = has_next ? S.aoff(nxt, 128 + RA[i]) + cb2[i] : oc1[i]; }
        for (int t = 0; t < nt; t += 2) {
            const bool last = (t == nt - 2);
            const char* a1 = Ab + (size_t)(t + 1) * kstep;
            const char* a2 = last ? Ab : Ab + (size_t)(t + 2) * kstep; const char* b2 = last ? nB : cB + (size_t)(t + 2) * kstep;
            const char* a3 = a2 + kstep; const char* b3 = b2 + kstep;
            unsigned o20[2], o21[2];
#pragma unroll
            for (int i = 0; i < 2; ++i) { o20[i] = last ? on0[i] : oc0[i]; o21[i] = last ? on1[i] : oc1[i]; }
            PG8_LDB(B0, 0, 0); PG8_SCHED; PG8_LDA(At, 0, 0); PG8_STAGE(PG8_SA(1, 1), a1, oc1);
            PG8_WAIT_L(8); PG8_BAR; PG8_WAIT_L(0); PG8_MMA(0, 0, At, B0); PG8_BAR; PG8_SCHED;
            PG8_LDB(B1, 0, 1); PG8_STAGE(PG8_SB(0, 0), b2, voffB);
            PG8_BAR; PG8_WAIT_L(0); PG8_MMA(0, 1, At, B1); PG8_BAR;
            PG8_LDA(At, 0, 1); PG8_STAGE(PG8_SA(0, 0), a2, o20);
            PG8_BAR; PG8_WAIT_L(0); PG8_MMA(1, 0, At, B0); PG8_BAR; PG8_SCHED;
            PG8_STAGE(PG8_SB(0, 1), b2 + hstepB, voffB);
            PG8_WAIT_V(6); PG8_BAR; PG8_MMA(1, 1, At, B1); PG8_BAR;
            PG8_LDB(B0, 1, 0); PG8_SCHED; PG8_LDA(At, 1, 0); PG8_STAGE(PG8_SA(0, 1), a2, o21);
            PG8_WAIT_L(8); PG8_BAR; PG8_WAIT_L(0); PG8_MMA(0, 0, At, B0); PG8_BAR; PG8_SCHED;
            PG8_LDB(B1, 1, 1); PG8_STAGE(PG8_SB(1, 0), b3, voffB);
            PG8_BAR; PG8_WAIT_L(0); PG8_MMA(0, 1, At, B1); PG8_BAR;
            PG8_LDA(At, 1, 1); PG8_STAGE(PG8_SA(1, 0), a3, o20);
            PG8_BAR; PG8_WAIT_L(0); PG8_MMA(1, 0, At, B0); PG8_BAR; PG8_SCHED;
            PG8_STAGE(PG8_SB(1, 1), b3 + hstepB, voffB);
            PG8_WAIT_V(6); PG8_BAR; PG8_MMA(1, 1, At, B1); PG8_BAR;
        }
#pragma unroll
        for (int ai = 0; ai < 2; ++ai)
#pragma unroll
            for (int m = 0; m < 4; ++m)
#pragma unroll
                for (int n = 0; n < 2; ++n) E(cur.pm * BM + ai * HALF + wr * 64 + m * 16 + fr, cur.pn, wc * 32 + n * 16 + fq * 4, acc[ai][0][m][n], acc[ai][1][m][n]);
        if (!has_next) break;
#pragma unroll
        for (int a = 0; a < 2; ++a)
#pragma unroll
            for (int b = 0; b < 2; ++b)
#pragma unroll
                for (int m = 0; m < 4; ++m)
#pragma unroll
                    for (int n = 0; n < 2; ++n) acc[a][b][m][n] = (f32x4){0.f, 0.f, 0.f, 0.f};
        cur = nxt; cB = nB; ++ui;
#pragma unroll
        for (int i = 0; i < 2; ++i) { oc0[i] = on0[i]; oc1[i] = on1[i]; }
    }
    PG8_WAIT_V(0);
    if (wr == 0) PG8_BAR;
    PG8_BAR;
#undef PG8_SA
#undef PG8_SB
#undef PG8_STAGE
#undef PG8_LDA
#undef PG8_LDB
#undef PG8_MMA
#undef PG8_WAIT_V
#undef PG8_WAIT_L
#undef PG8_BAR
#undef PG8_SCHED
}
}

struct EpiStoreBf16 { bf16_t* O; int ldc; int gelu_below;
    __device__ __forceinline__ void operator()(int row, int pn, int cx, f32x4 v0, f32x4 v1) const {
        const int c0 = pn * 256 + cx, c1 = c0 + 128;
        if (c0 < gelu_below) { v0[0] = gelu_tanh_f(v0[0]); v0[1] = gelu_tanh_f(v0[1]); v0[2] = gelu_tanh_f(v0[2]); v0[3] = gelu_tanh_f(v0[3]); }
        if (c1 < gelu_below) { v1[0] = gelu_tanh_f(v1[0]); v1[1] = gelu_tanh_f(v1[1]); v1[2] = gelu_tanh_f(v1[2]); v1[3] = gelu_tanh_f(v1[3]); }
        u32x2 a; a.x = pack2(v0[0], v0[1]); a.y = pack2(v0[2], v0[3]); u32x2 b; b.x = pack2(v1[0], v1[1]); b.y = pack2(v1[2], v1[3]);
        *(u32x2*)(O + (size_t)row * ldc + c0) = a; *(u32x2*)(O + (size_t)row * ldc + c1) = b; } };
struct EpiResidual { const float* srcl; const float* srcc; float* dstl; float* dstc; const float* mod;   int which;
    __device__ __forceinline__ void operator()(int row, int pn, int cx, f32x4 v0, f32x4 v1) const {
        const int b = row < TL ? (row >> 13) : 8; const float* g = mod + ((size_t)b * 6 + which) * 1024;
        const float* s = row < TL ? srcl + (size_t)row * 1024 : srcc + (size_t)(row - TL) * 1024;
        float* d = row < TL ? dstl + (size_t)row * 1024 : dstc + (size_t)(row - TL) * 1024;
        const int c0 = pn * 256 + cx, c1 = c0 + 128;
        *(f32x4*)(d + c0) = *(const f32x4*)(s + c0) + *(const f32x4*)(g + c0) * v0;
        *(f32x4*)(d + c1) = *(const f32x4*)(s + c1) + *(const f32x4*)(g + c1) * v1; } };
struct EpiMoe1 { bf16_t* H;
    __device__ __forceinline__ void operator()(int row, int pn, int cx, f32x4 v0, f32x4 v1) const {
        u32x2 a; a.x = pack2(silu_f(v0[0]) * v1[0], silu_f(v0[1]) * v1[1]); a.y = pack2(silu_f(v0[2]) * v1[2], silu_f(v0[3]) * v1[3]);
        *(u32x2*)(H + (size_t)row * 512 + pn * 128 + cx) = a; } };
struct EpiMoe2 { const int* stok; const float* sw; float* dstl; float* dstc; const float* mod;
    __device__ __forceinline__ void operator()(int row, int pn, int cx, f32x4 v0, f32x4 v1) const {
        const int t = stok[row]; if (t < 0) return; const float w = sw[row];
        const int b = t < TL ? (t >> 13) : 8; const float* g = mod + ((size_t)b * 6 + 5) * 1024;
        float* d = t < TL ? dstl + (size_t)t * 1024 : dstc + (size_t)(t - TL) * 1024;
        const int c0 = pn * 256 + cx, c1 = c0 + 128;
        *(f32x4*)(d + c0) = *(const f32x4*)(d + c0) + *(const f32x4*)(g + c0) * v0 * w;
        *(f32x4*)(d + c1) = *(const f32x4*)(d + c1) + *(const f32x4*)(g + c1) * v1 * w; } };

#ifndef FAST_GEMM
#define FAST_GEMM 1
#endif
template <class EP>
__device__ __forceinline__ void gemm_dense(const Frame& F, const bf16_t* A, const bf16_t* Bt, int M, int N, int K, const EP& E) {
#if FAST_GEMM
    pg8::ProbDense S; S.init(A, Bt, M, N, K, F.G, F.bid); pg8::gemm_phase(F.lds, S, E);
#else
    gemm_dense_naive(F, A, Bt, M, N, K, E);
#endif
}
__device__ __forceinline__ void ph_moe_gemm1(const Frame& F, int layer) {
    const unsigned* info = (const unsigned*)(F.ws + WS_CTRL + C_MOE + layer * 1024) + 128;
    const int ntiles = (int)__hip_atomic_load(&info[1], __ATOMIC_RELAXED, __HIP_MEMORY_SCOPE_AGENT);
    const int* tile_e = (const int*)(F.ws + WS_R2 + R2_TILEE); const int* stok = (const int*)(F.ws + WS_R2 + R2_STOK);
    const bf16_t* W1 = (const bf16_t*)(F.ws + WS_WMOE);
    EpiMoe1 E{(bf16_t*)(F.ws + WS_R2 + R2_H)};
#if FAST_GEMM
    pg8::ProbMoe1 S{(const char*)(F.ws + WS_ACT), stok, tile_e, (const char*)W1, 1024, ntiles, F.G, F.bid};
    pg8::gemm_phase(F.lds, S, E);
#else
    for (int u = F.bid; u < ntiles * 4; u += F.G) { const int pm = u >> 2, pn = u & 3; const int e = tile_e[pm] & 31;
        ARowGather ar{(const bf16_t*)(F.ws + WS_ACT), stok, pm};
        gemm_unit_naive(F, 1024, ar, W1 + ((size_t)e * 1024 + pn * 256) * 1024, E, pm, pn); }
#endif
}
__device__ __forceinline__ void ph_moe_gemm2(const Frame& F, int layer, int k) {
    const unsigned* info = (const unsigned*)(F.ws + WS_CTRL + C_MOE + layer * 1024) + 128;
    const int nk0 = (int)__hip_atomic_load(&info[0], __ATOMIC_RELAXED, __HIP_MEMORY_SCOPE_AGENT), nall = (int)__hip_atomic_load(&info[1], __ATOMIC_RELAXED, __HIP_MEMORY_SCOPE_AGENT);
    const int tlo = k == 0 ? 0 : nk0, thi = k == 0 ? nk0 : nall;
    const int* tile_e = (const int*)(F.ws + WS_R2 + R2_TILEE);
    const bf16_t* W2 = (const bf16_t*)(F.ws + WS_WMOE) + (size_t)32 * 1024 * 1024;
    EpiMoe2 E{(const int*)(F.ws + WS_R2 + R2_STOK), (const float*)(F.ws + WS_R2 + R2_SW), F.P->out, (float*)(F.ws + WS_XC), F.mod + (size_t)layer * 9 * 6144};
#if FAST_GEMM
    pg8::ProbMoe2 S{(const char*)(F.ws + WS_R2 + R2_H), tile_e, (const char*)W2, 512, tlo, thi, F.G, F.bid};
    pg8::gemm_phase(F.lds, S, E);
#else
    for (int u = F.bid; u < (thi - tlo) * 4; u += F.G) { const int pm = tlo + (u >> 2), pn = u & 3; const int e = tile_e[pm] & 31;
        ARowDense ar{(const bf16_t*)(F.ws + WS_R2 + R2_H), 512, pm};
        gemm_unit_naive(F, 512, ar, W2 + ((size_t)e * 1024 + pn * 256) * 512, E, pm, pn); }
#endif
}

__device__ __forceinline__ void ph_gmlp(const Frame& F) {
    const Params& P = *F.P;
    const bf16_t* PX = (const bf16_t*)(F.ws + WS_PX); bf16_t* CAT = (bf16_t*)(F.ws + WS_ACT);
    LAS float* Vs = (LAS float*)F.lds;
    LAS float* Wm = Vs + 128 * 128;
    LAS float* rs = Wm + 128 * 129;
    for (int it = F.bid; it < 528 * 4; it += F.G) {
        const int ch = it >> 2, g = it & 3, row0 = ch * 128;
        for (int q = F.wave; q < 128; q += 8) { const bf16_t* p = PX + (size_t)(row0 + q) * EVEN_IN + 512 + F.lane * 8;
            const u32x4 w = *(const u32x4*)p; float s = 0.f, x;
            x = lo2f(w.x); s += x * x; x = hi2f(w.x); s += x * x; x = lo2f(w.y); s += x * x; x = hi2f(w.y); s += x * x;
            x = lo2f(w.z); s += x * x; x = hi2f(w.z); s += x * x; x = lo2f(w.w); s += x * x; x = hi2f(w.w); s += x * x;
            s = wave_sum(s); if (F.lane == 0) rs[q] = rsqrtf(s * (1.f / 512.f) + EPS); }
        __syncthreads();
        for (int i = F.tid; i < 128 * 128; i += NTH) { const int q = i >> 7, c = i & 127;
            Vs[i] = bf2f(PX[(size_t)(row0 + q) * EVEN_IN + 512 + g * 128 + c]) * rs[q] * P.in[I_GNW][g * 128 + c];
            Wm[q * 129 + c] = P.in[I_GWS][(size_t)g * 16384 + i]; }
        __syncthreads();
        const int ty = F.tid >> 5, tx = F.tid & 31;
        float acc[8][4];
#pragma unroll
        for (int i = 0; i < 8; ++i)
#pragma unroll
            for (int j = 0; j < 4; ++j) acc[i][j] = 0.f;
        for (int q = 0; q < 128; ++q) { const f32x4 v = *(const LAS f32x4*)(Vs + q * 128 + tx * 4);
#pragma unroll
            for (int i = 0; i < 8; ++i) { const float w = Wm[(ty * 8 + i) * 129 + q];
#pragma unroll
                for (int j = 0; j < 4; ++j) acc[i][j] += w * v[j]; } }
#pragma unroll
        for (int i = 0; i < 8; ++i) { const int p = ty * 8 + i; const float bias = P.in[I_GBS][g * 128 + p];
            const size_t t = (size_t)(row0 + p); const int col = g * 128 + tx * 4;
            const u32x2 uu = *(const u32x2*)(PX + t * EVEN_IN + col);
            u32x2 o; o.x = pack2(lo2f(uu.x) * (acc[i][0] + bias), hi2f(uu.x) * (acc[i][1] + bias)); o.y = pack2(lo2f(uu.y) * (acc[i][2] + bias), hi2f(uu.y) * (acc[i][3] + bias));
            *(u32x2*)(CAT + t * 1024 + col) = o; }
        __syncthreads();
    }
}

__device__ __forceinline__ void ph_gmlp_mfma(const Frame& F) {
    const Params& P = *F.P;
    const bf16_t* PX = (const bf16_t*)(F.ws + WS_PX); bf16_t* CAT = (bf16_t*)(F.ws + WS_ACT);
    LAS unsigned char* VT = F.lds;
    LAS unsigned char* WB = F.lds + 34816;
    LAS float* rs = (LAS float*)(F.lds + 69632);
    const int l31 = F.lane & 31, hh = F.lane >> 5;
    for (int it = F.bid; it < 528 * 4; it += F.G) {
        const int ch = it >> 2, g = it & 3, row0 = ch * 128;
        for (int q = F.wave; q < 128; q += 8) { const bf16_t* p = PX + (size_t)(row0 + q) * EVEN_IN + 512 + F.lane * 8;
            const u32x4 w = *(const u32x4*)p; float s = 0.f, x;
            x = lo2f(w.x); s += x * x; x = hi2f(w.x); s += x * x; x = lo2f(w.y); s += x * x; x = hi2f(w.y); s += x * x;
            x = lo2f(w.z); s += x * x; x = hi2f(w.z); s += x * x; x = lo2f(w.w); s += x * x; x = hi2f(w.w); s += x * x;
            s = wave_sum(s); if (F.lane == 0) rs[q] = rsqrtf(s * (1.f / 512.f) + EPS); }
#pragma unroll
        for (int k = 0; k < 4; ++k) { const int c = F.tid + 512 * k, p = c >> 4, part = c & 15;
            const float* src = P.in[I_GWS] + (size_t)g * 16384 + p * 128 + part * 8; const f32x4 a = *(const f32x4*)src, b = *(const f32x4*)(src + 4);
            u32x4 w; w.x = pack2(a[0], a[1]); w.y = pack2(a[2], a[3]); w.z = pack2(b[0], b[1]); w.w = pack2(b[2], b[3]);
            *(LAS u32x4*)(WB + p * 272 + part * 16) = w; }
        __syncthreads();
#pragma unroll
        for (int k = 0; k < 4; ++k) { const int c = F.tid + 512 * k, q = c >> 4, c0 = (c & 15) * 8;
            const u32x4 w = *(const u32x4*)(PX + (size_t)(row0 + q) * EVEN_IN + 512 + g * 128 + c0); const float r = rs[q];
            const float* nw = P.in[I_GNW] + g * 128 + c0; const f32x4 n0 = *(const f32x4*)nw, n1 = *(const f32x4*)(nw + 4);
            LAS unsigned short* d = (LAS unsigned short*)(VT + c0 * 272 + q * 2);
            d[0 * 136] = f2bf(lo2f(w.x) * r * n0[0]); d[1 * 136] = f2bf(hi2f(w.x) * r * n0[1]); d[2 * 136] = f2bf(lo2f(w.y) * r * n0[2]); d[3 * 136] = f2bf(hi2f(w.y) * r * n0[3]);
            d[4 * 136] = f2bf(lo2f(w.z) * r * n1[0]); d[5 * 136] = f2bf(hi2f(w.z) * r * n1[1]); d[6 * 136] = f2bf(lo2f(w.w) * r * n1[2]); d[7 * 136] = f2bf(hi2f(w.w) * r * n1[3]); }
        __syncthreads();
        const int pb = F.wave >> 1, cb0 = (F.wave & 1) * 2;
        f32x16 a0, a1;
#pragma unroll
        for (int r = 0; r < 16; ++r) { a0[r] = 0.f; a1[r] = 0.f; }
#pragma unroll
        for (int ks = 0; ks < 8; ++ks) { const s16x8 wa = *(const LAS s16x8*)(WB + (32 * pb + l31) * 272 + ks * 32 + hh * 16);
            a0 = __builtin_amdgcn_mfma_f32_32x32x16_bf16(wa, *(const LAS s16x8*)(VT + (32 * cb0 + l31) * 272 + ks * 32 + hh * 16), a0, 0, 0, 0);
            a1 = __builtin_amdgcn_mfma_f32_32x32x16_bf16(wa, *(const LAS s16x8*)(VT + (32 * (cb0 + 1) + l31) * 272 + ks * 32 + hh * 16), a1, 0, 0, 0); }
#pragma unroll
        for (int r = 0; r < 16; ++r) { const int p = 32 * pb + (r & 3) + 8 * (r >> 2) + 4 * hh; const float bias = P.in[I_GBS][g * 128 + p];
            const size_t t = (size_t)(row0 + p); const int c0 = g * 128 + 32 * cb0 + l31, c1 = c0 + 32;
            CAT[t * 1024 + c0] = f2bf(bf2f(PX[t * EVEN_IN + c0]) * (a0[r] + bias));
            CAT[t * 1024 + c1] = f2bf(bf2f(PX[t * EVEN_IN + c1]) * (a1[r] + bias)); }
        __syncthreads();
    }
}

__device__ __forceinline__ void ph_gla(const Frame& F) {
    const Params& P = *F.P;
    const bf16_t* PX = (const bf16_t*)(F.ws + WS_PX);
    LAS float* qs = (LAS float*)F.lds;
    LAS float* fs = qs + 8192;
    LAS float* vs = fs + 8192;
    LAS float* os = vs + 2048;
    const int dg = F.lane & 15, el = F.wave * 4 + (F.lane >> 4);
    const int prow = F.tid >> 4, pd0 = (F.tid & 15) * 8;
    const int vrow = F.tid >> 2, ve0 = (F.tid & 3) * 8;
    for (int it = F.bid; it < 256; it += F.G) {
        const int b = it >> 5, h = (it >> 3) & 3, dir = (it >> 2) & 1, sl = it & 3;
        bf16_t* O = (bf16_t*)(F.ws + WS_R2 + (dir ? R2_OB0 : R2_OF0));
        float lb8[8];
#pragma unroll
        for (int i = 0; i < 8; ++i) { const int ch = h * 128 + pd0 + i; const float* lg = P.in[I_LB] + (size_t)dir * 3 * 512 + ch;
            const float a0 = lg[0], a1 = lg[512], a2 = lg[1024]; const float m = fmaxf(a0, fmaxf(a1, a2));
            const float e0 = __expf(a0 - m), e1 = __expf(a1 - m), e2 = __expf(a2 - m); lb8[i] = e0 / (e0 + e1 + e2); }
        float S[8];
#pragma unroll
        for (int i = 0; i < 8; ++i) S[i] = 0.f;
        u32x4 rq0, rq1, rf0, rf1, rv = {0u, 0u, 0u, 0u};
        auto rowof = [&](int nb, int s) -> size_t { const bool c = nb < 4; const int len = c ? CTXL : SEQ; const int tt = (c ? nb : nb - 4) * 64 + s; const int p = dir ? len - 1 - tt : tt;
            return (c ? (size_t)TL + b * CTXL : (size_t)b * SEQ) + p; };
        auto fetch = [&](int nb) { const bf16_t* r0 = PX + rowof(nb, prow) * EVEN_IN; const bf16_t* r1 = PX + rowof(nb, prow + 32) * EVEN_IN;
            rq0 = *(const u32x4*)(r0 + 1024 + h * 128 + pd0); rf0 = *(const u32x4*)(r0 + 2048 + dir * 512 + h * 128 + pd0);
            rq1 = *(const u32x4*)(r1 + 1024 + h * 128 + pd0); rf1 = *(const u32x4*)(r1 + 2048 + dir * 512 + h * 128 + pd0);
            if (F.tid < 256) rv = *(const u32x4*)(PX + rowof(nb, vrow) * EVEN_IN + 1536 + h * 128 + sl * 32 + ve0); };
        auto put = [&](int row, u32x4 q, u32x4 f) { LAS float* qd = qs + row * 128 + pd0; LAS float* fd = fs + row * 128 + pd0;
            const float q8[8] = {lo2f(q.x), hi2f(q.x), lo2f(q.y), hi2f(q.y), lo2f(q.z), hi2f(q.z), lo2f(q.w), hi2f(q.w)};
            const float f8[8] = {lo2f(f.x), hi2f(f.x), lo2f(f.y), hi2f(f.y), lo2f(f.z), hi2f(f.z), lo2f(f.w), hi2f(f.w)};
            f32x4 o0, o1, g0, g1;
#pragma unroll
            for (int i = 0; i < 4; ++i) { o0[i] = q8[i]; o1[i] = q8[4 + i]; g0[i] = lb8[i] + (1.f - lb8[i]) * sigmoid_f(f8[i]); g1[i] = lb8[4 + i] + (1.f - lb8[4 + i]) * sigmoid_f(f8[4 + i]); }
            *(LAS f32x4*)qd = o0; *(LAS f32x4*)(qd + 4) = o1; *(LAS f32x4*)fd = g0; *(LAS f32x4*)(fd + 4) = g1; };
        fetch(0);
        for (int nb = 0; nb < 132; ++nb) {
            __syncthreads();
            put(prow, rq0, rf0); put(prow + 32, rq1, rf1);
            if (F.tid < 256) { LAS float* vd = vs + vrow * 32 + ve0;
                *(LAS f32x4*)vd = (f32x4){lo2f(rv.x), hi2f(rv.x), lo2f(rv.y), hi2f(rv.y)}; *(LAS f32x4*)(vd + 4) = (f32x4){lo2f(rv.z), hi2f(rv.z), lo2f(rv.w), hi2f(rv.w)}; }
            __syncthreads();
            if (nb + 1 < 132) fetch(nb + 1);
#pragma unroll 4
            for (int st = 0; st < 64; ++st) {
                const f32x4 fa = *(const LAS f32x4*)(fs + st * 128 + dg * 8), fb = *(const LAS f32x4*)(fs + st * 128 + dg * 8 + 4);
                const f32x4 qa = *(const LAS f32x4*)(qs + st * 128 + dg * 8), qb = *(const LAS f32x4*)(qs + st * 128 + dg * 8 + 4);
                const float v = vs[st * 32 + el];
                float p0 = 0.f, p1 = 0.f;
#pragma unroll
                for (int i = 0; i < 4; ++i) { S[i] = fa[i] * (S[i] - v) + v; p0 += qa[i] * S[i]; S[4 + i] = fb[i] * (S[4 + i] - v) + v; p1 += qb[i] * S[4 + i]; }
                const float o = sum16(p0 + p1);
                if (dg == 0) os[st * 32 + el] = o;
            }
            __syncthreads();
#pragma unroll
            for (int k = 0; k < 2; ++k) { const int s = (F.tid >> 4) + 32 * k, e2 = (F.tid & 15) * 2;
              *(unsigned*)(O + rowof(nb, s) * 512 + h * 128 + sl * 32 + e2) = pack2(os[s * 32 + e2], os[s * 32 + e2 + 1]); }
        }
        __syncthreads();
    }
}

constexpr size_t R2_GU = 0, R2_GD = 264 * MiB;
__device__ __forceinline__ void gla_geom(int u, int& b, int& h, int& ck, size_t& rbase, int& p0) {
    b = u / 528; h = (u % 528) / 132; ck = u % 132;
    if (ck < 4) { rbase = (size_t)TL + b * CTXL; p0 = ck * 64; } else { rbase = (size_t)b * SEQ; p0 = (ck - 4) * 64; }
}
__device__ __forceinline__ void gla_prep_dir(const Frame& F, int dir, int h, size_t rbase, int p0, LAS float* G, LAS unsigned char* KB) {
    const Params& P = *F.P;
    const bf16_t* PX = (const bf16_t*)(F.ws + WS_PX);
    { const int part = F.tid & 15;
      float lb8[8];
#pragma unroll
      for (int i = 0; i < 8; ++i) { const int chn = h * 128 + part * 8 + i; const float* lg = P.in[I_LB] + (size_t)dir * 3 * 512 + chn;
          const float a0 = lg[0], a1 = lg[512], a2 = lg[1024]; const float m = fmaxf(a0, fmaxf(a1, a2));
          const float e0 = __expf(a0 - m), e1 = __expf(a1 - m), e2 = __expf(a2 - m); lb8[i] = e0 / (e0 + e1 + e2); }
#pragma unroll
      for (int k = 0; k < 2; ++k) { const int i = (F.tid >> 4) + 32 * k, il = dir ? 63 - i : i;
          const u32x4 w = *(const u32x4*)(PX + (rbase + p0 + i) * EVEN_IN + 2048 + dir * 512 + h * 128 + part * 8);
          const float fr[8] = {lo2f(w.x), hi2f(w.x), lo2f(w.y), hi2f(w.y), lo2f(w.z), hi2f(w.z), lo2f(w.w), hi2f(w.w)};
          float f[8], kk[8];
#pragma unroll
          for (int j = 0; j < 8; ++j) { f[j] = lb8[j] + (1.f - lb8[j]) * sigmoid_f(fr[j]); kk[j] = 1.f - f[j]; f[j] = __logf(f[j]); }
          *(LAS f32x4*)(G + il * 128 + part * 8) = (f32x4){f[0], f[1], f[2], f[3]}; *(LAS f32x4*)(G + il * 128 + part * 8 + 4) = (f32x4){f[4], f[5], f[6], f[7]};
          u32x4 kw; kw.x = pack2(kk[0], kk[1]); kw.y = pack2(kk[2], kk[3]); kw.z = pack2(kk[4], kk[5]); kw.w = pack2(kk[6], kk[7]);
          *(LAS u32x4*)(KB + il * 272 + part * 16) = kw; } }
    __syncthreads();
    const int d = F.tid & 127, seg = F.tid >> 7;
    { float run = 0.f;
#pragma unroll
      for (int r = 0; r < 16; ++r) { run += G[(seg * 16 + r) * 128 + d]; G[(seg * 16 + r) * 128 + d] = run; } }
    __syncthreads();
    float off = 0.f;
#pragma unroll
    for (int s2 = 0; s2 < 3; ++s2) off += (s2 < seg) ? G[(s2 * 16 + 15) * 128 + d] : 0.f;
    __syncthreads();
#pragma unroll
    for (int r = 0; r < 16; ++r) G[(seg * 16 + r) * 128 + d] += off;
    __syncthreads();
}
__device__ __forceinline__ void ph_gla_p1(const Frame& F) {
    const bf16_t* PX = (const bf16_t*)(F.ws + WS_PX);
    LAS float* G = (LAS float*)F.lds;
    LAS unsigned char* KB = F.lds + 32768;
    LAS unsigned char* VT = F.lds + 32768 + 17408;
    LAS unsigned char* KT = VT + 18432;
    const int l31 = F.lane & 31, hh = F.lane >> 5;
    for (int u = F.bid; u < 4224; u += F.G) {
        int b, h, ck, p0; size_t rbase; gla_geom(u, b, h, ck, rbase, p0);
#pragma unroll
        for (int k = 0; k < 2; ++k) { const int c = F.tid + 512 * k, i = c >> 4, part = c & 15;
            const u32x4 w = *(const u32x4*)(PX + (rbase + p0 + i) * EVEN_IN + 1536 + h * 128 + part * 8);
            LAS unsigned short* d = (LAS unsigned short*)(VT + (part * 8) * 144 + i * 2);
            d[0 * 72] = (unsigned short)(w.x & 0xffffu); d[1 * 72] = (unsigned short)(w.x >> 16); d[2 * 72] = (unsigned short)(w.y & 0xffffu); d[3 * 72] = (unsigned short)(w.y >> 16);
            d[4 * 72] = (unsigned short)(w.z & 0xffffu); d[5 * 72] = (unsigned short)(w.z >> 16); d[6 * 72] = (unsigned short)(w.w & 0xffffu); d[7 * 72] = (unsigned short)(w.w >> 16); }
        for (int dir = 0; dir < 2; ++dir) {
            gla_prep_dir(F, dir, h, rbase, p0, G, KB);
#pragma unroll
            for (int k = 0; k < 2; ++k) { const int c = F.tid + 512 * k, il = c >> 4, part = c & 15, i = dir ? 63 - il : il;
                const u32x4 kw = *(const LAS u32x4*)(KB + il * 272 + part * 16);
                const float kk[8] = {lo2f(kw.x), hi2f(kw.x), lo2f(kw.y), hi2f(kw.y), lo2f(kw.z), hi2f(kw.z), lo2f(kw.w), hi2f(kw.w)};
                const f32x4 g0 = *(const LAS f32x4*)(G + il * 128 + part * 8), g1 = *(const LAS f32x4*)(G + il * 128 + part * 8 + 4);
                const f32x4 l0 = *(const LAS f32x4*)(G + 63 * 128 + part * 8), l1 = *(const LAS f32x4*)(G + 63 * 128 + part * 8 + 4);
                LAS unsigned short* dd = (LAS unsigned short*)(KT + (part * 8) * 144 + i * 2);
#pragma unroll
                for (int j = 0; j < 4; ++j) { dd[j * 72] = f2bf(kk[j] * __expf(l0[j] - g0[j])); dd[(4 + j) * 72] = f2bf(kk[4 + j] * __expf(l1[j] - g1[j])); } }
            if (F.tid < 128) ((float*)(F.ws + WS_R2 + R2_GD))[(size_t)(u * 2 + dir) * 128 + F.tid] = __expf(G[63 * 128 + F.tid]);
            __syncthreads();
            { const int db = F.wave >> 1, eb0 = (F.wave & 1) * 2;
              f32x16 a0, a1;
#pragma unroll
              for (int r = 0; r < 16; ++r) { a0[r] = 0.f; a1[r] = 0.f; }
#pragma unroll
              for (int ks = 0; ks < 4; ++ks) { const s16x8 ka = *(const LAS s16x8*)(KT + (32 * db + l31) * 144 + ks * 32 + hh * 16);
                  a0 = __builtin_amdgcn_mfma_f32_32x32x16_bf16(ka, *(const LAS s16x8*)(VT + (32 * eb0 + l31) * 144 + ks * 32 + hh * 16), a0, 0, 0, 0);
                  a1 = __builtin_amdgcn_mfma_f32_32x32x16_bf16(ka, *(const LAS s16x8*)(VT + (32 * (eb0 + 1) + l31) * 144 + ks * 32 + hh * 16), a1, 0, 0, 0); }
              bf16_t* ut = (bf16_t*)(F.ws + WS_R2 + R2_GU) + (size_t)(u * 2 + dir) * 16384;
#pragma unroll
              for (int gq = 0; gq < 4; ++gq) { const int d0 = 32 * db + 8 * gq + 4 * hh; u32x2 x;
                  x.x = pack2(a0[4 * gq], a0[4 * gq + 1]); x.y = pack2(a0[4 * gq + 2], a0[4 * gq + 3]); *(u32x2*)(ut + (32 * eb0 + l31) * 128 + d0) = x;
                  x.x = pack2(a1[4 * gq], a1[4 * gq + 1]); x.y = pack2(a1[4 * gq + 2], a1[4 * gq + 3]); *(u32x2*)(ut + (32 * (eb0 + 1) + l31) * 128 + d0) = x; } }
            __syncthreads();
        }
    }
}
__device__ __forceinline__ void ph_gla_p2(const Frame& F) {
    bf16_t* GU = (bf16_t*)(F.ws + WS_R2 + R2_GU); const float* GD = (const float*)(F.ws + WS_R2 + R2_GD);
    for (int v = gtid(F); v < 64 * 2048; v += F.G * NTH) {
        const int chain = v >> 11, vec = v & 2047, d0 = (vec & 15) * 8;
        const int bh = chain >> 1, dir = chain & 1;
        float s[8];
#pragma unroll
        for (int j = 0; j < 8; ++j) s[j] = 0.f;
#pragma unroll 4
        for (int n = 0; n < 132; ++n) { const int ck = dir ? (n < 4 ? 3 - n : 135 - n) : n; const size_t ud = (size_t)(bh * 132 + ck) * 2 + dir;
            u32x4* p = (u32x4*)(GU + ud * 16384 + (size_t)vec * 8); const u32x4 w = *p;
            const f32x4 c0 = *(const f32x4*)(GD + ud * 128 + d0), c1 = *(const f32x4*)(GD + ud * 128 + d0 + 4);
            u32x4 o; o.x = pack2(s[0], s[1]); o.y = pack2(s[2], s[3]); o.z = pack2(s[4], s[5]); o.w = pack2(s[6], s[7]); *p = o;
            s[0] = c0[0] * s[0] + lo2f(w.x); s[1] = c0[1] * s[1] + hi2f(w.x); s[2] = c0[2] * s[2] + lo2f(w.y); s[3] = c0[3] * s[3] + hi2f(w.y);
            s[4] = c1[0] * s[4] + lo2f(w.z); s[5] = c1[1] * s[5] + hi2f(w.z); s[6] = c1[2] * s[6] + lo2f(w.w); s[7] = c1[3] * s[7] + hi2f(w.w); }
    }
}
__device__ __forceinline__ void ph_gla_p3(const Frame& F) {
    const Params& P = *F.P;
    const bf16_t* PX = (const bf16_t*)(F.ws + WS_PX); bf16_t* CAT = (bf16_t*)(F.ws + WS_ACT);
    LAS float* G = (LAS float*)F.lds;
    LAS unsigned char* KB = F.lds + 32768;
    LAS unsigned char* VT = KB + 17408;
    LAS unsigned char* QB = VT + 18432;
    LAS unsigned char* QT = QB + 17408;
    LAS unsigned char* AM = QT + 17408;
    LAS float* RS = (LAS float*)(AM + 9216);
    const int l31 = F.lane & 31, hh = F.lane >> 5, l15 = F.lane & 15, kq = F.lane >> 4;
    for (int u = F.bid; u < 4224; u += F.G) {
        int b, h, ck, p0; size_t rbase; gla_geom(u, b, h, ck, rbase, p0);
#pragma unroll
        for (int k = 0; k < 2; ++k) { const int c = F.tid + 512 * k, i = c >> 4, part = c & 15;
            const bf16_t* row = PX + (rbase + p0 + i) * EVEN_IN;
            const u32x4 w = *(const u32x4*)(row + 1536 + h * 128 + part * 8);
            LAS unsigned short* d = (LAS unsigned short*)(VT + (part * 8) * 144 + i * 2);
            d[0 * 72] = (unsigned short)(w.x & 0xffffu); d[1 * 72] = (unsigned short)(w.x >> 16); d[2 * 72] = (unsigned short)(w.y & 0xffffu); d[3 * 72] = (unsigned short)(w.y >> 16);
            d[4 * 72] = (unsigned short)(w.z & 0xffffu); d[5 * 72] = (unsigned short)(w.z >> 16); d[6 * 72] = (unsigned short)(w.w & 0xffffu); d[7 * 72] = (unsigned short)(w.w >> 16);
            *(LAS u32x4*)(QB + i * 272 + part * 16) = *(const u32x4*)(row + 1024 + h * 128 + part * 8); }
        const int eb = F.wave >> 1, ib = F.wave & 1;
        f32x16 acc;
#pragma unroll
        for (int r = 0; r < 16; ++r) acc[r] = 0.f;
        for (int dir = 0; dir < 2; ++dir) {
            gla_prep_dir(F, dir, h, rbase, p0, G, KB);
#pragma unroll
            for (int k = 0; k < 2; ++k) { const int c = F.tid + 512 * k, i = c >> 4, part = c & 15, il = dir ? 63 - i : i;
                const u32x4 qw = *(const LAS u32x4*)(QB + i * 272 + part * 16);
                const f32x4 g0 = *(const LAS f32x4*)(G + il * 128 + part * 8), g1 = *(const LAS f32x4*)(G + il * 128 + part * 8 + 4);
                u32x4 o; o.x = pack2(lo2f(qw.x) * __expf(g0[0]), hi2f(qw.x) * __expf(g0[1])); o.y = pack2(lo2f(qw.y) * __expf(g0[2]), hi2f(qw.y) * __expf(g0[3]));
                o.z = pack2(lo2f(qw.z) * __expf(g1[0]), hi2f(qw.z) * __expf(g1[1])); o.w = pack2(lo2f(qw.w) * __expf(g1[2]), hi2f(qw.w) * __expf(g1[3]));
                *(LAS u32x4*)(QT + i * 272 + part * 16) = o; }
            for (int c = F.tid; c < 576; c += NTH) *(LAS u32x4*)(AM + c * 16) = (u32x4){0u, 0u, 0u, 0u};
            __syncthreads();
            for (int blk = F.wave; blk < 10; blk += 8) {
                const int I = blk < 1 ? 0 : (blk < 3 ? 1 : (blk < 6 ? 2 : 3)); const int J = blk - (I * (I + 1)) / 2;
                const int ia = 16 * I + l15, ja = 16 * J + l15;
                const int ina = dir ? 63 - ia : ia;
                f32x4 ac = {0.f, 0.f, 0.f, 0.f};
#pragma unroll
                for (int ks = 0; ks < 4; ++ks) { const int d0 = 32 * ks + 8 * kq;
                    f32x4 r0 = {0.f, 0.f, 0.f, 0.f}, r1 = {0.f, 0.f, 0.f, 0.f};
                    if (I > 0) { r0 = *(const LAS f32x4*)(G + (16 * I - 1) * 128 + d0); r1 = *(const LAS f32x4*)(G + (16 * I - 1) * 128 + d0 + 4); }
                    const f32x4 gi0 = *(const LAS f32x4*)(G + ia * 128 + d0), gi1 = *(const LAS f32x4*)(G + ia * 128 + d0 + 4);
                    const f32x4 gj0 = *(const LAS f32x4*)(G + ja * 128 + d0), gj1 = *(const LAS f32x4*)(G + ja * 128 + d0 + 4);
                    const u32x4 qw = *(const LAS u32x4*)(QB + ina * 272 + d0 * 2), kw = *(const LAS u32x4*)(KB + ja * 272 + d0 * 2);
                    u32x4 af, bf;
                    af.x = pack2(lo2f(qw.x) * __expf(gi0[0] - r0[0]), hi2f(qw.x) * __expf(gi0[1] - r0[1])); af.y = pack2(lo2f(qw.y) * __expf(gi0[2] - r0[2]), hi2f(qw.y) * __expf(gi0[3] - r0[3]));
                    af.z = pack2(lo2f(qw.z) * __expf(gi1[0] - r1[0]), hi2f(qw.z) * __expf(gi1[1] - r1[1])); af.w = pack2(lo2f(qw.w) * __expf(gi1[2] - r1[2]), hi2f(qw.w) * __expf(gi1[3] - r1[3]));
                    bf.x = pack2(lo2f(kw.x) * __expf(fminf(r0[0] - gj0[0], 80.f)), hi2f(kw.x) * __expf(fminf(r0[1] - gj0[1], 80.f))); bf.y = pack2(lo2f(kw.y) * __expf(fminf(r0[2] - gj0[2], 80.f)), hi2f(kw.y) * __expf(fminf(r0[3] - gj0[3], 80.f)));
                    bf.z = pack2(lo2f(kw.z) * __expf(fminf(r1[0] - gj1[0], 80.f)), hi2f(kw.z) * __expf(fminf(r1[1] - gj1[1], 80.f))); bf.w = pack2(lo2f(kw.w) * __expf(fminf(r1[2] - gj1[2], 80.f)), hi2f(kw.w) * __expf(fminf(r1[3] - gj1[3], 80.f)));
                    ac = __builtin_amdgcn_mfma_f32_16x16x32_bf16(__builtin_bit_cast(s16x8, af), __builtin_bit_cast(s16x8, bf), ac, 0, 0, 0); }
#pragma unroll
                for (int rg = 0; rg < 4; ++rg) { const int il = 16 * I + 4 * kq + rg, jl = 16 * J + l15; const float val = (jl <= il) ? ac[rg] : 0.f;
                    const int in_ = dir ? 63 - il : il, jn = dir ? 63 - jl : jl;
                    *(LAS bf16_t*)(AM + in_ * 144 + jn * 2) = f2bf(val); }
            }
            __syncthreads();
            { const bf16_t* st = (const bf16_t*)(F.ws + WS_R2 + R2_GU) + (size_t)(u * 2 + dir) * 16384 + (size_t)(32 * eb + l31) * 128 + hh * 8;
              s16x8 sf[8];
#pragma unroll
              for (int ds = 0; ds < 8; ++ds) sf[ds] = *(const s16x8*)(st + ds * 16);
#pragma unroll
              for (int ds = 0; ds < 8; ++ds) acc = __builtin_amdgcn_mfma_f32_32x32x16_bf16(sf[ds], *(const LAS s16x8*)(QT + (32 * ib + l31) * 272 + ds * 32 + hh * 16), acc, 0, 0, 0);
#pragma unroll
              for (int js = 0; js < 4; ++js) acc = __builtin_amdgcn_mfma_f32_32x32x16_bf16(*(const LAS s16x8*)(VT + (32 * eb + l31) * 144 + js * 32 + hh * 16), *(const LAS s16x8*)(AM + (32 * ib + l31) * 144 + js * 32 + hh * 16), acc, 0, 0, 0); }
            __syncthreads();
        }
        { float ss = 0.f;
#pragma unroll
          for (int r = 0; r < 16; ++r) ss += acc[r] * acc[r];
          auto t = __builtin_amdgcn_permlane32_swap(__float_as_uint(ss), __float_as_uint(ss), false, false);
          ss = __uint_as_float(t[0]) + __uint_as_float(t[1]);
          if (hh == 0) RS[eb * 64 + 32 * ib + l31] = ss;
          __syncthreads();
          const int i = 32 * ib + l31; const float tot = RS[i] + RS[64 + i] + RS[128 + i] + RS[192 + i];
          const float rstd = rsqrtf(tot * (1.f / 128.f) + EPS);
          const size_t row = rbase + p0 + i;
#pragma unroll
          for (int gq = 0; gq < 4; ++gq) { const int e0 = 32 * eb + 8 * gq + 4 * hh; const int ch = h * 128 + e0;
              const u32x2 gw = *(const u32x2*)(PX + row * EVEN_IN + 3072 + ch); const f32x4 nw = *(const f32x4*)(P.in[I_HNW] + ch);
              u32x2 o; o.x = pack2(acc[4 * gq] * rstd * nw[0] * silu_f(lo2f(gw.x)), acc[4 * gq + 1] * rstd * nw[1] * silu_f(hi2f(gw.x)));
              o.y = pack2(acc[4 * gq + 2] * rstd * nw[2] * silu_f(lo2f(gw.y)), acc[4 * gq + 3] * rstd * nw[3] * silu_f(hi2f(gw.y)));
              *(u32x2*)(CAT + row * 1024 + 512 + ch) = o; }
          __syncthreads(); }
    }
}

__device__ __forceinline__ void ph_merge(const Frame& F, int mode) {
    const Params& P = *F.P;
    const bf16_t* PX = (const bf16_t*)(F.ws + WS_PX); bf16_t* CAT = (bf16_t*)(F.ws + WS_ACT);
    const bf16_t* Of = (const bf16_t*)(mode ? F.ws + WS_GOF : F.ws + WS_R2 + R2_OF0); const bf16_t* Ob = (const bf16_t*)(mode ? F.ws + WS_WMOE : F.ws + WS_R2 + R2_OB0);
    const int nrows = mode ? TL : TT, ldp = mode ? ODD_PAD : EVEN_IN, gcol = mode ? 1536 : 3072, dcol = mode ? 0 : 512;
    const float* nw = mode ? P.in[I_GDNNW] : P.in[I_HNW];
    for (int r = F.bid * 8 + F.wave; r < nrows; r += F.G * 8) {
        const int c = F.lane * 8;
        const u32x4 a = *(const u32x4*)(Of + (size_t)r * 512 + c), bb = *(const u32x4*)(Ob + (size_t)r * 512 + c), gg = *(const u32x4*)(PX + (size_t)r * ldp + gcol + c);
        float o[8] = {lo2f(a.x) + lo2f(bb.x), hi2f(a.x) + hi2f(bb.x), lo2f(a.y) + lo2f(bb.y), hi2f(a.y) + hi2f(bb.y), lo2f(a.z) + lo2f(bb.z), hi2f(a.z) + hi2f(bb.z), lo2f(a.w) + lo2f(bb.w), hi2f(a.w) + hi2f(bb.w)};
        const float g[8] = {lo2f(gg.x), hi2f(gg.x), lo2f(gg.y), hi2f(gg.y), lo2f(gg.z), hi2f(gg.z), lo2f(gg.w), hi2f(gg.w)};
        float ss = 0.f;
#pragma unroll
        for (int i = 0; i < 8; ++i) ss += o[i] * o[i];
        ss = sum16(ss);
        const float rstd = rsqrtf(ss * (1.f / 128.f) + EPS);
        float y[8];
#pragma unroll
        for (int i = 0; i < 8; ++i) { const float w = mode ? nw[(c & 127) + i] : nw[c + i]; y[i] = o[i] * rstd * w * silu_f(g[i]); }
        u32x4 w; w.x = pack2(y[0], y[1]); w.y = pack2(y[2], y[3]); w.z = pack2(y[4], y[5]); w.w = pack2(y[6], y[7]);
        *(u32x4*)(CAT + (size_t)r * 1024 + dcol + c) = w;
    }
}

__device__ __forceinline__ void ph_mla_norm(const Frame& F) {
    const Params& P = *F.P;
    const bf16_t* PX = (const bf16_t*)(F.ws + WS_PX);
    bf16_t* cqn = (bf16_t*)(F.ws + WS_R2 + R2_CQN); bf16_t* ckvn = cqn + (size_t)TL * 256;
    for (int r = F.bid * 8 + F.wave; r < TT; r += F.G * 8) {
        const bf16_t* row = PX + (size_t)r * ODD_PAD;
        if (r < TL) { const u32x2 w = *(const u32x2*)(row + 2064 + F.lane * 4);
            const float x0 = lo2f(w.x), x1 = hi2f(w.x), x2 = lo2f(w.y), x3 = hi2f(w.y);
            const float ss = wave_sum(x0 * x0 + x1 * x1 + x2 * x2 + x3 * x3); const float rstd = rsqrtf(ss * (1.f / 256.f) + EPS);
            const float* nw = P.in[I_QNW] + F.lane * 4;
            u32x2 o; o.x = pack2(x0 * rstd * nw[0], x1 * rstd * nw[1]); o.y = pack2(x2 * rstd * nw[2], x3 * rstd * nw[3]);
            *(u32x2*)(cqn + (size_t)r * 256 + F.lane * 4) = o; }
        { const unsigned w = *(const unsigned*)(row + 2320 + F.lane * 2);
          const float x0 = lo2f(w), x1 = hi2f(w);
          const float ss = wave_sum(x0 * x0 + x1 * x1); const float rstd = rsqrtf(ss * (1.f / 128.f) + EPS);
          const float* nw = P.in[I_KVNW] + F.lane * 2;
          *(unsigned*)(ckvn + (size_t)r * 256 + F.lane * 2) = pack2(x0 * rstd * nw[0], x1 * rstd * nw[1]);
          *(unsigned*)(ckvn + (size_t)r * 256 + 128 + F.lane * 2) = 0u; }
    }
}

__device__ __forceinline__ void ph_mla_final(const Frame& F) {
    const Params& P = *F.P;
    const bf16_t* PX = (const bf16_t*)(F.ws + WS_PX);
    bf16_t* Q = (bf16_t*)(F.ws + WS_WMOE);
    const bf16_t* KVR = (const bf16_t*)(F.ws + WS_PX + PX_KVRAW);
    bf16_t* Kb = (bf16_t*)(F.ws + WS_R2 + R2_K); bf16_t* Vb = (bf16_t*)(F.ws + WS_R2 + R2_V);
    const int hh = F.lane >> 3, sub = F.lane & 7;
    const float freq = __powf(10000.f, -(float)sub * 0.125f);
    const float qscale = 0.10206207261596577f * 1.4426950408889634f;
    for (int r = F.bid * 8 + F.wave; r < TT; r += F.G * 8) {
        const bool lat = r < TL; const int l = r & (SEQ - 1);
        float ca = 1.f, sa = 0.f, cb = 1.f, sb = 0.f;
        if (lat) { const float pr = (float)(l >> 6), pc = (float)(l & 63); sincosf(pr * freq, &sa, &ca); sincosf(pc * freq, &sb, &cb); }
        { const bf16_t* kv = KVR + (size_t)r * 1024 + hh * 128;
          const u32x4 w = *(const u32x4*)(kv + sub * 8);
          float x[12] = {lo2f(w.x), hi2f(w.x), lo2f(w.y), hi2f(w.y), lo2f(w.z), hi2f(w.z), lo2f(w.w), hi2f(w.w), 0.f, 0.f, 0.f, 0.f};
          const bf16_t* kr = PX + (size_t)r * ODD_PAD + 2448;
          x[8] = bf2f(kr[sub]); x[9] = bf2f(kr[8 + sub]); x[10] = bf2f(kr[16 + sub]); x[11] = bf2f(kr[24 + sub]);
          float ss = 0.f;
#pragma unroll
          for (int i = 0; i < 12; ++i) ss += x[i] * x[i];
          ss = sum8(ss);
          const float rstd = rsqrtf(ss * (1.f / 96.f) + EPS);
          const float* nw = P.in[I_QKK];
#pragma unroll
          for (int i = 0; i < 8; ++i) x[i] *= rstd * nw[sub * 8 + i];
          x[8] *= rstd * nw[64 + sub]; x[9] *= rstd * nw[72 + sub]; x[10] *= rstd * nw[80 + sub]; x[11] *= rstd * nw[88 + sub];
          const float a1 = x[8] * ca - x[9] * sa, a2 = x[9] * ca + x[8] * sa, b1 = x[10] * cb - x[11] * sb, b2 = x[11] * cb + x[10] * sb;
          const int bidx = lat ? (r >> 13) : ((r - TL) >> 8); const int s = lat ? (CTXL + l) : ((r - TL) & 255);
          bf16_t* kd = Kb + ((size_t)(bidx * 8 + hh) * (SEQ + CTXL) + s) * 96;
          u32x4 o; o.x = pack2(x[0], x[1]); o.y = pack2(x[2], x[3]); o.z = pack2(x[4], x[5]); o.w = pack2(x[6], x[7]);
          *(u32x4*)(kd + sub * 8) = o;
          kd[64 + sub] = f2bf(a1); kd[72 + sub] = f2bf(a2); kd[80 + sub] = f2bf(b1); kd[88 + sub] = f2bf(b2);
          const u32x4 vv = *(const u32x4*)(kv + 64 + sub * 8);
          *(u32x4*)(Vb + ((size_t)(bidx * 8 + hh) * (SEQ + CTXL) + s) * 64 + sub * 8) = vv; }
        if (lat) { bf16_t* q = Q + (size_t)r * 768 + hh * 96;
          const u32x4 w = *(const u32x4*)(q + sub * 8);
          float x[12] = {lo2f(w.x), hi2f(w.x), lo2f(w.y), hi2f(w.y), lo2f(w.z), hi2f(w.z), lo2f(w.w), hi2f(w.w), bf2f(q[64 + sub]), bf2f(q[72 + sub]), bf2f(q[80 + sub]), bf2f(q[88 + sub])};
          float ss = 0.f;
#pragma unroll
          for (int i = 0; i < 12; ++i) ss += x[i] * x[i];
          ss = sum8(ss);
          const float rstd = rsqrtf(ss * (1.f / 96.f) + EPS) * qscale;
          const float* nw = P.in[I_QKQ];
#pragma unroll
          for (int i = 0; i < 8; ++i) x[i] *= rstd * nw[sub * 8 + i];
          x[8] *= rstd * nw[64 + sub]; x[9] *= rstd * nw[72 + sub]; x[10] *= rstd * nw[80 + sub]; x[11] *= rstd * nw[88 + sub];
          const float a1 = x[8] * ca - x[9] * sa, a2 = x[9] * ca + x[8] * sa, b1 = x[10] * cb - x[11] * sb, b2 = x[11] * cb + x[10] * sb;
          u32x4 o; o.x = pack2(x[0], x[1]); o.y = pack2(x[2], x[3]); o.z = pack2(x[4], x[5]); o.w = pack2(x[6], x[7]);
          *(u32x4*)(q + sub * 8) = o;
          q[64 + sub] = f2bf(a1); q[72 + sub] = f2bf(a2); q[80 + sub] = f2bf(b1); q[88 + sub] = f2bf(b2); }
    }
}

__device__ __forceinline__ void ph_attn_naive(const Frame& F) {
    const bf16_t* Q = (const bf16_t*)(F.ws + WS_WMOE);
    const bf16_t* Kb = (const bf16_t*)(F.ws + WS_R2 + R2_K); const bf16_t* Vb = (const bf16_t*)(F.ws + WS_R2 + R2_V);
    bf16_t* CAT = (bf16_t*)(F.ws + WS_ACT);
    LAS float* Ks = (LAS float*)F.lds;
    LAS float* Vs = Ks + 64 * 96;
    constexpr int NK = SEQ + CTXL;
    const int hf = F.tid & 1;
    for (int it = F.bid; it < 8 * 8 * 32; it += F.G) {
        const int b = it >> 8, h = (it >> 5) & 7, qb = it & 31;
        const int l = qb * 256 + (F.tid >> 1); const size_t trow = (size_t)b * SEQ + l;
        float q[48], o[32];
        { const bf16_t* qp = Q + trow * 768 + h * 96 + hf * 48;
#pragma unroll
          for (int i = 0; i < 6; ++i) { const u32x4 w = *(const u32x4*)(qp + i * 8);
            q[i * 8 + 0] = lo2f(w.x); q[i * 8 + 1] = hi2f(w.x); q[i * 8 + 2] = lo2f(w.y); q[i * 8 + 3] = hi2f(w.y); q[i * 8 + 4] = lo2f(w.z); q[i * 8 + 5] = hi2f(w.z); q[i * 8 + 6] = lo2f(w.w); q[i * 8 + 7] = hi2f(w.w); } }
#pragma unroll
        for (int d = 0; d < 32; ++d) o[d] = 0.f;
        float m = -3.0e38f, ls = 0.f;
        const bf16_t* kb = Kb + (size_t)(b * 8 + h) * NK * 96; const bf16_t* vb = Vb + (size_t)(b * 8 + h) * NK * 64;
        for (int kt = 0; kt < NK / 64; ++kt) {
            for (int i = F.tid; i < 64 * 96 / 8; i += NTH) { const u32x4 w = *(const u32x4*)(kb + (size_t)kt * 64 * 96 + i * 8); LAS float* d = Ks + i * 8;
                d[0] = lo2f(w.x); d[1] = hi2f(w.x); d[2] = lo2f(w.y); d[3] = hi2f(w.y); d[4] = lo2f(w.z); d[5] = hi2f(w.z); d[6] = lo2f(w.w); d[7] = hi2f(w.w); }
            { const int i = F.tid; const u32x4 w = *(const u32x4*)(vb + (size_t)kt * 64 * 64 + i * 8); LAS float* d = Vs + i * 8;
                d[0] = lo2f(w.x); d[1] = hi2f(w.x); d[2] = lo2f(w.y); d[3] = hi2f(w.y); d[4] = lo2f(w.z); d[5] = hi2f(w.z); d[6] = lo2f(w.w); d[7] = hi2f(w.w); }
            __syncthreads();
            for (int jb = 0; jb < 16; ++jb) {
                float s[4]; float mx = m;
#pragma unroll
                for (int jj = 0; jj < 4; ++jj) { const LAS float* kr = Ks + (jb * 4 + jj) * 96 + hf * 48; float a = 0.f;
#pragma unroll
                    for (int d = 0; d < 48; d += 4) { const f32x4 kv = *(const LAS f32x4*)(kr + d); a += q[d] * kv[0] + q[d + 1] * kv[1] + q[d + 2] * kv[2] + q[d + 3] * kv[3]; }
                    a += __shfl_xor(a, 1);
                    s[jj] = a; mx = fmaxf(mx, a); }
                const float sc = exp2f(m - mx); ls *= sc;
#pragma unroll
                for (int d = 0; d < 32; ++d) o[d] *= sc;
                m = mx;
#pragma unroll
                for (int jj = 0; jj < 4; ++jj) { const float p = exp2f(s[jj] - mx); ls += p; const LAS float* vr = Vs + (jb * 4 + jj) * 64 + hf * 32;
#pragma unroll
                    for (int d = 0; d < 32; d += 4) { const f32x4 vv = *(const LAS f32x4*)(vr + d); o[d] += p * vv[0]; o[d + 1] += p * vv[1]; o[d + 2] += p * vv[2]; o[d + 3] += p * vv[3]; } }
            }
            __syncthreads();
        }
        const float inv = 1.f / ls;
        bf16_t* dst = CAT + trow * 1024 + 512 + h * 64 + hf * 32;
#pragma unroll
        for (int i = 0; i < 4; ++i) { u32x4 w; w.x = pack2(o[i * 8] * inv, o[i * 8 + 1] * inv); w.y = pack2(o[i * 8 + 2] * inv, o[i * 8 + 3] * inv); w.z = pack2(o[i * 8 + 4] * inv, o[i * 8 + 5] * inv); w.w = pack2(o[i * 8 + 6] * inv, o[i * 8 + 7] * inv);
            *(u32x4*)(dst + i * 8) = w; }
    }
}

__device__ __forceinline__ void ph_attn(const Frame& F) {
    constexpr int NK = SEQ + CTXL, NT = NK / 64;
    constexpr int KROWB = 208, VROWB = 144, KBYTES = 64 * KROWB, VBYTES = 64 * VROWB, BUFB = KBYTES + VBYTES;
    const bf16_t* Q = (const bf16_t*)(F.ws + WS_WMOE);
    const bf16_t* Kb = (const bf16_t*)(F.ws + WS_R2 + R2_K); const bf16_t* Vb = (const bf16_t*)(F.ws + WS_R2 + R2_V);
    bf16_t* CAT = (bf16_t*)(F.ws + WS_ACT);
    const int l31 = F.lane & 31, hh = F.lane >> 5;
    const int vcu = (F.G % 8 == 0) ? (F.bid % 8) * (F.G / 8) + F.bid / 8 : F.bid;
    const int kc0 = F.tid, kc1 = F.tid + 512;
    const unsigned kd0 = (unsigned)((kc0 / 12) * KROWB + (kc0 % 12) * 16), kd1 = (unsigned)((kc1 / 12) * KROWB + (kc1 % 12) * 16);
    const int vkey = F.tid >> 3, vpos = (vkey & ~12) | ((vkey & 4) << 1) | ((vkey & 8) >> 1);
    const unsigned vd = (unsigned)(((F.tid & 7) * 8) * VROWB + vpos * 2);
    for (int u = vcu; u < 2048; u += F.G) {
        const int bh = u >> 5, qblk = u & 31, b = bh >> 3, h = bh & 7;
        const size_t trow = (size_t)b * SEQ + qblk * 256 + F.wave * 32 + l31;
        s16x8 qf[6];
        { const bf16_t* qp = Q + trow * 768 + h * 96 + hh * 8;
#pragma unroll
          for (int ds = 0; ds < 6; ++ds) qf[ds] = *(const s16x8*)(qp + ds * 16); }
        f32x16 o0, o1;
#pragma unroll
        for (int i = 0; i < 16; ++i) { o0[i] = 0.f; o1[i] = 0.f; }
        float m = -1.0e30f, lsum = 0.f;
        const bf16_t* kg = Kb + (size_t)bh * NK * 96; const bf16_t* vg = Vb + (size_t)bh * NK * 64;
        u32x4 kr0, kr1 = {0u, 0u, 0u, 0u}, vr;
        kr0 = *(const u32x4*)(kg + (size_t)kc0 * 8); if (kc1 < 768) kr1 = *(const u32x4*)(kg + (size_t)kc1 * 8); vr = *(const u32x4*)(vg + (size_t)F.tid * 8);
        __syncthreads();
        for (int t = 0; t < NT; ++t) {
            { LAS unsigned char* kbuf = F.lds + (t & 1) * BUFB; LAS unsigned char* vbuf = kbuf + KBYTES;
              *(LAS u32x4*)(kbuf + kd0) = kr0; if (kc1 < 768) *(LAS u32x4*)(kbuf + kd1) = kr1;
              LAS unsigned short* vp = (LAS unsigned short*)(vbuf + vd);
              vp[0 * (VROWB / 2)] = (unsigned short)(vr.x & 0xffffu); vp[1 * (VROWB / 2)] = (unsigned short)(vr.x >> 16);
              vp[2 * (VROWB / 2)] = (unsigned short)(vr.y & 0xffffu); vp[3 * (VROWB / 2)] = (unsigned short)(vr.y >> 16);
              vp[4 * (VROWB / 2)] = (unsigned short)(vr.z & 0xffffu); vp[5 * (VROWB / 2)] = (unsigned short)(vr.z >> 16);
              vp[6 * (VROWB / 2)] = (unsigned short)(vr.w & 0xffffu); vp[7 * (VROWB / 2)] = (unsigned short)(vr.w >> 16); }
            __syncthreads();
            if (t + 1 < NT) { const bf16_t* kt = kg + (size_t)(t + 1) * 64 * 96; const bf16_t* vt = vg + (size_t)(t + 1) * 64 * 64;
                kr0 = *(const u32x4*)(kt + (size_t)kc0 * 8); if (kc1 < 768) kr1 = *(const u32x4*)(kt + (size_t)kc1 * 8); vr = *(const u32x4*)(vt + (size_t)F.tid * 8); }
            const LAS unsigned char* kbuf = F.lds + (t & 1) * BUFB; const LAS unsigned char* vbuf = kbuf + KBYTES;
            f32x16 s0, s1;
#pragma unroll
            for (int i = 0; i < 16; ++i) { s0[i] = 0.f; s1[i] = 0.f; }
#pragma unroll
            for (int ds = 0; ds < 6; ++ds) {
                const s16x8 a0 = *(const LAS s16x8*)(kbuf + l31 * KROWB + ds * 32 + hh * 16);
                const s16x8 a1 = *(const LAS s16x8*)(kbuf + (32 + l31) * KROWB + ds * 32 + hh * 16);
                s0 = __builtin_amdgcn_mfma_f32_32x32x16_bf16(a0, qf[ds], s0, 0, 0, 0);
                s1 = __builtin_amdgcn_mfma_f32_32x32x16_bf16(a1, qf[ds], s1, 0, 0, 0);
            }
            float mx = s0[0];
#pragma unroll
            for (int i = 1; i < 16; ++i) mx = fmaxf(mx, s0[i]);
#pragma unroll
            for (int i = 0; i < 16; ++i) mx = fmaxf(mx, s1[i]);
            mx = fmaxf(mx, __shfl_xor(mx, 32));
            const float mn = fmaxf(m, mx); const bool moved = __any(mn > m); const float alpha = __builtin_amdgcn_exp2f(m - mn); m = mn;
            float ps = 0.f;
#pragma unroll
            for (int i = 0; i < 16; ++i) { s0[i] = __builtin_amdgcn_exp2f(s0[i] - mn); s1[i] = __builtin_amdgcn_exp2f(s1[i] - mn); ps += s0[i] + s1[i]; }
            lsum = lsum * alpha + ps;
            if (moved) {
#pragma unroll
                for (int i = 0; i < 16; ++i) { o0[i] *= alpha; o1[i] *= alpha; } }
#pragma unroll
            for (int kb = 0; kb < 2; ++kb)
#pragma unroll
                for (int st = 0; st < 2; ++st) {
                    u32x4 pw;
                    if (kb == 0) { pw.x = pack2(s0[8 * st + 0], s0[8 * st + 1]); pw.y = pack2(s0[8 * st + 2], s0[8 * st + 3]); pw.z = pack2(s0[8 * st + 4], s0[8 * st + 5]); pw.w = pack2(s0[8 * st + 6], s0[8 * st + 7]); }
                    else         { pw.x = pack2(s1[8 * st + 0], s1[8 * st + 1]); pw.y = pack2(s1[8 * st + 2], s1[8 * st + 3]); pw.z = pack2(s1[8 * st + 4], s1[8 * st + 5]); pw.w = pack2(s1[8 * st + 6], s1[8 * st + 7]); }
                    const s16x8 pf = __builtin_bit_cast(s16x8, pw);
                    const int kof = (kb * 32 + 16 * st + 8 * hh) * 2;
                    o0 = __builtin_amdgcn_mfma_f32_32x32x16_bf16(*(const LAS s16x8*)(vbuf + l31 * VROWB + kof), pf, o0, 0, 0, 0);
                    o1 = __builtin_amdgcn_mfma_f32_32x32x16_bf16(*(const LAS s16x8*)(vbuf + (32 + l31) * VROWB + kof), pf, o1, 0, 0, 0);
                }
        }
        const float ltot = lsum + __shfl_xor(lsum, 32); const float inv = 1.f / ltot;
        bf16_t* dst = CAT + trow * 1024 + 512 + h * 64 + hh * 4;
#pragma unroll
        for (int g = 0; g < 4; ++g) { u32x2 w;
            w.x = pack2(o0[4 * g] * inv, o0[4 * g + 1] * inv); w.y = pack2(o0[4 * g + 2] * inv, o0[4 * g + 3] * inv); *(u32x2*)(dst + g * 8) = w;
            w.x = pack2(o1[4 * g] * inv, o1[4 * g + 1] * inv); w.y = pack2(o1[4 * g + 2] * inv, o1[4 * g + 3] * inv); *(u32x2*)(dst + 32 + g * 8) = w; }
    }
    __syncthreads();
}

__device__ __forceinline__ void ph_gdn(const Frame& F) {
    const Params& P = *F.P;
    const bf16_t* PX = (const bf16_t*)(F.ws + WS_PX);
    LAS bf16_t* rq = (LAS bf16_t*)F.lds;
    LAS bf16_t* rk = rq + 36 * 128;
    LAS bf16_t* rv = rk + 36 * 128;
    LAS float* qc = (LAS float*)(F.lds + 24576);
    LAS float* kc = qc + 4096;
    LAS float* vc = kc + 4096;
    LAS float* os = vc + 1024;
    LAS float* ba = os + 1024;
    const int dg = F.lane & 15, el = F.wave * 4 + (F.lane >> 4);
    for (int it = F.bid; it < 256; it += F.G) {
        const int b = it >> 5, h = (it >> 3) & 3, dir = (it >> 2) & 1, sl = it & 3;
        bf16_t* O = dir ? (bf16_t*)(F.ws + WS_WMOE) : (bf16_t*)(F.ws + WS_GOF);
        const float a_neg = -__expf(P.in[I_ALOG][dir * 4 + h]), dtb = P.in[I_DTB][dir * 4 + h];
        float cwq[5], cwk[5], cwv[5];
        { const int d = F.tid & 127;
#pragma unroll
          for (int j = 0; j < 5; ++j) { cwq[j] = P.in[I_CONVW][j * 1536 + h * 128 + d]; cwk[j] = P.in[I_CONVW][j * 1536 + 512 + h * 128 + d]; cwv[j] = P.in[I_CONVW][j * 1536 + 1024 + h * 128 + sl * 32 + (F.tid & 31)]; } }
        float S[8];
#pragma unroll
        for (int i = 0; i < 8; ++i) S[i] = 0.f;
        u32x4 pr0, pr1, pr2; float pbeta = 0.f, pdec = 0.f;
        auto blk_geom = [&](int bi, int& len, size_t& rbase, int& p0) { const bool c = bi < 8; len = c ? CTXL : SEQ; rbase = c ? (size_t)TL + b * CTXL : (size_t)b * SEQ;
            const int nbk = len / 32, k = c ? bi : bi - 8; p0 = (dir ? (nbk - 1 - k) : k) * 32; };
        auto fetch = [&](int bi, int id) -> u32x4 { int len, p0; size_t rbase; blk_geom(bi, len, rbase, p0);
            u32x4 z = {0u, 0u, 0u, 0u}; if (id >= 1296) return z;
            int arr = 0, j = id; if (j >= 1152) { arr = 2; j -= 1152; } else if (j >= 576) { arr = 1; j -= 576; }
            const int rr = arr == 2 ? (j >> 2) : (j >> 4), part = arr == 2 ? (j & 3) : (j & 15); const int p = p0 - 2 + rr;
            if (p < 0 || p >= len) return z;
            const bf16_t* row = PX + (rbase + p) * ODD_PAD + (arr == 0 ? h * 128 : (arr == 1 ? 512 + h * 128 : 1024 + h * 128 + sl * 32)) + part * 8;
            return *(const u32x4*)row; };
        auto stash = [&](int id, u32x4 w) { if (id >= 1296) return; int arr = 0, j = id; if (j >= 1152) { arr = 2; j -= 1152; } else if (j >= 576) { arr = 1; j -= 576; }
            LAS bf16_t* d = arr == 0 ? rq + j * 8 : (arr == 1 ? rk + j * 8 : rv + j * 8); *(LAS u32x4*)d = w; };
        auto fetch_all = [&](int bi) { pr0 = fetch(bi, F.tid); pr1 = fetch(bi, F.tid + 512); pr2 = fetch(bi, F.tid + 1024);
            if (F.tid < 32) { int len, p0; size_t rbase; blk_geom(bi, len, rbase, p0); const bf16_t* row = PX + (rbase + p0 + F.tid) * ODD_PAD;
                pbeta = bf2f(row[2048 + dir * 4 + h]); pdec = bf2f(row[2056 + dir * 4 + h]); } };
        fetch_all(0);
        for (int bi = 0; bi < 264; ++bi) {
            __syncthreads();
            stash(F.tid, pr0); stash(F.tid + 512, pr1); stash(F.tid + 1024, pr2);
            if (F.tid < 32) { ba[F.tid] = sigmoid_f(pbeta); ba[32 + F.tid] = __expf(a_neg * softplus_f(pdec + dtb)); }
            __syncthreads();
            if (bi + 1 < 264) fetch_all(bi + 1);
            { const int d = F.tid & 127;
#pragma unroll
              for (int i = 0; i < 8; ++i) { const int s = (F.tid >> 7) + i * 4; float a = 0.f, c = 0.f;
#pragma unroll
                for (int j = 0; j < 5; ++j) { a += bf2f(rq[(s + j) * 128 + d]) * cwq[j]; c += bf2f(rk[(s + j) * 128 + d]) * cwk[j]; }
                qc[s * 128 + d] = silu_f(a); kc[s * 128 + d] = silu_f(c); }
#pragma unroll
              for (int i = 0; i < 2; ++i) { const int s = (F.tid >> 5) + i * 16, e = F.tid & 31; float a = 0.f;
#pragma unroll
                for (int j = 0; j < 5; ++j) a += bf2f(rv[(s + j) * 32 + e]) * cwv[j];
                vc[s * 32 + e] = silu_f(a); } }
            __syncthreads();
            { const int s = F.wave * 4 + (F.lane >> 4);
              LAS float* qp = qc + s * 128 + dg * 8; LAS float* kp = kc + s * 128 + dg * 8;
              f32x4 q0 = *(LAS f32x4*)qp, q1 = *(LAS f32x4*)(qp + 4), k0 = *(LAS f32x4*)kp, k1 = *(LAS f32x4*)(kp + 4);
              float sq = 0.f, sk = 0.f;
#pragma unroll
              for (int i = 0; i < 4; ++i) { sq += q0[i] * q0[i] + q1[i] * q1[i]; sk += k0[i] * k0[i] + k1[i] * k1[i]; }
              sq = sum16(sq); sk = sum16(sk);
              const float rq_ = rsqrtf(sq + EPS) * 0.08838834764831845f, rk_ = rsqrtf(sk + EPS);
              *(LAS f32x4*)qp = q0 * rq_; *(LAS f32x4*)(qp + 4) = q1 * rq_; *(LAS f32x4*)kp = k0 * rk_; *(LAS f32x4*)(kp + 4) = k1 * rk_; }
            __syncthreads();
#pragma unroll 2
            for (int ss = 0; ss < 32; ++ss) {
                const int st = dir ? 31 - ss : ss;
                const f32x4 ka = *(const LAS f32x4*)(kc + st * 128 + dg * 8), kb = *(const LAS f32x4*)(kc + st * 128 + dg * 8 + 4);
                const f32x4 qa = *(const LAS f32x4*)(qc + st * 128 + dg * 8), qb = *(const LAS f32x4*)(qc + st * 128 + dg * 8 + 4);
                const float v = vc[st * 32 + el], beta = ba[st], a = ba[32 + st];
                float r0 = 0.f, r1 = 0.f;
#pragma unroll
                for (int i = 0; i < 4; ++i) { r0 += ka[i] * S[i]; r1 += kb[i] * S[4 + i]; }
                const float r = sum16(r0 + r1);
                const float u = beta * (v - a * r);
                float p0 = 0.f, p1 = 0.f;
#pragma unroll
                for (int i = 0; i < 4; ++i) { S[i] = a * S[i] + ka[i] * u; p0 += qa[i] * S[i]; S[4 + i] = a * S[4 + i] + kb[i] * u; p1 += qb[i] * S[4 + i]; }
                const float o = sum16(p0 + p1);
                if (dg == 0) os[st * 32 + el] = o;
            }
            __syncthreads();
            { int len, p0; size_t rbase; blk_geom(bi, len, rbase, p0);
              const int s = F.tid >> 4, e2 = (F.tid & 15) * 2;
              *(unsigned*)(O + (rbase + p0 + s) * 512 + h * 128 + sl * 32 + e2) = pack2(os[s * 32 + e2], os[s * 32 + e2 + 1]); }
        }
        __syncthreads();
    }
}

constexpr int GR_KN = 0, GR_QN = 16384, GR_VT = 32768, GR_T = 49152, GR_QK = 65536, GR_SC = 81920, GR_BYTES = 83968;
__device__ __forceinline__ s16x8 pack8(const f32x16& x, int s8) {
    u32x4 p; p.x = pack2(x[s8 + 0], x[s8 + 1]); p.y = pack2(x[s8 + 2], x[s8 + 3]); p.z = pack2(x[s8 + 4], x[s8 + 5]); p.w = pack2(x[s8 + 6], x[s8 + 7]);
    return __builtin_bit_cast(s16x8, p);
}
__device__ __forceinline__ s16x8 ld2x64(const LAS unsigned char* p) {
    const u32x2 a = *(const LAS u32x2*)p, b = *(const LAS u32x2*)(p + 16); u32x4 v; v.x = a.x; v.y = a.y; v.z = b.x; v.w = b.y; return __builtin_bit_cast(s16x8, v);
}
__device__ __forceinline__ void st2x64(LAS unsigned char* p, u32x4 v) { u32x2 a, b; a.x = v.x; a.y = v.y; b.x = v.z; b.y = v.w; *(LAS u32x2*)p = a; *(LAS u32x2*)(p + 8) = b; }
__device__ __forceinline__ u32x4 ld2x64n(const LAS unsigned char* p) { const u32x2 a = *(const LAS u32x2*)p, b = *(const LAS u32x2*)(p + 8); u32x4 v; v.x = a.x; v.y = a.y; v.z = b.x; v.w = b.y; return v; }
__device__ __forceinline__ void gdn_unit_geom(int b, int ck, size_t& rbase, int& len, int& p0) {
    if (ck < 4) { rbase = (size_t)TL + b * CTXL; len = CTXL; p0 = ck * 64; } else { rbase = (size_t)b * SEQ; len = SEQ; p0 = (ck - 4) * 64; }
}
__device__ __forceinline__ void ph_gdn_prep(const Frame& F) {
    const Params& P = *F.P;
    const bf16_t* PX = (const bf16_t*)(F.ws + WS_PX);
    LAS unsigned char* L = F.lds;
    LAS bf16_t* RAW = (LAS bf16_t*)L;
    LAS unsigned char* KNI = L; LAS unsigned char* QNI = L + 16896;
    LAS float* qf = (LAS float*)(L + 52224);
    LAS float* kf = qf + 8192;
    LAS unsigned char* VTI = L + 52224 + 65536;
    LAS float* SCL = (LAS float*)(L + 52224 + 65536 + 17408);
    const int l31 = F.lane & 31, hh = F.lane >> 5;
    for (int u = F.bid; u < 4224; u += F.G) {
        const int b = u / 528, h = (u % 528) / 132, ck = u % 132;
        size_t rbase; int len, p0; gdn_unit_geom(b, ck, rbase, len, p0);
        unsigned char* rec = F.ws + WS_GREC + (size_t)u * GR_BYTES;
        for (int c = F.tid; c < 68 * 48; c += NTH) { const int rr = c / 48, part = c % 48; const int p = p0 - 2 + rr; u32x4 w = {0u, 0u, 0u, 0u};
            if (p >= 0 && p < len) w = *(const u32x4*)(PX + (rbase + p) * ODD_PAD + (part >> 4) * 512 + h * 128 + (part & 15) * 8);
            *(LAS u32x4*)(RAW + rr * 384 + part * 8) = w; }
        if (F.tid < 64) { const bf16_t* row = PX + (rbase + p0 + F.tid) * ODD_PAD;
            const float an_f = -__expf(P.in[I_ALOG][h]), an_b = -__expf(P.in[I_ALOG][4 + h]);
            SCL[256 + F.tid] = sigmoid_f(bf2f(row[2048 + h])); SCL[320 + F.tid] = sigmoid_f(bf2f(row[2052 + h]));
            SCL[F.tid] = an_f * softplus_f(bf2f(row[2056 + h]) + P.in[I_DTB][h]); SCL[64 + F.tid] = an_b * softplus_f(bf2f(row[2060 + h]) + P.in[I_DTB][4 + h]); }
        __syncthreads();
        { const int d = F.tid & 127, rg = F.tid >> 7;
          float cq[5], ckk[5], cv[5];
#pragma unroll
          for (int j = 0; j < 5; ++j) { cq[j] = P.in[I_CONVW][j * 1536 + h * 128 + d]; ckk[j] = P.in[I_CONVW][j * 1536 + 512 + h * 128 + d]; cv[j] = P.in[I_CONVW][j * 1536 + 1024 + h * 128 + d]; }
#pragma unroll 4
          for (int ii = 0; ii < 16; ++ii) { const int i = rg * 16 + ii; float a = 0.f, c = 0.f, e = 0.f;
#pragma unroll
              for (int j = 0; j < 5; ++j) { const LAS bf16_t* rr = RAW + (i + j) * 384 + d; a += bf2f(rr[0]) * cq[j]; c += bf2f(rr[128]) * ckk[j]; e += bf2f(rr[256]) * cv[j]; }
              qf[i * 128 + d] = silu_f(a); kf[i * 128 + d] = silu_f(c);
              *(LAS bf16_t*)(VTI + d * 136 + i * 2) = f2bf(silu_f(e)); } }
        if (F.tid < 64) { float gf = 0.f, gb = 0.f;
            for (int j = 0; j < 64; ++j) { gf += (j <= F.tid) ? SCL[j] : 0.f; gb += (j >= F.tid) ? SCL[64 + j] : 0.f; }
            SCL[128 + F.tid] = gf; SCL[192 + F.tid] = gb; }
        __syncthreads();
#pragma unroll
        for (int rr = 0; rr < 8; ++rr) { const int i = F.wave * 8 + rr;
            const float q0 = qf[i * 128 + F.lane], q1 = qf[i * 128 + 64 + F.lane], k0 = kf[i * 128 + F.lane], k1 = kf[i * 128 + 64 + F.lane];
            const float sq = wave_sum(q0 * q0 + q1 * q1), sk = wave_sum(k0 * k0 + k1 * k1);
            const float rq_ = rsqrtf(sq + EPS) * 0.08838834764831845f, rk_ = rsqrtf(sk + EPS);
            *(LAS bf16_t*)(QNI + i * 264 + F.lane * 2) = f2bf(q0 * rq_); *(LAS bf16_t*)(QNI + i * 264 + 128 + F.lane * 2) = f2bf(q1 * rq_);
            *(LAS bf16_t*)(KNI + i * 264 + F.lane * 2) = f2bf(k0 * rk_); *(LAS bf16_t*)(KNI + i * 264 + 128 + F.lane * 2) = f2bf(k1 * rk_); }
        __syncthreads();
        { const int mq = F.wave >> 2, ib = (F.wave >> 1) & 1, jb = F.wave & 1;
          const LAS unsigned char* Ai = (mq ? QNI : KNI) + (32 * ib + l31) * 264 + hh * 16; const LAS unsigned char* Bi = KNI + (32 * jb + l31) * 264 + hh * 16;
          f32x16 acc;
#pragma unroll
          for (int r = 0; r < 16; ++r) acc[r] = 0.f;
#pragma unroll
          for (int ds = 0; ds < 8; ++ds) acc = __builtin_amdgcn_mfma_f32_32x32x16_bf16(__builtin_bit_cast(s16x8, ld2x64n(Ai + ds * 32)), __builtin_bit_cast(s16x8, ld2x64n(Bi + ds * 32)), acc, 0, 0, 0);
          __syncthreads();
          const int j = 32 * jb + l31; const float gfj = SCL[128 + j], gbj = SCL[192 + j];
          bf16_t* qkf = (bf16_t*)(rec + GR_QK); bf16_t* qkb = qkf + 4096;
#pragma unroll
          for (int r = 0; r < 16; ++r) { const int i = 32 * ib + (r & 3) + 8 * (r >> 2) + 4 * hh;
              const float ef = __expf(fminf(SCL[128 + i] - gfj, 0.f)), eb = __expf(fminf(SCL[192 + i] - gbj, 0.f));
              if (mq == 0) { qf[i * 64 + j] = (j < i) ? SCL[256 + i] * acc[r] * ef : 0.f; kf[(63 - i) * 64 + (63 - j)] = (j > i) ? SCL[320 + i] * acc[r] * eb : 0.f; }
              else { qkf[i * 64 + j] = f2bf((j <= i) ? acc[r] * ef : 0.f); qkb[i * 64 + j] = f2bf((j >= i) ? acc[r] * eb : 0.f); } } }
        __syncthreads();
        if (F.wave < 2) {
            const LAS float* Am = F.wave == 0 ? qf : kf; LAS float* Tl = (F.wave == 0 ? qf : kf) + 4096; const int c = F.lane;
            for (int i = 0; i < 64; ++i) Tl[i * 64 + c] = 0.f;
#pragma unroll
            for (int rb = 0; rb < 4; ++rb) {
#pragma unroll 1
                for (int ii = 0; ii < 16; ++ii) { const int i = rb * 16 + ii; float a0 = (c == i) ? 1.f : 0.f, a1 = 0.f;
#pragma unroll
                    for (int jg = 0; jg < 4 * (rb + 1); ++jg) { const f32x4 m = *(const LAS f32x4*)(Am + i * 64 + jg * 4);
                        a0 -= m[0] * Tl[(jg * 4 + 0) * 64 + c]; a1 -= m[1] * Tl[(jg * 4 + 1) * 64 + c]; a0 -= m[2] * Tl[(jg * 4 + 2) * 64 + c]; a1 -= m[3] * Tl[(jg * 4 + 3) * 64 + c]; }
                    Tl[i * 64 + c] = a0 + a1; } }
            bf16_t* Tg = (bf16_t*)(rec + GR_T) + (F.wave ? 4096 : 0);
            for (int i = 0; i < 64; ++i) { const bf16_t v = f2bf(Tl[i * 64 + c]); if (F.wave == 0) Tg[i * 64 + c] = v; else Tg[(63 - i) * 64 + (63 - c)] = v; }
        } else {
            const int t6 = F.tid - 128;
            for (int c = t6; c < 3072; c += 384) {
                u32x4 w; if (c < 2048) { const int cc = c & 1023, row = cc >> 4, part = cc & 15; w = ld2x64n((c < 1024 ? KNI : QNI) + row * 264 + part * 16); }
                else { const int cc = c - 2048, row = cc >> 3, part = cc & 7; w = ld2x64n(VTI + row * 136 + part * 16); }
                *(u32x4*)(rec + (size_t)c * 16) = w; }
            if (t6 < 64) { float* sc = (float*)(rec + GR_SC); const int i = t6;
                const float gf = SCL[128 + i], gb = SCL[192 + i], glf = SCL[128 + 63], glb = SCL[192 + 0];
                sc[i] = SCL[256 + i]; sc[64 + i] = __expf(gf); sc[128 + i] = __expf(glf - gf);
                sc[192 + i] = SCL[320 + i]; sc[256 + i] = __expf(gb); sc[320 + i] = __expf(glb - gb);
                if (i == 0) { sc[384] = __expf(glf); sc[385] = __expf(glb); } }
        }
        __syncthreads();
    }
}

__device__ __forceinline__ void ph_gdn_scan(const Frame& F) {
    LAS unsigned char* L = F.lds;
    LAS unsigned char* KNI = L;
    LAS unsigned char* QNI = L + 16896;
    LAS unsigned char* VTI = L + 33792;
    LAS unsigned char* KTI = L + 51200;
    LAS unsigned char* TI = L + 68608;
    LAS unsigned char* QKI = L + 77312;
    LAS float* SC = (LAS float*)(L + 86016);
    const int l31 = F.lane & 31, hh = F.lane >> 5, w = F.wave;
    for (int it = F.bid; it < 64; it += F.G) {
        const int b = it >> 3, h = (it >> 1) & 3, dir = it & 1;
        bf16_t* O = dir ? (bf16_t*)(F.ws + WS_WMOE) : (bf16_t*)(F.ws + WS_GOF);
        f32x16 S0, S1, S2, S3;
#pragma unroll
        for (int r = 0; r < 16; ++r) { S0[r] = 0.f; S1[r] = 0.f; S2[r] = 0.f; S3[r] = 0.f; }
        u32x4 pre[16]; float psc = 0.f;
        const int t4 = F.tid - 256;
        auto ckof = [&](int n) -> int { return dir ? (n < 4 ? 3 - n : 135 - n) : n; };
        auto fetch = [&](int n) { const unsigned char* rec = F.ws + WS_GREC + (size_t)((b * 4 + h) * 132 + ckof(n)) * GR_BYTES;
#pragma unroll
            for (int k = 0; k < 12; ++k) pre[k] = *(const u32x4*)(rec + (size_t)(t4 + 256 * k) * 16);
#pragma unroll
            for (int k = 0; k < 2; ++k) { pre[12 + k] = *(const u32x4*)(rec + GR_T + dir * 8192 + (t4 + 256 * k) * 16); pre[14 + k] = *(const u32x4*)(rec + GR_QK + dir * 8192 + (t4 + 256 * k) * 16); }
            if (t4 < 193) psc = ((const float*)(rec + GR_SC))[t4 < 192 ? dir * 192 + t4 : 384 + dir]; };
        if (w >= 4) {
            fetch(0);
            for (int n = 0; n < 132; ++n) {
                __syncthreads();
#pragma unroll
                for (int k = 0; k < 4; ++k) { const int c = t4 + 256 * k, row = c >> 4, part = c & 15; st2x64(KNI + row * 264 + part * 16, pre[k]);
                    LAS unsigned short* kt = (LAS unsigned short*)(KTI + (part * 8) * 136 + row * 2); const u32x4 v = pre[k];
                    kt[0 * 68] = (unsigned short)(v.x & 0xffffu); kt[1 * 68] = (unsigned short)(v.x >> 16); kt[2 * 68] = (unsigned short)(v.y & 0xffffu); kt[3 * 68] = (unsigned short)(v.y >> 16);
                    kt[4 * 68] = (unsigned short)(v.z & 0xffffu); kt[5 * 68] = (unsigned short)(v.z >> 16); kt[6 * 68] = (unsigned short)(v.w & 0xffffu); kt[7 * 68] = (unsigned short)(v.w >> 16); }
#pragma unroll
                for (int k = 4; k < 8; ++k) { const int c = t4 + 256 * (k - 4), row = c >> 4, part = c & 15; st2x64(QNI + row * 264 + part * 16, pre[k]); }
#pragma unroll
                for (int k = 8; k < 12; ++k) { const int c = t4 + 256 * (k - 8), row = c >> 3, part = c & 7; st2x64(VTI + row * 136 + part * 16, pre[k]); }
#pragma unroll
                for (int k = 0; k < 2; ++k) { const int c = t4 + 256 * k, row = c >> 3, part = c & 7; st2x64(TI + row * 136 + part * 16, pre[12 + k]); st2x64(QKI + row * 136 + part * 16, pre[14 + k]); }
                if (t4 < 193) SC[t4] = psc;
                __syncthreads();
                if (n + 1 < 132) fetch(n + 1);
            }
        } else
        for (int n = 0; n < 132; ++n) {
            __syncthreads();
            __syncthreads();
            {
                size_t rbase; int len, p0; gdn_unit_geom(b, ckof(n), rbase, len, p0);
                const float alast = SC[192];
                f32x16 P0, P1;
#pragma unroll
                for (int r = 0; r < 16; ++r) { P0[r] = 0.f; P1[r] = 0.f; }
#pragma unroll
                for (int hq = 0; hq < 2; ++hq) { s16x8 fa[4], fb[4];
#pragma unroll
                  for (int q4 = 0; q4 < 4; ++q4) { const int q = hq * 4 + q4; const int co = (32 * (q >> 1) + 16 * (q & 1) + 4 * hh) * 2; fa[q4] = ld2x64(KNI + l31 * 264 + co); fb[q4] = ld2x64(KNI + (32 + l31) * 264 + co); }
#pragma unroll
                  for (int q4 = 0; q4 < 4; ++q4) { const int q = hq * 4 + q4; const int r = q >> 1; const s16x8 sb = pack8(r == 0 ? S0 : (r == 1 ? S1 : (r == 2 ? S2 : S3)), 8 * (q & 1));
                      P0 = __builtin_amdgcn_mfma_f32_32x32x16_bf16(fa[q4], sb, P0, 0, 0, 0); P1 = __builtin_amdgcn_mfma_f32_32x32x16_bf16(fb[q4], sb, P1, 0, 0, 0); } }
#pragma unroll
                for (int gq = 0; gq < 4; ++gq) {
#pragma unroll
                    for (int ib = 0; ib < 2; ++ib) { const int i0 = 32 * ib + 8 * gq + 4 * hh;
                        const f32x4 be = *(const LAS f32x4*)(SC + i0), eg = *(const LAS f32x4*)(SC + 64 + i0);
                        const u32x2 vv = *(const LAS u32x2*)(VTI + (32 * w + l31) * 136 + i0 * 2);
                        const float v0 = lo2f(vv.x), v1 = hi2f(vv.x), v2 = lo2f(vv.y), v3 = hi2f(vv.y);
                        if (ib == 0) { P0[4 * gq + 0] = be[0] * (v0 - eg[0] * P0[4 * gq + 0]); P0[4 * gq + 1] = be[1] * (v1 - eg[1] * P0[4 * gq + 1]); P0[4 * gq + 2] = be[2] * (v2 - eg[2] * P0[4 * gq + 2]); P0[4 * gq + 3] = be[3] * (v3 - eg[3] * P0[4 * gq + 3]); }
                        else         { P1[4 * gq + 0] = be[0] * (v0 - eg[0] * P1[4 * gq + 0]); P1[4 * gq + 1] = be[1] * (v1 - eg[1] * P1[4 * gq + 1]); P1[4 * gq + 2] = be[2] * (v2 - eg[2] * P1[4 * gq + 2]); P1[4 * gq + 3] = be[3] * (v3 - eg[3] * P1[4 * gq + 3]); } } }
                f32x16 V0, V1;
#pragma unroll
                for (int r = 0; r < 16; ++r) { V0[r] = 0.f; V1[r] = 0.f; }
#pragma unroll
                for (int jb = 0; jb < 2; ++jb)
#pragma unroll
                    for (int s = 0; s < 2; ++s) { const s16x8 pb = pack8(jb == 0 ? P0 : P1, 8 * s); const int co = (32 * jb + 16 * s + 4 * hh) * 2;
                        V0 = __builtin_amdgcn_mfma_f32_32x32x16_bf16(ld2x64(TI + l31 * 136 + co), pb, V0, 0, 0, 0);
                        V1 = __builtin_amdgcn_mfma_f32_32x32x16_bf16(ld2x64(TI + (32 + l31) * 136 + co), pb, V1, 0, 0, 0); }
                f32x16 T0, T1;
#pragma unroll
                for (int r = 0; r < 16; ++r) { T0[r] = 0.f; T1[r] = 0.f; }
#pragma unroll
                for (int r = 0; r < 4; ++r)
#pragma unroll
                    for (int s = 0; s < 2; ++s) { const s16x8 sa = pack8(r == 0 ? S0 : (r == 1 ? S1 : (r == 2 ? S2 : S3)), 8 * s);
                        const int co = (32 * r + 16 * s + 4 * hh) * 2;
                        T0 = __builtin_amdgcn_mfma_f32_32x32x16_bf16(sa, ld2x64(QNI + l31 * 264 + co), T0, 0, 0, 0);
                        T1 = __builtin_amdgcn_mfma_f32_32x32x16_bf16(sa, ld2x64(QNI + (32 + l31) * 264 + co), T1, 0, 0, 0); }
                { const float e0 = SC[64 + l31], e1 = SC[64 + 32 + l31];
#pragma unroll
                  for (int r = 0; r < 16; ++r) { T0[r] *= e0; T1[r] *= e1; } }
#pragma unroll
                for (int jb = 0; jb < 2; ++jb)
#pragma unroll
                    for (int s = 0; s < 2; ++s) { const s16x8 va = pack8(jb == 0 ? V0 : V1, 8 * s); const int co = (32 * jb + 16 * s + 4 * hh) * 2;
                        T0 = __builtin_amdgcn_mfma_f32_32x32x16_bf16(va, ld2x64(QKI + l31 * 136 + co), T0, 0, 0, 0);
                        T1 = __builtin_amdgcn_mfma_f32_32x32x16_bf16(va, ld2x64(QKI + (32 + l31) * 136 + co), T1, 0, 0, 0); }
                { bf16_t* o0 = O + (rbase + p0 + l31) * 512 + h * 128 + 32 * w + 4 * hh; bf16_t* o1 = o0 + (size_t)32 * 512;
#pragma unroll
                  for (int gq = 0; gq < 4; ++gq) { u32x2 x; x.x = pack2(T0[4 * gq], T0[4 * gq + 1]); x.y = pack2(T0[4 * gq + 2], T0[4 * gq + 3]); *(u32x2*)(o0 + gq * 8) = x;
                      x.x = pack2(T1[4 * gq], T1[4 * gq + 1]); x.y = pack2(T1[4 * gq + 2], T1[4 * gq + 3]); *(u32x2*)(o1 + gq * 8) = x; } }
#pragma unroll
                for (int gq = 0; gq < 4; ++gq) { const f32x4 c0 = *(const LAS f32x4*)(SC + 128 + 8 * gq + 4 * hh), c1 = *(const LAS f32x4*)(SC + 128 + 32 + 8 * gq + 4 * hh);
#pragma unroll
                    for (int q = 0; q < 4; ++q) { V0[4 * gq + q] *= c0[q]; V1[4 * gq + q] *= c1[q]; } }
#pragma unroll
                for (int r = 0; r < 16; ++r) { S0[r] *= alast; S1[r] *= alast; S2[r] *= alast; S3[r] *= alast; }
#pragma unroll
                for (int hq = 0; hq < 2; ++hq) { s16x8 fk[8];
#pragma unroll
                  for (int q2 = 0; q2 < 2; ++q2) { const int q = hq * 2 + q2; const int co = (32 * (q >> 1) + 16 * (q & 1) + 4 * hh) * 2;
#pragma unroll
                      for (int r = 0; r < 4; ++r) fk[q2 * 4 + r] = ld2x64(KTI + (32 * r + l31) * 136 + co); }
#pragma unroll
                  for (int q2 = 0; q2 < 2; ++q2) { const int q = hq * 2 + q2; const s16x8 vb = pack8((q >> 1) == 0 ? V0 : V1, 8 * (q & 1));
                      S0 = __builtin_amdgcn_mfma_f32_32x32x16_bf16(fk[q2 * 4 + 0], vb, S0, 0, 0, 0); S1 = __builtin_amdgcn_mfma_f32_32x32x16_bf16(fk[q2 * 4 + 1], vb, S1, 0, 0, 0);
                      S2 = __builtin_amdgcn_mfma_f32_32x32x16_bf16(fk[q2 * 4 + 2], vb, S2, 0, 0, 0); S3 = __builtin_amdgcn_mfma_f32_32x32x16_bf16(fk[q2 * 4 + 3], vb, S3, 0, 0, 0); } }
            }
        }
        __syncthreads();
    }
}

#ifndef FAST_ATTN
#define FAST_ATTN 1
#endif
constexpr int NPHASES = 27;
__global__ void __launch_bounds__(NTH, 2) fwd(Params P) {
    extern __shared__ __attribute__((aligned(16))) unsigned char lds_raw[];
    Frame F; F.P = &P; F.ws = P.ws; F.lds = (LAS unsigned char*)lds_raw;
    F.tid = threadIdx.x; F.lane = F.tid & 63; F.wave = __builtin_amdgcn_readfirstlane(F.tid >> 6); F.G = gridDim.x; F.bid = blockIdx.x;
    F.mod = (float*)(P.ws + WS_CTRL + C_MOD); F.ctrl = (unsigned*)(P.ws + WS_CTRL);
    volatile LAS unsigned* xbw = (volatile LAS unsigned*)(F.lds + LDS_BYTES - 16);
    if (F.tid < 4) xbw[F.tid] = 0u;
    __syncthreads();
    const int lo = P.ph_lo, hi = P.ph_hi;
    const bool single = (hi - lo) > 1;
    XcdBarrier bar; bar.bar = F.ctrl; bar.x = 0; bar.st = xbw;
    if (single) bar = xcd_barrier_post(F.ctrl, xbw);
#ifndef PH_MASK
#define PH_MASK 0xffffffffu
#endif
#define IN(k) (((PH_MASK >> (k)) & 1u) && lo <= (k) && (k) < hi)
#define SEAM(k) do { if (IN(k) && IN((k) + 1)) xcd_barrier(bar); } while (0)
#ifndef DUP_MASK
#define DUP_MASK 0u
#endif
#define DUP(k) ((DUP_MASK >> (k)) & 1u)
    bf16_t* wsm = (bf16_t*)(P.ws + WS_WSM);
    bf16_t* ACT = (bf16_t*)(P.ws + WS_ACT); bf16_t* PX = (bf16_t*)(P.ws + WS_PX);
    float* XC = (float*)(P.ws + WS_XC);

    if (IN(0)) { ph_prologue(F); if (DUP(0)) { __syncthreads(); conv_moe_weights(F, 0, F.bid, F.G); } xcd_barrier(bar); mod_reduce(F); } SEAM(0);
    if (IN(1)) { ph_rownorm(F, 0, TT, P.in[I_X], P.in[I_CTX], P.in[I_NMIX], 0); if (DUP(1)) ph_rownorm(F, 0, TT, P.in[I_X], P.in[I_CTX], P.in[I_NMIX], 0); } SEAM(1);
    if (IN(2)) { EpiStoreBf16 E{PX, EVEN_IN, 1024}; gemm_dense(F, ACT, wsm + W_EIN / 2, TT, EVEN_IN, 1024, E); if (DUP(2)) gemm_dense(F, ACT, wsm + W_EIN / 2, TT, EVEN_IN, 1024, E); } SEAM(2);
    if (IN(3)) { ph_gmlp_mfma(F); __syncthreads(); }
#ifndef CHUNKED_GLA
#define CHUNKED_GLA 1
#endif
    if (IN(4)) { if (CHUNKED_GLA) ph_gla_p1(F); else ph_gla(F); } SEAM(4);
    if (IN(5)) { if (CHUNKED_GLA) { ph_gla_p2(F); xcd_barrier(bar); ph_gla_p3(F); } else ph_merge(F, 0); } SEAM(5);
    if (IN(6)) { EpiResidual E{P.in[I_X], P.in[I_CTX], P.out, XC, F.mod, 2}; gemm_dense(F, ACT, wsm + W_EOUT / 2, TT, 1024, 1024, E); } SEAM(6);
    if (IN(7)) { ph_router(F, 0, TT, P.out, XC, P.in[I_NFFN], 3); } SEAM(7);
    if (IN(8)) { ph_dispatch(F, 0, TT); } SEAM(8);
    if (IN(9)) { ph_moe_gemm1(F, 0); if (DUP(9)) ph_moe_gemm1(F, 0); } SEAM(9);
    if (IN(10)) { ph_moe_gemm2(F, 0, 0); } SEAM(10);
    if (IN(11)) { ph_moe_gemm2(F, 0, 1); } SEAM(11);
    if (IN(12)) { ph_rownorm(F, 1, TT, P.out, XC, P.in[I_NMIX] + 1024, 0);
#ifdef DBG_ZERO
        { u32x4 z = {0u, 0u, 0u, 0u}; u32x4* p = (u32x4*)(P.ws + WS_GREC); const size_t n = (size_t)(990 - 585) * MiB / 16;
          for (size_t i = (size_t)gtid(F); i < n; i += (size_t)F.G * NTH) p[i] = z;
          u32x4* q = (u32x4*)(P.ws + WS_WMOE); const size_t m = (size_t)66 * MiB / 16;
          for (size_t i = (size_t)gtid(F); i < m; i += (size_t)F.G * NTH) q[i] = z; }
#endif
    } SEAM(12);
    if (IN(13)) { EpiStoreBf16 E{PX, ODD_PAD, 0}; gemm_dense(F, ACT, wsm + W_OIN / 2, TT, ODD_PAD, 1024, E); if (DUP(13)) gemm_dense(F, ACT, wsm + W_OIN / 2, TT, ODD_PAD, 1024, E); } SEAM(13);
#ifndef CHUNKED_GDN
#define CHUNKED_GDN 1
#endif
    if (IN(14)) { if (CHUNKED_GDN) ph_gdn_prep(F); } SEAM(14);
    if (IN(15)) { if (CHUNKED_GDN) ph_gdn_scan(F); else ph_gdn(F); } SEAM(15);
    if (IN(16)) { ph_merge(F, 1); ph_mla_norm(F); } SEAM(16);
    if (IN(17)) { }
    if (IN(18)) { const bf16_t* cqn = (const bf16_t*)(P.ws + WS_R2 + R2_CQN);
                  EpiStoreBf16 E1{(bf16_t*)(P.ws + WS_WMOE), 768, 0}; gemm_dense(F, cqn, wsm + W_WQ / 2, TL, 768, 256, E1);
                  EpiStoreBf16 E2{(bf16_t*)(P.ws + WS_PX + PX_KVRAW), 1024, 0}; gemm_dense(F, cqn + (size_t)TL * 256, wsm + W_WKV / 2, TT, 1024, 256, E2); } SEAM(18);
    if (IN(19)) { ph_mla_final(F); } SEAM(19);
    if (IN(20)) { if (FAST_ATTN) ph_attn(F); else ph_attn_naive(F); if (DUP(20)) { __syncthreads(); ph_attn(F); } } SEAM(20);
    if (IN(21)) { EpiResidual E{P.out, P.out, P.out, P.out, F.mod + 9 * 6144, 2}; gemm_dense(F, ACT, wsm + W_OOUT / 2, TL, 1024, 1024, E); } SEAM(21);
    if (IN(22)) { ph_router(F, 1, TL, P.out, XC, P.in[I_NFFN] + 1024, 3); conv_moe_weights(F, 1, F.bid, F.G); } SEAM(22);
    if (IN(23)) { ph_dispatch(F, 1, TL); } SEAM(23);
    if (IN(24)) { ph_moe_gemm1(F, 1); if (DUP(24)) ph_moe_gemm1(F, 1); } SEAM(24);
    if (IN(25)) { ph_moe_gemm2(F, 1, 0); } SEAM(25);
    if (IN(26)) { ph_moe_gemm2(F, 1, 1); }
#undef IN
#undef SEAM
}

#ifndef N_LAUNCH_MODE
#define N_LAUNCH_MODE 1
#endif
extern "C" void kernel_launch(void* const* d_in, const int* in_sizes, int n_in, void* d_out, int out_size, void* d_ws, size_t ws_size, hipStream_t stream) {
    static int grid = 0;
    if (grid == 0) {
        if (n_in != 34 || out_size != TL * DM || ws_size < WS_END) { fprintf(stderr, "kernel_launch: unexpected shapes (n_in %d out %d ws %zu)\n", n_in, out_size, ws_size); grid = -1; return; }
        int dev = 0, cus = 0;
        if (hipGetDevice(&dev) != hipSuccess || hipDeviceGetAttribute(&cus, hipDeviceAttributeMultiprocessorCount, dev) != hipSuccess) { grid = -1; return; }
        if (hipFuncSetAttribute((const void*)fwd, hipFuncAttributeMaxDynamicSharedMemorySize, LDS_BYTES) != hipSuccess) { fprintf(stderr, "kernel_launch: hipFuncSetAttribute failed\n"); grid = -1; return; }
        int per_cu = 0;
        (void)hipOccupancyMaxActiveBlocksPerMultiprocessor(&per_cu, (const void*)fwd, NTH, LDS_BYTES);
        (void)hipGetLastError();
        if (per_cu < 1) fprintf(stderr, "kernel_launch: occupancy query says %d\n", per_cu);
        grid = cus;
    }
    if (grid < 0) return;
    (void)hipMemsetAsync(d_ws, 0, MiB, stream);
    Params p{};
    for (int i = 0; i < 34; ++i) p.in[i] = (const float*)d_in[i];
    p.out = (float*)d_out; p.ws = (unsigned char*)d_ws;
#if N_LAUNCH_MODE == 1
    p.ph_lo = 0; p.ph_hi = NPHASES;
    hipLaunchKernelGGL(fwd, dim3(grid), dim3(NTH), LDS_BYTES, stream, p);
#else
    for (int k = 0; k < NPHASES; ++k) { p.ph_lo = k; p.ph_hi = k + 1; hipLaunchKernelGGL(fwd, dim3(grid), dim3(NTH), LDS_BYTES, stream, p); }
#endif
}
```

```cpp
#include <hip/hip_runtime.h>
#include <cstdint>
#include <cstdio>

#define LAS __attribute__((address_space(3)))
typedef unsigned short bf16_t;
typedef float f32x4 __attribute__((ext_vector_type(4)));
typedef unsigned u32x4 __attribute__((ext_vector_type(4)));
typedef unsigned u32x2 __attribute__((ext_vector_type(2)));
typedef float f32x16 __attribute__((ext_vector_type(16)));
typedef short s16x8 __attribute__((ext_vector_type(8)));

constexpr int NB = 8, SEQ = 8192, CTXL = 256, DM = 1024;
constexpr int TL = NB * SEQ, TC = NB * CTXL, TT = TL + TC;
constexpr int EVEN_IN = 3584, ODD_IN = 2480, ODD_PAD = 2560;
constexpr int NTH = 512;
constexpr int LDS_BYTES = 144 * 1024;
constexpr int MAXSLOTS = 151552;
constexpr int MAXTILES = 592;
constexpr float EPS = 1e-6f;

constexpr size_t MiB = 1048576;
constexpr size_t WS_CTRL = 0;
constexpr size_t C_MOE = 16384;
constexpr size_t C_MOD = 65536;
constexpr size_t WS_XC = 1 * MiB;
constexpr size_t WS_WSM = 9 * MiB;
constexpr size_t W_EIN = 0, W_EOUT = 7340032, W_OIN = 9437184, W_OOUT = 14680064, W_WQ = 16777216, W_WKV = 17170432, W_RT = 17694720;
constexpr size_t WS_WMOE = 27 * MiB;
constexpr size_t WS_ACT = 123 * MiB;
constexpr size_t WS_PX = 255 * MiB;
constexpr size_t WS_R2 = 717 * MiB;
constexpr size_t WS_END = 1024 * MiB;
constexpr size_t R2_OF0 = 0, R2_OB0 = 66 * MiB;
constexpr size_t R2_H = 0, R2_STOK = 148 * MiB, R2_SW = 149 * MiB, R2_TOKE = 150 * MiB, R2_TOKW = 151 * MiB, R2_TILEE = 152 * MiB, R2_TSLOT = 153 * MiB;
constexpr size_t R2_K = 0, R2_V = 99 * MiB, R2_OF1 = 165 * MiB, R2_OB1 = 231 * MiB;
constexpr size_t PX_KVRAW = 346030080;
constexpr size_t WS_GREC = 585 * MiB;
constexpr size_t WS_GOF = 924 * MiB;
constexpr size_t R2_CQN = 0;
constexpr size_t R2_MODP = 200 * MiB;

struct Params {
    const float* in[34];
    float* out;
    unsigned char* ws;
    int ph_lo, ph_hi;
};
enum { I_X = 0, I_C, I_CTX, I_CCTX, I_ADAW, I_ADAB, I_NMIX, I_NFFN, I_EWIN, I_EWOUT, I_GNW, I_GWS, I_GBS, I_LB, I_HNW,
       I_OWIN, I_OWOUT, I_CONVW, I_ALOG, I_DTB, I_GDNNW, I_QNW, I_WQ, I_KVNW, I_WKV, I_QKQ, I_QKK, I_RGW, I_RGB, I_REW, I_REB, I_MG, I_MU, I_MD };

__device__ __forceinline__ float bf2f(bf16_t b) { return __uint_as_float(((unsigned)b) << 16); }
__device__ __forceinline__ bf16_t f2bf(float f) { unsigned u = __float_as_uint(f); u += 0x7FFFu + ((u >> 16) & 1u); return (bf16_t)(u >> 16); }
typedef __bf16 bf16_2v __attribute__((ext_vector_type(2)));
typedef float f32_2v __attribute__((ext_vector_type(2)));
__device__ __forceinline__ unsigned pack2(float a, float b) { f32_2v v = {a, b}; bf16_2v r = __builtin_convertvector(v, bf16_2v); return __builtin_bit_cast(unsigned, r); }
__device__ __forceinline__ float lo2f(unsigned u) { return __uint_as_float(u << 16); }
__device__ __forceinline__ float hi2f(unsigned u) { return __uint_as_float(u & 0xffff0000u); }
template <int CTRL> __device__ __forceinline__ float dppf(float x) { return __builtin_bit_cast(float, __builtin_amdgcn_mov_dpp(__builtin_bit_cast(int, x), CTRL, 0xf, 0xf, true)); }
__device__ __forceinline__ float sum8(float v) { v += dppf<0xB1>(v); v += dppf<0x4E>(v); v += dppf<0x141>(v); return v; }
__device__ __forceinline__ float sum16(float v) { v = sum8(v); v += dppf<0x128>(v); return v; }
__device__ __forceinline__ float wave_sum(float v) {
    v = sum16(v);
    auto s = __builtin_amdgcn_permlane16_swap(__float_as_uint(v), __float_as_uint(v), false, false);
    v = __uint_as_float(s[0]) + __uint_as_float(s[1]);
    auto t = __builtin_amdgcn_permlane32_swap(__float_as_uint(v), __float_as_uint(v), false, false);
    return __uint_as_float(t[0]) + __uint_as_float(t[1]);
}
__device__ __forceinline__ s16x8 pack8(const f32x16& x, int s8) {
    u32x4 p; p.x = pack2(x[s8 + 0], x[s8 + 1]); p.y = pack2(x[s8 + 2], x[s8 + 3]); p.z = pack2(x[s8 + 4], x[s8 + 5]); p.w = pack2(x[s8 + 6], x[s8 + 7]);
    return __builtin_bit_cast(s16x8, p);
}
__device__ __forceinline__ unsigned lds_inc(LAS unsigned* p) { return __hip_atomic_fetch_add(p, 1u, __ATOMIC_RELAXED, __HIP_MEMORY_SCOPE_WORKGROUP); }
__device__ __forceinline__ float sigmoid_f(float x) { return 1.f / (1.f + __expf(-x)); }
__device__ __forceinline__ float silu_f(float x) { return x / (1.f + __expf(-x)); }
__device__ __forceinline__ float gelu_tanh_f(float x) {
    const float u = 0.7978845608028654f * (x + 0.044715f * x * x * x);
    const float t = 1.f - 2.f / (__expf(2.f * u) + 1.f);
    return 0.5f * x * (1.f + t);
}
__device__ __forceinline__ float softplus_f(float x) { return x > 20.f ? x : log1pf(__expf(x)); }

#define XB_TMO      128
#define XB_XCNT(j)  (256  + 64 * (j))
#define XB_XSUB(j)  (1280 + 64 * (j))
#define XB_XGEN(j)  (2304 + 64 * (j))
#define XB_TOP      3328
#define XB_TOPGEN   3392
#define XCD_BAR_WORDS 3456
#define XB_SPIN_CAP (1u << 24)
__device__ __forceinline__ unsigned xb_ld(unsigned* p)              { return __hip_atomic_load(p, __ATOMIC_RELAXED, __HIP_MEMORY_SCOPE_AGENT); }
__device__ __forceinline__ unsigned xb_add(unsigned* p, unsigned v) { return __hip_atomic_fetch_add(p, v, __ATOMIC_RELAXED, __HIP_MEMORY_SCOPE_AGENT); }
__device__ __forceinline__ unsigned xb_xcc_id() { return (unsigned)__builtin_amdgcn_s_getreg((3 << 11) | 20) & 0xFu; }
#define XB_SPIN(cond, bar) do { unsigned _sp = 0; while (cond) { __builtin_amdgcn_s_sleep(1); \
    if ((++_sp & 255u) == 0u) { if (xb_ld(&(bar)[XB_TMO])) break; if (_sp > XB_SPIN_CAP) { atomicAdd(&(bar)[XB_TMO], 1u); break; } } } } while (0)
struct XcdBarrier { unsigned* bar; unsigned x; volatile LAS unsigned* st; };
__device__ __forceinline__ XcdBarrier xcd_barrier_post(unsigned* bar, volatile LAS unsigned* st) {
    XcdBarrier b; b.bar = bar; b.x = xb_xcc_id(); b.st = st;
    if (threadIdx.x == 0) (void)xb_add(&bar[XB_XCNT(b.x)], 1u);
    return b;
}
__device__ __forceinline__ void xcd_barrier_complete(unsigned* bar, unsigned x, unsigned& nloc, unsigned& nx) {
    const unsigned G = gridDim.x * gridDim.y * gridDim.z;
    unsigned sum, cnt, mine, sp = 0u;
    for (;;) {
        sum = 0u; cnt = 0u; mine = 0u;
#pragma unroll
        for (unsigned j = 0; j < 16; ++j) { const unsigned c = xb_ld(&bar[XB_XCNT(j)]); sum += c; cnt += (c > 0u) ? 1u : 0u; mine = (j == x) ? c : mine; }
        if (sum == G) break;
        __builtin_amdgcn_s_sleep(1);
        if ((++sp & 255u) == 0u) { if (xb_ld(&bar[XB_TMO])) break; if (sp > XB_SPIN_CAP) { atomicAdd(&bar[XB_TMO], 1u); break; } }
    }
    nloc = mine > 0u ? mine : 1u; nx = cnt > 0u ? cnt : 1u;
}
__device__ __forceinline__ void xcd_barrier(const XcdBarrier& b) {
    asm volatile("s_waitcnt vmcnt(0)" ::: "memory");
    __syncthreads();
    if (threadIdx.x == 0) {
        unsigned* bar = b.bar;
        __builtin_amdgcn_s_waitcnt(0);
        unsigned nloc = b.st[0], nx = b.st[1];
        if (nloc == 0u) { xcd_barrier_complete(bar, b.x, nloc, nx); b.st[0] = nloc; b.st[1] = nx; }
        const unsigned old = xb_add(&bar[XB_XSUB(b.x)], 1u);
        const unsigned gen = old / nloc;
        if (old + 1u == (gen + 1u) * nloc) {
            __builtin_amdgcn_fence(__ATOMIC_RELEASE, "agent");
            asm volatile("s_waitcnt vmcnt(0)" ::: "memory");
            const unsigned og = xb_add(&bar[XB_TOP], 1u);
            const unsigned tg = og / nx;
            if (og + 1u == (tg + 1u) * nx) xb_add(&bar[XB_TOPGEN], 1u);
            else XB_SPIN(xb_ld(&bar[XB_TOPGEN]) == tg, bar);
            __builtin_amdgcn_fence(__ATOMIC_ACQUIRE, "agent");
            xb_add(&bar[XB_XGEN(b.x)], 1u);
            asm volatile("s_waitcnt vmcnt(0)" ::: "memory");
        } else {
            XB_SPIN(xb_ld(&bar[XB_XGEN(b.x)]) == gen, bar);
            __builtin_amdgcn_fence(__ATOMIC_ACQUIRE, "agent");
            asm volatile("s_waitcnt vmcnt(0)" ::: "memory");
        }
    }
    __syncthreads();
}

struct Frame {
    const Params* P;
    unsigned char* ws;
    LAS unsigned char* lds;
    int tid, lane, wave, G, bid;
    float* mod;
    unsigned* ctrl;
};
__device__ __forceinline__ int gtid(const Frame& F) { int t = F.tid; asm volatile("" : "+v"(t)); return F.bid * NTH + t; }
__device__ __forceinline__ const float* modp(const Frame& F, int layer, int b, int which) { return F.mod + ((size_t)(layer * 9 + b) * 6 + which) * 1024; }

__device__ __forceinline__ void conv_tile(const Frame& F, const float* src, int K, int N, int lds_, bf16_t* dst, int ldd, int kt, int nt, int rm_mode) {
    LAS float* tile = (LAS float*)F.lds;
    const int t = F.tid;
    {
        const int c = t & 63, r0 = t >> 6;
#pragma unroll
        for (int i = 0; i < 8; ++i) { const int rr = r0 + i * 8, k = kt * 64 + rr, n = nt * 64 + c;
            tile[rr * 65 + c] = (k < K && n < N) ? src[(size_t)k * lds_ + n] : 0.f; }
    }
    __syncthreads();
    {
        const int nl = t >> 3, kc = (t & 7) * 8, n = nt * 64 + nl;
        int row = n;
        if (rm_mode == 1) row = (n >> 7) * 256 + (n & 127);
        else if (rm_mode == 2) row = (n >> 7) * 256 + 128 + (n & 127);
        float v[8];
#pragma unroll
        for (int j = 0; j < 8; ++j) v[j] = tile[(kc + j) * 65 + nl];
        u32x4 w; w.x = pack2(v[0], v[1]); w.y = pack2(v[2], v[3]); w.z = pack2(v[4], v[5]); w.w = pack2(v[6], v[7]);
        *(u32x4*)(dst + (size_t)row * ldd + kt * 64 + kc) = w;
    }
    __syncthreads();
}
__device__ __forceinline__ void conv_moe_weights(const Frame& F, int layer, int item0, int stride) {
    const Params& P = *F.P;
    bf16_t* W1 = (bf16_t*)(F.ws + WS_WMOE); bf16_t* W2 = W1 + (size_t)32 * 1024 * 1024;
    for (int it = item0; it < 12288; it += stride) {
        if (it < 8192) {
            const int up = it >= 4096, j = it & 4095, e = j >> 7, r = j & 127, kt = r >> 3, nt = r & 7;
            const float* src = P.in[up ? I_MU : I_MG] + ((size_t)(layer * 32 + e)) * 1024 * 512;
            conv_tile(F, src, 1024, 512, 512, W1 + (size_t)e * 1024 * 1024, 1024, kt, nt, up ? 2 : 1);
        } else {
            const int j = it - 8192, e = j >> 7, r = j & 127, kt = r >> 4, nt = r & 15;
            const float* src = P.in[I_MD] + ((size_t)(layer * 32 + e)) * 512 * 1024;
            conv_tile(F, src, 512, 1024, 1024, W2 + (size_t)e * 1024 * 512, 512, kt, nt, 0);
        }
    }
}
__device__ __forceinline__ void mod_reduce(const Frame& F) {
    const float* mp = (const float*)(F.ws + WS_R2 + R2_MODP);
    for (int i = gtid(F); i < 18 * 6144; i += F.G * NTH) { float a = F.P->in[I_ADAB][(i / (9 * 6144)) * 6144 + (i % 6144)];
#pragma unroll
        for (int kp = 0; kp < 8; ++kp) a += mp[(size_t)kp * 18 * 6144 + i];
        F.mod[i] = a; }
}
__device__ __forceinline__ void ph_prologue(const Frame& F) {
    const Params& P = *F.P;
    float* modp_ = (float*)(F.ws + WS_R2 + R2_MODP);
    for (int it = F.bid; it < 192; it += F.G) {
        const int l = it / 96, r = it % 96, cb = r >> 3, kp = r & 7;
        LAS float* sc = (LAS float*)F.lds;
        for (int i = F.tid; i < 9 * 128; i += NTH) { const int rr = i >> 7, k = kp * 128 + (i & 127);
            const float cv = rr < 8 ? P.in[I_C][rr * 1024 + k] : P.in[I_CCTX][k]; sc[i] = silu_f(cv); }
        __syncthreads();
        const int n = cb * 512 + F.tid;
        float acc[9];
#pragma unroll
        for (int rr = 0; rr < 9; ++rr) acc[rr] = 0.f;
        const float* w = P.in[I_ADAW] + ((size_t)l * 1024 + kp * 128) * 6144 + n;
#pragma unroll 8
        for (int k = 0; k < 128; ++k) { const float wv = w[(size_t)k * 6144];
#pragma unroll
            for (int rr = 0; rr < 9; ++rr) acc[rr] += sc[rr * 128 + k] * wv; }
#pragma unroll
        for (int rr = 0; rr < 9; ++rr) modp_[((size_t)kp * 18 + l * 9 + rr) * 6144 + n] = acc[rr];
        __syncthreads();
    }
    bf16_t* wsm = (bf16_t*)(F.ws + WS_WSM);
    for (int it = F.bid; it < 2160; it += F.G) {
        int j = it;
        if (j < 896) { conv_tile(F, P.in[I_EWIN], 1024, 3584, 3584, wsm + W_EIN / 2, 1024, j / 56, j % 56, 0); continue; } j -= 896;
        if (j < 256) { conv_tile(F, P.in[I_EWOUT], 1024, 1024, 1024, wsm + W_EOUT / 2, 1024, j >> 4, j & 15, 0); continue; } j -= 256;
        if (j < 640) { conv_tile(F, P.in[I_OWIN], 1024, 2480, 2480, wsm + W_OIN / 2, 1024, j / 40, j % 40, 0); continue; } j -= 640;
        if (j < 256) { conv_tile(F, P.in[I_OWOUT], 1024, 1024, 1024, wsm + W_OOUT / 2, 1024, j >> 4, j & 15, 0); continue; } j -= 256;
        if (j < 48) { conv_tile(F, P.in[I_WQ], 256, 768, 768, wsm + W_WQ / 2, 256, j / 12, j % 12, 0); continue; } j -= 48;
        conv_tile(F, P.in[I_WKV], 128, 1024, 1024, wsm + W_WKV / 2, 256, j >> 4, j & 15, 0);
    }
    for (int i = gtid(F); i < 2 * 48 * 1024; i += F.G * NTH) { const int l = i / (48 * 1024), r = i % (48 * 1024), n = r >> 10, k = r & 1023;
        float w = 0.f; if (n < 4) w = P.in[I_RGW][((size_t)l * 1024 + k) * 4 + n]; else if (n < 36) w = P.in[I_REW][((size_t)l * 1024 + k) * 32 + (n - 4)];
        const bf16_t h = f2bf(w); wsm[W_RT / 2 + (size_t)l * 2 * 48 * 1024 + r] = h; wsm[W_RT / 2 + (size_t)l * 2 * 48 * 1024 + 48 * 1024 + r] = f2bf(w - bf2f(h)); }
    conv_moe_weights(F, 0, F.bid, F.G);
}

__device__ __forceinline__ void ph_rownorm(const Frame& F, int layer, int nrows, const float* xlat, const float* xctx, const float* nw, int si) {
    bf16_t* dst = (bf16_t*)(F.ws + WS_ACT);
    for (int r = F.bid * 8 + F.wave; r < nrows; r += F.G * 8) {
        const float* src = r < TL ? xlat + (size_t)r * 1024 : xctx + (size_t)(r - TL) * 1024;
        const int b = r < TL ? (r >> 13) : 8;
        const float* sh = modp(F, layer, b, si); const float* sc = modp(F, layer, b, si + 1);
        f32x4 v[4]; float ss = 0.f;
#pragma unroll
        for (int j = 0; j < 4; ++j) { v[j] = *(const f32x4*)(src + j * 256 + F.lane * 4); ss += v[j][0] * v[j][0] + v[j][1] * v[j][1] + v[j][2] * v[j][2] + v[j][3] * v[j][3]; }
        ss = wave_sum(ss);
        const float rstd = rsqrtf(ss * (1.f / 1024.f) + EPS);
#pragma unroll
        for (int j = 0; j < 4; ++j) { const int c = j * 256 + F.lane * 4;
            const f32x4 w = *(const f32x4*)(nw + c), s1 = *(const f32x4*)(sc + c), s0 = *(const f32x4*)(sh + c);
            v[j] = (v[j] * rstd * w) * (1.f + s1) + s0;
            u32x2 o; o.x = pack2(v[j][0], v[j][1]); o.y = pack2(v[j][2], v[j][3]);
            *(u32x2*)(dst + (size_t)r * 1024 + c) = o; }
    }
}
typedef short s16x8r __attribute__((ext_vector_type(8)));
__device__ __forceinline__ void ph_router(const Frame& F, int layer, int nrows, const float* xlat, const float* xctx, const float* nw, int si) {
    const Params& P = *F.P;
    bf16_t* dst = (bf16_t*)(F.ws + WS_ACT);
    LAS unsigned* hist = (LAS unsigned*)F.lds;
    LAS float* lg = (LAS float*)(F.lds + 256) + F.wave * (16 * 48);
    int* tok_e = (int*)(F.ws + WS_R2 + R2_TOKE); float* tok_w = (float*)(F.ws + WS_R2 + R2_TOKW);
    if (F.tid < 64) hist[F.tid] = 0u;
    __syncthreads();
    { int* stok = (int*)(F.ws + WS_R2 + R2_STOK);
      float* swz = (float*)(F.ws + WS_R2 + R2_SW);
      for (int i = gtid(F); i < MAXSLOTS; i += F.G * NTH) { stok[i] = -1; swz[i] = 0.f; } }
    const bf16_t* Wh = (const bf16_t*)(F.ws + WS_WSM) + W_RT / 2 + (size_t)layer * 2 * 48 * 1024; const bf16_t* Wl = Wh + 48 * 1024;
    const int lr = F.lane & 15, kq = F.lane >> 4;
    const float* rgb = P.in[I_RGB] + layer * 4; const float* reb = P.in[I_REB] + layer * 32;
    for (int g = F.bid * 8 + F.wave; g < nrows / 16; g += F.G * 8) {
        const int r0 = g * 16;
        const float* src0 = r0 < TL ? xlat + (size_t)r0 * 1024 : xctx + (size_t)(r0 - TL) * 1024;
        const int b = r0 < TL ? (r0 >> 13) : 8;
        const float* sh = modp(F, layer, b, si); const float* sc = modp(F, layer, b, si + 1);
        float myrstd = 0.f;
#pragma unroll 4
        for (int rr = 0; rr < 16; ++rr) { const float* src = src0 + (size_t)rr * 1024; float ss = 0.f;
#pragma unroll
            for (int j = 0; j < 4; ++j) { const f32x4 v = *(const f32x4*)(src + j * 256 + F.lane * 4); ss += v[0] * v[0] + v[1] * v[1] + v[2] * v[2] + v[3] * v[3]; }
            ss = wave_sum(ss);
            const float rs = rsqrtf(ss * (1.f / 1024.f) + EPS); myrstd = (lr == rr) ? rs : myrstd; }
        f32x4 acc[3];
#pragma unroll
        for (int nb = 0; nb < 3; ++nb) acc[nb] = (f32x4){0.f, 0.f, 0.f, 0.f};
        const float* xr = src0 + (size_t)lr * 1024 + kq * 8;
        bf16_t* dr = dst + (size_t)(r0 + lr) * 1024 + kq * 8;
#pragma unroll 2
        for (int ks = 0; ks < 32; ++ks) { const int c = ks * 32 + kq * 8;
            const f32x4 x0 = *(const f32x4*)(xr + ks * 32), x1 = *(const f32x4*)(xr + ks * 32 + 4);
            const f32x4 w0 = *(const f32x4*)(nw + c), w1 = *(const f32x4*)(nw + c + 4), a0 = *(const f32x4*)(sc + c), a1 = *(const f32x4*)(sc + c + 4), b0 = *(const f32x4*)(sh + c), b1 = *(const f32x4*)(sh + c + 4);
            const f32x4 h0 = (x0 * myrstd * w0) * (1.f + a0) + b0, h1 = (x1 * myrstd * w1) * (1.f + a1) + b1;
            u32x4 hi; hi.x = pack2(h0[0], h0[1]); hi.y = pack2(h0[2], h0[3]); hi.z = pack2(h1[0], h1[1]); hi.w = pack2(h1[2], h1[3]);
            *(u32x4*)(dr + ks * 32) = hi;
            u32x4 lo; lo.x = pack2(h0[0] - lo2f(hi.x), h0[1] - hi2f(hi.x)); lo.y = pack2(h0[2] - lo2f(hi.y), h0[3] - hi2f(hi.y));
            lo.z = pack2(h1[0] - lo2f(hi.z), h1[1] - hi2f(hi.z)); lo.w = pack2(h1[2] - lo2f(hi.w), h1[3] - hi2f(hi.w));
            const s16x8r ah = __builtin_bit_cast(s16x8r, hi), al = __builtin_bit_cast(s16x8r, lo);
#pragma unroll
            for (int nb = 0; nb < 3; ++nb) { const s16x8r bh = *(const s16x8r*)(Wh + (size_t)(nb * 16 + lr) * 1024 + c), bl = *(const s16x8r*)(Wl + (size_t)(nb * 16 + lr) * 1024 + c);
                acc[nb] = __builtin_amdgcn_mfma_f32_16x16x32_bf16(ah, bh, acc[nb], 0, 0, 0);
                acc[nb] = __builtin_amdgcn_mfma_f32_16x16x32_bf16(al, bh, acc[nb], 0, 0, 0);
                acc[nb] = __builtin_amdgcn_mfma_f32_16x16x32_bf16(ah, bl, acc[nb], 0, 0, 0); } }
#pragma unroll
        for (int nb = 0; nb < 3; ++nb)
#pragma unroll
            for (int rg = 0; rg < 4; ++rg) lg[(4 * kq + rg) * 48 + nb * 16 + lr] = acc[nb][rg];
        asm volatile("s_waitcnt lgkmcnt(0)" ::: "memory");
        __builtin_amdgcn_wave_barrier();
        if (F.lane < 16) {
            const LAS float* L = lg + F.lane * 48;
            float lgv[4];
#pragma unroll
            for (int i = 0; i < 4; ++i) lgv[i] = L[i] + rgb[i];
            int gi = 0; float best = lgv[0];
#pragma unroll
            for (int i = 1; i < 4; ++i) if (lgv[i] > best) { best = lgv[i]; gi = i; }
            float den = 0.f;
#pragma unroll
            for (int i = 0; i < 4; ++i) den += __expf(lgv[i] - best);
            const float pg = 1.f / den;
            float le[8];
#pragma unroll
            for (int i = 0; i < 8; ++i) le[i] = L[4 + gi * 8 + i] + reb[gi * 8 + i];
            int i1 = 0; float b1 = le[0];
#pragma unroll
            for (int i = 1; i < 8; ++i) if (le[i] > b1) { b1 = le[i]; i1 = i; }
            int i2 = -1; float b2 = -3.0e38f;
#pragma unroll
            for (int i = 0; i < 8; ++i) if (i != i1 && le[i] > b2) { b2 = le[i]; i2 = i; }
            const float e2 = __expf(b2 - b1);
            const float w1 = pg / (1.f + e2), w2 = pg * e2 / (1.f + e2);
            const int e0g = gi * 8 + i1, e1g = gi * 8 + i2; const int r = r0 + F.lane;
            tok_e[r] = e0g | (e1g << 8); tok_w[2 * r] = w1; tok_w[2 * r + 1] = w2;
            lds_inc(&hist[e0g]); lds_inc(&hist[32 + e1g]);
        }
        __builtin_amdgcn_wave_barrier();
    }
    __syncthreads();
    unsigned* cnt = (unsigned*)(F.ws + WS_CTRL + C_MOE + layer * 1024);
    if (F.tid < 64 && hist[F.tid]) atomicAdd(&cnt[F.tid], hist[F.tid]);
    __syncthreads();
}

__device__ __forceinline__ void ph_dispatch(const Frame& F, int layer, int ntok) {
    unsigned* cnt = (unsigned*)(F.ws + WS_CTRL + C_MOE + layer * 1024); unsigned* cursor = cnt + 64; unsigned* info = cnt + 128;
    LAS unsigned* base = (LAS unsigned*)F.lds; LAS unsigned* lh = base + 64; LAS unsigned* gb = base + 128; LAS unsigned* lh2 = base + 192; LAS unsigned* pad = base + 256;
    const int* tok_e = (const int*)(F.ws + WS_R2 + R2_TOKE); const float* tok_w = (const float*)(F.ws + WS_R2 + R2_TOKW);
    int* stok = (int*)(F.ws + WS_R2 + R2_STOK); float* sw = (float*)(F.ws + WS_R2 + R2_SW); int* tile_e = (int*)(F.ws + WS_R2 + R2_TILEE); int* tsl = (int*)(F.ws + WS_R2 + R2_TSLOT);
    if (F.tid < 64) { pad[F.tid] = (__hip_atomic_load(&cnt[F.tid], __ATOMIC_RELAXED, __HIP_MEMORY_SCOPE_AGENT) + 255u) & ~255u; lh[F.tid] = 0u; lh2[F.tid] = 0u; }
    __syncthreads();
    if (F.tid == 0) { unsigned a = 0; for (int i = 0; i < 64; ++i) { base[i] = a; a += pad[i]; } base[320] = a; }
    __syncthreads();
    if (F.bid == 0) {
        for (int i = F.tid; i < MAXTILES; i += NTH) { const unsigned s = (unsigned)i * 256u; int l = -1;
            for (int j = 0; j < 64; ++j) if (s >= base[j] && s < base[j] + pad[j]) l = j;
            tile_e[i] = l; }
        if (F.tid == 0) { info[0] = base[32] / 256u; info[1] = base[320] / 256u; }
    }
    const int per = (ntok + F.G - 1) / F.G, t0 = F.bid * per, t1 = min(ntok, t0 + per);
    for (int t = t0 + F.tid; t < t1; t += NTH) { const int e = tok_e[t]; lds_inc(&lh[e & 255]); lds_inc(&lh[32 + (e >> 8)]); }
    __syncthreads();
    if (F.tid < 64) gb[F.tid] = lh[F.tid] ? __hip_atomic_fetch_add(&cursor[F.tid], lh[F.tid], __ATOMIC_RELAXED, __HIP_MEMORY_SCOPE_AGENT) : 0u;
    __syncthreads();
    for (int t = t0 + F.tid; t < t1; t += NTH) { const int e = tok_e[t];
        const int l0 = e & 255, l1 = 32 + (e >> 8);
        const unsigned p0 = base[l0] + gb[l0] + lds_inc(&lh2[l0]), p1 = base[l1] + gb[l1] + lds_inc(&lh2[l1]);
        stok[p0] = t; sw[p0] = tok_w[2 * t]; stok[p1] = t; sw[p1] = tok_w[2 * t + 1]; tsl[2 * t] = (int)p0; tsl[2 * t + 1] = (int)p1; }
    __syncthreads();
}

template <class AF, class EP>
__device__ __forceinline__ void gemm_unit_naive(const Frame& F, int K, const AF& arow, const bf16_t* Bt, const EP& E, int pm, int pn) {
    LAS float* As = (LAS float*)F.lds;
    LAS float* Bs = As + 32 * 132;
    const int t = F.tid, ty = t >> 5, tx = t & 31;
    for (int half = 0; half < 2; ++half) {
        float acc[8][8];
#pragma unroll
        for (int i = 0; i < 8; ++i)
#pragma unroll
            for (int j = 0; j < 8; ++j) acc[i][j] = 0.f;
        const bf16_t* ap = arow(half * 128 + (t >> 2));
        const bf16_t* bp = Bt + (size_t)(t >> 1) * K;
        for (int k0 = 0; k0 < K; k0 += 32) {
            { const int r = t >> 2, kq = (t & 3) * 8; u32x4 w = {0u, 0u, 0u, 0u}; if (ap) w = *(const u32x4*)(ap + k0 + kq);
              As[(kq + 0) * 132 + r] = lo2f(w.x); As[(kq + 1) * 132 + r] = hi2f(w.x); As[(kq + 2) * 132 + r] = lo2f(w.y); As[(kq + 3) * 132 + r] = hi2f(w.y);
              As[(kq + 4) * 132 + r] = lo2f(w.z); As[(kq + 5) * 132 + r] = hi2f(w.z); As[(kq + 6) * 132 + r] = lo2f(w.w); As[(kq + 7) * 132 + r] = hi2f(w.w); }
            { const int n = t >> 1, kh = (t & 1) * 16;
#pragma unroll
              for (int q = 0; q < 2; ++q) { const u32x4 w = *(const u32x4*)(bp + k0 + kh + q * 8); const int kk = kh + q * 8;
                Bs[(kk + 0) * 260 + n] = lo2f(w.x); Bs[(kk + 1) * 260 + n] = hi2f(w.x); Bs[(kk + 2) * 260 + n] = lo2f(w.y); Bs[(kk + 3) * 260 + n] = hi2f(w.y);
                Bs[(kk + 4) * 260 + n] = lo2f(w.z); Bs[(kk + 5) * 260 + n] = hi2f(w.z); Bs[(kk + 6) * 260 + n] = lo2f(w.w); Bs[(kk + 7) * 260 + n] = hi2f(w.w); } }
            __syncthreads();
#pragma unroll 4
            for (int k = 0; k < 32; ++k) {
                const f32x4 a0 = *(const LAS f32x4*)(As + k * 132 + ty * 8), a1 = *(const LAS f32x4*)(As + k * 132 + ty * 8 + 4);
                const f32x4 b0 = *(const LAS f32x4*)(Bs + k * 260 + tx * 4), b1 = *(const LAS f32x4*)(Bs + k * 260 + 128 + tx * 4);
#pragma unroll
                for (int i = 0; i < 8; ++i) { const float a = i < 4 ? a0[i & 3] : a1[i & 3];
#pragma unroll
                    for (int j = 0; j < 4; ++j) { acc[i][j] += a * b0[j]; acc[i][4 + j] += a * b1[j]; } }
            }
            __syncthreads();
        }
#pragma unroll
        for (int i = 0; i < 8; ++i) { const f32x4 v0 = {acc[i][0], acc[i][1], acc[i][2], acc[i][3]}, v1 = {acc[i][4], acc[i][5], acc[i][6], acc[i][7]};
            E(pm * 256 + half * 128 + ty * 8 + i, pn, tx * 4, v0, v1); }
    }
}
struct ARowDense { const bf16_t* A; int K; int pm; __device__ __forceinline__ const bf16_t* operator()(int r) const { return A + (size_t)(pm * 256 + r) * K; } };
struct ARowGather { const bf16_t* A; const int* stok; int pm; __device__ __forceinline__ const bf16_t* operator()(int r) const { const int t = stok[pm * 256 + r]; return t < 0 ? nullptr : A + (size_t)t * 1024; } };

template <class EP>
__device__ __forceinline__ void gemm_dense_naive(const Frame& F, const bf16_t* A, const bf16_t* Bt, int M, int N, int K, const EP& E) {
    const int nM = M / 256, nN = N / 256;
    for (int u = F.bid; u < nM * nN; u += F.G) { const int pm = u / nN, pn = u % nN;
        ARowDense ar{A, K, pm}; gemm_unit_naive(F, K, ar, Bt + (size_t)pn * 256 * K, E, pm, pn); }
}

namespace pg8 {
typedef short bf16x8 __attribute__((ext_vector_type(8)));
constexpr int BM = 256, BK = 64, HALF = 128, HTB = HALF * BK * 2, STAGE_BYTES = 8 * HTB, NXCD = 8, WGM = 8;
__device__ __forceinline__ int lds_byte(int r, int c) { const int st = (r >> 4) * 2 + (c >> 5), rr = r & 15, cc = c & 31, ob = rr * 64 + cc * 2; return st * 1024 + (ob ^ (((ob >> 9) & 1) << 5)); }
__device__ __forceinline__ int perm32(int rho) { const int n = rho >> 4, i = rho & 15; return 8 * (i >> 2) + 4 * n + (i & 3); }
__device__ __forceinline__ void stage_rc(int b, int& R, int& C) { const int st = b / 1024, sb = b % 1024, swz = sb ^ (((sb >> 9) & 1) << 5); R = (st >> 1) * 16 + swz / 64; C = (st & 1) * 32 + (swz % 64) / 2; }
struct Unit { int pm, pn; };
struct ProbDense {
    const char* A; const char* Bt; int K, nM, nN, nwg, G, c;
    __device__ __forceinline__ void init(const bf16_t* A_, const bf16_t* Bt_, int M, int N, int K_, int G_, int c_) { A = (const char*)A_; Bt = (const char*)Bt_; K = K_; nM = M / BM; nN = N / BM; nwg = nM * nN; G = G_; c = c_; }
    __device__ __forceinline__ bool next(int i, Unit& u) const {
        const long L = (long)i * G + c; if (L >= nwg) return false;
        int wgid = (int)L; { const int q = nwg / NXCD, r = nwg % NXCD, xcd = wgid % NXCD, off = wgid / NXCD; wgid = (xcd < r ? xcd * (q + 1) : r * (q + 1) + (xcd - r) * q) + off; }
        const int nig = WGM * nN, gid = wgid / nig, fm = gid * WGM, gsz = (nM - fm) < WGM ? (nM - fm) : WGM;
        u.pm = fm + ((wgid % nig) % gsz); u.pn = (wgid % nig) / gsz; return true;
    }
    __device__ __forceinline__ const char* bptr(const Unit& u) const { return Bt + (size_t)u.pn * 256 * K * 2; }
    __device__ __forceinline__ unsigned aoff(const Unit& u, int r) const { return (unsigned)(u.pm * 256 + r) * (unsigned)(K * 2); }
};
struct ProbMoe1 {
    const char* A; const int* stok; const int* tile_e; const char* W; int K, ntiles, G, c;
    __device__ __forceinline__ bool next(int i, Unit& u) const { const int L = i * G + c; if (L >= ntiles * 4) return false; u.pm = L >> 2; u.pn = L & 3; return true; }
    __device__ __forceinline__ const char* bptr(const Unit& u) const { return W + ((size_t)(tile_e[u.pm] & 31) * 1024 + u.pn * 256) * 2048; }
    __device__ __forceinline__ unsigned aoff(const Unit& u, int r) const { const int t = stok[u.pm * 256 + r]; return t < 0 ? 0u : (unsigned)t * 2048u; }
};
struct ProbMoe2 {
    const char* A; const int* tile_e; const char* W; int K, tlo, thi, G, c;
    __device__ __forceinline__ bool next(int i, Unit& u) const { const int L = i * G + c; if (L >= (thi - tlo) * 4) return false; u.pm = tlo + (L >> 2); u.pn = L & 3; return true; }
    __device__ __forceinline__ const char* bptr(const Unit& u) const { return W + ((size_t)(tile_e[u.pm] & 31) * 1024 + u.pn * 256) * 1024; }
    __device__ __forceinline__ unsigned aoff(const Unit& u, int r) const { return (unsigned)(u.pm * 256 + r) * 1024u; }
};

template <class Prob, class Epi>
__device__ __forceinline__ void gemm_phase(LAS unsigned char* lds, const Prob& S, const Epi& E) {
    const int tid = threadIdx.x, wid = __builtin_amdgcn_readfirstlane(tid >> 6), lane = tid & 63, wr = wid >> 2, wc = wid & 3, fr = lane & 15, fq = lane >> 4;
    const int K = S.K, nt = K / BK;
    int RA[2]; unsigned cb2[2], voffB[2];
#pragma unroll
    for (int i = 0; i < 2; ++i) { int R, C; stage_rc(tid * 16 + i * 8192, R, C); RA[i] = R; cb2[i] = (unsigned)C * 2u; const int Rb = Epi::PERM ? ((R & ~31) + perm32(R & 31)) : R; voffB[i] = (unsigned)(Rb * K + C) * 2u; }
    const size_t kstep = (size_t)(BK * 2);
    const size_t hstepB = (size_t)HALF * K * 2;
    const unsigned ldsw = (unsigned)wid * 1024u;
    const int aoff = lds_byte(wr * 64 + fr, fq * 8), boff = lds_byte(wc * 32 + fr, fq * 8);
#define PG8_SA(b, h) (((b) * 2 + (h)) * HTB)
#define PG8_SB(b, h) ((4 + (b) * 2 + (h)) * HTB)
#define PG8_STAGE(bufoff, gbase, voff) do { _Pragma("unroll") for (int _i = 0; _i < 2; ++_i) \
        __builtin_amdgcn_global_load_lds((const unsigned*)((const char*)(gbase) + (voff)[_i]), (LAS unsigned*)(lds + (bufoff) + ldsw + _i * 8192), 16, 0, 0); } while (0)
#define PG8_LDA(dst, b, h) do { _Pragma("unroll") for (int m = 0; m < 4; ++m) _Pragma("unroll") for (int k = 0; k < 2; ++k) dst[m][k] = *(const LAS bf16x8*)(lds + PG8_SA(b, h) + aoff + m * 2048 + k * 1024); } while (0)
#define PG8_LDB(dst, b, h) do { _Pragma("unroll") for (int n = 0; n < 2; ++n) _Pragma("unroll") for (int k = 0; k < 2; ++k) dst[n][k] = *(const LAS bf16x8*)(lds + PG8_SB(b, h) + boff + n * 2048 + k * 1024); } while (0)
#define PG8_MMA(ai, bj, At, Bt) do { __builtin_amdgcn_s_setprio(1); _Pragma("unroll") for (int m = 0; m < 4; ++m) _Pragma("unroll") for (int n = 0; n < 2; ++n) _Pragma("unroll") for (int k = 0; k < 2; ++k) \
        acc[ai][bj][m][n] = __builtin_amdgcn_mfma_f32_16x16x32_bf16(Bt[n][k], At[m][k], acc[ai][bj][m][n], 0, 0, 0); __builtin_amdgcn_s_setprio(0); } while (0)
#define PG8_WAIT_V(n) asm volatile("s_waitcnt vmcnt(" #n ")" ::: "memory")
#define PG8_WAIT_L(n) asm volatile("s_waitcnt lgkmcnt(" #n ")" ::: "memory")
#define PG8_BAR __builtin_amdgcn_s_barrier()
#define PG8_SCHED __builtin_amdgcn_sched_barrier(0)
    Unit cur, nxt; int ui = 0;
    if (!S.next(0, cur)) return;
    f32x4 acc[2][2][4][2];
#pragma unroll
    for (int a = 0; a < 2; ++a)
#pragma unroll
        for (int b = 0; b < 2; ++b)
#pragma unroll
            for (int m = 0; m < 4; ++m)
#pragma unroll
                for (int n = 0; n < 2; ++n) acc[a][b][m][n] = (f32x4){0.f, 0.f, 0.f, 0.f};
    bf16x8 At[4][2], B0[2][2], B1[2][2];
    unsigned oc0[2], oc1[2], on0[2], on1[2];
#pragma unroll
    for (int i = 0; i < 2; ++i) { oc0[i] = S.aoff(cur, RA[i]) + cb2[i]; oc1[i] = S.aoff(cur, 128 + RA[i]) + cb2[i]; }
    const char* cB = S.bptr(cur);
    const char* const Ab = S.A;
    PG8_STAGE(PG8_SB(0, 0), cB, voffB); PG8_STAGE(PG8_SA(0, 0), Ab, oc0); PG8_STAGE(PG8_SB(0, 1), cB + hstepB, voffB); PG8_STAGE(PG8_SA(0, 1), Ab, oc1);
    if (wr == 1) PG8_BAR;
    PG8_WAIT_V(4); PG8_BAR;
    PG8_STAGE(PG8_SB(1, 0), cB + kstep, voffB); PG8_STAGE(PG8_SA(1, 0), Ab + kstep, oc0); PG8_STAGE(PG8_SB(1, 1), cB + hstepB + kstep, voffB);
    PG8_WAIT_V(6); PG8_BAR;
    for (;;) {
        const bool has_next = S.next(ui + 1, nxt);
        const char* nB = has_next ? S.bptr(nxt) : cB;
#pragma unroll
        for (int i = 0; i < 2; ++i) { on0[i] = has_next ? S.aoff(nxt, RA[i]) + cb2[i] : oc0[i]; on1[i] = has_next ? S.aoff(nxt, 128 + RA[i]) + cb2[i] : oc1[i]; }
        for (int t = 0; t < nt; t += 2) {
            const bool last = (t == nt - 2);
            const char* a1 = Ab + (size_t)(t + 1) * kstep;
            const char* a2 = last ? Ab : Ab + (size_t)(t + 2) * kstep; const char* b2 = last ? nB : cB + (size_t)(t + 2) * kstep;
            const char* a3 = a2 + kstep; const char* b3 = b2 + kstep;
            unsigned o20[2], o21[2];
#pragma unroll
            for (int i = 0; i < 2; ++i) { o20[i] = last ? on0[i] : oc0[i]; o21[i] = last ? on1[i] : oc1[i]; }
            PG8_LDB(B0, 0, 0); PG8_SCHED; PG8_LDA(At, 0, 0); PG8_STAGE(PG8_SA(1, 1), a1, oc1);
            PG8_WAIT_L(8); PG8_BAR; PG8_WAIT_L(0); PG8_MMA(0, 0, At, B0); PG8_BAR; PG8_SCHED;
            PG8_LDB(B1, 0, 1); PG8_STAGE(PG8_SB(0, 0), b2, voffB);
            PG8_BAR; PG8_WAIT_L(0); PG8_MMA(0, 1, At, B1); PG8_BAR;
            PG8_LDA(At, 0, 1); PG8_STAGE(PG8_SA(0, 0), a2, o20);
            PG8_BAR; PG8_WAIT_L(0); PG8_MMA(1, 0, At, B0); PG8_BAR; PG8_SCHED;
            PG8_STAGE(PG8_SB(0, 1), b2 + hstepB, voffB);
            PG8_WAIT_V(6); PG8_BAR; PG8_MMA(1, 1, At, B1); PG8_BAR;
            PG8_LDB(B0, 1, 0); PG8_SCHED; PG8_LDA(At, 1, 0); PG8_STAGE(PG8_SA(0, 1), a2, o21);
            PG8_WAIT_L(8); PG8_BAR; PG8_WAIT_L(0); PG8_MMA(0, 0, At, B0); PG8_BAR; PG8_SCHED;
            PG8_LDB(B1, 1, 1); PG8_STAGE(PG8_SB(1, 0), b3, voffB);
            PG8_BAR; PG8_WAIT_L(0); PG8_MMA(0, 1, At, B1); PG8_BAR;
            PG8_LDA(At, 1, 1); PG8_STAGE(PG8_SA(1, 0), a3, o20);
            PG8_BAR; PG8_WAIT_L(0); PG8_MMA(1, 0, At, B0); PG8_BAR; PG8_SCHED;
            PG8_STAGE(PG8_SB(1, 1), b3 + hstepB, voffB);
            PG8_WAIT_V(6); PG8_BAR; PG8_MMA(1, 1, At, B1); PG8_BAR;
        }
#pragma unroll
        for (int ai = 0; ai < 2; ++ai)
#pragma unroll
            for (int m = 0; m < 4; ++m)
                { if constexpr (Epi::PERM) E.e8(cur.pm * BM + ai * HALF + wr * 64 + m * 16 + fr, cur.pn, wc * 32 + fq * 8, acc[ai][0][m][0], acc[ai][0][m][1], acc[ai][1][m][0], acc[ai][1][m][1]);
                  else { _Pragma("unroll") for (int n = 0; n < 2; ++n) E(cur.pm * BM + ai * HALF + wr * 64 + m * 16 + fr, cur.pn, wc * 32 + n * 16 + fq * 4, acc[ai][0][m][n], acc[ai][1][m][n]); } }
        if (!has_next) break;
#pragma unroll
        for (int a = 0; a < 2; ++a)
#pragma unroll
            for (int b = 0; b < 2; ++b)
#pragma unroll
                for (int m = 0; m < 4; ++m)
#pragma unroll
                    for (int n = 0; n < 2; ++n) acc[a][b][m][n] = (f32x4){0.f, 0.f, 0.f, 0.f};
        cur = nxt; cB = nB; ++ui;
#pragma unroll
        for (int i = 0; i < 2; ++i) { oc0[i] = on0[i]; oc1[i] = on1[i]; }
    }
    PG8_WAIT_V(0);
    if (wr == 0) PG8_BAR;
    PG8_BAR;
#undef PG8_SA
#undef PG8_SB
#undef PG8_STAGE
#undef PG8_LDA
#undef PG8_LDB
#undef PG8_MMA
#undef PG8_WAIT_V
#undef PG8_WAIT_L
#undef PG8_BAR
#undef PG8_SCHED
}
}

struct EpiStoreBf16 { static constexpr bool PERM = false; bf16_t* O; int ldc; int gelu_below;
    __device__ __forceinline__ void operator()(int row, int pn, int cx, f32x4 v0, f32x4 v1) const {
        const int c0 = pn * 256 + cx, c1 = c0 + 128;
        if (c0 < gelu_below) { v0[0] = gelu_tanh_f(v0[0]); v0[1] = gelu_tanh_f(v0[1]); v0[2] = gelu_tanh_f(v0[2]); v0[3] = gelu_tanh_f(v0[3]); }
        if (c1 < gelu_below) { v1[0] = gelu_tanh_f(v1[0]); v1[1] = gelu_tanh_f(v1[1]); v1[2] = gelu_tanh_f(v1[2]); v1[3] = gelu_tanh_f(v1[3]); }
        u32x2 a; a.x = pack2(v0[0], v0[1]); a.y = pack2(v0[2], v0[3]); u32x2 b; b.x = pack2(v1[0], v1[1]); b.y = pack2(v1[2], v1[3]);
        *(u32x2*)(O + (size_t)row * ldc + c0) = a; *(u32x2*)(O + (size_t)row * ldc + c1) = b; } };
struct EpiStoreBf16P { static constexpr bool PERM = true; bf16_t* O; int ldc; int gelu_below;
    __device__ __forceinline__ void e8(int row, int pn, int cx, f32x4 a0, f32x4 a1, f32x4 b0, f32x4 b1) const {
        const int c0 = pn * 256 + cx, c1 = c0 + 128;
        if (c0 < gelu_below) {
#pragma unroll
            for (int i = 0; i < 4; ++i) { a0[i] = gelu_tanh_f(a0[i]); a1[i] = gelu_tanh_f(a1[i]); } }
        if (c1 < gelu_below) {
#pragma unroll
            for (int i = 0; i < 4; ++i) { b0[i] = gelu_tanh_f(b0[i]); b1[i] = gelu_tanh_f(b1[i]); } }
        u32x4 x; x.x = pack2(a0[0], a0[1]); x.y = pack2(a0[2], a0[3]); x.z = pack2(a1[0], a1[1]); x.w = pack2(a1[2], a1[3]);
        u32x4 y; y.x = pack2(b0[0], b0[1]); y.y = pack2(b0[2], b0[3]); y.z = pack2(b1[0], b1[1]); y.w = pack2(b1[2], b1[3]);
        *(u32x4*)(O + (size_t)row * ldc + c0) = x; *(u32x4*)(O + (size_t)row * ldc + c1) = y; } };
struct EpiMoe1P { static constexpr bool PERM = true; bf16_t* H;
    __device__ __forceinline__ void e8(int row, int pn, int cx, f32x4 a0, f32x4 a1, f32x4 b0, f32x4 b1) const {
        u32x4 x; x.x = pack2(silu_f(a0[0]) * b0[0], silu_f(a0[1]) * b0[1]); x.y = pack2(silu_f(a0[2]) * b0[2], silu_f(a0[3]) * b0[3]);
        x.z = pack2(silu_f(a1[0]) * b1[0], silu_f(a1[1]) * b1[1]); x.w = pack2(silu_f(a1[2]) * b1[2], silu_f(a1[3]) * b1[3]);
        *(u32x4*)(H + (size_t)row * 512 + pn * 128 + cx) = x; } };
struct EpiMoe2YP { static constexpr bool PERM = true; const float* sw; bf16_t* Y;
    __device__ __forceinline__ void e8(int row, int pn, int cx, f32x4 a0, f32x4 a1, f32x4 b0, f32x4 b1) const {
        const float w = sw[row];
        u32x4 x; x.x = pack2(a0[0] * w, a0[1] * w); x.y = pack2(a0[2] * w, a0[3] * w); x.z = pack2(a1[0] * w, a1[1] * w); x.w = pack2(a1[2] * w, a1[3] * w);
        u32x4 y; y.x = pack2(b0[0] * w, b0[1] * w); y.y = pack2(b0[2] * w, b0[3] * w); y.z = pack2(b1[0] * w, b1[1] * w); y.w = pack2(b1[2] * w, b1[3] * w);
        bf16_t* d = Y + (size_t)row * 1024 + pn * 256 + cx; *(u32x4*)d = x; *(u32x4*)(d + 128) = y; } };
struct EpiResidual { static constexpr bool PERM = false; const float* srcl; const float* srcc; float* dstl; float* dstc; const float* mod;   int which;
    __device__ __forceinline__ void operator()(int row, int pn, int cx, f32x4 v0, f32x4 v1) const {
        const int b = row < TL ? (row >> 13) : 8; const float* g = mod + ((size_t)b * 6 + which) * 1024;
        const float* s = row < TL ? srcl + (size_t)row * 1024 : srcc + (size_t)(row - TL) * 1024;
        float* d = row < TL ? dstl + (size_t)row * 1024 : dstc + (size_t)(row - TL) * 1024;
        const int c0 = pn * 256 + cx, c1 = c0 + 128;
        *(f32x4*)(d + c0) = *(const f32x4*)(s + c0) + *(const f32x4*)(g + c0) * v0;
        *(f32x4*)(d + c1) = *(const f32x4*)(s + c1) + *(const f32x4*)(g + c1) * v1; } };
struct EpiMoe1 { static constexpr bool PERM = false; bf16_t* H;
    __device__ __forceinline__ void operator()(int row, int pn, int cx, f32x4 v0, f32x4 v1) const {
        u32x2 a; a.x = pack2(silu_f(v0[0]) * v1[0], silu_f(v0[1]) * v1[1]); a.y = pack2(silu_f(v0[2]) * v1[2], silu_f(v0[3]) * v1[3]);
        *(u32x2*)(H + (size_t)row * 512 + pn * 128 + cx) = a; } };
struct EpiMoe2 { static constexpr bool PERM = false; const int* stok; const float* sw; float* dstl; float* dstc; const float* mod;
    __device__ __forceinline__ void operator()(int row, int pn, int cx, f32x4 v0, f32x4 v1) const {
        const int t = stok[row]; if (t < 0) return; const float w = sw[row];
        const int b = t < TL ? (t >> 13) : 8; const float* g = mod + ((size_t)b * 6 + 5) * 1024;
        float* d = t < TL ? dstl + (size_t)t * 1024 : dstc + (size_t)(t - TL) * 1024;
        const int c0 = pn * 256 + cx, c1 = c0 + 128;
        *(f32x4*)(d + c0) = *(const f32x4*)(d + c0) + *(const f32x4*)(g + c0) * v0 * w;
        *(f32x4*)(d + c1) = *(const f32x4*)(d + c1) + *(const f32x4*)(g + c1) * v1 * w; } };

#ifndef FAST_GEMM
#define FAST_GEMM 1
#endif
template <class EP>
__device__ __forceinline__ void gemm_dense(const Frame& F, const bf16_t* A, const bf16_t* Bt, int M, int N, int K, const EP& E) {
#if FAST_GEMM
    pg8::ProbDense S; S.init(A, Bt, M, N, K, F.G, F.bid); pg8::gemm_phase(F.lds, S, E);
#else
    gemm_dense_naive(F, A, Bt, M, N, K, E);
#endif
}
struct EpiMoe2Y { static constexpr bool PERM = false; const int* stok; const float* sw; bf16_t* Y;
    __device__ __forceinline__ void operator()(int row, int pn, int cx, f32x4 v0, f32x4 v1) const {
        const int t = stok[row]; if (t < 0) return; const float w = sw[row];
        u32x2 a; a.x = pack2(v0[0] * w, v0[1] * w); a.y = pack2(v0[2] * w, v0[3] * w); u32x2 b; b.x = pack2(v1[0] * w, v1[1] * w); b.y = pack2(v1[2] * w, v1[3] * w);
        bf16_t* d = Y + (size_t)row * 1024 + pn * 256 + cx; *(u32x2*)d = a; *(u32x2*)(d + 128) = b; } };
__device__ __forceinline__ void ph_moe_gemm2y(const Frame& F, int layer) {
    const unsigned* info = (const unsigned*)(F.ws + WS_CTRL + C_MOE + layer * 1024) + 128;
    const int nall = (int)__hip_atomic_load(&info[1], __ATOMIC_RELAXED, __HIP_MEMORY_SCOPE_AGENT);
    const int* tile_e = (const int*)(F.ws + WS_R2 + R2_TILEE);
    const bf16_t* W2 = (const bf16_t*)(F.ws + WS_WMOE) + (size_t)32 * 1024 * 1024;
    EpiMoe2YP E{(const float*)(F.ws + WS_R2 + R2_SW), (bf16_t*)(F.ws + WS_PX)};
    pg8::ProbMoe2 S{(const char*)(F.ws + WS_R2 + R2_H), tile_e, (const char*)W2, 512, 0, nall, F.G, F.bid};
    pg8::gemm_phase(F.lds, S, E);
}
template <bool NORM>
__device__ __forceinline__ void ph_moe_combine(const Frame& F, int layer, int nrows, int nl, const float* nw) {
    const bf16_t* Y = (const bf16_t*)(F.ws + WS_PX); const int* tsl = (const int*)(F.ws + WS_R2 + R2_TSLOT);
    float* outl = F.P->out; float* outc = (float*)(F.ws + WS_XC); bf16_t* dst = (bf16_t*)(F.ws + WS_ACT);
    for (int r = F.bid * 8 + F.wave; r < nrows; r += F.G * 8) {
        float* xr = r < TL ? outl + (size_t)r * 1024 : outc + (size_t)(r - TL) * 1024;
        const int b = r < TL ? (r >> 13) : 8;
        const float* g5 = modp(F, layer, b, 5);
        const int s0 = tsl[2 * r], s1 = tsl[2 * r + 1];
        const bf16_t* y0 = Y + (size_t)s0 * 1024; const bf16_t* y1 = Y + (size_t)s1 * 1024;
        f32x4 v[4]; float ss = 0.f;
#pragma unroll
        for (int j = 0; j < 4; ++j) { const int c = j * 256 + F.lane * 4;
            const f32x4 x = *(const f32x4*)(xr + c), g = *(const f32x4*)(g5 + c); const u32x2 a = *(const u32x2*)(y0 + c), bb = *(const u32x2*)(y1 + c);
            f32x4 y; y[0] = lo2f(a.x) + lo2f(bb.x); y[1] = hi2f(a.x) + hi2f(bb.x); y[2] = lo2f(a.y) + lo2f(bb.y); y[3] = hi2f(a.y) + hi2f(bb.y);
            v[j] = x + g * y; *(f32x4*)(xr + c) = v[j];
            ss += v[j][0] * v[j][0] + v[j][1] * v[j][1] + v[j][2] * v[j][2] + v[j][3] * v[j][3]; }
        if (NORM) {
            const float* sh = modp(F, nl, b, 0); const float* sc = modp(F, nl, b, 1);
            ss = wave_sum(ss);
            const float rstd = rsqrtf(ss * (1.f / 1024.f) + EPS);
#pragma unroll
            for (int j = 0; j < 4; ++j) { const int c = j * 256 + F.lane * 4;
                const f32x4 w = *(const f32x4*)(nw + c), s1v = *(const f32x4*)(sc + c), s0v = *(const f32x4*)(sh + c);
                const f32x4 hq = (v[j] * rstd * w) * (1.f + s1v) + s0v;
                u32x2 o; o.x = pack2(hq[0], hq[1]); o.y = pack2(hq[2], hq[3]);
                *(u32x2*)(dst + (size_t)r * 1024 + c) = o; }
        }
    }
}
__device__ __forceinline__ void ph_moe_gemm1(const Frame& F, int layer) {
    const unsigned* info = (const unsigned*)(F.ws + WS_CTRL + C_MOE + layer * 1024) + 128;
    const int ntiles = (int)__hip_atomic_load(&info[1], __ATOMIC_RELAXED, __HIP_MEMORY_SCOPE_AGENT);
    const int* tile_e = (const int*)(F.ws + WS_R2 + R2_TILEE); const int* stok = (const int*)(F.ws + WS_R2 + R2_STOK);
    const bf16_t* W1 = (const bf16_t*)(F.ws + WS_WMOE);
    EpiMoe1P E{(bf16_t*)(F.ws + WS_R2 + R2_H)};
#if FAST_GEMM
    pg8::ProbMoe1 S{(const char*)(F.ws + WS_ACT), stok, tile_e, (const char*)W1, 1024, ntiles, F.G, F.bid};
    pg8::gemm_phase(F.lds, S, E);
#else
    for (int u = F.bid; u < ntiles * 4; u += F.G) { const int pm = u >> 2, pn = u & 3; const int e = tile_e[pm] & 31;
        ARowGather ar{(const bf16_t*)(F.ws + WS_ACT), stok, pm};
        gemm_unit_naive(F, 1024, ar, W1 + ((size_t)e * 1024 + pn * 256) * 1024, E, pm, pn); }
#endif
}
__device__ __forceinline__ void ph_moe_gemm2(const Frame& F, int layer, int k) {
    const unsigned* info = (const unsigned*)(F.ws + WS_CTRL + C_MOE + layer * 1024) + 128;
    const int nk0 = (int)__hip_atomic_load(&info[0], __ATOMIC_RELAXED, __HIP_MEMORY_SCOPE_AGENT), nall = (int)__hip_atomic_load(&info[1], __ATOMIC_RELAXED, __HIP_MEMORY_SCOPE_AGENT);
    const int tlo = k == 0 ? 0 : nk0, thi = k == 0 ? nk0 : nall;
    const int* tile_e = (const int*)(F.ws + WS_R2 + R2_TILEE);
    const bf16_t* W2 = (const bf16_t*)(F.ws + WS_WMOE) + (size_t)32 * 1024 * 1024;
    EpiMoe2 E{(const int*)(F.ws + WS_R2 + R2_STOK), (const float*)(F.ws + WS_R2 + R2_SW), F.P->out, (float*)(F.ws + WS_XC), F.mod + (size_t)layer * 9 * 6144};
#if FAST_GEMM
    pg8::ProbMoe2 S{(const char*)(F.ws + WS_R2 + R2_H), tile_e, (const char*)W2, 512, tlo, thi, F.G, F.bid};
    pg8::gemm_phase(F.lds, S, E);
#else
    for (int u = F.bid; u < (thi - tlo) * 4; u += F.G) { const int pm = tlo + (u >> 2), pn = u & 3; const int e = tile_e[pm] & 31;
        ARowDense ar{(const bf16_t*)(F.ws + WS_R2 + R2_H), 512, pm};
        gemm_unit_naive(F, 512, ar, W2 + ((size_t)e * 1024 + pn * 256) * 512, E, pm, pn); }
#endif
}

__device__ __forceinline__ void ph_gmlp(const Frame& F) {
    const Params& P = *F.P;
    const bf16_t* PX = (const bf16_t*)(F.ws + WS_PX); bf16_t* CAT = (bf16_t*)(F.ws + WS_ACT);
    LAS float* Vs = (LAS float*)F.lds;
    LAS float* Wm = Vs + 128 * 128;
    LAS float* rs = Wm + 128 * 129;
    for (int it = F.bid; it < 528 * 4; it += F.G) {
        const int ch = it >> 2, g = it & 3, row0 = ch * 128;
        for (int q = F.wave; q < 128; q += 8) { const bf16_t* p = PX + (size_t)(row0 + q) * EVEN_IN + 512 + F.lane * 8;
            const u32x4 w = *(const u32x4*)p; float s = 0.f, x;
            x = lo2f(w.x); s += x * x; x = hi2f(w.x); s += x * x; x = lo2f(w.y); s += x * x; x = hi2f(w.y); s += x * x;
            x = lo2f(w.z); s += x * x; x = hi2f(w.z); s += x * x; x = lo2f(w.w); s += x * x; x = hi2f(w.w); s += x * x;
            s = wave_sum(s); if (F.lane == 0) rs[q] = rsqrtf(s * (1.f / 512.f) + EPS); }
        __syncthreads();
        for (int i = F.tid; i < 128 * 128; i += NTH) { const int q = i >> 7, c = i & 127;
            Vs[i] = bf2f(PX[(size_t)(row0 + q) * EVEN_IN + 512 + g * 128 + c]) * rs[q] * P.in[I_GNW][g * 128 + c];
            Wm[q * 129 + c] = P.in[I_GWS][(size_t)g * 16384 + i]; }
        __syncthreads();
        const int ty = F.tid >> 5, tx = F.tid & 31;
        float acc[8][4];
#pragma unroll
        for (int i = 0; i < 8; ++i)
#pragma unroll
            for (int j = 0; j < 4; ++j) acc[i][j] = 0.f;
        for (int q = 0; q < 128; ++q) { const f32x4 v = *(const LAS f32x4*)(Vs + q * 128 + tx * 4);
#pragma unroll
            for (int i = 0; i < 8; ++i) { const float w = Wm[(ty * 8 + i) * 129 + q];
#pragma unroll
                for (int j = 0; j < 4; ++j) acc[i][j] += w * v[j]; } }
#pragma unroll
        for (int i = 0; i < 8; ++i) { const int p = ty * 8 + i; const float bias = P.in[I_GBS][g * 128 + p];
            const size_t t = (size_t)(row0 + p); const int col = g * 128 + tx * 4;
            const u32x2 uu = *(const u32x2*)(PX + t * EVEN_IN + col);
            u32x2 o; o.x = pack2(lo2f(uu.x) * (acc[i][0] + bias), hi2f(uu.x) * (acc[i][1] + bias)); o.y = pack2(lo2f(uu.y) * (acc[i][2] + bias), hi2f(uu.y) * (acc[i][3] + bias));
            *(u32x2*)(CAT + t * 1024 + col) = o; }
        __syncthreads();
    }
}

__device__ __forceinline__ void ph_gmlp_mfma(const Frame& F) {
    const Params& P = *F.P;
    const bf16_t* PX = (const bf16_t*)(F.ws + WS_PX); bf16_t* CAT = (bf16_t*)(F.ws + WS_ACT);
    LAS unsigned char* VT = F.lds;
    LAS unsigned char* WB = F.lds + 34816;
    LAS float* rs = (LAS float*)(F.lds + 69632);
    const int l31 = F.lane & 31, hh = F.lane >> 5;
    for (int it = F.bid; it < 528 * 4; it += F.G) {
        const int ch = it >> 2, g = it & 3, row0 = ch * 128;
        for (int q = F.wave; q < 128; q += 8) { const bf16_t* p = PX + (size_t)(row0 + q) * EVEN_IN + 512 + F.lane * 8;
            const u32x4 w = *(const u32x4*)p; float s = 0.f, x;
            x = lo2f(w.x); s += x * x; x = hi2f(w.x); s += x * x; x = lo2f(w.y); s += x * x; x = hi2f(w.y); s += x * x;
            x = lo2f(w.z); s += x * x; x = hi2f(w.z); s += x * x; x = lo2f(w.w); s += x * x; x = hi2f(w.w); s += x * x;
            s = wave_sum(s); if (F.lane == 0) rs[q] = rsqrtf(s * (1.f / 512.f) + EPS); }
#pragma unroll
        for (int k = 0; k < 4; ++k) { const int c = F.tid + 512 * k, p = c >> 4, part = c & 15;
            const float* src = P.in[I_GWS] + (size_t)g * 16384 + p * 128 + part * 8; const f32x4 a = *(const f32x4*)src, b = *(const f32x4*)(src + 4);
            u32x4 w; w.x = pack2(a[0], a[1]); w.y = pack2(a[2], a[3]); w.z = pack2(b[0], b[1]); w.w = pack2(b[2], b[3]);
            *(LAS u32x4*)(WB + p * 272 + part * 16) = w; }
        __syncthreads();
#pragma unroll
        for (int k = 0; k < 4; ++k) { const int c = F.tid + 512 * k, q = c >> 4, c0 = (c & 15) * 8;
            const u32x4 w = *(const u32x4*)(PX + (size_t)(row0 + q) * EVEN_IN + 512 + g * 128 + c0); const float r = rs[q];
            const float* nw = P.in[I_GNW] + g * 128 + c0; const f32x4 n0 = *(const f32x4*)nw, n1 = *(const f32x4*)(nw + 4);
            LAS unsigned short* d = (LAS unsigned short*)(VT + c0 * 272 + q * 2);
            d[0 * 136] = f2bf(lo2f(w.x) * r * n0[0]); d[1 * 136] = f2bf(hi2f(w.x) * r * n0[1]); d[2 * 136] = f2bf(lo2f(w.y) * r * n0[2]); d[3 * 136] = f2bf(hi2f(w.y) * r * n0[3]);
            d[4 * 136] = f2bf(lo2f(w.z) * r * n1[0]); d[5 * 136] = f2bf(hi2f(w.z) * r * n1[1]); d[6 * 136] = f2bf(lo2f(w.w) * r * n1[2]); d[7 * 136] = f2bf(hi2f(w.w) * r * n1[3]); }
        __syncthreads();
        const int pb = F.wave >> 1, cb0 = (F.wave & 1) * 2;
        f32x16 a0, a1;
#pragma unroll
        for (int r = 0; r < 16; ++r) { a0[r] = 0.f; a1[r] = 0.f; }
#pragma unroll
        for (int ks = 0; ks < 8; ++ks) { const s16x8 wa = *(const LAS s16x8*)(WB + (32 * pb + l31) * 272 + ks * 32 + hh * 16);
            a0 = __builtin_amdgcn_mfma_f32_32x32x16_bf16(wa, *(const LAS s16x8*)(VT + (32 * cb0 + l31) * 272 + ks * 32 + hh * 16), a0, 0, 0, 0);
            a1 = __builtin_amdgcn_mfma_f32_32x32x16_bf16(wa, *(const LAS s16x8*)(VT + (32 * (cb0 + 1) + l31) * 272 + ks * 32 + hh * 16), a1, 0, 0, 0); }
#pragma unroll
        for (int r = 0; r < 16; ++r) { const int p = 32 * pb + (r & 3) + 8 * (r >> 2) + 4 * hh; const float bias = P.in[I_GBS][g * 128 + p];
            const size_t t = (size_t)(row0 + p); const int c0 = g * 128 + 32 * cb0 + l31, c1 = c0 + 32;
            CAT[t * 1024 + c0] = f2bf(bf2f(PX[t * EVEN_IN + c0]) * (a0[r] + bias));
            CAT[t * 1024 + c1] = f2bf(bf2f(PX[t * EVEN_IN + c1]) * (a1[r] + bias)); }
        __syncthreads();
    }
}

__device__ __forceinline__ void ph_gla(const Frame& F) {
    const Params& P = *F.P;
    const bf16_t* PX = (const bf16_t*)(F.ws + WS_PX);
    LAS float* qs = (LAS float*)F.lds;
    LAS float* fs = qs + 8192;
    LAS float* vs = fs + 8192;
    LAS float* os = vs + 2048;
    const int dg = F.lane & 15, el = F.wave * 4 + (F.lane >> 4);
    const int prow = F.tid >> 4, pd0 = (F.tid & 15) * 8;
    const int vrow = F.tid >> 2, ve0 = (F.tid & 3) * 8;
    for (int it = F.bid; it < 256; it += F.G) {
        const int b = it >> 5, h = (it >> 3) & 3, dir = (it >> 2) & 1, sl = it & 3;
        bf16_t* O = (bf16_t*)(F.ws + WS_R2 + (dir ? R2_OB0 : R2_OF0));
        float lb8[8];
#pragma unroll
        for (int i = 0; i < 8; ++i) { const int ch = h * 128 + pd0 + i; const float* lg = P.in[I_LB] + (size_t)dir * 3 * 512 + ch;
            const float a0 = lg[0], a1 = lg[512], a2 = lg[1024]; const float m = fmaxf(a0, fmaxf(a1, a2));
            const float e0 = __expf(a0 - m), e1 = __expf(a1 - m), e2 = __expf(a2 - m); lb8[i] = e0 / (e0 + e1 + e2); }
        float S[8];
#pragma unroll
        for (int i = 0; i < 8; ++i) S[i] = 0.f;
        u32x4 rq0, rq1, rf0, rf1, rv = {0u, 0u, 0u, 0u};
        auto rowof = [&](int nb, int s) -> size_t { const bool c = nb < 4; const int len = c ? CTXL : SEQ; const int tt = (c ? nb : nb - 4) * 64 + s; const int p = dir ? len - 1 - tt : tt;
            return (c ? (size_t)TL + b * CTXL : (size_t)b * SEQ) + p; };
        auto fetch = [&](int nb) { const bf16_t* r0 = PX + rowof(nb, prow) * EVEN_IN; const bf16_t* r1 = PX + rowof(nb, prow + 32) * EVEN_IN;
            rq0 = *(const u32x4*)(r0 + 1024 + h * 128 + pd0); rf0 = *(const u32x4*)(r0 + 2048 + dir * 512 + h * 128 + pd0);
            rq1 = *(const u32x4*)(r1 + 1024 + h * 128 + pd0); rf1 = *(const u32x4*)(r1 + 2048 + dir * 512 + h * 128 + pd0);
            if (F.tid < 256) rv = *(const u32x4*)(PX + rowof(nb, vrow) * EVEN_IN + 1536 + h * 128 + sl * 32 + ve0); };
        auto put = [&](int row, u32x4 q, u32x4 f) { LAS float* qd = qs + row * 128 + pd0; LAS float* fd = fs + row * 128 + pd0;
            const float q8[8] = {lo2f(q.x), hi2f(q.x), lo2f(q.y), hi2f(q.y), lo2f(q.z), hi2f(q.z), lo2f(q.w), hi2f(q.w)};
            const float f8[8] = {lo2f(f.x), hi2f(f.x), lo2f(f.y), hi2f(f.y), lo2f(f.z), hi2f(f.z), lo2f(f.w), hi2f(f.w)};
            f32x4 o0, o1, g0, g1;
#pragma unroll
            for (int i = 0; i < 4; ++i) { o0[i] = q8[i]; o1[i] = q8[4 + i]; g0[i] = lb8[i] + (1.f - lb8[i]) * sigmoid_f(f8[i]); g1[i] = lb8[4 + i] + (1.f - lb8[4 + i]) * sigmoid_f(f8[4 + i]); }
            *(LAS f32x4*)qd = o0; *(LAS f32x4*)(qd + 4) = o1; *(LAS f32x4*)fd = g0; *(LAS f32x4*)(fd + 4) = g1; };
        fetch(0);
        for (int nb = 0; nb < 132; ++nb) {
            __syncthreads();
            put(prow, rq0, rf0); put(prow + 32, rq1, rf1);
            if (F.tid < 256) { LAS float* vd = vs + vrow * 32 + ve0;
                *(LAS f32x4*)vd = (f32x4){lo2f(rv.x), hi2f(rv.x), lo2f(rv.y), hi2f(rv.y)}; *(LAS f32x4*)(vd + 4) = (f32x4){lo2f(rv.z), hi2f(rv.z), lo2f(rv.w), hi2f(rv.w)}; }
            __syncthreads();
            if (nb + 1 < 132) fetch(nb + 1);
#pragma unroll 4
            for (int st = 0; st < 64; ++st) {
                const f32x4 fa = *(const LAS f32x4*)(fs + st * 128 + dg * 8), fb = *(const LAS f32x4*)(fs + st * 128 + dg * 8 + 4);
                const f32x4 qa = *(const LAS f32x4*)(qs + st * 128 + dg * 8), qb = *(const LAS f32x4*)(qs + st * 128 + dg * 8 + 4);
                const float v = vs[st * 32 + el];
                float p0 = 0.f, p1 = 0.f;
#pragma unroll
                for (int i = 0; i < 4; ++i) { S[i] = fa[i] * (S[i] - v) + v; p0 += qa[i] * S[i]; S[4 + i] = fb[i] * (S[4 + i] - v) + v; p1 += qb[i] * S[4 + i]; }
                const float o = sum16(p0 + p1);
                if (dg == 0) os[st * 32 + el] = o;
            }
            __syncthreads();
#pragma unroll
            for (int k = 0; k < 2; ++k) { const int s = (F.tid >> 4) + 32 * k, e2 = (F.tid & 15) * 2;
              *(unsigned*)(O + rowof(nb, s) * 512 + h * 128 + sl * 32 + e2) = pack2(os[s * 32 + e2], os[s * 32 + e2 + 1]); }
        }
        __syncthreads();
    }
}

constexpr size_t R2_GU = 0, R2_GD = 264 * MiB;
constexpr int GS = 132;
__device__ __forceinline__ void gla_geom(int u, int& b, int& h, int& ck, size_t& rbase, int& p0) {
    b = u / 528; h = (u % 528) / 132; ck = u % 132;
    if (ck < 4) { rbase = (size_t)TL + b * CTXL; p0 = ck * 64; } else { rbase = (size_t)b * SEQ; p0 = (ck - 4) * 64; }
}
__device__ __forceinline__ void gla_prep_dir(const Frame& F, int dir, int h, size_t rbase, int p0, LAS float* G, LAS unsigned char* KB) {
    const Params& P = *F.P;
    const bf16_t* PX = (const bf16_t*)(F.ws + WS_PX);
    { const int part = F.tid & 15;
      float lb8[8];
#pragma unroll
      for (int i = 0; i < 8; ++i) { const int chn = h * 128 + part * 8 + i; const float* lg = P.in[I_LB] + (size_t)dir * 3 * 512 + chn;
          const float a0 = lg[0], a1 = lg[512], a2 = lg[1024]; const float m = fmaxf(a0, fmaxf(a1, a2));
          const float e0 = __expf(a0 - m), e1 = __expf(a1 - m), e2 = __expf(a2 - m); lb8[i] = e0 / (e0 + e1 + e2); }
#pragma unroll
      for (int k = 0; k < 2; ++k) { const int i = (F.tid >> 4) + 32 * k, il = dir ? 63 - i : i;
          const u32x4 w = *(const u32x4*)(PX + (rbase + p0 + i) * EVEN_IN + 2048 + dir * 512 + h * 128 + part * 8);
          const float fr[8] = {lo2f(w.x), hi2f(w.x), lo2f(w.y), hi2f(w.y), lo2f(w.z), hi2f(w.z), lo2f(w.w), hi2f(w.w)};
          float f[8], kk[8];
#pragma unroll
          for (int j = 0; j < 8; ++j) { f[j] = lb8[j] + (1.f - lb8[j]) * sigmoid_f(fr[j]); kk[j] = 1.f - f[j]; f[j] = __logf(f[j]); }
          *(LAS f32x4*)(G + il * GS + part * 8) = (f32x4){f[0], f[1], f[2], f[3]}; *(LAS f32x4*)(G + il * GS + part * 8 + 4) = (f32x4){f[4], f[5], f[6], f[7]};
          u32x4 kw; kw.x = pack2(kk[0], kk[1]); kw.y = pack2(kk[2], kk[3]); kw.z = pack2(kk[4], kk[5]); kw.w = pack2(kk[6], kk[7]);
          *(LAS u32x4*)(KB + il * 272 + part * 16) = kw; } }
    __syncthreads();
    const int d = F.tid & 127, seg = F.tid >> 7;
    { float run = 0.f;
#pragma unroll
      for (int r = 0; r < 16; ++r) { run += G[(seg * 16 + r) * GS + d]; G[(seg * 16 + r) * GS + d] = run; } }
    __syncthreads();
    float off = 0.f;
#pragma unroll
    for (int s2 = 0; s2 < 3; ++s2) off += (s2 < seg) ? G[(s2 * 16 + 15) * GS + d] : 0.f;
    __syncthreads();
#pragma unroll
    for (int r = 0; r < 16; ++r) G[(seg * 16 + r) * GS + d] += off;
    __syncthreads();
}
__device__ __forceinline__ void ph_gla_p1(const Frame& F) {
    const bf16_t* PX = (const bf16_t*)(F.ws + WS_PX);
    LAS float* G = (LAS float*)F.lds;
    LAS unsigned char* KB = F.lds + 33792;
    LAS unsigned char* VT = F.lds + 33792 + 17408;
    LAS unsigned char* KT = VT + 18432;
    const int l31 = F.lane & 31, hh = F.lane >> 5;
    for (int u = F.bid; u < 4224; u += F.G) {
        int b, h, ck, p0; size_t rbase; gla_geom(u, b, h, ck, rbase, p0);
#pragma unroll
        for (int k = 0; k < 2; ++k) { const int c = F.tid + 512 * k, i = c >> 4, part = c & 15;
            const u32x4 w = *(const u32x4*)(PX + (rbase + p0 + i) * EVEN_IN + 1536 + h * 128 + part * 8);
            LAS unsigned short* d = (LAS unsigned short*)(VT + (part * 8) * 144 + i * 2);
            d[0 * 72] = (unsigned short)(w.x & 0xffffu); d[1 * 72] = (unsigned short)(w.x >> 16); d[2 * 72] = (unsigned short)(w.y & 0xffffu); d[3 * 72] = (unsigned short)(w.y >> 16);
            d[4 * 72] = (unsigned short)(w.z & 0xffffu); d[5 * 72] = (unsigned short)(w.z >> 16); d[6 * 72] = (unsigned short)(w.w & 0xffffu); d[7 * 72] = (unsigned short)(w.w >> 16); }
        for (int dir = 0; dir < 2; ++dir) {
            gla_prep_dir(F, dir, h, rbase, p0, G, KB);
#pragma unroll
            for (int k = 0; k < 2; ++k) { const int c = F.tid + 512 * k, il = c >> 4, part = c & 15, i = dir ? 63 - il : il;
                const u32x4 kw = *(const LAS u32x4*)(KB + il * 272 + part * 16);
                const float kk[8] = {lo2f(kw.x), hi2f(kw.x), lo2f(kw.y), hi2f(kw.y), lo2f(kw.z), hi2f(kw.z), lo2f(kw.w), hi2f(kw.w)};
                const f32x4 g0 = *(const LAS f32x4*)(G + il * GS + part * 8), g1 = *(const LAS f32x4*)(G + il * GS + part * 8 + 4);
                const f32x4 l0 = *(const LAS f32x4*)(G + 63 * GS + part * 8), l1 = *(const LAS f32x4*)(G + 63 * GS + part * 8 + 4);
                LAS unsigned short* dd = (LAS unsigned short*)(KT + (part * 8) * 144 + i * 2);
#pragma unroll
                for (int j = 0; j < 4; ++j) { dd[j * 72] = f2bf(kk[j] * __expf(l0[j] - g0[j])); dd[(4 + j) * 72] = f2bf(kk[4 + j] * __expf(l1[j] - g1[j])); } }
            if (F.tid < 128) ((float*)(F.ws + WS_R2 + R2_GD))[(size_t)(u * 2 + dir) * 128 + F.tid] = __expf(G[63 * GS + F.tid]);
            __syncthreads();
            { const int db = F.wave >> 1, eb0 = (F.wave & 1) * 2;
              f32x16 a0, a1;
#pragma unroll
              for (int r = 0; r < 16; ++r) { a0[r] = 0.f; a1[r] = 0.f; }
#pragma unroll
              for (int ks = 0; ks < 4; ++ks) { const s16x8 ka = *(const LAS s16x8*)(KT + (32 * db + l31) * 144 + ks * 32 + hh * 16);
                  a0 = __builtin_amdgcn_mfma_f32_32x32x16_bf16(ka, *(const LAS s16x8*)(VT + (32 * eb0 + l31) * 144 + ks * 32 + hh * 16), a0, 0, 0, 0);
                  a1 = __builtin_amdgcn_mfma_f32_32x32x16_bf16(ka, *(const LAS s16x8*)(VT + (32 * (eb0 + 1) + l31) * 144 + ks * 32 + hh * 16), a1, 0, 0, 0); }
              bf16_t* ut = (bf16_t*)(F.ws + WS_R2 + R2_GU) + (size_t)(u * 2 + dir) * 16384;
#pragma unroll
              for (int gq = 0; gq < 4; ++gq) { const int d0 = 32 * db + 8 * gq + 4 * hh; u32x2 x;
                  x.x = pack2(a0[4 * gq], a0[4 * gq + 1]); x.y = pack2(a0[4 * gq + 2], a0[4 * gq + 3]); *(u32x2*)(ut + (32 * eb0 + l31) * 128 + d0) = x;
                  x.x = pack2(a1[4 * gq], a1[4 * gq + 1]); x.y = pack2(a1[4 * gq + 2], a1[4 * gq + 3]); *(u32x2*)(ut + (32 * (eb0 + 1) + l31) * 128 + d0) = x; } }
            __syncthreads();
        }
    }
}
__device__ __forceinline__ void ph_gla_p2(const Frame& F) {
    bf16_t* GU = (bf16_t*)(F.ws + WS_R2 + R2_GU); const float* GD = (const float*)(F.ws + WS_R2 + R2_GD);
    for (int v = gtid(F); v < 64 * 2048; v += F.G * NTH) {
        const int chain = v >> 11, vec = v & 2047, d0 = (vec & 15) * 8;
        const int bh = chain >> 1, dir = chain & 1;
        float s[8];
#pragma unroll
        for (int j = 0; j < 8; ++j) s[j] = 0.f;
#pragma unroll 4
        for (int n = 0; n < 132; ++n) { const int ck = dir ? (n < 4 ? 3 - n : 135 - n) : n; const size_t ud = (size_t)(bh * 132 + ck) * 2 + dir;
            u32x4* p = (u32x4*)(GU + ud * 16384 + (size_t)vec * 8); const u32x4 w = *p;
            const f32x4 c0 = *(const f32x4*)(GD + ud * 128 + d0), c1 = *(const f32x4*)(GD + ud * 128 + d0 + 4);
            u32x4 o; o.x = pack2(s[0], s[1]); o.y = pack2(s[2], s[3]); o.z = pack2(s[4], s[5]); o.w = pack2(s[6], s[7]); *p = o;
            s[0] = c0[0] * s[0] + lo2f(w.x); s[1] = c0[1] * s[1] + hi2f(w.x); s[2] = c0[2] * s[2] + lo2f(w.y); s[3] = c0[3] * s[3] + hi2f(w.y);
            s[4] = c1[0] * s[4] + lo2f(w.z); s[5] = c1[1] * s[5] + hi2f(w.z); s[6] = c1[2] * s[6] + lo2f(w.w); s[7] = c1[3] * s[7] + hi2f(w.w); }
    }
}
__device__ __forceinline__ void ph_gla_p3(const Frame& F) {
    const Params& P = *F.P;
    const bf16_t* PX = (const bf16_t*)(F.ws + WS_PX); bf16_t* CAT = (bf16_t*)(F.ws + WS_ACT);
    LAS float* G = (LAS float*)F.lds;
    LAS unsigned char* KB = F.lds + 33792;
    LAS unsigned char* VT = KB + 17408;
    LAS unsigned char* QB = VT + 18432;
    LAS unsigned char* QT = QB + 17408;
    LAS unsigned char* AM = QT + 17408;
    LAS float* RS = (LAS float*)(AM + 9216);
    const int l31 = F.lane & 31, hh = F.lane >> 5, l15 = F.lane & 15, kq = F.lane >> 4;
    for (int u = F.bid; u < 4224; u += F.G) {
        int b, h, ck, p0; size_t rbase; gla_geom(u, b, h, ck, rbase, p0);
#pragma unroll
        for (int k = 0; k < 2; ++k) { const int c = F.tid + 512 * k, i = c >> 4, part = c & 15;
            const bf16_t* row = PX + (rbase + p0 + i) * EVEN_IN;
            const u32x4 w = *(const u32x4*)(row + 1536 + h * 128 + part * 8);
            LAS unsigned short* d = (LAS unsigned short*)(VT + (part * 8) * 144 + i * 2);
            d[0 * 72] = (unsigned short)(w.x & 0xffffu); d[1 * 72] = (unsigned short)(w.x >> 16); d[2 * 72] = (unsigned short)(w.y & 0xffffu); d[3 * 72] = (unsigned short)(w.y >> 16);
            d[4 * 72] = (unsigned short)(w.z & 0xffffu); d[5 * 72] = (unsigned short)(w.z >> 16); d[6 * 72] = (unsigned short)(w.w & 0xffffu); d[7 * 72] = (unsigned short)(w.w >> 16);
            *(LAS u32x4*)(QB + i * 272 + part * 16) = *(const u32x4*)(row + 1024 + h * 128 + part * 8); }
        const int eb = F.wave >> 1, ib = F.wave & 1;
        f32x16 acc;
#pragma unroll
        for (int r = 0; r < 16; ++r) acc[r] = 0.f;
        for (int dir = 0; dir < 2; ++dir) {
            gla_prep_dir(F, dir, h, rbase, p0, G, KB);
#pragma unroll
            for (int k = 0; k < 2; ++k) { const int c = F.tid + 512 * k, i = c >> 4, part = c & 15, il = dir ? 63 - i : i;
                const u32x4 qw = *(const LAS u32x4*)(QB + i * 272 + part * 16);
                const f32x4 g0 = *(const LAS f32x4*)(G + il * GS + part * 8), g1 = *(const LAS f32x4*)(G + il * GS + part * 8 + 4);
                u32x4 o; o.x = pack2(lo2f(qw.x) * __expf(g0[0]), hi2f(qw.x) * __expf(g0[1])); o.y = pack2(lo2f(qw.y) * __expf(g0[2]), hi2f(qw.y) * __expf(g0[3]));
                o.z = pack2(lo2f(qw.z) * __expf(g1[0]), hi2f(qw.z) * __expf(g1[1])); o.w = pack2(lo2f(qw.w) * __expf(g1[2]), hi2f(qw.w) * __expf(g1[3]));
                *(LAS u32x4*)(QT + i * 272 + part * 16) = o; }
            for (int c = F.tid; c < 576; c += NTH) *(LAS u32x4*)(AM + c * 16) = (u32x4){0u, 0u, 0u, 0u};
            __syncthreads();
            for (int blk = F.wave; blk < 10; blk += 8) {
                const int I = blk < 1 ? 0 : (blk < 3 ? 1 : (blk < 6 ? 2 : 3)); const int J = blk - (I * (I + 1)) / 2;
                const int ia = 16 * I + l15, ja = 16 * J + l15;
                const int ina = dir ? 63 - ia : ia;
                f32x4 ac = {0.f, 0.f, 0.f, 0.f};
#pragma unroll
                for (int ks = 0; ks < 4; ++ks) { const int d0 = 32 * ks + 8 * kq;
                    f32x4 r0 = {0.f, 0.f, 0.f, 0.f}, r1 = {0.f, 0.f, 0.f, 0.f};
                    if (I > 0) { r0 = *(const LAS f32x4*)(G + (16 * I - 1) * GS + d0); r1 = *(const LAS f32x4*)(G + (16 * I - 1) * GS + d0 + 4); }
                    const f32x4 gi0 = *(const LAS f32x4*)(G + ia * GS + d0), gi1 = *(const LAS f32x4*)(G + ia * GS + d0 + 4);
                    const f32x4 gj0 = *(const LAS f32x4*)(G + ja * GS + d0), gj1 = *(const LAS f32x4*)(G + ja * GS + d0 + 4);
                    const u32x4 qw = *(const LAS u32x4*)(QB + ina * 272 + d0 * 2), kw = *(const LAS u32x4*)(KB + ja * 272 + d0 * 2);
                    u32x4 af, bf;
                    af.x = pack2(lo2f(qw.x) * __expf(gi0[0] - r0[0]), hi2f(qw.x) * __expf(gi0[1] - r0[1])); af.y = pack2(lo2f(qw.y) * __expf(gi0[2] - r0[2]), hi2f(qw.y) * __expf(gi0[3] - r0[3]));
                    af.z = pack2(lo2f(qw.z) * __expf(gi1[0] - r1[0]), hi2f(qw.z) * __expf(gi1[1] - r1[1])); af.w = pack2(lo2f(qw.w) * __expf(gi1[2] - r1[2]), hi2f(qw.w) * __expf(gi1[3] - r1[3]));
                    bf.x = pack2(lo2f(kw.x) * __expf(fminf(r0[0] - gj0[0], 80.f)), hi2f(kw.x) * __expf(fminf(r0[1] - gj0[1], 80.f))); bf.y = pack2(lo2f(kw.y) * __expf(fminf(r0[2] - gj0[2], 80.f)), hi2f(kw.y) * __expf(fminf(r0[3] - gj0[3], 80.f)));
                    bf.z = pack2(lo2f(kw.z) * __expf(fminf(r1[0] - gj1[0], 80.f)), hi2f(kw.z) * __expf(fminf(r1[1] - gj1[1], 80.f))); bf.w = pack2(lo2f(kw.w) * __expf(fminf(r1[2] - gj1[2], 80.f)), hi2f(kw.w) * __expf(fminf(r1[3] - gj1[3], 80.f)));
                    ac = __builtin_amdgcn_mfma_f32_16x16x32_bf16(__builtin_bit_cast(s16x8, af), __builtin_bit_cast(s16x8, bf), ac, 0, 0, 0); }
#pragma unroll
                for (int rg = 0; rg < 4; ++rg) { const int il = 16 * I + 4 * kq + rg, jl = 16 * J + l15; const float val = (jl <= il) ? ac[rg] : 0.f;
                    const int in_ = dir ? 63 - il : il, jn = dir ? 63 - jl : jl;
                    *(LAS bf16_t*)(AM + in_ * 144 + jn * 2) = f2bf(val); }
            }
            __syncthreads();
            { const bf16_t* st = (const bf16_t*)(F.ws + WS_R2 + R2_GU) + (size_t)(u * 2 + dir) * 16384 + (size_t)(32 * eb + l31) * 128 + hh * 8;
              s16x8 sf[8];
#pragma unroll
              for (int ds = 0; ds < 8; ++ds) sf[ds] = *(const s16x8*)(st + ds * 16);
#pragma unroll
              for (int ds = 0; ds < 8; ++ds) acc = __builtin_amdgcn_mfma_f32_32x32x16_bf16(sf[ds], *(const LAS s16x8*)(QT + (32 * ib + l31) * 272 + ds * 32 + hh * 16), acc, 0, 0, 0);
#pragma unroll
              for (int js = 0; js < 4; ++js) acc = __builtin_amdgcn_mfma_f32_32x32x16_bf16(*(const LAS s16x8*)(VT + (32 * eb + l31) * 144 + js * 32 + hh * 16), *(const LAS s16x8*)(AM + (32 * ib + l31) * 144 + js * 32 + hh * 16), acc, 0, 0, 0); }
            __syncthreads();
        }
        { float ss = 0.f;
#pragma unroll
          for (int r = 0; r < 16; ++r) ss += acc[r] * acc[r];
          auto t = __builtin_amdgcn_permlane32_swap(__float_as_uint(ss), __float_as_uint(ss), false, false);
          ss = __uint_as_float(t[0]) + __uint_as_float(t[1]);
          if (hh == 0) RS[eb * 64 + 32 * ib + l31] = ss;
          __syncthreads();
          const int i = 32 * ib + l31; const float tot = RS[i] + RS[64 + i] + RS[128 + i] + RS[192 + i];
          const float rstd = rsqrtf(tot * (1.f / 128.f) + EPS);
          const size_t row = rbase + p0 + i;
#pragma unroll
          for (int gq = 0; gq < 4; ++gq) { const int e0 = 32 * eb + 8 * gq + 4 * hh; const int ch = h * 128 + e0;
              const u32x2 gw = *(const u32x2*)(PX + row * EVEN_IN + 3072 + ch); const f32x4 nw = *(const f32x4*)(P.in[I_HNW] + ch);
              u32x2 o; o.x = pack2(acc[4 * gq] * rstd * nw[0] * silu_f(lo2f(gw.x)), acc[4 * gq + 1] * rstd * nw[1] * silu_f(hi2f(gw.x)));
              o.y = pack2(acc[4 * gq + 2] * rstd * nw[2] * silu_f(lo2f(gw.y)), acc[4 * gq + 3] * rstd * nw[3] * silu_f(hi2f(gw.y)));
              *(u32x2*)(CAT + row * 1024 + 512 + ch) = o; }
          __syncthreads(); }
    }
}

__device__ __forceinline__ void ph_merge(const Frame& F, int mode) {
    const Params& P = *F.P;
    const bf16_t* PX = (const bf16_t*)(F.ws + WS_PX); bf16_t* CAT = (bf16_t*)(F.ws + WS_ACT);
    const bf16_t* Of = (const bf16_t*)(mode ? F.ws + WS_GOF : F.ws + WS_R2 + R2_OF0); const bf16_t* Ob = (const bf16_t*)(mode ? F.ws + WS_WMOE : F.ws + WS_R2 + R2_OB0);
    const int nrows = mode ? TL : TT, ldp = mode ? ODD_PAD : EVEN_IN, gcol = mode ? 1536 : 3072, dcol = mode ? 0 : 512;
    const float* nw = mode ? P.in[I_GDNNW] : P.in[I_HNW];
    for (int r = F.bid * 8 + F.wave; r < nrows; r += F.G * 8) {
        const int c = F.lane * 8;
        const u32x4 a = *(const u32x4*)(Of + (size_t)r * 512 + c), bb = *(const u32x4*)(Ob + (size_t)r * 512 + c), gg = *(const u32x4*)(PX + (size_t)r * ldp + gcol + c);
        float o[8] = {lo2f(a.x) + lo2f(bb.x), hi2f(a.x) + hi2f(bb.x), lo2f(a.y) + lo2f(bb.y), hi2f(a.y) + hi2f(bb.y), lo2f(a.z) + lo2f(bb.z), hi2f(a.z) + hi2f(bb.z), lo2f(a.w) + lo2f(bb.w), hi2f(a.w) + hi2f(bb.w)};
        const float g[8] = {lo2f(gg.x), hi2f(gg.x), lo2f(gg.y), hi2f(gg.y), lo2f(gg.z), hi2f(gg.z), lo2f(gg.w), hi2f(gg.w)};
        float ss = 0.f;
#pragma unroll
        for (int i = 0; i < 8; ++i) ss += o[i] * o[i];
        ss = sum16(ss);
        const float rstd = rsqrtf(ss * (1.f / 128.f) + EPS);
        float y[8];
#pragma unroll
        for (int i = 0; i < 8; ++i) { const float w = mode ? nw[(c & 127) + i] : nw[c + i]; y[i] = o[i] * rstd * w * silu_f(g[i]); }
        u32x4 w; w.x = pack2(y[0], y[1]); w.y = pack2(y[2], y[3]); w.z = pack2(y[4], y[5]); w.w = pack2(y[6], y[7]);
        *(u32x4*)(CAT + (size_t)r * 1024 + dcol + c) = w;
    }
}

__device__ __forceinline__ void ph_mla_norm(const Frame& F) {
    const Params& P = *F.P;
    const bf16_t* PX = (const bf16_t*)(F.ws + WS_PX);
    bf16_t* cqn = (bf16_t*)(F.ws + WS_R2 + R2_CQN); bf16_t* ckvn = cqn + (size_t)TL * 256;
    for (int r = F.bid * 8 + F.wave; r < TT; r += F.G * 8) {
        const bf16_t* row = PX + (size_t)r * ODD_PAD;
        if (r < TL) { const u32x2 w = *(const u32x2*)(row + 2064 + F.lane * 4);
            const float x0 = lo2f(w.x), x1 = hi2f(w.x), x2 = lo2f(w.y), x3 = hi2f(w.y);
            const float ss = wave_sum(x0 * x0 + x1 * x1 + x2 * x2 + x3 * x3); const float rstd = rsqrtf(ss * (1.f / 256.f) + EPS);
            const float* nw = P.in[I_QNW] + F.lane * 4;
            u32x2 o; o.x = pack2(x0 * rstd * nw[0], x1 * rstd * nw[1]); o.y = pack2(x2 * rstd * nw[2], x3 * rstd * nw[3]);
            *(u32x2*)(cqn + (size_t)r * 256 + F.lane * 4) = o; }
        { const unsigned w = *(const unsigned*)(row + 2320 + F.lane * 2);
          const float x0 = lo2f(w), x1 = hi2f(w);
          const float ss = wave_sum(x0 * x0 + x1 * x1); const float rstd = rsqrtf(ss * (1.f / 128.f) + EPS);
          const float* nw = P.in[I_KVNW] + F.lane * 2;
          *(unsigned*)(ckvn + (size_t)r * 256 + F.lane * 2) = pack2(x0 * rstd * nw[0], x1 * rstd * nw[1]);
          *(unsigned*)(ckvn + (size_t)r * 256 + 128 + F.lane * 2) = 0u; }
    }
}

__device__ __forceinline__ void ph_mla_final(const Frame& F) {
    const Params& P = *F.P;
    const bf16_t* PX = (const bf16_t*)(F.ws + WS_PX);
    bf16_t* Q = (bf16_t*)(F.ws + WS_WMOE);
    const bf16_t* KVR = (const bf16_t*)(F.ws + WS_PX + PX_KVRAW);
    bf16_t* Kb = (bf16_t*)(F.ws + WS_R2 + R2_K); bf16_t* Vb = (bf16_t*)(F.ws + WS_R2 + R2_V);
    const int hh = F.lane >> 3, sub = F.lane & 7;
    const float freq = __powf(10000.f, -(float)sub * 0.125f);
    const float qscale = 0.10206207261596577f * 1.4426950408889634f;
    for (int r = F.bid * 8 + F.wave; r < TT; r += F.G * 8) {
        const bool lat = r < TL; const int l = r & (SEQ - 1);
        float ca = 1.f, sa = 0.f, cb = 1.f, sb = 0.f;
        if (lat) { const float pr = (float)(l >> 6), pc = (float)(l & 63); sincosf(pr * freq, &sa, &ca); sincosf(pc * freq, &sb, &cb); }
        { const bf16_t* kv = KVR + (size_t)r * 1024 + hh * 128;
          const u32x4 w = *(const u32x4*)(kv + sub * 8);
          float x[12] = {lo2f(w.x), hi2f(w.x), lo2f(w.y), hi2f(w.y), lo2f(w.z), hi2f(w.z), lo2f(w.w), hi2f(w.w), 0.f, 0.f, 0.f, 0.f};
          const bf16_t* kr = PX + (size_t)r * ODD_PAD + 2448;
          x[8] = bf2f(kr[sub]); x[9] = bf2f(kr[8 + sub]); x[10] = bf2f(kr[16 + sub]); x[11] = bf2f(kr[24 + sub]);
          float ss = 0.f;
#pragma unroll
          for (int i = 0; i < 12; ++i) ss += x[i] * x[i];
          ss = sum8(ss);
          const float rstd = rsqrtf(ss * (1.f / 96.f) + EPS);
          const float* nw = P.in[I_QKK];
#pragma unroll
          for (int i = 0; i < 8; ++i) x[i] *= rstd * nw[sub * 8 + i];
          x[8] *= rstd * nw[64 + sub]; x[9] *= rstd * nw[72 + sub]; x[10] *= rstd * nw[80 + sub]; x[11] *= rstd * nw[88 + sub];
          const float a1 = x[8] * ca - x[9] * sa, a2 = x[9] * ca + x[8] * sa, b1 = x[10] * cb - x[11] * sb, b2 = x[11] * cb + x[10] * sb;
          const int bidx = lat ? (r >> 13) : ((r - TL) >> 8); const int s = lat ? (CTXL + l) : ((r - TL) & 255);
          bf16_t* kd = Kb + ((size_t)(bidx * 8 + hh) * (SEQ + CTXL) + s) * 96;
          u32x4 o; o.x = pack2(x[0], x[1]); o.y = pack2(x[2], x[3]); o.z = pack2(x[4], x[5]); o.w = pack2(x[6], x[7]);
          *(u32x4*)(kd + sub * 8) = o;
          kd[64 + sub] = f2bf(a1); kd[72 + sub] = f2bf(a2); kd[80 + sub] = f2bf(b1); kd[88 + sub] = f2bf(b2);
          const u32x4 vv = *(const u32x4*)(kv + 64 + sub * 8);
          *(u32x4*)(Vb + ((size_t)(bidx * 8 + hh) * (SEQ + CTXL) + s) * 64 + sub * 8) = vv; }
        if (lat) { bf16_t* q = Q + (size_t)r * 768 + hh * 96;
          const u32x4 w = *(const u32x4*)(q + sub * 8);
          float x[12] = {lo2f(w.x), hi2f(w.x), lo2f(w.y), hi2f(w.y), lo2f(w.z), hi2f(w.z), lo2f(w.w), hi2f(w.w), bf2f(q[64 + sub]), bf2f(q[72 + sub]), bf2f(q[80 + sub]), bf2f(q[88 + sub])};
          float ss = 0.f;
#pragma unroll
          for (int i = 0; i < 12; ++i) ss += x[i] * x[i];
          ss = sum8(ss);
          const float rstd = rsqrtf(ss * (1.f / 96.f) + EPS) * qscale;
          const float* nw = P.in[I_QKQ];
#pragma unroll
          for (int i = 0; i < 8; ++i) x[i] *= rstd * nw[sub * 8 + i];
          x[8] *= rstd * nw[64 + sub]; x[9] *= rstd * nw[72 + sub]; x[10] *= rstd * nw[80 + sub]; x[11] *= rstd * nw[88 + sub];
          const float a1 = x[8] * ca - x[9] * sa, a2 = x[9] * ca + x[8] * sa, b1 = x[10] * cb - x[11] * sb, b2 = x[11] * cb + x[10] * sb;
          u32x4 o; o.x = pack2(x[0], x[1]); o.y = pack2(x[2], x[3]); o.z = pack2(x[4], x[5]); o.w = pack2(x[6], x[7]);
          *(u32x4*)(q + sub * 8) = o;
          q[64 + sub] = f2bf(a1); q[72 + sub] = f2bf(a2); q[80 + sub] = f2bf(b1); q[88 + sub] = f2bf(b2); }
    }
}

__device__ __forceinline__ void ph_attn_naive(const Frame& F) {
    const bf16_t* Q = (const bf16_t*)(F.ws + WS_WMOE);
    const bf16_t* Kb = (const bf16_t*)(F.ws + WS_R2 + R2_K); const bf16_t* Vb = (const bf16_t*)(F.ws + WS_R2 + R2_V);
    bf16_t* CAT = (bf16_t*)(F.ws + WS_ACT);
    LAS float* Ks = (LAS float*)F.lds;
    LAS float* Vs = Ks + 64 * 96;
    constexpr int NK = SEQ + CTXL;
    const int hf = F.tid & 1;
    for (int it = F.bid; it < 8 * 8 * 32; it += F.G) {
        const int b = it >> 8, h = (it >> 5) & 7, qb = it & 31;
        const int l = qb * 256 + (F.tid >> 1); const size_t trow = (size_t)b * SEQ + l;
        float q[48], o[32];
        { const bf16_t* qp = Q + trow * 768 + h * 96 + hf * 48;
#pragma unroll
          for (int i = 0; i < 6; ++i) { const u32x4 w = *(const u32x4*)(qp + i * 8);
            q[i * 8 + 0] = lo2f(w.x); q[i * 8 + 1] = hi2f(w.x); q[i * 8 + 2] = lo2f(w.y); q[i * 8 + 3] = hi2f(w.y); q[i * 8 + 4] = lo2f(w.z); q[i * 8 + 5] = hi2f(w.z); q[i * 8 + 6] = lo2f(w.w); q[i * 8 + 7] = hi2f(w.w); } }
#pragma unroll
        for (int d = 0; d < 32; ++d) o[d] = 0.f;
        float m = -3.0e38f, ls = 0.f;
        const bf16_t* kb = Kb + (size_t)(b * 8 + h) * NK * 96; const bf16_t* vb = Vb + (size_t)(b * 8 + h) * NK * 64;
        for (int kt = 0; kt < NK / 64; ++kt) {
            for (int i = F.tid; i < 64 * 96 / 8; i += NTH) { const u32x4 w = *(const u32x4*)(kb + (size_t)kt * 64 * 96 + i * 8); LAS float* d = Ks + i * 8;
                d[0] = lo2f(w.x); d[1] = hi2f(w.x); d[2] = lo2f(w.y); d[3] = hi2f(w.y); d[4] = lo2f(w.z); d[5] = hi2f(w.z); d[6] = lo2f(w.w); d[7] = hi2f(w.w); }
            { const int i = F.tid; const u32x4 w = *(const u32x4*)(vb + (size_t)kt * 64 * 64 + i * 8); LAS float* d = Vs + i * 8;
                d[0] = lo2f(w.x); d[1] = hi2f(w.x); d[2] = lo2f(w.y); d[3] = hi2f(w.y); d[4] = lo2f(w.z); d[5] = hi2f(w.z); d[6] = lo2f(w.w); d[7] = hi2f(w.w); }
            __syncthreads();
            for (int jb = 0; jb < 16; ++jb) {
                float s[4]; float mx = m;
#pragma unroll
                for (int jj = 0; jj < 4; ++jj) { const LAS float* kr = Ks + (jb * 4 + jj) * 96 + hf * 48; float a = 0.f;
#pragma unroll
                    for (int d = 0; d < 48; d += 4) { const f32x4 kv = *(const LAS f32x4*)(kr + d); a += q[d] * kv[0] + q[d + 1] * kv[1] + q[d + 2] * kv[2] + q[d + 3] * kv[3]; }
                    a += __shfl_xor(a, 1);
                    s[jj] = a; mx = fmaxf(mx, a); }
                const float sc = exp2f(m - mx); ls *= sc;
#pragma unroll
                for (int d = 0; d < 32; ++d) o[d] *= sc;
                m = mx;
#pragma unroll
                for (int jj = 0; jj < 4; ++jj) { const float p = exp2f(s[jj] - mx); ls += p; const LAS float* vr = Vs + (jb * 4 + jj) * 64 + hf * 32;
#pragma unroll
                    for (int d = 0; d < 32; d += 4) { const f32x4 vv = *(const LAS f32x4*)(vr + d); o[d] += p * vv[0]; o[d + 1] += p * vv[1]; o[d + 2] += p * vv[2]; o[d + 3] += p * vv[3]; } }
            }
            __syncthreads();
        }
        const float inv = 1.f / ls;
        bf16_t* dst = CAT + trow * 1024 + 512 + h * 64 + hf * 32;
#pragma unroll
        for (int i = 0; i < 4; ++i) { u32x4 w; w.x = pack2(o[i * 8] * inv, o[i * 8 + 1] * inv); w.y = pack2(o[i * 8 + 2] * inv, o[i * 8 + 3] * inv); w.z = pack2(o[i * 8 + 4] * inv, o[i * 8 + 5] * inv); w.w = pack2(o[i * 8 + 6] * inv, o[i * 8 + 7] * inv);
            *(u32x4*)(dst + i * 8) = w; }
    }
}

__device__ __forceinline__ void ph_attn(const Frame& F) {
    constexpr int NK = SEQ + CTXL, NT = NK / 64;
    constexpr int KROWB = 208, VROWB = 144, KBYTES = 64 * KROWB, VBYTES = 64 * VROWB, BUFB = KBYTES + VBYTES;
    const bf16_t* Q = (const bf16_t*)(F.ws + WS_WMOE);
    const bf16_t* Kb = (const bf16_t*)(F.ws + WS_R2 + R2_K); const bf16_t* Vb = (const bf16_t*)(F.ws + WS_R2 + R2_V);
    bf16_t* CAT = (bf16_t*)(F.ws + WS_ACT);
    const int l31 = F.lane & 31, hh = F.lane >> 5;
    const int vcu = (F.G % 8 == 0) ? (F.bid % 8) * (F.G / 8) + F.bid / 8 : F.bid;
    const int kc0 = F.tid, kc1 = F.tid + 512;
    const unsigned kd0 = (unsigned)((kc0 / 12) * KROWB + (kc0 % 12) * 16), kd1 = (unsigned)((kc1 / 12) * KROWB + (kc1 % 12) * 16);
    const int vkey = F.tid >> 3, vpos = (vkey & ~12) | ((vkey & 4) << 1) | ((vkey & 8) >> 1);
    const unsigned vd = (unsigned)(((F.tid & 7) * 8) * VROWB + vpos * 2);
    for (int u = vcu; u < 2048; u += F.G) {
        const int bh = u >> 5, qblk = u & 31, b = bh >> 3, h = bh & 7;
        const size_t trow = (size_t)b * SEQ + qblk * 256 + F.wave * 32 + l31;
        s16x8 qf[6];
        { const bf16_t* qp = Q + trow * 768 + h * 96 + hh * 8;
#pragma unroll
          for (int ds = 0; ds < 6; ++ds) qf[ds] = *(const s16x8*)(qp + ds * 16); }
        f32x16 o0, o1;
#pragma unroll
        for (int i = 0; i < 16; ++i) { o0[i] = 0.f; o1[i] = 0.f; }
        float m = -1.0e30f, lsum = 0.f;
        const bf16_t* kg = Kb + (size_t)bh * NK * 96; const bf16_t* vg = Vb + (size_t)bh * NK * 64;
        u32x4 kr0, kr1 = {0u, 0u, 0u, 0u}, vr;
        kr0 = *(const u32x4*)(kg + (size_t)kc0 * 8); if (kc1 < 768) kr1 = *(const u32x4*)(kg + (size_t)kc1 * 8); vr = *(const u32x4*)(vg + (size_t)F.tid * 8);
        __syncthreads();
        for (int t = 0; t < NT; ++t) {
            { LAS unsigned char* kbuf = F.lds + (t & 1) * BUFB; LAS unsigned char* vbuf = kbuf + KBYTES;
              *(LAS u32x4*)(kbuf + kd0) = kr0; if (kc1 < 768) *(LAS u32x4*)(kbuf + kd1) = kr1;
              LAS unsigned short* vp = (LAS unsigned short*)(vbuf + vd);
              vp[0 * (VROWB / 2)] = (unsigned short)(vr.x & 0xffffu); vp[1 * (VROWB / 2)] = (unsigned short)(vr.x >> 16);
              vp[2 * (VROWB / 2)] = (unsigned short)(vr.y & 0xffffu); vp[3 * (VROWB / 2)] = (unsigned short)(vr.y >> 16);
              vp[4 * (VROWB / 2)] = (unsigned short)(vr.z & 0xffffu); vp[5 * (VROWB / 2)] = (unsigned short)(vr.z >> 16);
              vp[6 * (VROWB / 2)] = (unsigned short)(vr.w & 0xffffu); vp[7 * (VROWB / 2)] = (unsigned short)(vr.w >> 16); }
            __syncthreads();
            if (t + 1 < NT) { const bf16_t* kt = kg + (size_t)(t + 1) * 64 * 96; const bf16_t* vt = vg + (size_t)(t + 1) * 64 * 64;
                kr0 = *(const u32x4*)(kt + (size_t)kc0 * 8); if (kc1 < 768) kr1 = *(const u32x4*)(kt + (size_t)kc1 * 8); vr = *(const u32x4*)(vt + (size_t)F.tid * 8); }
            const LAS unsigned char* kbuf = F.lds + (t & 1) * BUFB; const LAS unsigned char* vbuf = kbuf + KBYTES;
            f32x16 s0, s1;
#pragma unroll
            for (int i = 0; i < 16; ++i) { s0[i] = 0.f; s1[i] = 0.f; }
#pragma unroll
            for (int ds = 0; ds < 6; ++ds) {
                const s16x8 a0 = *(const LAS s16x8*)(kbuf + l31 * KROWB + ds * 32 + hh * 16);
                const s16x8 a1 = *(const LAS s16x8*)(kbuf + (32 + l31) * KROWB + ds * 32 + hh * 16);
                s0 = __builtin_amdgcn_mfma_f32_32x32x16_bf16(a0, qf[ds], s0, 0, 0, 0);
                s1 = __builtin_amdgcn_mfma_f32_32x32x16_bf16(a1, qf[ds], s1, 0, 0, 0);
            }
            float mx = s0[0];
#pragma unroll
            for (int i = 1; i < 16; ++i) mx = fmaxf(mx, s0[i]);
#pragma unroll
            for (int i = 0; i < 16; ++i) mx = fmaxf(mx, s1[i]);
            mx = fmaxf(mx, __shfl_xor(mx, 32));
            const float mn = fmaxf(m, mx); const bool moved = __any(mn > m); const float alpha = __builtin_amdgcn_exp2f(m - mn); m = mn;
            float ps = 0.f;
#pragma unroll
            for (int i = 0; i < 16; ++i) { s0[i] = __builtin_amdgcn_exp2f(s0[i] - mn); s1[i] = __builtin_amdgcn_exp2f(s1[i] - mn); ps += s0[i] + s1[i]; }
            lsum = lsum * alpha + ps;
            if (moved) {
#pragma unroll
                for (int i = 0; i < 16; ++i) { o0[i] *= alpha; o1[i] *= alpha; } }
#pragma unroll
            for (int kb = 0; kb < 2; ++kb)
#pragma unroll
                for (int st = 0; st < 2; ++st) {
                    u32x4 pw;
                    if (kb == 0) { pw.x = pack2(s0[8 * st + 0], s0[8 * st + 1]); pw.y = pack2(s0[8 * st + 2], s0[8 * st + 3]); pw.z = pack2(s0[8 * st + 4], s0[8 * st + 5]); pw.w = pack2(s0[8 * st + 6], s0[8 * st + 7]); }
                    else         { pw.x = pack2(s1[8 * st + 0], s1[8 * st + 1]); pw.y = pack2(s1[8 * st + 2], s1[8 * st + 3]); pw.z = pack2(s1[8 * st + 4], s1[8 * st + 5]); pw.w = pack2(s1[8 * st + 6], s1[8 * st + 7]); }
                    const s16x8 pf = __builtin_bit_cast(s16x8, pw);
                    const int kof = (kb * 32 + 16 * st + 8 * hh) * 2;
                    o0 = __builtin_amdgcn_mfma_f32_32x32x16_bf16(*(const LAS s16x8*)(vbuf + l31 * VROWB + kof), pf, o0, 0, 0, 0);
                    o1 = __builtin_amdgcn_mfma_f32_32x32x16_bf16(*(const LAS s16x8*)(vbuf + (32 + l31) * VROWB + kof), pf, o1, 0, 0, 0);
                }
        }
        const float ltot = lsum + __shfl_xor(lsum, 32); const float inv = 1.f / ltot;
        bf16_t* dst = CAT + trow * 1024 + 512 + h * 64 + hh * 4;
#pragma unroll
        for (int g = 0; g < 4; ++g) { u32x2 w;
            w.x = pack2(o0[4 * g] * inv, o0[4 * g + 1] * inv); w.y = pack2(o0[4 * g + 2] * inv, o0[4 * g + 3] * inv); *(u32x2*)(dst + g * 8) = w;
            w.x = pack2(o1[4 * g] * inv, o1[4 * g + 1] * inv); w.y = pack2(o1[4 * g + 2] * inv, o1[4 * g + 3] * inv); *(u32x2*)(dst + 32 + g * 8) = w; }
    }
    __syncthreads();
}

__device__ __forceinline__ void ph_attn2(const Frame& F) {
    constexpr int NK = SEQ + CTXL, NT = NK / 64;
    constexpr int KROWB = 208, VROWB = 144, KBYTES = 64 * KROWB, VBYTES = 64 * VROWB, BUFB = KBYTES + VBYTES;
    const bf16_t* Q = (const bf16_t*)(F.ws + WS_WMOE);
    const bf16_t* Kb = (const bf16_t*)(F.ws + WS_R2 + R2_K); const bf16_t* Vb = (const bf16_t*)(F.ws + WS_R2 + R2_V);
    bf16_t* CAT = (bf16_t*)(F.ws + WS_ACT);
    const int l31 = F.lane & 31, hh = F.lane >> 5;
    const int vcu = (F.G % 8 == 0) ? (F.bid % 8) * (F.G / 8) + F.bid / 8 : F.bid;
    const int kc0 = F.tid, kc1 = F.tid + 512;
    const unsigned kd0 = (unsigned)((kc0 / 12) * KROWB + (kc0 % 12) * 16), kd1 = (unsigned)((kc1 / 12) * KROWB + (kc1 % 12) * 16);
    const int vkey = F.lane, vpos = (vkey & ~12) | ((vkey & 4) << 1) | ((vkey & 8) >> 1);
    const unsigned vd = (unsigned)((F.wave * 8) * VROWB + vpos * 2);
    const unsigned vgo = (unsigned)(F.lane * 64 + F.wave * 8);
    const bool grpB = F.wave >= 4;
    for (int u = vcu; u < 2048; u += F.G) {
        const int bh = u >> 5, qblk = u & 31, b = bh >> 3, h = bh & 7;
        const size_t trow = (size_t)b * SEQ + qblk * 256 + F.wave * 32 + l31;
        s16x8 qf[6];
        { const bf16_t* qp = Q + trow * 768 + h * 96 + hh * 8;
#pragma unroll
          for (int ds = 0; ds < 6; ++ds) qf[ds] = *(const s16x8*)(qp + ds * 16); }
        f32x16 o0, o1, s0, s1;
#pragma unroll
        for (int i = 0; i < 16; ++i) { o0[i] = 0.f; o1[i] = 0.f; }
        float m = -1.0e30f, lsum = 0.f;
        const bf16_t* kg = Kb + (size_t)bh * NK * 96; const bf16_t* vg = Vb + (size_t)bh * NK * 64;
        u32x4 kr0, kr1 = {0u, 0u, 0u, 0u}, vr;
#define AT_LOADK(t) do { if ((t) < NT) { const bf16_t* kt_ = kg + (size_t)(t) * 64 * 96; kr0 = *(const u32x4*)(kt_ + (size_t)kc0 * 8); if (kc1 < 768) kr1 = *(const u32x4*)(kt_ + (size_t)kc1 * 8); } } while (0)
#define AT_LOADV(t) do { if ((t) < NT) vr = *(const u32x4*)(vg + (size_t)(t) * 64 * 64 + vgo); } while (0)
#define AT_PUTK(t) do { if ((t) < NT) { LAS unsigned char* kb_ = F.lds + ((t) % 3) * BUFB; *(LAS u32x4*)(kb_ + kd0) = kr0; if (kc1 < 768) *(LAS u32x4*)(kb_ + kd1) = kr1; } } while (0)
#define AT_PUTV(t) do { if ((t) < NT) { LAS unsigned short* vp = (LAS unsigned short*)(F.lds + ((t) % 3) * BUFB + KBYTES + vd); \
            vp[0 * (VROWB / 2)] = (unsigned short)(vr.x & 0xffffu); vp[1 * (VROWB / 2)] = (unsigned short)(vr.x >> 16); vp[2 * (VROWB / 2)] = (unsigned short)(vr.y & 0xffffu); vp[3 * (VROWB / 2)] = (unsigned short)(vr.y >> 16); \
            vp[4 * (VROWB / 2)] = (unsigned short)(vr.z & 0xffffu); vp[5 * (VROWB / 2)] = (unsigned short)(vr.z >> 16); vp[6 * (VROWB / 2)] = (unsigned short)(vr.w & 0xffffu); vp[7 * (VROWB / 2)] = (unsigned short)(vr.w >> 16); } } while (0)
#define AT_QK(t) do { const LAS unsigned char* kbuf = F.lds + ((t) % 3) * BUFB; s16x8 ka_[6], kb2_[6]; \
            _Pragma("unroll") for (int ds = 0; ds < 6; ++ds) { ka_[ds] = *(const LAS s16x8*)(kbuf + l31 * KROWB + ds * 32 + hh * 16); kb2_[ds] = *(const LAS s16x8*)(kbuf + (32 + l31) * KROWB + ds * 32 + hh * 16); } \
            _Pragma("unroll") for (int i = 0; i < 16; ++i) { s0[i] = 0.f; s1[i] = 0.f; } \
            _Pragma("unroll") for (int ds = 0; ds < 6; ++ds) { \
                s0 = __builtin_amdgcn_mfma_f32_32x32x16_bf16(ka_[ds], qf[ds], s0, 0, 0, 0); s1 = __builtin_amdgcn_mfma_f32_32x32x16_bf16(kb2_[ds], qf[ds], s1, 0, 0, 0); } } while (0)
#define AT_SMPV(t) do { const LAS unsigned char* vbuf = F.lds + ((t) % 3) * BUFB + KBYTES; s16x8 va_[4], vb2_[4]; \
            _Pragma("unroll") for (int q = 0; q < 4; ++q) { const int kof = ((q >> 1) * 32 + 16 * (q & 1) + 8 * hh) * 2; va_[q] = *(const LAS s16x8*)(vbuf + l31 * VROWB + kof); vb2_[q] = *(const LAS s16x8*)(vbuf + (32 + l31) * VROWB + kof); } \
            float mx = s0[0]; \
            _Pragma("unroll") for (int i = 1; i < 16; ++i) mx = fmaxf(mx, s0[i]); \
            _Pragma("unroll") for (int i = 0; i < 16; ++i) mx = fmaxf(mx, s1[i]); \
            { auto sw_ = __builtin_amdgcn_permlane32_swap(__float_as_uint(mx), __float_as_uint(mx), false, false); mx = fmaxf(__uint_as_float(sw_[0]), __uint_as_float(sw_[1])); } \
            const float mn = fmaxf(m, mx); const bool moved = __any(mn > m); const float alpha = __builtin_amdgcn_exp2f(m - mn); m = mn; \
            float ps = 0.f; \
            _Pragma("unroll") for (int i = 0; i < 16; ++i) { s0[i] = __builtin_amdgcn_exp2f(s0[i] - mn); s1[i] = __builtin_amdgcn_exp2f(s1[i] - mn); ps += s0[i] + s1[i]; } \
            lsum = lsum * alpha + ps; \
            if (moved) { _Pragma("unroll") for (int i = 0; i < 16; ++i) { o0[i] *= alpha; o1[i] *= alpha; } } \
            _Pragma("unroll") for (int q = 0; q < 4; ++q) { \
                const s16x8 pf = pack8((q >> 1) == 0 ? s0 : s1, 8 * (q & 1)); \
                o0 = __builtin_amdgcn_mfma_f32_32x32x16_bf16(va_[q], pf, o0, 0, 0, 0); \
                o1 = __builtin_amdgcn_mfma_f32_32x32x16_bf16(vb2_[q], pf, o1, 0, 0, 0); } } while (0)
        __syncthreads();
        AT_LOADK(0); AT_LOADV(0); AT_PUTK(0); AT_PUTV(0); AT_LOADK(1);
        __syncthreads();
        if (!grpB) {
            for (int t = 0; t < NT; ++t) {
                AT_LOADV(t + 1); AT_QK(t); AT_PUTK(t + 1);
                __syncthreads();
                AT_LOADK(t + 2); AT_SMPV(t); AT_PUTV(t + 1);
                __syncthreads();
            }
            __syncthreads();
        } else {
            AT_PUTK(1); AT_LOADV(1);
            __syncthreads();
            for (int t = 0; t < NT; ++t) {
                AT_LOADK(t + 2); AT_QK(t); AT_PUTV(t + 1);
                __syncthreads();
                AT_LOADV(t + 2); AT_SMPV(t); AT_PUTK(t + 2);
                __syncthreads();
            }
        }
#undef AT_LOADK
#undef AT_LOADV
#undef AT_PUTK
#undef AT_PUTV
#undef AT_QK
#undef AT_SMPV
        float ltot; { auto sw_ = __builtin_amdgcn_permlane32_swap(__float_as_uint(lsum), __float_as_uint(lsum), false, false); ltot = __uint_as_float(sw_[0]) + __uint_as_float(sw_[1]); }
        const float inv = 1.f / ltot;
        bf16_t* dst = CAT + trow * 1024 + 512 + h * 64 + hh * 4;
#pragma unroll
        for (int g = 0; g < 4; ++g) { u32x2 w;
            w.x = pack2(o0[4 * g] * inv, o0[4 * g + 1] * inv); w.y = pack2(o0[4 * g + 2] * inv, o0[4 * g + 3] * inv); *(u32x2*)(dst + g * 8) = w;
            w.x = pack2(o1[4 * g] * inv, o1[4 * g + 1] * inv); w.y = pack2(o1[4 * g + 2] * inv, o1[4 * g + 3] * inv); *(u32x2*)(dst + 32 + g * 8) = w; }
    }
    __syncthreads();
}

__device__ __forceinline__ void ph_gdn(const Frame& F) {
    const Params& P = *F.P;
    const bf16_t* PX = (const bf16_t*)(F.ws + WS_PX);
    LAS bf16_t* rq = (LAS bf16_t*)F.lds;
    LAS bf16_t* rk = rq + 36 * 128;
    LAS bf16_t* rv = rk + 36 * 128;
    LAS float* qc = (LAS float*)(F.lds + 24576);
    LAS float* kc = qc + 4096;
    LAS float* vc = kc + 4096;
    LAS float* os = vc + 1024;
    LAS float* ba = os + 1024;
    const int dg = F.lane & 15, el = F.wave * 4 + (F.lane >> 4);
    for (int it = F.bid; it < 256; it += F.G) {
        const int b = it >> 5, h = (it >> 3) & 3, dir = (it >> 2) & 1, sl = it & 3;
        bf16_t* O = dir ? (bf16_t*)(F.ws + WS_WMOE) : (bf16_t*)(F.ws + WS_GOF);
        const float a_neg = -__expf(P.in[I_ALOG][dir * 4 + h]), dtb = P.in[I_DTB][dir * 4 + h];
        float cwq[5], cwk[5], cwv[5];
        { const int d = F.tid & 127;
#pragma unroll
          for (int j = 0; j < 5; ++j) { cwq[j] = P.in[I_CONVW][j * 1536 + h * 128 + d]; cwk[j] = P.in[I_CONVW][j * 1536 + 512 + h * 128 + d]; cwv[j] = P.in[I_CONVW][j * 1536 + 1024 + h * 128 + sl * 32 + (F.tid & 31)]; } }
        float S[8];
#pragma unroll
        for (int i = 0; i < 8; ++i) S[i] = 0.f;
        u32x4 pr0, pr1, pr2; float pbeta = 0.f, pdec = 0.f;
        auto blk_geom = [&](int bi, int& len, size_t& rbase, int& p0) { const bool c = bi < 8; len = c ? CTXL : SEQ; rbase = c ? (size_t)TL + b * CTXL : (size_t)b * SEQ;
            const int nbk = len / 32, k = c ? bi : bi - 8; p0 = (dir ? (nbk - 1 - k) : k) * 32; };
        auto fetch = [&](int bi, int id) -> u32x4 { int len, p0; size_t rbase; blk_geom(bi, len, rbase, p0);
            u32x4 z = {0u, 0u, 0u, 0u}; if (id >= 1296) return z;
            int arr = 0, j = id; if (j >= 1152) { arr = 2; j -= 1152; } else if (j >= 576) { arr = 1; j -= 576; }
            const int rr = arr == 2 ? (j >> 2) : (j >> 4), part = arr == 2 ? (j & 3) : (j & 15); const int p = p0 - 2 + rr;
            if (p < 0 || p >= len) return z;
            const bf16_t* row = PX + (rbase + p) * ODD_PAD + (arr == 0 ? h * 128 : (arr == 1 ? 512 + h * 128 : 1024 + h * 128 + sl * 32)) + part * 8;
            return *(const u32x4*)row; };
        auto stash = [&](int id, u32x4 w) { if (id >= 1296) return; int arr = 0, j = id; if (j >= 1152) { arr = 2; j -= 1152; } else if (j >= 576) { arr = 1; j -= 576; }
            LAS bf16_t* d = arr == 0 ? rq + j * 8 : (arr == 1 ? rk + j * 8 : rv + j * 8); *(LAS u32x4*)d = w; };
        auto fetch_all = [&](int bi) { pr0 = fetch(bi, F.tid); pr1 = fetch(bi, F.tid + 512); pr2 = fetch(bi, F.tid + 1024);
            if (F.tid < 32) { int len, p0; size_t rbase; blk_geom(bi, len, rbase, p0); const bf16_t* row = PX + (rbase + p0 + F.tid) * ODD_PAD;
                pbeta = bf2f(row[2048 + dir * 4 + h]); pdec = bf2f(row[2056 + dir * 4 + h]); } };
        fetch_all(0);
        for (int bi = 0; bi < 264; ++bi) {
            __syncthreads();
            stash(F.tid, pr0); stash(F.tid + 512, pr1); stash(F.tid + 1024, pr2);
            if (F.tid < 32) { ba[F.tid] = sigmoid_f(pbeta); ba[32 + F.tid] = __expf(a_neg * softplus_f(pdec + dtb)); }
            __syncthreads();
            if (bi + 1 < 264) fetch_all(bi + 1);
            { const int d = F.tid & 127;
#pragma unroll
              for (int i = 0; i < 8; ++i) { const int s = (F.tid >> 7) + i * 4; float a = 0.f, c = 0.f;
#pragma unroll
                for (int j = 0; j < 5; ++j) { a += bf2f(rq[(s + j) * 128 + d]) * cwq[j]; c += bf2f(rk[(s + j) * 128 + d]) * cwk[j]; }
                qc[s * 128 + d] = silu_f(a); kc[s * 128 + d] = silu_f(c); }
#pragma unroll
              for (int i = 0; i < 2; ++i) { const int s = (F.tid >> 5) + i * 16, e = F.tid & 31; float a = 0.f;
#pragma unroll
                for (int j = 0; j < 5; ++j) a += bf2f(rv[(s + j) * 32 + e]) * cwv[j];
                vc[s * 32 + e] = silu_f(a); } }
            __syncthreads();
            { const int s = F.wave * 4 + (F.lane >> 4);
              LAS float* qp = qc + s * 128 + dg * 8; LAS float* kp = kc + s * 128 + dg * 8;
              f32x4 q0 = *(LAS f32x4*)qp, q1 = *(LAS f32x4*)(qp + 4), k0 = *(LAS f32x4*)kp, k1 = *(LAS f32x4*)(kp + 4);
              float sq = 0.f, sk = 0.f;
#pragma unroll
              for (int i = 0; i < 4; ++i) { sq += q0[i] * q0[i] + q1[i] * q1[i]; sk += k0[i] * k0[i] + k1[i] * k1[i]; }
              sq = sum16(sq); sk = sum16(sk);
              const float rq_ = rsqrtf(sq + EPS) * 0.08838834764831845f, rk_ = rsqrtf(sk + EPS);
              *(LAS f32x4*)qp = q0 * rq_; *(LAS f32x4*)(qp + 4) = q1 * rq_; *(LAS f32x4*)kp = k0 * rk_; *(LAS f32x4*)(kp + 4) = k1 * rk_; }
            __syncthreads();
#pragma unroll 2
            for (int ss = 0; ss < 32; ++ss) {
                const int st = dir ? 31 - ss : ss;
                const f32x4 ka = *(const LAS f32x4*)(kc + st * 128 + dg * 8), kb = *(const LAS f32x4*)(kc + st * 128 + dg * 8 + 4);
                const f32x4 qa = *(const LAS f32x4*)(qc + st * 128 + dg * 8), qb = *(const LAS f32x4*)(qc + st * 128 + dg * 8 + 4);
                const float v = vc[st * 32 + el], beta = ba[st], a = ba[32 + st];
                float r0 = 0.f, r1 = 0.f;
#pragma unroll
                for (int i = 0; i < 4; ++i) { r0 += ka[i] * S[i]; r1 += kb[i] * S[4 + i]; }
                const float r = sum16(r0 + r1);
                const float u = beta * (v - a * r);
                float p0 = 0.f, p1 = 0.f;
#pragma unroll
                for (int i = 0; i < 4; ++i) { S[i] = a * S[i] + ka[i] * u; p0 += qa[i] * S[i]; S[4 + i] = a * S[4 + i] + kb[i] * u; p1 += qb[i] * S[4 + i]; }
                const float o = sum16(p0 + p1);
                if (dg == 0) os[st * 32 + el] = o;
            }
            __syncthreads();
            { int len, p0; size_t rbase; blk_geom(bi, len, rbase, p0);
              const int s = F.tid >> 4, e2 = (F.tid & 15) * 2;
              *(unsigned*)(O + (rbase + p0 + s) * 512 + h * 128 + sl * 32 + e2) = pack2(os[s * 32 + e2], os[s * 32 + e2 + 1]); }
        }
        __syncthreads();
    }
}

constexpr int GR_KN = 0, GR_QN = 16384, GR_VT = 32768, GR_T = 49152, GR_QK = 65536, GR_SC = 81920, GR_BYTES = 83968;
__device__ __forceinline__ s16x8 ld2x64(const LAS unsigned char* p) {
    const u32x2 a = *(const LAS u32x2*)p, b = *(const LAS u32x2*)(p + 16); u32x4 v; v.x = a.x; v.y = a.y; v.z = b.x; v.w = b.y; return __builtin_bit_cast(s16x8, v);
}
__device__ __forceinline__ void st2x64(LAS unsigned char* p, u32x4 v) { u32x2 a, b; a.x = v.x; a.y = v.y; b.x = v.z; b.y = v.w; *(LAS u32x2*)p = a; *(LAS u32x2*)(p + 8) = b; }
__device__ __forceinline__ u32x4 ld2x64n(const LAS unsigned char* p) { const u32x2 a = *(const LAS u32x2*)p, b = *(const LAS u32x2*)(p + 8); u32x4 v; v.x = a.x; v.y = a.y; v.z = b.x; v.w = b.y; return v; }
__device__ __forceinline__ void gdn_unit_geom(int b, int ck, size_t& rbase, int& len, int& p0) {
    if (ck < 4) { rbase = (size_t)TL + b * CTXL; len = CTXL; p0 = ck * 64; } else { rbase = (size_t)b * SEQ; len = SEQ; p0 = (ck - 4) * 64; }
}
__device__ __forceinline__ void ph_gdn_prep(const Frame& F) {
    const Params& P = *F.P;
    const bf16_t* PX = (const bf16_t*)(F.ws + WS_PX);
    LAS unsigned char* L = F.lds;
    LAS bf16_t* RAW = (LAS bf16_t*)L;
    LAS unsigned char* KNI = L; LAS unsigned char* QNI = L + 16896;
    LAS float* qf = (LAS float*)(L + 52224);
    LAS float* kf = qf + 8192;
    LAS unsigned char* VTI = L + 52224 + 65536;
    LAS float* SCL = (LAS float*)(L + 52224 + 65536 + 17408);
    const int l31 = F.lane & 31, hh = F.lane >> 5;
    for (int u = F.bid; u < 4224; u += F.G) {
        const int b = u / 528, h = (u % 528) / 132, ck = u % 132;
        size_t rbase; int len, p0; gdn_unit_geom(b, ck, rbase, len, p0);
        unsigned char* rec = F.ws + WS_GREC + (size_t)u * GR_BYTES;
        for (int c = F.tid; c < 68 * 48; c += NTH) { const int rr = c / 48, part = c % 48; const int p = p0 - 2 + rr; u32x4 w = {0u, 0u, 0u, 0u};
            if (p >= 0 && p < len) w = *(const u32x4*)(PX + (rbase + p) * ODD_PAD + (part >> 4) * 512 + h * 128 + (part & 15) * 8);
            *(LAS u32x4*)(RAW + rr * 384 + part * 8) = w; }
        if (F.tid < 64) { const bf16_t* row = PX + (rbase + p0 + F.tid) * ODD_PAD;
            const float an_f = -__expf(P.in[I_ALOG][h]), an_b = -__expf(P.in[I_ALOG][4 + h]);
            SCL[256 + F.tid] = sigmoid_f(bf2f(row[2048 + h])); SCL[320 + F.tid] = sigmoid_f(bf2f(row[2052 + h]));
            SCL[F.tid] = an_f * softplus_f(bf2f(row[2056 + h]) + P.in[I_DTB][h]); SCL[64 + F.tid] = an_b * softplus_f(bf2f(row[2060 + h]) + P.in[I_DTB][4 + h]); }
        __syncthreads();
        { const int d = F.tid & 127, rg = F.tid >> 7;
          float cq[5], ckk[5], cv[5];
#pragma unroll
          for (int j = 0; j < 5; ++j) { cq[j] = P.in[I_CONVW][j * 1536 + h * 128 + d]; ckk[j] = P.in[I_CONVW][j * 1536 + 512 + h * 128 + d]; cv[j] = P.in[I_CONVW][j * 1536 + 1024 + h * 128 + d]; }
#pragma unroll 4
          for (int ii = 0; ii < 16; ++ii) { const int i = rg * 16 + ii; float a = 0.f, c = 0.f, e = 0.f;
#pragma unroll
              for (int j = 0; j < 5; ++j) { const LAS bf16_t* rr = RAW + (i + j) * 384 + d; a += bf2f(rr[0]) * cq[j]; c += bf2f(rr[128]) * ckk[j]; e += bf2f(rr[256]) * cv[j]; }
              qf[i * 128 + d] = silu_f(a); kf[i * 128 + d] = silu_f(c);
              *(LAS bf16_t*)(VTI + d * 136 + i * 2) = f2bf(silu_f(e)); } }
        if (F.tid < 64) { float gf = 0.f, gb = 0.f;
            for (int j = 0; j < 64; ++j) { gf += (j <= F.tid) ? SCL[j] : 0.f; gb += (j >= F.tid) ? SCL[64 + j] : 0.f; }
            SCL[128 + F.tid] = gf; SCL[192 + F.tid] = gb; }
        __syncthreads();
#pragma unroll
        for (int rr = 0; rr < 8; ++rr) { const int i = F.wave * 8 + rr;
            const float q0 = qf[i * 128 + F.lane], q1 = qf[i * 128 + 64 + F.lane], k0 = kf[i * 128 + F.lane], k1 = kf[i * 128 + 64 + F.lane];
            const float sq = wave_sum(q0 * q0 + q1 * q1), sk = wave_sum(k0 * k0 + k1 * k1);
            const float rq_ = rsqrtf(sq + EPS) * 0.08838834764831845f, rk_ = rsqrtf(sk + EPS);
            *(LAS bf16_t*)(QNI + i * 264 + F.lane * 2) = f2bf(q0 * rq_); *(LAS bf16_t*)(QNI + i * 264 + 128 + F.lane * 2) = f2bf(q1 * rq_);
            *(LAS bf16_t*)(KNI + i * 264 + F.lane * 2) = f2bf(k0 * rk_); *(LAS bf16_t*)(KNI + i * 264 + 128 + F.lane * 2) = f2bf(k1 * rk_); }
        __syncthreads();
        { const int mq = F.wave >> 2, ib = (F.wave >> 1) & 1, jb = F.wave & 1;
          const LAS unsigned char* Ai = (mq ? QNI : KNI) + (32 * ib + l31) * 264 + hh * 16; const LAS unsigned char* Bi = KNI + (32 * jb + l31) * 264 + hh * 16;
          f32x16 acc;
#pragma unroll
          for (int r = 0; r < 16; ++r) acc[r] = 0.f;
#pragma unroll
          for (int ds = 0; ds < 8; ++ds) acc = __builtin_amdgcn_mfma_f32_32x32x16_bf16(__builtin_bit_cast(s16x8, ld2x64n(Ai + ds * 32)), __builtin_bit_cast(s16x8, ld2x64n(Bi + ds * 32)), acc, 0, 0, 0);
          __syncthreads();
          const int j = 32 * jb + l31; const float gfj = SCL[128 + j], gbj = SCL[192 + j];
          bf16_t* qkf = (bf16_t*)(rec + GR_QK); bf16_t* qkb = qkf + 4096;
#pragma unroll
          for (int r = 0; r < 16; ++r) { const int i = 32 * ib + (r & 3) + 8 * (r >> 2) + 4 * hh;
              const float ef = __expf(fminf(SCL[128 + i] - gfj, 0.f)), eb = __expf(fminf(SCL[192 + i] - gbj, 0.f));
              if (mq == 0) { qf[i * 64 + j] = (j < i) ? SCL[256 + i] * acc[r] * ef : 0.f; kf[(63 - i) * 64 + (63 - j)] = (j > i) ? SCL[320 + i] * acc[r] * eb : 0.f; }
              else { qkf[i * 64 + j] = f2bf((j <= i) ? acc[r] * ef : 0.f); qkb[i * 64 + j] = f2bf((j >= i) ? acc[r] * eb : 0.f); } } }
        __syncthreads();
        if (F.wave < 2) {
            const LAS float* Am = F.wave == 0 ? qf : kf; LAS float* Tl = (F.wave == 0 ? qf : kf) + 4096; const int c = F.lane;
            for (int i = 0; i < 64; ++i) Tl[i * 64 + c] = 0.f;
#pragma unroll
            for (int rb = 0; rb < 4; ++rb) {
#pragma unroll 1
                for (int ii = 0; ii < 16; ++ii) { const int i = rb * 16 + ii; float a0 = (c == i) ? 1.f : 0.f, a1 = 0.f;
#pragma unroll
                    for (int jg = 0; jg < 4 * (rb + 1); ++jg) { const f32x4 m = *(const LAS f32x4*)(Am + i * 64 + jg * 4);
                        a0 -= m[0] * Tl[(jg * 4 + 0) * 64 + c]; a1 -= m[1] * Tl[(jg * 4 + 1) * 64 + c]; a0 -= m[2] * Tl[(jg * 4 + 2) * 64 + c]; a1 -= m[3] * Tl[(jg * 4 + 3) * 64 + c]; }
                    Tl[i * 64 + c] = a0 + a1; } }
            bf16_t* Tg = (bf16_t*)(rec + GR_T) + (F.wave ? 4096 : 0);
            for (int i = 0; i < 64; ++i) { const bf16_t v = f2bf(Tl[i * 64 + c]); if (F.wave == 0) Tg[i * 64 + c] = v; else Tg[(63 - i) * 64 + (63 - c)] = v; }
        } else {
            const int t6 = F.tid - 128;
            for (int c = t6; c < 3072; c += 384) {
                u32x4 w; if (c < 2048) { const int cc = c & 1023, row = cc >> 4, part = cc & 15; w = ld2x64n((c < 1024 ? KNI : QNI) + row * 264 + part * 16); }
                else { const int cc = c - 2048, row = cc >> 3, part = cc & 7; w = ld2x64n(VTI + row * 136 + part * 16); }
                *(u32x4*)(rec + (size_t)c * 16) = w; }
            if (t6 < 64) { float* sc = (float*)(rec + GR_SC); const int i = t6;
                const float gf = SCL[128 + i], gb = SCL[192 + i], glf = SCL[128 + 63], glb = SCL[192 + 0];
                sc[i] = SCL[256 + i]; sc[64 + i] = __expf(gf); sc[128 + i] = __expf(glf - gf);
                sc[192 + i] = SCL[320 + i]; sc[256 + i] = __expf(gb); sc[320 + i] = __expf(glb - gb);
                if (i == 0) { sc[384] = __expf(glf); sc[385] = __expf(glb); } }
        }
        __syncthreads();
    }
}

__device__ __forceinline__ void ph_gdn_scan(const Frame& F) {
    LAS unsigned char* L = F.lds;
    LAS unsigned char* KNI = L;
    LAS unsigned char* QNI = L + 16896;
    LAS unsigned char* VTI = L + 33792;
    LAS unsigned char* KTI = L + 51200;
    LAS unsigned char* TI = L + 68608;
    LAS unsigned char* QKI = L + 77312;
    LAS float* SC = (LAS float*)(L + 86016);
    const int l31 = F.lane & 31, hh = F.lane >> 5, w = F.wave;
    for (int it = F.bid; it < 64; it += F.G) {
        const int b = it >> 3, h = (it >> 1) & 3, dir = it & 1;
        bf16_t* O = dir ? (bf16_t*)(F.ws + WS_WMOE) : (bf16_t*)(F.ws + WS_GOF);
        f32x16 S0, S1, S2, S3;
#pragma unroll
        for (int r = 0; r < 16; ++r) { S0[r] = 0.f; S1[r] = 0.f; S2[r] = 0.f; S3[r] = 0.f; }
        u32x4 pre[16]; float psc = 0.f;
        const int t4 = F.tid - 256;
        auto ckof = [&](int n) -> int { return dir ? (n < 4 ? 3 - n : 135 - n) : n; };
        auto fetch = [&](int n) { const unsigned char* rec = F.ws + WS_GREC + (size_t)((b * 4 + h) * 132 + ckof(n)) * GR_BYTES;
#pragma unroll
            for (int k = 0; k < 12; ++k) pre[k] = *(const u32x4*)(rec + (size_t)(t4 + 256 * k) * 16);
#pragma unroll
            for (int k = 0; k < 2; ++k) { pre[12 + k] = *(const u32x4*)(rec + GR_T + dir * 8192 + (t4 + 256 * k) * 16); pre[14 + k] = *(const u32x4*)(rec + GR_QK + dir * 8192 + (t4 + 256 * k) * 16); }
            if (t4 < 193) psc = ((const float*)(rec + GR_SC))[t4 < 192 ? dir * 192 + t4 : 384 + dir]; };
        if (w >= 4) {
            fetch(0);
            for (int n = 0; n < 132; ++n) {
                __syncthreads();
#pragma unroll
                for (int k = 0; k < 4; ++k) { const int c = t4 + 256 * k, row = c >> 4, part = c & 15; st2x64(KNI + row * 264 + part * 16, pre[k]);
                    LAS unsigned short* kt = (LAS unsigned short*)(KTI + (part * 8) * 136 + row * 2); const u32x4 v = pre[k];
                    kt[0 * 68] = (unsigned short)(v.x & 0xffffu); kt[1 * 68] = (unsigned short)(v.x >> 16); kt[2 * 68] = (unsigned short)(v.y & 0xffffu); kt[3 * 68] = (unsigned short)(v.y >> 16);
                    kt[4 * 68] = (unsigned short)(v.z & 0xffffu); kt[5 * 68] = (unsigned short)(v.z >> 16); kt[6 * 68] = (unsigned short)(v.w & 0xffffu); kt[7 * 68] = (unsigned short)(v.w >> 16); }
#pragma unroll
                for (int k = 4; k < 8; ++k) { const int c = t4 + 256 * (k - 4), row = c >> 4, part = c & 15; st2x64(QNI + row * 264 + part * 16, pre[k]); }
#pragma unroll
                for (int k = 8; k < 12; ++k) { const int c = t4 + 256 * (k - 8), row = c >> 3, part = c & 7; st2x64(VTI + row * 136 + part * 16, pre[k]); }
#pragma unroll
                for (int k = 0; k < 2; ++k) { const int c = t4 + 256 * k, row = c >> 3, part = c & 7; st2x64(TI + row * 136 + part * 16, pre[12 + k]); st2x64(QKI + row * 136 + part * 16, pre[14 + k]); }
                if (t4 < 193) SC[t4] = psc;
                __syncthreads();
                if (n + 1 < 132) fetch(n + 1);
            }
        } else
        for (int n = 0; n < 132; ++n) {
            __syncthreads();
            __syncthreads();
            {
                size_t rbase; int len, p0; gdn_unit_geom(b, ckof(n), rbase, len, p0);
                const float alast = SC[192];
                f32x16 P0, P1;
#pragma unroll
                for (int r = 0; r < 16; ++r) { P0[r] = 0.f; P1[r] = 0.f; }
#pragma unroll
                for (int hq = 0; hq < 2; ++hq) { s16x8 fa[4], fb[4];
#pragma unroll
                  for (int q4 = 0; q4 < 4; ++q4) { const int q = hq * 4 + q4; const int co = (32 * (q >> 1) + 16 * (q & 1) + 4 * hh) * 2; fa[q4] = ld2x64(KNI + l31 * 264 + co); fb[q4] = ld2x64(KNI + (32 + l31) * 264 + co); }
#pragma unroll
                  for (int q4 = 0; q4 < 4; ++q4) { const int q = hq * 4 + q4; const int r = q >> 1; const s16x8 sb = pack8(r == 0 ? S0 : (r == 1 ? S1 : (r == 2 ? S2 : S3)), 8 * (q & 1));
                      P0 = __builtin_amdgcn_mfma_f32_32x32x16_bf16(fa[q4], sb, P0, 0, 0, 0); P1 = __builtin_amdgcn_mfma_f32_32x32x16_bf16(fb[q4], sb, P1, 0, 0, 0); } }
#pragma unroll
                for (int gq = 0; gq < 4; ++gq) {
#pragma unroll
                    for (int ib = 0; ib < 2; ++ib) { const int i0 = 32 * ib + 8 * gq + 4 * hh;
                        const f32x4 be = *(const LAS f32x4*)(SC + i0), eg = *(const LAS f32x4*)(SC + 64 + i0);
                        const u32x2 vv = *(const LAS u32x2*)(VTI + (32 * w + l31) * 136 + i0 * 2);
                        const float v0 = lo2f(vv.x), v1 = hi2f(vv.x), v2 = lo2f(vv.y), v3 = hi2f(vv.y);
                        if (ib == 0) { P0[4 * gq + 0] = be[0] * (v0 - eg[0] * P0[4 * gq + 0]); P0[4 * gq + 1] = be[1] * (v1 - eg[1] * P0[4 * gq + 1]); P0[4 * gq + 2] = be[2] * (v2 - eg[2] * P0[4 * gq + 2]); P0[4 * gq + 3] = be[3] * (v3 - eg[3] * P0[4 * gq + 3]); }
                        else         { P1[4 * gq + 0] = be[0] * (v0 - eg[0] * P1[4 * gq + 0]); P1[4 * gq + 1] = be[1] * (v1 - eg[1] * P1[4 * gq + 1]); P1[4 * gq + 2] = be[2] * (v2 - eg[2] * P1[4 * gq + 2]); P1[4 * gq + 3] = be[3] * (v3 - eg[3] * P1[4 * gq + 3]); } } }
                f32x16 V0, V1;
#pragma unroll
                for (int r = 0; r < 16; ++r) { V0[r] = 0.f; V1[r] = 0.f; }
#pragma unroll
                for (int jb = 0; jb < 2; ++jb)
#pragma unroll
                    for (int s = 0; s < 2; ++s) { const s16x8 pb = pack8(jb == 0 ? P0 : P1, 8 * s); const int co = (32 * jb + 16 * s + 4 * hh) * 2;
                        V0 = __builtin_amdgcn_mfma_f32_32x32x16_bf16(ld2x64(TI + l31 * 136 + co), pb, V0, 0, 0, 0);
                        V1 = __builtin_amdgcn_mfma_f32_32x32x16_bf16(ld2x64(TI + (32 + l31) * 136 + co), pb, V1, 0, 0, 0); }
                f32x16 T0, T1;
#pragma unroll
                for (int r = 0; r < 16; ++r) { T0[r] = 0.f; T1[r] = 0.f; }
#pragma unroll
                for (int r = 0; r < 4; ++r)
#pragma unroll
                    for (int s = 0; s < 2; ++s) { const s16x8 sa = pack8(r == 0 ? S0 : (r == 1 ? S1 : (r == 2 ? S2 : S3)), 8 * s);
                        const int co = (32 * r + 16 * s + 4 * hh) * 2;
                        T0 = __builtin_amdgcn_mfma_f32_32x32x16_bf16(sa, ld2x64(QNI + l31 * 264 + co), T0, 0, 0, 0);
                        T1 = __builtin_amdgcn_mfma_f32_32x32x16_bf16(sa, ld2x64(QNI + (32 + l31) * 264 + co), T1, 0, 0, 0); }
                { const float e0 = SC[64 + l31], e1 = SC[64 + 32 + l31];
#pragma unroll
                  for (int r = 0; r < 16; ++r) { T0[r] *= e0; T1[r] *= e1; } }
#pragma unroll
                for (int jb = 0; jb < 2; ++jb)
#pragma unroll
                    for (int s = 0; s < 2; ++s) { const s16x8 va = pack8(jb == 0 ? V0 : V1, 8 * s); const int co = (32 * jb + 16 * s + 4 * hh) * 2;
                        T0 = __builtin_amdgcn_mfma_f32_32x32x16_bf16(va, ld2x64(QKI + l31 * 136 + co), T0, 0, 0, 0);
                        T1 = __builtin_amdgcn_mfma_f32_32x32x16_bf16(va, ld2x64(QKI + (32 + l31) * 136 + co), T1, 0, 0, 0); }
                { bf16_t* o0 = O + (rbase + p0 + l31) * 512 + h * 128 + 32 * w + 4 * hh; bf16_t* o1 = o0 + (size_t)32 * 512;
#pragma unroll
                  for (int gq = 0; gq < 4; ++gq) { u32x2 x; x.x = pack2(T0[4 * gq], T0[4 * gq + 1]); x.y = pack2(T0[4 * gq + 2], T0[4 * gq + 3]); *(u32x2*)(o0 + gq * 8) = x;
                      x.x = pack2(T1[4 * gq], T1[4 * gq + 1]); x.y = pack2(T1[4 * gq + 2], T1[4 * gq + 3]); *(u32x2*)(o1 + gq * 8) = x; } }
#pragma unroll
                for (int gq = 0; gq < 4; ++gq) { const f32x4 c0 = *(const LAS f32x4*)(SC + 128 + 8 * gq + 4 * hh), c1 = *(const LAS f32x4*)(SC + 128 + 32 + 8 * gq + 4 * hh);
#pragma unroll
                    for (int q = 0; q < 4; ++q) { V0[4 * gq + q] *= c0[q]; V1[4 * gq + q] *= c1[q]; } }
#pragma unroll
                for (int r = 0; r < 16; ++r) { S0[r] *= alast; S1[r] *= alast; S2[r] *= alast; S3[r] *= alast; }
#pragma unroll
                for (int hq = 0; hq < 2; ++hq) { s16x8 fk[8];
#pragma unroll
                  for (int q2 = 0; q2 < 2; ++q2) { const int q = hq * 2 + q2; const int co = (32 * (q >> 1) + 16 * (q & 1) + 4 * hh) * 2;
#pragma unroll
                      for (int r = 0; r < 4; ++r) fk[q2 * 4 + r] = ld2x64(KTI + (32 * r + l31) * 136 + co); }
#pragma unroll
                  for (int q2 = 0; q2 < 2; ++q2) { const int q = hq * 2 + q2; const s16x8 vb = pack8((q >> 1) == 0 ? V0 : V1, 8 * (q & 1));
                      S0 = __builtin_amdgcn_mfma_f32_32x32x16_bf16(fk[q2 * 4 + 0], vb, S0, 0, 0, 0); S1 = __builtin_amdgcn_mfma_f32_32x32x16_bf16(fk[q2 * 4 + 1], vb, S1, 0, 0, 0);
                      S2 = __builtin_amdgcn_mfma_f32_32x32x16_bf16(fk[q2 * 4 + 2], vb, S2, 0, 0, 0); S3 = __builtin_amdgcn_mfma_f32_32x32x16_bf16(fk[q2 * 4 + 3], vb, S3, 0, 0, 0); } }
            }
        }
        __syncthreads();
    }
}

#ifndef FAST_ATTN
#define FAST_ATTN 2
#endif
constexpr int NPHASES = 27;
__global__ void __launch_bounds__(NTH, 2) fwd(Params P) {
    extern __shared__ __attribute__((aligned(16))) unsigned char lds_raw[];
    Frame F; F.P = &P; F.ws = P.ws; F.lds = (LAS unsigned char*)lds_raw;
    F.tid = threadIdx.x; F.lane = F.tid & 63; F.wave = __builtin_amdgcn_readfirstlane(F.tid >> 6); F.G = gridDim.x; F.bid = blockIdx.x;
    F.mod = (float*)(P.ws + WS_CTRL + C_MOD); F.ctrl = (unsigned*)(P.ws + WS_CTRL);
    volatile LAS unsigned* xbw = (volatile LAS unsigned*)(F.lds + LDS_BYTES - 16);
    if (F.tid < 4) xbw[F.tid] = 0u;
    __syncthreads();
    const int lo = P.ph_lo, hi = P.ph_hi;
    const bool single = (hi - lo) > 1;
    XcdBarrier bar; bar.bar = F.ctrl; bar.x = 0; bar.st = xbw;
    if (single) bar = xcd_barrier_post(F.ctrl, xbw);
#ifndef PH_MASK
#define PH_MASK 0xffffffffu
#endif
#ifndef PROBE_MASK
#define PROBE_MASK 0u
#endif
    unsigned long long t_acc = 0ull, t_0 = 0ull;
#define TIC(k) do { if ((PROBE_MASK >> (k)) & 1u) t_0 = __builtin_amdgcn_s_memrealtime(); } while (0)
#define TOC(k) do { if ((PROBE_MASK >> (k)) & 1u) t_acc += __builtin_amdgcn_s_memrealtime() - t_0; } while (0)
#define IN(k) (((PH_MASK >> (k)) & 1u) && lo <= (k) && (k) < hi)
#define SEAM(k) do { if (IN(k) && IN((k) + 1)) xcd_barrier(bar); } while (0)
#ifndef DUP_MASK
#define DUP_MASK 0u
#endif
#define DUP(k) ((DUP_MASK >> (k)) & 1u)
    bf16_t* wsm = (bf16_t*)(P.ws + WS_WSM);
    bf16_t* ACT = (bf16_t*)(P.ws + WS_ACT); bf16_t* PX = (bf16_t*)(P.ws + WS_PX);
    float* XC = (float*)(P.ws + WS_XC);

    TIC(0);
    if (IN(0)) { ph_prologue(F); if (DUP(0)) { __syncthreads(); conv_moe_weights(F, 0, F.bid, F.G); } xcd_barrier(bar); mod_reduce(F); } SEAM(0);
    TOC(0);
    TIC(1);
    if (IN(1)) { ph_rownorm(F, 0, TT, P.in[I_X], P.in[I_CTX], P.in[I_NMIX], 0); if (DUP(1)) ph_rownorm(F, 0, TT, P.in[I_X], P.in[I_CTX], P.in[I_NMIX], 0); } SEAM(1);
    TOC(1);
    TIC(2);
    if (IN(2)) { EpiStoreBf16P E{PX, EVEN_IN, 1024}; gemm_dense(F, ACT, wsm + W_EIN / 2, TT, EVEN_IN, 1024, E); if (DUP(2)) gemm_dense(F, ACT, wsm + W_EIN / 2, TT, EVEN_IN, 1024, E); } SEAM(2);
    TOC(2);
    TIC(3);
    if (IN(3)) { ph_gmlp_mfma(F); __syncthreads(); }
    TOC(3);
#ifndef CHUNKED_GLA
#define CHUNKED_GLA 1
#endif
    TIC(4);
    if (IN(4)) { if (CHUNKED_GLA) ph_gla_p1(F); else ph_gla(F); } SEAM(4);
    TOC(4);
    TIC(5);
    if (IN(5)) { if (CHUNKED_GLA) { ph_gla_p2(F); xcd_barrier(bar); ph_gla_p3(F); } else ph_merge(F, 0); } SEAM(5);
    TOC(5);
    TIC(6);
    if (IN(6)) { EpiResidual E{P.in[I_X], P.in[I_CTX], P.out, XC, F.mod, 2}; gemm_dense(F, ACT, wsm + W_EOUT / 2, TT, 1024, 1024, E); } SEAM(6);
    TOC(6);
    TIC(7);
    if (IN(7)) { ph_router(F, 0, TT, P.out, XC, P.in[I_NFFN], 3); } SEAM(7);
    TOC(7);
    TIC(8);
    if (IN(8)) { ph_dispatch(F, 0, TT); } SEAM(8);
    TOC(8);
    TIC(9);
    if (IN(9)) { ph_moe_gemm1(F, 0); if (DUP(9)) ph_moe_gemm1(F, 0); } SEAM(9);
    TOC(9);
    TIC(10);
    if (IN(10)) { ph_moe_gemm2y(F, 0); } SEAM(10);
    TOC(10);
    TIC(11);
    if (IN(11)) { }
    TOC(11);
    TIC(12);
    if (IN(12)) { ph_moe_combine<true>(F, 0, TT, 1, P.in[I_NMIX] + 1024);
#ifdef DBG_ZERO
        { u32x4 z = {0u, 0u, 0u, 0u}; u32x4* p = (u32x4*)(P.ws + WS_GREC); const size_t n = (size_t)(990 - 585) * MiB / 16;
          for (size_t i = (size_t)gtid(F); i < n; i += (size_t)F.G * NTH) p[i] = z;
          u32x4* q = (u32x4*)(P.ws + WS_WMOE); const size_t m = (size_t)66 * MiB / 16;
          for (size_t i = (size_t)gtid(F); i < m; i += (size_t)F.G * NTH) q[i] = z; }
#endif
    } SEAM(12);
    TOC(12);
    TIC(13);
    if (IN(13)) { EpiStoreBf16P E{PX, ODD_PAD, 0}; gemm_dense(F, ACT, wsm + W_OIN / 2, TT, ODD_PAD, 1024, E); if (DUP(13)) gemm_dense(F, ACT, wsm + W_OIN / 2, TT, ODD_PAD, 1024, E); } SEAM(13);
    TOC(13);
#ifndef CHUNKED_GDN
#define CHUNKED_GDN 1
#endif
    TIC(14);
    if (IN(14)) { if (CHUNKED_GDN) ph_gdn_prep(F); } SEAM(14);
    TOC(14);
    TIC(15);
    if (IN(15)) { if (CHUNKED_GDN) ph_gdn_scan(F); else ph_gdn(F); } SEAM(15);
    TOC(15);
    TIC(16);
    if (IN(16)) { ph_merge(F, 1); ph_mla_norm(F); } SEAM(16);
    TOC(16);
    TIC(17);
    if (IN(17)) { }
    TOC(17);
    TIC(18);
    if (IN(18)) { const bf16_t* cqn = (const bf16_t*)(P.ws + WS_R2 + R2_CQN);
                  EpiStoreBf16P E1{(bf16_t*)(P.ws + WS_WMOE), 768, 0}; gemm_dense(F, cqn, wsm + W_WQ / 2, TL, 768, 256, E1);
                  EpiStoreBf16P E2{(bf16_t*)(P.ws + WS_PX + PX_KVRAW), 1024, 0}; gemm_dense(F, cqn + (size_t)TL * 256, wsm + W_WKV / 2, TT, 1024, 256, E2); } SEAM(18);
    TOC(18);
    TIC(19);
    if (IN(19)) { ph_mla_final(F); } SEAM(19);
    TOC(19);
    TIC(20);
    if (IN(20)) { if (FAST_ATTN == 2) ph_attn2(F); else if (FAST_ATTN) ph_attn(F); else ph_attn_naive(F); if (DUP(20)) { __syncthreads(); ph_attn2(F); } } SEAM(20);
    TOC(20);
    TIC(21);
    if (IN(21)) { EpiResidual E{P.out, P.out, P.out, P.out, F.mod + 9 * 6144, 2}; gemm_dense(F, ACT, wsm + W_OOUT / 2, TL, 1024, 1024, E); } SEAM(21);
    TOC(21);
    TIC(22);
    if (IN(22)) { ph_router(F, 1, TL, P.out, XC, P.in[I_NFFN] + 1024, 3); conv_moe_weights(F, 1, F.bid, F.G); } SEAM(22);
    TOC(22);
    TIC(23);
    if (IN(23)) { ph_dispatch(F, 1, TL); } SEAM(23);
    TOC(23);
    TIC(24);
    if (IN(24)) { ph_moe_gemm1(F, 1); if (DUP(24)) ph_moe_gemm1(F, 1); } SEAM(24);
    TOC(24);
    TIC(25);
    if (IN(25)) { ph_moe_gemm2y(F, 1); } SEAM(25);
    TOC(25);
    TIC(26);
    if (IN(26)) { ph_moe_combine<false>(F, 1, TL, 1, nullptr); }
    TOC(26);
    if (PROBE_MASK) { const unsigned long long te = __builtin_amdgcn_s_memrealtime() + 10ull * t_acc; while (__builtin_amdgcn_s_memrealtime() < te) __builtin_amdgcn_s_sleep(8); }
#undef IN
#undef SEAM
}

#ifndef N_LAUNCH_MODE
#define N_LAUNCH_MODE 1
#endif
extern "C" void kernel_launch(void* const* d_in, const int* in_sizes, int n_in, void* d_out, int out_size, void* d_ws, size_t ws_size, hipStream_t stream) {
    static int grid = 0;
    if (grid == 0) {
        if (n_in != 34 || out_size != TL * DM || ws_size < WS_END) { fprintf(stderr, "kernel_launch: unexpected shapes (n_in %d out %d ws %zu)\n", n_in, out_size, ws_size); grid = -1; return; }
        int dev = 0, cus = 0;
        if (hipGetDevice(&dev) != hipSuccess || hipDeviceGetAttribute(&cus, hipDeviceAttributeMultiprocessorCount, dev) != hipSuccess) { grid = -1; return; }
        if (hipFuncSetAttribute((const void*)fwd, hipFuncAttributeMaxDynamicSharedMemorySize, LDS_BYTES) != hipSuccess) { fprintf(stderr, "kernel_launch: hipFuncSetAttribute failed\n"); grid = -1; return; }
        int per_cu = 0;
        (void)hipOccupancyMaxActiveBlocksPerMultiprocessor(&per_cu, (const void*)fwd, NTH, LDS_BYTES);
        (void)hipGetLastError();
        if (per_cu < 1) fprintf(stderr, "kernel_launch: occupancy query says %d\n", per_cu);
        grid = cus;
    }
    if (grid < 0) return;
    (void)hipMemsetAsync(d_ws, 0, MiB, stream);
    Params p{};
    for (int i = 0; i < 34; ++i) p.in[i] = (const float*)d_in[i];
    p.out = (float*)d_out; p.ws = (unsigned char*)d_ws;
#if N_LAUNCH_MODE == 1
    p.ph_lo = 0; p.ph_hi = NPHASES;
    hipLaunchKernelGGL(fwd, dim3(grid), dim3(NTH), LDS_BYTES, stream, p);
#else
    for (int k = 0; k < NPHASES; ++k) { p.ph_lo = k; p.ph_hi = k + 1; hipLaunchKernelGGL(fwd, dim3(grid), dim3(NTH), LDS_BYTES, stream, p); }
#endif
}
```

```cpp
#include <hip/hip_runtime.h>
#include <cstdint>
#include <cstdio>

#define LAS __attribute__((address_space(3)))
typedef unsigned short bf16_t;
typedef float f32x4 __attribute__((ext_vector_type(4)));
typedef unsigned u32x4 __attribute__((ext_vector_type(4)));
typedef unsigned u32x2 __attribute__((ext_vector_type(2)));
typedef float f32x16 __attribute__((ext_vector_type(16)));
typedef short s16x8 __attribute__((ext_vector_type(8)));

constexpr int NB = 8, SEQ = 8192, CTXL = 256, DM = 1024;
constexpr int TL = NB * SEQ, TC = NB * CTXL, TT = TL + TC;
constexpr int EVEN_IN = 3584, ODD_IN = 2480, ODD_PAD = 2560;
constexpr int NTH = 512;
constexpr int LDS_BYTES = 144 * 1024;
constexpr int MAXSLOTS = 151552;
constexpr int MAXTILES = 592;
constexpr float EPS = 1e-6f;

constexpr size_t MiB = 1048576;
constexpr size_t WS_CTRL = 0;
constexpr size_t C_MOE = 16384;
constexpr size_t C_MOD = 65536;
constexpr size_t WS_XC = 1 * MiB;
constexpr size_t WS_WSM = 9 * MiB;
constexpr size_t W_EIN = 0, W_EOUT = 7340032, W_OIN = 9437184, W_OOUT = 14680064, W_WQ = 16777216, W_WKV = 17170432, W_RT = 17694720;
constexpr size_t WS_WMOE = 27 * MiB;
constexpr size_t WS_ACT = 123 * MiB;
constexpr size_t WS_PX = 255 * MiB;
constexpr size_t WS_R2 = 717 * MiB;
constexpr size_t WS_END = 1024 * MiB;
constexpr size_t R2_OF0 = 0, R2_OB0 = 66 * MiB;
constexpr size_t R2_H = 0, R2_STOK = 148 * MiB, R2_SW = 149 * MiB, R2_TOKE = 150 * MiB, R2_TOKW = 151 * MiB, R2_TILEE = 152 * MiB, R2_TSLOT = 153 * MiB;
constexpr size_t R2_K = 0, R2_V = 99 * MiB, R2_OF1 = 165 * MiB, R2_OB1 = 231 * MiB;
constexpr size_t PX_KVRAW = 346030080;
constexpr size_t WS_GREC = 585 * MiB;
constexpr size_t WS_GOF = 924 * MiB;
constexpr size_t R2_CQN = 0;
constexpr size_t R2_RSS = 160 * MiB;
constexpr size_t R2_MODP = 200 * MiB;

struct Params {
    const float* in[34];
    float* out;
    unsigned char* ws;
    int ph_lo, ph_hi;
};
enum { I_X = 0, I_C, I_CTX, I_CCTX, I_ADAW, I_ADAB, I_NMIX, I_NFFN, I_EWIN, I_EWOUT, I_GNW, I_GWS, I_GBS, I_LB, I_HNW,
       I_OWIN, I_OWOUT, I_CONVW, I_ALOG, I_DTB, I_GDNNW, I_QNW, I_WQ, I_KVNW, I_WKV, I_QKQ, I_QKK, I_RGW, I_RGB, I_REW, I_REB, I_MG, I_MU, I_MD };

__device__ __forceinline__ float bf2f(bf16_t b) { return __uint_as_float(((unsigned)b) << 16); }
__device__ __forceinline__ bf16_t f2bf(float f) { unsigned u = __float_as_uint(f); u += 0x7FFFu + ((u >> 16) & 1u); return (bf16_t)(u >> 16); }
typedef __bf16 bf16_2v __attribute__((ext_vector_type(2)));
typedef float f32_2v __attribute__((ext_vector_type(2)));
__device__ __forceinline__ unsigned pack2(float a, float b) { f32_2v v = {a, b}; bf16_2v r = __builtin_convertvector(v, bf16_2v); return __builtin_bit_cast(unsigned, r); }
__device__ __forceinline__ float lo2f(unsigned u) { return __uint_as_float(u << 16); }
__device__ __forceinline__ float hi2f(unsigned u) { return __uint_as_float(u & 0xffff0000u); }
template <int CTRL> __device__ __forceinline__ float dppf(float x) { return __builtin_bit_cast(float, __builtin_amdgcn_mov_dpp(__builtin_bit_cast(int, x), CTRL, 0xf, 0xf, true)); }
__device__ __forceinline__ float sum8(float v) { v += dppf<0xB1>(v); v += dppf<0x4E>(v); v += dppf<0x141>(v); return v; }
__device__ __forceinline__ float sum16(float v) { v = sum8(v); v += dppf<0x128>(v); return v; }
__device__ __forceinline__ float wave_sum(float v) {
    v = sum16(v);
    auto s = __builtin_amdgcn_permlane16_swap(__float_as_uint(v), __float_as_uint(v), false, false);
    v = __uint_as_float(s[0]) + __uint_as_float(s[1]);
    auto t = __builtin_amdgcn_permlane32_swap(__float_as_uint(v), __float_as_uint(v), false, false);
    return __uint_as_float(t[0]) + __uint_as_float(t[1]);
}
__device__ __forceinline__ s16x8 pack8(const f32x16& x, int s8) {
    u32x4 p; p.x = pack2(x[s8 + 0], x[s8 + 1]); p.y = pack2(x[s8 + 2], x[s8 + 3]); p.z = pack2(x[s8 + 4], x[s8 + 5]); p.w = pack2(x[s8 + 6], x[s8 + 7]);
    return __builtin_bit_cast(s16x8, p);
}
__device__ __forceinline__ unsigned lds_inc(LAS unsigned* p) { return __hip_atomic_fetch_add(p, 1u, __ATOMIC_RELAXED, __HIP_MEMORY_SCOPE_WORKGROUP); }
__device__ __forceinline__ float sigmoid_f(float x) { return 1.f / (1.f + __expf(-x)); }
__device__ __forceinline__ float silu_f(float x) { return x / (1.f + __expf(-x)); }
__device__ __forceinline__ float gelu_tanh_f(float x) {
    const float u = 0.7978845608028654f * (x + 0.044715f * x * x * x);
    const float t = 1.f - 2.f / (__expf(2.f * u) + 1.f);
    return 0.5f * x * (1.f + t);
}
__device__ __forceinline__ float softplus_f(float x) { return x > 20.f ? x : log1pf(__expf(x)); }

#define XB_TMO      128
#define XB_XCNT(j)  (256  + 64 * (j))
#define XB_XSUB(j)  (1280 + 64 * (j))
#define XB_XGEN(j)  (2304 + 64 * (j))
#define XB_TOP      3328
#define XB_TOPGEN   3392
#define XCD_BAR_WORDS 3456
#define XB_SPIN_CAP (1u << 24)
__device__ __forceinline__ unsigned xb_ld(unsigned* p)              { return __hip_atomic_load(p, __ATOMIC_RELAXED, __HIP_MEMORY_SCOPE_AGENT); }
__device__ __forceinline__ unsigned xb_add(unsigned* p, unsigned v) { return __hip_atomic_fetch_add(p, v, __ATOMIC_RELAXED, __HIP_MEMORY_SCOPE_AGENT); }
__device__ __forceinline__ unsigned xb_xcc_id() { return (unsigned)__builtin_amdgcn_s_getreg((3 << 11) | 20) & 0xFu; }
#define XB_SPIN(cond, bar) do { unsigned _sp = 0; while (cond) { __builtin_amdgcn_s_sleep(1); \
    if ((++_sp & 255u) == 0u) { if (xb_ld(&(bar)[XB_TMO])) break; if (_sp > XB_SPIN_CAP) { atomicAdd(&(bar)[XB_TMO], 1u); break; } } } } while (0)
struct XcdBarrier { unsigned* bar; unsigned x; volatile LAS unsigned* st; };
__device__ __forceinline__ XcdBarrier xcd_barrier_post(unsigned* bar, volatile LAS unsigned* st) {
    XcdBarrier b; b.bar = bar; b.x = xb_xcc_id(); b.st = st;
    if (threadIdx.x == 0) (void)xb_add(&bar[XB_XCNT(b.x)], 1u);
    return b;
}
__device__ __forceinline__ void xcd_barrier_complete(unsigned* bar, unsigned x, unsigned& nloc, unsigned& nx) {
    const unsigned G = gridDim.x * gridDim.y * gridDim.z;
    unsigned sum, cnt, mine, sp = 0u;
    for (;;) {
        sum = 0u; cnt = 0u; mine = 0u;
#pragma unroll
        for (unsigned j = 0; j < 16; ++j) { const unsigned c = xb_ld(&bar[XB_XCNT(j)]); sum += c; cnt += (c > 0u) ? 1u : 0u; mine = (j == x) ? c : mine; }
        if (sum == G) break;
        __builtin_amdgcn_s_sleep(1);
        if ((++sp & 255u) == 0u) { if (xb_ld(&bar[XB_TMO])) break; if (sp > XB_SPIN_CAP) { atomicAdd(&bar[XB_TMO], 1u); break; } }
    }
    nloc = mine > 0u ? mine : 1u; nx = cnt > 0u ? cnt : 1u;
}
__device__ __forceinline__ void xcd_barrier(const XcdBarrier& b) {
    asm volatile("s_waitcnt vmcnt(0)" ::: "memory");
    __syncthreads();
    if (threadIdx.x == 0) {
        unsigned* bar = b.bar;
        __builtin_amdgcn_s_waitcnt(0);
        unsigned nloc = b.st[0], nx = b.st[1];
        if (nloc == 0u) { xcd_barrier_complete(bar, b.x, nloc, nx); b.st[0] = nloc; b.st[1] = nx; }
        const unsigned old = xb_add(&bar[XB_XSUB(b.x)], 1u);
        const unsigned gen = old / nloc;
        if (old + 1u == (gen + 1u) * nloc) {
            __builtin_amdgcn_fence(__ATOMIC_RELEASE, "agent");
            asm volatile("s_waitcnt vmcnt(0)" ::: "memory");
            const unsigned og = xb_add(&bar[XB_TOP], 1u);
            const unsigned tg = og / nx;
            if (og + 1u == (tg + 1u) * nx) xb_add(&bar[XB_TOPGEN], 1u);
            else XB_SPIN(xb_ld(&bar[XB_TOPGEN]) == tg, bar);
            __builtin_amdgcn_fence(__ATOMIC_ACQUIRE, "agent");
            xb_add(&bar[XB_XGEN(b.x)], 1u);
            asm volatile("s_waitcnt vmcnt(0)" ::: "memory");
        } else {
            XB_SPIN(xb_ld(&bar[XB_XGEN(b.x)]) == gen, bar);
            __builtin_amdgcn_fence(__ATOMIC_ACQUIRE, "agent");
            asm volatile("s_waitcnt vmcnt(0)" ::: "memory");
        }
    }
    __syncthreads();
}

struct Frame {
    const Params* P;
    unsigned char* ws;
    LAS unsigned char* lds;
    int tid, lane, wave, G, bid;
    float* mod;
    unsigned* ctrl;
};
__device__ __forceinline__ int gtid(const Frame& F) { int t = F.tid; asm volatile("" : "+v"(t)); return F.bid * NTH + t; }
__device__ __forceinline__ const float* modp(const Frame& F, int layer, int b, int which) { return F.mod + ((size_t)(layer * 9 + b) * 6 + which) * 1024; }

__device__ __forceinline__ void conv_tile(const Frame& F, const float* src, int K, int N, int lds_, bf16_t* dst, int ldd, int kt, int nt, int rm_mode) {
    LAS float* tile = (LAS float*)F.lds;
    const int t = F.tid;
    {
        const int c = t & 63, r0 = t >> 6;
#pragma unroll
        for (int i = 0; i < 8; ++i) { const int rr = r0 + i * 8, k = kt * 64 + rr, n = nt * 64 + c;
            tile[rr * 65 + c] = (k < K && n < N) ? src[(size_t)k * lds_ + n] : 0.f; }
    }
    __syncthreads();
    {
        const int nl = t >> 3, kc = (t & 7) * 8, n = nt * 64 + nl;
        int row = n;
        if (rm_mode == 1) row = (n >> 7) * 256 + (n & 127);
        else if (rm_mode == 2) row = (n >> 7) * 256 + 128 + (n & 127);
        float v[8];
#pragma unroll
        for (int j = 0; j < 8; ++j) v[j] = tile[(kc + j) * 65 + nl];
        u32x4 w; w.x = pack2(v[0], v[1]); w.y = pack2(v[2], v[3]); w.z = pack2(v[4], v[5]); w.w = pack2(v[6], v[7]);
        *(u32x4*)(dst + (size_t)row * ldd + kt * 64 + kc) = w;
    }
    __syncthreads();
}
__device__ __forceinline__ void conv_moe_weights(const Frame& F, int layer, int item0, int stride) {
    const Params& P = *F.P;
    bf16_t* W1 = (bf16_t*)(F.ws + WS_WMOE); bf16_t* W2 = W1 + (size_t)32 * 1024 * 1024;
    for (int it = item0; it < 12288; it += stride) {
        if (it < 8192) {
            const int up = it >= 4096, j = it & 4095, e = j >> 7, r = j & 127, kt = r >> 3, nt = r & 7;
            const float* src = P.in[up ? I_MU : I_MG] + ((size_t)(layer * 32 + e)) * 1024 * 512;
            conv_tile(F, src, 1024, 512, 512, W1 + (size_t)e * 1024 * 1024, 1024, kt, nt, up ? 2 : 1);
        } else {
            const int j = it - 8192, e = j >> 7, r = j & 127, kt = r >> 4, nt = r & 15;
            const float* src = P.in[I_MD] + ((size_t)(layer * 32 + e)) * 512 * 1024;
            conv_tile(F, src, 512, 1024, 1024, W2 + (size_t)e * 1024 * 512, 512, kt, nt, 0);
        }
    }
}
__device__ __forceinline__ void mod_reduce(const Frame& F) {
    const float* mp = (const float*)(F.ws + WS_R2 + R2_MODP);
    for (int i = gtid(F); i < 18 * 6144; i += F.G * NTH) { float a = F.P->in[I_ADAB][(i / (9 * 6144)) * 6144 + (i % 6144)];
#pragma unroll
        for (int kp = 0; kp < 8; ++kp) a += mp[(size_t)kp * 18 * 6144 + i];
        F.mod[i] = a; }
}
__device__ __forceinline__ void ph_prologue(const Frame& F) {
    const Params& P = *F.P;
    float* modp_ = (float*)(F.ws + WS_R2 + R2_MODP);
    for (int it = F.bid; it < 192; it += F.G) {
        const int l = it / 96, r = it % 96, cb = r >> 3, kp = r & 7;
        LAS float* sc = (LAS float*)F.lds;
        for (int i = F.tid; i < 9 * 128; i += NTH) { const int rr = i >> 7, k = kp * 128 + (i & 127);
            const float cv = rr < 8 ? P.in[I_C][rr * 1024 + k] : P.in[I_CCTX][k]; sc[i] = silu_f(cv); }
        __syncthreads();
        const int n = cb * 512 + F.tid;
        float acc[9];
#pragma unroll
        for (int rr = 0; rr < 9; ++rr) acc[rr] = 0.f;
        const float* w = P.in[I_ADAW] + ((size_t)l * 1024 + kp * 128) * 6144 + n;
#pragma unroll 8
        for (int k = 0; k < 128; ++k) { const float wv = w[(size_t)k * 6144];
#pragma unroll
            for (int rr = 0; rr < 9; ++rr) acc[rr] += sc[rr * 128 + k] * wv; }
#pragma unroll
        for (int rr = 0; rr < 9; ++rr) modp_[((size_t)kp * 18 + l * 9 + rr) * 6144 + n] = acc[rr];
        __syncthreads();
    }
    bf16_t* wsm = (bf16_t*)(F.ws + WS_WSM);
    for (int it = F.bid; it < 2160; it += F.G) {
        int j = it;
        if (j < 896) { conv_tile(F, P.in[I_EWIN], 1024, 3584, 3584, wsm + W_EIN / 2, 1024, j / 56, j % 56, 0); continue; } j -= 896;
        if (j < 256) { conv_tile(F, P.in[I_EWOUT], 1024, 1024, 1024, wsm + W_EOUT / 2, 1024, j >> 4, j & 15, 0); continue; } j -= 256;
        if (j < 640) { conv_tile(F, P.in[I_OWIN], 1024, 2480, 2480, wsm + W_OIN / 2, 1024, j / 40, j % 40, 0); continue; } j -= 640;
        if (j < 256) { conv_tile(F, P.in[I_OWOUT], 1024, 1024, 1024, wsm + W_OOUT / 2, 1024, j >> 4, j & 15, 0); continue; } j -= 256;
        if (j < 48) { conv_tile(F, P.in[I_WQ], 256, 768, 768, wsm + W_WQ / 2, 256, j / 12, j % 12, 0); continue; } j -= 48;
        conv_tile(F, P.in[I_WKV], 128, 1024, 1024, wsm + W_WKV / 2, 256, j >> 4, j & 15, 0);
    }
    for (int i = gtid(F); i < 2 * 48 * 1024; i += F.G * NTH) { const int l = i / (48 * 1024), r = i % (48 * 1024), n = r >> 10, k = r & 1023;
        float w = 0.f; if (n < 4) w = P.in[I_RGW][((size_t)l * 1024 + k) * 4 + n]; else if (n < 36) w = P.in[I_REW][((size_t)l * 1024 + k) * 32 + (n - 4)];
        const bf16_t h = f2bf(w); wsm[W_RT / 2 + (size_t)l * 2 * 48 * 1024 + r] = h; wsm[W_RT / 2 + (size_t)l * 2 * 48 * 1024 + 48 * 1024 + r] = f2bf(w - bf2f(h)); }
    conv_moe_weights(F, 0, F.bid, F.G);
}

__device__ __forceinline__ void ph_rownorm(const Frame& F, int layer, int nrows, const float* xlat, const float* xctx, const float* nw, int si) {
    bf16_t* dst = (bf16_t*)(F.ws + WS_ACT);
    for (int r = F.bid * 8 + F.wave; r < nrows; r += F.G * 8) {
        const float* src = r < TL ? xlat + (size_t)r * 1024 : xctx + (size_t)(r - TL) * 1024;
        const int b = r < TL ? (r >> 13) : 8;
        const float* sh = modp(F, layer, b, si); const float* sc = modp(F, layer, b, si + 1);
        f32x4 v[4]; float ss = 0.f;
#pragma unroll
        for (int j = 0; j < 4; ++j) { v[j] = *(const f32x4*)(src + j * 256 + F.lane * 4); ss += v[j][0] * v[j][0] + v[j][1] * v[j][1] + v[j][2] * v[j][2] + v[j][3] * v[j][3]; }
        ss = wave_sum(ss);
        const float rstd = rsqrtf(ss * (1.f / 1024.f) + EPS);
#pragma unroll
        for (int j = 0; j < 4; ++j) { const int c = j * 256 + F.lane * 4;
            const f32x4 w = *(const f32x4*)(nw + c), s1 = *(const f32x4*)(sc + c), s0 = *(const f32x4*)(sh + c);
            v[j] = (v[j] * rstd * w) * (1.f + s1) + s0;
            u32x2 o; o.x = pack2(v[j][0], v[j][1]); o.y = pack2(v[j][2], v[j][3]);
            *(u32x2*)(dst + (size_t)r * 1024 + c) = o; }
    }
}
typedef short s16x8r __attribute__((ext_vector_type(8)));
__device__ __forceinline__ void ph_router(const Frame& F, int layer, int nrows, const float* xlat, const float* xctx, const float* nw, int si) {
    const Params& P = *F.P;
    bf16_t* dst = (bf16_t*)(F.ws + WS_ACT);
    LAS unsigned* hist = (LAS unsigned*)F.lds;
    LAS float* lg = (LAS float*)(F.lds + 256) + F.wave * (16 * 48);
    int* tok_e = (int*)(F.ws + WS_R2 + R2_TOKE); float* tok_w = (float*)(F.ws + WS_R2 + R2_TOKW);
    LAS float* CA = (LAS float*)(F.lds + 24832); LAS float* CB = CA + 9 * 1024;
    if (F.tid < 64) hist[F.tid] = 0u;
    for (int i = F.tid; i < 9 * 1024; i += NTH) { const int bb = i >> 10, c = i & 1023; const float sc1 = modp(F, layer, bb, si + 1)[c];
        CA[i] = nw[c] * (1.f + sc1); CB[i] = modp(F, layer, bb, si)[c]; }
    __syncthreads();
    unsigned* gq = (unsigned*)(F.ws + WS_CTRL + C_MOE + layer * 1024) + 160;
    { int* stok = (int*)(F.ws + WS_R2 + R2_STOK);
      float* swz = (float*)(F.ws + WS_R2 + R2_SW);
      for (int i = gtid(F); i < MAXSLOTS; i += F.G * NTH) { stok[i] = -1; swz[i] = 0.f; } }
    const bf16_t* Wh = (const bf16_t*)(F.ws + WS_WSM) + W_RT / 2 + (size_t)layer * 2 * 48 * 1024; const bf16_t* Wl = Wh + 48 * 1024;
    const int lr = F.lane & 15, kq = F.lane >> 4;
    const float* rgb = P.in[I_RGB] + layer * 4; const float* reb = P.in[I_REB] + layer * 32;
    for (;;) {
        int g = 0; if (F.lane == 0) g = (int)__hip_atomic_fetch_add(gq, 1u, __ATOMIC_RELAXED, __HIP_MEMORY_SCOPE_AGENT);
        g = __builtin_amdgcn_readfirstlane(g);
        if (g >= nrows / 16) break;
        const int r0 = g * 16;
        const float* src0 = r0 < TL ? xlat + (size_t)r0 * 1024 : xctx + (size_t)(r0 - TL) * 1024;
        const int b = r0 < TL ? (r0 >> 13) : 8;
        const LAS float* ca = CA + b * 1024 + kq * 8; const LAS float* cb = CB + b * 1024 + kq * 8;
        float myrstd;
        { const float* rp = (const float*)(F.ws + WS_R2 + R2_RSS) + (size_t)(r0 + lr) * 32 + kq * 8;
          const f32x4 p0 = *(const f32x4*)rp, p1 = *(const f32x4*)(rp + 4);
          float ss = ((p0[0] + p0[1]) + (p0[2] + p0[3])) + ((p1[0] + p1[1]) + (p1[2] + p1[3]));
          auto t1 = __builtin_amdgcn_permlane16_swap(__float_as_uint(ss), __float_as_uint(ss), false, false); ss = __uint_as_float(t1[0]) + __uint_as_float(t1[1]);
          auto t2 = __builtin_amdgcn_permlane32_swap(__float_as_uint(ss), __float_as_uint(ss), false, false); ss = __uint_as_float(t2[0]) + __uint_as_float(t2[1]);
          myrstd = rsqrtf(ss * (1.f / 1024.f) + EPS); }
        f32x4 acc[3];
#pragma unroll
        for (int nb = 0; nb < 3; ++nb) acc[nb] = (f32x4){0.f, 0.f, 0.f, 0.f};
        const float* xr = src0 + (size_t)lr * 1024 + kq * 8;
        bf16_t* dr = dst + (size_t)(r0 + lr) * 1024 + kq * 8;
#pragma unroll 4
        for (int ks = 0; ks < 32; ++ks) { const int c = ks * 32 + kq * 8;
            const f32x4 x0 = *(const f32x4*)(xr + ks * 32), x1 = *(const f32x4*)(xr + ks * 32 + 4);
            const f32x4 a0 = *(const LAS f32x4*)(ca + ks * 32), a1 = *(const LAS f32x4*)(ca + ks * 32 + 4), b0 = *(const LAS f32x4*)(cb + ks * 32), b1 = *(const LAS f32x4*)(cb + ks * 32 + 4);
            const f32x4 h0 = (x0 * myrstd) * a0 + b0, h1 = (x1 * myrstd) * a1 + b1;
            u32x4 hi; hi.x = pack2(h0[0], h0[1]); hi.y = pack2(h0[2], h0[3]); hi.z = pack2(h1[0], h1[1]); hi.w = pack2(h1[2], h1[3]);
            *(u32x4*)(dr + ks * 32) = hi;
            u32x4 lo; lo.x = pack2(h0[0] - lo2f(hi.x), h0[1] - hi2f(hi.x)); lo.y = pack2(h0[2] - lo2f(hi.y), h0[3] - hi2f(hi.y));
            lo.z = pack2(h1[0] - lo2f(hi.z), h1[1] - hi2f(hi.z)); lo.w = pack2(h1[2] - lo2f(hi.w), h1[3] - hi2f(hi.w));
            const s16x8r ah = __builtin_bit_cast(s16x8r, hi), al = __builtin_bit_cast(s16x8r, lo);
#pragma unroll
            for (int nb = 0; nb < 3; ++nb) { const s16x8r bh = *(const s16x8r*)(Wh + (size_t)(nb * 16 + lr) * 1024 + c), bl = *(const s16x8r*)(Wl + (size_t)(nb * 16 + lr) * 1024 + c);
                acc[nb] = __builtin_amdgcn_mfma_f32_16x16x32_bf16(ah, bh, acc[nb], 0, 0, 0);
                acc[nb] = __builtin_amdgcn_mfma_f32_16x16x32_bf16(al, bh, acc[nb], 0, 0, 0);
                acc[nb] = __builtin_amdgcn_mfma_f32_16x16x32_bf16(ah, bl, acc[nb], 0, 0, 0); } }
#pragma unroll
        for (int nb = 0; nb < 3; ++nb)
#pragma unroll
            for (int rg = 0; rg < 4; ++rg) lg[(4 * kq + rg) * 48 + nb * 16 + lr] = acc[nb][rg];
        asm volatile("s_waitcnt lgkmcnt(0)" ::: "memory");
        __builtin_amdgcn_wave_barrier();
        if (F.lane < 16) {
            const LAS float* L = lg + F.lane * 48;
            float lgv[4];
#pragma unroll
            for (int i = 0; i < 4; ++i) lgv[i] = L[i] + rgb[i];
            int gi = 0; float best = lgv[0];
#pragma unroll
            for (int i = 1; i < 4; ++i) if (lgv[i] > best) { best = lgv[i]; gi = i; }
            float den = 0.f;
#pragma unroll
            for (int i = 0; i < 4; ++i) den += __expf(lgv[i] - best);
            const float pg = 1.f / den;
            float le[8];
#pragma unroll
            for (int i = 0; i < 8; ++i) le[i] = L[4 + gi * 8 + i] + reb[gi * 8 + i];
            int i1 = 0; float b1 = le[0];
#pragma unroll
            for (int i = 1; i < 8; ++i) if (le[i] > b1) { b1 = le[i]; i1 = i; }
            int i2 = -1; float b2 = -3.0e38f;
#pragma unroll
            for (int i = 0; i < 8; ++i) if (i != i1 && le[i] > b2) { b2 = le[i]; i2 = i; }
            const float e2 = __expf(b2 - b1);
            const float w1 = pg / (1.f + e2), w2 = pg * e2 / (1.f + e2);
            const int e0g = gi * 8 + i1, e1g = gi * 8 + i2; const int r = r0 + F.lane;
            tok_e[r] = e0g | (e1g << 8); tok_w[2 * r] = w1; tok_w[2 * r + 1] = w2;
            lds_inc(&hist[e0g]); lds_inc(&hist[32 + e1g]);
        }
        __builtin_amdgcn_wave_barrier();
    }
    __syncthreads();
    unsigned* cnt = (unsigned*)(F.ws + WS_CTRL + C_MOE + layer * 1024);
    if (F.tid < 64 && hist[F.tid]) atomicAdd(&cnt[F.tid], hist[F.tid]);
    __syncthreads();
}

__device__ __forceinline__ void ph_dispatch(const Frame& F, int layer, int ntok) {
    unsigned* cnt = (unsigned*)(F.ws + WS_CTRL + C_MOE + layer * 1024); unsigned* cursor = cnt + 64; unsigned* info = cnt + 128;
    LAS unsigned* base = (LAS unsigned*)F.lds; LAS unsigned* lh = base + 64; LAS unsigned* gb = base + 128; LAS unsigned* lh2 = base + 192; LAS unsigned* pad = base + 256;
    const int* tok_e = (const int*)(F.ws + WS_R2 + R2_TOKE); const float* tok_w = (const float*)(F.ws + WS_R2 + R2_TOKW);
    int* stok = (int*)(F.ws + WS_R2 + R2_STOK); float* sw = (float*)(F.ws + WS_R2 + R2_SW); int* tile_e = (int*)(F.ws + WS_R2 + R2_TILEE); int* tsl = (int*)(F.ws + WS_R2 + R2_TSLOT);
    if (F.tid < 64) { pad[F.tid] = (__hip_atomic_load(&cnt[F.tid], __ATOMIC_RELAXED, __HIP_MEMORY_SCOPE_AGENT) + 255u) & ~255u; lh[F.tid] = 0u; lh2[F.tid] = 0u; }
    __syncthreads();
    if (F.tid == 0) { unsigned a = 0; for (int i = 0; i < 64; ++i) { base[i] = a; a += pad[i]; } base[320] = a; }
    __syncthreads();
    if (F.bid == 0) {
        for (int i = F.tid; i < MAXTILES; i += NTH) { const unsigned s = (unsigned)i * 256u; int l = -1;
            for (int j = 0; j < 64; ++j) if (s >= base[j] && s < base[j] + pad[j]) l = j;
            tile_e[i] = l; }
        if (F.tid == 0) { info[0] = base[32] / 256u; info[1] = base[320] / 256u; }
    }
    const int per = (ntok + F.G - 1) / F.G, t0 = F.bid * per, t1 = min(ntok, t0 + per);
    for (int t = t0 + F.tid; t < t1; t += NTH) { const int e = tok_e[t]; lds_inc(&lh[e & 255]); lds_inc(&lh[32 + (e >> 8)]); }
    __syncthreads();
    if (F.tid < 64) gb[F.tid] = lh[F.tid] ? __hip_atomic_fetch_add(&cursor[F.tid], lh[F.tid], __ATOMIC_RELAXED, __HIP_MEMORY_SCOPE_AGENT) : 0u;
    __syncthreads();
    for (int t = t0 + F.tid; t < t1; t += NTH) { const int e = tok_e[t];
        const int l0 = e & 255, l1 = 32 + (e >> 8);
        const unsigned p0 = base[l0] + gb[l0] + lds_inc(&lh2[l0]), p1 = base[l1] + gb[l1] + lds_inc(&lh2[l1]);
        stok[p0] = t; sw[p0] = tok_w[2 * t]; stok[p1] = t; sw[p1] = tok_w[2 * t + 1]; tsl[2 * t] = (int)p0; tsl[2 * t + 1] = (int)p1; }
    __syncthreads();
}

template <class AF, class EP>
__device__ __forceinline__ void gemm_unit_naive(const Frame& F, int K, const AF& arow, const bf16_t* Bt, const EP& E, int pm, int pn) {
    LAS float* As = (LAS float*)F.lds;
    LAS float* Bs = As + 32 * 132;
    const int t = F.tid, ty = t >> 5, tx = t & 31;
    for (int half = 0; half < 2; ++half) {
        float acc[8][8];
#pragma unroll
        for (int i = 0; i < 8; ++i)
#pragma unroll
            for (int j = 0; j < 8; ++j) acc[i][j] = 0.f;
        const bf16_t* ap = arow(half * 128 + (t >> 2));
        const bf16_t* bp = Bt + (size_t)(t >> 1) * K;
        for (int k0 = 0; k0 < K; k0 += 32) {
            { const int r = t >> 2, kq = (t & 3) * 8; u32x4 w = {0u, 0u, 0u, 0u}; if (ap) w = *(const u32x4*)(ap + k0 + kq);
              As[(kq + 0) * 132 + r] = lo2f(w.x); As[(kq + 1) * 132 + r] = hi2f(w.x); As[(kq + 2) * 132 + r] = lo2f(w.y); As[(kq + 3) * 132 + r] = hi2f(w.y);
              As[(kq + 4) * 132 + r] = lo2f(w.z); As[(kq + 5) * 132 + r] = hi2f(w.z); As[(kq + 6) * 132 + r] = lo2f(w.w); As[(kq + 7) * 132 + r] = hi2f(w.w); }
            { const int n = t >> 1, kh = (t & 1) * 16;
#pragma unroll
              for (int q = 0; q < 2; ++q) { const u32x4 w = *(const u32x4*)(bp + k0 + kh + q * 8); const int kk = kh + q * 8;
                Bs[(kk + 0) * 260 + n] = lo2f(w.x); Bs[(kk + 1) * 260 + n] = hi2f(w.x); Bs[(kk + 2) * 260 + n] = lo2f(w.y); Bs[(kk + 3) * 260 + n] = hi2f(w.y);
                Bs[(kk + 4) * 260 + n] = lo2f(w.z); Bs[(kk + 5) * 260 + n] = hi2f(w.z); Bs[(kk + 6) * 260 + n] = lo2f(w.w); Bs[(kk + 7) * 260 + n] = hi2f(w.w); } }
            __syncthreads();
#pragma unroll 4
            for (int k = 0; k < 32; ++k) {
                const f32x4 a0 = *(const LAS f32x4*)(As + k * 132 + ty * 8), a1 = *(const LAS f32x4*)(As + k * 132 + ty * 8 + 4);
                const f32x4 b0 = *(const LAS f32x4*)(Bs + k * 260 + tx * 4), b1 = *(const LAS f32x4*)(Bs + k * 260 + 128 + tx * 4);
#pragma unroll
                for (int i = 0; i < 8; ++i) { const float a = i < 4 ? a0[i & 3] : a1[i & 3];
#pragma unroll
                    for (int j = 0; j < 4; ++j) { acc[i][j] += a * b0[j]; acc[i][4 + j] += a * b1[j]; } }
            }
            __syncthreads();
        }
#pragma unroll
        for (int i = 0; i < 8; ++i) { const f32x4 v0 = {acc[i][0], acc[i][1], acc[i][2], acc[i][3]}, v1 = {acc[i][4], acc[i][5], acc[i][6], acc[i][7]};
            E(pm * 256 + half * 128 + ty * 8 + i, pn, tx * 4, v0, v1); }
    }
}
struct ARowDense { const bf16_t* A; int K; int pm; __device__ __forceinline__ const bf16_t* operator()(int r) const { return A + (size_t)(pm * 256 + r) * K; } };
struct ARowGather { const bf16_t* A; const int* stok; int pm; __device__ __forceinline__ const bf16_t* operator()(int r) const { const int t = stok[pm * 256 + r]; return t < 0 ? nullptr : A + (size_t)t * 1024; } };

template <class EP>
__device__ __forceinline__ void gemm_dense_naive(const Frame& F, const bf16_t* A, const bf16_t* Bt, int M, int N, int K, const EP& E) {
    const int nM = M / 256, nN = N / 256;
    for (int u = F.bid; u < nM * nN; u += F.G) { const int pm = u / nN, pn = u % nN;
        ARowDense ar{A, K, pm}; gemm_unit_naive(F, K, ar, Bt + (size_t)pn * 256 * K, E, pm, pn); }
}

namespace pg8 {
typedef short bf16x8 __attribute__((ext_vector_type(8)));
constexpr int BM = 256, BK = 64, HALF = 128, HTB = HALF * BK * 2, STAGE_BYTES = 8 * HTB, NXCD = 8, WGM = 8;
__device__ __forceinline__ int lds_byte(int r, int c) { const int st = (r >> 4) * 2 + (c >> 5), rr = r & 15, cc = c & 31, ob = rr * 64 + cc * 2; return st * 1024 + (ob ^ (((ob >> 9) & 1) << 5)); }
__device__ __forceinline__ int perm32(int rho) { const int n = rho >> 4, i = rho & 15; return 8 * (i >> 2) + 4 * n + (i & 3); }
__device__ __forceinline__ void stage_rc(int b, int& R, int& C) { const int st = b / 1024, sb = b % 1024, swz = sb ^ (((sb >> 9) & 1) << 5); R = (st >> 1) * 16 + swz / 64; C = (st & 1) * 32 + (swz % 64) / 2; }
struct Unit { int pm, pn; };
struct ProbDense {
    const char* A; const char* Bt; int K, nM, nN, nwg, G, c;
    __device__ __forceinline__ void init(const bf16_t* A_, const bf16_t* Bt_, int M, int N, int K_, int G_, int c_) { A = (const char*)A_; Bt = (const char*)Bt_; K = K_; nM = M / BM; nN = N / BM; nwg = nM * nN; G = G_; c = c_; }
    __device__ __forceinline__ bool next(int i, Unit& u) const {
        const long L = (long)i * G + c; if (L >= nwg) return false;
        int wgid = (int)L; { const int q = nwg / NXCD, r = nwg % NXCD, xcd = wgid % NXCD, off = wgid / NXCD; wgid = (xcd < r ? xcd * (q + 1) : r * (q + 1) + (xcd - r) * q) + off; }
        const int nig = WGM * nN, gid = wgid / nig, fm = gid * WGM, gsz = (nM - fm) < WGM ? (nM - fm) : WGM;
        u.pm = fm + ((wgid % nig) % gsz); u.pn = (wgid % nig) / gsz; return true;
    }
    __device__ __forceinline__ const char* bptr(const Unit& u) const { return Bt + (size_t)u.pn * 256 * K * 2; }
    __device__ __forceinline__ unsigned aoff(const Unit& u, int r) const { return (unsigned)(u.pm * 256 + r) * (unsigned)(K * 2); }
};
struct ProbMoe1 {
    const char* A; const int* stok; const int* tile_e; const char* W; int K, ntiles, G, c;
    __device__ __forceinline__ bool next(int i, Unit& u) const { const int L = i * G + c; if (L >= ntiles * 4) return false; u.pm = L >> 2; u.pn = L & 3; return true; }
    __device__ __forceinline__ const char* bptr(const Unit& u) const { return W + ((size_t)(tile_e[u.pm] & 31) * 1024 + u.pn * 256) * 2048; }
    __device__ __forceinline__ unsigned aoff(const Unit& u, int r) const { const int t = stok[u.pm * 256 + r]; return t < 0 ? 0u : (unsigned)t * 2048u; }
};
struct ProbMoe2 {
    const char* A; const int* tile_e; const char* W; int K, tlo, thi, G, c;
    __device__ __forceinline__ bool next(int i, Unit& u) const { const int L = i * G + c; if (L >= (thi - tlo) * 4) return false; u.pm = tlo + (L >> 2); u.pn = L & 3; return true; }
    __device__ __forceinline__ const char* bptr(const Unit& u) const { return W + ((size_t)(tile_e[u.pm] & 31) * 1024 + u.pn * 256) * 1024; }
    __device__ __forceinline__ unsigned aoff(const Unit& u, int r) const { return (unsigned)(u.pm * 256 + r) * 1024u; }
};

template <class Prob, class Epi>
__device__ __forceinline__ void gemm_phase(LAS unsigned char* lds, const Prob& S, const Epi& E) {
    const int tid = threadIdx.x, wid = __builtin_amdgcn_readfirstlane(tid >> 6), lane = tid & 63, wr = wid >> 2, wc = wid & 3, fr = lane & 15, fq = lane >> 4;
    const int K = S.K, nt = K / BK;
    int RA[2]; unsigned cb2[2], voffB[2];
#pragma unroll
    for (int i = 0; i < 2; ++i) { int R, C; stage_rc(tid * 16 + i * 8192, R, C); RA[i] = R; cb2[i] = (unsigned)C * 2u; const int Rb = Epi::PERM ? ((R & ~31) + perm32(R & 31)) : R; voffB[i] = (unsigned)(Rb * K + C) * 2u; }
    const size_t kstep = (size_t)(BK * 2);
    const size_t hstepB = (size_t)HALF * K * 2;
    const unsigned ldsw = (unsigned)wid * 1024u;
    const int aoff = lds_byte(wr * 64 + fr, fq * 8), boff = lds_byte(wc * 32 + fr, fq * 8);
#define PG8_SA(b, h) (((b) * 2 + (h)) * HTB)
#define PG8_SB(b, h) ((4 + (b) * 2 + (h)) * HTB)
#define PG8_STAGE(bufoff, gbase, voff) do { _Pragma("unroll") for (int _i = 0; _i < 2; ++_i) \
        __builtin_amdgcn_global_load_lds((const unsigned*)((const char*)(gbase) + (voff)[_i]), (LAS unsigned*)(lds + (bufoff) + ldsw + _i * 8192), 16, 0, 0); } while (0)
#define PG8_LDA(dst, b, h) do { _Pragma("unroll") for (int m = 0; m < 4; ++m) _Pragma("unroll") for (int k = 0; k < 2; ++k) dst[m][k] = *(const LAS bf16x8*)(lds + PG8_SA(b, h) + aoff + m * 2048 + k * 1024); } while (0)
#define PG8_LDB(dst, b, h) do { _Pragma("unroll") for (int n = 0; n < 2; ++n) _Pragma("unroll") for (int k = 0; k < 2; ++k) dst[n][k] = *(const LAS bf16x8*)(lds + PG8_SB(b, h) + boff + n * 2048 + k * 1024); } while (0)
#define PG8_MMA(ai, bj, At, Bt) do { __builtin_amdgcn_s_setprio(1); _Pragma("unroll") for (int m = 0; m < 4; ++m) _Pragma("unroll") for (int n = 0; n < 2; ++n) _Pragma("unroll") for (int k = 0; k < 2; ++k) \
        acc[ai][bj][m][n] = __builtin_amdgcn_mfma_f32_16x16x32_bf16(Bt[n][k], At[m][k], acc[ai][bj][m][n], 0, 0, 0); __builtin_amdgcn_s_setprio(0); } while (0)
#define PG8_WAIT_V(n) asm volatile("s_waitcnt vmcnt(" #n ")" ::: "memory")
#define PG8_WAIT_L(n) asm volatile("s_waitcnt lgkmcnt(" #n ")" ::: "memory")
#define PG8_BAR __builtin_amdgcn_s_barrier()
#define PG8_SCHED __builtin_amdgcn_sched_barrier(0)
    Unit cur, nxt; int ui = 0;
    if (!S.next(0, cur)) return;
    f32x4 acc[2][2][4][2];
#pragma unroll
    for (int a = 0; a < 2; ++a)
#pragma unroll
        for (int b = 0; b < 2; ++b)
#pragma unroll
            for (int m = 0; m < 4; ++m)
#pragma unroll
                for (int n = 0; n < 2; ++n) acc[a][b][m][n] = (f32x4){0.f, 0.f, 0.f, 0.f};
    bf16x8 At[4][2], B0[2][2], B1[2][2];
    unsigned oc0[2], oc1[2], on0[2], on1[2];
#pragma unroll
    for (int i = 0; i < 2; ++i) { oc0[i] = S.aoff(cur, RA[i]) + cb2[i]; oc1[i] = S.aoff(cur, 128 + RA[i]) + cb2[i]; }
    const char* cB = S.bptr(cur);
    const char* const Ab = S.A;
    PG8_STAGE(PG8_SB(0, 0), cB, voffB); PG8_STAGE(PG8_SA(0, 0), Ab, oc0); PG8_STAGE(PG8_SB(0, 1), cB + hstepB, voffB); PG8_STAGE(PG8_SA(0, 1), Ab, oc1);
    if (wr == 1) PG8_BAR;
    PG8_WAIT_V(4); PG8_BAR;
    PG8_STAGE(PG8_SB(1, 0), cB + kstep, voffB); PG8_STAGE(PG8_SA(1, 0), Ab + kstep, oc0); PG8_STAGE(PG8_SB(1, 1), cB + hstepB + kstep, voffB);
    PG8_WAIT_V(6); PG8_BAR;
    for (;;) {
        const bool has_next = S.next(ui + 1, nxt);
        const char* nB = has_next ? S.bptr(nxt) : cB;
#pragma unroll
        for (int i = 0; i < 2; ++i) { on0[i] = has_next ? S.aoff(nxt, RA[i]) + cb2[i] : oc0[i]; on1[i] = has_next ? S.aoff(nxt, 128 + RA[i]) + cb2[i] : oc1[i]; }
        for (int t = 0; t < nt; t += 2) {
            const bool last = (t == nt - 2);
            const char* a1 = Ab + (size_t)(t + 1) * kstep;
            const char* a2 = last ? Ab : Ab + (size_t)(t + 2) * kstep; const char* b2 = last ? nB : cB + (size_t)(t + 2) * kstep;
            const char* a3 = a2 + kstep; const char* b3 = b2 + kstep;
            unsigned o20[2], o21[2];
#pragma unroll
            for (int i = 0; i < 2; ++i) { o20[i] = last ? on0[i] : oc0[i]; o21[i] = last ? on1[i] : oc1[i]; }
            PG8_LDB(B0, 0, 0); PG8_SCHED; PG8_LDA(At, 0, 0); PG8_STAGE(PG8_SA(1, 1), a1, oc1);
            PG8_WAIT_L(8); PG8_BAR; PG8_WAIT_L(0); PG8_MMA(0, 0, At, B0); PG8_BAR; PG8_SCHED;
            PG8_LDB(B1, 0, 1); PG8_STAGE(PG8_SB(0, 0), b2, voffB);
            PG8_BAR; PG8_WAIT_L(0); PG8_MMA(0, 1, At, B1); PG8_BAR;
            PG8_LDA(At, 0, 1); PG8_STAGE(PG8_SA(0, 0), a2, o20);
            PG8_BAR; PG8_WAIT_L(0); PG8_MMA(1, 0, At, B0); PG8_BAR; PG8_SCHED;
            PG8_STAGE(PG8_SB(0, 1), b2 + hstepB, voffB);
            PG8_WAIT_V(6); PG8_BAR; PG8_MMA(1, 1, At, B1); PG8_BAR;
            PG8_LDB(B0, 1, 0); PG8_SCHED; PG8_LDA(At, 1, 0); PG8_STAGE(PG8_SA(0, 1), a2, o21);
            PG8_WAIT_L(8); PG8_BAR; PG8_WAIT_L(0); PG8_MMA(0, 0, At, B0); PG8_BAR; PG8_SCHED;
            PG8_LDB(B1, 1, 1); PG8_STAGE(PG8_SB(1, 0), b3, voffB);
            PG8_BAR; PG8_WAIT_L(0); PG8_MMA(0, 1, At, B1); PG8_BAR;
            PG8_LDA(At, 1, 1); PG8_STAGE(PG8_SA(1, 0), a3, o20);
            PG8_BAR; PG8_WAIT_L(0); PG8_MMA(1, 0, At, B0); PG8_BAR; PG8_SCHED;
            PG8_STAGE(PG8_SB(1, 1), b3 + hstepB, voffB);
            PG8_WAIT_V(6); PG8_BAR; PG8_MMA(1, 1, At, B1); PG8_BAR;
        }
#pragma unroll
        for (int ai = 0; ai < 2; ++ai)
#pragma unroll
            for (int m = 0; m < 4; ++m)
                { if constexpr (Epi::PERM) E.e8(cur.pm * BM + ai * HALF + wr * 64 + m * 16 + fr, cur.pn, wc * 32 + fq * 8, acc[ai][0][m][0], acc[ai][0][m][1], acc[ai][1][m][0], acc[ai][1][m][1]);
                  else { _Pragma("unroll") for (int n = 0; n < 2; ++n) E(cur.pm * BM + ai * HALF + wr * 64 + m * 16 + fr, cur.pn, wc * 32 + n * 16 + fq * 4, acc[ai][0][m][n], acc[ai][1][m][n]); } }
        if (!has_next) break;
#pragma unroll
        for (int a = 0; a < 2; ++a)
#pragma unroll
            for (int b = 0; b < 2; ++b)
#pragma unroll
                for (int m = 0; m < 4; ++m)
#pragma unroll
                    for (int n = 0; n < 2; ++n) acc[a][b][m][n] = (f32x4){0.f, 0.f, 0.f, 0.f};
        cur = nxt; cB = nB; ++ui;
#pragma unroll
        for (int i = 0; i < 2; ++i) { oc0[i] = on0[i]; oc1[i] = on1[i]; }
    }
    PG8_WAIT_V(0);
    if (wr == 0) PG8_BAR;
    PG8_BAR;
#undef PG8_SA
#undef PG8_SB
#undef PG8_STAGE
#undef PG8_LDA
#undef PG8_LDB
#undef PG8_MMA
#undef PG8_WAIT_V
#undef PG8_WAIT_L
#undef PG8_BAR
#undef PG8_SCHED
}
}

struct EpiStoreBf16 { static constexpr bool PERM = false; bf16_t* O; int ldc; int gelu_below;
    __device__ __forceinline__ void operator()(int row, int pn, int cx, f32x4 v0, f32x4 v1) const {
        const int c0 = pn * 256 + cx, c1 = c0 + 128;
        if (c0 < gelu_below) { v0[0] = gelu_tanh_f(v0[0]); v0[1] = gelu_tanh_f(v0[1]); v0[2] = gelu_tanh_f(v0[2]); v0[3] = gelu_tanh_f(v0[3]); }
        if (c1 < gelu_below) { v1[0] = gelu_tanh_f(v1[0]); v1[1] = gelu_tanh_f(v1[1]); v1[2] = gelu_tanh_f(v1[2]); v1[3] = gelu_tanh_f(v1[3]); }
        u32x2 a; a.x = pack2(v0[0], v0[1]); a.y = pack2(v0[2], v0[3]); u32x2 b; b.x = pack2(v1[0], v1[1]); b.y = pack2(v1[2], v1[3]);
        *(u32x2*)(O + (size_t)row * ldc + c0) = a; *(u32x2*)(O + (size_t)row * ldc + c1) = b; } };
struct EpiStoreBf16P { static constexpr bool PERM = true; bf16_t* O; int ldc; int gelu_below;
    __device__ __forceinline__ void e8(int row, int pn, int cx, f32x4 a0, f32x4 a1, f32x4 b0, f32x4 b1) const {
        const int c0 = pn * 256 + cx, c1 = c0 + 128;
        if (c0 < gelu_below) {
#pragma unroll
            for (int i = 0; i < 4; ++i) { a0[i] = gelu_tanh_f(a0[i]); a1[i] = gelu_tanh_f(a1[i]); } }
        if (c1 < gelu_below) {
#pragma unroll
            for (int i = 0; i < 4; ++i) { b0[i] = gelu_tanh_f(b0[i]); b1[i] = gelu_tanh_f(b1[i]); } }
        u32x4 x; x.x = pack2(a0[0], a0[1]); x.y = pack2(a0[2], a0[3]); x.z = pack2(a1[0], a1[1]); x.w = pack2(a1[2], a1[3]);
        u32x4 y; y.x = pack2(b0[0], b0[1]); y.y = pack2(b0[2], b0[3]); y.z = pack2(b1[0], b1[1]); y.w = pack2(b1[2], b1[3]);
        *(u32x4*)(O + (size_t)row * ldc + c0) = x; *(u32x4*)(O + (size_t)row * ldc + c1) = y; } };
struct EpiMoe1P { static constexpr bool PERM = true; bf16_t* H;
    __device__ __forceinline__ void e8(int row, int pn, int cx, f32x4 a0, f32x4 a1, f32x4 b0, f32x4 b1) const {
        u32x4 x; x.x = pack2(silu_f(a0[0]) * b0[0], silu_f(a0[1]) * b0[1]); x.y = pack2(silu_f(a0[2]) * b0[2], silu_f(a0[3]) * b0[3]);
        x.z = pack2(silu_f(a1[0]) * b1[0], silu_f(a1[1]) * b1[1]); x.w = pack2(silu_f(a1[2]) * b1[2], silu_f(a1[3]) * b1[3]);
        *(u32x4*)(H + (size_t)row * 512 + pn * 128 + cx) = x; } };
struct EpiMoe2YP { static constexpr bool PERM = true; const float* sw; bf16_t* Y;
    __device__ __forceinline__ void e8(int row, int pn, int cx, f32x4 a0, f32x4 a1, f32x4 b0, f32x4 b1) const {
        const float w = sw[row];
        u32x4 x; x.x = pack2(a0[0] * w, a0[1] * w); x.y = pack2(a0[2] * w, a0[3] * w); x.z = pack2(a1[0] * w, a1[1] * w); x.w = pack2(a1[2] * w, a1[3] * w);
        u32x4 y; y.x = pack2(b0[0] * w, b0[1] * w); y.y = pack2(b0[2] * w, b0[3] * w); y.z = pack2(b1[0] * w, b1[1] * w); y.w = pack2(b1[2] * w, b1[3] * w);
        bf16_t* d = Y + (size_t)row * 1024 + pn * 256 + cx; *(u32x4*)d = x; *(u32x4*)(d + 128) = y; } };
struct EpiResidual { static constexpr bool PERM = false; const float* srcl; const float* srcc; float* dstl; float* dstc; const float* mod;   int which; float* rss;
    __device__ __forceinline__ void operator()(int row, int pn, int cx, f32x4 v0, f32x4 v1) const {
        const int b = row < TL ? (row >> 13) : 8; const float* g = mod + ((size_t)b * 6 + which) * 1024;
        const float* s = row < TL ? srcl + (size_t)row * 1024 : srcc + (size_t)(row - TL) * 1024;
        float* d = row < TL ? dstl + (size_t)row * 1024 : dstc + (size_t)(row - TL) * 1024;
        const int c0 = pn * 256 + cx, c1 = c0 + 128;
        const f32x4 y0 = *(const f32x4*)(s + c0) + *(const f32x4*)(g + c0) * v0, y1 = *(const f32x4*)(s + c1) + *(const f32x4*)(g + c1) * v1;
        *(f32x4*)(d + c0) = y0; *(f32x4*)(d + c1) = y1;
        float ss = y0[0] * y0[0] + y0[1] * y0[1] + y0[2] * y0[2] + y0[3] * y0[3] + y1[0] * y1[0] + y1[1] * y1[1] + y1[2] * y1[2] + y1[3] * y1[3];
        { auto t1 = __builtin_amdgcn_permlane16_swap(__float_as_uint(ss), __float_as_uint(ss), false, false); ss = __uint_as_float(t1[0]) + __uint_as_float(t1[1]);
          auto t2 = __builtin_amdgcn_permlane32_swap(__float_as_uint(ss), __float_as_uint(ss), false, false); ss = __uint_as_float(t2[0]) + __uint_as_float(t2[1]); }
        if (((cx >> 2) & 3) == 0) rss[(size_t)row * 32 + pn * 8 + (cx >> 5) * 2 + ((cx >> 4) & 1)] = ss; } };
struct EpiMoe1 { static constexpr bool PERM = false; bf16_t* H;
    __device__ __forceinline__ void operator()(int row, int pn, int cx, f32x4 v0, f32x4 v1) const {
        u32x2 a; a.x = pack2(silu_f(v0[0]) * v1[0], silu_f(v0[1]) * v1[1]); a.y = pack2(silu_f(v0[2]) * v1[2], silu_f(v0[3]) * v1[3]);
        *(u32x2*)(H + (size_t)row * 512 + pn * 128 + cx) = a; } };
struct EpiMoe2 { static constexpr bool PERM = false; const int* stok; const float* sw; float* dstl; float* dstc; const float* mod;
    __device__ __forceinline__ void operator()(int row, int pn, int cx, f32x4 v0, f32x4 v1) const {
        const int t = stok[row]; if (t < 0) return; const float w = sw[row];
        const int b = t < TL ? (t >> 13) : 8; const float* g = mod + ((size_t)b * 6 + 5) * 1024;
        float* d = t < TL ? dstl + (size_t)t * 1024 : dstc + (size_t)(t - TL) * 1024;
        const int c0 = pn * 256 + cx, c1 = c0 + 128;
        *(f32x4*)(d + c0) = *(const f32x4*)(d + c0) + *(const f32x4*)(g + c0) * v0 * w;
        *(f32x4*)(d + c1) = *(const f32x4*)(d + c1) + *(const f32x4*)(g + c1) * v1 * w; } };

#ifndef FAST_GEMM
#define FAST_GEMM 1
#endif
template <class EP>
__device__ __forceinline__ void gemm_dense(const Frame& F, const bf16_t* A, const bf16_t* Bt, int M, int N, int K, const EP& E) {
#if FAST_GEMM
    pg8::ProbDense S; S.init(A, Bt, M, N, K, F.G, F.bid); pg8::gemm_phase(F.lds, S, E);
#else
    gemm_dense_naive(F, A, Bt, M, N, K, E);
#endif
}
struct EpiMoe2Y { static constexpr bool PERM = false; const int* stok; const float* sw; bf16_t* Y;
    __device__ __forceinline__ void operator()(int row, int pn, int cx, f32x4 v0, f32x4 v1) const {
        const int t = stok[row]; if (t < 0) return; const float w = sw[row];
        u32x2 a; a.x = pack2(v0[0] * w, v0[1] * w); a.y = pack2(v0[2] * w, v0[3] * w); u32x2 b; b.x = pack2(v1[0] * w, v1[1] * w); b.y = pack2(v1[2] * w, v1[3] * w);
        bf16_t* d = Y + (size_t)row * 1024 + pn * 256 + cx; *(u32x2*)d = a; *(u32x2*)(d + 128) = b; } };
__device__ __forceinline__ void ph_moe_gemm2y(const Frame& F, int layer) {
    const unsigned* info = (const unsigned*)(F.ws + WS_CTRL + C_MOE + layer * 1024) + 128;
    const int nall = (int)__hip_atomic_load(&info[1], __ATOMIC_RELAXED, __HIP_MEMORY_SCOPE_AGENT);
    const int* tile_e = (const int*)(F.ws + WS_R2 + R2_TILEE);
    const bf16_t* W2 = (const bf16_t*)(F.ws + WS_WMOE) + (size_t)32 * 1024 * 1024;
    EpiMoe2YP E{(const float*)(F.ws + WS_R2 + R2_SW), (bf16_t*)(F.ws + WS_PX)};
    pg8::ProbMoe2 S{(const char*)(F.ws + WS_R2 + R2_H), tile_e, (const char*)W2, 512, 0, nall, F.G, F.bid};
    pg8::gemm_phase(F.lds, S, E);
}
template <bool NORM>
__device__ __forceinline__ void ph_moe_combine(const Frame& F, int layer, int nrows, int nl, const float* nw) {
    const bf16_t* Y = (const bf16_t*)(F.ws + WS_PX); const int* tsl = (const int*)(F.ws + WS_R2 + R2_TSLOT);
    float* outl = F.P->out; float* outc = (float*)(F.ws + WS_XC); bf16_t* dst = (bf16_t*)(F.ws + WS_ACT);
    for (int r = F.bid * 8 + F.wave; r < nrows; r += F.G * 8) {
        float* xr = r < TL ? outl + (size_t)r * 1024 : outc + (size_t)(r - TL) * 1024;
        const int b = r < TL ? (r >> 13) : 8;
        const float* g5 = modp(F, layer, b, 5);
        const int s0 = tsl[2 * r], s1 = tsl[2 * r + 1];
        const bf16_t* y0 = Y + (size_t)s0 * 1024; const bf16_t* y1 = Y + (size_t)s1 * 1024;
        f32x4 v[4]; float ss = 0.f;
#pragma unroll
        for (int j = 0; j < 4; ++j) { const int c = j * 256 + F.lane * 4;
            const f32x4 x = *(const f32x4*)(xr + c), g = *(const f32x4*)(g5 + c); const u32x2 a = *(const u32x2*)(y0 + c), bb = *(const u32x2*)(y1 + c);
            f32x4 y; y[0] = lo2f(a.x) + lo2f(bb.x); y[1] = hi2f(a.x) + hi2f(bb.x); y[2] = lo2f(a.y) + lo2f(bb.y); y[3] = hi2f(a.y) + hi2f(bb.y);
            v[j] = x + g * y; *(f32x4*)(xr + c) = v[j];
            ss += v[j][0] * v[j][0] + v[j][1] * v[j][1] + v[j][2] * v[j][2] + v[j][3] * v[j][3]; }
        if (NORM) {
            const float* sh = modp(F, nl, b, 0); const float* sc = modp(F, nl, b, 1);
            ss = wave_sum(ss);
            const float rstd = rsqrtf(ss * (1.f / 1024.f) + EPS);
#pragma unroll
            for (int j = 0; j < 4; ++j) { const int c = j * 256 + F.lane * 4;
                const f32x4 w = *(const f32x4*)(nw + c), s1v = *(const f32x4*)(sc + c), s0v = *(const f32x4*)(sh + c);
                const f32x4 hq = (v[j] * rstd * w) * (1.f + s1v) + s0v;
                u32x2 o; o.x = pack2(hq[0], hq[1]); o.y = pack2(hq[2], hq[3]);
                *(u32x2*)(dst + (size_t)r * 1024 + c) = o; }
        }
    }
}
__device__ __forceinline__ void ph_moe_gemm1(const Frame& F, int layer) {
    const unsigned* info = (const unsigned*)(F.ws + WS_CTRL + C_MOE + layer * 1024) + 128;
    const int ntiles = (int)__hip_atomic_load(&info[1], __ATOMIC_RELAXED, __HIP_MEMORY_SCOPE_AGENT);
    const int* tile_e = (const int*)(F.ws + WS_R2 + R2_TILEE); const int* stok = (const int*)(F.ws + WS_R2 + R2_STOK);
    const bf16_t* W1 = (const bf16_t*)(F.ws + WS_WMOE);
    EpiMoe1P E{(bf16_t*)(F.ws + WS_R2 + R2_H)};
#if FAST_GEMM
    pg8::ProbMoe1 S{(const char*)(F.ws + WS_ACT), stok, tile_e, (const char*)W1, 1024, ntiles, F.G, F.bid};
    pg8::gemm_phase(F.lds, S, E);
#else
    for (int u = F.bid; u < ntiles * 4; u += F.G) { const int pm = u >> 2, pn = u & 3; const int e = tile_e[pm] & 31;
        ARowGather ar{(const bf16_t*)(F.ws + WS_ACT), stok, pm};
        gemm_unit_naive(F, 1024, ar, W1 + ((size_t)e * 1024 + pn * 256) * 1024, E, pm, pn); }
#endif
}
__device__ __forceinline__ void ph_moe_gemm2(const Frame& F, int layer, int k) {
    const unsigned* info = (const unsigned*)(F.ws + WS_CTRL + C_MOE + layer * 1024) + 128;
    const int nk0 = (int)__hip_atomic_load(&info[0], __ATOMIC_RELAXED, __HIP_MEMORY_SCOPE_AGENT), nall = (int)__hip_atomic_load(&info[1], __ATOMIC_RELAXED, __HIP_MEMORY_SCOPE_AGENT);
    const int tlo = k == 0 ? 0 : nk0, thi = k == 0 ? nk0 : nall;
    const int* tile_e = (const int*)(F.ws + WS_R2 + R2_TILEE);
    const bf16_t* W2 = (const bf16_t*)(F.ws + WS_WMOE) + (size_t)32 * 1024 * 1024;
    EpiMoe2 E{(const int*)(F.ws + WS_R2 + R2_STOK), (const float*)(F.ws + WS_R2 + R2_SW), F.P->out, (float*)(F.ws + WS_XC), F.mod + (size_t)layer * 9 * 6144};
#if FAST_GEMM
    pg8::ProbMoe2 S{(const char*)(F.ws + WS_R2 + R2_H), tile_e, (const char*)W2, 512, tlo, thi, F.G, F.bid};
    pg8::gemm_phase(F.lds, S, E);
#else
    for (int u = F.bid; u < (thi - tlo) * 4; u += F.G) { const int pm = tlo + (u >> 2), pn = u & 3; const int e = tile_e[pm] & 31;
        ARowDense ar{(const bf16_t*)(F.ws + WS_R2 + R2_H), 512, pm};
        gemm_unit_naive(F, 512, ar, W2 + ((size_t)e * 1024 + pn * 256) * 512, E, pm, pn); }
#endif
}

__device__ __forceinline__ void ph_gmlp(const Frame& F) {
    const Params& P = *F.P;
    const bf16_t* PX = (const bf16_t*)(F.ws + WS_PX); bf16_t* CAT = (bf16_t*)(F.ws + WS_ACT);
    LAS float* Vs = (LAS float*)F.lds;
    LAS float* Wm = Vs + 128 * 128;
    LAS float* rs = Wm + 128 * 129;
    for (int it = F.bid; it < 528 * 4; it += F.G) {
        const int ch = it >> 2, g = it & 3, row0 = ch * 128;
        for (int q = F.wave; q < 128; q += 8) { const bf16_t* p = PX + (size_t)(row0 + q) * EVEN_IN + 512 + F.lane * 8;
            const u32x4 w = *(const u32x4*)p; float s = 0.f, x;
            x = lo2f(w.x); s += x * x; x = hi2f(w.x); s += x * x; x = lo2f(w.y); s += x * x; x = hi2f(w.y); s += x * x;
            x = lo2f(w.z); s += x * x; x = hi2f(w.z); s += x * x; x = lo2f(w.w); s += x * x; x = hi2f(w.w); s += x * x;
            s = wave_sum(s); if (F.lane == 0) rs[q] = rsqrtf(s * (1.f / 512.f) + EPS); }
        __syncthreads();
        for (int i = F.tid; i < 128 * 128; i += NTH) { const int q = i >> 7, c = i & 127;
            Vs[i] = bf2f(PX[(size_t)(row0 + q) * EVEN_IN + 512 + g * 128 + c]) * rs[q] * P.in[I_GNW][g * 128 + c];
            Wm[q * 129 + c] = P.in[I_GWS][(size_t)g * 16384 + i]; }
        __syncthreads();
        const int ty = F.tid >> 5, tx = F.tid & 31;
        float acc[8][4];
#pragma unroll
        for (int i = 0; i < 8; ++i)
#pragma unroll
            for (int j = 0; j < 4; ++j) acc[i][j] = 0.f;
        for (int q = 0; q < 128; ++q) { const f32x4 v = *(const LAS f32x4*)(Vs + q * 128 + tx * 4);
#pragma unroll
            for (int i = 0; i < 8; ++i) { const float w = Wm[(ty * 8 + i) * 129 + q];
#pragma unroll
                for (int j = 0; j < 4; ++j) acc[i][j] += w * v[j]; } }
#pragma unroll
        for (int i = 0; i < 8; ++i) { const int p = ty * 8 + i; const float bias = P.in[I_GBS][g * 128 + p];
            const size_t t = (size_t)(row0 + p); const int col = g * 128 + tx * 4;
            const u32x2 uu = *(const u32x2*)(PX + t * EVEN_IN + col);
            u32x2 o; o.x = pack2(lo2f(uu.x) * (acc[i][0] + bias), hi2f(uu.x) * (acc[i][1] + bias)); o.y = pack2(lo2f(uu.y) * (acc[i][2] + bias), hi2f(uu.y) * (acc[i][3] + bias));
            *(u32x2*)(CAT + t * 1024 + col) = o; }
        __syncthreads();
    }
}

__device__ __forceinline__ void ph_gmlp_mfma(const Frame& F) {
    const Params& P = *F.P;
    const bf16_t* PX = (const bf16_t*)(F.ws + WS_PX); bf16_t* CAT = (bf16_t*)(F.ws + WS_ACT);
    LAS unsigned char* VT = F.lds;
    LAS unsigned char* WB = F.lds + 34816;
    LAS float* rs = (LAS float*)(F.lds + 69632);
    const int l31 = F.lane & 31, hh = F.lane >> 5;
    for (int it = F.bid; it < 528 * 4; it += F.G) {
        const int ch = it >> 2, g = it & 3, row0 = ch * 128;
        for (int q = F.wave; q < 128; q += 8) { const bf16_t* p = PX + (size_t)(row0 + q) * EVEN_IN + 512 + F.lane * 8;
            const u32x4 w = *(const u32x4*)p; float s = 0.f, x;
            x = lo2f(w.x); s += x * x; x = hi2f(w.x); s += x * x; x = lo2f(w.y); s += x * x; x = hi2f(w.y); s += x * x;
            x = lo2f(w.z); s += x * x; x = hi2f(w.z); s += x * x; x = lo2f(w.w); s += x * x; x = hi2f(w.w); s += x * x;
            s = wave_sum(s); if (F.lane == 0) rs[q] = rsqrtf(s * (1.f / 512.f) + EPS); }
#pragma unroll
        for (int k = 0; k < 4; ++k) { const int c = F.tid + 512 * k, p = c >> 4, part = c & 15;
            const float* src = P.in[I_GWS] + (size_t)g * 16384 + p * 128 + part * 8; const f32x4 a = *(const f32x4*)src, b = *(const f32x4*)(src + 4);
            u32x4 w; w.x = pack2(a[0], a[1]); w.y = pack2(a[2], a[3]); w.z = pack2(b[0], b[1]); w.w = pack2(b[2], b[3]);
            *(LAS u32x4*)(WB + p * 272 + part * 16) = w; }
        __syncthreads();
#pragma unroll
        for (int k = 0; k < 4; ++k) { const int c = F.tid + 512 * k, q = c >> 4, c0 = (c & 15) * 8;
            const u32x4 w = *(const u32x4*)(PX + (size_t)(row0 + q) * EVEN_IN + 512 + g * 128 + c0); const float r = rs[q];
            const float* nw = P.in[I_GNW] + g * 128 + c0; const f32x4 n0 = *(const f32x4*)nw, n1 = *(const f32x4*)(nw + 4);
            LAS unsigned short* d = (LAS unsigned short*)(VT + c0 * 272 + q * 2);
            d[0 * 136] = f2bf(lo2f(w.x) * r * n0[0]); d[1 * 136] = f2bf(hi2f(w.x) * r * n0[1]); d[2 * 136] = f2bf(lo2f(w.y) * r * n0[2]); d[3 * 136] = f2bf(hi2f(w.y) * r * n0[3]);
            d[4 * 136] = f2bf(lo2f(w.z) * r * n1[0]); d[5 * 136] = f2bf(hi2f(w.z) * r * n1[1]); d[6 * 136] = f2bf(lo2f(w.w) * r * n1[2]); d[7 * 136] = f2bf(hi2f(w.w) * r * n1[3]); }
        __syncthreads();
        const int pb = F.wave >> 1, cb0 = (F.wave & 1) * 2;
        f32x16 a0, a1;
#pragma unroll
        for (int r = 0; r < 16; ++r) { a0[r] = 0.f; a1[r] = 0.f; }
#pragma unroll
        for (int ks = 0; ks < 8; ++ks) { const s16x8 wa = *(const LAS s16x8*)(WB + (32 * pb + l31) * 272 + ks * 32 + hh * 16);
            a0 = __builtin_amdgcn_mfma_f32_32x32x16_bf16(wa, *(const LAS s16x8*)(VT + (32 * cb0 + l31) * 272 + ks * 32 + hh * 16), a0, 0, 0, 0);
            a1 = __builtin_amdgcn_mfma_f32_32x32x16_bf16(wa, *(const LAS s16x8*)(VT + (32 * (cb0 + 1) + l31) * 272 + ks * 32 + hh * 16), a1, 0, 0, 0); }
#pragma unroll
        for (int r = 0; r < 16; ++r) { const int p = 32 * pb + (r & 3) + 8 * (r >> 2) + 4 * hh; const float bias = P.in[I_GBS][g * 128 + p];
            const size_t t = (size_t)(row0 + p); const int c0 = g * 128 + 32 * cb0 + l31, c1 = c0 + 32;
            CAT[t * 1024 + c0] = f2bf(bf2f(PX[t * EVEN_IN + c0]) * (a0[r] + bias));
            CAT[t * 1024 + c1] = f2bf(bf2f(PX[t * EVEN_IN + c1]) * (a1[r] + bias)); }
        __syncthreads();
    }
}

__device__ __forceinline__ void ph_gla(const Frame& F) {
    const Params& P = *F.P;
    const bf16_t* PX = (const bf16_t*)(F.ws + WS_PX);
    LAS float* qs = (LAS float*)F.lds;
    LAS float* fs = qs + 8192;
    LAS float* vs = fs + 8192;
    LAS float* os = vs + 2048;
    const int dg = F.lane & 15, el = F.wave * 4 + (F.lane >> 4);
    const int prow = F.tid >> 4, pd0 = (F.tid & 15) * 8;
    const int vrow = F.tid >> 2, ve0 = (F.tid & 3) * 8;
    for (int it = F.bid; it < 256; it += F.G) {
        const int b = it >> 5, h = (it >> 3) & 3, dir = (it >> 2) & 1, sl = it & 3;
        bf16_t* O = (bf16_t*)(F.ws + WS_R2 + (dir ? R2_OB0 : R2_OF0));
        float lb8[8];
#pragma unroll
        for (int i = 0; i < 8; ++i) { const int ch = h * 128 + pd0 + i; const float* lg = P.in[I_LB] + (size_t)dir * 3 * 512 + ch;
            const float a0 = lg[0], a1 = lg[512], a2 = lg[1024]; const float m = fmaxf(a0, fmaxf(a1, a2));
            const float e0 = __expf(a0 - m), e1 = __expf(a1 - m), e2 = __expf(a2 - m); lb8[i] = e0 / (e0 + e1 + e2); }
        float S[8];
#pragma unroll
        for (int i = 0; i < 8; ++i) S[i] = 0.f;
        u32x4 rq0, rq1, rf0, rf1, rv = {0u, 0u, 0u, 0u};
        auto rowof = [&](int nb, int s) -> size_t { const bool c = nb < 4; const int len = c ? CTXL : SEQ; const int tt = (c ? nb : nb - 4) * 64 + s; const int p = dir ? len - 1 - tt : tt;
            return (c ? (size_t)TL + b * CTXL : (size_t)b * SEQ) + p; };
        auto fetch = [&](int nb) { const bf16_t* r0 = PX + rowof(nb, prow) * EVEN_IN; const bf16_t* r1 = PX + rowof(nb, prow + 32) * EVEN_IN;
            rq0 = *(const u32x4*)(r0 + 1024 + h * 128 + pd0); rf0 = *(const u32x4*)(r0 + 2048 + dir * 512 + h * 128 + pd0);
            rq1 = *(const u32x4*)(r1 + 1024 + h * 128 + pd0); rf1 = *(const u32x4*)(r1 + 2048 + dir * 512 + h * 128 + pd0);
            if (F.tid < 256) rv = *(const u32x4*)(PX + rowof(nb, vrow) * EVEN_IN + 1536 + h * 128 + sl * 32 + ve0); };
        auto put = [&](int row, u32x4 q, u32x4 f) { LAS float* qd = qs + row * 128 + pd0; LAS float* fd = fs + row * 128 + pd0;
            const float q8[8] = {lo2f(q.x), hi2f(q.x), lo2f(q.y), hi2f(q.y), lo2f(q.z), hi2f(q.z), lo2f(q.w), hi2f(q.w)};
            const float f8[8] = {lo2f(f.x), hi2f(f.x), lo2f(f.y), hi2f(f.y), lo2f(f.z), hi2f(f.z), lo2f(f.w), hi2f(f.w)};
            f32x4 o0, o1, g0, g1;
#pragma unroll
            for (int i = 0; i < 4; ++i) { o0[i] = q8[i]; o1[i] = q8[4 + i]; g0[i] = lb8[i] + (1.f - lb8[i]) * sigmoid_f(f8[i]); g1[i] = lb8[4 + i] + (1.f - lb8[4 + i]) * sigmoid_f(f8[4 + i]); }
            *(LAS f32x4*)qd = o0; *(LAS f32x4*)(qd + 4) = o1; *(LAS f32x4*)fd = g0; *(LAS f32x4*)(fd + 4) = g1; };
        fetch(0);
        for (int nb = 0; nb < 132; ++nb) {
            __syncthreads();
            put(prow, rq0, rf0); put(prow + 32, rq1, rf1);
            if (F.tid < 256) { LAS float* vd = vs + vrow * 32 + ve0;
                *(LAS f32x4*)vd = (f32x4){lo2f(rv.x), hi2f(rv.x), lo2f(rv.y), hi2f(rv.y)}; *(LAS f32x4*)(vd + 4) = (f32x4){lo2f(rv.z), hi2f(rv.z), lo2f(rv.w), hi2f(rv.w)}; }
            __syncthreads();
            if (nb + 1 < 132) fetch(nb + 1);
#pragma unroll 4
            for (int st = 0; st < 64; ++st) {
                const f32x4 fa = *(const LAS f32x4*)(fs + st * 128 + dg * 8), fb = *(const LAS f32x4*)(fs + st * 128 + dg * 8 + 4);
                const f32x4 qa = *(const LAS f32x4*)(qs + st * 128 + dg * 8), qb = *(const LAS f32x4*)(qs + st * 128 + dg * 8 + 4);
                const float v = vs[st * 32 + el];
                float p0 = 0.f, p1 = 0.f;
#pragma unroll
                for (int i = 0; i < 4; ++i) { S[i] = fa[i] * (S[i] - v) + v; p0 += qa[i] * S[i]; S[4 + i] = fb[i] * (S[4 + i] - v) + v; p1 += qb[i] * S[4 + i]; }
                const float o = sum16(p0 + p1);
                if (dg == 0) os[st * 32 + el] = o;
            }
            __syncthreads();
#pragma unroll
            for (int k = 0; k < 2; ++k) { const int s = (F.tid >> 4) + 32 * k, e2 = (F.tid & 15) * 2;
              *(unsigned*)(O + rowof(nb, s) * 512 + h * 128 + sl * 32 + e2) = pack2(os[s * 32 + e2], os[s * 32 + e2 + 1]); }
        }
        __syncthreads();
    }
}

constexpr size_t R2_GU = 0, R2_GD = 264 * MiB;
constexpr int GS = 132;
__device__ __forceinline__ void gla_geom(int u, int& b, int& h, int& ck, size_t& rbase, int& p0) {
    b = u / 528; h = (u % 528) / 132; ck = u % 132;
    if (ck < 4) { rbase = (size_t)TL + b * CTXL; p0 = ck * 64; } else { rbase = (size_t)b * SEQ; p0 = (ck - 4) * 64; }
}
__device__ __forceinline__ void gla_prep_dir(const Frame& F, int dir, int h, size_t rbase, int p0, LAS float* G, LAS unsigned char* KB) {
    const Params& P = *F.P;
    const bf16_t* PX = (const bf16_t*)(F.ws + WS_PX);
    { const int part = F.tid & 15;
      float lb8[8];
#pragma unroll
      for (int i = 0; i < 8; ++i) { const int chn = h * 128 + part * 8 + i; const float* lg = P.in[I_LB] + (size_t)dir * 3 * 512 + chn;
          const float a0 = lg[0], a1 = lg[512], a2 = lg[1024]; const float m = fmaxf(a0, fmaxf(a1, a2));
          const float e0 = __expf(a0 - m), e1 = __expf(a1 - m), e2 = __expf(a2 - m); lb8[i] = e0 / (e0 + e1 + e2); }
#pragma unroll
      for (int k = 0; k < 2; ++k) { const int i = (F.tid >> 4) + 32 * k, il = dir ? 63 - i : i;
          const u32x4 w = *(const u32x4*)(PX + (rbase + p0 + i) * EVEN_IN + 2048 + dir * 512 + h * 128 + part * 8);
          const float fr[8] = {lo2f(w.x), hi2f(w.x), lo2f(w.y), hi2f(w.y), lo2f(w.z), hi2f(w.z), lo2f(w.w), hi2f(w.w)};
          float f[8], kk[8];
#pragma unroll
          for (int j = 0; j < 8; ++j) { f[j] = lb8[j] + (1.f - lb8[j]) * sigmoid_f(fr[j]); kk[j] = 1.f - f[j]; f[j] = __logf(f[j]); }
          *(LAS f32x4*)(G + il * GS + part * 8) = (f32x4){f[0], f[1], f[2], f[3]}; *(LAS f32x4*)(G + il * GS + part * 8 + 4) = (f32x4){f[4], f[5], f[6], f[7]};
          u32x4 kw; kw.x = pack2(kk[0], kk[1]); kw.y = pack2(kk[2], kk[3]); kw.z = pack2(kk[4], kk[5]); kw.w = pack2(kk[6], kk[7]);
          *(LAS u32x4*)(KB + il * 272 + part * 16) = kw; } }
    __syncthreads();
    const int d = F.tid & 127, seg = F.tid >> 7;
    { float v[16];
#pragma unroll
      for (int r = 0; r < 16; ++r) v[r] = G[(seg * 16 + r) * GS + d];
      float run = 0.f;
#pragma unroll
      for (int r = 0; r < 16; ++r) { run += v[r]; v[r] = run; }
#pragma unroll
      for (int r = 0; r < 16; ++r) G[(seg * 16 + r) * GS + d] = v[r]; }
    __syncthreads();
    float off = 0.f;
#pragma unroll
    for (int s2 = 0; s2 < 3; ++s2) off += (s2 < seg) ? G[(s2 * 16 + 15) * GS + d] : 0.f;
    __syncthreads();
    { float v[16];
#pragma unroll
      for (int r = 0; r < 16; ++r) v[r] = G[(seg * 16 + r) * GS + d];
#pragma unroll
      for (int r = 0; r < 16; ++r) G[(seg * 16 + r) * GS + d] = v[r] + off; }
    __syncthreads();
}
__device__ __forceinline__ void ph_gla_p1(const Frame& F) {
    const bf16_t* PX = (const bf16_t*)(F.ws + WS_PX);
    LAS float* G = (LAS float*)F.lds;
    LAS unsigned char* KB = F.lds + 33792;
    LAS unsigned char* VT = F.lds + 33792 + 17408;
    LAS unsigned char* KT = VT + 18432;
    const int l31 = F.lane & 31, hh = F.lane >> 5;
    for (int u = F.bid; u < 4224; u += F.G) {
        int b, h, ck, p0; size_t rbase; gla_geom(u, b, h, ck, rbase, p0);
#pragma unroll
        for (int k = 0; k < 2; ++k) { const int c = F.tid + 512 * k, i = c >> 4, part = c & 15;
            const u32x4 w = *(const u32x4*)(PX + (rbase + p0 + i) * EVEN_IN + 1536 + h * 128 + part * 8);
            LAS unsigned short* d = (LAS unsigned short*)(VT + (part * 8) * 144 + i * 2);
            d[0 * 72] = (unsigned short)(w.x & 0xffffu); d[1 * 72] = (unsigned short)(w.x >> 16); d[2 * 72] = (unsigned short)(w.y & 0xffffu); d[3 * 72] = (unsigned short)(w.y >> 16);
            d[4 * 72] = (unsigned short)(w.z & 0xffffu); d[5 * 72] = (unsigned short)(w.z >> 16); d[6 * 72] = (unsigned short)(w.w & 0xffffu); d[7 * 72] = (unsigned short)(w.w >> 16); }
        for (int dir = 0; dir < 2; ++dir) {
            gla_prep_dir(F, dir, h, rbase, p0, G, KB);
#pragma unroll
            for (int k = 0; k < 2; ++k) { const int c = F.tid + 512 * k, il = c >> 4, part = c & 15, i = dir ? 63 - il : il;
                const u32x4 kw = *(const LAS u32x4*)(KB + il * 272 + part * 16);
                const float kk[8] = {lo2f(kw.x), hi2f(kw.x), lo2f(kw.y), hi2f(kw.y), lo2f(kw.z), hi2f(kw.z), lo2f(kw.w), hi2f(kw.w)};
                const f32x4 g0 = *(const LAS f32x4*)(G + il * GS + part * 8), g1 = *(const LAS f32x4*)(G + il * GS + part * 8 + 4);
                const f32x4 l0 = *(const LAS f32x4*)(G + 63 * GS + part * 8), l1 = *(const LAS f32x4*)(G + 63 * GS + part * 8 + 4);
                LAS unsigned short* dd = (LAS unsigned short*)(KT + (part * 8) * 144 + i * 2);
#pragma unroll
                for (int j = 0; j < 4; ++j) { dd[j * 72] = f2bf(kk[j] * __expf(l0[j] - g0[j])); dd[(4 + j) * 72] = f2bf(kk[4 + j] * __expf(l1[j] - g1[j])); } }
            if (F.tid < 128) ((float*)(F.ws + WS_R2 + R2_GD))[(size_t)(u * 2 + dir) * 128 + F.tid] = __expf(G[63 * GS + F.tid]);
            __syncthreads();
            { const int db = F.wave >> 1, eb0 = (F.wave & 1) * 2;
              f32x16 a0, a1;
#pragma unroll
              for (int r = 0; r < 16; ++r) { a0[r] = 0.f; a1[r] = 0.f; }
#pragma unroll
              for (int ks = 0; ks < 4; ++ks) { const s16x8 ka = *(const LAS s16x8*)(KT + (32 * db + l31) * 144 + ks * 32 + hh * 16);
                  a0 = __builtin_amdgcn_mfma_f32_32x32x16_bf16(ka, *(const LAS s16x8*)(VT + (32 * eb0 + l31) * 144 + ks * 32 + hh * 16), a0, 0, 0, 0);
                  a1 = __builtin_amdgcn_mfma_f32_32x32x16_bf16(ka, *(const LAS s16x8*)(VT + (32 * (eb0 + 1) + l31) * 144 + ks * 32 + hh * 16), a1, 0, 0, 0); }
              bf16_t* ut = (bf16_t*)(F.ws + WS_R2 + R2_GU) + (size_t)(u * 2 + dir) * 16384;
#pragma unroll
              for (int gq = 0; gq < 4; ++gq) { const int d0 = 32 * db + 8 * gq + 4 * hh; u32x2 x;
                  x.x = pack2(a0[4 * gq], a0[4 * gq + 1]); x.y = pack2(a0[4 * gq + 2], a0[4 * gq + 3]); *(u32x2*)(ut + (32 * eb0 + l31) * 128 + d0) = x;
                  x.x = pack2(a1[4 * gq], a1[4 * gq + 1]); x.y = pack2(a1[4 * gq + 2], a1[4 * gq + 3]); *(u32x2*)(ut + (32 * (eb0 + 1) + l31) * 128 + d0) = x; } }
            __syncthreads();
        }
    }
}
__device__ __forceinline__ void ph_gla_p2(const Frame& F) {
    bf16_t* GU = (bf16_t*)(F.ws + WS_R2 + R2_GU); const float* GD = (const float*)(F.ws + WS_R2 + R2_GD);
    for (int v = gtid(F); v < 64 * 2048; v += F.G * NTH) {
        const int chain = v >> 11, vec = v & 2047, d0 = (vec & 15) * 8;
        const int bh = chain >> 1, dir = chain & 1;
        float s[8];
#pragma unroll
        for (int j = 0; j < 8; ++j) s[j] = 0.f;
#pragma unroll 4
        for (int n = 0; n < 132; ++n) { const int ck = dir ? (n < 4 ? 3 - n : 135 - n) : n; const size_t ud = (size_t)(bh * 132 + ck) * 2 + dir;
            u32x4* p = (u32x4*)(GU + ud * 16384 + (size_t)vec * 8); const u32x4 w = *p;
            const f32x4 c0 = *(const f32x4*)(GD + ud * 128 + d0), c1 = *(const f32x4*)(GD + ud * 128 + d0 + 4);
            u32x4 o; o.x = pack2(s[0], s[1]); o.y = pack2(s[2], s[3]); o.z = pack2(s[4], s[5]); o.w = pack2(s[6], s[7]); *p = o;
            s[0] = c0[0] * s[0] + lo2f(w.x); s[1] = c0[1] * s[1] + hi2f(w.x); s[2] = c0[2] * s[2] + lo2f(w.y); s[3] = c0[3] * s[3] + hi2f(w.y);
            s[4] = c1[0] * s[4] + lo2f(w.z); s[5] = c1[1] * s[5] + hi2f(w.z); s[6] = c1[2] * s[6] + lo2f(w.w); s[7] = c1[3] * s[7] + hi2f(w.w); }
    }
}
__device__ __forceinline__ void ph_gla_p3(const Frame& F) {
    const Params& P = *F.P;
    const bf16_t* PX = (const bf16_t*)(F.ws + WS_PX); bf16_t* CAT = (bf16_t*)(F.ws + WS_ACT);
    LAS float* G = (LAS float*)F.lds;
    LAS unsigned char* KB = F.lds + 33792;
    LAS unsigned char* VT = KB + 17408;
    LAS unsigned char* QB = VT + 18432;
    LAS unsigned char* QT = QB + 17408;
    LAS unsigned char* AM = QT + 17408;
    LAS float* RS = (LAS float*)(AM + 9216);
    const int l31 = F.lane & 31, hh = F.lane >> 5, l15 = F.lane & 15, kq = F.lane >> 4;
    for (int u = F.bid; u < 4224; u += F.G) {
        int b, h, ck, p0; size_t rbase; gla_geom(u, b, h, ck, rbase, p0);
#pragma unroll
        for (int k = 0; k < 2; ++k) { const int c = F.tid + 512 * k, i = c >> 4, part = c & 15;
            const bf16_t* row = PX + (rbase + p0 + i) * EVEN_IN;
            const u32x4 w = *(const u32x4*)(row + 1536 + h * 128 + part * 8);
            LAS unsigned short* d = (LAS unsigned short*)(VT + (part * 8) * 144 + i * 2);
            d[0 * 72] = (unsigned short)(w.x & 0xffffu); d[1 * 72] = (unsigned short)(w.x >> 16); d[2 * 72] = (unsigned short)(w.y & 0xffffu); d[3 * 72] = (unsigned short)(w.y >> 16);
            d[4 * 72] = (unsigned short)(w.z & 0xffffu); d[5 * 72] = (unsigned short)(w.z >> 16); d[6 * 72] = (unsigned short)(w.w & 0xffffu); d[7 * 72] = (unsigned short)(w.w >> 16);
            *(LAS u32x4*)(QB + i * 272 + part * 16) = *(const u32x4*)(row + 1024 + h * 128 + part * 8); }
        const int eb = F.wave >> 1, ib = F.wave & 1;
        f32x16 acc;
#pragma unroll
        for (int r = 0; r < 16; ++r) acc[r] = 0.f;
        for (int dir = 0; dir < 2; ++dir) {
            s16x8 sf[8];
            { const bf16_t* st = (const bf16_t*)(F.ws + WS_R2 + R2_GU) + (size_t)(u * 2 + dir) * 16384 + (size_t)(32 * eb + l31) * 128 + hh * 8;
#pragma unroll
              for (int ds = 0; ds < 8; ++ds) sf[ds] = *(const s16x8*)(st + ds * 16); }
            gla_prep_dir(F, dir, h, rbase, p0, G, KB);
#pragma unroll
            for (int k = 0; k < 2; ++k) { const int c = F.tid + 512 * k, i = c >> 4, part = c & 15, il = dir ? 63 - i : i;
                const u32x4 qw = *(const LAS u32x4*)(QB + i * 272 + part * 16);
                const f32x4 g0 = *(const LAS f32x4*)(G + il * GS + part * 8), g1 = *(const LAS f32x4*)(G + il * GS + part * 8 + 4);
                u32x4 o; o.x = pack2(lo2f(qw.x) * __expf(g0[0]), hi2f(qw.x) * __expf(g0[1])); o.y = pack2(lo2f(qw.y) * __expf(g0[2]), hi2f(qw.y) * __expf(g0[3]));
                o.z = pack2(lo2f(qw.z) * __expf(g1[0]), hi2f(qw.z) * __expf(g1[1])); o.w = pack2(lo2f(qw.w) * __expf(g1[2]), hi2f(qw.w) * __expf(g1[3]));
                *(LAS u32x4*)(QT + i * 272 + part * 16) = o; }
            for (int c = F.tid; c < 576; c += NTH) *(LAS u32x4*)(AM + c * 16) = (u32x4){0u, 0u, 0u, 0u};
            __syncthreads();
            for (int blk = F.wave; blk < 10; blk += 8) {
                const int I = blk < 1 ? 0 : (blk < 3 ? 1 : (blk < 6 ? 2 : 3)); const int J = blk - (I * (I + 1)) / 2;
                const int ia = 16 * I + l15, ja = 16 * J + l15;
                const int ina = dir ? 63 - ia : ia;
                f32x4 ac = {0.f, 0.f, 0.f, 0.f};
#pragma unroll
                for (int ks = 0; ks < 4; ++ks) { const int d0 = 32 * ks + 8 * kq;
                    f32x4 r0 = {0.f, 0.f, 0.f, 0.f}, r1 = {0.f, 0.f, 0.f, 0.f};
                    if (I > 0) { r0 = *(const LAS f32x4*)(G + (16 * I - 1) * GS + d0); r1 = *(const LAS f32x4*)(G + (16 * I - 1) * GS + d0 + 4); }
                    const f32x4 gi0 = *(const LAS f32x4*)(G + ia * GS + d0), gi1 = *(const LAS f32x4*)(G + ia * GS + d0 + 4);
                    const f32x4 gj0 = *(const LAS f32x4*)(G + ja * GS + d0), gj1 = *(const LAS f32x4*)(G + ja * GS + d0 + 4);
                    const u32x4 qw = *(const LAS u32x4*)(QB + ina * 272 + d0 * 2), kw = *(const LAS u32x4*)(KB + ja * 272 + d0 * 2);
                    u32x4 af, bf;
                    af.x = pack2(lo2f(qw.x) * __expf(gi0[0] - r0[0]), hi2f(qw.x) * __expf(gi0[1] - r0[1])); af.y = pack2(lo2f(qw.y) * __expf(gi0[2] - r0[2]), hi2f(qw.y) * __expf(gi0[3] - r0[3]));
                    af.z = pack2(lo2f(qw.z) * __expf(gi1[0] - r1[0]), hi2f(qw.z) * __expf(gi1[1] - r1[1])); af.w = pack2(lo2f(qw.w) * __expf(gi1[2] - r1[2]), hi2f(qw.w) * __expf(gi1[3] - r1[3]));
                    bf.x = pack2(lo2f(kw.x) * __expf(fminf(r0[0] - gj0[0], 80.f)), hi2f(kw.x) * __expf(fminf(r0[1] - gj0[1], 80.f))); bf.y = pack2(lo2f(kw.y) * __expf(fminf(r0[2] - gj0[2], 80.f)), hi2f(kw.y) * __expf(fminf(r0[3] - gj0[3], 80.f)));
                    bf.z = pack2(lo2f(kw.z) * __expf(fminf(r1[0] - gj1[0], 80.f)), hi2f(kw.z) * __expf(fminf(r1[1] - gj1[1], 80.f))); bf.w = pack2(lo2f(kw.w) * __expf(fminf(r1[2] - gj1[2], 80.f)), hi2f(kw.w) * __expf(fminf(r1[3] - gj1[3], 80.f)));
                    ac = __builtin_amdgcn_mfma_f32_16x16x32_bf16(__builtin_bit_cast(s16x8, af), __builtin_bit_cast(s16x8, bf), ac, 0, 0, 0); }
#pragma unroll
                for (int rg = 0; rg < 4; ++rg) { const int il = 16 * I + 4 * kq + rg, jl = 16 * J + l15; const float val = (jl <= il) ? ac[rg] : 0.f;
                    const int in_ = dir ? 63 - il : il, jn = dir ? 63 - jl : jl;
                    *(LAS bf16_t*)(AM + in_ * 144 + jn * 2) = f2bf(val); }
            }
            __syncthreads();
            {
#pragma unroll
              for (int ds = 0; ds < 8; ++ds) acc = __builtin_amdgcn_mfma_f32_32x32x16_bf16(sf[ds], *(const LAS s16x8*)(QT + (32 * ib + l31) * 272 + ds * 32 + hh * 16), acc, 0, 0, 0);
#pragma unroll
              for (int js = 0; js < 4; ++js) acc = __builtin_amdgcn_mfma_f32_32x32x16_bf16(*(const LAS s16x8*)(VT + (32 * eb + l31) * 144 + js * 32 + hh * 16), *(const LAS s16x8*)(AM + (32 * ib + l31) * 144 + js * 32 + hh * 16), acc, 0, 0, 0); }
            __syncthreads();
        }
        { float ss = 0.f;
#pragma unroll
          for (int r = 0; r < 16; ++r) ss += acc[r] * acc[r];
          auto t = __builtin_amdgcn_permlane32_swap(__float_as_uint(ss), __float_as_uint(ss), false, false);
          ss = __uint_as_float(t[0]) + __uint_as_float(t[1]);
          if (hh == 0) RS[eb * 64 + 32 * ib + l31] = ss;
          __syncthreads();
          const int i = 32 * ib + l31; const float tot = RS[i] + RS[64 + i] + RS[128 + i] + RS[192 + i];
          const float rstd = rsqrtf(tot * (1.f / 128.f) + EPS);
          const size_t row = rbase + p0 + i;
#pragma unroll
          for (int gq = 0; gq < 4; ++gq) { const int e0 = 32 * eb + 8 * gq + 4 * hh; const int ch = h * 128 + e0;
              const u32x2 gw = *(const u32x2*)(PX + row * EVEN_IN + 3072 + ch); const f32x4 nw = *(const f32x4*)(P.in[I_HNW] + ch);
              u32x2 o; o.x = pack2(acc[4 * gq] * rstd * nw[0] * silu_f(lo2f(gw.x)), acc[4 * gq + 1] * rstd * nw[1] * silu_f(hi2f(gw.x)));
              o.y = pack2(acc[4 * gq + 2] * rstd * nw[2] * silu_f(lo2f(gw.y)), acc[4 * gq + 3] * rstd * nw[3] * silu_f(hi2f(gw.y)));
              *(u32x2*)(CAT + row * 1024 + 512 + ch) = o; }
          __syncthreads(); }
    }
}

__device__ __forceinline__ void ph_merge(const Frame& F, int mode) {
    const Params& P = *F.P;
    const bf16_t* PX = (const bf16_t*)(F.ws + WS_PX); bf16_t* CAT = (bf16_t*)(F.ws + WS_ACT);
    const bf16_t* Of = (const bf16_t*)(mode ? F.ws + WS_GOF : F.ws + WS_R2 + R2_OF0); const bf16_t* Ob = (const bf16_t*)(mode ? F.ws + WS_WMOE : F.ws + WS_R2 + R2_OB0);
    const int nrows = mode ? TL : TT, ldp = mode ? ODD_PAD : EVEN_IN, gcol = mode ? 1536 : 3072, dcol = mode ? 0 : 512;
    const float* nw = mode ? P.in[I_GDNNW] : P.in[I_HNW];
    for (int r = F.bid * 8 + F.wave; r < nrows; r += F.G * 8) {
        const int c = F.lane * 8;
        const u32x4 a = *(const u32x4*)(Of + (size_t)r * 512 + c), bb = *(const u32x4*)(Ob + (size_t)r * 512 + c), gg = *(const u32x4*)(PX + (size_t)r * ldp + gcol + c);
        float o[8] = {lo2f(a.x) + lo2f(bb.x), hi2f(a.x) + hi2f(bb.x), lo2f(a.y) + lo2f(bb.y), hi2f(a.y) + hi2f(bb.y), lo2f(a.z) + lo2f(bb.z), hi2f(a.z) + hi2f(bb.z), lo2f(a.w) + lo2f(bb.w), hi2f(a.w) + hi2f(bb.w)};
        const float g[8] = {lo2f(gg.x), hi2f(gg.x), lo2f(gg.y), hi2f(gg.y), lo2f(gg.z), hi2f(gg.z), lo2f(gg.w), hi2f(gg.w)};
        float ss = 0.f;
#pragma unroll
        for (int i = 0; i < 8; ++i) ss += o[i] * o[i];
        ss = sum16(ss);
        const float rstd = rsqrtf(ss * (1.f / 128.f) + EPS);
        float y[8];
#pragma unroll
        for (int i = 0; i < 8; ++i) { const float w = mode ? nw[(c & 127) + i] : nw[c + i]; y[i] = o[i] * rstd * w * silu_f(g[i]); }
        u32x4 w; w.x = pack2(y[0], y[1]); w.y = pack2(y[2], y[3]); w.z = pack2(y[4], y[5]); w.w = pack2(y[6], y[7]);
        *(u32x4*)(CAT + (size_t)r * 1024 + dcol + c) = w;
    }
}

__device__ __forceinline__ void ph_mla_norm(const Frame& F) {
    const Params& P = *F.P;
    const bf16_t* PX = (const bf16_t*)(F.ws + WS_PX);
    bf16_t* cqn = (bf16_t*)(F.ws + WS_R2 + R2_CQN); bf16_t* ckvn = cqn + (size_t)TL * 256;
    for (int r = F.bid * 8 + F.wave; r < TT; r += F.G * 8) {
        const bf16_t* row = PX + (size_t)r * ODD_PAD;
        if (r < TL) { const u32x2 w = *(const u32x2*)(row + 2064 + F.lane * 4);
            const float x0 = lo2f(w.x), x1 = hi2f(w.x), x2 = lo2f(w.y), x3 = hi2f(w.y);
            const float ss = wave_sum(x0 * x0 + x1 * x1 + x2 * x2 + x3 * x3); const float rstd = rsqrtf(ss * (1.f / 256.f) + EPS);
            const float* nw = P.in[I_QNW] + F.lane * 4;
            u32x2 o; o.x = pack2(x0 * rstd * nw[0], x1 * rstd * nw[1]); o.y = pack2(x2 * rstd * nw[2], x3 * rstd * nw[3]);
            *(u32x2*)(cqn + (size_t)r * 256 + F.lane * 4) = o; }
        { const unsigned w = *(const unsigned*)(row + 2320 + F.lane * 2);
          const float x0 = lo2f(w), x1 = hi2f(w);
          const float ss = wave_sum(x0 * x0 + x1 * x1); const float rstd = rsqrtf(ss * (1.f / 128.f) + EPS);
          const float* nw = P.in[I_KVNW] + F.lane * 2;
          *(unsigned*)(ckvn + (size_t)r * 256 + F.lane * 2) = pack2(x0 * rstd * nw[0], x1 * rstd * nw[1]);
          *(unsigned*)(ckvn + (size_t)r * 256 + 128 + F.lane * 2) = 0u; }
    }
}

__device__ __forceinline__ void ph_mla_final(const Frame& F) {
    const Params& P = *F.P;
    const bf16_t* PX = (const bf16_t*)(F.ws + WS_PX);
    bf16_t* Q = (bf16_t*)(F.ws + WS_WMOE);
    const bf16_t* KVR = (const bf16_t*)(F.ws + WS_PX + PX_KVRAW);
    bf16_t* Kb = (bf16_t*)(F.ws + WS_R2 + R2_K); bf16_t* Vb = (bf16_t*)(F.ws + WS_R2 + R2_V);
    const int hh = F.lane >> 3, sub = F.lane & 7;
    const float freq = __powf(10000.f, -(float)sub * 0.125f);
    const float qscale = 0.10206207261596577f * 1.4426950408889634f;
    for (int r = F.bid * 8 + F.wave; r < TT; r += F.G * 8) {
        const bool lat = r < TL; const int l = r & (SEQ - 1);
        float ca = 1.f, sa = 0.f, cb = 1.f, sb = 0.f;
        if (lat) { const float pr = (float)(l >> 6), pc = (float)(l & 63); sincosf(pr * freq, &sa, &ca); sincosf(pc * freq, &sb, &cb); }
        { const bf16_t* kv = KVR + (size_t)r * 1024 + hh * 128;
          const u32x4 w = *(const u32x4*)(kv + sub * 8);
          float x[12] = {lo2f(w.x), hi2f(w.x), lo2f(w.y), hi2f(w.y), lo2f(w.z), hi2f(w.z), lo2f(w.w), hi2f(w.w), 0.f, 0.f, 0.f, 0.f};
          const bf16_t* kr = PX + (size_t)r * ODD_PAD + 2448;
          x[8] = bf2f(kr[sub]); x[9] = bf2f(kr[8 + sub]); x[10] = bf2f(kr[16 + sub]); x[11] = bf2f(kr[24 + sub]);
          float ss = 0.f;
#pragma unroll
          for (int i = 0; i < 12; ++i) ss += x[i] * x[i];
          ss = sum8(ss);
          const float rstd = rsqrtf(ss * (1.f / 96.f) + EPS);
          const float* nw = P.in[I_QKK];
#pragma unroll
          for (int i = 0; i < 8; ++i) x[i] *= rstd * nw[sub * 8 + i];
          x[8] *= rstd * nw[64 + sub]; x[9] *= rstd * nw[72 + sub]; x[10] *= rstd * nw[80 + sub]; x[11] *= rstd * nw[88 + sub];
          const float a1 = x[8] * ca - x[9] * sa, a2 = x[9] * ca + x[8] * sa, b1 = x[10] * cb - x[11] * sb, b2 = x[11] * cb + x[10] * sb;
          const int bidx = lat ? (r >> 13) : ((r - TL) >> 8); const int s = lat ? (CTXL + l) : ((r - TL) & 255);
          bf16_t* kd = Kb + ((size_t)(bidx * 8 + hh) * (SEQ + CTXL) + s) * 96;
          u32x4 o; o.x = pack2(x[0], x[1]); o.y = pack2(x[2], x[3]); o.z = pack2(x[4], x[5]); o.w = pack2(x[6], x[7]);
          *(u32x4*)(kd + sub * 8) = o;
          kd[64 + sub] = f2bf(a1); kd[72 + sub] = f2bf(a2); kd[80 + sub] = f2bf(b1); kd[88 + sub] = f2bf(b2);
          const u32x4 vv = *(const u32x4*)(kv + 64 + sub * 8);
          *(u32x4*)(Vb + ((size_t)(bidx * 8 + hh) * (SEQ + CTXL) + s) * 64 + sub * 8) = vv; }
        if (lat) { bf16_t* q = Q + (size_t)r * 768 + hh * 96;
          const u32x4 w = *(const u32x4*)(q + sub * 8);
          float x[12] = {lo2f(w.x), hi2f(w.x), lo2f(w.y), hi2f(w.y), lo2f(w.z), hi2f(w.z), lo2f(w.w), hi2f(w.w), bf2f(q[64 + sub]), bf2f(q[72 + sub]), bf2f(q[80 + sub]), bf2f(q[88 + sub])};
          float ss = 0.f;
#pragma unroll
          for (int i = 0; i < 12; ++i) ss += x[i] * x[i];
          ss = sum8(ss);
          const float rstd = rsqrtf(ss * (1.f / 96.f) + EPS) * qscale;
          const float* nw = P.in[I_QKQ];
#pragma unroll
          for (int i = 0; i < 8; ++i) x[i] *= rstd * nw[sub * 8 + i];
          x[8] *= rstd * nw[64 + sub]; x[9] *= rstd * nw[72 + sub]; x[10] *= rstd * nw[80 + sub]; x[11] *= rstd * nw[88 + sub];
          const float a1 = x[8] * ca - x[9] * sa, a2 = x[9] * ca + x[8] * sa, b1 = x[10] * cb - x[11] * sb, b2 = x[11] * cb + x[10] * sb;
          u32x4 o; o.x = pack2(x[0], x[1]); o.y = pack2(x[2], x[3]); o.z = pack2(x[4], x[5]); o.w = pack2(x[6], x[7]);
          *(u32x4*)(q + sub * 8) = o;
          q[64 + sub] = f2bf(a1); q[72 + sub] = f2bf(a2); q[80 + sub] = f2bf(b1); q[88 + sub] = f2bf(b2); }
    }
}

__device__ __forceinline__ void ph_attn_naive(const Frame& F) {
    const bf16_t* Q = (const bf16_t*)(F.ws + WS_WMOE);
    const bf16_t* Kb = (const bf16_t*)(F.ws + WS_R2 + R2_K); const bf16_t* Vb = (const bf16_t*)(F.ws + WS_R2 + R2_V);
    bf16_t* CAT = (bf16_t*)(F.ws + WS_ACT);
    LAS float* Ks = (LAS float*)F.lds;
    LAS float* Vs = Ks + 64 * 96;
    constexpr int NK = SEQ + CTXL;
    const int hf = F.tid & 1;
    for (int it = F.bid; it < 8 * 8 * 32; it += F.G) {
        const int b = it >> 8, h = (it >> 5) & 7, qb = it & 31;
        const int l = qb * 256 + (F.tid >> 1); const size_t trow = (size_t)b * SEQ + l;
        float q[48], o[32];
        { const bf16_t* qp = Q + trow * 768 + h * 96 + hf * 48;
#pragma unroll
          for (int i = 0; i < 6; ++i) { const u32x4 w = *(const u32x4*)(qp + i * 8);
            q[i * 8 + 0] = lo2f(w.x); q[i * 8 + 1] = hi2f(w.x); q[i * 8 + 2] = lo2f(w.y); q[i * 8 + 3] = hi2f(w.y); q[i * 8 + 4] = lo2f(w.z); q[i * 8 + 5] = hi2f(w.z); q[i * 8 + 6] = lo2f(w.w); q[i * 8 + 7] = hi2f(w.w); } }
#pragma unroll
        for (int d = 0; d < 32; ++d) o[d] = 0.f;
        float m = -3.0e38f, ls = 0.f;
        const bf16_t* kb = Kb + (size_t)(b * 8 + h) * NK * 96; const bf16_t* vb = Vb + (size_t)(b * 8 + h) * NK * 64;
        for (int kt = 0; kt < NK / 64; ++kt) {
            for (int i = F.tid; i < 64 * 96 / 8; i += NTH) { const u32x4 w = *(const u32x4*)(kb + (size_t)kt * 64 * 96 + i * 8); LAS float* d = Ks + i * 8;
                d[0] = lo2f(w.x); d[1] = hi2f(w.x); d[2] = lo2f(w.y); d[3] = hi2f(w.y); d[4] = lo2f(w.z); d[5] = hi2f(w.z); d[6] = lo2f(w.w); d[7] = hi2f(w.w); }
            { const int i = F.tid; const u32x4 w = *(const u32x4*)(vb + (size_t)kt * 64 * 64 + i * 8); LAS float* d = Vs + i * 8;
                d[0] = lo2f(w.x); d[1] = hi2f(w.x); d[2] = lo2f(w.y); d[3] = hi2f(w.y); d[4] = lo2f(w.z); d[5] = hi2f(w.z); d[6] = lo2f(w.w); d[7] = hi2f(w.w); }
            __syncthreads();
            for (int jb = 0; jb < 16; ++jb) {
                float s[4]; float mx = m;
#pragma unroll
                for (int jj = 0; jj < 4; ++jj) { const LAS float* kr = Ks + (jb * 4 + jj) * 96 + hf * 48; float a = 0.f;
#pragma unroll
                    for (int d = 0; d < 48; d += 4) { const f32x4 kv = *(const LAS f32x4*)(kr + d); a += q[d] * kv[0] + q[d + 1] * kv[1] + q[d + 2] * kv[2] + q[d + 3] * kv[3]; }
                    a += __shfl_xor(a, 1);
                    s[jj] = a; mx = fmaxf(mx, a); }
                const float sc = exp2f(m - mx); ls *= sc;
#pragma unroll
                for (int d = 0; d < 32; ++d) o[d] *= sc;
                m = mx;
#pragma unroll
                for (int jj = 0; jj < 4; ++jj) { const float p = exp2f(s[jj] - mx); ls += p; const LAS float* vr = Vs + (jb * 4 + jj) * 64 + hf * 32;
#pragma unroll
                    for (int d = 0; d < 32; d += 4) { const f32x4 vv = *(const LAS f32x4*)(vr + d); o[d] += p * vv[0]; o[d + 1] += p * vv[1]; o[d + 2] += p * vv[2]; o[d + 3] += p * vv[3]; } }
            }
            __syncthreads();
        }
        const float inv = 1.f / ls;
        bf16_t* dst = CAT + trow * 1024 + 512 + h * 64 + hf * 32;
#pragma unroll
        for (int i = 0; i < 4; ++i) { u32x4 w; w.x = pack2(o[i * 8] * inv, o[i * 8 + 1] * inv); w.y = pack2(o[i * 8 + 2] * inv, o[i * 8 + 3] * inv); w.z = pack2(o[i * 8 + 4] * inv, o[i * 8 + 5] * inv); w.w = pack2(o[i * 8 + 6] * inv, o[i * 8 + 7] * inv);
            *(u32x4*)(dst + i * 8) = w; }
    }
}

__device__ __forceinline__ void ph_attn(const Frame& F) {
    constexpr int NK = SEQ + CTXL, NT = NK / 64;
    constexpr int KROWB = 208, VROWB = 144, KBYTES = 64 * KROWB, VBYTES = 64 * VROWB, BUFB = KBYTES + VBYTES;
    const bf16_t* Q = (const bf16_t*)(F.ws + WS_WMOE);
    const bf16_t* Kb = (const bf16_t*)(F.ws + WS_R2 + R2_K); const bf16_t* Vb = (const bf16_t*)(F.ws + WS_R2 + R2_V);
    bf16_t* CAT = (bf16_t*)(F.ws + WS_ACT);
    const int l31 = F.lane & 31, hh = F.lane >> 5;
    const int vcu = (F.G % 8 == 0) ? (F.bid % 8) * (F.G / 8) + F.bid / 8 : F.bid;
    const int kc0 = F.tid, kc1 = F.tid + 512;
    const unsigned kd0 = (unsigned)((kc0 / 12) * KROWB + (kc0 % 12) * 16), kd1 = (unsigned)((kc1 / 12) * KROWB + (kc1 % 12) * 16);
    const int vkey = F.tid >> 3, vpos = (vkey & ~12) | ((vkey & 4) << 1) | ((vkey & 8) >> 1);
    const unsigned vd = (unsigned)(((F.tid & 7) * 8) * VROWB + vpos * 2);
    for (int u = vcu; u < 2048; u += F.G) {
        const int bh = u >> 5, qblk = u & 31, b = bh >> 3, h = bh & 7;
        const size_t trow = (size_t)b * SEQ + qblk * 256 + F.wave * 32 + l31;
        s16x8 qf[6];
        { const bf16_t* qp = Q + trow * 768 + h * 96 + hh * 8;
#pragma unroll
          for (int ds = 0; ds < 6; ++ds) qf[ds] = *(const s16x8*)(qp + ds * 16); }
        f32x16 o0, o1;
#pragma unroll
        for (int i = 0; i < 16; ++i) { o0[i] = 0.f; o1[i] = 0.f; }
        float m = -1.0e30f, lsum = 0.f;
        const bf16_t* kg = Kb + (size_t)bh * NK * 96; const bf16_t* vg = Vb + (size_t)bh * NK * 64;
        u32x4 kr0, kr1 = {0u, 0u, 0u, 0u}, vr;
        kr0 = *(const u32x4*)(kg + (size_t)kc0 * 8); if (kc1 < 768) kr1 = *(const u32x4*)(kg + (size_t)kc1 * 8); vr = *(const u32x4*)(vg + (size_t)F.tid * 8);
        __syncthreads();
        for (int t = 0; t < NT; ++t) {
            { LAS unsigned char* kbuf = F.lds + (t & 1) * BUFB; LAS unsigned char* vbuf = kbuf + KBYTES;
              *(LAS u32x4*)(kbuf + kd0) = kr0; if (kc1 < 768) *(LAS u32x4*)(kbuf + kd1) = kr1;
              LAS unsigned short* vp = (LAS unsigned short*)(vbuf + vd);
              vp[0 * (VROWB / 2)] = (unsigned short)(vr.x & 0xffffu); vp[1 * (VROWB / 2)] = (unsigned short)(vr.x >> 16);
              vp[2 * (VROWB / 2)] = (unsigned short)(vr.y & 0xffffu); vp[3 * (VROWB / 2)] = (unsigned short)(vr.y >> 16);
              vp[4 * (VROWB / 2)] = (unsigned short)(vr.z & 0xffffu); vp[5 * (VROWB / 2)] = (unsigned short)(vr.z >> 16);
              vp[6 * (VROWB / 2)] = (unsigned short)(vr.w & 0xffffu); vp[7 * (VROWB / 2)] = (unsigned short)(vr.w >> 16); }
            __syncthreads();
            if (t + 1 < NT) { const bf16_t* kt = kg + (size_t)(t + 1) * 64 * 96; const bf16_t* vt = vg + (size_t)(t + 1) * 64 * 64;
                kr0 = *(const u32x4*)(kt + (size_t)kc0 * 8); if (kc1 < 768) kr1 = *(const u32x4*)(kt + (size_t)kc1 * 8); vr = *(const u32x4*)(vt + (size_t)F.tid * 8); }
            const LAS unsigned char* kbuf = F.lds + (t & 1) * BUFB; const LAS unsigned char* vbuf = kbuf + KBYTES;
            f32x16 s0, s1;
#pragma unroll
            for (int i = 0; i < 16; ++i) { s0[i] = 0.f; s1[i] = 0.f; }
#pragma unroll
            for (int ds = 0; ds < 6; ++ds) {
                const s16x8 a0 = *(const LAS s16x8*)(kbuf + l31 * KROWB + ds * 32 + hh * 16);
                const s16x8 a1 = *(const LAS s16x8*)(kbuf + (32 + l31) * KROWB + ds * 32 + hh * 16);
                s0 = __builtin_amdgcn_mfma_f32_32x32x16_bf16(a0, qf[ds], s0, 0, 0, 0);
                s1 = __builtin_amdgcn_mfma_f32_32x32x16_bf16(a1, qf[ds], s1, 0, 0, 0);
            }
            float mx = s0[0];
#pragma unroll
            for (int i = 1; i < 16; ++i) mx = fmaxf(mx, s0[i]);
#pragma unroll
            for (int i = 0; i < 16; ++i) mx = fmaxf(mx, s1[i]);
            mx = fmaxf(mx, __shfl_xor(mx, 32));
            const float mn = fmaxf(m, mx); const bool moved = __any(mn > m); const float alpha = __builtin_amdgcn_exp2f(m - mn); m = mn;
            float ps = 0.f;
#pragma unroll
            for (int i = 0; i < 16; ++i) { s0[i] = __builtin_amdgcn_exp2f(s0[i] - mn); s1[i] = __builtin_amdgcn_exp2f(s1[i] - mn); ps += s0[i] + s1[i]; }
            lsum = lsum * alpha + ps;
            if (moved) {
#pragma unroll
                for (int i = 0; i < 16; ++i) { o0[i] *= alpha; o1[i] *= alpha; } }
#pragma unroll
            for (int kb = 0; kb < 2; ++kb)
#pragma unroll
                for (int st = 0; st < 2; ++st) {
                    u32x4 pw;
                    if (kb == 0) { pw.x = pack2(s0[8 * st + 0], s0[8 * st + 1]); pw.y = pack2(s0[8 * st + 2], s0[8 * st + 3]); pw.z = pack2(s0[8 * st + 4], s0[8 * st + 5]); pw.w = pack2(s0[8 * st + 6], s0[8 * st + 7]); }
                    else         { pw.x = pack2(s1[8 * st + 0], s1[8 * st + 1]); pw.y = pack2(s1[8 * st + 2], s1[8 * st + 3]); pw.z = pack2(s1[8 * st + 4], s1[8 * st + 5]); pw.w = pack2(s1[8 * st + 6], s1[8 * st + 7]); }
                    const s16x8 pf = __builtin_bit_cast(s16x8, pw);
                    const int kof = (kb * 32 + 16 * st + 8 * hh) * 2;
                    o0 = __builtin_amdgcn_mfma_f32_32x32x16_bf16(*(const LAS s16x8*)(vbuf + l31 * VROWB + kof), pf, o0, 0, 0, 0);
                    o1 = __builtin_amdgcn_mfma_f32_32x32x16_bf16(*(const LAS s16x8*)(vbuf + (32 + l31) * VROWB + kof), pf, o1, 0, 0, 0);
                }
        }
        const float ltot = lsum + __shfl_xor(lsum, 32); const float inv = 1.f / ltot;
        bf16_t* dst = CAT + trow * 1024 + 512 + h * 64 + hh * 4;
#pragma unroll
        for (int g = 0; g < 4; ++g) { u32x2 w;
            w.x = pack2(o0[4 * g] * inv, o0[4 * g + 1] * inv); w.y = pack2(o0[4 * g + 2] * inv, o0[4 * g + 3] * inv); *(u32x2*)(dst + g * 8) = w;
            w.x = pack2(o1[4 * g] * inv, o1[4 * g + 1] * inv); w.y = pack2(o1[4 * g + 2] * inv, o1[4 * g + 3] * inv); *(u32x2*)(dst + 32 + g * 8) = w; }
    }
    __syncthreads();
}

__device__ __forceinline__ void ph_attn2(const Frame& F) {
    constexpr int NK = SEQ + CTXL, NT = NK / 64;
    constexpr int KROWB = 208, VROWB = 144, KBYTES = 64 * KROWB, VBYTES = 64 * VROWB, BUFB = KBYTES + VBYTES;
    const bf16_t* Q = (const bf16_t*)(F.ws + WS_WMOE);
    const bf16_t* Kb = (const bf16_t*)(F.ws + WS_R2 + R2_K); const bf16_t* Vb = (const bf16_t*)(F.ws + WS_R2 + R2_V);
    bf16_t* CAT = (bf16_t*)(F.ws + WS_ACT);
    const int l31 = F.lane & 31, hh = F.lane >> 5;
    const int vcu = (F.G % 8 == 0) ? (F.bid % 8) * (F.G / 8) + F.bid / 8 : F.bid;
    const int kc0 = F.tid, kc1 = F.tid + 512;
    const unsigned kd0 = (unsigned)((kc0 / 12) * KROWB + (kc0 % 12) * 16), kd1 = (unsigned)((kc1 / 12) * KROWB + (kc1 % 12) * 16);
    const int vkey = F.lane, vpos = (vkey & ~12) | ((vkey & 4) << 1) | ((vkey & 8) >> 1);
    const unsigned vd = (unsigned)((F.wave * 8) * VROWB + vpos * 2);
    const unsigned vgo = (unsigned)(F.lane * 64 + F.wave * 8);
    const bool grpB = F.wave >= 4;
    for (int u = vcu; u < 2048; u += F.G) {
        const int bh = u >> 5, qblk = u & 31, b = bh >> 3, h = bh & 7;
        const size_t trow = (size_t)b * SEQ + qblk * 256 + F.wave * 32 + l31;
        s16x8 qf[6];
        { const bf16_t* qp = Q + trow * 768 + h * 96 + hh * 8;
#pragma unroll
          for (int ds = 0; ds < 6; ++ds) qf[ds] = *(const s16x8*)(qp + ds * 16); }
        f32x16 o0, o1, s0, s1;
#pragma unroll
        for (int i = 0; i < 16; ++i) { o0[i] = 0.f; o1[i] = 0.f; }
        float m = -1.0e30f, lsum = 0.f;
        const bf16_t* kg = Kb + (size_t)bh * NK * 96; const bf16_t* vg = Vb + (size_t)bh * NK * 64;
        u32x4 kr0, kr1 = {0u, 0u, 0u, 0u}, vr;
#define AT_LOADK(t) do { if ((t) < NT) { const bf16_t* kt_ = kg + (size_t)(t) * 64 * 96; kr0 = *(const u32x4*)(kt_ + (size_t)kc0 * 8); if (kc1 < 768) kr1 = *(const u32x4*)(kt_ + (size_t)kc1 * 8); } } while (0)
#define AT_LOADV(t) do { if ((t) < NT) vr = *(const u32x4*)(vg + (size_t)(t) * 64 * 64 + vgo); } while (0)
#define AT_PUTK(t) do { if ((t) < NT) { LAS unsigned char* kb_ = F.lds + ((t) % 3) * BUFB; *(LAS u32x4*)(kb_ + kd0) = kr0; if (kc1 < 768) *(LAS u32x4*)(kb_ + kd1) = kr1; } } while (0)
#define AT_PUTV(t) do { if ((t) < NT) { LAS unsigned short* vp = (LAS unsigned short*)(F.lds + ((t) % 3) * BUFB + KBYTES + vd); \
            vp[0 * (VROWB / 2)] = (unsigned short)(vr.x & 0xffffu); vp[1 * (VROWB / 2)] = (unsigned short)(vr.x >> 16); vp[2 * (VROWB / 2)] = (unsigned short)(vr.y & 0xffffu); vp[3 * (VROWB / 2)] = (unsigned short)(vr.y >> 16); \
            vp[4 * (VROWB / 2)] = (unsigned short)(vr.z & 0xffffu); vp[5 * (VROWB / 2)] = (unsigned short)(vr.z >> 16); vp[6 * (VROWB / 2)] = (unsigned short)(vr.w & 0xffffu); vp[7 * (VROWB / 2)] = (unsigned short)(vr.w >> 16); } } while (0)
#define AT_QK(t) do { const LAS unsigned char* kbuf = F.lds + ((t) % 3) * BUFB; s16x8 ka_[6], kb2_[6]; \
            _Pragma("unroll") for (int ds = 0; ds < 6; ++ds) { ka_[ds] = *(const LAS s16x8*)(kbuf + l31 * KROWB + ds * 32 + hh * 16); kb2_[ds] = *(const LAS s16x8*)(kbuf + (32 + l31) * KROWB + ds * 32 + hh * 16); } \
            _Pragma("unroll") for (int i = 0; i < 16; ++i) { s0[i] = 0.f; s1[i] = 0.f; } \
            _Pragma("unroll") for (int ds = 0; ds < 6; ++ds) { \
                s0 = __builtin_amdgcn_mfma_f32_32x32x16_bf16(ka_[ds], qf[ds], s0, 0, 0, 0); s1 = __builtin_amdgcn_mfma_f32_32x32x16_bf16(kb2_[ds], qf[ds], s1, 0, 0, 0); } } while (0)
#define AT_SMPV(t) do { const LAS unsigned char* vbuf = F.lds + ((t) % 3) * BUFB + KBYTES; s16x8 va_[4], vb2_[4]; \
            _Pragma("unroll") for (int q = 0; q < 4; ++q) { const int kof = ((q >> 1) * 32 + 16 * (q & 1) + 8 * hh) * 2; va_[q] = *(const LAS s16x8*)(vbuf + l31 * VROWB + kof); vb2_[q] = *(const LAS s16x8*)(vbuf + (32 + l31) * VROWB + kof); } \
            float mx = s0[0]; \
            _Pragma("unroll") for (int i = 1; i < 16; ++i) mx = fmaxf(mx, s0[i]); \
            _Pragma("unroll") for (int i = 0; i < 16; ++i) mx = fmaxf(mx, s1[i]); \
            { auto sw_ = __builtin_amdgcn_permlane32_swap(__float_as_uint(mx), __float_as_uint(mx), false, false); mx = fmaxf(__uint_as_float(sw_[0]), __uint_as_float(sw_[1])); } \
            const float mn = fmaxf(m, mx); const bool moved = __any(mn > m); const float alpha = __builtin_amdgcn_exp2f(m - mn); m = mn; \
            float ps = 0.f; \
            _Pragma("unroll") for (int i = 0; i < 16; ++i) { s0[i] = __builtin_amdgcn_exp2f(s0[i] - mn); s1[i] = __builtin_amdgcn_exp2f(s1[i] - mn); ps += s0[i] + s1[i]; } \
            lsum = lsum * alpha + ps; \
            if (moved) { _Pragma("unroll") for (int i = 0; i < 16; ++i) { o0[i] *= alpha; o1[i] *= alpha; } } \
            _Pragma("unroll") for (int q = 0; q < 4; ++q) { \
                const s16x8 pf = pack8((q >> 1) == 0 ? s0 : s1, 8 * (q & 1)); \
                o0 = __builtin_amdgcn_mfma_f32_32x32x16_bf16(va_[q], pf, o0, 0, 0, 0); \
                o1 = __builtin_amdgcn_mfma_f32_32x32x16_bf16(vb2_[q], pf, o1, 0, 0, 0); } } while (0)
        __syncthreads();
        AT_LOADK(0); AT_LOADV(0); AT_PUTK(0); AT_PUTV(0); AT_LOADK(1);
        __syncthreads();
        if (!grpB) {
            for (int t = 0; t < NT; ++t) {
                AT_LOADV(t + 1); AT_QK(t); AT_PUTK(t + 1);
                __syncthreads();
                AT_LOADK(t + 2); AT_SMPV(t); AT_PUTV(t + 1);
                __syncthreads();
            }
            __syncthreads();
        } else {
            AT_PUTK(1); AT_LOADV(1);
            __syncthreads();
            for (int t = 0; t < NT; ++t) {
                AT_LOADK(t + 2); AT_QK(t); AT_PUTV(t + 1);
                __syncthreads();
                AT_LOADV(t + 2); AT_SMPV(t); AT_PUTK(t + 2);
                __syncthreads();
            }
        }
#undef AT_LOADK
#undef AT_LOADV
#undef AT_PUTK
#undef AT_PUTV
#undef AT_QK
#undef AT_SMPV
        float ltot; { auto sw_ = __builtin_amdgcn_permlane32_swap(__float_as_uint(lsum), __float_as_uint(lsum), false, false); ltot = __uint_as_float(sw_[0]) + __uint_as_float(sw_[1]); }
        const float inv = 1.f / ltot;
        bf16_t* dst = CAT + trow * 1024 + 512 + h * 64 + hh * 4;
#pragma unroll
        for (int g = 0; g < 4; ++g) { u32x2 w;
            w.x = pack2(o0[4 * g] * inv, o0[4 * g + 1] * inv); w.y = pack2(o0[4 * g + 2] * inv, o0[4 * g + 3] * inv); *(u32x2*)(dst + g * 8) = w;
            w.x = pack2(o1[4 * g] * inv, o1[4 * g + 1] * inv); w.y = pack2(o1[4 * g + 2] * inv, o1[4 * g + 3] * inv); *(u32x2*)(dst + 32 + g * 8) = w; }
    }
    __syncthreads();
}

__device__ __forceinline__ void ph_gdn(const Frame& F) {
    const Params& P = *F.P;
    const bf16_t* PX = (const bf16_t*)(F.ws + WS_PX);
    LAS bf16_t* rq = (LAS bf16_t*)F.lds;
    LAS bf16_t* rk = rq + 36 * 128;
    LAS bf16_t* rv = rk + 36 * 128;
    LAS float* qc = (LAS float*)(F.lds + 24576);
    LAS float* kc = qc + 4096;
    LAS float* vc = kc + 4096;
    LAS float* os = vc + 1024;
    LAS float* ba = os + 1024;
    const int dg = F.lane & 15, el = F.wave * 4 + (F.lane >> 4);
    for (int it = F.bid; it < 256; it += F.G) {
        const int b = it >> 5, h = (it >> 3) & 3, dir = (it >> 2) & 1, sl = it & 3;
        bf16_t* O = dir ? (bf16_t*)(F.ws + WS_WMOE) : (bf16_t*)(F.ws + WS_GOF);
        const float a_neg = -__expf(P.in[I_ALOG][dir * 4 + h]), dtb = P.in[I_DTB][dir * 4 + h];
        float cwq[5], cwk[5], cwv[5];
        { const int d = F.tid & 127;
#pragma unroll
          for (int j = 0; j < 5; ++j) { cwq[j] = P.in[I_CONVW][j * 1536 + h * 128 + d]; cwk[j] = P.in[I_CONVW][j * 1536 + 512 + h * 128 + d]; cwv[j] = P.in[I_CONVW][j * 1536 + 1024 + h * 128 + sl * 32 + (F.tid & 31)]; } }
        float S[8];
#pragma unroll
        for (int i = 0; i < 8; ++i) S[i] = 0.f;
        u32x4 pr0, pr1, pr2; float pbeta = 0.f, pdec = 0.f;
        auto blk_geom = [&](int bi, int& len, size_t& rbase, int& p0) { const bool c = bi < 8; len = c ? CTXL : SEQ; rbase = c ? (size_t)TL + b * CTXL : (size_t)b * SEQ;
            const int nbk = len / 32, k = c ? bi : bi - 8; p0 = (dir ? (nbk - 1 - k) : k) * 32; };
        auto fetch = [&](int bi, int id) -> u32x4 { int len, p0; size_t rbase; blk_geom(bi, len, rbase, p0);
            u32x4 z = {0u, 0u, 0u, 0u}; if (id >= 1296) return z;
            int arr = 0, j = id; if (j >= 1152) { arr = 2; j -= 1152; } else if (j >= 576) { arr = 1; j -= 576; }
            const int rr = arr == 2 ? (j >> 2) : (j >> 4), part = arr == 2 ? (j & 3) : (j & 15); const int p = p0 - 2 + rr;
            if (p < 0 || p >= len) return z;
            const bf16_t* row = PX + (rbase + p) * ODD_PAD + (arr == 0 ? h * 128 : (arr == 1 ? 512 + h * 128 : 1024 + h * 128 + sl * 32)) + part * 8;
            return *(const u32x4*)row; };
        auto stash = [&](int id, u32x4 w) { if (id >= 1296) return; int arr = 0, j = id; if (j >= 1152) { arr = 2; j -= 1152; } else if (j >= 576) { arr = 1; j -= 576; }
            LAS bf16_t* d = arr == 0 ? rq + j * 8 : (arr == 1 ? rk + j * 8 : rv + j * 8); *(LAS u32x4*)d = w; };
        auto fetch_all = [&](int bi) { pr0 = fetch(bi, F.tid); pr1 = fetch(bi, F.tid + 512); pr2 = fetch(bi, F.tid + 1024);
            if (F.tid < 32) { int len, p0; size_t rbase; blk_geom(bi, len, rbase, p0); const bf16_t* row = PX + (rbase + p0 + F.tid) * ODD_PAD;
                pbeta = bf2f(row[2048 + dir * 4 + h]); pdec = bf2f(row[2056 + dir * 4 + h]); } };
        fetch_all(0);
        for (int bi = 0; bi < 264; ++bi) {
            __syncthreads();
            stash(F.tid, pr0); stash(F.tid + 512, pr1); stash(F.tid + 1024, pr2);
            if (F.tid < 32) { ba[F.tid] = sigmoid_f(pbeta); ba[32 + F.tid] = __expf(a_neg * softplus_f(pdec + dtb)); }
            __syncthreads();
            if (bi + 1 < 264) fetch_all(bi + 1);
            { const int d = F.tid & 127;
#pragma unroll
              for (int i = 0; i < 8; ++i) { const int s = (F.tid >> 7) + i * 4; float a = 0.f, c = 0.f;
#pragma unroll
                for (int j = 0; j < 5; ++j) { a += bf2f(rq[(s + j) * 128 + d]) * cwq[j]; c += bf2f(rk[(s + j) * 128 + d]) * cwk[j]; }
                qc[s * 128 + d] = silu_f(a); kc[s * 128 + d] = silu_f(c); }
#pragma unroll
              for (int i = 0; i < 2; ++i) { const int s = (F.tid >> 5) + i * 16, e = F.tid & 31; float a = 0.f;
#pragma unroll
                for (int j = 0; j < 5; ++j) a += bf2f(rv[(s + j) * 32 + e]) * cwv[j];
                vc[s * 32 + e] = silu_f(a); } }
            __syncthreads();
            { const int s = F.wave * 4 + (F.lane >> 4);
              LAS float* qp = qc + s * 128 + dg * 8; LAS float* kp = kc + s * 128 + dg * 8;
              f32x4 q0 = *(LAS f32x4*)qp, q1 = *(LAS f32x4*)(qp + 4), k0 = *(LAS f32x4*)kp, k1 = *(LAS f32x4*)(kp + 4);
              float sq = 0.f, sk = 0.f;
#pragma unroll
              for (int i = 0; i < 4; ++i) { sq += q0[i] * q0[i] + q1[i] * q1[i]; sk += k0[i] * k0[i] + k1[i] * k1[i]; }
              sq = sum16(sq); sk = sum16(sk);
              const float rq_ = rsqrtf(sq + EPS) * 0.08838834764831845f, rk_ = rsqrtf(sk + EPS);
              *(LAS f32x4*)qp = q0 * rq_; *(LAS f32x4*)(qp + 4) = q1 * rq_; *(LAS f32x4*)kp = k0 * rk_; *(LAS f32x4*)(kp + 4) = k1 * rk_; }
            __syncthreads();
#pragma unroll 2
            for (int ss = 0; ss < 32; ++ss) {
                const int st = dir ? 31 - ss : ss;
                const f32x4 ka = *(const LAS f32x4*)(kc + st * 128 + dg * 8), kb = *(const LAS f32x4*)(kc + st * 128 + dg * 8 + 4);
                const f32x4 qa = *(const LAS f32x4*)(qc + st * 128 + dg * 8), qb = *(const LAS f32x4*)(qc + st * 128 + dg * 8 + 4);
                const float v = vc[st * 32 + el], beta = ba[st], a = ba[32 + st];
                float r0 = 0.f, r1 = 0.f;
#pragma unroll
                for (int i = 0; i < 4; ++i) { r0 += ka[i] * S[i]; r1 += kb[i] * S[4 + i]; }
                const float r = sum16(r0 + r1);
                const float u = beta * (v - a * r);
                float p0 = 0.f, p1 = 0.f;
#pragma unroll
                for (int i = 0; i < 4; ++i) { S[i] = a * S[i] + ka[i] * u; p0 += qa[i] * S[i]; S[4 + i] = a * S[4 + i] + kb[i] * u; p1 += qb[i] * S[4 + i]; }
                const float o = sum16(p0 + p1);
                if (dg == 0) os[st * 32 + el] = o;
            }
            __syncthreads();
            { int len, p0; size_t rbase; blk_geom(bi, len, rbase, p0);
              const int s = F.tid >> 4, e2 = (F.tid & 15) * 2;
              *(unsigned*)(O + (rbase + p0 + s) * 512 + h * 128 + sl * 32 + e2) = pack2(os[s * 32 + e2], os[s * 32 + e2 + 1]); }
        }
        __syncthreads();
    }
}

constexpr int GR_KN = 0, GR_QN = 16384, GR_VT = 32768, GR_T = 49152, GR_QK = 65536, GR_SC = 81920, GR_BYTES = 83968;
__device__ __forceinline__ s16x8 ld2x64(const LAS unsigned char* p) {
    const u32x2 a = *(const LAS u32x2*)p, b = *(const LAS u32x2*)(p + 16); u32x4 v; v.x = a.x; v.y = a.y; v.z = b.x; v.w = b.y; return __builtin_bit_cast(s16x8, v);
}
__device__ __forceinline__ void st2x64(LAS unsigned char* p, u32x4 v) { u32x2 a, b; a.x = v.x; a.y = v.y; b.x = v.z; b.y = v.w; *(LAS u32x2*)p = a; *(LAS u32x2*)(p + 8) = b; }
__device__ __forceinline__ u32x4 ld2x64n(const LAS unsigned char* p) { const u32x2 a = *(const LAS u32x2*)p, b = *(const LAS u32x2*)(p + 8); u32x4 v; v.x = a.x; v.y = a.y; v.z = b.x; v.w = b.y; return v; }
__device__ __forceinline__ void gdn_unit_geom(int b, int ck, size_t& rbase, int& len, int& p0) {
    if (ck < 4) { rbase = (size_t)TL + b * CTXL; len = CTXL; p0 = ck * 64; } else { rbase = (size_t)b * SEQ; len = SEQ; p0 = (ck - 4) * 64; }
}
__device__ __forceinline__ void ph_gdn_prep(const Frame& F) {
    const Params& P = *F.P;
    const bf16_t* PX = (const bf16_t*)(F.ws + WS_PX);
    LAS unsigned char* L = F.lds;
    LAS bf16_t* RAW = (LAS bf16_t*)L;
    LAS unsigned char* KNI = L; LAS unsigned char* QNI = L + 16896;
    LAS float* qf = (LAS float*)(L + 52224);
    LAS float* kf = qf + 8192;
    LAS unsigned char* VTI = L + 52224 + 65536;
    LAS float* SCL = (LAS float*)(L + 52224 + 65536 + 17408);
    LAS float* XS = SCL + 384;
    u32x4 pf[7]; float ps0 = 0.f, ps1 = 0.f, ps2 = 0.f, ps3 = 0.f;
    auto fetch = [&](int u, int tid) { const int b = u / 528, h = (u % 528) / 132, ck = u % 132; size_t rbase; int len, p0; gdn_unit_geom(b, ck, rbase, len, p0);
#pragma unroll
        for (int k = 0; k < 7; ++k) { const int c = tid + 512 * k; u32x4 w = {0u, 0u, 0u, 0u};
            if (c < 68 * 48) { const int rr = c / 48, part = c % 48; const int p = p0 - 2 + rr;
                if (p >= 0 && p < len) w = *(const u32x4*)(PX + (rbase + p) * ODD_PAD + (part >> 4) * 512 + h * 128 + (part & 15) * 8); }
            pf[k] = w; }
        if (tid < 64) { const bf16_t* row = PX + (rbase + p0 + tid) * ODD_PAD; ps0 = bf2f(row[2048 + h]); ps1 = bf2f(row[2052 + h]); ps2 = bf2f(row[2056 + h]); ps3 = bf2f(row[2060 + h]); } };
    if (F.bid < 4224) fetch(F.bid, F.tid);
    for (int u = F.bid; u < 4224; u += F.G) {
        const int b = u / 528, h = (u % 528) / 132, ck = u % 132;
        (void)b; (void)ck;
        int tid = F.tid; asm volatile("" : "+v"(tid));
        const int lane = tid & 63, l31 = lane & 31, hh = lane >> 5, l15 = lane & 15, kq = lane >> 4;
        unsigned char* rec = F.ws + WS_GREC + (size_t)u * GR_BYTES;
#pragma unroll
        for (int k = 0; k < 7; ++k) { const int c = tid + 512 * k; if (c < 68 * 48) *(LAS u32x4*)(RAW + (c / 48) * 384 + (c % 48) * 8) = pf[k]; }
        if (tid < 64) { const float an_f = -__expf(P.in[I_ALOG][h]), an_b = -__expf(P.in[I_ALOG][4 + h]);
            SCL[256 + tid] = sigmoid_f(ps0); SCL[320 + tid] = sigmoid_f(ps1);
            SCL[tid] = an_f * softplus_f(ps2 + P.in[I_DTB][h]); SCL[64 + tid] = an_b * softplus_f(ps3 + P.in[I_DTB][4 + h]); }
        __syncthreads();
        if (u + F.G < 4224) fetch(u + F.G, tid);
        { const int d = tid & 127, rg = tid >> 7;
#pragma unroll 1
          for (int arr = 0; arr < 3; ++arr) {
              float cw[5];
#pragma unroll
              for (int j = 0; j < 5; ++j) cw[j] = P.in[I_CONVW][j * 1536 + arr * 512 + h * 128 + d];
              const LAS bf16_t* rp = RAW + (rg * 16) * 384 + arr * 128 + d;
              float w0 = bf2f(rp[0]), w1 = bf2f(rp[384]), w2 = bf2f(rp[2 * 384]), w3 = bf2f(rp[3 * 384]);
#pragma unroll 4
              for (int ii = 0; ii < 16; ++ii) { const int i = rg * 16 + ii; const float w4 = bf2f(rp[(ii + 4) * 384]);
                  const float o = silu_f(w0 * cw[0] + w1 * cw[1] + w2 * cw[2] + w3 * cw[3] + w4 * cw[4]);
                  if (arr == 0) qf[i * 128 + d] = o; else if (arr == 1) kf[i * 128 + d] = o; else *(LAS bf16_t*)(VTI + d * 136 + i * 2) = f2bf(o);
                  w0 = w1; w1 = w2; w2 = w3; w3 = w4; } } }
        if (tid < 64) { float gf = 0.f, gb = 0.f;
            for (int j = 0; j < 64; ++j) { gf += (j <= tid) ? SCL[j] : 0.f; gb += (j >= tid) ? SCL[64 + j] : 0.f; }
            SCL[128 + tid] = gf; SCL[192 + tid] = gb; }
        __syncthreads();
#pragma unroll
        for (int rr = 0; rr < 8; ++rr) { const int i = F.wave * 8 + rr;
            const float q0 = qf[i * 128 + lane], q1 = qf[i * 128 + 64 + lane], k0 = kf[i * 128 + lane], k1 = kf[i * 128 + 64 + lane];
            const float sq = wave_sum(q0 * q0 + q1 * q1), sk = wave_sum(k0 * k0 + k1 * k1);
            const float rq_ = rsqrtf(sq + EPS) * 0.08838834764831845f, rk_ = rsqrtf(sk + EPS);
            *(LAS bf16_t*)(QNI + i * 264 + lane * 2) = f2bf(q0 * rq_); *(LAS bf16_t*)(QNI + i * 264 + 128 + lane * 2) = f2bf(q1 * rq_);
            *(LAS bf16_t*)(KNI + i * 264 + lane * 2) = f2bf(k0 * rk_); *(LAS bf16_t*)(KNI + i * 264 + 128 + lane * 2) = f2bf(k1 * rk_); }
        __syncthreads();
        { const int mq = F.wave >> 2, ib = (F.wave >> 1) & 1, jb = F.wave & 1;
          const LAS unsigned char* Ai = (mq ? QNI : KNI) + (32 * ib + l31) * 264 + hh * 16; const LAS unsigned char* Bi = KNI + (32 * jb + l31) * 264 + hh * 16;
          f32x16 acc;
#pragma unroll
          for (int r = 0; r < 16; ++r) acc[r] = 0.f;
#pragma unroll
          for (int ds = 0; ds < 8; ++ds) acc = __builtin_amdgcn_mfma_f32_32x32x16_bf16(__builtin_bit_cast(s16x8, ld2x64n(Ai + ds * 32)), __builtin_bit_cast(s16x8, ld2x64n(Bi + ds * 32)), acc, 0, 0, 0);
          const int j = 32 * jb + l31; const float gfj = SCL[128 + j], gbj = SCL[192 + j];
          bf16_t* qkf = (bf16_t*)(rec + GR_QK); bf16_t* qkb = qkf + 4096;
#pragma unroll
          for (int r = 0; r < 16; ++r) { const int i = 32 * ib + (r & 3) + 8 * (r >> 2) + 4 * hh;
              const float ef = __expf(fminf(SCL[128 + i] - gfj, 0.f)), eb = __expf(fminf(SCL[192 + i] - gbj, 0.f));
              if (mq == 0) { qf[i * 64 + j] = (j < i) ? SCL[256 + i] * acc[r] * ef : 0.f; kf[(63 - i) * 64 + (63 - j)] = (j > i) ? SCL[320 + i] * acc[r] * eb : 0.f; }
              else { qkf[i * 64 + j] = f2bf((j <= i) ? acc[r] * ef : 0.f); qkb[i * 64 + j] = f2bf((j >= i) ? acc[r] * eb : 0.f); } }
          for (int c = tid; c < 2048; c += NTH) { const int m2 = c >> 10, o = c & 1023; *(LAS f32x4*)((m2 ? kf : qf) + 4096 + o * 4) = (f32x4){0.f, 0.f, 0.f, 0.f}; } }
        __syncthreads();
        if (F.wave < 2) {
            const LAS float* Am = F.wave == 0 ? qf : kf; LAS float* Tl = (F.wave == 0 ? qf : kf) + 4096;
            const int I = kq, c = l15; const LAS float* Ab = Am + (16 * I) * 64 + 16 * I;
            float t[16];
#pragma unroll
            for (int r = 0; r < 16; ++r) { float a = (c == r) ? 1.f : 0.f;
#pragma unroll
                for (int jg = 0; jg < (r + 3) / 4; ++jg) { const f32x4 m = *(const LAS f32x4*)(Ab + r * 64 + jg * 4);
#pragma unroll
                    for (int q = 0; q < 4; ++q) if (jg * 4 + q < r) a -= m[q] * t[jg * 4 + q]; }
                t[r] = a; Tl[(16 * I + r) * 64 + 16 * I + c] = a; }
        } else {
            const int t6 = tid - 128;
            for (int c = t6; c < 3072; c += 384) {
                u32x4 w; if (c < 2048) { const int cc = c & 1023, row = cc >> 4, part = cc & 15; w = ld2x64n((c < 1024 ? KNI : QNI) + row * 264 + part * 16); }
                else { const int cc = c - 2048, row = cc >> 3, part = cc & 7; w = ld2x64n(VTI + row * 136 + part * 16); }
                *(u32x4*)(rec + (size_t)c * 16) = w; }
            if (t6 < 64) { float* sc = (float*)(rec + GR_SC); const int i = t6;
                const float gf = SCL[128 + i], gb = SCL[192 + i], glf = SCL[128 + 63], glb = SCL[192 + 0];
                sc[i] = SCL[256 + i]; sc[64 + i] = __expf(gf); sc[128 + i] = __expf(glf - gf);
                sc[192 + i] = SCL[320 + i]; sc[256 + i] = __expf(gb); sc[320 + i] = __expf(glb - gb);
                if (i == 0) { sc[384] = __expf(glf); sc[385] = __expf(glb); } }
        }
        __syncthreads();
#pragma unroll
        for (int lev = 1; lev < 4; ++lev) {
            const int mtx = F.wave & 1, idx = F.wave >> 1;
            if (idx < 4 - lev) {
                const int I = idx + lev, J = idx;
                const LAS float* Am = mtx ? kf : qf; LAS float* Tl = (mtx ? kf : qf) + 4096; LAS float* xs = XS + F.wave * 256;
                f32x4 x = {0.f, 0.f, 0.f, 0.f};
                for (int K = J; K < I; ++K) {
#pragma unroll
                    for (int ks = 0; ks < 4; ++ks) x = __builtin_amdgcn_mfma_f32_16x16x4f32(Am[(16 * I + l15) * 64 + 16 * K + 4 * ks + kq], Tl[(16 * K + 4 * ks + kq) * 64 + 16 * J + l15], x, 0, 0, 0); }
#pragma unroll
                for (int rg = 0; rg < 4; ++rg) xs[(4 * kq + rg) * 16 + l15] = x[rg];
                asm volatile("s_waitcnt lgkmcnt(0)" ::: "memory");
                __builtin_amdgcn_wave_barrier();
                f32x4 y = {0.f, 0.f, 0.f, 0.f};
#pragma unroll
                for (int ks = 0; ks < 4; ++ks) y = __builtin_amdgcn_mfma_f32_16x16x4f32(Tl[(16 * I + l15) * 64 + 16 * I + 4 * ks + kq], xs[(4 * ks + kq) * 16 + l15], y, 0, 0, 0);
#pragma unroll
                for (int rg = 0; rg < 4; ++rg) Tl[(16 * I + 4 * kq + rg) * 64 + 16 * J + l15] = -y[rg];
            }
            __syncthreads();
        }
        { bf16_t* Tg = (bf16_t*)(rec + GR_T);
#pragma unroll
          for (int k = 0; k < 16; ++k) { const int e = tid + 512 * k, m2 = e >> 12, o = e & 4095, i = o >> 6, c = o & 63;
              const float v = (m2 ? kf : qf)[4096 + o];
              if (m2 == 0) Tg[i * 64 + c] = f2bf(v); else Tg[4096 + (63 - i) * 64 + (63 - c)] = f2bf(v); } }
        __syncthreads();
    }
}

__device__ __forceinline__ void ph_gdn_scan(const Frame& F) {
    LAS unsigned char* L = F.lds;
    LAS unsigned char* KNI = L;
    LAS unsigned char* QNI = L + 16896;
    LAS unsigned char* VTI = L + 33792;
    LAS unsigned char* KTI = L + 51200;
    LAS unsigned char* TI = L + 68608;
    LAS unsigned char* QKI = L + 77312;
    LAS float* SC = (LAS float*)(L + 86016);
    const int l31 = F.lane & 31, hh = F.lane >> 5, w = F.wave;
    for (int it = F.bid; it < 64; it += F.G) {
        const int b = it >> 3, h = (it >> 1) & 3, dir = it & 1;
        bf16_t* O = dir ? (bf16_t*)(F.ws + WS_WMOE) : (bf16_t*)(F.ws + WS_GOF);
        f32x16 S0, S1, S2, S3;
#pragma unroll
        for (int r = 0; r < 16; ++r) { S0[r] = 0.f; S1[r] = 0.f; S2[r] = 0.f; S3[r] = 0.f; }
        u32x4 pre[16]; float psc = 0.f;
        const int t4 = F.tid - 256;
        auto ckof = [&](int n) -> int { return dir ? (n < 4 ? 3 - n : 135 - n) : n; };
        auto fetch = [&](int n) { const unsigned char* rec = F.ws + WS_GREC + (size_t)((b * 4 + h) * 132 + ckof(n)) * GR_BYTES;
#pragma unroll
            for (int k = 0; k < 12; ++k) pre[k] = *(const u32x4*)(rec + (size_t)(t4 + 256 * k) * 16);
#pragma unroll
            for (int k = 0; k < 2; ++k) { pre[12 + k] = *(const u32x4*)(rec + GR_T + dir * 8192 + (t4 + 256 * k) * 16); pre[14 + k] = *(const u32x4*)(rec + GR_QK + dir * 8192 + (t4 + 256 * k) * 16); }
            if (t4 < 193) psc = ((const float*)(rec + GR_SC))[t4 < 192 ? dir * 192 + t4 : 384 + dir]; };
        if (w >= 4) {
            fetch(0);
            for (int n = 0; n < 132; ++n) {
                __syncthreads();
#pragma unroll
                for (int k = 0; k < 4; ++k) { const int c = t4 + 256 * k, row = c >> 4, part = c & 15; st2x64(KNI + row * 264 + part * 16, pre[k]);
                    LAS unsigned short* kt = (LAS unsigned short*)(KTI + (part * 8) * 136 + row * 2); const u32x4 v = pre[k];
                    kt[0 * 68] = (unsigned short)(v.x & 0xffffu); kt[1 * 68] = (unsigned short)(v.x >> 16); kt[2 * 68] = (unsigned short)(v.y & 0xffffu); kt[3 * 68] = (unsigned short)(v.y >> 16);
                    kt[4 * 68] = (unsigned short)(v.z & 0xffffu); kt[5 * 68] = (unsigned short)(v.z >> 16); kt[6 * 68] = (unsigned short)(v.w & 0xffffu); kt[7 * 68] = (unsigned short)(v.w >> 16); }
#pragma unroll
                for (int k = 4; k < 8; ++k) { const int c = t4 + 256 * (k - 4), row = c >> 4, part = c & 15; st2x64(QNI + row * 264 + part * 16, pre[k]); }
#pragma unroll
                for (int k = 8; k < 12; ++k) { const int c = t4 + 256 * (k - 8), row = c >> 3, part = c & 7; st2x64(VTI + row * 136 + part * 16, pre[k]); }
#pragma unroll
                for (int k = 0; k < 2; ++k) { const int c = t4 + 256 * k, row = c >> 3, part = c & 7; st2x64(TI + row * 136 + part * 16, pre[12 + k]); st2x64(QKI + row * 136 + part * 16, pre[14 + k]); }
                if (t4 < 193) SC[t4] = psc;
                __syncthreads();
                if (n + 1 < 132) fetch(n + 1);
            }
        } else
        for (int n = 0; n < 132; ++n) {
            __syncthreads();
            __syncthreads();
            {
                size_t rbase; int len, p0; gdn_unit_geom(b, ckof(n), rbase, len, p0);
                const float alast = SC[192];
                f32x16 P0, P1;
#pragma unroll
                for (int r = 0; r < 16; ++r) { P0[r] = 0.f; P1[r] = 0.f; }
#pragma unroll
                for (int hq = 0; hq < 2; ++hq) { s16x8 fa[4], fb[4];
#pragma unroll
                  for (int q4 = 0; q4 < 4; ++q4) { const int q = hq * 4 + q4; const int co = (32 * (q >> 1) + 16 * (q & 1) + 4 * hh) * 2; fa[q4] = ld2x64(KNI + l31 * 264 + co); fb[q4] = ld2x64(KNI + (32 + l31) * 264 + co); }
#pragma unroll
                  for (int q4 = 0; q4 < 4; ++q4) { const int q = hq * 4 + q4; const int r = q >> 1; const s16x8 sb = pack8(r == 0 ? S0 : (r == 1 ? S1 : (r == 2 ? S2 : S3)), 8 * (q & 1));
                      P0 = __builtin_amdgcn_mfma_f32_32x32x16_bf16(fa[q4], sb, P0, 0, 0, 0); P1 = __builtin_amdgcn_mfma_f32_32x32x16_bf16(fb[q4], sb, P1, 0, 0, 0); } }
#pragma unroll
                for (int gq = 0; gq < 4; ++gq) {
#pragma unroll
                    for (int ib = 0; ib < 2; ++ib) { const int i0 = 32 * ib + 8 * gq + 4 * hh;
                        const f32x4 be = *(const LAS f32x4*)(SC + i0), eg = *(const LAS f32x4*)(SC + 64 + i0);
                        const u32x2 vv = *(const LAS u32x2*)(VTI + (32 * w + l31) * 136 + i0 * 2);
                        const float v0 = lo2f(vv.x), v1 = hi2f(vv.x), v2 = lo2f(vv.y), v3 = hi2f(vv.y);
                        if (ib == 0) { P0[4 * gq + 0] = be[0] * (v0 - eg[0] * P0[4 * gq + 0]); P0[4 * gq + 1] = be[1] * (v1 - eg[1] * P0[4 * gq + 1]); P0[4 * gq + 2] = be[2] * (v2 - eg[2] * P0[4 * gq + 2]); P0[4 * gq + 3] = be[3] * (v3 - eg[3] * P0[4 * gq + 3]); }
                        else         { P1[4 * gq + 0] = be[0] * (v0 - eg[0] * P1[4 * gq + 0]); P1[4 * gq + 1] = be[1] * (v1 - eg[1] * P1[4 * gq + 1]); P1[4 * gq + 2] = be[2] * (v2 - eg[2] * P1[4 * gq + 2]); P1[4 * gq + 3] = be[3] * (v3 - eg[3] * P1[4 * gq + 3]); } } }
                f32x16 V0, V1;
#pragma unroll
                for (int r = 0; r < 16; ++r) { V0[r] = 0.f; V1[r] = 0.f; }
#pragma unroll
                for (int jb = 0; jb < 2; ++jb)
#pragma unroll
                    for (int s = 0; s < 2; ++s) { const s16x8 pb = pack8(jb == 0 ? P0 : P1, 8 * s); const int co = (32 * jb + 16 * s + 4 * hh) * 2;
                        V0 = __builtin_amdgcn_mfma_f32_32x32x16_bf16(ld2x64(TI + l31 * 136 + co), pb, V0, 0, 0, 0);
                        V1 = __builtin_amdgcn_mfma_f32_32x32x16_bf16(ld2x64(TI + (32 + l31) * 136 + co), pb, V1, 0, 0, 0); }
                f32x16 T0, T1;
#pragma unroll
                for (int r = 0; r < 16; ++r) { T0[r] = 0.f; T1[r] = 0.f; }
#pragma unroll
                for (int r = 0; r < 4; ++r)
#pragma unroll
                    for (int s = 0; s < 2; ++s) { const s16x8 sa = pack8(r == 0 ? S0 : (r == 1 ? S1 : (r == 2 ? S2 : S3)), 8 * s);
                        const int co = (32 * r + 16 * s + 4 * hh) * 2;
                        T0 = __builtin_amdgcn_mfma_f32_32x32x16_bf16(sa, ld2x64(QNI + l31 * 264 + co), T0, 0, 0, 0);
                        T1 = __builtin_amdgcn_mfma_f32_32x32x16_bf16(sa, ld2x64(QNI + (32 + l31) * 264 + co), T1, 0, 0, 0); }
                { const float e0 = SC[64 + l31], e1 = SC[64 + 32 + l31];
#pragma unroll
                  for (int r = 0; r < 16; ++r) { T0[r] *= e0; T1[r] *= e1; } }
#pragma unroll
                for (int jb = 0; jb < 2; ++jb)
#pragma unroll
                    for (int s = 0; s < 2; ++s) { const s16x8 va = pack8(jb == 0 ? V0 : V1, 8 * s); const int co = (32 * jb + 16 * s + 4 * hh) * 2;
                        T0 = __builtin_amdgcn_mfma_f32_32x32x16_bf16(va, ld2x64(QKI + l31 * 136 + co), T0, 0, 0, 0);
                        T1 = __builtin_amdgcn_mfma_f32_32x32x16_bf16(va, ld2x64(QKI + (32 + l31) * 136 + co), T1, 0, 0, 0); }
                { bf16_t* o0 = O + (rbase + p0 + l31) * 512 + h * 128 + 32 * w + 4 * hh; bf16_t* o1 = o0 + (size_t)32 * 512;
#pragma unroll
                  for (int gq = 0; gq < 4; ++gq) { u32x2 x; x.x = pack2(T0[4 * gq], T0[4 * gq + 1]); x.y = pack2(T0[4 * gq + 2], T0[4 * gq + 3]); *(u32x2*)(o0 + gq * 8) = x;
                      x.x = pack2(T1[4 * gq], T1[4 * gq + 1]); x.y = pack2(T1[4 * gq + 2], T1[4 * gq + 3]); *(u32x2*)(o1 + gq * 8) = x; } }
#pragma unroll
                for (int gq = 0; gq < 4; ++gq) { const f32x4 c0 = *(const LAS f32x4*)(SC + 128 + 8 * gq + 4 * hh), c1 = *(const LAS f32x4*)(SC + 128 + 32 + 8 * gq + 4 * hh);
#pragma unroll
                    for (int q = 0; q < 4; ++q) { V0[4 * gq + q] *= c0[q]; V1[4 * gq + q] *= c1[q]; } }
#pragma unroll
                for (int r = 0; r < 16; ++r) { S0[r] *= alast; S1[r] *= alast; S2[r] *= alast; S3[r] *= alast; }
#pragma unroll
                for (int hq = 0; hq < 2; ++hq) { s16x8 fk[8];
#pragma unroll
                  for (int q2 = 0; q2 < 2; ++q2) { const int q = hq * 2 + q2; const int co = (32 * (q >> 1) + 16 * (q & 1) + 4 * hh) * 2;
#pragma unroll
                      for (int r = 0; r < 4; ++r) fk[q2 * 4 + r] = ld2x64(KTI + (32 * r + l31) * 136 + co); }
#pragma unroll
                  for (int q2 = 0; q2 < 2; ++q2) { const int q = hq * 2 + q2; const s16x8 vb = pack8((q >> 1) == 0 ? V0 : V1, 8 * (q & 1));
                      S0 = __builtin_amdgcn_mfma_f32_32x32x16_bf16(fk[q2 * 4 + 0], vb, S0, 0, 0, 0); S1 = __builtin_amdgcn_mfma_f32_32x32x16_bf16(fk[q2 * 4 + 1], vb, S1, 0, 0, 0);
                      S2 = __builtin_amdgcn_mfma_f32_32x32x16_bf16(fk[q2 * 4 + 2], vb, S2, 0, 0, 0); S3 = __builtin_amdgcn_mfma_f32_32x32x16_bf16(fk[q2 * 4 + 3], vb, S3, 0, 0, 0); } }
            }
        }
        __syncthreads();
    }
}

#ifndef FAST_ATTN
#define FAST_ATTN 2
#endif
constexpr int NPHASES = 27;
__global__ void __launch_bounds__(NTH, 2) fwd(Params P) {
    extern __shared__ __attribute__((aligned(16))) unsigned char lds_raw[];
    Frame F; F.P = &P; F.ws = P.ws; F.lds = (LAS unsigned char*)lds_raw;
    F.tid = threadIdx.x; F.lane = F.tid & 63; F.wave = __builtin_amdgcn_readfirstlane(F.tid >> 6); F.G = gridDim.x; F.bid = blockIdx.x;
    F.mod = (float*)(P.ws + WS_CTRL + C_MOD); F.ctrl = (unsigned*)(P.ws + WS_CTRL);
    volatile LAS unsigned* xbw = (volatile LAS unsigned*)(F.lds + LDS_BYTES - 16);
    if (F.tid < 4) xbw[F.tid] = 0u;
    __syncthreads();
    const int lo = P.ph_lo, hi = P.ph_hi;
    const bool single = (hi - lo) > 1;
    XcdBarrier bar; bar.bar = F.ctrl; bar.x = 0; bar.st = xbw;
    if (single) bar = xcd_barrier_post(F.ctrl, xbw);
#ifndef PH_MASK
#define PH_MASK 0xffffffffu
#endif
#ifndef PROBE_MASK
#define PROBE_MASK 0u
#endif
    unsigned long long t_acc = 0ull, t_0 = 0ull;
#define TIC(k) do { if ((PROBE_MASK >> (k)) & 1u) t_0 = __builtin_amdgcn_s_memrealtime(); } while (0)
#define TOC(k) do { if ((PROBE_MASK >> (k)) & 1u) t_acc += __builtin_amdgcn_s_memrealtime() - t_0; } while (0)
#define IN(k) (((PH_MASK >> (k)) & 1u) && lo <= (k) && (k) < hi)
#define SEAM(k) do { if (IN(k) && IN((k) + 1)) xcd_barrier(bar); } while (0)
#ifndef DUP_MASK
#define DUP_MASK 0u
#endif
#define DUP(k) ((DUP_MASK >> (k)) & 1u)
    bf16_t* wsm = (bf16_t*)(P.ws + WS_WSM);
    bf16_t* ACT = (bf16_t*)(P.ws + WS_ACT); bf16_t* PX = (bf16_t*)(P.ws + WS_PX);
    float* XC = (float*)(P.ws + WS_XC);

    TIC(0);
    if (IN(0)) { ph_prologue(F); if (DUP(0)) { __syncthreads(); conv_moe_weights(F, 0, F.bid, F.G); } xcd_barrier(bar); mod_reduce(F); } SEAM(0);
    TOC(0);
    TIC(1);
    if (IN(1)) { ph_rownorm(F, 0, TT, P.in[I_X], P.in[I_CTX], P.in[I_NMIX], 0); if (DUP(1)) ph_rownorm(F, 0, TT, P.in[I_X], P.in[I_CTX], P.in[I_NMIX], 0); } SEAM(1);
    TOC(1);
    TIC(2);
    if (IN(2)) { EpiStoreBf16P E{PX, EVEN_IN, 1024}; gemm_dense(F, ACT, wsm + W_EIN / 2, TT, EVEN_IN, 1024, E); if (DUP(2)) gemm_dense(F, ACT, wsm + W_EIN / 2, TT, EVEN_IN, 1024, E); } SEAM(2);
    TOC(2);
    TIC(3);
    if (IN(3)) { ph_gmlp_mfma(F); __syncthreads(); }
    TOC(3);
#ifndef CHUNKED_GLA
#define CHUNKED_GLA 1
#endif
    TIC(4);
    if (IN(4)) { if (CHUNKED_GLA) ph_gla_p1(F); else ph_gla(F); } SEAM(4);
    TOC(4);
    TIC(5);
    if (IN(5)) { if (CHUNKED_GLA) { ph_gla_p2(F); xcd_barrier(bar); ph_gla_p3(F); } else ph_merge(F, 0); } SEAM(5);
    TOC(5);
    TIC(6);
    if (IN(6)) { EpiResidual E{P.in[I_X], P.in[I_CTX], P.out, XC, F.mod, 2, (float*)(P.ws + WS_R2 + R2_RSS)}; gemm_dense(F, ACT, wsm + W_EOUT / 2, TT, 1024, 1024, E); } SEAM(6);
    TOC(6);
    TIC(7);
    if (IN(7)) { ph_router(F, 0, TT, P.out, XC, P.in[I_NFFN], 3); } SEAM(7);
    TOC(7);
    TIC(8);
    if (IN(8)) { ph_dispatch(F, 0, TT); } SEAM(8);
    TOC(8);
    TIC(9);
    if (IN(9)) { ph_moe_gemm1(F, 0); if (DUP(9)) ph_moe_gemm1(F, 0); } SEAM(9);
    TOC(9);
    TIC(10);
    if (IN(10)) { ph_moe_gemm2y(F, 0); } SEAM(10);
    TOC(10);
    TIC(11);
    if (IN(11)) { }
    TOC(11);
    TIC(12);
    if (IN(12)) { ph_moe_combine<true>(F, 0, TT, 1, P.in[I_NMIX] + 1024);
#ifdef DBG_ZERO
        { u32x4 z = {0u, 0u, 0u, 0u}; u32x4* p = (u32x4*)(P.ws + WS_GREC); const size_t n = (size_t)(990 - 585) * MiB / 16;
          for (size_t i = (size_t)gtid(F); i < n; i += (size_t)F.G * NTH) p[i] = z;
          u32x4* q = (u32x4*)(P.ws + WS_WMOE); const size_t m = (size_t)66 * MiB / 16;
          for (size_t i = (size_t)gtid(F); i < m; i += (size_t)F.G * NTH) q[i] = z; }
#endif
    } SEAM(12);
    TOC(12);
    TIC(13);
    if (IN(13)) { EpiStoreBf16P E{PX, ODD_PAD, 0}; gemm_dense(F, ACT, wsm + W_OIN / 2, TT, ODD_PAD, 1024, E); if (DUP(13)) gemm_dense(F, ACT, wsm + W_OIN / 2, TT, ODD_PAD, 1024, E); } SEAM(13);
    TOC(13);
#ifndef CHUNKED_GDN
#define CHUNKED_GDN 1
#endif
    TIC(14);
    if (IN(14)) { if (CHUNKED_GDN) ph_gdn_prep(F); } SEAM(14);
    TOC(14);
    TIC(15);
    if (IN(15)) { if (CHUNKED_GDN) ph_gdn_scan(F); else ph_gdn(F); } SEAM(15);
    TOC(15);
    TIC(16);
    if (IN(16)) { ph_merge(F, 1); ph_mla_norm(F); } SEAM(16);
    TOC(16);
    TIC(17);
    if (IN(17)) { }
    TOC(17);
    TIC(18);
    if (IN(18)) { const bf16_t* cqn = (const bf16_t*)(P.ws + WS_R2 + R2_CQN);
                  EpiStoreBf16P E1{(bf16_t*)(P.ws + WS_WMOE), 768, 0}; gemm_dense(F, cqn, wsm + W_WQ / 2, TL, 768, 256, E1);
                  EpiStoreBf16P E2{(bf16_t*)(P.ws + WS_PX + PX_KVRAW), 1024, 0}; gemm_dense(F, cqn + (size_t)TL * 256, wsm + W_WKV / 2, TT, 1024, 256, E2); } SEAM(18);
    TOC(18);
    TIC(19);
    if (IN(19)) { ph_mla_final(F); } SEAM(19);
    TOC(19);
    TIC(20);
    if (IN(20)) { if (FAST_ATTN == 2) ph_attn2(F); else if (FAST_ATTN) ph_attn(F); else ph_attn_naive(F); if (DUP(20)) { __syncthreads(); ph_attn2(F); } } SEAM(20);
    TOC(20);
    TIC(21);
    if (IN(21)) { EpiResidual E{P.out, P.out, P.out, P.out, F.mod + 9 * 6144, 2, (float*)(P.ws + WS_R2 + R2_RSS)}; gemm_dense(F, ACT, wsm + W_OOUT / 2, TL, 1024, 1024, E); } SEAM(21);
    TOC(21);
    TIC(22);
    if (IN(22)) { ph_router(F, 1, TL, P.out, XC, P.in[I_NFFN] + 1024, 3); conv_moe_weights(F, 1, F.bid, F.G); } SEAM(22);
    TOC(22);
    TIC(23);
    if (IN(23)) { ph_dispatch(F, 1, TL); } SEAM(23);
    TOC(23);
    TIC(24);
    if (IN(24)) { ph_moe_gemm1(F, 1); if (DUP(24)) ph_moe_gemm1(F, 1); } SEAM(24);
    TOC(24);
    TIC(25);
    if (IN(25)) { ph_moe_gemm2y(F, 1); } SEAM(25);
    TOC(25);
    TIC(26);
    if (IN(26)) { ph_moe_combine<false>(F, 1, TL, 1, nullptr); }
    TOC(26);
    if (PROBE_MASK) { const unsigned long long te = __builtin_amdgcn_s_memrealtime() + 10ull * t_acc; while (__builtin_amdgcn_s_memrealtime() < te) __builtin_amdgcn_s_sleep(8); }
#undef IN
#undef SEAM
}

#ifndef N_LAUNCH_MODE
#define N_LAUNCH_MODE 1
#endif
extern "C" void kernel_launch(void* const* d_in, const int* in_sizes, int n_in, void* d_out, int out_size, void* d_ws, size_t ws_size, hipStream_t stream) {
    static int grid = 0;
    if (grid == 0) {
        if (n_in != 34 || out_size != TL * DM || ws_size < WS_END) { fprintf(stderr, "kernel_launch: unexpected shapes (n_in %d out %d ws %zu)\n", n_in, out_size, ws_size); grid = -1; return; }
        int dev = 0, cus = 0;
        if (hipGetDevice(&dev) != hipSuccess || hipDeviceGetAttribute(&cus, hipDeviceAttributeMultiprocessorCount, dev) != hipSuccess) { grid = -1; return; }
        if (hipFuncSetAttribute((const void*)fwd, hipFuncAttributeMaxDynamicSharedMemorySize, LDS_BYTES) != hipSuccess) { fprintf(stderr, "kernel_launch: hipFuncSetAttribute failed\n"); grid = -1; return; }
        int per_cu = 0;
        (void)hipOccupancyMaxActiveBlocksPerMultiprocessor(&per_cu, (const void*)fwd, NTH, LDS_BYTES);
        (void)hipGetLastError();
        if (per_cu < 1) fprintf(stderr, "kernel_launch: occupancy query says %d\n", per_cu);
        grid = cus;
    }
    if (grid < 0) return;
    (void)hipMemsetAsync(d_ws, 0, MiB, stream);
    Params p{};
    for (int i = 0; i < 34; ++i) p.in[i] = (const float*)d_in[i];
    p.out = (float*)d_out; p.ws = (unsigned char*)d_ws;
#if N_LAUNCH_MODE == 1
    p.ph_lo = 0; p.ph_hi = NPHASES;
    hipLaunchKernelGGL(fwd, dim3(grid), dim3(NTH), LDS_BYTES, stream, p);
#else
    for (int k = 0; k < NPHASES; ++k) { p.ph_lo = k; p.ph_hi = k + 1; hipLaunchKernelGGL(fwd, dim3(grid), dim3(NTH), LDS_BYTES, stream, p); }
#endif
}
```

```cpp
#include <hip/hip_runtime.h>
#include <cstdint>
#include <cstdio>

#define LAS __attribute__((address_space(3)))
typedef unsigned short bf16_t;
typedef float f32x4 __attribute__((ext_vector_type(4)));
typedef unsigned u32x4 __attribute__((ext_vector_type(4)));
typedef unsigned u32x2 __attribute__((ext_vector_type(2)));
typedef float f32x16 __attribute__((ext_vector_type(16)));
typedef short s16x8 __attribute__((ext_vector_type(8)));

constexpr int NB = 8, SEQ = 8192, CTXL = 256, DM = 1024;
constexpr int TL = NB * SEQ, TC = NB * CTXL, TT = TL + TC;
constexpr int EVEN_IN = 3584, ODD_IN = 2480, ODD_PAD = 2560;
constexpr int NTH = 512;
constexpr int LDS_BYTES = 144 * 1024;
constexpr int MAXSLOTS = 151552;
constexpr int MAXTILES = 592;
constexpr float EPS = 1e-6f;

constexpr size_t MiB = 1048576;
constexpr size_t WS_CTRL = 0;
constexpr size_t C_MOE = 16384;
constexpr size_t C_MOD = 65536;
constexpr size_t C_LBT = 32768;
constexpr size_t WS_XC = 1 * MiB;
constexpr size_t WS_WSM = 9 * MiB;
constexpr size_t W_EIN = 0, W_EOUT = 7340032, W_OIN = 9437184, W_OOUT = 14680064, W_WQ = 16777216, W_WKV = 17170432, W_RT = 17694720;
constexpr size_t WS_WMOE = 27 * MiB;
constexpr size_t WS_ACT = 123 * MiB;
constexpr size_t WS_PX = 255 * MiB;
constexpr size_t WS_R2 = 717 * MiB;
constexpr size_t WS_END = 1024 * MiB;
constexpr size_t R2_OF0 = 0, R2_OB0 = 66 * MiB;
constexpr size_t R2_H = 0, R2_STOK = 148 * MiB, R2_SW = 149 * MiB, R2_TOKE = 150 * MiB, R2_TOKW = 151 * MiB, R2_TILEE = 152 * MiB, R2_TSLOT = 153 * MiB;
constexpr size_t R2_K = 0, R2_V = 99 * MiB, R2_OF1 = 165 * MiB, R2_OB1 = 231 * MiB;
constexpr size_t PX_KVRAW = 346030080;
constexpr size_t WS_GREC = 585 * MiB;
constexpr size_t WS_GOF = 924 * MiB;
constexpr size_t R2_CQN = 0;
constexpr size_t R2_RSS = 160 * MiB;
constexpr size_t R2_MODP = 200 * MiB;

struct Params {
    const float* in[34];
    float* out;
    unsigned char* ws;
    int ph_lo, ph_hi;
};
enum { I_X = 0, I_C, I_CTX, I_CCTX, I_ADAW, I_ADAB, I_NMIX, I_NFFN, I_EWIN, I_EWOUT, I_GNW, I_GWS, I_GBS, I_LB, I_HNW,
       I_OWIN, I_OWOUT, I_CONVW, I_ALOG, I_DTB, I_GDNNW, I_QNW, I_WQ, I_KVNW, I_WKV, I_QKQ, I_QKK, I_RGW, I_RGB, I_REW, I_REB, I_MG, I_MU, I_MD };

__device__ __forceinline__ float bf2f(bf16_t b) { return __uint_as_float(((unsigned)b) << 16); }
__device__ __forceinline__ bf16_t f2bf(float f) { unsigned u = __float_as_uint(f); u += 0x7FFFu + ((u >> 16) & 1u); return (bf16_t)(u >> 16); }
typedef __bf16 bf16_2v __attribute__((ext_vector_type(2)));
typedef float f32_2v __attribute__((ext_vector_type(2)));
__device__ __forceinline__ unsigned pack2(float a, float b) { f32_2v v = {a, b}; bf16_2v r = __builtin_convertvector(v, bf16_2v); return __builtin_bit_cast(unsigned, r); }
__device__ __forceinline__ float lo2f(unsigned u) { return __uint_as_float(u << 16); }
__device__ __forceinline__ float hi2f(unsigned u) { return __uint_as_float(u & 0xffff0000u); }
template <int CTRL> __device__ __forceinline__ float dppf(float x) { return __builtin_bit_cast(float, __builtin_amdgcn_mov_dpp(__builtin_bit_cast(int, x), CTRL, 0xf, 0xf, true)); }
__device__ __forceinline__ float sum8(float v) { v += dppf<0xB1>(v); v += dppf<0x4E>(v); v += dppf<0x141>(v); return v; }
__device__ __forceinline__ float sum16(float v) { v = sum8(v); v += dppf<0x128>(v); return v; }
__device__ __forceinline__ float wave_sum(float v) {
    v = sum16(v);
    auto s = __builtin_amdgcn_permlane16_swap(__float_as_uint(v), __float_as_uint(v), false, false);
    v = __uint_as_float(s[0]) + __uint_as_float(s[1]);
    auto t = __builtin_amdgcn_permlane32_swap(__float_as_uint(v), __float_as_uint(v), false, false);
    return __uint_as_float(t[0]) + __uint_as_float(t[1]);
}
__device__ __forceinline__ s16x8 pack8(const f32x16& x, int s8) {
    u32x4 p; p.x = pack2(x[s8 + 0], x[s8 + 1]); p.y = pack2(x[s8 + 2], x[s8 + 3]); p.z = pack2(x[s8 + 4], x[s8 + 5]); p.w = pack2(x[s8 + 6], x[s8 + 7]);
    return __builtin_bit_cast(s16x8, p);
}
__device__ __forceinline__ unsigned lds_inc(LAS unsigned* p) { return __hip_atomic_fetch_add(p, 1u, __ATOMIC_RELAXED, __HIP_MEMORY_SCOPE_WORKGROUP); }
__device__ __forceinline__ float sigmoid_f(float x) { return 1.f / (1.f + __expf(-x)); }
__device__ __forceinline__ float silu_f(float x) { return x / (1.f + __expf(-x)); }
__device__ __forceinline__ float gelu_tanh_f(float x) {
    const float u = 0.7978845608028654f * (x + 0.044715f * x * x * x);
    const float t = 1.f - 2.f / (__expf(2.f * u) + 1.f);
    return 0.5f * x * (1.f + t);
}
__device__ __forceinline__ float softplus_f(float x) { return x > 20.f ? x : log1pf(__expf(x)); }

#define XB_TMO      128
#define XB_XCNT(j)  (256  + 64 * (j))
#define XB_XSUB(j)  (1280 + 64 * (j))
#define XB_XGEN(j)  (2304 + 64 * (j))
#define XB_TOP      3328
#define XB_TOPGEN   3392
#define XCD_BAR_WORDS 3456
#define XB_SPIN_CAP (1u << 24)
__device__ __forceinline__ unsigned xb_ld(unsigned* p)              { return __hip_atomic_load(p, __ATOMIC_RELAXED, __HIP_MEMORY_SCOPE_AGENT); }
__device__ __forceinline__ unsigned xb_add(unsigned* p, unsigned v) { return __hip_atomic_fetch_add(p, v, __ATOMIC_RELAXED, __HIP_MEMORY_SCOPE_AGENT); }
__device__ __forceinline__ unsigned xb_xcc_id() { return (unsigned)__builtin_amdgcn_s_getreg((3 << 11) | 20) & 0xFu; }
#define XB_SPIN(cond, bar) do { unsigned _sp = 0; while (cond) { __builtin_amdgcn_s_sleep(1); \
    if ((++_sp & 255u) == 0u) { if (xb_ld(&(bar)[XB_TMO])) break; if (_sp > XB_SPIN_CAP) { atomicAdd(&(bar)[XB_TMO], 1u); break; } } } } while (0)
struct XcdBarrier { unsigned* bar; unsigned x; volatile LAS unsigned* st; };
__device__ __forceinline__ XcdBarrier xcd_barrier_post(unsigned* bar, volatile LAS unsigned* st) {
    XcdBarrier b; b.bar = bar; b.x = xb_xcc_id(); b.st = st;
    if (threadIdx.x == 0) (void)xb_add(&bar[XB_XCNT(b.x)], 1u);
    return b;
}
__device__ __forceinline__ void xcd_barrier_complete(unsigned* bar, unsigned x, unsigned& nloc, unsigned& nx) {
    const unsigned G = gridDim.x * gridDim.y * gridDim.z;
    unsigned sum, cnt, mine, sp = 0u;
    for (;;) {
        sum = 0u; cnt = 0u; mine = 0u;
#pragma unroll
        for (unsigned j = 0; j < 16; ++j) { const unsigned c = xb_ld(&bar[XB_XCNT(j)]); sum += c; cnt += (c > 0u) ? 1u : 0u; mine = (j == x) ? c : mine; }
        if (sum == G) break;
        __builtin_amdgcn_s_sleep(1);
        if ((++sp & 255u) == 0u) { if (xb_ld(&bar[XB_TMO])) break; if (sp > XB_SPIN_CAP) { atomicAdd(&bar[XB_TMO], 1u); break; } }
    }
    nloc = mine > 0u ? mine : 1u; nx = cnt > 0u ? cnt : 1u;
}
__device__ __forceinline__ void xcd_barrier(const XcdBarrier& b) {
    asm volatile("s_waitcnt vmcnt(0)" ::: "memory");
    __syncthreads();
    if (threadIdx.x == 0) {
        unsigned* bar = b.bar;
        __builtin_amdgcn_s_waitcnt(0);
        unsigned nloc = b.st[0], nx = b.st[1];
        if (nloc == 0u) { xcd_barrier_complete(bar, b.x, nloc, nx); b.st[0] = nloc; b.st[1] = nx; }
        const unsigned old = xb_add(&bar[XB_XSUB(b.x)], 1u);
        const unsigned gen = old / nloc;
        if (old + 1u == (gen + 1u) * nloc) {
            __builtin_amdgcn_fence(__ATOMIC_RELEASE, "agent");
            asm volatile("s_waitcnt vmcnt(0)" ::: "memory");
            const unsigned og = xb_add(&bar[XB_TOP], 1u);
            const unsigned tg = og / nx;
            if (og + 1u == (tg + 1u) * nx) xb_add(&bar[XB_TOPGEN], 1u);
            else XB_SPIN(xb_ld(&bar[XB_TOPGEN]) == tg, bar);
            __builtin_amdgcn_fence(__ATOMIC_ACQUIRE, "agent");
            xb_add(&bar[XB_XGEN(b.x)], 1u);
            asm volatile("s_waitcnt vmcnt(0)" ::: "memory");
        } else {
            XB_SPIN(xb_ld(&bar[XB_XGEN(b.x)]) == gen, bar);
            __builtin_amdgcn_fence(__ATOMIC_ACQUIRE, "agent");
            asm volatile("s_waitcnt vmcnt(0)" ::: "memory");
        }
    }
    __syncthreads();
}

struct Frame {
    const Params* P;
    unsigned char* ws;
    LAS unsigned char* lds;
    int tid, lane, wave, G, bid;
    float* mod;
    unsigned* ctrl;
};
__device__ __forceinline__ int gtid(const Frame& F) { int t = F.tid; asm volatile("" : "+v"(t)); return F.bid * NTH + t; }
__device__ __forceinline__ const float* modp(const Frame& F, int layer, int b, int which) { return F.mod + ((size_t)(layer * 9 + b) * 6 + which) * 1024; }

__device__ __forceinline__ void conv_tile(const Frame& F, const float* src, int K, int N, int lds_, bf16_t* dst, int ldd, int kt, int nt, int rm_mode) {
    LAS float* tile = (LAS float*)F.lds;
    const int t = F.tid;
    {
        const int c = t & 63, r0 = t >> 6;
#pragma unroll
        for (int i = 0; i < 8; ++i) { const int rr = r0 + i * 8, k = kt * 64 + rr, n = nt * 64 + c;
            tile[rr * 65 + c] = (k < K && n < N) ? src[(size_t)k * lds_ + n] : 0.f; }
    }
    __syncthreads();
    {
        const int nl = t >> 3, kc = (t & 7) * 8, n = nt * 64 + nl;
        int row = n;
        if (rm_mode == 1) row = (n >> 7) * 256 + (n & 127);
        else if (rm_mode == 2) row = (n >> 7) * 256 + 128 + (n & 127);
        float v[8];
#pragma unroll
        for (int j = 0; j < 8; ++j) v[j] = tile[(kc + j) * 65 + nl];
        u32x4 w; w.x = pack2(v[0], v[1]); w.y = pack2(v[2], v[3]); w.z = pack2(v[4], v[5]); w.w = pack2(v[6], v[7]);
        *(u32x4*)(dst + (size_t)row * ldd + kt * 64 + kc) = w;
    }
    __syncthreads();
}
__device__ __forceinline__ void conv_moe_weights(const Frame& F, int layer, int item0, int stride) {
    const Params& P = *F.P;
    bf16_t* W1 = (bf16_t*)(F.ws + WS_WMOE); bf16_t* W2 = W1 + (size_t)32 * 1024 * 1024;
    for (int it = item0; it < 12288; it += stride) {
        if (it < 8192) {
            const int up = it >= 4096, j = it & 4095, e = j >> 7, r = j & 127, kt = r >> 3, nt = r & 7;
            const float* src = P.in[up ? I_MU : I_MG] + ((size_t)(layer * 32 + e)) * 1024 * 512;
            conv_tile(F, src, 1024, 512, 512, W1 + (size_t)e * 1024 * 1024, 1024, kt, nt, up ? 2 : 1);
        } else {
            const int j = it - 8192, e = j >> 7, r = j & 127, kt = r >> 4, nt = r & 15;
            const float* src = P.in[I_MD] + ((size_t)(layer * 32 + e)) * 512 * 1024;
            conv_tile(F, src, 512, 1024, 1024, W2 + (size_t)e * 1024 * 512, 512, kt, nt, 0);
        }
    }
}
__device__ __forceinline__ void mod_reduce(const Frame& F) {
    const float* mp = (const float*)(F.ws + WS_R2 + R2_MODP);
    for (int i = gtid(F); i < 18 * 6144; i += F.G * NTH) { float a = F.P->in[I_ADAB][(i / (9 * 6144)) * 6144 + (i % 6144)];
#pragma unroll
        for (int kp = 0; kp < 8; ++kp) a += mp[(size_t)kp * 18 * 6144 + i];
        F.mod[i] = a; }
}
__device__ __forceinline__ void ph_prologue(const Frame& F) {
    const Params& P = *F.P;
    float* modp_ = (float*)(F.ws + WS_R2 + R2_MODP);
    for (int it = F.bid; it < 192; it += F.G) {
        const int l = it / 96, r = it % 96, cb = r >> 3, kp = r & 7;
        LAS float* sc = (LAS float*)F.lds;
        for (int i = F.tid; i < 9 * 128; i += NTH) { const int rr = i >> 7, k = kp * 128 + (i & 127);
            const float cv = rr < 8 ? P.in[I_C][rr * 1024 + k] : P.in[I_CCTX][k]; sc[i] = silu_f(cv); }
        __syncthreads();
        const int n = cb * 512 + F.tid;
        float acc[9];
#pragma unroll
        for (int rr = 0; rr < 9; ++rr) acc[rr] = 0.f;
        const float* w = P.in[I_ADAW] + ((size_t)l * 1024 + kp * 128) * 6144 + n;
#pragma unroll 8
        for (int k = 0; k < 128; ++k) { const float wv = w[(size_t)k * 6144];
#pragma unroll
            for (int rr = 0; rr < 9; ++rr) acc[rr] += sc[rr * 128 + k] * wv; }
#pragma unroll
        for (int rr = 0; rr < 9; ++rr) modp_[((size_t)kp * 18 + l * 9 + rr) * 6144 + n] = acc[rr];
        __syncthreads();
    }
    if (F.bid == 0) for (int i = F.tid; i < 1024; i += NTH) { const float* lg = P.in[I_LB] + (size_t)(i >> 9) * 3 * 512 + (i & 511);
        const float a0 = lg[0], a1 = lg[512], a2 = lg[1024]; const float m = fmaxf(a0, fmaxf(a1, a2));
        const float e0 = __expf(a0 - m), e1 = __expf(a1 - m), e2 = __expf(a2 - m); ((float*)(F.ws + WS_CTRL + C_LBT))[i] = e0 / (e0 + e1 + e2); }
    bf16_t* wsm = (bf16_t*)(F.ws + WS_WSM);
    for (int it = F.bid; it < 2160; it += F.G) {
        int j = it;
        if (j < 896) { conv_tile(F, P.in[I_EWIN], 1024, 3584, 3584, wsm + W_EIN / 2, 1024, j / 56, j % 56, 0); continue; } j -= 896;
        if (j < 256) { conv_tile(F, P.in[I_EWOUT], 1024, 1024, 1024, wsm + W_EOUT / 2, 1024, j >> 4, j & 15, 0); continue; } j -= 256;
        if (j < 640) { conv_tile(F, P.in[I_OWIN], 1024, 2480, 2480, wsm + W_OIN / 2, 1024, j / 40, j % 40, 0); continue; } j -= 640;
        if (j < 256) { conv_tile(F, P.in[I_OWOUT], 1024, 1024, 1024, wsm + W_OOUT / 2, 1024, j >> 4, j & 15, 0); continue; } j -= 256;
        if (j < 48) { conv_tile(F, P.in[I_WQ], 256, 768, 768, wsm + W_WQ / 2, 256, j / 12, j % 12, 0); continue; } j -= 48;
        conv_tile(F, P.in[I_WKV], 128, 1024, 1024, wsm + W_WKV / 2, 256, j >> 4, j & 15, 0);
    }
    for (int i = gtid(F); i < 2 * 48 * 1024; i += F.G * NTH) { const int l = i / (48 * 1024), r = i % (48 * 1024), n = r >> 10, k = r & 1023;
        float w = 0.f; if (n < 4) w = P.in[I_RGW][((size_t)l * 1024 + k) * 4 + n]; else if (n < 36) w = P.in[I_REW][((size_t)l * 1024 + k) * 32 + (n - 4)];
        const bf16_t h = f2bf(w); wsm[W_RT / 2 + (size_t)l * 2 * 48 * 1024 + r] = h; wsm[W_RT / 2 + (size_t)l * 2 * 48 * 1024 + 48 * 1024 + r] = f2bf(w - bf2f(h)); }
    conv_moe_weights(F, 0, F.bid, F.G);
}

__device__ __forceinline__ void ph_rownorm(const Frame& F, int layer, int nrows, const float* xlat, const float* xctx, const float* nw, int si) {
    bf16_t* dst = (bf16_t*)(F.ws + WS_ACT);
    for (int r = F.bid * 8 + F.wave; r < nrows; r += F.G * 8) {
        const float* src = r < TL ? xlat + (size_t)r * 1024 : xctx + (size_t)(r - TL) * 1024;
        const int b = r < TL ? (r >> 13) : 8;
        const float* sh = modp(F, layer, b, si); const float* sc = modp(F, layer, b, si + 1);
        f32x4 v[4]; float ss = 0.f;
#pragma unroll
        for (int j = 0; j < 4; ++j) { v[j] = *(const f32x4*)(src + j * 256 + F.lane * 4); ss += v[j][0] * v[j][0] + v[j][1] * v[j][1] + v[j][2] * v[j][2] + v[j][3] * v[j][3]; }
        ss = wave_sum(ss);
        const float rstd = rsqrtf(ss * (1.f / 1024.f) + EPS);
#pragma unroll
        for (int j = 0; j < 4; ++j) { const int c = j * 256 + F.lane * 4;
            const f32x4 w = *(const f32x4*)(nw + c), s1 = *(const f32x4*)(sc + c), s0 = *(const f32x4*)(sh + c);
            v[j] = (v[j] * rstd * w) * (1.f + s1) + s0;
            u32x2 o; o.x = pack2(v[j][0], v[j][1]); o.y = pack2(v[j][2], v[j][3]);
            *(u32x2*)(dst + (size_t)r * 1024 + c) = o; }
    }
}
typedef short s16x8r __attribute__((ext_vector_type(8)));
__device__ __forceinline__ void ph_router(const Frame& F, int layer, int nrows, const float* xlat, const float* xctx, const float* nw, int si) {
    const Params& P = *F.P;
    bf16_t* dst = (bf16_t*)(F.ws + WS_ACT);
    LAS unsigned* hist = (LAS unsigned*)F.lds;
    LAS float* lg = (LAS float*)(F.lds + 256) + F.wave * (16 * 48);
    int* tok_e = (int*)(F.ws + WS_R2 + R2_TOKE); float* tok_w = (float*)(F.ws + WS_R2 + R2_TOKW);
    LAS float* CA = (LAS float*)(F.lds + 24832); LAS float* CB = CA + 9 * 1024;
    if (F.tid < 64) hist[F.tid] = 0u;
    for (int i = F.tid; i < 9 * 1024; i += NTH) { const int bb = i >> 10, c = i & 1023; const float sc1 = modp(F, layer, bb, si + 1)[c];
        CA[i] = nw[c] * (1.f + sc1); CB[i] = modp(F, layer, bb, si)[c]; }
    __syncthreads();
    unsigned* gq = (unsigned*)(F.ws + WS_CTRL + C_MOE + layer * 1024) + 160;
    { int* stok = (int*)(F.ws + WS_R2 + R2_STOK);
      float* swz = (float*)(F.ws + WS_R2 + R2_SW);
      for (int i = gtid(F); i < MAXSLOTS; i += F.G * NTH) { stok[i] = -1; swz[i] = 0.f; } }
    const bf16_t* Wh = (const bf16_t*)(F.ws + WS_WSM) + W_RT / 2 + (size_t)layer * 2 * 48 * 1024; const bf16_t* Wl = Wh + 48 * 1024;
    const int lr = F.lane & 15, kq = F.lane >> 4;
    const float* rgb = P.in[I_RGB] + layer * 4; const float* reb = P.in[I_REB] + layer * 32;
    for (;;) {
        int g = 0; if (F.lane == 0) g = (int)__hip_atomic_fetch_add(gq, 1u, __ATOMIC_RELAXED, __HIP_MEMORY_SCOPE_AGENT);
        g = __builtin_amdgcn_readfirstlane(g);
        if (g >= nrows / 16) break;
        const int r0 = g * 16;
        const float* src0 = r0 < TL ? xlat + (size_t)r0 * 1024 : xctx + (size_t)(r0 - TL) * 1024;
        const int b = r0 < TL ? (r0 >> 13) : 8;
        const LAS float* ca = CA + b * 1024 + kq * 8; const LAS float* cb = CB + b * 1024 + kq * 8;
        float myrstd;
        { const float* rp = (const float*)(F.ws + WS_R2 + R2_RSS) + (size_t)(r0 + lr) * 32 + kq * 8;
          const f32x4 p0 = *(const f32x4*)rp, p1 = *(const f32x4*)(rp + 4);
          float ss = ((p0[0] + p0[1]) + (p0[2] + p0[3])) + ((p1[0] + p1[1]) + (p1[2] + p1[3]));
          auto t1 = __builtin_amdgcn_permlane16_swap(__float_as_uint(ss), __float_as_uint(ss), false, false); ss = __uint_as_float(t1[0]) + __uint_as_float(t1[1]);
          auto t2 = __builtin_amdgcn_permlane32_swap(__float_as_uint(ss), __float_as_uint(ss), false, false); ss = __uint_as_float(t2[0]) + __uint_as_float(t2[1]);
          myrstd = rsqrtf(ss * (1.f / 1024.f) + EPS); }
        f32x4 acc[3];
#pragma unroll
        for (int nb = 0; nb < 3; ++nb) acc[nb] = (f32x4){0.f, 0.f, 0.f, 0.f};
        const float* xr = src0 + (size_t)lr * 1024 + kq * 8;
        bf16_t* dr = dst + (size_t)(r0 + lr) * 1024 + kq * 8;
#pragma unroll 4
        for (int ks = 0; ks < 32; ++ks) { const int c = ks * 32 + kq * 8;
            const f32x4 x0 = *(const f32x4*)(xr + ks * 32), x1 = *(const f32x4*)(xr + ks * 32 + 4);
            const f32x4 a0 = *(const LAS f32x4*)(ca + ks * 32), a1 = *(const LAS f32x4*)(ca + ks * 32 + 4), b0 = *(const LAS f32x4*)(cb + ks * 32), b1 = *(const LAS f32x4*)(cb + ks * 32 + 4);
            const f32x4 h0 = (x0 * myrstd) * a0 + b0, h1 = (x1 * myrstd) * a1 + b1;
            u32x4 hi; hi.x = pack2(h0[0], h0[1]); hi.y = pack2(h0[2], h0[3]); hi.z = pack2(h1[0], h1[1]); hi.w = pack2(h1[2], h1[3]);
            *(u32x4*)(dr + ks * 32) = hi;
            u32x4 lo; lo.x = pack2(h0[0] - lo2f(hi.x), h0[1] - hi2f(hi.x)); lo.y = pack2(h0[2] - lo2f(hi.y), h0[3] - hi2f(hi.y));
            lo.z = pack2(h1[0] - lo2f(hi.z), h1[1] - hi2f(hi.z)); lo.w = pack2(h1[2] - lo2f(hi.w), h1[3] - hi2f(hi.w));
            const s16x8r ah = __builtin_bit_cast(s16x8r, hi), al = __builtin_bit_cast(s16x8r, lo);
#pragma unroll
            for (int nb = 0; nb < 3; ++nb) { const s16x8r bh = *(const s16x8r*)(Wh + (size_t)(nb * 16 + lr) * 1024 + c), bl = *(const s16x8r*)(Wl + (size_t)(nb * 16 + lr) * 1024 + c);
                acc[nb] = __builtin_amdgcn_mfma_f32_16x16x32_bf16(ah, bh, acc[nb], 0, 0, 0);
                acc[nb] = __builtin_amdgcn_mfma_f32_16x16x32_bf16(al, bh, acc[nb], 0, 0, 0);
                acc[nb] = __builtin_amdgcn_mfma_f32_16x16x32_bf16(ah, bl, acc[nb], 0, 0, 0); } }
#pragma unroll
        for (int nb = 0; nb < 3; ++nb)
#pragma unroll
            for (int rg = 0; rg < 4; ++rg) lg[(4 * kq + rg) * 48 + nb * 16 + lr] = acc[nb][rg];
        asm volatile("s_waitcnt lgkmcnt(0)" ::: "memory");
        __builtin_amdgcn_wave_barrier();
        if (F.lane < 16) {
            const LAS float* L = lg + F.lane * 48;
            float lgv[4];
#pragma unroll
            for (int i = 0; i < 4; ++i) lgv[i] = L[i] + rgb[i];
            int gi = 0; float best = lgv[0];
#pragma unroll
            for (int i = 1; i < 4; ++i) if (lgv[i] > best) { best = lgv[i]; gi = i; }
            float den = 0.f;
#pragma unroll
            for (int i = 0; i < 4; ++i) den += __expf(lgv[i] - best);
            const float pg = 1.f / den;
            float le[8];
#pragma unroll
            for (int i = 0; i < 8; ++i) le[i] = L[4 + gi * 8 + i] + reb[gi * 8 + i];
            int i1 = 0; float b1 = le[0];
#pragma unroll
            for (int i = 1; i < 8; ++i) if (le[i] > b1) { b1 = le[i]; i1 = i; }
            int i2 = -1; float b2 = -3.0e38f;
#pragma unroll
            for (int i = 0; i < 8; ++i) if (i != i1 && le[i] > b2) { b2 = le[i]; i2 = i; }
            const float e2 = __expf(b2 - b1);
            const float w1 = pg / (1.f + e2), w2 = pg * e2 / (1.f + e2);
            const int e0g = gi * 8 + i1, e1g = gi * 8 + i2; const int r = r0 + F.lane;
            tok_e[r] = e0g | (e1g << 8); tok_w[2 * r] = w1; tok_w[2 * r + 1] = w2;
            lds_inc(&hist[e0g]); lds_inc(&hist[32 + e1g]);
        }
        __builtin_amdgcn_wave_barrier();
    }
    __syncthreads();
    unsigned* cnt = (unsigned*)(F.ws + WS_CTRL + C_MOE + layer * 1024);
    if (F.tid < 64 && hist[F.tid]) atomicAdd(&cnt[F.tid], hist[F.tid]);
    __syncthreads();
}

__device__ __forceinline__ void ph_dispatch(const Frame& F, int layer, int ntok) {
    unsigned* cnt = (unsigned*)(F.ws + WS_CTRL + C_MOE + layer * 1024); unsigned* cursor = cnt + 64; unsigned* info = cnt + 128;
    LAS unsigned* base = (LAS unsigned*)F.lds; LAS unsigned* lh = base + 64; LAS unsigned* gb = base + 128; LAS unsigned* lh2 = base + 192; LAS unsigned* pad = base + 256;
    const int* tok_e = (const int*)(F.ws + WS_R2 + R2_TOKE); const float* tok_w = (const float*)(F.ws + WS_R2 + R2_TOKW);
    int* stok = (int*)(F.ws + WS_R2 + R2_STOK); float* sw = (float*)(F.ws + WS_R2 + R2_SW); int* tile_e = (int*)(F.ws + WS_R2 + R2_TILEE); int* tsl = (int*)(F.ws + WS_R2 + R2_TSLOT);
    if (F.tid < 64) { pad[F.tid] = (__hip_atomic_load(&cnt[F.tid], __ATOMIC_RELAXED, __HIP_MEMORY_SCOPE_AGENT) + 255u) & ~255u; lh[F.tid] = 0u; lh2[F.tid] = 0u; }
    __syncthreads();
    if (F.tid == 0) { unsigned a = 0; for (int i = 0; i < 64; ++i) { base[i] = a; a += pad[i]; } base[320] = a; }
    __syncthreads();
    if (F.bid == 0) {
        for (int i = F.tid; i < MAXTILES; i += NTH) { const unsigned s = (unsigned)i * 256u; int l = -1;
            for (int j = 0; j < 64; ++j) if (s >= base[j] && s < base[j] + pad[j]) l = j;
            tile_e[i] = l; }
        if (F.tid == 0) { info[0] = base[32] / 256u; info[1] = base[320] / 256u; }
    }
    const int per = (ntok + F.G - 1) / F.G, t0 = F.bid * per, t1 = min(ntok, t0 + per);
    for (int t = t0 + F.tid; t < t1; t += NTH) { const int e = tok_e[t]; lds_inc(&lh[e & 255]); lds_inc(&lh[32 + (e >> 8)]); }
    __syncthreads();
    if (F.tid < 64) gb[F.tid] = lh[F.tid] ? __hip_atomic_fetch_add(&cursor[F.tid], lh[F.tid], __ATOMIC_RELAXED, __HIP_MEMORY_SCOPE_AGENT) : 0u;
    __syncthreads();
    for (int t = t0 + F.tid; t < t1; t += NTH) { const int e = tok_e[t];
        const int l0 = e & 255, l1 = 32 + (e >> 8);
        const unsigned p0 = base[l0] + gb[l0] + lds_inc(&lh2[l0]), p1 = base[l1] + gb[l1] + lds_inc(&lh2[l1]);
        stok[p0] = t; sw[p0] = tok_w[2 * t]; stok[p1] = t; sw[p1] = tok_w[2 * t + 1]; tsl[2 * t] = (int)p0; tsl[2 * t + 1] = (int)p1; }
    __syncthreads();
}

template <class AF, class EP>
__device__ __forceinline__ void gemm_unit_naive(const Frame& F, int K, const AF& arow, const bf16_t* Bt, const EP& E, int pm, int pn) {
    LAS float* As = (LAS float*)F.lds;
    LAS float* Bs = As + 32 * 132;
    const int t = F.tid, ty = t >> 5, tx = t & 31;
    for (int half = 0; half < 2; ++half) {
        float acc[8][8];
#pragma unroll
        for (int i = 0; i < 8; ++i)
#pragma unroll
            for (int j = 0; j < 8; ++j) acc[i][j] = 0.f;
        const bf16_t* ap = arow(half * 128 + (t >> 2));
        const bf16_t* bp = Bt + (size_t)(t >> 1) * K;
        for (int k0 = 0; k0 < K; k0 += 32) {
            { const int r = t >> 2, kq = (t & 3) * 8; u32x4 w = {0u, 0u, 0u, 0u}; if (ap) w = *(const u32x4*)(ap + k0 + kq);
              As[(kq + 0) * 132 + r] = lo2f(w.x); As[(kq + 1) * 132 + r] = hi2f(w.x); As[(kq + 2) * 132 + r] = lo2f(w.y); As[(kq + 3) * 132 + r] = hi2f(w.y);
              As[(kq + 4) * 132 + r] = lo2f(w.z); As[(kq + 5) * 132 + r] = hi2f(w.z); As[(kq + 6) * 132 + r] = lo2f(w.w); As[(kq + 7) * 132 + r] = hi2f(w.w); }
            { const int n = t >> 1, kh = (t & 1) * 16;
#pragma unroll
              for (int q = 0; q < 2; ++q) { const u32x4 w = *(const u32x4*)(bp + k0 + kh + q * 8); const int kk = kh + q * 8;
                Bs[(kk + 0) * 260 + n] = lo2f(w.x); Bs[(kk + 1) * 260 + n] = hi2f(w.x); Bs[(kk + 2) * 260 + n] = lo2f(w.y); Bs[(kk + 3) * 260 + n] = hi2f(w.y);
                Bs[(kk + 4) * 260 + n] = lo2f(w.z); Bs[(kk + 5) * 260 + n] = hi2f(w.z); Bs[(kk + 6) * 260 + n] = lo2f(w.w); Bs[(kk + 7) * 260 + n] = hi2f(w.w); } }
            __syncthreads();
#pragma unroll 4
            for (int k = 0; k < 32; ++k) {
                const f32x4 a0 = *(const LAS f32x4*)(As + k * 132 + ty * 8), a1 = *(const LAS f32x4*)(As + k * 132 + ty * 8 + 4);
                const f32x4 b0 = *(const LAS f32x4*)(Bs + k * 260 + tx * 4), b1 = *(const LAS f32x4*)(Bs + k * 260 + 128 + tx * 4);
#pragma unroll
                for (int i = 0; i < 8; ++i) { const float a = i < 4 ? a0[i & 3] : a1[i & 3];
#pragma unroll
                    for (int j = 0; j < 4; ++j) { acc[i][j] += a * b0[j]; acc[i][4 + j] += a * b1[j]; } }
            }
            __syncthreads();
        }
#pragma unroll
        for (int i = 0; i < 8; ++i) { const f32x4 v0 = {acc[i][0], acc[i][1], acc[i][2], acc[i][3]}, v1 = {acc[i][4], acc[i][5], acc[i][6], acc[i][7]};
            E(pm * 256 + half * 128 + ty * 8 + i, pn, tx * 4, v0, v1); }
    }
}
struct ARowDense { const bf16_t* A; int K; int pm; __device__ __forceinline__ const bf16_t* operator()(int r) const { return A + (size_t)(pm * 256 + r) * K; } };
struct ARowGather { const bf16_t* A; const int* stok; int pm; __device__ __forceinline__ const bf16_t* operator()(int r) const { const int t = stok[pm * 256 + r]; return t < 0 ? nullptr : A + (size_t)t * 1024; } };

template <class EP>
__device__ __forceinline__ void gemm_dense_naive(const Frame& F, const bf16_t* A, const bf16_t* Bt, int M, int N, int K, const EP& E) {
    const int nM = M / 256, nN = N / 256;
    for (int u = F.bid; u < nM * nN; u += F.G) { const int pm = u / nN, pn = u % nN;
        ARowDense ar{A, K, pm}; gemm_unit_naive(F, K, ar, Bt + (size_t)pn * 256 * K, E, pm, pn); }
}

namespace pg8 {
typedef short bf16x8 __attribute__((ext_vector_type(8)));
constexpr int BM = 256, BK = 64, HALF = 128, HTB = HALF * BK * 2, STAGE_BYTES = 8 * HTB, NXCD = 8, WGM = 8;
__device__ __forceinline__ int lds_byte(int r, int c) { const int st = (r >> 4) * 2 + (c >> 5), rr = r & 15, cc = c & 31, ob = rr * 64 + cc * 2; return st * 1024 + (ob ^ (((ob >> 9) & 1) << 5)); }
__device__ __forceinline__ int perm32(int rho) { const int n = rho >> 4, i = rho & 15; return 8 * (i >> 2) + 4 * n + (i & 3); }
__device__ __forceinline__ void stage_rc(int b, int& R, int& C) { const int st = b / 1024, sb = b % 1024, swz = sb ^ (((sb >> 9) & 1) << 5); R = (st >> 1) * 16 + swz / 64; C = (st & 1) * 32 + (swz % 64) / 2; }
struct Unit { int pm, pn; };
struct ProbDense {
    const char* A; const char* Bt; int K, nM, nN, nwg, G, c;
    __device__ __forceinline__ void init(const bf16_t* A_, const bf16_t* Bt_, int M, int N, int K_, int G_, int c_) { A = (const char*)A_; Bt = (const char*)Bt_; K = K_; nM = M / BM; nN = N / BM; nwg = nM * nN; G = G_; c = c_; }
    __device__ __forceinline__ bool next(int i, Unit& u) const {
        const long L = (long)i * G + c; if (L >= nwg) return false;
        int wgid = (int)L; { const int q = nwg / NXCD, r = nwg % NXCD, xcd = wgid % NXCD, off = wgid / NXCD; wgid = (xcd < r ? xcd * (q + 1) : r * (q + 1) + (xcd - r) * q) + off; }
        const int nig = WGM * nN, gid = wgid / nig, fm = gid * WGM, gsz = (nM - fm) < WGM ? (nM - fm) : WGM;
        u.pm = fm + ((wgid % nig) % gsz); u.pn = (wgid % nig) / gsz; return true;
    }
    __device__ __forceinline__ const char* bptr(const Unit& u) const { return Bt + (size_t)u.pn * 256 * K * 2; }
    __device__ __forceinline__ unsigned aoff(const Unit& u, int r) const { return (unsigned)(u.pm * 256 + r) * (unsigned)(K * 2); }
};
struct ProbMoe1 {
    const char* A; const int* stok; const int* tile_e; const char* W; int K, ntiles, G, c;
    __device__ __forceinline__ bool next(int i, Unit& u) const { const int L = i * G + c; if (L >= ntiles * 4) return false; u.pm = L >> 2; u.pn = L & 3; return true; }
    __device__ __forceinline__ const char* bptr(const Unit& u) const { return W + ((size_t)(tile_e[u.pm] & 31) * 1024 + u.pn * 256) * 2048; }
    __device__ __forceinline__ unsigned aoff(const Unit& u, int r) const { const int t = stok[u.pm * 256 + r]; return t < 0 ? 0u : (unsigned)t * 2048u; }
};
struct ProbMoe2 {
    const char* A; const int* tile_e; const char* W; int K, tlo, thi, G, c;
    __device__ __forceinline__ bool next(int i, Unit& u) const { const int L = i * G + c; if (L >= (thi - tlo) * 4) return false; u.pm = tlo + (L >> 2); u.pn = L & 3; return true; }
    __device__ __forceinline__ const char* bptr(const Unit& u) const { return W + ((size_t)(tile_e[u.pm] & 31) * 1024 + u.pn * 256) * 1024; }
    __device__ __forceinline__ unsigned aoff(const Unit& u, int r) const { return (unsigned)(u.pm * 256 + r) * 1024u; }
};

template <class Prob, class Epi>
__device__ __forceinline__ void gemm_phase(LAS unsigned char* lds, const Prob& S, const Epi& E) {
    const int tid = threadIdx.x, wid = __builtin_amdgcn_readfirstlane(tid >> 6), lane = tid & 63, wr = wid >> 2, wc = wid & 3, fr = lane & 15, fq = lane >> 4;
    const int K = S.K, nt = K / BK;
    int RA[2]; unsigned cb2[2], voffB[2];
#pragma unroll
    for (int i = 0; i < 2; ++i) { int R, C; stage_rc(tid * 16 + i * 8192, R, C); RA[i] = R; cb2[i] = (unsigned)C * 2u; const int Rb = Epi::PERM ? ((R & ~31) + perm32(R & 31)) : R; voffB[i] = (unsigned)(Rb * K + C) * 2u; }
    const size_t kstep = (size_t)(BK * 2);
    const size_t hstepB = (size_t)HALF * K * 2;
    const unsigned ldsw = (unsigned)wid * 1024u;
    const int aoff = lds_byte(wr * 64 + fr, fq * 8), boff = lds_byte(wc * 32 + fr, fq * 8);
#define PG8_SA(b, h) (((b) * 2 + (h)) * HTB)
#define PG8_SB(b, h) ((4 + (b) * 2 + (h)) * HTB)
#define PG8_STAGE(bufoff, gbase, voff) do { _Pragma("unroll") for (int _i = 0; _i < 2; ++_i) \
        __builtin_amdgcn_global_load_lds((const unsigned*)((const char*)(gbase) + (voff)[_i]), (LAS unsigned*)(lds + (bufoff) + ldsw + _i * 8192), 16, 0, 0); } while (0)
#define PG8_LDA(dst, b, h) do { _Pragma("unroll") for (int m = 0; m < 4; ++m) _Pragma("unroll") for (int k = 0; k < 2; ++k) dst[m][k] = *(const LAS bf16x8*)(lds + PG8_SA(b, h) + aoff + m * 2048 + k * 1024); } while (0)
#define PG8_LDB(dst, b, h) do { _Pragma("unroll") for (int n = 0; n < 2; ++n) _Pragma("unroll") for (int k = 0; k < 2; ++k) dst[n][k] = *(const LAS bf16x8*)(lds + PG8_SB(b, h) + boff + n * 2048 + k * 1024); } while (0)
#define PG8_MMA(ai, bj, At, Bt) do { __builtin_amdgcn_s_setprio(1); _Pragma("unroll") for (int m = 0; m < 4; ++m) _Pragma("unroll") for (int n = 0; n < 2; ++n) _Pragma("unroll") for (int k = 0; k < 2; ++k) \
        acc[ai][bj][m][n] = __builtin_amdgcn_mfma_f32_16x16x32_bf16(Bt[n][k], At[m][k], acc[ai][bj][m][n], 0, 0, 0); __builtin_amdgcn_s_setprio(0); } while (0)
#define PG8_WAIT_V(n) asm volatile("s_waitcnt vmcnt(" #n ")" ::: "memory")
#define PG8_WAIT_L(n) asm volatile("s_waitcnt lgkmcnt(" #n ")" ::: "memory")
#define PG8_BAR __builtin_amdgcn_s_barrier()
#define PG8_SCHED __builtin_amdgcn_sched_barrier(0)
    Unit cur, nxt; int ui = 0;
    if (!S.next(0, cur)) return;
    f32x4 acc[2][2][4][2];
#pragma unroll
    for (int a = 0; a < 2; ++a)
#pragma unroll
        for (int b = 0; b < 2; ++b)
#pragma unroll
            for (int m = 0; m < 4; ++m)
#pragma unroll
                for (int n = 0; n < 2; ++n) acc[a][b][m][n] = (f32x4){0.f, 0.f, 0.f, 0.f};
    bf16x8 At[4][2], B0[2][2], B1[2][2];
    unsigned oc0[2], oc1[2], on0[2], on1[2];
#pragma unroll
    for (int i = 0; i < 2; ++i) { oc0[i] = S.aoff(cur, RA[i]) + cb2[i]; oc1[i] = S.aoff(cur, 128 + RA[i]) + cb2[i]; }
    const char* cB = S.bptr(cur);
    const char* const Ab = S.A;
    PG8_STAGE(PG8_SB(0, 0), cB, voffB); PG8_STAGE(PG8_SA(0, 0), Ab, oc0); PG8_STAGE(PG8_SB(0, 1), cB + hstepB, voffB); PG8_STAGE(PG8_SA(0, 1), Ab, oc1);
    if (wr == 1) PG8_BAR;
    PG8_WAIT_V(4); PG8_BAR;
    PG8_STAGE(PG8_SB(1, 0), cB + kstep, voffB); PG8_STAGE(PG8_SA(1, 0), Ab + kstep, oc0); PG8_STAGE(PG8_SB(1, 1), cB + hstepB + kstep, voffB);
    PG8_WAIT_V(6); PG8_BAR;
    for (;;) {
        const bool has_next = S.next(ui + 1, nxt);
        const char* nB = has_next ? S.bptr(nxt) : cB;
#pragma unroll
        for (int i = 0; i < 2; ++i) { on0[i] = has_next ? S.aoff(nxt, RA[i]) + cb2[i] : oc0[i]; on1[i] = has_next ? S.aoff(nxt, 128 + RA[i]) + cb2[i] : oc1[i]; }
        for (int t = 0; t < nt; t += 2) {
            const bool last = (t == nt - 2);
            const char* a1 = Ab + (size_t)(t + 1) * kstep;
            const char* a2 = last ? Ab : Ab + (size_t)(t + 2) * kstep; const char* b2 = last ? nB : cB + (size_t)(t + 2) * kstep;
            const char* a3 = a2 + kstep; const char* b3 = b2 + kstep;
            unsigned o20[2], o21[2];
#pragma unroll
            for (int i = 0; i < 2; ++i) { o20[i] = last ? on0[i] : oc0[i]; o21[i] = last ? on1[i] : oc1[i]; }
            PG8_LDB(B0, 0, 0); PG8_SCHED; PG8_LDA(At, 0, 0); PG8_STAGE(PG8_SA(1, 1), a1, oc1);
            PG8_WAIT_L(8); PG8_BAR; PG8_WAIT_L(0); PG8_MMA(0, 0, At, B0); PG8_BAR; PG8_SCHED;
            PG8_LDB(B1, 0, 1); PG8_STAGE(PG8_SB(0, 0), b2, voffB);
            PG8_BAR; PG8_WAIT_L(0); PG8_MMA(0, 1, At, B1); PG8_BAR;
            PG8_LDA(At, 0, 1); PG8_STAGE(PG8_SA(0, 0), a2, o20);
            PG8_BAR; PG8_WAIT_L(0); PG8_MMA(1, 0, At, B0); PG8_BAR; PG8_SCHED;
            PG8_STAGE(PG8_SB(0, 1), b2 + hstepB, voffB);
            PG8_WAIT_V(6); PG8_BAR; PG8_MMA(1, 1, At, B1); PG8_BAR;
            PG8_LDB(B0, 1, 0); PG8_SCHED; PG8_LDA(At, 1, 0); PG8_STAGE(PG8_SA(0, 1), a2, o21);
            PG8_WAIT_L(8); PG8_BAR; PG8_WAIT_L(0); PG8_MMA(0, 0, At, B0); PG8_BAR; PG8_SCHED;
            PG8_LDB(B1, 1, 1); PG8_STAGE(PG8_SB(1, 0), b3, voffB);
            PG8_BAR; PG8_WAIT_L(0); PG8_MMA(0, 1, At, B1); PG8_BAR;
            PG8_LDA(At, 1, 1); PG8_STAGE(PG8_SA(1, 0), a3, o20);
            PG8_BAR; PG8_WAIT_L(0); PG8_MMA(1, 0, At, B0); PG8_BAR; PG8_SCHED;
            PG8_STAGE(PG8_SB(1, 1), b3 + hstepB, voffB);
            PG8_WAIT_V(6); PG8_BAR; PG8_MMA(1, 1, At, B1); PG8_BAR;
        }
#pragma unroll
        for (int ai = 0; ai < 2; ++ai)
#pragma unroll
            for (int m = 0; m < 4; ++m)
                { if constexpr (Epi::PERM) E.e8(cur.pm * BM + ai * HALF + wr * 64 + m * 16 + fr, cur.pn, wc * 32 + fq * 8, acc[ai][0][m][0], acc[ai][0][m][1], acc[ai][1][m][0], acc[ai][1][m][1]);
                  else { _Pragma("unroll") for (int n = 0; n < 2; ++n) E(cur.pm * BM + ai * HALF + wr * 64 + m * 16 + fr, cur.pn, wc * 32 + n * 16 + fq * 4, acc[ai][0][m][n], acc[ai][1][m][n]); } }
        if (!has_next) break;
#pragma unroll
        for (int a = 0; a < 2; ++a)
#pragma unroll
            for (int b = 0; b < 2; ++b)
#pragma unroll
                for (int m = 0; m < 4; ++m)
#pragma unroll
                    for (int n = 0; n < 2; ++n) acc[a][b][m][n] = (f32x4){0.f, 0.f, 0.f, 0.f};
        cur = nxt; cB = nB; ++ui;
#pragma unroll
        for (int i = 0; i < 2; ++i) { oc0[i] = on0[i]; oc1[i] = on1[i]; }
    }
    PG8_WAIT_V(0);
    if (wr == 0) PG8_BAR;
    PG8_BAR;
#undef PG8_SA
#undef PG8_SB
#undef PG8_STAGE
#undef PG8_LDA
#undef PG8_LDB
#undef PG8_MMA
#undef PG8_WAIT_V
#undef PG8_WAIT_L
#undef PG8_BAR
#undef PG8_SCHED
}
}

struct EpiStoreBf16 { static constexpr bool PERM = false; bf16_t* O; int ldc; int gelu_below;
    __device__ __forceinline__ void operator()(int row, int pn, int cx, f32x4 v0, f32x4 v1) const {
        const int c0 = pn * 256 + cx, c1 = c0 + 128;
        if (c0 < gelu_below) { v0[0] = gelu_tanh_f(v0[0]); v0[1] = gelu_tanh_f(v0[1]); v0[2] = gelu_tanh_f(v0[2]); v0[3] = gelu_tanh_f(v0[3]); }
        if (c1 < gelu_below) { v1[0] = gelu_tanh_f(v1[0]); v1[1] = gelu_tanh_f(v1[1]); v1[2] = gelu_tanh_f(v1[2]); v1[3] = gelu_tanh_f(v1[3]); }
        u32x2 a; a.x = pack2(v0[0], v0[1]); a.y = pack2(v0[2], v0[3]); u32x2 b; b.x = pack2(v1[0], v1[1]); b.y = pack2(v1[2], v1[3]);
        *(u32x2*)(O + (size_t)row * ldc + c0) = a; *(u32x2*)(O + (size_t)row * ldc + c1) = b; } };
struct EpiStoreBf16P { static constexpr bool PERM = true; bf16_t* O; int ldc; int gelu_below;
    __device__ __forceinline__ void e8(int row, int pn, int cx, f32x4 a0, f32x4 a1, f32x4 b0, f32x4 b1) const {
        const int c0 = pn * 256 + cx, c1 = c0 + 128;
        if (c0 < gelu_below) {
#pragma unroll
            for (int i = 0; i < 4; ++i) { a0[i] = gelu_tanh_f(a0[i]); a1[i] = gelu_tanh_f(a1[i]); } }
        if (c1 < gelu_below) {
#pragma unroll
            for (int i = 0; i < 4; ++i) { b0[i] = gelu_tanh_f(b0[i]); b1[i] = gelu_tanh_f(b1[i]); } }
        u32x4 x; x.x = pack2(a0[0], a0[1]); x.y = pack2(a0[2], a0[3]); x.z = pack2(a1[0], a1[1]); x.w = pack2(a1[2], a1[3]);
        u32x4 y; y.x = pack2(b0[0], b0[1]); y.y = pack2(b0[2], b0[3]); y.z = pack2(b1[0], b1[1]); y.w = pack2(b1[2], b1[3]);
        *(u32x4*)(O + (size_t)row * ldc + c0) = x; *(u32x4*)(O + (size_t)row * ldc + c1) = y; } };
struct EpiMoe1P { static constexpr bool PERM = true; bf16_t* H;
    __device__ __forceinline__ void e8(int row, int pn, int cx, f32x4 a0, f32x4 a1, f32x4 b0, f32x4 b1) const {
        u32x4 x; x.x = pack2(silu_f(a0[0]) * b0[0], silu_f(a0[1]) * b0[1]); x.y = pack2(silu_f(a0[2]) * b0[2], silu_f(a0[3]) * b0[3]);
        x.z = pack2(silu_f(a1[0]) * b1[0], silu_f(a1[1]) * b1[1]); x.w = pack2(silu_f(a1[2]) * b1[2], silu_f(a1[3]) * b1[3]);
        *(u32x4*)(H + (size_t)row * 512 + pn * 128 + cx) = x; } };
struct EpiMoe2YP { static constexpr bool PERM = true; const float* sw; bf16_t* Y;
    __device__ __forceinline__ void e8(int row, int pn, int cx, f32x4 a0, f32x4 a1, f32x4 b0, f32x4 b1) const {
        const float w = sw[row];
        u32x4 x; x.x = pack2(a0[0] * w, a0[1] * w); x.y = pack2(a0[2] * w, a0[3] * w); x.z = pack2(a1[0] * w, a1[1] * w); x.w = pack2(a1[2] * w, a1[3] * w);
        u32x4 y; y.x = pack2(b0[0] * w, b0[1] * w); y.y = pack2(b0[2] * w, b0[3] * w); y.z = pack2(b1[0] * w, b1[1] * w); y.w = pack2(b1[2] * w, b1[3] * w);
        bf16_t* d = Y + (size_t)row * 1024 + pn * 256 + cx; *(u32x4*)d = x; *(u32x4*)(d + 128) = y; } };
struct EpiResidual { static constexpr bool PERM = false; const float* srcl; const float* srcc; float* dstl; float* dstc; const float* mod;   int which; float* rss;
    __device__ __forceinline__ void operator()(int row, int pn, int cx, f32x4 v0, f32x4 v1) const {
        const int b = row < TL ? (row >> 13) : 8; const float* g = mod + ((size_t)b * 6 + which) * 1024;
        const float* s = row < TL ? srcl + (size_t)row * 1024 : srcc + (size_t)(row - TL) * 1024;
        float* d = row < TL ? dstl + (size_t)row * 1024 : dstc + (size_t)(row - TL) * 1024;
        const int c0 = pn * 256 + cx, c1 = c0 + 128;
        const f32x4 y0 = *(const f32x4*)(s + c0) + *(const f32x4*)(g + c0) * v0, y1 = *(const f32x4*)(s + c1) + *(const f32x4*)(g + c1) * v1;
        *(f32x4*)(d + c0) = y0; *(f32x4*)(d + c1) = y1;
        float ss = y0[0] * y0[0] + y0[1] * y0[1] + y0[2] * y0[2] + y0[3] * y0[3] + y1[0] * y1[0] + y1[1] * y1[1] + y1[2] * y1[2] + y1[3] * y1[3];
        { auto t1 = __builtin_amdgcn_permlane16_swap(__float_as_uint(ss), __float_as_uint(ss), false, false); ss = __uint_as_float(t1[0]) + __uint_as_float(t1[1]);
          auto t2 = __builtin_amdgcn_permlane32_swap(__float_as_uint(ss), __float_as_uint(ss), false, false); ss = __uint_as_float(t2[0]) + __uint_as_float(t2[1]); }
        if (((cx >> 2) & 3) == 0) rss[(size_t)row * 32 + pn * 8 + (cx >> 5) * 2 + ((cx >> 4) & 1)] = ss; } };
struct EpiMoe1 { static constexpr bool PERM = false; bf16_t* H;
    __device__ __forceinline__ void operator()(int row, int pn, int cx, f32x4 v0, f32x4 v1) const {
        u32x2 a; a.x = pack2(silu_f(v0[0]) * v1[0], silu_f(v0[1]) * v1[1]); a.y = pack2(silu_f(v0[2]) * v1[2], silu_f(v0[3]) * v1[3]);
        *(u32x2*)(H + (size_t)row * 512 + pn * 128 + cx) = a; } };
struct EpiMoe2 { static constexpr bool PERM = false; const int* stok; const float* sw; float* dstl; float* dstc; const float* mod;
    __device__ __forceinline__ void operator()(int row, int pn, int cx, f32x4 v0, f32x4 v1) const {
        const int t = stok[row]; if (t < 0) return; const float w = sw[row];
        const int b = t < TL ? (t >> 13) : 8; const float* g = mod + ((size_t)b * 6 + 5) * 1024;
        float* d = t < TL ? dstl + (size_t)t * 1024 : dstc + (size_t)(t - TL) * 1024;
        const int c0 = pn * 256 + cx, c1 = c0 + 128;
        *(f32x4*)(d + c0) = *(const f32x4*)(d + c0) + *(const f32x4*)(g + c0) * v0 * w;
        *(f32x4*)(d + c1) = *(const f32x4*)(d + c1) + *(const f32x4*)(g + c1) * v1 * w; } };

#ifndef FAST_GEMM
#define FAST_GEMM 1
#endif
template <class EP>
__device__ __forceinline__ void gemm_dense(const Frame& F, const bf16_t* A, const bf16_t* Bt, int M, int N, int K, const EP& E) {
#if FAST_GEMM
    pg8::ProbDense S; S.init(A, Bt, M, N, K, F.G, F.bid); pg8::gemm_phase(F.lds, S, E);
#else
    gemm_dense_naive(F, A, Bt, M, N, K, E);
#endif
}
struct EpiMoe2Y { static constexpr bool PERM = false; const int* stok; const float* sw; bf16_t* Y;
    __device__ __forceinline__ void operator()(int row, int pn, int cx, f32x4 v0, f32x4 v1) const {
        const int t = stok[row]; if (t < 0) return; const float w = sw[row];
        u32x2 a; a.x = pack2(v0[0] * w, v0[1] * w); a.y = pack2(v0[2] * w, v0[3] * w); u32x2 b; b.x = pack2(v1[0] * w, v1[1] * w); b.y = pack2(v1[2] * w, v1[3] * w);
        bf16_t* d = Y + (size_t)row * 1024 + pn * 256 + cx; *(u32x2*)d = a; *(u32x2*)(d + 128) = b; } };
__device__ __forceinline__ void ph_moe_gemm2y(const Frame& F, int layer) {
    const unsigned* info = (const unsigned*)(F.ws + WS_CTRL + C_MOE + layer * 1024) + 128;
    const int nall = (int)__hip_atomic_load(&info[1], __ATOMIC_RELAXED, __HIP_MEMORY_SCOPE_AGENT);
    const int* tile_e = (const int*)(F.ws + WS_R2 + R2_TILEE);
    const bf16_t* W2 = (const bf16_t*)(F.ws + WS_WMOE) + (size_t)32 * 1024 * 1024;
    EpiMoe2YP E{(const float*)(F.ws + WS_R2 + R2_SW), (bf16_t*)(F.ws + WS_PX)};
    pg8::ProbMoe2 S{(const char*)(F.ws + WS_R2 + R2_H), tile_e, (const char*)W2, 512, 0, nall, F.G, F.bid};
    pg8::gemm_phase(F.lds, S, E);
}
template <bool NORM>
__device__ __forceinline__ void ph_moe_combine(const Frame& F, int layer, int nrows, int nl, const float* nw) {
    const bf16_t* Y = (const bf16_t*)(F.ws + WS_PX); const int* tsl = (const int*)(F.ws + WS_R2 + R2_TSLOT);
    float* outl = F.P->out; float* outc = (float*)(F.ws + WS_XC); bf16_t* dst = (bf16_t*)(F.ws + WS_ACT);
    for (int r = F.bid * 8 + F.wave; r < nrows; r += F.G * 8) {
        float* xr = r < TL ? outl + (size_t)r * 1024 : outc + (size_t)(r - TL) * 1024;
        const int b = r < TL ? (r >> 13) : 8;
        const float* g5 = modp(F, layer, b, 5);
        const int s0 = tsl[2 * r], s1 = tsl[2 * r + 1];
        const bf16_t* y0 = Y + (size_t)s0 * 1024; const bf16_t* y1 = Y + (size_t)s1 * 1024;
        f32x4 v[4]; float ss = 0.f;
#pragma unroll
        for (int j = 0; j < 4; ++j) { const int c = j * 256 + F.lane * 4;
            const f32x4 x = *(const f32x4*)(xr + c), g = *(const f32x4*)(g5 + c); const u32x2 a = *(const u32x2*)(y0 + c), bb = *(const u32x2*)(y1 + c);
            f32x4 y; y[0] = lo2f(a.x) + lo2f(bb.x); y[1] = hi2f(a.x) + hi2f(bb.x); y[2] = lo2f(a.y) + lo2f(bb.y); y[3] = hi2f(a.y) + hi2f(bb.y);
            v[j] = x + g * y; *(f32x4*)(xr + c) = v[j];
            ss += v[j][0] * v[j][0] + v[j][1] * v[j][1] + v[j][2] * v[j][2] + v[j][3] * v[j][3]; }
        if (NORM) {
            const float* sh = modp(F, nl, b, 0); const float* sc = modp(F, nl, b, 1);
            ss = wave_sum(ss);
            const float rstd = rsqrtf(ss * (1.f / 1024.f) + EPS);
#pragma unroll
            for (int j = 0; j < 4; ++j) { const int c = j * 256 + F.lane * 4;
                const f32x4 w = *(const f32x4*)(nw + c), s1v = *(const f32x4*)(sc + c), s0v = *(const f32x4*)(sh + c);
                const f32x4 hq = (v[j] * rstd * w) * (1.f + s1v) + s0v;
                u32x2 o; o.x = pack2(hq[0], hq[1]); o.y = pack2(hq[2], hq[3]);
                *(u32x2*)(dst + (size_t)r * 1024 + c) = o; }
        }
    }
}
__device__ __forceinline__ void ph_moe_gemm1(const Frame& F, int layer) {
    const unsigned* info = (const unsigned*)(F.ws + WS_CTRL + C_MOE + layer * 1024) + 128;
    const int ntiles = (int)__hip_atomic_load(&info[1], __ATOMIC_RELAXED, __HIP_MEMORY_SCOPE_AGENT);
    const int* tile_e = (const int*)(F.ws + WS_R2 + R2_TILEE); const int* stok = (const int*)(F.ws + WS_R2 + R2_STOK);
    const bf16_t* W1 = (const bf16_t*)(F.ws + WS_WMOE);
    EpiMoe1P E{(bf16_t*)(F.ws + WS_R2 + R2_H)};
#if FAST_GEMM
    pg8::ProbMoe1 S{(const char*)(F.ws + WS_ACT), stok, tile_e, (const char*)W1, 1024, ntiles, F.G, F.bid};
    pg8::gemm_phase(F.lds, S, E);
#else
    for (int u = F.bid; u < ntiles * 4; u += F.G) { const int pm = u >> 2, pn = u & 3; const int e = tile_e[pm] & 31;
        ARowGather ar{(const bf16_t*)(F.ws + WS_ACT), stok, pm};
        gemm_unit_naive(F, 1024, ar, W1 + ((size_t)e * 1024 + pn * 256) * 1024, E, pm, pn); }
#endif
}
__device__ __forceinline__ void ph_moe_gemm2(const Frame& F, int layer, int k) {
    const unsigned* info = (const unsigned*)(F.ws + WS_CTRL + C_MOE + layer * 1024) + 128;
    const int nk0 = (int)__hip_atomic_load(&info[0], __ATOMIC_RELAXED, __HIP_MEMORY_SCOPE_AGENT), nall = (int)__hip_atomic_load(&info[1], __ATOMIC_RELAXED, __HIP_MEMORY_SCOPE_AGENT);
    const int tlo = k == 0 ? 0 : nk0, thi = k == 0 ? nk0 : nall;
    const int* tile_e = (const int*)(F.ws + WS_R2 + R2_TILEE);
    const bf16_t* W2 = (const bf16_t*)(F.ws + WS_WMOE) + (size_t)32 * 1024 * 1024;
    EpiMoe2 E{(const int*)(F.ws + WS_R2 + R2_STOK), (const float*)(F.ws + WS_R2 + R2_SW), F.P->out, (float*)(F.ws + WS_XC), F.mod + (size_t)layer * 9 * 6144};
#if FAST_GEMM
    pg8::ProbMoe2 S{(const char*)(F.ws + WS_R2 + R2_H), tile_e, (const char*)W2, 512, tlo, thi, F.G, F.bid};
    pg8::gemm_phase(F.lds, S, E);
#else
    for (int u = F.bid; u < (thi - tlo) * 4; u += F.G) { const int pm = tlo + (u >> 2), pn = u & 3; const int e = tile_e[pm] & 31;
        ARowDense ar{(const bf16_t*)(F.ws + WS_R2 + R2_H), 512, pm};
        gemm_unit_naive(F, 512, ar, W2 + ((size_t)e * 1024 + pn * 256) * 512, E, pm, pn); }
#endif
}

__device__ __forceinline__ void ph_gmlp(const Frame& F) {
    const Params& P = *F.P;
    const bf16_t* PX = (const bf16_t*)(F.ws + WS_PX); bf16_t* CAT = (bf16_t*)(F.ws + WS_ACT);
    LAS float* Vs = (LAS float*)F.lds;
    LAS float* Wm = Vs + 128 * 128;
    LAS float* rs = Wm + 128 * 129;
    for (int it = F.bid; it < 528 * 4; it += F.G) {
        const int ch = it >> 2, g = it & 3, row0 = ch * 128;
        for (int q = F.wave; q < 128; q += 8) { const bf16_t* p = PX + (size_t)(row0 + q) * EVEN_IN + 512 + F.lane * 8;
            const u32x4 w = *(const u32x4*)p; float s = 0.f, x;
            x = lo2f(w.x); s += x * x; x = hi2f(w.x); s += x * x; x = lo2f(w.y); s += x * x; x = hi2f(w.y); s += x * x;
            x = lo2f(w.z); s += x * x; x = hi2f(w.z); s += x * x; x = lo2f(w.w); s += x * x; x = hi2f(w.w); s += x * x;
            s = wave_sum(s); if (F.lane == 0) rs[q] = rsqrtf(s * (1.f / 512.f) + EPS); }
        __syncthreads();
        for (int i = F.tid; i < 128 * 128; i += NTH) { const int q = i >> 7, c = i & 127;
            Vs[i] = bf2f(PX[(size_t)(row0 + q) * EVEN_IN + 512 + g * 128 + c]) * rs[q] * P.in[I_GNW][g * 128 + c];
            Wm[q * 129 + c] = P.in[I_GWS][(size_t)g * 16384 + i]; }
        __syncthreads();
        const int ty = F.tid >> 5, tx = F.tid & 31;
        float acc[8][4];
#pragma unroll
        for (int i = 0; i < 8; ++i)
#pragma unroll
            for (int j = 0; j < 4; ++j) acc[i][j] = 0.f;
        for (int q = 0; q < 128; ++q) { const f32x4 v = *(const LAS f32x4*)(Vs + q * 128 + tx * 4);
#pragma unroll
            for (int i = 0; i < 8; ++i) { const float w = Wm[(ty * 8 + i) * 129 + q];
#pragma unroll
                for (int j = 0; j < 4; ++j) acc[i][j] += w * v[j]; } }
#pragma unroll
        for (int i = 0; i < 8; ++i) { const int p = ty * 8 + i; const float bias = P.in[I_GBS][g * 128 + p];
            const size_t t = (size_t)(row0 + p); const int col = g * 128 + tx * 4;
            const u32x2 uu = *(const u32x2*)(PX + t * EVEN_IN + col);
            u32x2 o; o.x = pack2(lo2f(uu.x) * (acc[i][0] + bias), hi2f(uu.x) * (acc[i][1] + bias)); o.y = pack2(lo2f(uu.y) * (acc[i][2] + bias), hi2f(uu.y) * (acc[i][3] + bias));
            *(u32x2*)(CAT + t * 1024 + col) = o; }
        __syncthreads();
    }
}

__device__ __forceinline__ void ph_gmlp_mfma(const Frame& F) {
    const Params& P = *F.P;
    const bf16_t* PX = (const bf16_t*)(F.ws + WS_PX); bf16_t* CAT = (bf16_t*)(F.ws + WS_ACT);
    LAS unsigned char* VT = F.lds;
    LAS unsigned char* WB = F.lds + 34816;
    LAS float* rs = (LAS float*)(F.lds + 69632);
    const int l31 = F.lane & 31, hh = F.lane >> 5;
    for (int it = F.bid; it < 528 * 4; it += F.G) {
        const int ch = it >> 2, g = it & 3, row0 = ch * 128;
        for (int q = F.wave; q < 128; q += 8) { const bf16_t* p = PX + (size_t)(row0 + q) * EVEN_IN + 512 + F.lane * 8;
            const u32x4 w = *(const u32x4*)p; float s = 0.f, x;
            x = lo2f(w.x); s += x * x; x = hi2f(w.x); s += x * x; x = lo2f(w.y); s += x * x; x = hi2f(w.y); s += x * x;
            x = lo2f(w.z); s += x * x; x = hi2f(w.z); s += x * x; x = lo2f(w.w); s += x * x; x = hi2f(w.w); s += x * x;
            s = wave_sum(s); if (F.lane == 0) rs[q] = rsqrtf(s * (1.f / 512.f) + EPS); }
#pragma unroll
        for (int k = 0; k < 4; ++k) { const int c = F.tid + 512 * k, p = c >> 4, part = c & 15;
            const float* src = P.in[I_GWS] + (size_t)g * 16384 + p * 128 + part * 8; const f32x4 a = *(const f32x4*)src, b = *(const f32x4*)(src + 4);
            u32x4 w; w.x = pack2(a[0], a[1]); w.y = pack2(a[2], a[3]); w.z = pack2(b[0], b[1]); w.w = pack2(b[2], b[3]);
            *(LAS u32x4*)(WB + p * 272 + part * 16) = w; }
        __syncthreads();
#pragma unroll
        for (int k = 0; k < 4; ++k) { const int c = F.tid + 512 * k, q = c >> 4, c0 = (c & 15) * 8;
            const u32x4 w = *(const u32x4*)(PX + (size_t)(row0 + q) * EVEN_IN + 512 + g * 128 + c0); const float r = rs[q];
            const float* nw = P.in[I_GNW] + g * 128 + c0; const f32x4 n0 = *(const f32x4*)nw, n1 = *(const f32x4*)(nw + 4);
            LAS unsigned short* d = (LAS unsigned short*)(VT + c0 * 272 + q * 2);
            d[0 * 136] = f2bf(lo2f(w.x) * r * n0[0]); d[1 * 136] = f2bf(hi2f(w.x) * r * n0[1]); d[2 * 136] = f2bf(lo2f(w.y) * r * n0[2]); d[3 * 136] = f2bf(hi2f(w.y) * r * n0[3]);
            d[4 * 136] = f2bf(lo2f(w.z) * r * n1[0]); d[5 * 136] = f2bf(hi2f(w.z) * r * n1[1]); d[6 * 136] = f2bf(lo2f(w.w) * r * n1[2]); d[7 * 136] = f2bf(hi2f(w.w) * r * n1[3]); }
        __syncthreads();
        const int pb = F.wave >> 1, cb0 = (F.wave & 1) * 2;
        f32x16 a0, a1;
#pragma unroll
        for (int r = 0; r < 16; ++r) { a0[r] = 0.f; a1[r] = 0.f; }
#pragma unroll
        for (int ks = 0; ks < 8; ++ks) { const s16x8 wa = *(const LAS s16x8*)(WB + (32 * pb + l31) * 272 + ks * 32 + hh * 16);
            a0 = __builtin_amdgcn_mfma_f32_32x32x16_bf16(wa, *(const LAS s16x8*)(VT + (32 * cb0 + l31) * 272 + ks * 32 + hh * 16), a0, 0, 0, 0);
            a1 = __builtin_amdgcn_mfma_f32_32x32x16_bf16(wa, *(const LAS s16x8*)(VT + (32 * (cb0 + 1) + l31) * 272 + ks * 32 + hh * 16), a1, 0, 0, 0); }
#pragma unroll
        for (int r = 0; r < 16; ++r) { const int p = 32 * pb + (r & 3) + 8 * (r >> 2) + 4 * hh; const float bias = P.in[I_GBS][g * 128 + p];
            const size_t t = (size_t)(row0 + p); const int c0 = g * 128 + 32 * cb0 + l31, c1 = c0 + 32;
            CAT[t * 1024 + c0] = f2bf(bf2f(PX[t * EVEN_IN + c0]) * (a0[r] + bias));
            CAT[t * 1024 + c1] = f2bf(bf2f(PX[t * EVEN_IN + c1]) * (a1[r] + bias)); }
        __syncthreads();
    }
}

__device__ __forceinline__ void ph_gla(const Frame& F) {
    const Params& P = *F.P;
    const bf16_t* PX = (const bf16_t*)(F.ws + WS_PX);
    LAS float* qs = (LAS float*)F.lds;
    LAS float* fs = qs + 8192;
    LAS float* vs = fs + 8192;
    LAS float* os = vs + 2048;
    const int dg = F.lane & 15, el = F.wave * 4 + (F.lane >> 4);
    const int prow = F.tid >> 4, pd0 = (F.tid & 15) * 8;
    const int vrow = F.tid >> 2, ve0 = (F.tid & 3) * 8;
    for (int it = F.bid; it < 256; it += F.G) {
        const int b = it >> 5, h = (it >> 3) & 3, dir = (it >> 2) & 1, sl = it & 3;
        bf16_t* O = (bf16_t*)(F.ws + WS_R2 + (dir ? R2_OB0 : R2_OF0));
        float lb8[8];
#pragma unroll
        for (int i = 0; i < 8; ++i) { const int ch = h * 128 + pd0 + i; const float* lg = P.in[I_LB] + (size_t)dir * 3 * 512 + ch;
            const float a0 = lg[0], a1 = lg[512], a2 = lg[1024]; const float m = fmaxf(a0, fmaxf(a1, a2));
            const float e0 = __expf(a0 - m), e1 = __expf(a1 - m), e2 = __expf(a2 - m); lb8[i] = e0 / (e0 + e1 + e2); }
        float S[8];
#pragma unroll
        for (int i = 0; i < 8; ++i) S[i] = 0.f;
        u32x4 rq0, rq1, rf0, rf1, rv = {0u, 0u, 0u, 0u};
        auto rowof = [&](int nb, int s) -> size_t { const bool c = nb < 4; const int len = c ? CTXL : SEQ; const int tt = (c ? nb : nb - 4) * 64 + s; const int p = dir ? len - 1 - tt : tt;
            return (c ? (size_t)TL + b * CTXL : (size_t)b * SEQ) + p; };
        auto fetch = [&](int nb) { const bf16_t* r0 = PX + rowof(nb, prow) * EVEN_IN; const bf16_t* r1 = PX + rowof(nb, prow + 32) * EVEN_IN;
            rq0 = *(const u32x4*)(r0 + 1024 + h * 128 + pd0); rf0 = *(const u32x4*)(r0 + 2048 + dir * 512 + h * 128 + pd0);
            rq1 = *(const u32x4*)(r1 + 1024 + h * 128 + pd0); rf1 = *(const u32x4*)(r1 + 2048 + dir * 512 + h * 128 + pd0);
            if (F.tid < 256) rv = *(const u32x4*)(PX + rowof(nb, vrow) * EVEN_IN + 1536 + h * 128 + sl * 32 + ve0); };
        auto put = [&](int row, u32x4 q, u32x4 f) { LAS float* qd = qs + row * 128 + pd0; LAS float* fd = fs + row * 128 + pd0;
            const float q8[8] = {lo2f(q.x), hi2f(q.x), lo2f(q.y), hi2f(q.y), lo2f(q.z), hi2f(q.z), lo2f(q.w), hi2f(q.w)};
            const float f8[8] = {lo2f(f.x), hi2f(f.x), lo2f(f.y), hi2f(f.y), lo2f(f.z), hi2f(f.z), lo2f(f.w), hi2f(f.w)};
            f32x4 o0, o1, g0, g1;
#pragma unroll
            for (int i = 0; i < 4; ++i) { o0[i] = q8[i]; o1[i] = q8[4 + i]; g0[i] = lb8[i] + (1.f - lb8[i]) * sigmoid_f(f8[i]); g1[i] = lb8[4 + i] + (1.f - lb8[4 + i]) * sigmoid_f(f8[4 + i]); }
            *(LAS f32x4*)qd = o0; *(LAS f32x4*)(qd + 4) = o1; *(LAS f32x4*)fd = g0; *(LAS f32x4*)(fd + 4) = g1; };
        fetch(0);
        for (int nb = 0; nb < 132; ++nb) {
            __syncthreads();
            put(prow, rq0, rf0); put(prow + 32, rq1, rf1);
            if (F.tid < 256) { LAS float* vd = vs + vrow * 32 + ve0;
                *(LAS f32x4*)vd = (f32x4){lo2f(rv.x), hi2f(rv.x), lo2f(rv.y), hi2f(rv.y)}; *(LAS f32x4*)(vd + 4) = (f32x4){lo2f(rv.z), hi2f(rv.z), lo2f(rv.w), hi2f(rv.w)}; }
            __syncthreads();
            if (nb + 1 < 132) fetch(nb + 1);
#pragma unroll 4
            for (int st = 0; st < 64; ++st) {
                const f32x4 fa = *(const LAS f32x4*)(fs + st * 128 + dg * 8), fb = *(const LAS f32x4*)(fs + st * 128 + dg * 8 + 4);
                const f32x4 qa = *(const LAS f32x4*)(qs + st * 128 + dg * 8), qb = *(const LAS f32x4*)(qs + st * 128 + dg * 8 + 4);
                const float v = vs[st * 32 + el];
                float p0 = 0.f, p1 = 0.f;
#pragma unroll
                for (int i = 0; i < 4; ++i) { S[i] = fa[i] * (S[i] - v) + v; p0 += qa[i] * S[i]; S[4 + i] = fb[i] * (S[4 + i] - v) + v; p1 += qb[i] * S[4 + i]; }
                const float o = sum16(p0 + p1);
                if (dg == 0) os[st * 32 + el] = o;
            }
            __syncthreads();
#pragma unroll
            for (int k = 0; k < 2; ++k) { const int s = (F.tid >> 4) + 32 * k, e2 = (F.tid & 15) * 2;
              *(unsigned*)(O + rowof(nb, s) * 512 + h * 128 + sl * 32 + e2) = pack2(os[s * 32 + e2], os[s * 32 + e2 + 1]); }
        }
        __syncthreads();
    }
}

constexpr size_t R2_GU = 0, R2_GD = 264 * MiB;
constexpr int GS = 132;
__device__ __forceinline__ void gla_geom(int u, int& b, int& h, int& ck, size_t& rbase, int& p0) {
    b = u / 528; h = (u % 528) / 132; ck = u % 132;
    if (ck < 4) { rbase = (size_t)TL + b * CTXL; p0 = ck * 64; } else { rbase = (size_t)b * SEQ; p0 = (ck - 4) * 64; }
}
__device__ __forceinline__ void gla_prep_dir(const Frame& F, int dir, int h, u32x4 fw0, u32x4 fw1, LAS float* G, LAS unsigned char* KB) {
    { const int part = F.tid & 15;
      const float* lbt = (const float*)(F.ws + WS_CTRL + C_LBT) + dir * 512 + h * 128 + part * 8;
      const f32x4 la = *(const f32x4*)lbt, lb = *(const f32x4*)(lbt + 4);
      const float lb8[8] = {la[0], la[1], la[2], la[3], lb[0], lb[1], lb[2], lb[3]};
#pragma unroll
      for (int k = 0; k < 2; ++k) { const int i = (F.tid >> 4) + 32 * k, il = dir ? 63 - i : i;
          const u32x4 w = k ? fw1 : fw0;
          const float fr[8] = {lo2f(w.x), hi2f(w.x), lo2f(w.y), hi2f(w.y), lo2f(w.z), hi2f(w.z), lo2f(w.w), hi2f(w.w)};
          float f[8], kk[8];
#pragma unroll
          for (int j = 0; j < 8; ++j) { f[j] = lb8[j] + (1.f - lb8[j]) * sigmoid_f(fr[j]); kk[j] = 1.f - f[j]; f[j] = __logf(f[j]); }
          *(LAS f32x4*)(G + il * GS + part * 8) = (f32x4){f[0], f[1], f[2], f[3]}; *(LAS f32x4*)(G + il * GS + part * 8 + 4) = (f32x4){f[4], f[5], f[6], f[7]};
          u32x4 kw; kw.x = pack2(kk[0], kk[1]); kw.y = pack2(kk[2], kk[3]); kw.z = pack2(kk[4], kk[5]); kw.w = pack2(kk[6], kk[7]);
          *(LAS u32x4*)(KB + il * 272 + part * 16) = kw; } }
    __syncthreads();
    const int d = F.tid & 127, seg = F.tid >> 7;
    { float v[16];
#pragma unroll
      for (int r = 0; r < 16; ++r) v[r] = G[(seg * 16 + r) * GS + d];
      float run = 0.f;
#pragma unroll
      for (int r = 0; r < 16; ++r) { run += v[r]; v[r] = run; }
#pragma unroll
      for (int r = 0; r < 16; ++r) G[(seg * 16 + r) * GS + d] = v[r]; }
    __syncthreads();
    float off = 0.f;
#pragma unroll
    for (int s2 = 0; s2 < 3; ++s2) off += (s2 < seg) ? G[(s2 * 16 + 15) * GS + d] : 0.f;
    __syncthreads();
    { float v[16];
#pragma unroll
      for (int r = 0; r < 16; ++r) v[r] = G[(seg * 16 + r) * GS + d];
#pragma unroll
      for (int r = 0; r < 16; ++r) G[(seg * 16 + r) * GS + d] = v[r] + off; }
    __syncthreads();
}
__device__ __forceinline__ void ph_gla_p1(const Frame& F) {
    const bf16_t* PX = (const bf16_t*)(F.ws + WS_PX);
    LAS float* G = (LAS float*)F.lds;
    LAS unsigned char* KB = F.lds + 33792;
    LAS unsigned char* VT = F.lds + 33792 + 17408;
    LAS unsigned char* KT = VT + 18432;
    const int l31 = F.lane & 31, hh = F.lane >> 5;
    for (int u = F.bid; u < 4224; u += F.G) {
        int b, h, ck, p0; size_t rbase; gla_geom(u, b, h, ck, rbase, p0);
        u32x4 fw[4];
#pragma unroll
        for (int q = 0; q < 4; ++q) fw[q] = *(const u32x4*)(PX + (rbase + p0 + (F.tid >> 4) + 32 * (q & 1)) * EVEN_IN + 2048 + (q >> 1) * 512 + h * 128 + (F.tid & 15) * 8);
#pragma unroll
        for (int k = 0; k < 2; ++k) { const int c = F.tid + 512 * k, i = c >> 4, part = c & 15;
            const u32x4 w = *(const u32x4*)(PX + (rbase + p0 + i) * EVEN_IN + 1536 + h * 128 + part * 8);
            LAS unsigned short* d = (LAS unsigned short*)(VT + (part * 8) * 144 + i * 2);
            d[0 * 72] = (unsigned short)(w.x & 0xffffu); d[1 * 72] = (unsigned short)(w.x >> 16); d[2 * 72] = (unsigned short)(w.y & 0xffffu); d[3 * 72] = (unsigned short)(w.y >> 16);
            d[4 * 72] = (unsigned short)(w.z & 0xffffu); d[5 * 72] = (unsigned short)(w.z >> 16); d[6 * 72] = (unsigned short)(w.w & 0xffffu); d[7 * 72] = (unsigned short)(w.w >> 16); }
        for (int dir = 0; dir < 2; ++dir) {
            gla_prep_dir(F, dir, h, dir ? fw[2] : fw[0], dir ? fw[3] : fw[1], G, KB);
#pragma unroll
            for (int k = 0; k < 2; ++k) { const int c = F.tid + 512 * k, il = c >> 4, part = c & 15, i = dir ? 63 - il : il;
                const u32x4 kw = *(const LAS u32x4*)(KB + il * 272 + part * 16);
                const float kk[8] = {lo2f(kw.x), hi2f(kw.x), lo2f(kw.y), hi2f(kw.y), lo2f(kw.z), hi2f(kw.z), lo2f(kw.w), hi2f(kw.w)};
                const f32x4 g0 = *(const LAS f32x4*)(G + il * GS + part * 8), g1 = *(const LAS f32x4*)(G + il * GS + part * 8 + 4);
                const f32x4 l0 = *(const LAS f32x4*)(G + 63 * GS + part * 8), l1 = *(const LAS f32x4*)(G + 63 * GS + part * 8 + 4);
                LAS unsigned short* dd = (LAS unsigned short*)(KT + (part * 8) * 144 + i * 2);
#pragma unroll
                for (int j = 0; j < 4; ++j) { dd[j * 72] = f2bf(kk[j] * __expf(l0[j] - g0[j])); dd[(4 + j) * 72] = f2bf(kk[4 + j] * __expf(l1[j] - g1[j])); } }
            if (F.tid < 128) ((float*)(F.ws + WS_R2 + R2_GD))[(size_t)(u * 2 + dir) * 128 + F.tid] = __expf(G[63 * GS + F.tid]);
            __syncthreads();
            { const int db = F.wave >> 1, eb0 = (F.wave & 1) * 2;
              f32x16 a0, a1;
#pragma unroll
              for (int r = 0; r < 16; ++r) { a0[r] = 0.f; a1[r] = 0.f; }
#pragma unroll
              for (int ks = 0; ks < 4; ++ks) { const s16x8 ka = *(const LAS s16x8*)(KT + (32 * db + l31) * 144 + ks * 32 + hh * 16);
                  a0 = __builtin_amdgcn_mfma_f32_32x32x16_bf16(ka, *(const LAS s16x8*)(VT + (32 * eb0 + l31) * 144 + ks * 32 + hh * 16), a0, 0, 0, 0);
                  a1 = __builtin_amdgcn_mfma_f32_32x32x16_bf16(ka, *(const LAS s16x8*)(VT + (32 * (eb0 + 1) + l31) * 144 + ks * 32 + hh * 16), a1, 0, 0, 0); }
              bf16_t* ut = (bf16_t*)(F.ws + WS_R2 + R2_GU) + (size_t)(u * 2 + dir) * 16384;
#pragma unroll
              for (int gq = 0; gq < 4; ++gq) { const int d0 = 32 * db + 8 * gq + 4 * hh; u32x2 x;
                  x.x = pack2(a0[4 * gq], a0[4 * gq + 1]); x.y = pack2(a0[4 * gq + 2], a0[4 * gq + 3]); *(u32x2*)(ut + (32 * eb0 + l31) * 128 + d0) = x;
                  x.x = pack2(a1[4 * gq], a1[4 * gq + 1]); x.y = pack2(a1[4 * gq + 2], a1[4 * gq + 3]); *(u32x2*)(ut + (32 * (eb0 + 1) + l31) * 128 + d0) = x; } }
            __syncthreads();
        }
    }
}
__device__ __forceinline__ void ph_gla_p2(const Frame& F) {
    bf16_t* GU = (bf16_t*)(F.ws + WS_R2 + R2_GU); const float* GD = (const float*)(F.ws + WS_R2 + R2_GD);
    for (int v = gtid(F); v < 64 * 2048; v += F.G * NTH) {
        const int chain = v >> 11, vec = v & 2047, d0 = (vec & 15) * 8;
        const int bh = chain >> 1, dir = chain & 1;
        float s[8];
#pragma unroll
        for (int j = 0; j < 8; ++j) s[j] = 0.f;
#pragma unroll 4
        for (int n = 0; n < 132; ++n) { const int ck = dir ? (n < 4 ? 3 - n : 135 - n) : n; const size_t ud = (size_t)(bh * 132 + ck) * 2 + dir;
            u32x4* p = (u32x4*)(GU + ud * 16384 + (size_t)vec * 8); const u32x4 w = *p;
            const f32x4 c0 = *(const f32x4*)(GD + ud * 128 + d0), c1 = *(const f32x4*)(GD + ud * 128 + d0 + 4);
            u32x4 o; o.x = pack2(s[0], s[1]); o.y = pack2(s[2], s[3]); o.z = pack2(s[4], s[5]); o.w = pack2(s[6], s[7]); *p = o;
            s[0] = c0[0] * s[0] + lo2f(w.x); s[1] = c0[1] * s[1] + hi2f(w.x); s[2] = c0[2] * s[2] + lo2f(w.y); s[3] = c0[3] * s[3] + hi2f(w.y);
            s[4] = c1[0] * s[4] + lo2f(w.z); s[5] = c1[1] * s[5] + hi2f(w.z); s[6] = c1[2] * s[6] + lo2f(w.w); s[7] = c1[3] * s[7] + hi2f(w.w); }
    }
}
__device__ __forceinline__ void ph_gla_p3(const Frame& F) {
    const Params& P = *F.P;
    const bf16_t* PX = (const bf16_t*)(F.ws + WS_PX); bf16_t* CAT = (bf16_t*)(F.ws + WS_ACT);
    LAS float* G = (LAS float*)F.lds;
    LAS unsigned char* KB = F.lds + 33792;
    LAS unsigned char* VT = KB + 17408;
    LAS unsigned char* QB = VT + 18432;
    LAS unsigned char* QT = QB + 17408;
    LAS unsigned char* AM = QT + 17408;
    LAS float* RS = (LAS float*)(AM + 9216);
    const int l31 = F.lane & 31, hh = F.lane >> 5, l15 = F.lane & 15, kq = F.lane >> 4;
    for (int u = F.bid; u < 4224; u += F.G) {
        int b, h, ck, p0; size_t rbase; gla_geom(u, b, h, ck, rbase, p0);
        u32x4 fw[4];
#pragma unroll
        for (int q = 0; q < 4; ++q) fw[q] = *(const u32x4*)(PX + (rbase + p0 + (F.tid >> 4) + 32 * (q & 1)) * EVEN_IN + 2048 + (q >> 1) * 512 + h * 128 + (F.tid & 15) * 8);
#pragma unroll
        for (int k = 0; k < 2; ++k) { const int c = F.tid + 512 * k, i = c >> 4, part = c & 15;
            const bf16_t* row = PX + (rbase + p0 + i) * EVEN_IN;
            const u32x4 w = *(const u32x4*)(row + 1536 + h * 128 + part * 8);
            LAS unsigned short* d = (LAS unsigned short*)(VT + (part * 8) * 144 + i * 2);
            d[0 * 72] = (unsigned short)(w.x & 0xffffu); d[1 * 72] = (unsigned short)(w.x >> 16); d[2 * 72] = (unsigned short)(w.y & 0xffffu); d[3 * 72] = (unsigned short)(w.y >> 16);
            d[4 * 72] = (unsigned short)(w.z & 0xffffu); d[5 * 72] = (unsigned short)(w.z >> 16); d[6 * 72] = (unsigned short)(w.w & 0xffffu); d[7 * 72] = (unsigned short)(w.w >> 16);
            *(LAS u32x4*)(QB + i * 272 + part * 16) = *(const u32x4*)(row + 1024 + h * 128 + part * 8); }
        const int eb = F.wave >> 1, ib = F.wave & 1;
        f32x16 acc;
#pragma unroll
        for (int r = 0; r < 16; ++r) acc[r] = 0.f;
        for (int dir = 0; dir < 2; ++dir) {
            s16x8 sf[8];
            { const bf16_t* st = (const bf16_t*)(F.ws + WS_R2 + R2_GU) + (size_t)(u * 2 + dir) * 16384 + (size_t)(32 * eb + l31) * 128 + hh * 8;
#pragma unroll
              for (int ds = 0; ds < 8; ++ds) sf[ds] = *(const s16x8*)(st + ds * 16); }
            gla_prep_dir(F, dir, h, dir ? fw[2] : fw[0], dir ? fw[3] : fw[1], G, KB);
#pragma unroll
            for (int k = 0; k < 2; ++k) { const int c = F.tid + 512 * k, i = c >> 4, part = c & 15, il = dir ? 63 - i : i;
                const u32x4 qw = *(const LAS u32x4*)(QB + i * 272 + part * 16);
                const f32x4 g0 = *(const LAS f32x4*)(G + il * GS + part * 8), g1 = *(const LAS f32x4*)(G + il * GS + part * 8 + 4);
                u32x4 o; o.x = pack2(lo2f(qw.x) * __expf(g0[0]), hi2f(qw.x) * __expf(g0[1])); o.y = pack2(lo2f(qw.y) * __expf(g0[2]), hi2f(qw.y) * __expf(g0[3]));
                o.z = pack2(lo2f(qw.z) * __expf(g1[0]), hi2f(qw.z) * __expf(g1[1])); o.w = pack2(lo2f(qw.w) * __expf(g1[2]), hi2f(qw.w) * __expf(g1[3]));
                *(LAS u32x4*)(QT + i * 272 + part * 16) = o; }
            for (int c = F.tid; c < 576; c += NTH) *(LAS u32x4*)(AM + c * 16) = (u32x4){0u, 0u, 0u, 0u};
            __syncthreads();
            for (int blk = F.wave; blk < 10; blk += 8) {
                const int I = blk < 1 ? 0 : (blk < 3 ? 1 : (blk < 6 ? 2 : 3)); const int J = blk - (I * (I + 1)) / 2;
                const int ia = 16 * I + l15, ja = 16 * J + l15;
                const int ina = dir ? 63 - ia : ia;
                f32x4 ac = {0.f, 0.f, 0.f, 0.f};
#pragma unroll
                for (int ks = 0; ks < 4; ++ks) { const int d0 = 32 * ks + 8 * kq;
                    f32x4 r0 = {0.f, 0.f, 0.f, 0.f}, r1 = {0.f, 0.f, 0.f, 0.f};
                    if (I > 0) { r0 = *(const LAS f32x4*)(G + (16 * I - 1) * GS + d0); r1 = *(const LAS f32x4*)(G + (16 * I - 1) * GS + d0 + 4); }
                    const f32x4 gi0 = *(const LAS f32x4*)(G + ia * GS + d0), gi1 = *(const LAS f32x4*)(G + ia * GS + d0 + 4);
                    const f32x4 gj0 = *(const LAS f32x4*)(G + ja * GS + d0), gj1 = *(const LAS f32x4*)(G + ja * GS + d0 + 4);
                    const u32x4 qw = *(const LAS u32x4*)(QB + ina * 272 + d0 * 2), kw = *(const LAS u32x4*)(KB + ja * 272 + d0 * 2);
                    u32x4 af, bf;
                    af.x = pack2(lo2f(qw.x) * __expf(gi0[0] - r0[0]), hi2f(qw.x) * __expf(gi0[1] - r0[1])); af.y = pack2(lo2f(qw.y) * __expf(gi0[2] - r0[2]), hi2f(qw.y) * __expf(gi0[3] - r0[3]));
                    af.z = pack2(lo2f(qw.z) * __expf(gi1[0] - r1[0]), hi2f(qw.z) * __expf(gi1[1] - r1[1])); af.w = pack2(lo2f(qw.w) * __expf(gi1[2] - r1[2]), hi2f(qw.w) * __expf(gi1[3] - r1[3]));
                    bf.x = pack2(lo2f(kw.x) * __expf(fminf(r0[0] - gj0[0], 80.f)), hi2f(kw.x) * __expf(fminf(r0[1] - gj0[1], 80.f))); bf.y = pack2(lo2f(kw.y) * __expf(fminf(r0[2] - gj0[2], 80.f)), hi2f(kw.y) * __expf(fminf(r0[3] - gj0[3], 80.f)));
                    bf.z = pack2(lo2f(kw.z) * __expf(fminf(r1[0] - gj1[0], 80.f)), hi2f(kw.z) * __expf(fminf(r1[1] - gj1[1], 80.f))); bf.w = pack2(lo2f(kw.w) * __expf(fminf(r1[2] - gj1[2], 80.f)), hi2f(kw.w) * __expf(fminf(r1[3] - gj1[3], 80.f)));
                    ac = __builtin_amdgcn_mfma_f32_16x16x32_bf16(__builtin_bit_cast(s16x8, af), __builtin_bit_cast(s16x8, bf), ac, 0, 0, 0); }
#pragma unroll
                for (int rg = 0; rg < 4; ++rg) { const int il = 16 * I + 4 * kq + rg, jl = 16 * J + l15; const float val = (jl <= il) ? ac[rg] : 0.f;
                    const int in_ = dir ? 63 - il : il, jn = dir ? 63 - jl : jl;
                    *(LAS bf16_t*)(AM + in_ * 144 + jn * 2) = f2bf(val); }
            }
            __syncthreads();
            {
#pragma unroll
              for (int ds = 0; ds < 8; ++ds) acc = __builtin_amdgcn_mfma_f32_32x32x16_bf16(sf[ds], *(const LAS s16x8*)(QT + (32 * ib + l31) * 272 + ds * 32 + hh * 16), acc, 0, 0, 0);
#pragma unroll
              for (int js = 0; js < 4; ++js) acc = __builtin_amdgcn_mfma_f32_32x32x16_bf16(*(const LAS s16x8*)(VT + (32 * eb + l31) * 144 + js * 32 + hh * 16), *(const LAS s16x8*)(AM + (32 * ib + l31) * 144 + js * 32 + hh * 16), acc, 0, 0, 0); }
            __syncthreads();
        }
        { float ss = 0.f;
#pragma unroll
          for (int r = 0; r < 16; ++r) ss += acc[r] * acc[r];
          auto t = __builtin_amdgcn_permlane32_swap(__float_as_uint(ss), __float_as_uint(ss), false, false);
          ss = __uint_as_float(t[0]) + __uint_as_float(t[1]);
          if (hh == 0) RS[eb * 64 + 32 * ib + l31] = ss;
          __syncthreads();
          const int i = 32 * ib + l31; const float tot = RS[i] + RS[64 + i] + RS[128 + i] + RS[192 + i];
          const float rstd = rsqrtf(tot * (1.f / 128.f) + EPS);
          const size_t row = rbase + p0 + i;
#pragma unroll
          for (int gq = 0; gq < 4; ++gq) { const int e0 = 32 * eb + 8 * gq + 4 * hh; const int ch = h * 128 + e0;
              const u32x2 gw = *(const u32x2*)(PX + row * EVEN_IN + 3072 + ch); const f32x4 nw = *(const f32x4*)(P.in[I_HNW] + ch);
              u32x2 o; o.x = pack2(acc[4 * gq] * rstd * nw[0] * silu_f(lo2f(gw.x)), acc[4 * gq + 1] * rstd * nw[1] * silu_f(hi2f(gw.x)));
              o.y = pack2(acc[4 * gq + 2] * rstd * nw[2] * silu_f(lo2f(gw.y)), acc[4 * gq + 3] * rstd * nw[3] * silu_f(hi2f(gw.y)));
              *(u32x2*)(CAT + row * 1024 + 512 + ch) = o; }
          __syncthreads(); }
    }
}

__device__ __forceinline__ void ph_merge(const Frame& F, int mode) {
    const Params& P = *F.P;
    const bf16_t* PX = (const bf16_t*)(F.ws + WS_PX); bf16_t* CAT = (bf16_t*)(F.ws + WS_ACT);
    const bf16_t* Of = (const bf16_t*)(mode ? F.ws + WS_GOF : F.ws + WS_R2 + R2_OF0); const bf16_t* Ob = (const bf16_t*)(mode ? F.ws + WS_WMOE : F.ws + WS_R2 + R2_OB0);
    const int nrows = mode ? TL : TT, ldp = mode ? ODD_PAD : EVEN_IN, gcol = mode ? 1536 : 3072, dcol = mode ? 0 : 512;
    const float* nw = mode ? P.in[I_GDNNW] : P.in[I_HNW];
    for (int r = F.bid * 8 + F.wave; r < nrows; r += F.G * 8) {
        const int c = F.lane * 8;
        const u32x4 a = *(const u32x4*)(Of + (size_t)r * 512 + c), bb = *(const u32x4*)(Ob + (size_t)r * 512 + c), gg = *(const u32x4*)(PX + (size_t)r * ldp + gcol + c);
        float o[8] = {lo2f(a.x) + lo2f(bb.x), hi2f(a.x) + hi2f(bb.x), lo2f(a.y) + lo2f(bb.y), hi2f(a.y) + hi2f(bb.y), lo2f(a.z) + lo2f(bb.z), hi2f(a.z) + hi2f(bb.z), lo2f(a.w) + lo2f(bb.w), hi2f(a.w) + hi2f(bb.w)};
        const float g[8] = {lo2f(gg.x), hi2f(gg.x), lo2f(gg.y), hi2f(gg.y), lo2f(gg.z), hi2f(gg.z), lo2f(gg.w), hi2f(gg.w)};
        float ss = 0.f;
#pragma unroll
        for (int i = 0; i < 8; ++i) ss += o[i] * o[i];
        ss = sum16(ss);
        const float rstd = rsqrtf(ss * (1.f / 128.f) + EPS);
        float y[8];
#pragma unroll
        for (int i = 0; i < 8; ++i) { const float w = mode ? nw[(c & 127) + i] : nw[c + i]; y[i] = o[i] * rstd * w * silu_f(g[i]); }
        u32x4 w; w.x = pack2(y[0], y[1]); w.y = pack2(y[2], y[3]); w.z = pack2(y[4], y[5]); w.w = pack2(y[6], y[7]);
        *(u32x4*)(CAT + (size_t)r * 1024 + dcol + c) = w;
    }
}

__device__ __forceinline__ void ph_mla_norm(const Frame& F) {
    const Params& P = *F.P;
    const bf16_t* PX = (const bf16_t*)(F.ws + WS_PX);
    bf16_t* cqn = (bf16_t*)(F.ws + WS_R2 + R2_CQN); bf16_t* ckvn = cqn + (size_t)TL * 256;
    for (int r = F.bid * 8 + F.wave; r < TT; r += F.G * 8) {
        const bf16_t* row = PX + (size_t)r * ODD_PAD;
        if (r < TL) { const u32x2 w = *(const u32x2*)(row + 2064 + F.lane * 4);
            const float x0 = lo2f(w.x), x1 = hi2f(w.x), x2 = lo2f(w.y), x3 = hi2f(w.y);
            const float ss = wave_sum(x0 * x0 + x1 * x1 + x2 * x2 + x3 * x3); const float rstd = rsqrtf(ss * (1.f / 256.f) + EPS);
            const float* nw = P.in[I_QNW] + F.lane * 4;
            u32x2 o; o.x = pack2(x0 * rstd * nw[0], x1 * rstd * nw[1]); o.y = pack2(x2 * rstd * nw[2], x3 * rstd * nw[3]);
            *(u32x2*)(cqn + (size_t)r * 256 + F.lane * 4) = o; }
        { const unsigned w = *(const unsigned*)(row + 2320 + F.lane * 2);
          const float x0 = lo2f(w), x1 = hi2f(w);
          const float ss = wave_sum(x0 * x0 + x1 * x1); const float rstd = rsqrtf(ss * (1.f / 128.f) + EPS);
          const float* nw = P.in[I_KVNW] + F.lane * 2;
          *(unsigned*)(ckvn + (size_t)r * 256 + F.lane * 2) = pack2(x0 * rstd * nw[0], x1 * rstd * nw[1]);
          *(unsigned*)(ckvn + (size_t)r * 256 + 128 + F.lane * 2) = 0u; }
    }
}

__device__ __forceinline__ void ph_mla_final(const Frame& F) {
    const Params& P = *F.P;
    const bf16_t* PX = (const bf16_t*)(F.ws + WS_PX);
    bf16_t* Q = (bf16_t*)(F.ws + WS_WMOE);
    const bf16_t* KVR = (const bf16_t*)(F.ws + WS_PX + PX_KVRAW);
    bf16_t* Kb = (bf16_t*)(F.ws + WS_R2 + R2_K); bf16_t* Vb = (bf16_t*)(F.ws + WS_R2 + R2_V);
    const int hh = F.lane >> 3, sub = F.lane & 7;
    const float freq = __powf(10000.f, -(float)sub * 0.125f);
    const float qscale = 0.10206207261596577f * 1.4426950408889634f;
    for (int r = F.bid * 8 + F.wave; r < TT; r += F.G * 8) {
        const bool lat = r < TL; const int l = r & (SEQ - 1);
        float ca = 1.f, sa = 0.f, cb = 1.f, sb = 0.f;
        if (lat) { const float pr = (float)(l >> 6), pc = (float)(l & 63); sincosf(pr * freq, &sa, &ca); sincosf(pc * freq, &sb, &cb); }
        { const bf16_t* kv = KVR + (size_t)r * 1024 + hh * 128;
          const u32x4 w = *(const u32x4*)(kv + sub * 8);
          float x[12] = {lo2f(w.x), hi2f(w.x), lo2f(w.y), hi2f(w.y), lo2f(w.z), hi2f(w.z), lo2f(w.w), hi2f(w.w), 0.f, 0.f, 0.f, 0.f};
          const bf16_t* kr = PX + (size_t)r * ODD_PAD + 2448;
          x[8] = bf2f(kr[sub]); x[9] = bf2f(kr[8 + sub]); x[10] = bf2f(kr[16 + sub]); x[11] = bf2f(kr[24 + sub]);
          float ss = 0.f;
#pragma unroll
          for (int i = 0; i < 12; ++i) ss += x[i] * x[i];
          ss = sum8(ss);
          const float rstd = rsqrtf(ss * (1.f / 96.f) + EPS);
          const float* nw = P.in[I_QKK];
#pragma unroll
          for (int i = 0; i < 8; ++i) x[i] *= rstd * nw[sub * 8 + i];
          x[8] *= rstd * nw[64 + sub]; x[9] *= rstd * nw[72 + sub]; x[10] *= rstd * nw[80 + sub]; x[11] *= rstd * nw[88 + sub];
          const float a1 = x[8] * ca - x[9] * sa, a2 = x[9] * ca + x[8] * sa, b1 = x[10] * cb - x[11] * sb, b2 = x[11] * cb + x[10] * sb;
          const int bidx = lat ? (r >> 13) : ((r - TL) >> 8); const int s = lat ? (CTXL + l) : ((r - TL) & 255);
          bf16_t* kd = Kb + ((size_t)(bidx * 8 + hh) * (SEQ + CTXL) + s) * 96;
          u32x4 o; o.x = pack2(x[0], x[1]); o.y = pack2(x[2], x[3]); o.z = pack2(x[4], x[5]); o.w = pack2(x[6], x[7]);
          *(u32x4*)(kd + sub * 8) = o;
          kd[64 + sub] = f2bf(a1); kd[72 + sub] = f2bf(a2); kd[80 + sub] = f2bf(b1); kd[88 + sub] = f2bf(b2);
          const u32x4 vv = *(const u32x4*)(kv + 64 + sub * 8);
          *(u32x4*)(Vb + ((size_t)(bidx * 8 + hh) * (SEQ + CTXL) + s) * 64 + sub * 8) = vv; }
        if (lat) { bf16_t* q = Q + (size_t)r * 768 + hh * 96;
          const u32x4 w = *(const u32x4*)(q + sub * 8);
          float x[12] = {lo2f(w.x), hi2f(w.x), lo2f(w.y), hi2f(w.y), lo2f(w.z), hi2f(w.z), lo2f(w.w), hi2f(w.w), bf2f(q[64 + sub]), bf2f(q[72 + sub]), bf2f(q[80 + sub]), bf2f(q[88 + sub])};
          float ss = 0.f;
#pragma unroll
          for (int i = 0; i < 12; ++i) ss += x[i] * x[i];
          ss = sum8(ss);
          const float rstd = rsqrtf(ss * (1.f / 96.f) + EPS) * qscale;
          const float* nw = P.in[I_QKQ];
#pragma unroll
          for (int i = 0; i < 8; ++i) x[i] *= rstd * nw[sub * 8 + i];
          x[8] *= rstd * nw[64 + sub]; x[9] *= rstd * nw[72 + sub]; x[10] *= rstd * nw[80 + sub]; x[11] *= rstd * nw[88 + sub];
          const float a1 = x[8] * ca - x[9] * sa, a2 = x[9] * ca + x[8] * sa, b1 = x[10] * cb - x[11] * sb, b2 = x[11] * cb + x[10] * sb;
          u32x4 o; o.x = pack2(x[0], x[1]); o.y = pack2(x[2], x[3]); o.z = pack2(x[4], x[5]); o.w = pack2(x[6], x[7]);
          *(u32x4*)(q + sub * 8) = o;
          q[64 + sub] = f2bf(a1); q[72 + sub] = f2bf(a2); q[80 + sub] = f2bf(b1); q[88 + sub] = f2bf(b2); }
    }
}

__device__ __forceinline__ void ph_attn_naive(const Frame& F) {
    const bf16_t* Q = (const bf16_t*)(F.ws + WS_WMOE);
    const bf16_t* Kb = (const bf16_t*)(F.ws + WS_R2 + R2_K); const bf16_t* Vb = (const bf16_t*)(F.ws + WS_R2 + R2_V);
    bf16_t* CAT = (bf16_t*)(F.ws + WS_ACT);
    LAS float* Ks = (LAS float*)F.lds;
    LAS float* Vs = Ks + 64 * 96;
    constexpr int NK = SEQ + CTXL;
    const int hf = F.tid & 1;
    for (int it = F.bid; it < 8 * 8 * 32; it += F.G) {
        const int b = it >> 8, h = (it >> 5) & 7, qb = it & 31;
        const int l = qb * 256 + (F.tid >> 1); const size_t trow = (size_t)b * SEQ + l;
        float q[48], o[32];
        { const bf16_t* qp = Q + trow * 768 + h * 96 + hf * 48;
#pragma unroll
          for (int i = 0; i < 6; ++i) { const u32x4 w = *(const u32x4*)(qp + i * 8);
            q[i * 8 + 0] = lo2f(w.x); q[i * 8 + 1] = hi2f(w.x); q[i * 8 + 2] = lo2f(w.y); q[i * 8 + 3] = hi2f(w.y); q[i * 8 + 4] = lo2f(w.z); q[i * 8 + 5] = hi2f(w.z); q[i * 8 + 6] = lo2f(w.w); q[i * 8 + 7] = hi2f(w.w); } }
#pragma unroll
        for (int d = 0; d < 32; ++d) o[d] = 0.f;
        float m = -3.0e38f, ls = 0.f;
        const bf16_t* kb = Kb + (size_t)(b * 8 + h) * NK * 96; const bf16_t* vb = Vb + (size_t)(b * 8 + h) * NK * 64;
        for (int kt = 0; kt < NK / 64; ++kt) {
            for (int i = F.tid; i < 64 * 96 / 8; i += NTH) { const u32x4 w = *(const u32x4*)(kb + (size_t)kt * 64 * 96 + i * 8); LAS float* d = Ks + i * 8;
                d[0] = lo2f(w.x); d[1] = hi2f(w.x); d[2] = lo2f(w.y); d[3] = hi2f(w.y); d[4] = lo2f(w.z); d[5] = hi2f(w.z); d[6] = lo2f(w.w); d[7] = hi2f(w.w); }
            { const int i = F.tid; const u32x4 w = *(const u32x4*)(vb + (size_t)kt * 64 * 64 + i * 8); LAS float* d = Vs + i * 8;
                d[0] = lo2f(w.x); d[1] = hi2f(w.x); d[2] = lo2f(w.y); d[3] = hi2f(w.y); d[4] = lo2f(w.z); d[5] = hi2f(w.z); d[6] = lo2f(w.w); d[7] = hi2f(w.w); }
            __syncthreads();
            for (int jb = 0; jb < 16; ++jb) {
                float s[4]; float mx = m;
#pragma unroll
                for (int jj = 0; jj < 4; ++jj) { const LAS float* kr = Ks + (jb * 4 + jj) * 96 + hf * 48; float a = 0.f;
#pragma unroll
                    for (int d = 0; d < 48; d += 4) { const f32x4 kv = *(const LAS f32x4*)(kr + d); a += q[d] * kv[0] + q[d + 1] * kv[1] + q[d + 2] * kv[2] + q[d + 3] * kv[3]; }
                    a += __shfl_xor(a, 1);
                    s[jj] = a; mx = fmaxf(mx, a); }
                const float sc = exp2f(m - mx); ls *= sc;
#pragma unroll
                for (int d = 0; d < 32; ++d) o[d] *= sc;
                m = mx;
#pragma unroll
                for (int jj = 0; jj < 4; ++jj) { const float p = exp2f(s[jj] - mx); ls += p; const LAS float* vr = Vs + (jb * 4 + jj) * 64 + hf * 32;
#pragma unroll
                    for (int d = 0; d < 32; d += 4) { const f32x4 vv = *(const LAS f32x4*)(vr + d); o[d] += p * vv[0]; o[d + 1] += p * vv[1]; o[d + 2] += p * vv[2]; o[d + 3] += p * vv[3]; } }
            }
            __syncthreads();
        }
        const float inv = 1.f / ls;
        bf16_t* dst = CAT + trow * 1024 + 512 + h * 64 + hf * 32;
#pragma unroll
        for (int i = 0; i < 4; ++i) { u32x4 w; w.x = pack2(o[i * 8] * inv, o[i * 8 + 1] * inv); w.y = pack2(o[i * 8 + 2] * inv, o[i * 8 + 3] * inv); w.z = pack2(o[i * 8 + 4] * inv, o[i * 8 + 5] * inv); w.w = pack2(o[i * 8 + 6] * inv, o[i * 8 + 7] * inv);
            *(u32x4*)(dst + i * 8) = w; }
    }
}

__device__ __forceinline__ void ph_attn(const Frame& F) {
    constexpr int NK = SEQ + CTXL, NT = NK / 64;
    constexpr int KROWB = 208, VROWB = 144, KBYTES = 64 * KROWB, VBYTES = 64 * VROWB, BUFB = KBYTES + VBYTES;
    const bf16_t* Q = (const bf16_t*)(F.ws + WS_WMOE);
    const bf16_t* Kb = (const bf16_t*)(F.ws + WS_R2 + R2_K); const bf16_t* Vb = (const bf16_t*)(F.ws + WS_R2 + R2_V);
    bf16_t* CAT = (bf16_t*)(F.ws + WS_ACT);
    const int l31 = F.lane & 31, hh = F.lane >> 5;
    const int vcu = (F.G % 8 == 0) ? (F.bid % 8) * (F.G / 8) + F.bid / 8 : F.bid;
    const int kc0 = F.tid, kc1 = F.tid + 512;
    const unsigned kd0 = (unsigned)((kc0 / 12) * KROWB + (kc0 % 12) * 16), kd1 = (unsigned)((kc1 / 12) * KROWB + (kc1 % 12) * 16);
    const int vkey = F.tid >> 3, vpos = (vkey & ~12) | ((vkey & 4) << 1) | ((vkey & 8) >> 1);
    const unsigned vd = (unsigned)(((F.tid & 7) * 8) * VROWB + vpos * 2);
    for (int u = vcu; u < 2048; u += F.G) {
        const int bh = u >> 5, qblk = u & 31, b = bh >> 3, h = bh & 7;
        const size_t trow = (size_t)b * SEQ + qblk * 256 + F.wave * 32 + l31;
        s16x8 qf[6];
        { const bf16_t* qp = Q + trow * 768 + h * 96 + hh * 8;
#pragma unroll
          for (int ds = 0; ds < 6; ++ds) qf[ds] = *(const s16x8*)(qp + ds * 16); }
        f32x16 o0, o1;
#pragma unroll
        for (int i = 0; i < 16; ++i) { o0[i] = 0.f; o1[i] = 0.f; }
        float m = -1.0e30f, lsum = 0.f;
        const bf16_t* kg = Kb + (size_t)bh * NK * 96; const bf16_t* vg = Vb + (size_t)bh * NK * 64;
        u32x4 kr0, kr1 = {0u, 0u, 0u, 0u}, vr;
        kr0 = *(const u32x4*)(kg + (size_t)kc0 * 8); if (kc1 < 768) kr1 = *(const u32x4*)(kg + (size_t)kc1 * 8); vr = *(const u32x4*)(vg + (size_t)F.tid * 8);
        __syncthreads();
        for (int t = 0; t < NT; ++t) {
            { LAS unsigned char* kbuf = F.lds + (t & 1) * BUFB; LAS unsigned char* vbuf = kbuf + KBYTES;
              *(LAS u32x4*)(kbuf + kd0) = kr0; if (kc1 < 768) *(LAS u32x4*)(kbuf + kd1) = kr1;
              LAS unsigned short* vp = (LAS unsigned short*)(vbuf + vd);
              vp[0 * (VROWB / 2)] = (unsigned short)(vr.x & 0xffffu); vp[1 * (VROWB / 2)] = (unsigned short)(vr.x >> 16);
              vp[2 * (VROWB / 2)] = (unsigned short)(vr.y & 0xffffu); vp[3 * (VROWB / 2)] = (unsigned short)(vr.y >> 16);
              vp[4 * (VROWB / 2)] = (unsigned short)(vr.z & 0xffffu); vp[5 * (VROWB / 2)] = (unsigned short)(vr.z >> 16);
              vp[6 * (VROWB / 2)] = (unsigned short)(vr.w & 0xffffu); vp[7 * (VROWB / 2)] = (unsigned short)(vr.w >> 16); }
            __syncthreads();
            if (t + 1 < NT) { const bf16_t* kt = kg + (size_t)(t + 1) * 64 * 96; const bf16_t* vt = vg + (size_t)(t + 1) * 64 * 64;
                kr0 = *(const u32x4*)(kt + (size_t)kc0 * 8); if (kc1 < 768) kr1 = *(const u32x4*)(kt + (size_t)kc1 * 8); vr = *(const u32x4*)(vt + (size_t)F.tid * 8); }
            const LAS unsigned char* kbuf = F.lds + (t & 1) * BUFB; const LAS unsigned char* vbuf = kbuf + KBYTES;
            f32x16 s0, s1;
#pragma unroll
            for (int i = 0; i < 16; ++i) { s0[i] = 0.f; s1[i] = 0.f; }
#pragma unroll
            for (int ds = 0; ds < 6; ++ds) {
                const s16x8 a0 = *(const LAS s16x8*)(kbuf + l31 * KROWB + ds * 32 + hh * 16);
                const s16x8 a1 = *(const LAS s16x8*)(kbuf + (32 + l31) * KROWB + ds * 32 + hh * 16);
                s0 = __builtin_amdgcn_mfma_f32_32x32x16_bf16(a0, qf[ds], s0, 0, 0, 0);
                s1 = __builtin_amdgcn_mfma_f32_32x32x16_bf16(a1, qf[ds], s1, 0, 0, 0);
            }
            float mx = s0[0];
#pragma unroll
            for (int i = 1; i < 16; ++i) mx = fmaxf(mx, s0[i]);
#pragma unroll
            for (int i = 0; i < 16; ++i) mx = fmaxf(mx, s1[i]);
            mx = fmaxf(mx, __shfl_xor(mx, 32));
            const float mn = fmaxf(m, mx); const bool moved = __any(mn > m); const float alpha = __builtin_amdgcn_exp2f(m - mn); m = mn;
            float ps = 0.f;
#pragma unroll
            for (int i = 0; i < 16; ++i) { s0[i] = __builtin_amdgcn_exp2f(s0[i] - mn); s1[i] = __builtin_amdgcn_exp2f(s1[i] - mn); ps += s0[i] + s1[i]; }
            lsum = lsum * alpha + ps;
            if (moved) {
#pragma unroll
                for (int i = 0; i < 16; ++i) { o0[i] *= alpha; o1[i] *= alpha; } }
#pragma unroll
            for (int kb = 0; kb < 2; ++kb)
#pragma unroll
                for (int st = 0; st < 2; ++st) {
                    u32x4 pw;
                    if (kb == 0) { pw.x = pack2(s0[8 * st + 0], s0[8 * st + 1]); pw.y = pack2(s0[8 * st + 2], s0[8 * st + 3]); pw.z = pack2(s0[8 * st + 4], s0[8 * st + 5]); pw.w = pack2(s0[8 * st + 6], s0[8 * st + 7]); }
                    else         { pw.x = pack2(s1[8 * st + 0], s1[8 * st + 1]); pw.y = pack2(s1[8 * st + 2], s1[8 * st + 3]); pw.z = pack2(s1[8 * st + 4], s1[8 * st + 5]); pw.w = pack2(s1[8 * st + 6], s1[8 * st + 7]); }
                    const s16x8 pf = __builtin_bit_cast(s16x8, pw);
                    const int kof = (kb * 32 + 16 * st + 8 * hh) * 2;
                    o0 = __builtin_amdgcn_mfma_f32_32x32x16_bf16(*(const LAS s16x8*)(vbuf + l31 * VROWB + kof), pf, o0, 0, 0, 0);
                    o1 = __builtin_amdgcn_mfma_f32_32x32x16_bf16(*(const LAS s16x8*)(vbuf + (32 + l31) * VROWB + kof), pf, o1, 0, 0, 0);
                }
        }
        const float ltot = lsum + __shfl_xor(lsum, 32); const float inv = 1.f / ltot;
        bf16_t* dst = CAT + trow * 1024 + 512 + h * 64 + hh * 4;
#pragma unroll
        for (int g = 0; g < 4; ++g) { u32x2 w;
            w.x = pack2(o0[4 * g] * inv, o0[4 * g + 1] * inv); w.y = pack2(o0[4 * g + 2] * inv, o0[4 * g + 3] * inv); *(u32x2*)(dst + g * 8) = w;
            w.x = pack2(o1[4 * g] * inv, o1[4 * g + 1] * inv); w.y = pack2(o1[4 * g + 2] * inv, o1[4 * g + 3] * inv); *(u32x2*)(dst + 32 + g * 8) = w; }
    }
    __syncthreads();
}

__device__ __forceinline__ void ph_attn2(const Frame& F) {
    constexpr int NK = SEQ + CTXL, NT = NK / 64;
    constexpr int KROWB = 208, VROWB = 144, KBYTES = 64 * KROWB, VBYTES = 64 * VROWB, BUFB = KBYTES + VBYTES;
    const bf16_t* Q = (const bf16_t*)(F.ws + WS_WMOE);
    const bf16_t* Kb = (const bf16_t*)(F.ws + WS_R2 + R2_K); const bf16_t* Vb = (const bf16_t*)(F.ws + WS_R2 + R2_V);
    bf16_t* CAT = (bf16_t*)(F.ws + WS_ACT);
    const int l31 = F.lane & 31, hh = F.lane >> 5;
    const int vcu = (F.G % 8 == 0) ? (F.bid % 8) * (F.G / 8) + F.bid / 8 : F.bid;
    const int kc0 = F.tid, kc1 = F.tid + 512;
    const unsigned kd0 = (unsigned)((kc0 / 12) * KROWB + (kc0 % 12) * 16), kd1 = (unsigned)((kc1 / 12) * KROWB + (kc1 % 12) * 16);
    const int vkey = F.lane, vpos = (vkey & ~12) | ((vkey & 4) << 1) | ((vkey & 8) >> 1);
    const unsigned vd = (unsigned)((F.wave * 8) * VROWB + vpos * 2);
    const unsigned vgo = (unsigned)(F.lane * 64 + F.wave * 8);
    const bool grpB = F.wave >= 4;
    for (int u = vcu; u < 2048; u += F.G) {
        const int bh = u >> 5, qblk = u & 31, b = bh >> 3, h = bh & 7;
        const size_t trow = (size_t)b * SEQ + qblk * 256 + F.wave * 32 + l31;
        s16x8 qf[6];
        { const bf16_t* qp = Q + trow * 768 + h * 96 + hh * 8;
#pragma unroll
          for (int ds = 0; ds < 6; ++ds) qf[ds] = *(const s16x8*)(qp + ds * 16); }
        f32x16 o0, o1, s0, s1;
#pragma unroll
        for (int i = 0; i < 16; ++i) { o0[i] = 0.f; o1[i] = 0.f; }
        float m = 0.f, lsum = 0.f;
        const bf16_t* kg = Kb + (size_t)bh * NK * 96; const bf16_t* vg = Vb + (size_t)bh * NK * 64;
        u32x4 kr0, kr1 = {0u, 0u, 0u, 0u}, vr;
#define AT_LOADK(t) do { if ((t) < NT) { const bf16_t* kt_ = kg + (size_t)(t) * 64 * 96; kr0 = *(const u32x4*)(kt_ + (size_t)kc0 * 8); if (kc1 < 768) kr1 = *(const u32x4*)(kt_ + (size_t)kc1 * 8); } } while (0)
#define AT_LOADV(t) do { if ((t) < NT) vr = *(const u32x4*)(vg + (size_t)(t) * 64 * 64 + vgo); } while (0)
#define AT_PUTK(t) do { if ((t) < NT) { LAS unsigned char* kb_ = F.lds + ((t) % 3) * BUFB; *(LAS u32x4*)(kb_ + kd0) = kr0; if (kc1 < 768) *(LAS u32x4*)(kb_ + kd1) = kr1; } } while (0)
#define AT_PUTV(t) do { if ((t) < NT) { LAS unsigned short* vp = (LAS unsigned short*)(F.lds + ((t) % 3) * BUFB + KBYTES + vd); \
            vp[0 * (VROWB / 2)] = (unsigned short)(vr.x & 0xffffu); vp[1 * (VROWB / 2)] = (unsigned short)(vr.x >> 16); vp[2 * (VROWB / 2)] = (unsigned short)(vr.y & 0xffffu); vp[3 * (VROWB / 2)] = (unsigned short)(vr.y >> 16); \
            vp[4 * (VROWB / 2)] = (unsigned short)(vr.z & 0xffffu); vp[5 * (VROWB / 2)] = (unsigned short)(vr.z >> 16); vp[6 * (VROWB / 2)] = (unsigned short)(vr.w & 0xffffu); vp[7 * (VROWB / 2)] = (unsigned short)(vr.w >> 16); } } while (0)
#define AT_QK(t) do { const LAS unsigned char* kbuf = F.lds + ((t) % 3) * BUFB; s16x8 ka_[6], kb2_[6]; \
            _Pragma("unroll") for (int ds = 0; ds < 6; ++ds) { ka_[ds] = *(const LAS s16x8*)(kbuf + l31 * KROWB + ds * 32 + hh * 16); kb2_[ds] = *(const LAS s16x8*)(kbuf + (32 + l31) * KROWB + ds * 32 + hh * 16); } \
            _Pragma("unroll") for (int i = 0; i < 16; ++i) { s0[i] = -m; s1[i] = -m; } \
            _Pragma("unroll") for (int ds = 0; ds < 6; ++ds) { \
                s0 = __builtin_amdgcn_mfma_f32_32x32x16_bf16(ka_[ds], qf[ds], s0, 0, 0, 0); s1 = __builtin_amdgcn_mfma_f32_32x32x16_bf16(kb2_[ds], qf[ds], s1, 0, 0, 0); } } while (0)
#define AT_SMPV(t) do { const LAS unsigned char* vbuf = F.lds + ((t) % 3) * BUFB + KBYTES; s16x8 va_[4], vb2_[4]; \
            _Pragma("unroll") for (int q = 0; q < 4; ++q) { const int kof = ((q >> 1) * 32 + 16 * (q & 1) + 8 * hh) * 2; va_[q] = *(const LAS s16x8*)(vbuf + l31 * VROWB + kof); vb2_[q] = *(const LAS s16x8*)(vbuf + (32 + l31) * VROWB + kof); } \
            float mx = s0[0]; \
            _Pragma("unroll") for (int i = 1; i < 16; ++i) mx = fmaxf(mx, s0[i]); \
            _Pragma("unroll") for (int i = 0; i < 16; ++i) mx = fmaxf(mx, s1[i]); \
            { auto sw_ = __builtin_amdgcn_permlane32_swap(__float_as_uint(mx), __float_as_uint(mx), false, false); mx = fmaxf(__uint_as_float(sw_[0]), __uint_as_float(sw_[1])); } \
            if (__any(mx > 0.f)) { const float dl = fmaxf(mx, 0.f); const float alpha = __builtin_amdgcn_exp2f(-dl); m += dl; lsum *= alpha; \
                _Pragma("unroll") for (int i = 0; i < 16; ++i) { o0[i] *= alpha; o1[i] *= alpha; s0[i] -= dl; s1[i] -= dl; } } \
            float ps = 0.f; \
            _Pragma("unroll") for (int i = 0; i < 16; ++i) { s0[i] = __builtin_amdgcn_exp2f(s0[i]); s1[i] = __builtin_amdgcn_exp2f(s1[i]); ps += s0[i] + s1[i]; } \
            lsum += ps; \
            _Pragma("unroll") for (int q = 0; q < 4; ++q) { \
                const s16x8 pf = pack8((q >> 1) == 0 ? s0 : s1, 8 * (q & 1)); \
                o0 = __builtin_amdgcn_mfma_f32_32x32x16_bf16(va_[q], pf, o0, 0, 0, 0); \
                o1 = __builtin_amdgcn_mfma_f32_32x32x16_bf16(vb2_[q], pf, o1, 0, 0, 0); } } while (0)
        __syncthreads();
        AT_LOADK(0); AT_LOADV(0); AT_PUTK(0); AT_PUTV(0); AT_LOADK(1);
        __syncthreads();
        if (!grpB) {
            for (int t = 0; t < NT; ++t) {
                AT_LOADV(t + 1); AT_QK(t); AT_PUTK(t + 1);
                __syncthreads();
                AT_LOADK(t + 2); AT_SMPV(t); AT_PUTV(t + 1);
                __syncthreads();
            }
            __syncthreads();
        } else {
            AT_PUTK(1); AT_LOADV(1);
            __syncthreads();
            for (int t = 0; t < NT; ++t) {
                AT_LOADK(t + 2); AT_QK(t); AT_PUTV(t + 1);
                __syncthreads();
                AT_LOADV(t + 2); AT_SMPV(t); AT_PUTK(t + 2);
                __syncthreads();
            }
        }
#undef AT_LOADK
#undef AT_LOADV
#undef AT_PUTK
#undef AT_PUTV
#undef AT_QK
#undef AT_SMPV
        float ltot; { auto sw_ = __builtin_amdgcn_permlane32_swap(__float_as_uint(lsum), __float_as_uint(lsum), false, false); ltot = __uint_as_float(sw_[0]) + __uint_as_float(sw_[1]); }
        const float inv = 1.f / ltot;
        bf16_t* dst = CAT + trow * 1024 + 512 + h * 64 + hh * 4;
#pragma unroll
        for (int g = 0; g < 4; ++g) { u32x2 w;
            w.x = pack2(o0[4 * g] * inv, o0[4 * g + 1] * inv); w.y = pack2(o0[4 * g + 2] * inv, o0[4 * g + 3] * inv); *(u32x2*)(dst + g * 8) = w;
            w.x = pack2(o1[4 * g] * inv, o1[4 * g + 1] * inv); w.y = pack2(o1[4 * g + 2] * inv, o1[4 * g + 3] * inv); *(u32x2*)(dst + 32 + g * 8) = w; }
    }
    __syncthreads();
}

__device__ __forceinline__ void ph_gdn(const Frame& F) {
    const Params& P = *F.P;
    const bf16_t* PX = (const bf16_t*)(F.ws + WS_PX);
    LAS bf16_t* rq = (LAS bf16_t*)F.lds;
    LAS bf16_t* rk = rq + 36 * 128;
    LAS bf16_t* rv = rk + 36 * 128;
    LAS float* qc = (LAS float*)(F.lds + 24576);
    LAS float* kc = qc + 4096;
    LAS float* vc = kc + 4096;
    LAS float* os = vc + 1024;
    LAS float* ba = os + 1024;
    const int dg = F.lane & 15, el = F.wave * 4 + (F.lane >> 4);
    for (int it = F.bid; it < 256; it += F.G) {
        const int b = it >> 5, h = (it >> 3) & 3, dir = (it >> 2) & 1, sl = it & 3;
        bf16_t* O = dir ? (bf16_t*)(F.ws + WS_WMOE) : (bf16_t*)(F.ws + WS_GOF);
        const float a_neg = -__expf(P.in[I_ALOG][dir * 4 + h]), dtb = P.in[I_DTB][dir * 4 + h];
        float cwq[5], cwk[5], cwv[5];
        { const int d = F.tid & 127;
#pragma unroll
          for (int j = 0; j < 5; ++j) { cwq[j] = P.in[I_CONVW][j * 1536 + h * 128 + d]; cwk[j] = P.in[I_CONVW][j * 1536 + 512 + h * 128 + d]; cwv[j] = P.in[I_CONVW][j * 1536 + 1024 + h * 128 + sl * 32 + (F.tid & 31)]; } }
        float S[8];
#pragma unroll
        for (int i = 0; i < 8; ++i) S[i] = 0.f;
        u32x4 pr0, pr1, pr2; float pbeta = 0.f, pdec = 0.f;
        auto blk_geom = [&](int bi, int& len, size_t& rbase, int& p0) { const bool c = bi < 8; len = c ? CTXL : SEQ; rbase = c ? (size_t)TL + b * CTXL : (size_t)b * SEQ;
            const int nbk = len / 32, k = c ? bi : bi - 8; p0 = (dir ? (nbk - 1 - k) : k) * 32; };
        auto fetch = [&](int bi, int id) -> u32x4 { int len, p0; size_t rbase; blk_geom(bi, len, rbase, p0);
            u32x4 z = {0u, 0u, 0u, 0u}; if (id >= 1296) return z;
            int arr = 0, j = id; if (j >= 1152) { arr = 2; j -= 1152; } else if (j >= 576) { arr = 1; j -= 576; }
            const int rr = arr == 2 ? (j >> 2) : (j >> 4), part = arr == 2 ? (j & 3) : (j & 15); const int p = p0 - 2 + rr;
            if (p < 0 || p >= len) return z;
            const bf16_t* row = PX + (rbase + p) * ODD_PAD + (arr == 0 ? h * 128 : (arr == 1 ? 512 + h * 128 : 1024 + h * 128 + sl * 32)) + part * 8;
            return *(const u32x4*)row; };
        auto stash = [&](int id, u32x4 w) { if (id >= 1296) return; int arr = 0, j = id; if (j >= 1152) { arr = 2; j -= 1152; } else if (j >= 576) { arr = 1; j -= 576; }
            LAS bf16_t* d = arr == 0 ? rq + j * 8 : (arr == 1 ? rk + j * 8 : rv + j * 8); *(LAS u32x4*)d = w; };
        auto fetch_all = [&](int bi) { pr0 = fetch(bi, F.tid); pr1 = fetch(bi, F.tid + 512); pr2 = fetch(bi, F.tid + 1024);
            if (F.tid < 32) { int len, p0; size_t rbase; blk_geom(bi, len, rbase, p0); const bf16_t* row = PX + (rbase + p0 + F.tid) * ODD_PAD;
                pbeta = bf2f(row[2048 + dir * 4 + h]); pdec = bf2f(row[2056 + dir * 4 + h]); } };
        fetch_all(0);
        for (int bi = 0; bi < 264; ++bi) {
            __syncthreads();
            stash(F.tid, pr0); stash(F.tid + 512, pr1); stash(F.tid + 1024, pr2);
            if (F.tid < 32) { ba[F.tid] = sigmoid_f(pbeta); ba[32 + F.tid] = __expf(a_neg * softplus_f(pdec + dtb)); }
            __syncthreads();
            if (bi + 1 < 264) fetch_all(bi + 1);
            { const int d = F.tid & 127;
#pragma unroll
              for (int i = 0; i < 8; ++i) { const int s = (F.tid >> 7) + i * 4; float a = 0.f, c = 0.f;
#pragma unroll
                for (int j = 0; j < 5; ++j) { a += bf2f(rq[(s + j) * 128 + d]) * cwq[j]; c += bf2f(rk[(s + j) * 128 + d]) * cwk[j]; }
                qc[s * 128 + d] = silu_f(a); kc[s * 128 + d] = silu_f(c); }
#pragma unroll
              for (int i = 0; i < 2; ++i) { const int s = (F.tid >> 5) + i * 16, e = F.tid & 31; float a = 0.f;
#pragma unroll
                for (int j = 0; j < 5; ++j) a += bf2f(rv[(s + j) * 32 + e]) * cwv[j];
                vc[s * 32 + e] = silu_f(a); } }
            __syncthreads();
            { const int s = F.wave * 4 + (F.lane >> 4);
              LAS float* qp = qc + s * 128 + dg * 8; LAS float* kp = kc + s * 128 + dg * 8;
              f32x4 q0 = *(LAS f32x4*)qp, q1 = *(LAS f32x4*)(qp + 4), k0 = *(LAS f32x4*)kp, k1 = *(LAS f32x4*)(kp + 4);
              float sq = 0.f, sk = 0.f;
#pragma unroll
              for (int i = 0; i < 4; ++i) { sq += q0[i] * q0[i] + q1[i] * q1[i]; sk += k0[i] * k0[i] + k1[i] * k1[i]; }
              sq = sum16(sq); sk = sum16(sk);
              const float rq_ = rsqrtf(sq + EPS) * 0.08838834764831845f, rk_ = rsqrtf(sk + EPS);
              *(LAS f32x4*)qp = q0 * rq_; *(LAS f32x4*)(qp + 4) = q1 * rq_; *(LAS f32x4*)kp = k0 * rk_; *(LAS f32x4*)(kp + 4) = k1 * rk_; }
            __syncthreads();
#pragma unroll 2
            for (int ss = 0; ss < 32; ++ss) {
                const int st = dir ? 31 - ss : ss;
                const f32x4 ka = *(const LAS f32x4*)(kc + st * 128 + dg * 8), kb = *(const LAS f32x4*)(kc + st * 128 + dg * 8 + 4);
                const f32x4 qa = *(const LAS f32x4*)(qc + st * 128 + dg * 8), qb = *(const LAS f32x4*)(qc + st * 128 + dg * 8 + 4);
                const float v = vc[st * 32 + el], beta = ba[st], a = ba[32 + st];
                float r0 = 0.f, r1 = 0.f;
#pragma unroll
                for (int i = 0; i < 4; ++i) { r0 += ka[i] * S[i]; r1 += kb[i] * S[4 + i]; }
                const float r = sum16(r0 + r1);
                const float u = beta * (v - a * r);
                float p0 = 0.f, p1 = 0.f;
#pragma unroll
                for (int i = 0; i < 4; ++i) { S[i] = a * S[i] + ka[i] * u; p0 += qa[i] * S[i]; S[4 + i] = a * S[4 + i] + kb[i] * u; p1 += qb[i] * S[4 + i]; }
                const float o = sum16(p0 + p1);
                if (dg == 0) os[st * 32 + el] = o;
            }
            __syncthreads();
            { int len, p0; size_t rbase; blk_geom(bi, len, rbase, p0);
              const int s = F.tid >> 4, e2 = (F.tid & 15) * 2;
              *(unsigned*)(O + (rbase + p0 + s) * 512 + h * 128 + sl * 32 + e2) = pack2(os[s * 32 + e2], os[s * 32 + e2 + 1]); }
        }
        __syncthreads();
    }
}

constexpr int GR_KN = 0, GR_QN = 16384, GR_VT = 32768, GR_T = 49152, GR_QK = 65536, GR_SC = 81920, GR_BYTES = 83968;
__device__ __forceinline__ s16x8 ld2x64(const LAS unsigned char* p) {
    const u32x2 a = *(const LAS u32x2*)p, b = *(const LAS u32x2*)(p + 16); u32x4 v; v.x = a.x; v.y = a.y; v.z = b.x; v.w = b.y; return __builtin_bit_cast(s16x8, v);
}
__device__ __forceinline__ void st2x64(LAS unsigned char* p, u32x4 v) { u32x2 a, b; a.x = v.x; a.y = v.y; b.x = v.z; b.y = v.w; *(LAS u32x2*)p = a; *(LAS u32x2*)(p + 8) = b; }
__device__ __forceinline__ u32x4 ld2x64n(const LAS unsigned char* p) { const u32x2 a = *(const LAS u32x2*)p, b = *(const LAS u32x2*)(p + 8); u32x4 v; v.x = a.x; v.y = a.y; v.z = b.x; v.w = b.y; return v; }
__device__ __forceinline__ void gdn_unit_geom(int b, int ck, size_t& rbase, int& len, int& p0) {
    if (ck < 4) { rbase = (size_t)TL + b * CTXL; len = CTXL; p0 = ck * 64; } else { rbase = (size_t)b * SEQ; len = SEQ; p0 = (ck - 4) * 64; }
}
__device__ __forceinline__ void ph_gdn_prep(const Frame& F) {
    const Params& P = *F.P;
    const bf16_t* PX = (const bf16_t*)(F.ws + WS_PX);
    LAS unsigned char* L = F.lds;
    LAS bf16_t* RAW = (LAS bf16_t*)L;
    LAS unsigned char* KNI = L; LAS unsigned char* QNI = L + 16896;
    LAS float* qf = (LAS float*)(L + 52224);
    LAS float* kf = qf + 8192;
    LAS unsigned char* VTI = L + 52224 + 65536;
    LAS float* SCL = (LAS float*)(L + 52224 + 65536 + 17408);
    LAS float* XS = SCL + 384;
    u32x4 pf[7]; float ps0 = 0.f, ps1 = 0.f, ps2 = 0.f, ps3 = 0.f;
    auto fetch = [&](int u, int tid) { const int b = u / 528, h = (u % 528) / 132, ck = u % 132; size_t rbase; int len, p0; gdn_unit_geom(b, ck, rbase, len, p0);
#pragma unroll
        for (int k = 0; k < 7; ++k) { const int c = tid + 512 * k; u32x4 w = {0u, 0u, 0u, 0u};
            if (c < 68 * 48) { const int rr = c / 48, part = c % 48; const int p = p0 - 2 + rr;
                if (p >= 0 && p < len) w = *(const u32x4*)(PX + (rbase + p) * ODD_PAD + (part >> 4) * 512 + h * 128 + (part & 15) * 8); }
            pf[k] = w; }
        if (tid < 64) { const bf16_t* row = PX + (rbase + p0 + tid) * ODD_PAD; ps0 = bf2f(row[2048 + h]); ps1 = bf2f(row[2052 + h]); ps2 = bf2f(row[2056 + h]); ps3 = bf2f(row[2060 + h]); } };
    if (F.bid < 4224) fetch(F.bid, F.tid);
    for (int u = F.bid; u < 4224; u += F.G) {
        const int b = u / 528, h = (u % 528) / 132, ck = u % 132;
        (void)b; (void)ck;
        int tid = F.tid; asm volatile("" : "+v"(tid));
        const int lane = tid & 63, l31 = lane & 31, hh = lane >> 5, l15 = lane & 15, kq = lane >> 4;
        unsigned char* rec = F.ws + WS_GREC + (size_t)u * GR_BYTES;
#pragma unroll
        for (int k = 0; k < 7; ++k) { const int c = tid + 512 * k; if (c < 68 * 48) *(LAS u32x4*)(RAW + (c / 48) * 384 + (c % 48) * 8) = pf[k]; }
        if (tid < 64) { const float an_f = -__expf(P.in[I_ALOG][h]), an_b = -__expf(P.in[I_ALOG][4 + h]);
            SCL[256 + tid] = sigmoid_f(ps0); SCL[320 + tid] = sigmoid_f(ps1);
            SCL[tid] = an_f * softplus_f(ps2 + P.in[I_DTB][h]); SCL[64 + tid] = an_b * softplus_f(ps3 + P.in[I_DTB][4 + h]); }
        __syncthreads();
        if (u + F.G < 4224) fetch(u + F.G, tid);
        { const int d = tid & 127, rg = tid >> 7;
#pragma unroll 1
          for (int arr = 0; arr < 3; ++arr) {
              float cw[5];
#pragma unroll
              for (int j = 0; j < 5; ++j) cw[j] = P.in[I_CONVW][j * 1536 + arr * 512 + h * 128 + d];
              const LAS bf16_t* rp = RAW + (rg * 16) * 384 + arr * 128 + d;
              float w0 = bf2f(rp[0]), w1 = bf2f(rp[384]), w2 = bf2f(rp[2 * 384]), w3 = bf2f(rp[3 * 384]);
#pragma unroll 4
              for (int ii = 0; ii < 16; ++ii) { const int i = rg * 16 + ii; const float w4 = bf2f(rp[(ii + 4) * 384]);
                  const float o = silu_f(w0 * cw[0] + w1 * cw[1] + w2 * cw[2] + w3 * cw[3] + w4 * cw[4]);
                  if (arr == 0) qf[i * 128 + d] = o; else if (arr == 1) kf[i * 128 + d] = o; else *(LAS bf16_t*)(VTI + d * 136 + i * 2) = f2bf(o);
                  w0 = w1; w1 = w2; w2 = w3; w3 = w4; } } }
        if (tid < 64) { float gf = 0.f, gb = 0.f;
            for (int j = 0; j < 64; ++j) { gf += (j <= tid) ? SCL[j] : 0.f; gb += (j >= tid) ? SCL[64 + j] : 0.f; }
            SCL[128 + tid] = gf; SCL[192 + tid] = gb; }
        __syncthreads();
#pragma unroll
        for (int rr = 0; rr < 8; ++rr) { const int i = F.wave * 8 + rr;
            const float q0 = qf[i * 128 + lane], q1 = qf[i * 128 + 64 + lane], k0 = kf[i * 128 + lane], k1 = kf[i * 128 + 64 + lane];
            const float sq = wave_sum(q0 * q0 + q1 * q1), sk = wave_sum(k0 * k0 + k1 * k1);
            const float rq_ = rsqrtf(sq + EPS) * 0.08838834764831845f, rk_ = rsqrtf(sk + EPS);
            *(LAS bf16_t*)(QNI + i * 264 + lane * 2) = f2bf(q0 * rq_); *(LAS bf16_t*)(QNI + i * 264 + 128 + lane * 2) = f2bf(q1 * rq_);
            *(LAS bf16_t*)(KNI + i * 264 + lane * 2) = f2bf(k0 * rk_); *(LAS bf16_t*)(KNI + i * 264 + 128 + lane * 2) = f2bf(k1 * rk_); }
        __syncthreads();
        { const int mq = F.wave >> 2, ib = (F.wave >> 1) & 1, jb = F.wave & 1;
          const LAS unsigned char* Ai = (mq ? QNI : KNI) + (32 * ib + l31) * 264 + hh * 16; const LAS unsigned char* Bi = KNI + (32 * jb + l31) * 264 + hh * 16;
          f32x16 acc;
#pragma unroll
          for (int r = 0; r < 16; ++r) acc[r] = 0.f;
#pragma unroll
          for (int ds = 0; ds < 8; ++ds) acc = __builtin_amdgcn_mfma_f32_32x32x16_bf16(__builtin_bit_cast(s16x8, ld2x64n(Ai + ds * 32)), __builtin_bit_cast(s16x8, ld2x64n(Bi + ds * 32)), acc, 0, 0, 0);
          const int j = 32 * jb + l31; const float gfj = SCL[128 + j], gbj = SCL[192 + j];
          bf16_t* qkf = (bf16_t*)(rec + GR_QK); bf16_t* qkb = qkf + 4096;
#pragma unroll
          for (int r = 0; r < 16; ++r) { const int i = 32 * ib + (r & 3) + 8 * (r >> 2) + 4 * hh;
              const float ef = __expf(fminf(SCL[128 + i] - gfj, 0.f)), eb = __expf(fminf(SCL[192 + i] - gbj, 0.f));
              if (mq == 0) { qf[i * 64 + j] = (j < i) ? SCL[256 + i] * acc[r] * ef : 0.f; kf[(63 - i) * 64 + (63 - j)] = (j > i) ? SCL[320 + i] * acc[r] * eb : 0.f; }
              else { qkf[i * 64 + j] = f2bf((j <= i) ? acc[r] * ef : 0.f); qkb[i * 64 + j] = f2bf((j >= i) ? acc[r] * eb : 0.f); } }
          for (int c = tid; c < 2048; c += NTH) { const int m2 = c >> 10, o = c & 1023; *(LAS f32x4*)((m2 ? kf : qf) + 4096 + o * 4) = (f32x4){0.f, 0.f, 0.f, 0.f}; } }
        __syncthreads();
        if (F.wave < 2) {
            const LAS float* Am = F.wave == 0 ? qf : kf; LAS float* Tl = (F.wave == 0 ? qf : kf) + 4096;
            const int I = kq, c = l15; const LAS float* Ab = Am + (16 * I) * 64 + 16 * I;
            float t[16];
#pragma unroll
            for (int r = 0; r < 16; ++r) { float a = (c == r) ? 1.f : 0.f;
#pragma unroll
                for (int jg = 0; jg < (r + 3) / 4; ++jg) { const f32x4 m = *(const LAS f32x4*)(Ab + r * 64 + jg * 4);
#pragma unroll
                    for (int q = 0; q < 4; ++q) if (jg * 4 + q < r) a -= m[q] * t[jg * 4 + q]; }
                t[r] = a; Tl[(16 * I + r) * 64 + 16 * I + c] = a; }
        } else {
            const int t6 = tid - 128;
            for (int c = t6; c < 3072; c += 384) {
                u32x4 w; if (c < 2048) { const int cc = c & 1023, row = cc >> 4, part = cc & 15; w = ld2x64n((c < 1024 ? KNI : QNI) + row * 264 + part * 16); }
                else { const int cc = c - 2048, row = cc >> 3, part = cc & 7; w = ld2x64n(VTI + row * 136 + part * 16); }
                *(u32x4*)(rec + (size_t)c * 16) = w; }
            if (t6 < 64) { float* sc = (float*)(rec + GR_SC); const int i = t6;
                const float gf = SCL[128 + i], gb = SCL[192 + i], glf = SCL[128 + 63], glb = SCL[192 + 0];
                sc[i] = SCL[256 + i]; sc[64 + i] = __expf(gf); sc[128 + i] = __expf(glf - gf);
                sc[192 + i] = SCL[320 + i]; sc[256 + i] = __expf(gb); sc[320 + i] = __expf(glb - gb);
                if (i == 0) { sc[384] = __expf(glf); sc[385] = __expf(glb); } }
        }
        __syncthreads();
#pragma unroll
        for (int lev = 1; lev < 4; ++lev) {
            const int mtx = F.wave & 1, idx = F.wave >> 1;
            if (idx < 4 - lev) {
                const int I = idx + lev, J = idx;
                const LAS float* Am = mtx ? kf : qf; LAS float* Tl = (mtx ? kf : qf) + 4096; LAS float* xs = XS + F.wave * 256;
                f32x4 x = {0.f, 0.f, 0.f, 0.f};
                for (int K = J; K < I; ++K) {
#pragma unroll
                    for (int ks = 0; ks < 4; ++ks) x = __builtin_amdgcn_mfma_f32_16x16x4f32(Am[(16 * I + l15) * 64 + 16 * K + 4 * ks + kq], Tl[(16 * K + 4 * ks + kq) * 64 + 16 * J + l15], x, 0, 0, 0); }
#pragma unroll
                for (int rg = 0; rg < 4; ++rg) xs[(4 * kq + rg) * 16 + l15] = x[rg];
                asm volatile("s_waitcnt lgkmcnt(0)" ::: "memory");
                __builtin_amdgcn_wave_barrier();
                f32x4 y = {0.f, 0.f, 0.f, 0.f};
#pragma unroll
                for (int ks = 0; ks < 4; ++ks) y = __builtin_amdgcn_mfma_f32_16x16x4f32(Tl[(16 * I + l15) * 64 + 16 * I + 4 * ks + kq], xs[(4 * ks + kq) * 16 + l15], y, 0, 0, 0);
#pragma unroll
                for (int rg = 0; rg < 4; ++rg) Tl[(16 * I + 4 * kq + rg) * 64 + 16 * J + l15] = -y[rg];
            }
            __syncthreads();
        }
        { bf16_t* Tg = (bf16_t*)(rec + GR_T);
#pragma unroll
          for (int k = 0; k < 16; ++k) { const int e = tid + 512 * k, m2 = e >> 12, o = e & 4095, i = o >> 6, c = o & 63;
              const float v = (m2 ? kf : qf)[4096 + o];
              if (m2 == 0) Tg[i * 64 + c] = f2bf(v); else Tg[4096 + (63 - i) * 64 + (63 - c)] = f2bf(v); } }
        __syncthreads();
    }
}

__device__ __forceinline__ void ph_gdn_scan(const Frame& F) {
    LAS unsigned char* L = F.lds;
    LAS unsigned char* KNI = L;
    LAS unsigned char* QNI = L + 16896;
    LAS unsigned char* VTI = L + 33792;
    LAS unsigned char* KTI = L + 51200;
    LAS unsigned char* TI = L + 68608;
    LAS unsigned char* QKI = L + 77312;
    LAS float* SC = (LAS float*)(L + 86016);
    const int l31 = F.lane & 31, hh = F.lane >> 5, w = F.wave;
    for (int it = F.bid; it < 64; it += F.G) {
        const int b = it >> 3, h = (it >> 1) & 3, dir = it & 1;
        bf16_t* O = dir ? (bf16_t*)(F.ws + WS_WMOE) : (bf16_t*)(F.ws + WS_GOF);
        f32x16 S0, S1, S2, S3;
#pragma unroll
        for (int r = 0; r < 16; ++r) { S0[r] = 0.f; S1[r] = 0.f; S2[r] = 0.f; S3[r] = 0.f; }
        u32x4 pre[16]; float psc = 0.f;
        const int t4base = F.tid - 256;
        auto ckof = [&](int n) -> int { return dir ? (n < 4 ? 3 - n : 135 - n) : n; };
        auto fetch = [&](int n, int t4) { const unsigned char* rec = F.ws + WS_GREC + (size_t)((b * 4 + h) * 132 + ckof(n)) * GR_BYTES;
#pragma unroll
            for (int k = 0; k < 4; ++k) pre[k] = *(const u32x4*)(rec + (size_t)((t4 & 63) * 16 + (t4 >> 6) + 4 * k) * 16);
#pragma unroll
            for (int k = 4; k < 12; ++k) pre[k] = *(const u32x4*)(rec + (size_t)(t4 + 256 * k) * 16);
#pragma unroll
            for (int k = 0; k < 2; ++k) { pre[12 + k] = *(const u32x4*)(rec + GR_T + dir * 8192 + (t4 + 256 * k) * 16); pre[14 + k] = *(const u32x4*)(rec + GR_QK + dir * 8192 + (t4 + 256 * k) * 16); }
            if (t4 < 193) psc = ((const float*)(rec + GR_SC))[t4 < 192 ? dir * 192 + t4 : 384 + dir]; };
        if (w >= 4) {
            fetch(0, t4base);
            for (int n = 0; n < 132; ++n) {
                int t4 = t4base; asm volatile("" : "+v"(t4));
                __syncthreads();
#pragma unroll
                for (int k = 0; k < 4; ++k) { const int row = t4 & 63, part = (t4 >> 6) + 4 * k; st2x64(KNI + row * 264 + part * 16, pre[k]);
                    LAS unsigned short* kt = (LAS unsigned short*)(KTI + (part * 8) * 136 + row * 2); const u32x4 v = pre[k];
                    kt[0 * 68] = (unsigned short)(v.x & 0xffffu); kt[1 * 68] = (unsigned short)(v.x >> 16); kt[2 * 68] = (unsigned short)(v.y & 0xffffu); kt[3 * 68] = (unsigned short)(v.y >> 16);
                    kt[4 * 68] = (unsigned short)(v.z & 0xffffu); kt[5 * 68] = (unsigned short)(v.z >> 16); kt[6 * 68] = (unsigned short)(v.w & 0xffffu); kt[7 * 68] = (unsigned short)(v.w >> 16); }
#pragma unroll
                for (int k = 4; k < 8; ++k) { const int c = t4 + 256 * (k - 4), row = c >> 4, part = c & 15; st2x64(QNI + row * 264 + part * 16, pre[k]); }
#pragma unroll
                for (int k = 8; k < 12; ++k) { const int c = t4 + 256 * (k - 8), row = c >> 3, part = c & 7; st2x64(VTI + row * 136 + part * 16, pre[k]); }
#pragma unroll
                for (int k = 0; k < 2; ++k) { const int c = t4 + 256 * k, row = c >> 3, part = c & 7; st2x64(TI + row * 136 + part * 16, pre[12 + k]); st2x64(QKI + row * 136 + part * 16, pre[14 + k]); }
                if (t4 < 193) SC[t4] = psc;
                __syncthreads();
                if (n + 1 < 132) fetch(n + 1, t4);
            }
        } else
        for (int n = 0; n < 132; ++n) {
            __syncthreads();
            __syncthreads();
            {
                size_t rbase; int len, p0; gdn_unit_geom(b, ckof(n), rbase, len, p0);
                const float alast = SC[192];
                f32x16 P0, P1;
#pragma unroll
                for (int r = 0; r < 16; ++r) { P0[r] = 0.f; P1[r] = 0.f; }
#pragma unroll
                for (int hq = 0; hq < 2; ++hq) { s16x8 fa[4], fb[4];
#pragma unroll
                  for (int q4 = 0; q4 < 4; ++q4) { const int q = hq * 4 + q4; const int co = (32 * (q >> 1) + 16 * (q & 1) + 4 * hh) * 2; fa[q4] = ld2x64(KNI + l31 * 264 + co); fb[q4] = ld2x64(KNI + (32 + l31) * 264 + co); }
#pragma unroll
                  for (int q4 = 0; q4 < 4; ++q4) { const int q = hq * 4 + q4; const int r = q >> 1; const s16x8 sb = pack8(r == 0 ? S0 : (r == 1 ? S1 : (r == 2 ? S2 : S3)), 8 * (q & 1));
                      P0 = __builtin_amdgcn_mfma_f32_32x32x16_bf16(fa[q4], sb, P0, 0, 0, 0); P1 = __builtin_amdgcn_mfma_f32_32x32x16_bf16(fb[q4], sb, P1, 0, 0, 0); } }
#pragma unroll
                for (int gq = 0; gq < 4; ++gq) {
#pragma unroll
                    for (int ib = 0; ib < 2; ++ib) { const int i0 = 32 * ib + 8 * gq + 4 * hh;
                        const f32x4 be = *(const LAS f32x4*)(SC + i0), eg = *(const LAS f32x4*)(SC + 64 + i0);
                        const u32x2 vv = *(const LAS u32x2*)(VTI + (32 * w + l31) * 136 + i0 * 2);
                        const float v0 = lo2f(vv.x), v1 = hi2f(vv.x), v2 = lo2f(vv.y), v3 = hi2f(vv.y);
                        if (ib == 0) { P0[4 * gq + 0] = be[0] * (v0 - eg[0] * P0[4 * gq + 0]); P0[4 * gq + 1] = be[1] * (v1 - eg[1] * P0[4 * gq + 1]); P0[4 * gq + 2] = be[2] * (v2 - eg[2] * P0[4 * gq + 2]); P0[4 * gq + 3] = be[3] * (v3 - eg[3] * P0[4 * gq + 3]); }
                        else         { P1[4 * gq + 0] = be[0] * (v0 - eg[0] * P1[4 * gq + 0]); P1[4 * gq + 1] = be[1] * (v1 - eg[1] * P1[4 * gq + 1]); P1[4 * gq + 2] = be[2] * (v2 - eg[2] * P1[4 * gq + 2]); P1[4 * gq + 3] = be[3] * (v3 - eg[3] * P1[4 * gq + 3]); } } }
                f32x16 V0, V1;
#pragma unroll
                for (int r = 0; r < 16; ++r) { V0[r] = 0.f; V1[r] = 0.f; }
#pragma unroll
                for (int jb = 0; jb < 2; ++jb)
#pragma unroll
                    for (int s = 0; s < 2; ++s) { const s16x8 pb = pack8(jb == 0 ? P0 : P1, 8 * s); const int co = (32 * jb + 16 * s + 4 * hh) * 2;
                        V0 = __builtin_amdgcn_mfma_f32_32x32x16_bf16(ld2x64(TI + l31 * 136 + co), pb, V0, 0, 0, 0);
                        V1 = __builtin_amdgcn_mfma_f32_32x32x16_bf16(ld2x64(TI + (32 + l31) * 136 + co), pb, V1, 0, 0, 0); }
                f32x16 T0, T1;
#pragma unroll
                for (int r = 0; r < 16; ++r) { T0[r] = 0.f; T1[r] = 0.f; }
#pragma unroll
                for (int r = 0; r < 4; ++r)
#pragma unroll
                    for (int s = 0; s < 2; ++s) { const s16x8 sa = pack8(r == 0 ? S0 : (r == 1 ? S1 : (r == 2 ? S2 : S3)), 8 * s);
                        const int co = (32 * r + 16 * s + 4 * hh) * 2;
                        T0 = __builtin_amdgcn_mfma_f32_32x32x16_bf16(sa, ld2x64(QNI + l31 * 264 + co), T0, 0, 0, 0);
                        T1 = __builtin_amdgcn_mfma_f32_32x32x16_bf16(sa, ld2x64(QNI + (32 + l31) * 264 + co), T1, 0, 0, 0); }
                { const float e0 = SC[64 + l31], e1 = SC[64 + 32 + l31];
#pragma unroll
                  for (int r = 0; r < 16; ++r) { T0[r] *= e0; T1[r] *= e1; } }
#pragma unroll
                for (int jb = 0; jb < 2; ++jb)
#pragma unroll
                    for (int s = 0; s < 2; ++s) { const s16x8 va = pack8(jb == 0 ? V0 : V1, 8 * s); const int co = (32 * jb + 16 * s + 4 * hh) * 2;
                        T0 = __builtin_amdgcn_mfma_f32_32x32x16_bf16(va, ld2x64(QKI + l31 * 136 + co), T0, 0, 0, 0);
                        T1 = __builtin_amdgcn_mfma_f32_32x32x16_bf16(va, ld2x64(QKI + (32 + l31) * 136 + co), T1, 0, 0, 0); }
                { bf16_t* o0 = O + (rbase + p0 + l31) * 512 + h * 128 + 32 * w + 4 * hh; bf16_t* o1 = o0 + (size_t)32 * 512;
#pragma unroll
                  for (int gq = 0; gq < 4; ++gq) { u32x2 x; x.x = pack2(T0[4 * gq], T0[4 * gq + 1]); x.y = pack2(T0[4 * gq + 2], T0[4 * gq + 3]); *(u32x2*)(o0 + gq * 8) = x;
                      x.x = pack2(T1[4 * gq], T1[4 * gq + 1]); x.y = pack2(T1[4 * gq + 2], T1[4 * gq + 3]); *(u32x2*)(o1 + gq * 8) = x; } }
#pragma unroll
                for (int gq = 0; gq < 4; ++gq) { const f32x4 c0 = *(const LAS f32x4*)(SC + 128 + 8 * gq + 4 * hh), c1 = *(const LAS f32x4*)(SC + 128 + 32 + 8 * gq + 4 * hh);
#pragma unroll
                    for (int q = 0; q < 4; ++q) { V0[4 * gq + q] *= c0[q]; V1[4 * gq + q] *= c1[q]; } }
#pragma unroll
                for (int r = 0; r < 16; ++r) { S0[r] *= alast; S1[r] *= alast; S2[r] *= alast; S3[r] *= alast; }
#pragma unroll
                for (int hq = 0; hq < 2; ++hq) { s16x8 fk[8];
#pragma unroll
                  for (int q2 = 0; q2 < 2; ++q2) { const int q = hq * 2 + q2; const int co = (32 * (q >> 1) + 16 * (q & 1) + 4 * hh) * 2;
#pragma unroll
                      for (int r = 0; r < 4; ++r) fk[q2 * 4 + r] = ld2x64(KTI + (32 * r + l31) * 136 + co); }
#pragma unroll
                  for (int q2 = 0; q2 < 2; ++q2) { const int q = hq * 2 + q2; const s16x8 vb = pack8((q >> 1) == 0 ? V0 : V1, 8 * (q & 1));
                      S0 = __builtin_amdgcn_mfma_f32_32x32x16_bf16(fk[q2 * 4 + 0], vb, S0, 0, 0, 0); S1 = __builtin_amdgcn_mfma_f32_32x32x16_bf16(fk[q2 * 4 + 1], vb, S1, 0, 0, 0);
                      S2 = __builtin_amdgcn_mfma_f32_32x32x16_bf16(fk[q2 * 4 + 2], vb, S2, 0, 0, 0); S3 = __builtin_amdgcn_mfma_f32_32x32x16_bf16(fk[q2 * 4 + 3], vb, S3, 0, 0, 0); } }
            }
        }
        __syncthreads();
    }
}

#ifndef FAST_ATTN
#define FAST_ATTN 2
#endif
constexpr int NPHASES = 27;
__global__ void __launch_bounds__(NTH, 2) fwd(Params P) {
    extern __shared__ __attribute__((aligned(16))) unsigned char lds_raw[];
    Frame F; F.P = &P; F.ws = P.ws; F.lds = (LAS unsigned char*)lds_raw;
    F.tid = threadIdx.x; F.lane = F.tid & 63; F.wave = __builtin_amdgcn_readfirstlane(F.tid >> 6); F.G = gridDim.x; F.bid = blockIdx.x;
    F.mod = (float*)(P.ws + WS_CTRL + C_MOD); F.ctrl = (unsigned*)(P.ws + WS_CTRL);
    volatile LAS unsigned* xbw = (volatile LAS unsigned*)(F.lds + LDS_BYTES - 16);
    if (F.tid < 4) xbw[F.tid] = 0u;
    __syncthreads();
    const int lo = P.ph_lo, hi = P.ph_hi;
    const bool single = (hi - lo) > 1;
    XcdBarrier bar; bar.bar = F.ctrl; bar.x = 0; bar.st = xbw;
    if (single) bar = xcd_barrier_post(F.ctrl, xbw);
#ifndef PH_MASK
#define PH_MASK 0xffffffffu
#endif
#ifndef PROBE_MASK
#define PROBE_MASK 0u
#endif
    unsigned long long t_acc = 0ull, t_0 = 0ull;
#define TIC(k) do { if ((PROBE_MASK >> (k)) & 1u) t_0 = __builtin_amdgcn_s_memrealtime(); } while (0)
#define TOC(k) do { if ((PROBE_MASK >> (k)) & 1u) t_acc += __builtin_amdgcn_s_memrealtime() - t_0; } while (0)
#define IN(k) (((PH_MASK >> (k)) & 1u) && lo <= (k) && (k) < hi)
#define SEAM(k) do { if (IN(k) && IN((k) + 1)) xcd_barrier(bar); } while (0)
#ifndef DUP_MASK
#define DUP_MASK 0u
#endif
#define DUP(k) ((DUP_MASK >> (k)) & 1u)
    bf16_t* wsm = (bf16_t*)(P.ws + WS_WSM);
    bf16_t* ACT = (bf16_t*)(P.ws + WS_ACT); bf16_t* PX = (bf16_t*)(P.ws + WS_PX);
    float* XC = (float*)(P.ws + WS_XC);

    TIC(0);
    if (IN(0)) { ph_prologue(F); if (DUP(0)) { __syncthreads(); conv_moe_weights(F, 0, F.bid, F.G); } xcd_barrier(bar); mod_reduce(F); } SEAM(0);
    TOC(0);
    TIC(1);
    if (IN(1)) { ph_rownorm(F, 0, TT, P.in[I_X], P.in[I_CTX], P.in[I_NMIX], 0); if (DUP(1)) ph_rownorm(F, 0, TT, P.in[I_X], P.in[I_CTX], P.in[I_NMIX], 0); } SEAM(1);
    TOC(1);
    TIC(2);
    if (IN(2)) { EpiStoreBf16P E{PX, EVEN_IN, 1024}; gemm_dense(F, ACT, wsm + W_EIN / 2, TT, EVEN_IN, 1024, E); if (DUP(2)) gemm_dense(F, ACT, wsm + W_EIN / 2, TT, EVEN_IN, 1024, E); } SEAM(2);
    TOC(2);
    TIC(3);
    if (IN(3)) { ph_gmlp_mfma(F); __syncthreads(); }
    TOC(3);
#ifndef CHUNKED_GLA
#define CHUNKED_GLA 1
#endif
    TIC(4);
    if (IN(4)) { if (CHUNKED_GLA) ph_gla_p1(F); else ph_gla(F); } SEAM(4);
    TOC(4);
    TIC(5);
    if (IN(5)) { if (CHUNKED_GLA) { ph_gla_p2(F); xcd_barrier(bar); ph_gla_p3(F); } else ph_merge(F, 0); } SEAM(5);
    TOC(5);
    TIC(6);
    if (IN(6)) { EpiResidual E{P.in[I_X], P.in[I_CTX], P.out, XC, F.mod, 2, (float*)(P.ws + WS_R2 + R2_RSS)}; gemm_dense(F, ACT, wsm + W_EOUT / 2, TT, 1024, 1024, E); } SEAM(6);
    TOC(6);
    TIC(7);
    if (IN(7)) { ph_router(F, 0, TT, P.out, XC, P.in[I_NFFN], 3); } SEAM(7);
    TOC(7);
    TIC(8);
    if (IN(8)) { ph_dispatch(F, 0, TT); } SEAM(8);
    TOC(8);
    TIC(9);
    if (IN(9)) { ph_moe_gemm1(F, 0); if (DUP(9)) ph_moe_gemm1(F, 0); } SEAM(9);
    TOC(9);
    TIC(10);
    if (IN(10)) { ph_moe_gemm2y(F, 0); } SEAM(10);
    TOC(10);
    TIC(11);
    if (IN(11)) { }
    TOC(11);
    TIC(12);
    if (IN(12)) { ph_moe_combine<true>(F, 0, TT, 1, P.in[I_NMIX] + 1024);
#ifdef DBG_ZERO
        { u32x4 z = {0u, 0u, 0u, 0u}; u32x4* p = (u32x4*)(P.ws + WS_GREC); const size_t n = (size_t)(990 - 585) * MiB / 16;
          for (size_t i = (size_t)gtid(F); i < n; i += (size_t)F.G * NTH) p[i] = z;
          u32x4* q = (u32x4*)(P.ws + WS_WMOE); const size_t m = (size_t)66 * MiB / 16;
          for (size_t i = (size_t)gtid(F); i < m; i += (size_t)F.G * NTH) q[i] = z; }
#endif
    } SEAM(12);
    TOC(12);
    TIC(13);
    if (IN(13)) { EpiStoreBf16P E{PX, ODD_PAD, 0}; gemm_dense(F, ACT, wsm + W_OIN / 2, TT, ODD_PAD, 1024, E); if (DUP(13)) gemm_dense(F, ACT, wsm + W_OIN / 2, TT, ODD_PAD, 1024, E); } SEAM(13);
    TOC(13);
#ifndef CHUNKED_GDN
#define CHUNKED_GDN 1
#endif
    TIC(14);
    if (IN(14)) { if (CHUNKED_GDN) ph_gdn_prep(F); } SEAM(14);
    TOC(14);
    TIC(15);
    if (IN(15)) { if (CHUNKED_GDN) ph_gdn_scan(F); else ph_gdn(F); } SEAM(15);
    TOC(15);
    TIC(16);
    if (IN(16)) { ph_merge(F, 1); ph_mla_norm(F); } SEAM(16);
    TOC(16);
    TIC(17);
    if (IN(17)) { }
    TOC(17);
    TIC(18);
    if (IN(18)) { const bf16_t* cqn = (const bf16_t*)(P.ws + WS_R2 + R2_CQN);
                  EpiStoreBf16P E1{(bf16_t*)(P.ws + WS_WMOE), 768, 0}; gemm_dense(F, cqn, wsm + W_WQ / 2, TL, 768, 256, E1);
                  EpiStoreBf16P E2{(bf16_t*)(P.ws + WS_PX + PX_KVRAW), 1024, 0}; gemm_dense(F, cqn + (size_t)TL * 256, wsm + W_WKV / 2, TT, 1024, 256, E2); } SEAM(18);
    TOC(18);
    TIC(19);
    if (IN(19)) { ph_mla_final(F); } SEAM(19);
    TOC(19);
    TIC(20);
    if (IN(20)) { if (FAST_ATTN == 2) ph_attn2(F); else if (FAST_ATTN) ph_attn(F); else ph_attn_naive(F); if (DUP(20)) { __syncthreads(); ph_attn2(F); } } SEAM(20);
    TOC(20);
    TIC(21);
    if (IN(21)) { EpiResidual E{P.out, P.out, P.out, P.out, F.mod + 9 * 6144, 2, (float*)(P.ws + WS_R2 + R2_RSS)}; gemm_dense(F, ACT, wsm + W_OOUT / 2, TL, 1024, 1024, E); } SEAM(21);
    TOC(21);
    TIC(22);
    if (IN(22)) { ph_router(F, 1, TL, P.out, XC, P.in[I_NFFN] + 1024, 3); conv_moe_weights(F, 1, F.bid, F.G); } SEAM(22);
    TOC(22);
    TIC(23);
    if (IN(23)) { ph_dispatch(F, 1, TL); } SEAM(23);
    TOC(23);
    TIC(24);
    if (IN(24)) { ph_moe_gemm1(F, 1); if (DUP(24)) ph_moe_gemm1(F, 1); } SEAM(24);
    TOC(24);
    TIC(25);
    if (IN(25)) { ph_moe_gemm2y(F, 1); } SEAM(25);
    TOC(25);
    TIC(26);
    if (IN(26)) { ph_moe_combine<false>(F, 1, TL, 1, nullptr); }
    TOC(26);
    if (PROBE_MASK) { const unsigned long long te = __builtin_amdgcn_s_memrealtime() + 10ull * t_acc; while (__builtin_amdgcn_s_memrealtime() < te) __builtin_amdgcn_s_sleep(8); }
#undef IN
#undef SEAM
}

#ifndef N_LAUNCH_MODE
#define N_LAUNCH_MODE 1
#endif
extern "C" void kernel_launch(void* const* d_in, const int* in_sizes, int n_in, void* d_out, int out_size, void* d_ws, size_t ws_size, hipStream_t stream) {
    static int grid = 0;
    if (grid == 0) {
        if (n_in != 34 || out_size != TL * DM || ws_size < WS_END) { fprintf(stderr, "kernel_launch: unexpected shapes (n_in %d out %d ws %zu)\n", n_in, out_size, ws_size); grid = -1; return; }
        int dev = 0, cus = 0;
        if (hipGetDevice(&dev) != hipSuccess || hipDeviceGetAttribute(&cus, hipDeviceAttributeMultiprocessorCount, dev) != hipSuccess) { grid = -1; return; }
        if (hipFuncSetAttribute((const void*)fwd, hipFuncAttributeMaxDynamicSharedMemorySize, LDS_BYTES) != hipSuccess) { fprintf(stderr, "kernel_launch: hipFuncSetAttribute failed\n"); grid = -1; return; }
        int per_cu = 0;
        (void)hipOccupancyMaxActiveBlocksPerMultiprocessor(&per_cu, (const void*)fwd, NTH, LDS_BYTES);
        (void)hipGetLastError();
        if (per_cu < 1) fprintf(stderr, "kernel_launch: occupancy query says %d\n", per_cu);
        grid = cus;
    }
    if (grid < 0) return;
    (void)hipMemsetAsync(d_ws, 0, MiB, stream);
    Params p{};
    for (int i = 0; i < 34; ++i) p.in[i] = (const float*)d_in[i];
    p.out = (float*)d_out; p.ws = (unsigned char*)d_ws;
#if N_LAUNCH_MODE == 1
    p.ph_lo = 0; p.ph_hi = NPHASES;
    hipLaunchKernelGGL(fwd, dim3(grid), dim3(NTH), LDS_BYTES, stream, p);
#else
    for (int k = 0; k < NPHASES; ++k) { p.ph_lo = k; p.ph_hi = k + 1; hipLaunchKernelGGL(fwd, dim3(grid), dim3(NTH), LDS_BYTES, stream, p); }
#endif
}
```

```cpp
#include <hip/hip_runtime.h>
#include <cstdint>
#include <cstdio>

#define LAS __attribute__((address_space(3)))
typedef unsigned short bf16_t;
typedef float f32x4 __attribute__((ext_vector_type(4)));
typedef unsigned u32x4 __attribute__((ext_vector_type(4)));
typedef unsigned u32x2 __attribute__((ext_vector_type(2)));
typedef float f32x16 __attribute__((ext_vector_type(16)));
typedef short s16x8 __attribute__((ext_vector_type(8)));

constexpr int NB = 8, SEQ = 8192, CTXL = 256, DM = 1024;
constexpr int TL = NB * SEQ, TC = NB * CTXL, TT = TL + TC;
constexpr int EVEN_IN = 3584, ODD_IN = 2480, ODD_PAD = 2560;
constexpr int NTH = 512;
constexpr int LDS_BYTES = 144 * 1024;
constexpr int MAXSLOTS = 151552;
constexpr int MAXTILES = 592;
constexpr float EPS = 1e-6f;

constexpr size_t MiB = 1048576;
constexpr size_t WS_CTRL = 0;
constexpr size_t C_MOE = 16384;
constexpr size_t C_MOD = 65536;
constexpr size_t C_LBT = 32768;
constexpr size_t WS_XC = 1 * MiB;
constexpr size_t WS_WSM = 9 * MiB;
constexpr size_t W_EIN = 0, W_EOUT = 7340032, W_OIN = 9437184, W_OOUT = 14680064, W_WQ = 16777216, W_WKV = 17170432, W_RT = 17694720;
constexpr size_t WS_WMOE = 27 * MiB;
constexpr size_t WS_ACT = 123 * MiB;
constexpr size_t WS_PX = 255 * MiB;
constexpr size_t WS_R2 = 717 * MiB;
constexpr size_t WS_END = 1024 * MiB;
constexpr size_t R2_OF0 = 0, R2_OB0 = 66 * MiB;
constexpr size_t R2_H = 0, R2_STOK = 148 * MiB, R2_SW = 149 * MiB, R2_TOKE = 150 * MiB, R2_TOKW = 151 * MiB, R2_TILEE = 152 * MiB, R2_TSLOT = 153 * MiB;
constexpr size_t R2_K = 0, R2_V = 99 * MiB, R2_OF1 = 165 * MiB, R2_OB1 = 231 * MiB;
constexpr size_t PX_KVRAW = 346030080;
constexpr size_t WS_GREC = 585 * MiB;
constexpr size_t WS_W2L1 = 990 * MiB;
constexpr size_t WS_GOF = 924 * MiB;
constexpr size_t R2_CQN = 0;
constexpr size_t R2_RSS = 160 * MiB;
constexpr size_t R2_MODP = 200 * MiB;

struct Params {
    const float* in[34];
    float* out;
    unsigned char* ws;
    int ph_lo, ph_hi;
};
enum { I_X = 0, I_C, I_CTX, I_CCTX, I_ADAW, I_ADAB, I_NMIX, I_NFFN, I_EWIN, I_EWOUT, I_GNW, I_GWS, I_GBS, I_LB, I_HNW,
       I_OWIN, I_OWOUT, I_CONVW, I_ALOG, I_DTB, I_GDNNW, I_QNW, I_WQ, I_KVNW, I_WKV, I_QKQ, I_QKK, I_RGW, I_RGB, I_REW, I_REB, I_MG, I_MU, I_MD };

__device__ __forceinline__ float bf2f(bf16_t b) { return __uint_as_float(((unsigned)b) << 16); }

typedef __bf16 bf16_2v __attribute__((ext_vector_type(2)));
typedef float f32_2v __attribute__((ext_vector_type(2)));
__device__ __forceinline__ unsigned pack2(float a, float b) { f32_2v v = {a, b}; bf16_2v r = __builtin_convertvector(v, bf16_2v); return __builtin_bit_cast(unsigned, r); }
__device__ __forceinline__ bf16_t f2bf(float f) { return (bf16_t)(pack2(f, 0.f) & 0xffffu); }
__device__ __forceinline__ float lo2f(unsigned u) { return __uint_as_float(u << 16); }
__device__ __forceinline__ float hi2f(unsigned u) { return __uint_as_float(u & 0xffff0000u); }
template <int CTRL> __device__ __forceinline__ float dppf(float x) { return __builtin_bit_cast(float, __builtin_amdgcn_mov_dpp(__builtin_bit_cast(int, x), CTRL, 0xf, 0xf, true)); }
__device__ __forceinline__ float sum8(float v) { v += dppf<0xB1>(v); v += dppf<0x4E>(v); v += dppf<0x141>(v); return v; }
__device__ __forceinline__ float sum16(float v) { v = sum8(v); v += dppf<0x128>(v); return v; }
__device__ __forceinline__ float wave_sum(float v) {
    v = sum16(v);
    auto s = __builtin_amdgcn_permlane16_swap(__float_as_uint(v), __float_as_uint(v), false, false);
    v = __uint_as_float(s[0]) + __uint_as_float(s[1]);
    auto t = __builtin_amdgcn_permlane32_swap(__float_as_uint(v), __float_as_uint(v), false, false);
    return __uint_as_float(t[0]) + __uint_as_float(t[1]);
}
__device__ __forceinline__ s16x8 pack8(const f32x16& x, int s8) {
    u32x4 p; p.x = pack2(x[s8 + 0], x[s8 + 1]); p.y = pack2(x[s8 + 2], x[s8 + 3]); p.z = pack2(x[s8 + 4], x[s8 + 5]); p.w = pack2(x[s8 + 6], x[s8 + 7]);
    return __builtin_bit_cast(s16x8, p);
}
__device__ __forceinline__ unsigned lds_inc(LAS unsigned* p) { return __hip_atomic_fetch_add(p, 1u, __ATOMIC_RELAXED, __HIP_MEMORY_SCOPE_WORKGROUP); }
__device__ __forceinline__ float sigmoid_f(float x) { return __builtin_amdgcn_rcpf(1.f + __expf(-x)); }
__device__ __forceinline__ float silu_f(float x) { return x * __builtin_amdgcn_rcpf(1.f + __expf(-x)); }
__device__ __forceinline__ float gelu_tanh_f(float x) {
    const float u = 0.7978845608028654f * (x + 0.044715f * x * x * x);
    const float t = 1.f - 2.f * __builtin_amdgcn_rcpf(__expf(2.f * u) + 1.f);
    return 0.5f * x * (1.f + t);
}
__device__ __forceinline__ float softplus_f(float x) { return x > 20.f ? x : __logf(1.f + __expf(x)); }

#define XB_TMO      128
#define XB_XCNT(j)  (256  + 64 * (j))
#define XB_XSUB(j)  (1280 + 64 * (j))
#define XB_XGEN(j)  (2304 + 64 * (j))
#define XB_TOP      3328
#define XB_TOPGEN   3392
#define XCD_BAR_WORDS 3456
#define XB_SPIN_CAP (1u << 24)
__device__ __forceinline__ unsigned xb_ld(unsigned* p)              { return __hip_atomic_load(p, __ATOMIC_RELAXED, __HIP_MEMORY_SCOPE_AGENT); }
__device__ __forceinline__ unsigned xb_add(unsigned* p, unsigned v) { return __hip_atomic_fetch_add(p, v, __ATOMIC_RELAXED, __HIP_MEMORY_SCOPE_AGENT); }
__device__ __forceinline__ unsigned xb_xcc_id() { return (unsigned)__builtin_amdgcn_s_getreg((3 << 11) | 20) & 0xFu; }
#define XB_SPIN(cond, bar) do { unsigned _sp = 0; while (cond) { __builtin_amdgcn_s_sleep(1); \
    if ((++_sp & 255u) == 0u) { if (xb_ld(&(bar)[XB_TMO])) break; if (_sp > XB_SPIN_CAP) { atomicAdd(&(bar)[XB_TMO], 1u); break; } } } } while (0)
struct XcdBarrier { unsigned* bar; unsigned x; volatile LAS unsigned* st; };
__device__ __forceinline__ XcdBarrier xcd_barrier_post(unsigned* bar, volatile LAS unsigned* st) {
    XcdBarrier b; b.bar = bar; b.x = xb_xcc_id(); b.st = st;
    if (threadIdx.x == 0) (void)xb_add(&bar[XB_XCNT(b.x)], 1u);
    return b;
}
__device__ __forceinline__ void xcd_barrier_complete(unsigned* bar, unsigned x, unsigned& nloc, unsigned& nx) {
    const unsigned G = gridDim.x * gridDim.y * gridDim.z;
    unsigned sum, cnt, mine, sp = 0u;
    for (;;) {
        sum = 0u; cnt = 0u; mine = 0u;
#pragma unroll
        for (unsigned j = 0; j < 16; ++j) { const unsigned c = xb_ld(&bar[XB_XCNT(j)]); sum += c; cnt += (c > 0u) ? 1u : 0u; mine = (j == x) ? c : mine; }
        if (sum == G) break;
        __builtin_amdgcn_s_sleep(1);
        if ((++sp & 255u) == 0u) { if (xb_ld(&bar[XB_TMO])) break; if (sp > XB_SPIN_CAP) { atomicAdd(&bar[XB_TMO], 1u); break; } }
    }
    nloc = mine > 0u ? mine : 1u; nx = cnt > 0u ? cnt : 1u;
}
__device__ __forceinline__ void xcd_barrier(const XcdBarrier& b) {
    asm volatile("s_waitcnt vmcnt(0)" ::: "memory");
    __syncthreads();
    if (threadIdx.x == 0) {
        unsigned* bar = b.bar;
        __builtin_amdgcn_s_waitcnt(0);
        unsigned nloc = b.st[0], nx = b.st[1];
        if (nloc == 0u) { xcd_barrier_complete(bar, b.x, nloc, nx); b.st[0] = nloc; b.st[1] = nx; }
        const unsigned old = xb_add(&bar[XB_XSUB(b.x)], 1u);
        const unsigned gen = old / nloc;
        if (old + 1u == (gen + 1u) * nloc) {
            __builtin_amdgcn_fence(__ATOMIC_RELEASE, "agent");
            asm volatile("s_waitcnt vmcnt(0)" ::: "memory");
            const unsigned og = xb_add(&bar[XB_TOP], 1u);
            const unsigned tg = og / nx;
            if (og + 1u == (tg + 1u) * nx) xb_add(&bar[XB_TOPGEN], 1u);
            else XB_SPIN(xb_ld(&bar[XB_TOPGEN]) == tg, bar);
            __builtin_amdgcn_fence(__ATOMIC_ACQUIRE, "agent");
            xb_add(&bar[XB_XGEN(b.x)], 1u);
            asm volatile("s_waitcnt vmcnt(0)" ::: "memory");
        } else {
            XB_SPIN(xb_ld(&bar[XB_XGEN(b.x)]) == gen, bar);
            __builtin_amdgcn_fence(__ATOMIC_ACQUIRE, "agent");
            asm volatile("s_waitcnt vmcnt(0)" ::: "memory");
        }
    }
    __syncthreads();
}

struct Frame {
    const Params* P;
    unsigned char* ws;
    LAS unsigned char* lds;
    int tid, lane, wave, G, bid;
    float* mod;
    unsigned* ctrl;
};
__device__ __forceinline__ int gtid(const Frame& F) { int t = F.tid; asm volatile("" : "+v"(t)); return F.bid * NTH + t; }
__device__ __forceinline__ const float* modp(const Frame& F, int layer, int b, int which) { return F.mod + ((size_t)(layer * 9 + b) * 6 + which) * 1024; }

__device__ __forceinline__ void conv_tile(const Frame& F, const float* src, int K, int N, int lds_, bf16_t* dst, int ldd, int kt, int nt, int rm_mode) {
    LAS float* tile = (LAS float*)F.lds;
    const int t = F.tid;
    {
        const int c = t & 63, r0 = t >> 6;
#pragma unroll
        for (int i = 0; i < 8; ++i) { const int rr = r0 + i * 8, k = kt * 64 + rr, n = nt * 64 + c;
            tile[rr * 65 + c] = (k < K && n < N) ? src[(size_t)k * lds_ + n] : 0.f; }
    }
    __syncthreads();
    {
        const int nl = t >> 3, kc = (t & 7) * 8, n = nt * 64 + nl;
        int row = n;
        if (rm_mode == 1) row = (n >> 7) * 256 + (n & 127);
        else if (rm_mode == 2) row = (n >> 7) * 256 + 128 + (n & 127);
        float v[8];
#pragma unroll
        for (int j = 0; j < 8; ++j) v[j] = tile[(kc + j) * 65 + nl];
        u32x4 w; w.x = pack2(v[0], v[1]); w.y = pack2(v[2], v[3]); w.z = pack2(v[4], v[5]); w.w = pack2(v[6], v[7]);
        *(u32x4*)(dst + (size_t)row * ldd + kt * 64 + kc) = w;
    }
    __syncthreads();
}
__device__ __forceinline__ void conv_tile4(const Frame& F, const float* src, int lds_, bf16_t* dst, int ldd, int kt, int ng, int rm_mode) {
    LAS float* tile = (LAS float*)F.lds;
    const int t = F.tid;
    { const int c = t & 255, r0 = t >> 8; const float* sp = src + (size_t)(kt * 64 + r0) * lds_ + ng * 256 + c;
      float v[32];
#pragma unroll
      for (int i = 0; i < 32; ++i) v[i] = sp[(size_t)(2 * i) * lds_];
#pragma unroll
      for (int i = 0; i < 32; ++i) tile[(r0 + 2 * i) * 257 + c] = v[i]; }
    __syncthreads();
#pragma unroll
    for (int q = 0; q < 4; ++q) { const int ch = t + 512 * q, nl = ch >> 3, kc = (ch & 7) * 8, n = ng * 256 + nl;
        int row = n;
        if (rm_mode == 1) row = (n >> 7) * 256 + (n & 127);
        else if (rm_mode == 2) row = (n >> 7) * 256 + 128 + (n & 127);
        float v[8];
#pragma unroll
        for (int j = 0; j < 8; ++j) v[j] = tile[(kc + j) * 257 + nl];
        u32x4 w; w.x = pack2(v[0], v[1]); w.y = pack2(v[2], v[3]); w.z = pack2(v[4], v[5]); w.w = pack2(v[6], v[7]);
        *(u32x4*)(dst + (size_t)row * ldd + kt * 64 + kc) = w; }
    __syncthreads();
}
__device__ __forceinline__ void conv_moe_weights(const Frame& F, int layer, int item0, int stride, int it_lo, int it_hi) {
    const Params& P = *F.P;
    bf16_t* W1 = (bf16_t*)(F.ws + WS_WMOE); bf16_t* W2 = layer ? (bf16_t*)(F.ws + WS_W2L1) : W1 + (size_t)32 * 1024 * 1024;
    LAS float* tile = (LAS float*)F.lds;
    const int t = F.tid;
    auto geom = [&](int it, const float*& src, int& lds_, bf16_t*& dst, int& ldd, int& kt, int& ng, int& rm) {
        if (it < 2048) { const int up = it >= 1024, j = it & 1023, e = j >> 5, r = j & 31; kt = r >> 1; ng = r & 1;
            src = P.in[up ? I_MU : I_MG] + ((size_t)(layer * 32 + e)) * 1024 * 512; lds_ = 512; dst = W1 + (size_t)e * 1024 * 1024; ldd = 1024; rm = up ? 2 : 1; }
        else { const int j = it - 2048, e = j >> 5, r = j & 31; kt = r >> 2; ng = r & 3;
            src = P.in[I_MD] + ((size_t)(layer * 32 + e)) * 512 * 1024; lds_ = 1024; dst = W2 + (size_t)e * 1024 * 512; ldd = 512; rm = 0; } };
    float v[32];
    auto issue = [&](int it) { const float* src; int lds_, ldd, kt, ng, rm; bf16_t* dst; geom(it, src, lds_, dst, ldd, kt, ng, rm); (void)dst; (void)ldd; (void)rm;
        const int c = t & 255, r0 = t >> 8; const float* sp = src + (size_t)(kt * 64 + r0) * lds_ + ng * 256 + c;
#pragma unroll
        for (int i = 0; i < 32; ++i) v[i] = sp[(size_t)(2 * i) * lds_]; };
    if (it_lo + item0 < it_hi) issue(it_lo + item0);
    for (int it = it_lo + item0; it < it_hi; it += stride) {
        const float* src; int lds_, ldd, kt, ng, rm; bf16_t* dst; geom(it, src, lds_, dst, ldd, kt, ng, rm); (void)src; (void)lds_;
        { const int c = t & 255, r0 = t >> 8;
#pragma unroll
          for (int i = 0; i < 32; ++i) tile[(r0 + 2 * i) * 257 + c] = v[i]; }
        __syncthreads();
        if (it + stride < it_hi) issue(it + stride);
#pragma unroll
        for (int q = 0; q < 4; ++q) { const int ch = t + 512 * q, nl = ch >> 3, kc = (ch & 7) * 8, n = ng * 256 + nl;
            int row = n;
            if (rm == 1) row = (n >> 7) * 256 + (n & 127);
            else if (rm == 2) row = (n >> 7) * 256 + 128 + (n & 127);
            float x[8];
#pragma unroll
            for (int j = 0; j < 8; ++j) x[j] = tile[(kc + j) * 257 + nl];
            u32x4 w; w.x = pack2(x[0], x[1]); w.y = pack2(x[2], x[3]); w.z = pack2(x[4], x[5]); w.w = pack2(x[6], x[7]);
            *(u32x4*)(dst + (size_t)row * ldd + kt * 64 + kc) = w; }
        __syncthreads();
    }
}
__device__ __forceinline__ void mod_reduce(const Frame& F) {
    const float* mp = (const float*)(F.ws + WS_R2 + R2_MODP);
    for (int i = gtid(F); i < 18 * 6144; i += F.G * NTH) { float a = F.P->in[I_ADAB][(i / (9 * 6144)) * 6144 + (i % 6144)];
#pragma unroll
        for (int kp = 0; kp < 8; ++kp) a += mp[(size_t)kp * 18 * 6144 + i];
        F.mod[i] = a; }
}
__device__ __forceinline__ void ph_prologue(const Frame& F) {
    const Params& P = *F.P;
    float* modp_ = (float*)(F.ws + WS_R2 + R2_MODP);
    for (int it = F.bid; it < 192; it += F.G) {
        const int l = it / 96, r = it % 96, cb = r >> 3, kp = r & 7;
        LAS float* sc = (LAS float*)F.lds;
        for (int i = F.tid; i < 9 * 128; i += NTH) { const int rr = i >> 7, k = kp * 128 + (i & 127);
            const float cv = rr < 8 ? P.in[I_C][rr * 1024 + k] : P.in[I_CCTX][k]; sc[i] = silu_f(cv); }
        __syncthreads();
        const int n = cb * 512 + F.tid;
        float acc[9];
#pragma unroll
        for (int rr = 0; rr < 9; ++rr) acc[rr] = 0.f;
        const float* w = P.in[I_ADAW] + ((size_t)l * 1024 + kp * 128) * 6144 + n;
#pragma unroll 8
        for (int k = 0; k < 128; ++k) { const float wv = w[(size_t)k * 6144];
#pragma unroll
            for (int rr = 0; rr < 9; ++rr) acc[rr] += sc[rr * 128 + k] * wv; }
#pragma unroll
        for (int rr = 0; rr < 9; ++rr) modp_[((size_t)kp * 18 + l * 9 + rr) * 6144 + n] = acc[rr];
        __syncthreads();
    }
    if (F.bid == 0) for (int i = F.tid; i < 1024; i += NTH) { const float* lg = P.in[I_LB] + (size_t)(i >> 9) * 3 * 512 + (i & 511);
        const float a0 = lg[0], a1 = lg[512], a2 = lg[1024]; const float m = fmaxf(a0, fmaxf(a1, a2));
        const float e0 = __expf(a0 - m), e1 = __expf(a1 - m), e2 = __expf(a2 - m); ((float*)(F.ws + WS_CTRL + C_LBT))[i] = e0 / (e0 + e1 + e2); }
    bf16_t* wsm = (bf16_t*)(F.ws + WS_WSM);
    for (int it = F.bid; it < 2160; it += F.G) {
        int j = it;
        if (j < 896) { conv_tile(F, P.in[I_EWIN], 1024, 3584, 3584, wsm + W_EIN / 2, 1024, j / 56, j % 56, 0); continue; } j -= 896;
        if (j < 256) { conv_tile(F, P.in[I_EWOUT], 1024, 1024, 1024, wsm + W_EOUT / 2, 1024, j >> 4, j & 15, 0); continue; } j -= 256;
        if (j < 640) { conv_tile(F, P.in[I_OWIN], 1024, 2480, 2480, wsm + W_OIN / 2, 1024, j / 40, j % 40, 0); continue; } j -= 640;
        if (j < 256) { conv_tile(F, P.in[I_OWOUT], 1024, 1024, 1024, wsm + W_OOUT / 2, 1024, j >> 4, j & 15, 0); continue; } j -= 256;
        if (j < 48) { conv_tile(F, P.in[I_WQ], 256, 768, 768, wsm + W_WQ / 2, 256, j / 12, j % 12, 0); continue; } j -= 48;
        conv_tile(F, P.in[I_WKV], 128, 1024, 1024, wsm + W_WKV / 2, 256, j >> 4, j & 15, 0);
    }
    for (int i = gtid(F); i < 2 * 48 * 1024; i += F.G * NTH) { const int l = i / (48 * 1024), r = i % (48 * 1024), n = r >> 10, k = r & 1023;
        float w = 0.f; if (n < 4) w = P.in[I_RGW][((size_t)l * 1024 + k) * 4 + n]; else if (n < 36) w = P.in[I_REW][((size_t)l * 1024 + k) * 32 + (n - 4)];
        const bf16_t h = f2bf(w); const size_t fo = W_RT / 2 + (size_t)l * 2 * 48 * 1024 + (size_t)(((k >> 5) * 3 + (n >> 4)) * 2) * 512 + (((k >> 3) & 3) * 16 + (n & 15)) * 8 + (k & 7);
        wsm[fo] = h; wsm[fo + 512] = f2bf(w - bf2f(h)); }
    conv_moe_weights(F, 0, F.bid, F.G, 0, 3072);
}

__device__ __forceinline__ void ph_rownorm(const Frame& F, int layer, int nrows, const float* xlat, const float* xctx, const float* nw, int si) {
    bf16_t* dst = (bf16_t*)(F.ws + WS_ACT);
    const int per = (nrows + F.G * 8 - 1) / (F.G * 8);
    const int ra = (F.bid * 8 + F.wave) * per, rb = min(nrows, ra + per);
    const int cl = F.lane * 4;
    int bcur = -1;
    f32x4 NW[4], SC[4], SH[4];
#pragma unroll
    for (int j = 0; j < 4; ++j) NW[j] = *(const f32x4*)(nw + j * 256 + cl);
    for (int r = ra; r < rb;) {
        const int b = r < TL ? (r >> 13) : 8;
        const bool two = (r + 1 < rb) && ((r + 1 < TL ? ((r + 1) >> 13) : 8) == b);
        const int r2 = two ? r + 1 : r;
        if (b != bcur) { bcur = b; const float* sh = modp(F, layer, b, si); const float* sc = modp(F, layer, b, si + 1);
#pragma unroll
            for (int j = 0; j < 4; ++j) { SC[j] = 1.f + *(const f32x4*)(sc + j * 256 + cl); SH[j] = *(const f32x4*)(sh + j * 256 + cl); } }
        const float* xa = (r < TL ? xlat + (size_t)r * 1024 : xctx + (size_t)(r - TL) * 1024) + cl;
        const float* xb = (r2 < TL ? xlat + (size_t)r2 * 1024 : xctx + (size_t)(r2 - TL) * 1024) + cl;
        f32x4 XA[4], XB[4];
#pragma unroll
        for (int j = 0; j < 4; ++j) XA[j] = *(const f32x4*)(xa + j * 256);
#pragma unroll
        for (int j = 0; j < 4; ++j) XB[j] = *(const f32x4*)(xb + j * 256);
        float ssa = 0.f, ssb = 0.f;
#pragma unroll
        for (int j = 0; j < 4; ++j) { ssa += XA[j][0] * XA[j][0] + XA[j][1] * XA[j][1] + XA[j][2] * XA[j][2] + XA[j][3] * XA[j][3];
                                      ssb += XB[j][0] * XB[j][0] + XB[j][1] * XB[j][1] + XB[j][2] * XB[j][2] + XB[j][3] * XB[j][3]; }
        ssa = wave_sum(ssa); ssb = wave_sum(ssb);
        const float rsa = rsqrtf(ssa * (1.f / 1024.f) + EPS), rsb = rsqrtf(ssb * (1.f / 1024.f) + EPS);
#pragma unroll
        for (int j = 0; j < 4; ++j) { const f32x4 hq = (XA[j] * rsa * NW[j]) * SC[j] + SH[j];
            u32x2 o; o.x = pack2(hq[0], hq[1]); o.y = pack2(hq[2], hq[3]); *(u32x2*)(dst + (size_t)r * 1024 + cl + j * 256) = o; }
        if (two) {
#pragma unroll
            for (int j = 0; j < 4; ++j) { const f32x4 hq = (XB[j] * rsb * NW[j]) * SC[j] + SH[j];
                u32x2 o; o.x = pack2(hq[0], hq[1]); o.y = pack2(hq[2], hq[3]); *(u32x2*)(dst + (size_t)r2 * 1024 + cl + j * 256) = o; } }
        r = r2 + 1;
    }
}
typedef short s16x8r __attribute__((ext_vector_type(8)));
__device__ __forceinline__ void ph_router(const Frame& F, int layer, int nrows, const float* xlat, const float* xctx, const float* nw, int si) {
    const Params& P = *F.P;
    bf16_t* dst = (bf16_t*)(F.ws + WS_ACT);
    LAS unsigned* hist = (LAS unsigned*)F.lds;
    LAS unsigned char* SG = F.lds + 256 + F.wave * 8704;
    LAS float* lg = (LAS float*)SG;
    int* tok_e = (int*)(F.ws + WS_R2 + R2_TOKE); float* tok_w = (float*)(F.ws + WS_R2 + R2_TOKW);
    LAS float* CA = (LAS float*)(F.lds + 69888); LAS float* CB = CA + 9 * 1024;
    LAS unsigned* wq = (LAS unsigned*)(F.lds + 69888 + 2 * 9 * 1024 * 4);
    if (F.tid < 64) hist[F.tid] = 0u;
    if (F.tid == 64) *wq = 0u;
#pragma unroll
    for (int q = 0; q < 5; ++q) { const int i4 = F.tid + q * NTH;
        if (i4 < 9 * 256) { const int bb = i4 >> 8, c = (i4 & 255) * 4;
            const f32x4 sc1 = *(const f32x4*)(modp(F, layer, bb, si + 1) + c), w4 = *(const f32x4*)(nw + c), sh4 = *(const f32x4*)(modp(F, layer, bb, si) + c);
            *(LAS f32x4*)(CA + bb * 1024 + c) = w4 * (1.f + sc1); *(LAS f32x4*)(CB + bb * 1024 + c) = sh4; } }
    __syncthreads();
    { int* stok = (int*)(F.ws + WS_R2 + R2_STOK);
      float* swz = (float*)(F.ws + WS_R2 + R2_SW);
      for (int i = gtid(F); i < MAXSLOTS; i += F.G * NTH) { stok[i] = -1; swz[i] = 0.f; } }
    const bf16_t* Wf = (const bf16_t*)(F.ws + WS_WSM) + W_RT / 2 + (size_t)layer * 2 * 48 * 1024 + F.lane * 8;
    const int lr = F.lane & 15, kq = F.lane >> 4, l31 = F.lane & 31, hh = F.lane >> 5;
    const float* rgb = P.in[I_RGB] + layer * 4; const float* reb = P.in[I_REB] + layer * 32;
    const int ngrp = nrows / 16;
    int g; { int q = 0; if (F.lane == 0) q = (int)lds_inc(wq); g = __builtin_amdgcn_readfirstlane(q) * F.G + F.bid; }
    if (g < ngrp) {
        f32x4 X[8]; s16x8r BH[4][3], BL[4][3];
#define RT_LDX(p) do { _Pragma("unroll") for (int i_ = 0; i_ < 8; ++i_) X[i_] = *(const f32x4*)((p) + i_ * 2048); } while (0)
#define RT_LDB(j, ks) do { _Pragma("unroll") for (int nb_ = 0; nb_ < 3; ++nb_) { BH[j][nb_] = *(const s16x8r*)(Wf + (((ks) * 3 + nb_) * 2) * 512); BL[j][nb_] = *(const s16x8r*)(Wf + (((ks) * 3 + nb_) * 2 + 1) * 512); } } while (0)
        const float* xp = (g * 16 < TL ? xlat + (size_t)(g * 16) * 1024 : xctx + (size_t)(g * 16 - TL) * 1024) + hh * 1024 + l31 * 4;
        RT_LDX(xp);
#pragma unroll
        for (int j = 0; j < 4; ++j) RT_LDB(j, j);
        __builtin_amdgcn_sched_barrier(0);
        for (;;) {
            int gn; { int q = 0; if (F.lane == 0) q = (int)lds_inc(wq); gn = __builtin_amdgcn_readfirstlane(q) * F.G + F.bid; }
            const float* xpn = gn < ngrp ? (gn * 16 < TL ? xlat + (size_t)(gn * 16) * 1024 : xctx + (size_t)(gn * 16 - TL) * 1024) + hh * 1024 + l31 * 4 : xp;
            const int r0 = g * 16;
            const int b = r0 < TL ? (r0 >> 13) : 8;
            const LAS float* cap = CA + b * 1024 + l31 * 4; const LAS float* cbp = CB + b * 1024 + l31 * 4;
            float rs[8];
            { const float* rp = (const float*)(F.ws + WS_R2 + R2_RSS) + (size_t)(r0 + lr) * 32 + kq * 8;
              const f32x4 p0 = *(const f32x4*)rp, p1 = *(const f32x4*)(rp + 4);
              float ss = ((p0[0] + p0[1]) + (p0[2] + p0[3])) + ((p1[0] + p1[1]) + (p1[2] + p1[3]));
              auto t1 = __builtin_amdgcn_permlane16_swap(__float_as_uint(ss), __float_as_uint(ss), false, false); ss = __uint_as_float(t1[0]) + __uint_as_float(t1[1]);
              auto t2 = __builtin_amdgcn_permlane32_swap(__float_as_uint(ss), __float_as_uint(ss), false, false); ss = __uint_as_float(t2[0]) + __uint_as_float(t2[1]);
              LAS float* rsl = (LAS float*)(SG + 8192);
              if (F.lane < 16) rsl[F.lane] = rsqrtf(ss * (1.f / 1024.f) + EPS);
#pragma unroll
              for (int i = 0; i < 8; ++i) rs[i] = rsl[2 * i + hh]; }
            f32x4 acc[3];
#pragma unroll
            for (int nb = 0; nb < 3; ++nb) acc[nb] = (f32x4){0.f, 0.f, 0.f, 0.f};
            bf16_t* dp = dst + (size_t)(r0 + hh) * 1024 + l31 * 4;
            LAS unsigned char* sw_ = SG + hh * 272 + l31 * 8;
            const LAS unsigned char* sr_ = SG + lr * 272 + kq * 16;
#pragma unroll 1
            for (int c = 0; c < 8; ++c) {
                const f32x4 ca4 = *(const LAS f32x4*)(cap + c * 128), cb4 = *(const LAS f32x4*)(cbp + c * 128);
#pragma unroll
                for (int i = 0; i < 8; ++i) {
                    const f32x4 h = (X[i] * rs[i]) * ca4 + cb4;
                    u32x2 hi; hi.x = pack2(h[0], h[1]); hi.y = pack2(h[2], h[3]);
                    *(u32x2*)(dp + i * 2048 + c * 128) = hi;
                    u32x2 lo; lo.x = pack2(h[0] - lo2f(hi.x), h[1] - hi2f(hi.x)); lo.y = pack2(h[2] - lo2f(hi.y), h[3] - hi2f(hi.y));
                    *(LAS u32x2*)(sw_ + i * 544) = hi; *(LAS u32x2*)(sw_ + 4352 + i * 544) = lo; }
                __builtin_amdgcn_sched_barrier(0);
                { const float* xq = c < 7 ? xp + (c + 1) * 128 : xpn; RT_LDX(xq); }
                __builtin_amdgcn_sched_barrier(0);
#pragma unroll
                for (int j = 0; j < 4; ++j) {
                    const s16x8r ah = *(const LAS s16x8r*)(sr_ + j * 64), al = *(const LAS s16x8r*)(sr_ + 4352 + j * 64);
#pragma unroll
                    for (int nb = 0; nb < 3; ++nb) {
                        acc[nb] = __builtin_amdgcn_mfma_f32_16x16x32_bf16(ah, BH[j][nb], acc[nb], 0, 0, 0);
                        acc[nb] = __builtin_amdgcn_mfma_f32_16x16x32_bf16(al, BH[j][nb], acc[nb], 0, 0, 0);
                        acc[nb] = __builtin_amdgcn_mfma_f32_16x16x32_bf16(ah, BL[j][nb], acc[nb], 0, 0, 0); }
                    __builtin_amdgcn_sched_barrier(0);
                    RT_LDB(j, (((c + 1) & 7) * 4 + j));
                    __builtin_amdgcn_sched_barrier(0); }
            }
#pragma unroll
            for (int nb = 0; nb < 3; ++nb)
#pragma unroll
                for (int rg = 0; rg < 4; ++rg) lg[(4 * kq + rg) * 48 + nb * 16 + lr] = acc[nb][rg];
            asm volatile("s_waitcnt lgkmcnt(0)" ::: "memory");
            __builtin_amdgcn_wave_barrier();
            if (F.lane < 16) {
                const LAS float* L = lg + F.lane * 48;
                float lgv[4];
#pragma unroll
                for (int i = 0; i < 4; ++i) lgv[i] = L[i] + rgb[i];
                int gi = 0; float best = lgv[0];
#pragma unroll
                for (int i = 1; i < 4; ++i) if (lgv[i] > best) { best = lgv[i]; gi = i; }
                float den = 0.f;
#pragma unroll
                for (int i = 0; i < 4; ++i) den += __expf(lgv[i] - best);
                const float pg = 1.f / den;
                float le[8];
#pragma unroll
                for (int i = 0; i < 8; ++i) le[i] = L[4 + gi * 8 + i] + reb[gi * 8 + i];
                int i1 = 0; float b1 = le[0];
#pragma unroll
                for (int i = 1; i < 8; ++i) if (le[i] > b1) { b1 = le[i]; i1 = i; }
                int i2 = -1; float b2 = -3.0e38f;
#pragma unroll
                for (int i = 0; i < 8; ++i) if (i != i1 && le[i] > b2) { b2 = le[i]; i2 = i; }
                const float e2 = __expf(b2 - b1);
                const float w1 = pg / (1.f + e2), w2 = pg * e2 / (1.f + e2);
                const int e0g = gi * 8 + i1, e1g = gi * 8 + i2; const int r = r0 + F.lane;
                tok_e[r] = e0g | (e1g << 8); tok_w[2 * r] = w1; tok_w[2 * r + 1] = w2;
                lds_inc(&hist[e0g]); lds_inc(&hist[e1g]);
            }
            __builtin_amdgcn_wave_barrier();
            if (gn >= ngrp) break;
            g = gn; xp = xpn;
        }
#undef RT_LDX
#undef RT_LDB
    }
    __syncthreads();
    unsigned* cnt = (unsigned*)(F.ws + WS_CTRL + C_MOE + layer * 1024);
    if (F.tid < 64 && hist[F.tid]) atomicAdd(&cnt[F.tid], hist[F.tid]);
    __syncthreads();
}

__device__ __forceinline__ void ph_dispatch(const Frame& F, int layer, int ntok) {
    unsigned* cnt = (unsigned*)(F.ws + WS_CTRL + C_MOE + layer * 1024); unsigned* cursor = cnt + 64; unsigned* info = cnt + 128;
    LAS unsigned* base = (LAS unsigned*)F.lds; LAS unsigned* lh = base + 64; LAS unsigned* gb = base + 128; LAS unsigned* lh2 = base + 192; LAS unsigned* pad = base + 256;
    const int* tok_e = (const int*)(F.ws + WS_R2 + R2_TOKE); const float* tok_w = (const float*)(F.ws + WS_R2 + R2_TOKW);
    int* stok = (int*)(F.ws + WS_R2 + R2_STOK); float* sw = (float*)(F.ws + WS_R2 + R2_SW); int* tile_e = (int*)(F.ws + WS_R2 + R2_TILEE); int* tsl = (int*)(F.ws + WS_R2 + R2_TSLOT);
    if (F.tid < 64) { pad[F.tid] = (__hip_atomic_load(&cnt[F.tid], __ATOMIC_RELAXED, __HIP_MEMORY_SCOPE_AGENT) + 255u) & ~255u; lh[F.tid] = 0u; lh2[F.tid] = 0u; }
    __syncthreads();
    if (F.tid == 0) { unsigned a = 0; for (int i = 0; i < 64; ++i) { base[i] = a; a += pad[i]; } base[320] = a; }
    __syncthreads();
    if (F.bid == 0) {
        for (int i = F.tid; i < MAXTILES; i += NTH) { const unsigned s = (unsigned)i * 256u; int l = -1;
            for (int j = 0; j < 64; ++j) if (s >= base[j] && s < base[j] + pad[j]) l = j;
            tile_e[i] = l; }
        if (F.tid == 0) { info[0] = base[32] / 256u; info[1] = base[320] / 256u; }
    }
    const int per = (ntok + F.G - 1) / F.G, t0 = F.bid * per, t1 = min(ntok, t0 + per);
    for (int t = t0 + F.tid; t < t1; t += NTH) { const int e = tok_e[t]; lds_inc(&lh[e & 255]); lds_inc(&lh[e >> 8]); }
    __syncthreads();
    if (F.tid < 64) gb[F.tid] = lh[F.tid] ? __hip_atomic_fetch_add(&cursor[F.tid], lh[F.tid], __ATOMIC_RELAXED, __HIP_MEMORY_SCOPE_AGENT) : 0u;
    __syncthreads();
    for (int t = t0 + F.tid; t < t1; t += NTH) { const int e = tok_e[t];
        const int l0 = e & 255, l1 = e >> 8;
        const unsigned p0 = base[l0] + gb[l0] + lds_inc(&lh2[l0]), p1 = base[l1] + gb[l1] + lds_inc(&lh2[l1]);
        stok[p0] = t; sw[p0] = tok_w[2 * t]; stok[p1] = t; sw[p1] = tok_w[2 * t + 1]; tsl[2 * t] = (int)p0; tsl[2 * t + 1] = (int)p1; }
    __syncthreads();
}

template <class AF, class EP>
__device__ __forceinline__ void gemm_unit_naive(const Frame& F, int K, const AF& arow, const bf16_t* Bt, const EP& E, int pm, int pn) {
    LAS float* As = (LAS float*)F.lds;
    LAS float* Bs = As + 32 * 132;
    const int t = F.tid, ty = t >> 5, tx = t & 31;
    for (int half = 0; half < 2; ++half) {
        float acc[8][8];
#pragma unroll
        for (int i = 0; i < 8; ++i)
#pragma unroll
            for (int j = 0; j < 8; ++j) acc[i][j] = 0.f;
        const bf16_t* ap = arow(half * 128 + (t >> 2));
        const bf16_t* bp = Bt + (size_t)(t >> 1) * K;
        for (int k0 = 0; k0 < K; k0 += 32) {
            { const int r = t >> 2, kq = (t & 3) * 8; u32x4 w = {0u, 0u, 0u, 0u}; if (ap) w = *(const u32x4*)(ap + k0 + kq);
              As[(kq + 0) * 132 + r] = lo2f(w.x); As[(kq + 1) * 132 + r] = hi2f(w.x); As[(kq + 2) * 132 + r] = lo2f(w.y); As[(kq + 3) * 132 + r] = hi2f(w.y);
              As[(kq + 4) * 132 + r] = lo2f(w.z); As[(kq + 5) * 132 + r] = hi2f(w.z); As[(kq + 6) * 132 + r] = lo2f(w.w); As[(kq + 7) * 132 + r] = hi2f(w.w); }
            { const int n = t >> 1, kh = (t & 1) * 16;
#pragma unroll
              for (int q = 0; q < 2; ++q) { const u32x4 w = *(const u32x4*)(bp + k0 + kh + q * 8); const int kk = kh + q * 8;
                Bs[(kk + 0) * 260 + n] = lo2f(w.x); Bs[(kk + 1) * 260 + n] = hi2f(w.x); Bs[(kk + 2) * 260 + n] = lo2f(w.y); Bs[(kk + 3) * 260 + n] = hi2f(w.y);
                Bs[(kk + 4) * 260 + n] = lo2f(w.z); Bs[(kk + 5) * 260 + n] = hi2f(w.z); Bs[(kk + 6) * 260 + n] = lo2f(w.w); Bs[(kk + 7) * 260 + n] = hi2f(w.w); } }
            __syncthreads();
#pragma unroll 4
            for (int k = 0; k < 32; ++k) {
                const f32x4 a0 = *(const LAS f32x4*)(As + k * 132 + ty * 8), a1 = *(const LAS f32x4*)(As + k * 132 + ty * 8 + 4);
                const f32x4 b0 = *(const LAS f32x4*)(Bs + k * 260 + tx * 4), b1 = *(const LAS f32x4*)(Bs + k * 260 + 128 + tx * 4);
#pragma unroll
                for (int i = 0; i < 8; ++i) { const float a = i < 4 ? a0[i & 3] : a1[i & 3];
#pragma unroll
                    for (int j = 0; j < 4; ++j) { acc[i][j] += a * b0[j]; acc[i][4 + j] += a * b1[j]; } }
            }
            __syncthreads();
        }
#pragma unroll
        for (int i = 0; i < 8; ++i) { const f32x4 v0 = {acc[i][0], acc[i][1], acc[i][2], acc[i][3]}, v1 = {acc[i][4], acc[i][5], acc[i][6], acc[i][7]};
            E(pm * 256 + half * 128 + ty * 8 + i, pn, tx * 4, v0, v1); }
    }
}
struct ARowDense { const bf16_t* A; int K; int pm; __device__ __forceinline__ const bf16_t* operator()(int r) const { return A + (size_t)(pm * 256 + r) * K; } };
struct ARowGather { const bf16_t* A; const int* stok; int pm; __device__ __forceinline__ const bf16_t* operator()(int r) const { const int t = stok[pm * 256 + r]; return t < 0 ? nullptr : A + (size_t)t * 1024; } };

template <class EP>
__device__ __forceinline__ void gemm_dense_naive(const Frame& F, const bf16_t* A, const bf16_t* Bt, int M, int N, int K, const EP& E) {
    const int nM = M / 256, nN = N / 256;
    for (int u = F.bid; u < nM * nN; u += F.G) { const int pm = u / nN, pn = u % nN;
        ARowDense ar{A, K, pm}; gemm_unit_naive(F, K, ar, Bt + (size_t)pn * 256 * K, E, pm, pn); }
}

namespace pg8 {
typedef short bf16x8 __attribute__((ext_vector_type(8)));
constexpr int BM = 256, BK = 64, HALF = 128, HTB = HALF * BK * 2, STAGE_BYTES = 8 * HTB, NXCD = 8, WGM = 8;
__device__ __forceinline__ int lds_byte(int r, int c) { const int st = (r >> 4) * 2 + (c >> 5), rr = r & 15, cc = c & 31, ob = rr * 64 + cc * 2; return st * 1024 + (ob ^ (((ob >> 9) & 1) << 5)); }
__device__ __forceinline__ int perm32(int rho) { const int n = rho >> 4, i = rho & 15; return 8 * (i >> 2) + 4 * n + (i & 3); }
__device__ __forceinline__ void stage_rc(int b, int& R, int& C) { const int st = b / 1024, sb = b % 1024, swz = sb ^ (((sb >> 9) & 1) << 5); R = (st >> 1) * 16 + swz / 64; C = (st & 1) * 32 + (swz % 64) / 2; }
struct Unit { int pm, pn; };
struct ProbDense {
    const char* A; const char* Bt; int K, nM, nN, nwg, G, c;
    __device__ __forceinline__ void init(const bf16_t* A_, const bf16_t* Bt_, int M, int N, int K_, int G_, int c_) { A = (const char*)A_; Bt = (const char*)Bt_; K = K_; nM = M / BM; nN = N / BM; nwg = nM * nN; G = G_; c = c_; }
    __device__ __forceinline__ bool next(int i, Unit& u) const {
        const long L = (long)i * G + c; if (L >= nwg) return false;
        int wgid = (int)L; { const int q = nwg / NXCD, r = nwg % NXCD, xcd = wgid % NXCD, off = wgid / NXCD; wgid = (xcd < r ? xcd * (q + 1) : r * (q + 1) + (xcd - r) * q) + off; }
        const int nig = WGM * nN, gid = wgid / nig, fm = gid * WGM, gsz = (nM - fm) < WGM ? (nM - fm) : WGM;
        u.pm = fm + ((wgid % nig) % gsz); u.pn = (wgid % nig) / gsz; return true;
    }
    __device__ __forceinline__ const char* bptr(const Unit& u) const { return Bt + (size_t)u.pn * 256 * K * 2; }
    __device__ __forceinline__ unsigned aoff(const Unit& u, int r) const { return (unsigned)(u.pm * 256 + r) * (unsigned)(K * 2); }
};
struct ProbMoe1 {
    const char* A; const int* stok; const int* tile_e; const char* W; int K, ntiles, G, c;
    __device__ __forceinline__ bool next(int i, Unit& u) const { const int L = i * G + c; if (L >= ntiles * 4) return false; u.pm = L >> 2; u.pn = L & 3; return true; }
    __device__ __forceinline__ const char* bptr(const Unit& u) const { return W + ((size_t)(tile_e[u.pm] & 31) * 1024 + u.pn * 256) * 2048; }
    __device__ __forceinline__ unsigned aoff(const Unit& u, int r) const { const int t = stok[u.pm * 256 + r]; return t < 0 ? 0u : (unsigned)t * 2048u; }
};
struct ProbMoe2 {
    const char* A; const int* tile_e; const char* W; int K, tlo, thi, G, c;
    __device__ __forceinline__ bool next(int i, Unit& u) const { const int L = i * G + c; if (L >= (thi - tlo) * 4) return false; u.pm = tlo + (L >> 2); u.pn = L & 3; return true; }
    __device__ __forceinline__ const char* bptr(const Unit& u) const { return W + ((size_t)(tile_e[u.pm] & 31) * 1024 + u.pn * 256) * 1024; }
    __device__ __forceinline__ unsigned aoff(const Unit& u, int r) const { return (unsigned)(u.pm * 256 + r) * 1024u; }
};

template <class Prob, class Epi>
__device__ __forceinline__ void gemm_phase(LAS unsigned char* lds, const Prob& S, const Epi& E) {
    const int tid = threadIdx.x, wid = __builtin_amdgcn_readfirstlane(tid >> 6), lane = tid & 63, wr = wid >> 2, wc = wid & 3, fr = lane & 15, fq = lane >> 4;
    const int K = S.K, nt = K / BK;
    int RA[2]; unsigned cb2[2], voffB[2];
#pragma unroll
    for (int i = 0; i < 2; ++i) { int R, C; stage_rc(tid * 16 + i * 8192, R, C); RA[i] = R; cb2[i] = (unsigned)C * 2u; const int Rb = Epi::PERM ? ((R & ~31) + perm32(R & 31)) : R; voffB[i] = (unsigned)(Rb * K + C) * 2u; }
    const size_t kstep = (size_t)(BK * 2);
    const size_t hstepB = (size_t)HALF * K * 2;
    const unsigned ldsw = (unsigned)wid * 1024u;
    const int aoff = lds_byte(wr * 64 + fr, fq * 8), boff = lds_byte(wc * 32 + fr, fq * 8);
#define PG8_SA(b, h) (((b) * 2 + (h)) * HTB)
#define PG8_SB(b, h) ((4 + (b) * 2 + (h)) * HTB)
#define PG8_STAGE(bufoff, gbase, voff) do { _Pragma("unroll") for (int _i = 0; _i < 2; ++_i) \
        __builtin_amdgcn_global_load_lds((const unsigned*)((const char*)(gbase) + (voff)[_i]), (LAS unsigned*)(lds + (bufoff) + ldsw + _i * 8192), 16, 0, 0); } while (0)
#define PG8_LDA(dst, b, h) do { _Pragma("unroll") for (int m = 0; m < 4; ++m) _Pragma("unroll") for (int k = 0; k < 2; ++k) dst[m][k] = *(const LAS bf16x8*)(lds + PG8_SA(b, h) + aoff + m * 2048 + k * 1024); } while (0)
#define PG8_LDB(dst, b, h) do { _Pragma("unroll") for (int n = 0; n < 2; ++n) _Pragma("unroll") for (int k = 0; k < 2; ++k) dst[n][k] = *(const LAS bf16x8*)(lds + PG8_SB(b, h) + boff + n * 2048 + k * 1024); } while (0)
#define PG8_MMA(ai, bj, At, Bt) do { __builtin_amdgcn_s_setprio(1); _Pragma("unroll") for (int m = 0; m < 4; ++m) _Pragma("unroll") for (int n = 0; n < 2; ++n) _Pragma("unroll") for (int k = 0; k < 2; ++k) \
        acc[ai][bj][m][n] = __builtin_amdgcn_mfma_f32_16x16x32_bf16(Bt[n][k], At[m][k], acc[ai][bj][m][n], 0, 0, 0); __builtin_amdgcn_s_setprio(0); } while (0)
#define PG8_WAIT_V(n) asm volatile("s_waitcnt vmcnt(" #n ")" ::: "memory")
#define PG8_WAIT_L(n) asm volatile("s_waitcnt lgkmcnt(" #n ")" ::: "memory")
#define PG8_BAR __builtin_amdgcn_s_barrier()
#define PG8_SCHED __builtin_amdgcn_sched_barrier(0)
    Unit cur, nxt; int ui = 0;
    if (!S.next(0, cur)) return;
    f32x4 acc[2][2][4][2];
#pragma unroll
    for (int a = 0; a < 2; ++a)
#pragma unroll
        for (int b = 0; b < 2; ++b)
#pragma unroll
            for (int m = 0; m < 4; ++m)
#pragma unroll
                for (int n = 0; n < 2; ++n) acc[a][b][m][n] = (f32x4){0.f, 0.f, 0.f, 0.f};
    bf16x8 At[4][2], B0[2][2], B1[2][2];
    unsigned oc0[2], oc1[2], on0[2], on1[2];
#pragma unroll
    for (int i = 0; i < 2; ++i) { oc0[i] = S.aoff(cur, RA[i]) + cb2[i]; oc1[i] = S.aoff(cur, 128 + RA[i]) + cb2[i]; }
    const char* cB = S.bptr(cur);
    const char* const Ab = S.A;
    PG8_STAGE(PG8_SB(0, 0), cB, voffB); PG8_STAGE(PG8_SA(0, 0), Ab, oc0); PG8_STAGE(PG8_SB(0, 1), cB + hstepB, voffB); PG8_STAGE(PG8_SA(0, 1), Ab, oc1);
    if (wr == 1) PG8_BAR;
    PG8_WAIT_V(4); PG8_BAR;
    PG8_STAGE(PG8_SB(1, 0), cB + kstep, voffB); PG8_STAGE(PG8_SA(1, 0), Ab + kstep, oc0); PG8_STAGE(PG8_SB(1, 1), cB + hstepB + kstep, voffB);
    PG8_WAIT_V(6); PG8_BAR;
    for (;;) {
        const bool has_next = S.next(ui + 1, nxt);
        const char* nB = has_next ? S.bptr(nxt) : cB;
#pragma unroll
        for (int i = 0; i < 2; ++i) { on0[i] = has_next ? S.aoff(nxt, RA[i]) + cb2[i] : oc0[i]; on1[i] = has_next ? S.aoff(nxt, 128 + RA[i]) + cb2[i] : oc1[i]; }
        for (int t = 0; t < nt; t += 2) {
            const bool last = (t == nt - 2);
            const char* a1 = Ab + (size_t)(t + 1) * kstep;
            const char* a2 = last ? Ab : Ab + (size_t)(t + 2) * kstep; const char* b2 = last ? nB : cB + (size_t)(t + 2) * kstep;
            const char* a3 = a2 + kstep; const char* b3 = b2 + kstep;
            unsigned o20[2], o21[2];
#pragma unroll
            for (int i = 0; i < 2; ++i) { o20[i] = last ? on0[i] : oc0[i]; o21[i] = last ? on1[i] : oc1[i]; }
            PG8_LDB(B0, 0, 0); PG8_SCHED; PG8_LDA(At, 0, 0); PG8_STAGE(PG8_SA(1, 1), a1, oc1);
            PG8_WAIT_L(8); PG8_BAR; PG8_WAIT_L(0); PG8_MMA(0, 0, At, B0); PG8_BAR; PG8_SCHED;
            PG8_LDB(B1, 0, 1); PG8_STAGE(PG8_SB(0, 0), b2, voffB);
            PG8_BAR; PG8_WAIT_L(0); PG8_MMA(0, 1, At, B1); PG8_BAR;
            PG8_LDA(At, 0, 1); PG8_STAGE(PG8_SA(0, 0), a2, o20);
            PG8_BAR; PG8_WAIT_L(0); PG8_MMA(1, 0, At, B0); PG8_BAR; PG8_SCHED;
            PG8_STAGE(PG8_SB(0, 1), b2 + hstepB, voffB);
            PG8_WAIT_V(6); PG8_BAR; PG8_MMA(1, 1, At, B1); PG8_BAR;
            PG8_LDB(B0, 1, 0); PG8_SCHED; PG8_LDA(At, 1, 0); PG8_STAGE(PG8_SA(0, 1), a2, o21);
            PG8_WAIT_L(8); PG8_BAR; PG8_WAIT_L(0); PG8_MMA(0, 0, At, B0); PG8_BAR; PG8_SCHED;
            PG8_LDB(B1, 1, 1); PG8_STAGE(PG8_SB(1, 0), b3, voffB);
            PG8_BAR; PG8_WAIT_L(0); PG8_MMA(0, 1, At, B1); PG8_BAR;
            PG8_LDA(At, 1, 1); PG8_STAGE(PG8_SA(1, 0), a3, o20);
            PG8_BAR; PG8_WAIT_L(0); PG8_MMA(1, 0, At, B0); PG8_BAR; PG8_SCHED;
            PG8_STAGE(PG8_SB(1, 1), b3 + hstepB, voffB);
            PG8_WAIT_V(6); PG8_BAR; PG8_MMA(1, 1, At, B1); PG8_BAR;
        }
#pragma unroll
        for (int ai = 0; ai < 2; ++ai)
#pragma unroll
            for (int m = 0; m < 4; ++m)
                { if constexpr (Epi::PERM) E.e8(cur.pm * BM + ai * HALF + wr * 64 + m * 16 + fr, cur.pn, wc * 32 + fq * 8, acc[ai][0][m][0], acc[ai][0][m][1], acc[ai][1][m][0], acc[ai][1][m][1]);
                  else { _Pragma("unroll") for (int n = 0; n < 2; ++n) E(cur.pm * BM + ai * HALF + wr * 64 + m * 16 + fr, cur.pn, wc * 32 + n * 16 + fq * 4, acc[ai][0][m][n], acc[ai][1][m][n]); } }
        if (!has_next) break;
#pragma unroll
        for (int a = 0; a < 2; ++a)
#pragma unroll
            for (int b = 0; b < 2; ++b)
#pragma unroll
                for (int m = 0; m < 4; ++m)
#pragma unroll
                    for (int n = 0; n < 2; ++n) acc[a][b][m][n] = (f32x4){0.f, 0.f, 0.f, 0.f};
        cur = nxt; cB = nB; ++ui;
#pragma unroll
        for (int i = 0; i < 2; ++i) { oc0[i] = on0[i]; oc1[i] = on1[i]; }
    }
    PG8_WAIT_V(0);
    if (wr == 0) PG8_BAR;
    PG8_BAR;
#undef PG8_SA
#undef PG8_SB
#undef PG8_STAGE
#undef PG8_LDA
#undef PG8_LDB
#undef PG8_MMA
#undef PG8_WAIT_V
#undef PG8_WAIT_L
#undef PG8_BAR
#undef PG8_SCHED
}
}

struct EpiStoreBf16 { static constexpr bool PERM = false; bf16_t* O; int ldc; int gelu_below;
    __device__ __forceinline__ void operator()(int row, int pn, int cx, f32x4 v0, f32x4 v1) const {
        const int c0 = pn * 256 + cx, c1 = c0 + 128;
        if (c0 < gelu_below) { v0[0] = gelu_tanh_f(v0[0]); v0[1] = gelu_tanh_f(v0[1]); v0[2] = gelu_tanh_f(v0[2]); v0[3] = gelu_tanh_f(v0[3]); }
        if (c1 < gelu_below) { v1[0] = gelu_tanh_f(v1[0]); v1[1] = gelu_tanh_f(v1[1]); v1[2] = gelu_tanh_f(v1[2]); v1[3] = gelu_tanh_f(v1[3]); }
        u32x2 a; a.x = pack2(v0[0], v0[1]); a.y = pack2(v0[2], v0[3]); u32x2 b; b.x = pack2(v1[0], v1[1]); b.y = pack2(v1[2], v1[3]);
        *(u32x2*)(O + (size_t)row * ldc + c0) = a; *(u32x2*)(O + (size_t)row * ldc + c1) = b; } };
struct EpiStoreBf16P { static constexpr bool PERM = true; bf16_t* O; int ldc; int gelu_below;
    __device__ __forceinline__ void e8(int row, int pn, int cx, f32x4 a0, f32x4 a1, f32x4 b0, f32x4 b1) const {
        const int c0 = pn * 256 + cx, c1 = c0 + 128;
        if (c0 < gelu_below) {
#pragma unroll
            for (int i = 0; i < 4; ++i) { a0[i] = gelu_tanh_f(a0[i]); a1[i] = gelu_tanh_f(a1[i]); } }
        if (c1 < gelu_below) {
#pragma unroll
            for (int i = 0; i < 4; ++i) { b0[i] = gelu_tanh_f(b0[i]); b1[i] = gelu_tanh_f(b1[i]); } }
        u32x4 x; x.x = pack2(a0[0], a0[1]); x.y = pack2(a0[2], a0[3]); x.z = pack2(a1[0], a1[1]); x.w = pack2(a1[2], a1[3]);
        u32x4 y; y.x = pack2(b0[0], b0[1]); y.y = pack2(b0[2], b0[3]); y.z = pack2(b1[0], b1[1]); y.w = pack2(b1[2], b1[3]);
        *(u32x4*)(O + (size_t)row * ldc + c0) = x; *(u32x4*)(O + (size_t)row * ldc + c1) = y; } };
struct EpiMoe1P { static constexpr bool PERM = true; bf16_t* H;
    __device__ __forceinline__ void e8(int row, int pn, int cx, f32x4 a0, f32x4 a1, f32x4 b0, f32x4 b1) const {
        u32x4 x; x.x = pack2(silu_f(a0[0]) * b0[0], silu_f(a0[1]) * b0[1]); x.y = pack2(silu_f(a0[2]) * b0[2], silu_f(a0[3]) * b0[3]);
        x.z = pack2(silu_f(a1[0]) * b1[0], silu_f(a1[1]) * b1[1]); x.w = pack2(silu_f(a1[2]) * b1[2], silu_f(a1[3]) * b1[3]);
        *(u32x4*)(H + (size_t)row * 512 + pn * 128 + cx) = x; } };
struct EpiMoe2YP { static constexpr bool PERM = true; const float* sw; bf16_t* Y;
    __device__ __forceinline__ void e8(int row, int pn, int cx, f32x4 a0, f32x4 a1, f32x4 b0, f32x4 b1) const {
        const float w = sw[row];
        u32x4 x; x.x = pack2(a0[0] * w, a0[1] * w); x.y = pack2(a0[2] * w, a0[3] * w); x.z = pack2(a1[0] * w, a1[1] * w); x.w = pack2(a1[2] * w, a1[3] * w);
        u32x4 y; y.x = pack2(b0[0] * w, b0[1] * w); y.y = pack2(b0[2] * w, b0[3] * w); y.z = pack2(b1[0] * w, b1[1] * w); y.w = pack2(b1[2] * w, b1[3] * w);
        bf16_t* d = Y + (size_t)row * 1024 + pn * 256 + cx; *(u32x4*)d = x; *(u32x4*)(d + 128) = y; } };
struct EpiResidual { static constexpr bool PERM = false; const float* srcl; const float* srcc; float* dstl; float* dstc; const float* mod;   int which; float* rss;
    __device__ __forceinline__ void operator()(int row, int pn, int cx, f32x4 v0, f32x4 v1) const {
        const int b = row < TL ? (row >> 13) : 8; const float* g = mod + ((size_t)b * 6 + which) * 1024;
        const float* s = row < TL ? srcl + (size_t)row * 1024 : srcc + (size_t)(row - TL) * 1024;
        float* d = row < TL ? dstl + (size_t)row * 1024 : dstc + (size_t)(row - TL) * 1024;
        const int c0 = pn * 256 + cx, c1 = c0 + 128;
        const f32x4 y0 = *(const f32x4*)(s + c0) + *(const f32x4*)(g + c0) * v0, y1 = *(const f32x4*)(s + c1) + *(const f32x4*)(g + c1) * v1;
        *(f32x4*)(d + c0) = y0; *(f32x4*)(d + c1) = y1;
        float ss = y0[0] * y0[0] + y0[1] * y0[1] + y0[2] * y0[2] + y0[3] * y0[3] + y1[0] * y1[0] + y1[1] * y1[1] + y1[2] * y1[2] + y1[3] * y1[3];
        { auto t1 = __builtin_amdgcn_permlane16_swap(__float_as_uint(ss), __float_as_uint(ss), false, false); ss = __uint_as_float(t1[0]) + __uint_as_float(t1[1]);
          auto t2 = __builtin_amdgcn_permlane32_swap(__float_as_uint(ss), __float_as_uint(ss), false, false); ss = __uint_as_float(t2[0]) + __uint_as_float(t2[1]); }
        if (((cx >> 2) & 3) == 0) rss[(size_t)row * 32 + pn * 8 + (cx >> 5) * 2 + ((cx >> 4) & 1)] = ss; } };
struct EpiMoe1 { static constexpr bool PERM = false; bf16_t* H;
    __device__ __forceinline__ void operator()(int row, int pn, int cx, f32x4 v0, f32x4 v1) const {
        u32x2 a; a.x = pack2(silu_f(v0[0]) * v1[0], silu_f(v0[1]) * v1[1]); a.y = pack2(silu_f(v0[2]) * v1[2], silu_f(v0[3]) * v1[3]);
        *(u32x2*)(H + (size_t)row * 512 + pn * 128 + cx) = a; } };
struct EpiMoe2 { static constexpr bool PERM = false; const int* stok; const float* sw; float* dstl; float* dstc; const float* mod;
    __device__ __forceinline__ void operator()(int row, int pn, int cx, f32x4 v0, f32x4 v1) const {
        const int t = stok[row]; if (t < 0) return; const float w = sw[row];
        const int b = t < TL ? (t >> 13) : 8; const float* g = mod + ((size_t)b * 6 + 5) * 1024;
        float* d = t < TL ? dstl + (size_t)t * 1024 : dstc + (size_t)(t - TL) * 1024;
        const int c0 = pn * 256 + cx, c1 = c0 + 128;
        *(f32x4*)(d + c0) = *(const f32x4*)(d + c0) + *(const f32x4*)(g + c0) * v0 * w;
        *(f32x4*)(d + c1) = *(const f32x4*)(d + c1) + *(const f32x4*)(g + c1) * v1 * w; } };

#ifndef FAST_GEMM
#define FAST_GEMM 1
#endif
template <class EP>
__device__ __forceinline__ void gemm_dense(const Frame& F, const bf16_t* A, const bf16_t* Bt, int M, int N, int K, const EP& E) {
#if FAST_GEMM
    pg8::ProbDense S; S.init(A, Bt, M, N, K, F.G, F.bid); pg8::gemm_phase(F.lds, S, E);
#else
    gemm_dense_naive(F, A, Bt, M, N, K, E);
#endif
}
struct EpiMoe2Y { static constexpr bool PERM = false; const int* stok; const float* sw; bf16_t* Y;
    __device__ __forceinline__ void operator()(int row, int pn, int cx, f32x4 v0, f32x4 v1) const {
        const int t = stok[row]; if (t < 0) return; const float w = sw[row];
        u32x2 a; a.x = pack2(v0[0] * w, v0[1] * w); a.y = pack2(v0[2] * w, v0[3] * w); u32x2 b; b.x = pack2(v1[0] * w, v1[1] * w); b.y = pack2(v1[2] * w, v1[3] * w);
        bf16_t* d = Y + (size_t)row * 1024 + pn * 256 + cx; *(u32x2*)d = a; *(u32x2*)(d + 128) = b; } };
__device__ __forceinline__ void ph_moe_gemm2y(const Frame& F, int layer) {
    const unsigned* info = (const unsigned*)(F.ws + WS_CTRL + C_MOE + layer * 1024) + 128;
    const int nall = (int)__hip_atomic_load(&info[1], __ATOMIC_RELAXED, __HIP_MEMORY_SCOPE_AGENT);
    const int* tile_e = (const int*)(F.ws + WS_R2 + R2_TILEE);
    const bf16_t* W2 = layer ? (const bf16_t*)(F.ws + WS_W2L1) : (const bf16_t*)(F.ws + WS_WMOE) + (size_t)32 * 1024 * 1024;
    EpiMoe2YP E{(const float*)(F.ws + WS_R2 + R2_SW), (bf16_t*)(F.ws + WS_PX)};
    pg8::ProbMoe2 S{(const char*)(F.ws + WS_R2 + R2_H), tile_e, (const char*)W2, 512, 0, nall, F.G, F.bid};
    pg8::gemm_phase(F.lds, S, E);
}
template <bool NORM>
__device__ __forceinline__ void ph_moe_combine(const Frame& F, int layer, int nrows, int nl, const float* nw) {
    const bf16_t* Y = (const bf16_t*)(F.ws + WS_PX); const int* tsl = (const int*)(F.ws + WS_R2 + R2_TSLOT);
    float* outl = F.P->out; float* outc = (float*)(F.ws + WS_XC); bf16_t* dst = (bf16_t*)(F.ws + WS_ACT);
    const int per = (nrows + F.G * 8 - 1) / (F.G * 8);
    const int ra = (F.bid * 8 + F.wave) * per, rb = min(nrows, ra + per);
    const int cl = F.lane * 4;
    int bcur = -1;
    f32x4 G5[4], NW[4], SC[4], SH[4];
    if (NORM) {
#pragma unroll
        for (int j = 0; j < 4; ++j) NW[j] = *(const f32x4*)(nw + j * 256 + cl); }
    int sa0 = 0, sa1 = 0, sb0 = 0, sb1 = 0;
    if (ra < rb) { sa0 = tsl[2 * ra]; sa1 = tsl[2 * ra + 1]; const int q = min(ra + 1, nrows - 1); sb0 = tsl[2 * q]; sb1 = tsl[2 * q + 1]; }
    for (int r = ra; r < rb;) {
        const int b = r < TL ? (r >> 13) : 8;
        const bool two = (r + 1 < rb) && ((r + 1 < TL ? ((r + 1) >> 13) : 8) == b);
        const int r2 = two ? r + 1 : r, rn = r2 + 1;
        if (b != bcur) { bcur = b; const float* g5 = modp(F, layer, b, 5);
#pragma unroll
            for (int j = 0; j < 4; ++j) G5[j] = *(const f32x4*)(g5 + j * 256 + cl);
            if (NORM) { const float* sh = modp(F, nl, b, 0); const float* sc = modp(F, nl, b, 1);
#pragma unroll
                for (int j = 0; j < 4; ++j) { SC[j] = 1.f + *(const f32x4*)(sc + j * 256 + cl); SH[j] = *(const f32x4*)(sh + j * 256 + cl); } } }
        float* xa = (r < TL ? outl + (size_t)r * 1024 : outc + (size_t)(r - TL) * 1024) + cl;
        float* xb = (r2 < TL ? outl + (size_t)r2 * 1024 : outc + (size_t)(r2 - TL) * 1024) + cl;
        const bf16_t* ya0 = Y + (size_t)sa0 * 1024 + cl; const bf16_t* ya1 = Y + (size_t)sa1 * 1024 + cl;
        const bf16_t* yb0 = Y + (size_t)(two ? sb0 : sa0) * 1024 + cl; const bf16_t* yb1 = Y + (size_t)(two ? sb1 : sa1) * 1024 + cl;
        f32x4 XA[4], XB[4]; u32x2 A0[4], A1[4], B0[4], B1[4];
#pragma unroll
        for (int j = 0; j < 4; ++j) { XA[j] = *(const f32x4*)(xa + j * 256); A0[j] = *(const u32x2*)(ya0 + j * 256); A1[j] = *(const u32x2*)(ya1 + j * 256); }
#pragma unroll
        for (int j = 0; j < 4; ++j) { XB[j] = *(const f32x4*)(xb + j * 256); B0[j] = *(const u32x2*)(yb0 + j * 256); B1[j] = *(const u32x2*)(yb1 + j * 256); }
        { const int q0 = min(rn, nrows - 1), q1 = min(rn + 1, nrows - 1); sa0 = tsl[2 * q0]; sa1 = tsl[2 * q0 + 1]; sb0 = tsl[2 * q1]; sb1 = tsl[2 * q1 + 1]; }
        float ssa = 0.f, ssb = 0.f;
#pragma unroll
        for (int j = 0; j < 4; ++j) {
            f32x4 y; y[0] = lo2f(A0[j].x) + lo2f(A1[j].x); y[1] = hi2f(A0[j].x) + hi2f(A1[j].x); y[2] = lo2f(A0[j].y) + lo2f(A1[j].y); y[3] = hi2f(A0[j].y) + hi2f(A1[j].y);
            XA[j] = XA[j] + G5[j] * y; *(f32x4*)(xa + j * 256) = XA[j];
            ssa += XA[j][0] * XA[j][0] + XA[j][1] * XA[j][1] + XA[j][2] * XA[j][2] + XA[j][3] * XA[j][3]; }
#pragma unroll
        for (int j = 0; j < 4; ++j) {
            f32x4 y; y[0] = lo2f(B0[j].x) + lo2f(B1[j].x); y[1] = hi2f(B0[j].x) + hi2f(B1[j].x); y[2] = lo2f(B0[j].y) + lo2f(B1[j].y); y[3] = hi2f(B0[j].y) + hi2f(B1[j].y);
            XB[j] = XB[j] + G5[j] * y;
            ssb += XB[j][0] * XB[j][0] + XB[j][1] * XB[j][1] + XB[j][2] * XB[j][2] + XB[j][3] * XB[j][3]; }
        if (two) {
#pragma unroll
            for (int j = 0; j < 4; ++j) *(f32x4*)(xb + j * 256) = XB[j]; }
        if (NORM) {
            ssa = wave_sum(ssa); ssb = wave_sum(ssb);
            const float rsa = rsqrtf(ssa * (1.f / 1024.f) + EPS), rsb = rsqrtf(ssb * (1.f / 1024.f) + EPS);
#pragma unroll
            for (int j = 0; j < 4; ++j) { const f32x4 hq = (XA[j] * rsa * NW[j]) * SC[j] + SH[j];
                u32x2 o; o.x = pack2(hq[0], hq[1]); o.y = pack2(hq[2], hq[3]); *(u32x2*)(dst + (size_t)r * 1024 + cl + j * 256) = o; }
            if (two) {
#pragma unroll
                for (int j = 0; j < 4; ++j) { const f32x4 hq = (XB[j] * rsb * NW[j]) * SC[j] + SH[j];
                    u32x2 o; o.x = pack2(hq[0], hq[1]); o.y = pack2(hq[2], hq[3]); *(u32x2*)(dst + (size_t)r2 * 1024 + cl + j * 256) = o; } }
        }
        r = rn;
    }
}
__device__ __forceinline__ void ph_moe_gemm1(const Frame& F, int layer) {
    const unsigned* info = (const unsigned*)(F.ws + WS_CTRL + C_MOE + layer * 1024) + 128;
    const int ntiles = (int)__hip_atomic_load(&info[1], __ATOMIC_RELAXED, __HIP_MEMORY_SCOPE_AGENT);
    const int* tile_e = (const int*)(F.ws + WS_R2 + R2_TILEE); const int* stok = (const int*)(F.ws + WS_R2 + R2_STOK);
    const bf16_t* W1 = (const bf16_t*)(F.ws + WS_WMOE);
    EpiMoe1P E{(bf16_t*)(F.ws + WS_R2 + R2_H)};
#if FAST_GEMM
    pg8::ProbMoe1 S{(const char*)(F.ws + WS_ACT), stok, tile_e, (const char*)W1, 1024, ntiles, F.G, F.bid};
    pg8::gemm_phase(F.lds, S, E);
#else
    for (int u = F.bid; u < ntiles * 4; u += F.G) { const int pm = u >> 2, pn = u & 3; const int e = tile_e[pm] & 31;
        ARowGather ar{(const bf16_t*)(F.ws + WS_ACT), stok, pm};
        gemm_unit_naive(F, 1024, ar, W1 + ((size_t)e * 1024 + pn * 256) * 1024, E, pm, pn); }
#endif
}
__device__ __forceinline__ void ph_moe_gemm2(const Frame& F, int layer, int k) {
    const unsigned* info = (const unsigned*)(F.ws + WS_CTRL + C_MOE + layer * 1024) + 128;
    const int nk0 = (int)__hip_atomic_load(&info[0], __ATOMIC_RELAXED, __HIP_MEMORY_SCOPE_AGENT), nall = (int)__hip_atomic_load(&info[1], __ATOMIC_RELAXED, __HIP_MEMORY_SCOPE_AGENT);
    const int tlo = k == 0 ? 0 : nk0, thi = k == 0 ? nk0 : nall;
    const int* tile_e = (const int*)(F.ws + WS_R2 + R2_TILEE);
    const bf16_t* W2 = layer ? (const bf16_t*)(F.ws + WS_W2L1) : (const bf16_t*)(F.ws + WS_WMOE) + (size_t)32 * 1024 * 1024;
    EpiMoe2 E{(const int*)(F.ws + WS_R2 + R2_STOK), (const float*)(F.ws + WS_R2 + R2_SW), F.P->out, (float*)(F.ws + WS_XC), F.mod + (size_t)layer * 9 * 6144};
#if FAST_GEMM
    pg8::ProbMoe2 S{(const char*)(F.ws + WS_R2 + R2_H), tile_e, (const char*)W2, 512, tlo, thi, F.G, F.bid};
    pg8::gemm_phase(F.lds, S, E);
#else
    for (int u = F.bid; u < (thi - tlo) * 4; u += F.G) { const int pm = tlo + (u >> 2), pn = u & 3; const int e = tile_e[pm] & 31;
        ARowDense ar{(const bf16_t*)(F.ws + WS_R2 + R2_H), 512, pm};
        gemm_unit_naive(F, 512, ar, W2 + ((size_t)e * 1024 + pn * 256) * 512, E, pm, pn); }
#endif
}

__device__ __forceinline__ void ph_gmlp(const Frame& F) {
    const Params& P = *F.P;
    const bf16_t* PX = (const bf16_t*)(F.ws + WS_PX); bf16_t* CAT = (bf16_t*)(F.ws + WS_ACT);
    LAS float* Vs = (LAS float*)F.lds;
    LAS float* Wm = Vs + 128 * 128;
    LAS float* rs = Wm + 128 * 129;
    for (int it = F.bid; it < 528 * 4; it += F.G) {
        const int ch = it >> 2, g = it & 3, row0 = ch * 128;
        for (int q = F.wave; q < 128; q += 8) { const bf16_t* p = PX + (size_t)(row0 + q) * EVEN_IN + 512 + F.lane * 8;
            const u32x4 w = *(const u32x4*)p; float s = 0.f, x;
            x = lo2f(w.x); s += x * x; x = hi2f(w.x); s += x * x; x = lo2f(w.y); s += x * x; x = hi2f(w.y); s += x * x;
            x = lo2f(w.z); s += x * x; x = hi2f(w.z); s += x * x; x = lo2f(w.w); s += x * x; x = hi2f(w.w); s += x * x;
            s = wave_sum(s); if (F.lane == 0) rs[q] = rsqrtf(s * (1.f / 512.f) + EPS); }
        __syncthreads();
        for (int i = F.tid; i < 128 * 128; i += NTH) { const int q = i >> 7, c = i & 127;
            Vs[i] = bf2f(PX[(size_t)(row0 + q) * EVEN_IN + 512 + g * 128 + c]) * rs[q] * P.in[I_GNW][g * 128 + c];
            Wm[q * 129 + c] = P.in[I_GWS][(size_t)g * 16384 + i]; }
        __syncthreads();
        const int ty = F.tid >> 5, tx = F.tid & 31;
        float acc[8][4];
#pragma unroll
        for (int i = 0; i < 8; ++i)
#pragma unroll
            for (int j = 0; j < 4; ++j) acc[i][j] = 0.f;
        for (int q = 0; q < 128; ++q) { const f32x4 v = *(const LAS f32x4*)(Vs + q * 128 + tx * 4);
#pragma unroll
            for (int i = 0; i < 8; ++i) { const float w = Wm[(ty * 8 + i) * 129 + q];
#pragma unroll
                for (int j = 0; j < 4; ++j) acc[i][j] += w * v[j]; } }
#pragma unroll
        for (int i = 0; i < 8; ++i) { const int p = ty * 8 + i; const float bias = P.in[I_GBS][g * 128 + p];
            const size_t t = (size_t)(row0 + p); const int col = g * 128 + tx * 4;
            const u32x2 uu = *(const u32x2*)(PX + t * EVEN_IN + col);
            u32x2 o; o.x = pack2(lo2f(uu.x) * (acc[i][0] + bias), hi2f(uu.x) * (acc[i][1] + bias)); o.y = pack2(lo2f(uu.y) * (acc[i][2] + bias), hi2f(uu.y) * (acc[i][3] + bias));
            *(u32x2*)(CAT + t * 1024 + col) = o; }
        __syncthreads();
    }
}

__device__ __forceinline__ void ph_gmlp_mfma(const Frame& F) {
    const Params& P = *F.P;
    const bf16_t* PX = (const bf16_t*)(F.ws + WS_PX); bf16_t* CAT = (bf16_t*)(F.ws + WS_ACT);
    LAS unsigned char* VT = F.lds;
    LAS unsigned char* WB = F.lds + 34816;
    LAS float* rs = (LAS float*)(F.lds + 69632);
    const int l31 = F.lane & 31, hh = F.lane >> 5;
    for (int it = F.bid; it < 528 * 4; it += F.G) {
        const int ch = it >> 2, g = it & 3, row0 = ch * 128;
        const int cb = F.wave >> 1, pb0 = (F.wave & 1) * 2;
        u32x4 wr[16];
#pragma unroll
        for (int i = 0; i < 16; ++i) wr[i] = *(const u32x4*)(PX + (size_t)(row0 + F.wave + 8 * i) * EVEN_IN + 512 + F.lane * 8);
        u32x4 wv[4]; f32x4 n0[4], n1[4];
#pragma unroll
        for (int k = 0; k < 4; ++k) { const int q = F.tid & 127, c0 = ((F.tid >> 7) + 4 * k) * 8;
            wv[k] = *(const u32x4*)(PX + (size_t)(row0 + q) * EVEN_IN + 512 + g * 128 + c0);
            const float* nw = P.in[I_GNW] + g * 128 + c0; n0[k] = *(const f32x4*)nw; n1[k] = *(const f32x4*)(nw + 4); }
        f32x4 wa[4], wb[4];
#pragma unroll
        for (int k = 0; k < 4; ++k) { const int c = F.tid + 512 * k, p = c >> 4, part = c & 15;
            const float* src = P.in[I_GWS] + (size_t)g * 16384 + p * 128 + part * 8; wa[k] = *(const f32x4*)src; wb[k] = *(const f32x4*)(src + 4); }
        const int p0 = 32 * pb0 + l31, p1 = p0 + 32; const float bias0 = P.in[I_GBS][g * 128 + p0], bias1 = P.in[I_GBS][g * 128 + p1];
        const size_t t0 = (size_t)(row0 + p0), t1 = (size_t)(row0 + p1);
        u32x2 u0[4], u1[4];
#pragma unroll
        for (int gq = 0; gq < 4; ++gq) { const int col = g * 128 + 32 * cb + 8 * gq + 4 * hh; u0[gq] = *(const u32x2*)(PX + t0 * EVEN_IN + col); u1[gq] = *(const u32x2*)(PX + t1 * EVEN_IN + col); }
        __builtin_amdgcn_sched_barrier(0);
#pragma unroll
        for (int i = 0; i < 16; ++i) { const u32x4 w = wr[i]; float s = 0.f, x;
            x = lo2f(w.x); s += x * x; x = hi2f(w.x); s += x * x; x = lo2f(w.y); s += x * x; x = hi2f(w.y); s += x * x;
            x = lo2f(w.z); s += x * x; x = hi2f(w.z); s += x * x; x = lo2f(w.w); s += x * x; x = hi2f(w.w); s += x * x;
            s = wave_sum(s); if (F.lane == 0) rs[F.wave + 8 * i] = rsqrtf(s * (1.f / 512.f) + EPS); }
#pragma unroll
        for (int k = 0; k < 4; ++k) { const int c = F.tid + 512 * k, p = c >> 4, part = c & 15;
            u32x4 w; w.x = pack2(wa[k][0], wa[k][1]); w.y = pack2(wa[k][2], wa[k][3]); w.z = pack2(wb[k][0], wb[k][1]); w.w = pack2(wb[k][2], wb[k][3]);
            *(LAS u32x4*)(WB + p * 272 + part * 16) = w; }
        __syncthreads();
#pragma unroll
        for (int k = 0; k < 4; ++k) { const int q = F.tid & 127, c0 = ((F.tid >> 7) + 4 * k) * 8;
            const u32x4 w = wv[k]; const float r = rs[q];
            LAS unsigned short* d = (LAS unsigned short*)(VT + c0 * 272 + q * 2);
            d[0 * 136] = f2bf(lo2f(w.x) * r * n0[k][0]); d[1 * 136] = f2bf(hi2f(w.x) * r * n0[k][1]); d[2 * 136] = f2bf(lo2f(w.y) * r * n0[k][2]); d[3 * 136] = f2bf(hi2f(w.y) * r * n0[k][3]);
            d[4 * 136] = f2bf(lo2f(w.z) * r * n1[k][0]); d[5 * 136] = f2bf(hi2f(w.z) * r * n1[k][1]); d[6 * 136] = f2bf(lo2f(w.w) * r * n1[k][2]); d[7 * 136] = f2bf(hi2f(w.w) * r * n1[k][3]); }
        __syncthreads();
        f32x16 a0, a1;
#pragma unroll
        for (int r = 0; r < 16; ++r) { a0[r] = 0.f; a1[r] = 0.f; }
#pragma unroll
        for (int ks = 0; ks < 8; ++ks) { const s16x8 va = *(const LAS s16x8*)(VT + (32 * cb + l31) * 272 + ks * 32 + hh * 16);
            a0 = __builtin_amdgcn_mfma_f32_32x32x16_bf16(va, *(const LAS s16x8*)(WB + (32 * pb0 + l31) * 272 + ks * 32 + hh * 16), a0, 0, 0, 0);
            a1 = __builtin_amdgcn_mfma_f32_32x32x16_bf16(va, *(const LAS s16x8*)(WB + (32 * (pb0 + 1) + l31) * 272 + ks * 32 + hh * 16), a1, 0, 0, 0); }
        {
#pragma unroll
          for (int gq = 0; gq < 4; ++gq) { const int col = g * 128 + 32 * cb + 8 * gq + 4 * hh;
              u32x2 o; o.x = pack2(lo2f(u0[gq].x) * (a0[4 * gq] + bias0), hi2f(u0[gq].x) * (a0[4 * gq + 1] + bias0)); o.y = pack2(lo2f(u0[gq].y) * (a0[4 * gq + 2] + bias0), hi2f(u0[gq].y) * (a0[4 * gq + 3] + bias0));
              *(u32x2*)(CAT + t0 * 1024 + col) = o;
              o.x = pack2(lo2f(u1[gq].x) * (a1[4 * gq] + bias1), hi2f(u1[gq].x) * (a1[4 * gq + 1] + bias1)); o.y = pack2(lo2f(u1[gq].y) * (a1[4 * gq + 2] + bias1), hi2f(u1[gq].y) * (a1[4 * gq + 3] + bias1));
              *(u32x2*)(CAT + t1 * 1024 + col) = o; } }
        __syncthreads();
    }
}

__device__ __forceinline__ void ph_gla(const Frame& F) {
    const Params& P = *F.P;
    const bf16_t* PX = (const bf16_t*)(F.ws + WS_PX);
    LAS float* qs = (LAS float*)F.lds;
    LAS float* fs = qs + 8192;
    LAS float* vs = fs + 8192;
    LAS float* os = vs + 2048;
    const int dg = F.lane & 15, el = F.wave * 4 + (F.lane >> 4);
    const int prow = F.tid >> 4, pd0 = (F.tid & 15) * 8;
    const int vrow = F.tid >> 2, ve0 = (F.tid & 3) * 8;
    for (int it = F.bid; it < 256; it += F.G) {
        const int b = it >> 5, h = (it >> 3) & 3, dir = (it >> 2) & 1, sl = it & 3;
        bf16_t* O = (bf16_t*)(F.ws + WS_R2 + (dir ? R2_OB0 : R2_OF0));
        float lb8[8];
#pragma unroll
        for (int i = 0; i < 8; ++i) { const int ch = h * 128 + pd0 + i; const float* lg = P.in[I_LB] + (size_t)dir * 3 * 512 + ch;
            const float a0 = lg[0], a1 = lg[512], a2 = lg[1024]; const float m = fmaxf(a0, fmaxf(a1, a2));
            const float e0 = __expf(a0 - m), e1 = __expf(a1 - m), e2 = __expf(a2 - m); lb8[i] = e0 / (e0 + e1 + e2); }
        float S[8];
#pragma unroll
        for (int i = 0; i < 8; ++i) S[i] = 0.f;
        u32x4 rq0, rq1, rf0, rf1, rv = {0u, 0u, 0u, 0u};
        auto rowof = [&](int nb, int s) -> size_t { const bool c = nb < 4; const int len = c ? CTXL : SEQ; const int tt = (c ? nb : nb - 4) * 64 + s; const int p = dir ? len - 1 - tt : tt;
            return (c ? (size_t)TL + b * CTXL : (size_t)b * SEQ) + p; };
        auto fetch = [&](int nb) { const bf16_t* r0 = PX + rowof(nb, prow) * EVEN_IN; const bf16_t* r1 = PX + rowof(nb, prow + 32) * EVEN_IN;
            rq0 = *(const u32x4*)(r0 + 1024 + h * 128 + pd0); rf0 = *(const u32x4*)(r0 + 2048 + dir * 512 + h * 128 + pd0);
            rq1 = *(const u32x4*)(r1 + 1024 + h * 128 + pd0); rf1 = *(const u32x4*)(r1 + 2048 + dir * 512 + h * 128 + pd0);
            if (F.tid < 256) rv = *(const u32x4*)(PX + rowof(nb, vrow) * EVEN_IN + 1536 + h * 128 + sl * 32 + ve0); };
        auto put = [&](int row, u32x4 q, u32x4 f) { LAS float* qd = qs + row * 128 + pd0; LAS float* fd = fs + row * 128 + pd0;
            const float q8[8] = {lo2f(q.x), hi2f(q.x), lo2f(q.y), hi2f(q.y), lo2f(q.z), hi2f(q.z), lo2f(q.w), hi2f(q.w)};
            const float f8[8] = {lo2f(f.x), hi2f(f.x), lo2f(f.y), hi2f(f.y), lo2f(f.z), hi2f(f.z), lo2f(f.w), hi2f(f.w)};
            f32x4 o0, o1, g0, g1;
#pragma unroll
            for (int i = 0; i < 4; ++i) { o0[i] = q8[i]; o1[i] = q8[4 + i]; g0[i] = lb8[i] + (1.f - lb8[i]) * sigmoid_f(f8[i]); g1[i] = lb8[4 + i] + (1.f - lb8[4 + i]) * sigmoid_f(f8[4 + i]); }
            *(LAS f32x4*)qd = o0; *(LAS f32x4*)(qd + 4) = o1; *(LAS f32x4*)fd = g0; *(LAS f32x4*)(fd + 4) = g1; };
        fetch(0);
        for (int nb = 0; nb < 132; ++nb) {
            __syncthreads();
            put(prow, rq0, rf0); put(prow + 32, rq1, rf1);
            if (F.tid < 256) { LAS float* vd = vs + vrow * 32 + ve0;
                *(LAS f32x4*)vd = (f32x4){lo2f(rv.x), hi2f(rv.x), lo2f(rv.y), hi2f(rv.y)}; *(LAS f32x4*)(vd + 4) = (f32x4){lo2f(rv.z), hi2f(rv.z), lo2f(rv.w), hi2f(rv.w)}; }
            __syncthreads();
            if (nb + 1 < 132) fetch(nb + 1);
#pragma unroll 4
            for (int st = 0; st < 64; ++st) {
                const f32x4 fa = *(const LAS f32x4*)(fs + st * 128 + dg * 8), fb = *(const LAS f32x4*)(fs + st * 128 + dg * 8 + 4);
                const f32x4 qa = *(const LAS f32x4*)(qs + st * 128 + dg * 8), qb = *(const LAS f32x4*)(qs + st * 128 + dg * 8 + 4);
                const float v = vs[st * 32 + el];
                float p0 = 0.f, p1 = 0.f;
#pragma unroll
                for (int i = 0; i < 4; ++i) { S[i] = fa[i] * (S[i] - v) + v; p0 += qa[i] * S[i]; S[4 + i] = fb[i] * (S[4 + i] - v) + v; p1 += qb[i] * S[4 + i]; }
                const float o = sum16(p0 + p1);
                if (dg == 0) os[st * 32 + el] = o;
            }
            __syncthreads();
#pragma unroll
            for (int k = 0; k < 2; ++k) { const int s = (F.tid >> 4) + 32 * k, e2 = (F.tid & 15) * 2;
              *(unsigned*)(O + rowof(nb, s) * 512 + h * 128 + sl * 32 + e2) = pack2(os[s * 32 + e2], os[s * 32 + e2 + 1]); }
        }
        __syncthreads();
    }
}

constexpr size_t R2_GU = 0, R2_GD = 264 * MiB;
constexpr int GS = 132;
__device__ __forceinline__ void gla_geom(int u, int& b, int& h, int& ck, size_t& rbase, int& p0) {
    b = u / 528; h = (u % 528) / 132; ck = u % 132;
    if (ck < 4) { rbase = (size_t)TL + b * CTXL; p0 = ck * 64; } else { rbase = (size_t)b * SEQ; p0 = (ck - 4) * 64; }
}
typedef short s16x4t __attribute__((ext_vector_type(4)));
__device__ __forceinline__ s16x8 ldtr2(const LAS unsigned char* p0, const LAS unsigned char* p1) {
    const s16x4t a = __builtin_amdgcn_ds_read_tr16_b64_v4i16((LAS s16x4t*)p0), b = __builtin_amdgcn_ds_read_tr16_b64_v4i16((LAS s16x4t*)p1);
    return __builtin_shufflevector(a, b, 0, 1, 2, 3, 4, 5, 6, 7); }
__device__ __forceinline__ void gla_prep_dir(const Frame& F, int dir, int h, u32x4 fw0, u32x4 fw1, LAS float* G, LAS unsigned char* KB) {
    { const int part = F.tid & 15;
      const float* lbt = (const float*)(F.ws + WS_CTRL + C_LBT) + dir * 512 + h * 128 + part * 8;
      const f32x4 la = *(const f32x4*)lbt, lb = *(const f32x4*)(lbt + 4);
      const float lb8[8] = {la[0], la[1], la[2], la[3], lb[0], lb[1], lb[2], lb[3]};
#pragma unroll
      for (int k = 0; k < 2; ++k) { const int i = (F.tid >> 4) + 32 * k, il = dir ? 63 - i : i;
          const u32x4 w = k ? fw1 : fw0;
          const float fr[8] = {lo2f(w.x), hi2f(w.x), lo2f(w.y), hi2f(w.y), lo2f(w.z), hi2f(w.z), lo2f(w.w), hi2f(w.w)};
          float f[8], kk[8];
#pragma unroll
          for (int j = 0; j < 8; ++j) { f[j] = lb8[j] + (1.f - lb8[j]) * sigmoid_f(fr[j]); kk[j] = 1.f - f[j]; f[j] = __builtin_amdgcn_logf(f[j]); }
          *(LAS f32x4*)(G + il * GS + part * 8) = (f32x4){f[0], f[1], f[2], f[3]}; *(LAS f32x4*)(G + il * GS + part * 8 + 4) = (f32x4){f[4], f[5], f[6], f[7]};
          u32x4 kw; kw.x = pack2(kk[0], kk[1]); kw.y = pack2(kk[2], kk[3]); kw.z = pack2(kk[4], kk[5]); kw.w = pack2(kk[6], kk[7]);
          *(LAS u32x4*)(KB + il * 272 + part * 16) = kw; } }
    __syncthreads();
    const int d = F.tid & 127, seg = F.tid >> 7;
    LAS float* TOT = (LAS float*)(F.lds + 120000);
    float v[16];
#pragma unroll
    for (int r = 0; r < 16; ++r) v[r] = G[(seg * 16 + r) * GS + d];
    float run = 0.f;
#pragma unroll
    for (int r = 0; r < 16; ++r) { run += v[r]; v[r] = run; }
    TOT[seg * 128 + d] = run;
    __syncthreads();
    float off = 0.f;
#pragma unroll
    for (int s2 = 0; s2 < 3; ++s2) off += (s2 < seg) ? TOT[s2 * 128 + d] : 0.f;
#pragma unroll
    for (int r = 0; r < 16; ++r) G[(seg * 16 + r) * GS + d] = v[r] + off;
    __syncthreads();
}
__device__ __forceinline__ void ph_gla_p1(const Frame& F) {
    const bf16_t* PX = (const bf16_t*)(F.ws + WS_PX);
    LAS float* G = (LAS float*)F.lds;
    LAS unsigned char* KB = F.lds + 33792;
    LAS unsigned char* VT = F.lds + 33792 + 17408;
    LAS unsigned char* KT = VT + 20480;
    const int l31 = F.lane & 31, hh = F.lane >> 5;
    const LAS unsigned char* trV = VT + (8 * hh + ((F.lane >> 2) & 3)) * 320 + (16 * ((F.lane >> 4) & 1) + 4 * (F.lane & 3)) * 2;
    u32x4 fw[4], vw[2];
    auto fetch = [&](int u_) { int b_, h_, ck_, p0_; size_t rb_; gla_geom(u_, b_, h_, ck_, rb_, p0_);
#pragma unroll
        for (int q = 0; q < 4; ++q) fw[q] = *(const u32x4*)(PX + (rb_ + p0_ + (F.tid >> 4) + 32 * (q & 1)) * EVEN_IN + 2048 + (q >> 1) * 512 + h_ * 128 + (F.tid & 15) * 8);
#pragma unroll
        for (int k = 0; k < 2; ++k) { const int c = F.tid + 512 * k, i = c >> 4, part = c & 15;
            vw[k] = *(const u32x4*)(PX + (rb_ + p0_ + i) * EVEN_IN + 1536 + h_ * 128 + part * 8); } };
    if (F.bid < 4224) fetch(F.bid);
    for (int u = F.bid; u < 4224; u += F.G) {
        int b, h, ck, p0; size_t rbase; gla_geom(u, b, h, ck, rbase, p0);
        (void)b; (void)ck; (void)rbase; (void)p0;
#pragma unroll
        for (int k = 0; k < 2; ++k) { const int c = F.tid + 512 * k, i = c >> 4, part = c & 15;
            const u32x4 w = vw[k];
            *(LAS u32x4*)(VT + i * 320 + part * 16) = w; }
        const u32x4 f0 = fw[0], f1 = fw[1], f2 = fw[2], f3 = fw[3];
        for (int dir = 0; dir < 2; ++dir) {
            gla_prep_dir(F, dir, h, dir ? f2 : f0, dir ? f3 : f1, G, KB);
            if (dir == 1 && u + F.G < 4224) fetch(u + F.G);
#pragma unroll
            for (int k = 0; k < 2; ++k) { const int c = F.tid + 512 * k, il = c & 63, part = c >> 6, i = dir ? 63 - il : il;
                const u32x4 kw = *(const LAS u32x4*)(KB + il * 272 + part * 16);
                const float kk[8] = {lo2f(kw.x), hi2f(kw.x), lo2f(kw.y), hi2f(kw.y), lo2f(kw.z), hi2f(kw.z), lo2f(kw.w), hi2f(kw.w)};
                const f32x4 g0 = *(const LAS f32x4*)(G + il * GS + part * 8), g1 = *(const LAS f32x4*)(G + il * GS + part * 8 + 4);
                const f32x4 l0 = *(const LAS f32x4*)(G + 63 * GS + part * 8), l1 = *(const LAS f32x4*)(G + 63 * GS + part * 8 + 4);
                LAS unsigned short* dd = (LAS unsigned short*)(KT + (part * 8) * 144 + i * 2);
#pragma unroll
                for (int j = 0; j < 4; ++j) { dd[j * 72] = f2bf(kk[j] * __builtin_amdgcn_exp2f(l0[j] - g0[j])); dd[(4 + j) * 72] = f2bf(kk[4 + j] * __builtin_amdgcn_exp2f(l1[j] - g1[j])); } }
            if (F.tid < 128) ((float*)(F.ws + WS_R2 + R2_GD))[(size_t)(u * 2 + dir) * 128 + F.tid] = __builtin_amdgcn_exp2f(G[63 * GS + F.tid]);
            __syncthreads();
            { const int db = F.wave >> 1, eb0 = (F.wave & 1) * 2;
              f32x16 a0, a1;
#pragma unroll
              for (int r = 0; r < 16; ++r) { a0[r] = 0.f; a1[r] = 0.f; }
#pragma unroll
              for (int ks = 0; ks < 4; ++ks) { const s16x8 ka = *(const LAS s16x8*)(KT + (32 * db + l31) * 144 + ks * 32 + hh * 16);
                  a0 = __builtin_amdgcn_mfma_f32_32x32x16_bf16(ka, ldtr2(trV + (16 * ks) * 320 + 64 * eb0, trV + (16 * ks + 4) * 320 + 64 * eb0), a0, 0, 0, 0);
                  a1 = __builtin_amdgcn_mfma_f32_32x32x16_bf16(ka, ldtr2(trV + (16 * ks) * 320 + 64 * (eb0 + 1), trV + (16 * ks + 4) * 320 + 64 * (eb0 + 1)), a1, 0, 0, 0); }
              bf16_t* ut = (bf16_t*)(F.ws + WS_R2 + R2_GU) + (size_t)(u * 2 + dir) * 16384;
#pragma unroll
              for (int gq = 0; gq < 4; ++gq) { const int d0 = 32 * db + 8 * gq + 4 * hh; u32x2 x;
                  x.x = pack2(a0[4 * gq], a0[4 * gq + 1]); x.y = pack2(a0[4 * gq + 2], a0[4 * gq + 3]); *(u32x2*)(ut + (32 * eb0 + l31) * 128 + d0) = x;
                  x.x = pack2(a1[4 * gq], a1[4 * gq + 1]); x.y = pack2(a1[4 * gq + 2], a1[4 * gq + 3]); *(u32x2*)(ut + (32 * (eb0 + 1) + l31) * 128 + d0) = x; } }
            __syncthreads();
        }
    }
}
__device__ __forceinline__ void ph_gla_p2(const Frame& F) {
    bf16_t* GU = (bf16_t*)(F.ws + WS_R2 + R2_GU); const float* GD = (const float*)(F.ws + WS_R2 + R2_GD);
    for (int v = gtid(F); v < 64 * 2048; v += F.G * NTH) {
        const int chain = v >> 11, vec = v & 2047, d0 = (vec & 15) * 8;
        const int bh = chain >> 1, dir = chain & 1;
        float s[8];
#pragma unroll
        for (int j = 0; j < 8; ++j) s[j] = 0.f;
#pragma unroll 1
        for (int nb = 0; nb < 132; nb += 12) {
            u32x4 W[12]; f32x4 C0[12], C1[12];
#pragma unroll
            for (int k = 0; k < 12; ++k) { const int n = nb + k, ck = dir ? (n < 4 ? 3 - n : 135 - n) : n; const size_t ud = (size_t)(bh * 132 + ck) * 2 + dir;
                W[k] = *(const u32x4*)(GU + ud * 16384 + (size_t)vec * 8); C0[k] = *(const f32x4*)(GD + ud * 128 + d0); C1[k] = *(const f32x4*)(GD + ud * 128 + d0 + 4); }
#pragma unroll
            for (int k = 0; k < 12; ++k) { const int n = nb + k, ck = dir ? (n < 4 ? 3 - n : 135 - n) : n; const size_t ud = (size_t)(bh * 132 + ck) * 2 + dir;
                const u32x4 w = W[k]; const f32x4 c0 = C0[k], c1 = C1[k];
                u32x4 o; o.x = pack2(s[0], s[1]); o.y = pack2(s[2], s[3]); o.z = pack2(s[4], s[5]); o.w = pack2(s[6], s[7]); *(u32x4*)(GU + ud * 16384 + (size_t)vec * 8) = o;
                s[0] = c0[0] * s[0] + lo2f(w.x); s[1] = c0[1] * s[1] + hi2f(w.x); s[2] = c0[2] * s[2] + lo2f(w.y); s[3] = c0[3] * s[3] + hi2f(w.y);
                s[4] = c1[0] * s[4] + lo2f(w.z); s[5] = c1[1] * s[5] + hi2f(w.z); s[6] = c1[2] * s[6] + lo2f(w.w); s[7] = c1[3] * s[7] + hi2f(w.w); }
        }
    }
}
__device__ __forceinline__ void ph_gla_p3(const Frame& F) {
    const Params& P = *F.P;
    const bf16_t* PX = (const bf16_t*)(F.ws + WS_PX); bf16_t* CAT = (bf16_t*)(F.ws + WS_ACT);
    LAS float* G = (LAS float*)F.lds;
    LAS unsigned char* KB = F.lds + 33792;
    LAS unsigned char* VT = KB + 17408;
    LAS unsigned char* QB = VT + 20480;
    LAS unsigned char* QT = QB + 17408;
    LAS unsigned char* AM = QT + 17408;
    LAS float* RS = (LAS float*)(AM + 9216);
    const int l31 = F.lane & 31, hh = F.lane >> 5, l15 = F.lane & 15, kq = F.lane >> 4;
    const LAS unsigned char* trV = VT + (8 * hh + ((F.lane >> 2) & 3)) * 320 + (16 * ((F.lane >> 4) & 1) + 4 * (F.lane & 3)) * 2;
    u32x4 fw[4], vw[2], qw2[2];
    auto fetch = [&](int u_) { int b_, h_, ck_, p0_; size_t rb_; gla_geom(u_, b_, h_, ck_, rb_, p0_);
#pragma unroll
        for (int q = 0; q < 4; ++q) fw[q] = *(const u32x4*)(PX + (rb_ + p0_ + (F.tid >> 4) + 32 * (q & 1)) * EVEN_IN + 2048 + (q >> 1) * 512 + h_ * 128 + (F.tid & 15) * 8);
#pragma unroll
        for (int k = 0; k < 2; ++k) { const int c = F.tid + 512 * k, i = c >> 4, part = c & 15; const bf16_t* row = PX + (rb_ + p0_ + i) * EVEN_IN;
            vw[k] = *(const u32x4*)(row + 1536 + h_ * 128 + part * 8); qw2[k] = *(const u32x4*)(row + 1024 + h_ * 128 + part * 8); } };
    if (F.bid < 4224) fetch(F.bid);
    for (int u = F.bid; u < 4224; u += F.G) {
        int b, h, ck, p0; size_t rbase; gla_geom(u, b, h, ck, rbase, p0);
#pragma unroll
        for (int k = 0; k < 2; ++k) { const int c = F.tid + 512 * k, i = c >> 4, part = c & 15;
            const u32x4 w = vw[k];
            *(LAS u32x4*)(VT + i * 320 + part * 16) = w;
            *(LAS u32x4*)(QB + i * 272 + part * 16) = qw2[k]; }
        const u32x4 f0 = fw[0], f1 = fw[1], f2 = fw[2], f3 = fw[3];
        const int eb = F.wave >> 1, ib = F.wave & 1;
        f32x16 acc;
#pragma unroll
        for (int r = 0; r < 16; ++r) acc[r] = 0.f;
        for (int dir = 0; dir < 2; ++dir) {
            s16x8 sf[8];
            { const bf16_t* st = (const bf16_t*)(F.ws + WS_R2 + R2_GU) + (size_t)(u * 2 + dir) * 16384 + (size_t)(32 * eb + l31) * 128 + hh * 8;
#pragma unroll
              for (int ds = 0; ds < 8; ++ds) sf[ds] = *(const s16x8*)(st + ds * 16); }
            gla_prep_dir(F, dir, h, dir ? f2 : f0, dir ? f3 : f1, G, KB);
            if (dir == 1 && u + F.G < 4224) fetch(u + F.G);
#pragma unroll
            for (int k = 0; k < 2; ++k) { const int c = F.tid + 512 * k, i = c >> 4, part = c & 15, il = dir ? 63 - i : i;
                const u32x4 qw = *(const LAS u32x4*)(QB + i * 272 + part * 16);
                const f32x4 g0 = *(const LAS f32x4*)(G + il * GS + part * 8), g1 = *(const LAS f32x4*)(G + il * GS + part * 8 + 4);
                u32x4 o; o.x = pack2(lo2f(qw.x) * __builtin_amdgcn_exp2f(g0[0]), hi2f(qw.x) * __builtin_amdgcn_exp2f(g0[1])); o.y = pack2(lo2f(qw.y) * __builtin_amdgcn_exp2f(g0[2]), hi2f(qw.y) * __builtin_amdgcn_exp2f(g0[3]));
                o.z = pack2(lo2f(qw.z) * __builtin_amdgcn_exp2f(g1[0]), hi2f(qw.z) * __builtin_amdgcn_exp2f(g1[1])); o.w = pack2(lo2f(qw.w) * __builtin_amdgcn_exp2f(g1[2]), hi2f(qw.w) * __builtin_amdgcn_exp2f(g1[3]));
                *(LAS u32x4*)(QT + i * 272 + part * 16) = o; }
            for (int c = F.tid; c < 576; c += NTH) *(LAS u32x4*)(AM + c * 16) = (u32x4){0u, 0u, 0u, 0u};
            __syncthreads();
            for (int blk = F.wave; blk < 10; blk += 8) {
                const int I = blk < 1 ? 0 : (blk < 3 ? 1 : (blk < 6 ? 2 : 3)); const int J = blk - (I * (I + 1)) / 2;
                const int ia = 16 * I + l15, ja = 16 * J + l15;
                const int ina = dir ? 63 - ia : ia;
                f32x4 ac = {0.f, 0.f, 0.f, 0.f};
#pragma unroll
                for (int ks = 0; ks < 4; ++ks) { const int d0 = 32 * ks + 8 * kq;
                    f32x4 r0 = {0.f, 0.f, 0.f, 0.f}, r1 = {0.f, 0.f, 0.f, 0.f};
                    if (I > 0) { r0 = *(const LAS f32x4*)(G + (16 * I - 1) * GS + d0); r1 = *(const LAS f32x4*)(G + (16 * I - 1) * GS + d0 + 4); }
                    const f32x4 gi0 = *(const LAS f32x4*)(G + ia * GS + d0), gi1 = *(const LAS f32x4*)(G + ia * GS + d0 + 4);
                    const f32x4 gj0 = *(const LAS f32x4*)(G + ja * GS + d0), gj1 = *(const LAS f32x4*)(G + ja * GS + d0 + 4);
                    const u32x4 qw = *(const LAS u32x4*)(QB + ina * 272 + d0 * 2), kw = *(const LAS u32x4*)(KB + ja * 272 + d0 * 2);
                    u32x4 af, bf;
                    af.x = pack2(lo2f(qw.x) * __builtin_amdgcn_exp2f(gi0[0] - r0[0]), hi2f(qw.x) * __builtin_amdgcn_exp2f(gi0[1] - r0[1])); af.y = pack2(lo2f(qw.y) * __builtin_amdgcn_exp2f(gi0[2] - r0[2]), hi2f(qw.y) * __builtin_amdgcn_exp2f(gi0[3] - r0[3]));
                    af.z = pack2(lo2f(qw.z) * __builtin_amdgcn_exp2f(gi1[0] - r1[0]), hi2f(qw.z) * __builtin_amdgcn_exp2f(gi1[1] - r1[1])); af.w = pack2(lo2f(qw.w) * __builtin_amdgcn_exp2f(gi1[2] - r1[2]), hi2f(qw.w) * __builtin_amdgcn_exp2f(gi1[3] - r1[3]));
                    bf.x = pack2(lo2f(kw.x) * __builtin_amdgcn_exp2f(fminf(r0[0] - gj0[0], 115.f)), hi2f(kw.x) * __builtin_amdgcn_exp2f(fminf(r0[1] - gj0[1], 115.f))); bf.y = pack2(lo2f(kw.y) * __builtin_amdgcn_exp2f(fminf(r0[2] - gj0[2], 115.f)), hi2f(kw.y) * __builtin_amdgcn_exp2f(fminf(r0[3] - gj0[3], 115.f)));
                    bf.z = pack2(lo2f(kw.z) * __builtin_amdgcn_exp2f(fminf(r1[0] - gj1[0], 115.f)), hi2f(kw.z) * __builtin_amdgcn_exp2f(fminf(r1[1] - gj1[1], 115.f))); bf.w = pack2(lo2f(kw.w) * __builtin_amdgcn_exp2f(fminf(r1[2] - gj1[2], 115.f)), hi2f(kw.w) * __builtin_amdgcn_exp2f(fminf(r1[3] - gj1[3], 115.f)));
                    ac = __builtin_amdgcn_mfma_f32_16x16x32_bf16(__builtin_bit_cast(s16x8, af), __builtin_bit_cast(s16x8, bf), ac, 0, 0, 0); }
#pragma unroll
                for (int rg = 0; rg < 4; ++rg) { const int il = 16 * I + 4 * kq + rg, jl = 16 * J + l15; const float val = (jl <= il) ? ac[rg] : 0.f;
                    const int in_ = dir ? 63 - il : il, jn = dir ? 63 - jl : jl;
                    *(LAS bf16_t*)(AM + in_ * 144 + jn * 2) = f2bf(val); }
            }
            __syncthreads();
            {
#pragma unroll
              for (int ds = 0; ds < 8; ++ds) acc = __builtin_amdgcn_mfma_f32_32x32x16_bf16(sf[ds], *(const LAS s16x8*)(QT + (32 * ib + l31) * 272 + ds * 32 + hh * 16), acc, 0, 0, 0);
#pragma unroll
              for (int js = 0; js < 4; ++js) acc = __builtin_amdgcn_mfma_f32_32x32x16_bf16(ldtr2(trV + (16 * js) * 320 + 64 * eb, trV + (16 * js + 4) * 320 + 64 * eb), *(const LAS s16x8*)(AM + (32 * ib + l31) * 144 + js * 32 + hh * 16), acc, 0, 0, 0); }
            __syncthreads();
        }
        { float ss = 0.f;
#pragma unroll
          for (int r = 0; r < 16; ++r) ss += acc[r] * acc[r];
          auto t = __builtin_amdgcn_permlane32_swap(__float_as_uint(ss), __float_as_uint(ss), false, false);
          ss = __uint_as_float(t[0]) + __uint_as_float(t[1]);
          if (hh == 0) RS[eb * 64 + 32 * ib + l31] = ss;
          __syncthreads();
          const int i = 32 * ib + l31; const float tot = RS[i] + RS[64 + i] + RS[128 + i] + RS[192 + i];
          const float rstd = rsqrtf(tot * (1.f / 128.f) + EPS);
          const size_t row = rbase + p0 + i;
#pragma unroll
          for (int gq = 0; gq < 4; ++gq) { const int e0 = 32 * eb + 8 * gq + 4 * hh; const int ch = h * 128 + e0;
              const u32x2 gw = *(const u32x2*)(PX + row * EVEN_IN + 3072 + ch); const f32x4 nw = *(const f32x4*)(P.in[I_HNW] + ch);
              u32x2 o; o.x = pack2(acc[4 * gq] * rstd * nw[0] * silu_f(lo2f(gw.x)), acc[4 * gq + 1] * rstd * nw[1] * silu_f(hi2f(gw.x)));
              o.y = pack2(acc[4 * gq + 2] * rstd * nw[2] * silu_f(lo2f(gw.y)), acc[4 * gq + 3] * rstd * nw[3] * silu_f(hi2f(gw.y)));
              *(u32x2*)(CAT + row * 1024 + 512 + ch) = o; }
          __syncthreads(); }
    }
}

__device__ __forceinline__ void ph_merge(const Frame& F, int mode) {
    const Params& P = *F.P;
    const bf16_t* PX = (const bf16_t*)(F.ws + WS_PX); bf16_t* CAT = (bf16_t*)(F.ws + WS_ACT);
    const bf16_t* Of = (const bf16_t*)(mode ? F.ws + WS_GOF : F.ws + WS_R2 + R2_OF0); const bf16_t* Ob = (const bf16_t*)(mode ? F.ws + WS_WMOE : F.ws + WS_R2 + R2_OB0);
    const int nrows = mode ? TL : TT, ldp = mode ? ODD_PAD : EVEN_IN, gcol = mode ? 1536 : 3072, dcol = mode ? 0 : 512;
    const float* nw = mode ? P.in[I_GDNNW] : P.in[I_HNW];
    const int per = (nrows + F.G * 8 - 1) / (F.G * 8);
    const int ra = (F.bid * 8 + F.wave) * per, rb = min(nrows, ra + per);
    const int c = F.lane * 8;
    float nwv[8];
#pragma unroll
    for (int i = 0; i < 8; ++i) nwv[i] = mode ? nw[(c & 127) + i] : nw[c + i];
    for (int r = ra; r < rb; r += 4) {
        u32x4 a[4], bb[4], gg[4];
#pragma unroll
        for (int k = 0; k < 4; ++k) { const int rr = min(r + k, rb - 1);
            a[k] = *(const u32x4*)(Of + (size_t)rr * 512 + c); bb[k] = *(const u32x4*)(Ob + (size_t)rr * 512 + c); gg[k] = *(const u32x4*)(PX + (size_t)rr * ldp + gcol + c); }
#pragma unroll
        for (int k = 0; k < 4; ++k) {
            float o[8] = {lo2f(a[k].x) + lo2f(bb[k].x), hi2f(a[k].x) + hi2f(bb[k].x), lo2f(a[k].y) + lo2f(bb[k].y), hi2f(a[k].y) + hi2f(bb[k].y),
                          lo2f(a[k].z) + lo2f(bb[k].z), hi2f(a[k].z) + hi2f(bb[k].z), lo2f(a[k].w) + lo2f(bb[k].w), hi2f(a[k].w) + hi2f(bb[k].w)};
            const float g[8] = {lo2f(gg[k].x), hi2f(gg[k].x), lo2f(gg[k].y), hi2f(gg[k].y), lo2f(gg[k].z), hi2f(gg[k].z), lo2f(gg[k].w), hi2f(gg[k].w)};
            float ss = 0.f;
#pragma unroll
            for (int i = 0; i < 8; ++i) ss += o[i] * o[i];
            ss = sum16(ss);
            const float rstd = rsqrtf(ss * (1.f / 128.f) + EPS);
            float y[8];
#pragma unroll
            for (int i = 0; i < 8; ++i) y[i] = o[i] * rstd * nwv[i] * silu_f(g[i]);
            u32x4 w; w.x = pack2(y[0], y[1]); w.y = pack2(y[2], y[3]); w.z = pack2(y[4], y[5]); w.w = pack2(y[6], y[7]);
            if (r + k < rb) *(u32x4*)(CAT + (size_t)(r + k) * 1024 + dcol + c) = w; }
    }
}
__device__ __forceinline__ void ph_mla_norm(const Frame& F) {
    const Params& P = *F.P;
    const bf16_t* PX = (const bf16_t*)(F.ws + WS_PX);
    bf16_t* cqn = (bf16_t*)(F.ws + WS_R2 + R2_CQN); bf16_t* ckvn = cqn + (size_t)TL * 256;
    const int per = (TT + F.G * 8 - 1) / (F.G * 8);
    const int ra = (F.bid * 8 + F.wave) * per, rb = min(TT, ra + per);
    const f32x4 nq = *(const f32x4*)(P.in[I_QNW] + F.lane * 4);
    const float nk0 = P.in[I_KVNW][F.lane * 2], nk1 = P.in[I_KVNW][F.lane * 2 + 1];
    for (int r = ra; r < rb; r += 8) {
        u32x2 wq[8]; unsigned wk[8];
#pragma unroll
        for (int k = 0; k < 8; ++k) { const int rr = min(r + k, rb - 1); const bf16_t* row = PX + (size_t)rr * ODD_PAD;
            wq[k] = *(const u32x2*)(row + 2064 + F.lane * 4); wk[k] = *(const unsigned*)(row + 2320 + F.lane * 2); }
#pragma unroll
        for (int k = 0; k < 8; ++k) { const int rr = r + k;
            if (rr < rb) {
                if (rr < TL) { const float x0 = lo2f(wq[k].x), x1 = hi2f(wq[k].x), x2 = lo2f(wq[k].y), x3 = hi2f(wq[k].y);
                    const float ss = wave_sum(x0 * x0 + x1 * x1 + x2 * x2 + x3 * x3); const float rstd = rsqrtf(ss * (1.f / 256.f) + EPS);
                    u32x2 o; o.x = pack2(x0 * rstd * nq[0], x1 * rstd * nq[1]); o.y = pack2(x2 * rstd * nq[2], x3 * rstd * nq[3]);
                    *(u32x2*)(cqn + (size_t)rr * 256 + F.lane * 4) = o; }
                { const float x0 = lo2f(wk[k]), x1 = hi2f(wk[k]);
                  const float ss = wave_sum(x0 * x0 + x1 * x1); const float rstd = rsqrtf(ss * (1.f / 128.f) + EPS);
                  *(unsigned*)(ckvn + (size_t)rr * 256 + F.lane * 2) = pack2(x0 * rstd * nk0, x1 * rstd * nk1);
                  *(unsigned*)(ckvn + (size_t)rr * 256 + 128 + F.lane * 2) = 0u; } } }
    }
}

struct MlaRowIn { u32x4 kw, vv, qw; bf16_t kr[4], qr[4]; };
__device__ __forceinline__ void ph_mla_final(const Frame& F) {
    const Params& P = *F.P;
    const bf16_t* PX = (const bf16_t*)(F.ws + WS_PX);
    bf16_t* Q = (bf16_t*)(F.ws + WS_WMOE);
    const bf16_t* KVR = (const bf16_t*)(F.ws + WS_PX + PX_KVRAW);
    bf16_t* Kb = (bf16_t*)(F.ws + WS_R2 + R2_K); bf16_t* Vb = (bf16_t*)(F.ws + WS_R2 + R2_V);
    const int hh = F.lane >> 3, sub = F.lane & 7;
    const float freq = __powf(10000.f, -(float)sub * 0.125f);
    const float qscale = 0.10206207261596577f * 1.4426950408889634f;
    float nwk[12], nwq[12];
#pragma unroll
    for (int i = 0; i < 8; ++i) { nwk[i] = P.in[I_QKK][sub * 8 + i]; nwq[i] = P.in[I_QKQ][sub * 8 + i]; }
#pragma unroll
    for (int i = 0; i < 4; ++i) { nwk[8 + i] = P.in[I_QKK][64 + 8 * i + sub]; nwq[8 + i] = P.in[I_QKQ][64 + 8 * i + sub]; }
    auto load_row = [&](int r) -> MlaRowIn { MlaRowIn in;
        const bf16_t* kv = KVR + (size_t)r * 1024 + hh * 128;
        in.kw = *(const u32x4*)(kv + sub * 8); in.vv = *(const u32x4*)(kv + 64 + sub * 8);
        const bf16_t* kr = PX + (size_t)r * ODD_PAD + 2448;
#pragma unroll
        for (int i = 0; i < 4; ++i) in.kr[i] = kr[8 * i + sub];
        const bf16_t* q = Q + (size_t)(r < TL ? r : 0) * 768 + hh * 96;
        in.qw = *(const u32x4*)(q + sub * 8);
#pragma unroll
        for (int i = 0; i < 4; ++i) in.qr[i] = q[64 + 8 * i + sub];
        return in; };
    auto proc_row = [&](int r, const MlaRowIn& in) {
        const bool lat = r < TL; const int l = r & (SEQ - 1);
        float ca = 1.f, sa = 0.f, cb = 1.f, sb = 0.f;
        if (lat) { const float pr = (float)(l >> 6), pc = (float)(l & 63); sa = __sinf(pr * freq); ca = __cosf(pr * freq); sb = __sinf(pc * freq); cb = __cosf(pc * freq); }
        { const u32x4 w = in.kw;
          float x[12] = {lo2f(w.x), hi2f(w.x), lo2f(w.y), hi2f(w.y), lo2f(w.z), hi2f(w.z), lo2f(w.w), hi2f(w.w), bf2f(in.kr[0]), bf2f(in.kr[1]), bf2f(in.kr[2]), bf2f(in.kr[3])};
          float ss = 0.f;
#pragma unroll
          for (int i = 0; i < 12; ++i) ss += x[i] * x[i];
          ss = sum8(ss);
          const float rstd = rsqrtf(ss * (1.f / 96.f) + EPS);
#pragma unroll
          for (int i = 0; i < 12; ++i) x[i] *= rstd * nwk[i];
          const float a1 = x[8] * ca - x[9] * sa, a2 = x[9] * ca + x[8] * sa, b1 = x[10] * cb - x[11] * sb, b2 = x[11] * cb + x[10] * sb;
          const int bidx = lat ? (r >> 13) : ((r - TL) >> 8); const int s_ = lat ? (CTXL + l) : ((r - TL) & 255);
          bf16_t* kd = Kb + ((size_t)(bidx * 8 + hh) * (SEQ + CTXL) + s_) * 96;
          u32x4 o; o.x = pack2(x[0], x[1]); o.y = pack2(x[2], x[3]); o.z = pack2(x[4], x[5]); o.w = pack2(x[6], x[7]);
          *(u32x4*)(kd + sub * 8) = o;
          kd[64 + sub] = f2bf(a1); kd[72 + sub] = f2bf(a2); kd[80 + sub] = f2bf(b1); kd[88 + sub] = f2bf(b2);
          *(u32x4*)(Vb + ((size_t)(bidx * 8 + hh) * (SEQ + CTXL) + s_) * 64 + sub * 8) = in.vv; }
        if (lat) { bf16_t* q = Q + (size_t)r * 768 + hh * 96;
          const u32x4 w = in.qw;
          float x[12] = {lo2f(w.x), hi2f(w.x), lo2f(w.y), hi2f(w.y), lo2f(w.z), hi2f(w.z), lo2f(w.w), hi2f(w.w), bf2f(in.qr[0]), bf2f(in.qr[1]), bf2f(in.qr[2]), bf2f(in.qr[3])};
          float ss = 0.f;
#pragma unroll
          for (int i = 0; i < 12; ++i) ss += x[i] * x[i];
          ss = sum8(ss);
          const float rstd = rsqrtf(ss * (1.f / 96.f) + EPS) * qscale;
#pragma unroll
          for (int i = 0; i < 12; ++i) x[i] *= rstd * nwq[i];
          const float a1 = x[8] * ca - x[9] * sa, a2 = x[9] * ca + x[8] * sa, b1 = x[10] * cb - x[11] * sb, b2 = x[11] * cb + x[10] * sb;
          u32x4 o; o.x = pack2(x[0], x[1]); o.y = pack2(x[2], x[3]); o.z = pack2(x[4], x[5]); o.w = pack2(x[6], x[7]);
          *(u32x4*)(q + sub * 8) = o;
          q[64 + sub] = f2bf(a1); q[72 + sub] = f2bf(a2); q[80 + sub] = f2bf(b1); q[88 + sub] = f2bf(b2); } };
    const int per = (TT + F.G * 8 - 1) / (F.G * 8);
    const int ra = (F.bid * 8 + F.wave) * per, rb = min(TT, ra + per);
    for (int r = ra; r < rb; r += 2) {
        const bool two = r + 1 < rb;
        const MlaRowIn i0 = load_row(r), i1 = load_row(two ? r + 1 : r);
        proc_row(r, i0);
        if (two) proc_row(r + 1, i1);
    }
}

__device__ __forceinline__ void ph_attn_naive(const Frame& F) {
    const bf16_t* Q = (const bf16_t*)(F.ws + WS_WMOE);
    const bf16_t* Kb = (const bf16_t*)(F.ws + WS_R2 + R2_K); const bf16_t* Vb = (const bf16_t*)(F.ws + WS_R2 + R2_V);
    bf16_t* CAT = (bf16_t*)(F.ws + WS_ACT);
    LAS float* Ks = (LAS float*)F.lds;
    LAS float* Vs = Ks + 64 * 96;
    constexpr int NK = SEQ + CTXL;
    const int hf = F.tid & 1;
    for (int it = F.bid; it < 8 * 8 * 32; it += F.G) {
        const int b = it >> 8, h = (it >> 5) & 7, qb = it & 31;
        const int l = qb * 256 + (F.tid >> 1); const size_t trow = (size_t)b * SEQ + l;
        float q[48], o[32];
        { const bf16_t* qp = Q + trow * 768 + h * 96 + hf * 48;
#pragma unroll
          for (int i = 0; i < 6; ++i) { const u32x4 w = *(const u32x4*)(qp + i * 8);
            q[i * 8 + 0] = lo2f(w.x); q[i * 8 + 1] = hi2f(w.x); q[i * 8 + 2] = lo2f(w.y); q[i * 8 + 3] = hi2f(w.y); q[i * 8 + 4] = lo2f(w.z); q[i * 8 + 5] = hi2f(w.z); q[i * 8 + 6] = lo2f(w.w); q[i * 8 + 7] = hi2f(w.w); } }
#pragma unroll
        for (int d = 0; d < 32; ++d) o[d] = 0.f;
        float m = -3.0e38f, ls = 0.f;
        const bf16_t* kb = Kb + (size_t)(b * 8 + h) * NK * 96; const bf16_t* vb = Vb + (size_t)(b * 8 + h) * NK * 64;
        for (int kt = 0; kt < NK / 64; ++kt) {
            for (int i = F.tid; i < 64 * 96 / 8; i += NTH) { const u32x4 w = *(const u32x4*)(kb + (size_t)kt * 64 * 96 + i * 8); LAS float* d = Ks + i * 8;
                d[0] = lo2f(w.x); d[1] = hi2f(w.x); d[2] = lo2f(w.y); d[3] = hi2f(w.y); d[4] = lo2f(w.z); d[5] = hi2f(w.z); d[6] = lo2f(w.w); d[7] = hi2f(w.w); }
            { const int i = F.tid; const u32x4 w = *(const u32x4*)(vb + (size_t)kt * 64 * 64 + i * 8); LAS float* d = Vs + i * 8;
                d[0] = lo2f(w.x); d[1] = hi2f(w.x); d[2] = lo2f(w.y); d[3] = hi2f(w.y); d[4] = lo2f(w.z); d[5] = hi2f(w.z); d[6] = lo2f(w.w); d[7] = hi2f(w.w); }
            __syncthreads();
            for (int jb = 0; jb < 16; ++jb) {
                float s[4]; float mx = m;
#pragma unroll
                for (int jj = 0; jj < 4; ++jj) { const LAS float* kr = Ks + (jb * 4 + jj) * 96 + hf * 48; float a = 0.f;
#pragma unroll
                    for (int d = 0; d < 48; d += 4) { const f32x4 kv = *(const LAS f32x4*)(kr + d); a += q[d] * kv[0] + q[d + 1] * kv[1] + q[d + 2] * kv[2] + q[d + 3] * kv[3]; }
                    a += __shfl_xor(a, 1);
                    s[jj] = a; mx = fmaxf(mx, a); }
                const float sc = exp2f(m - mx); ls *= sc;
#pragma unroll
                for (int d = 0; d < 32; ++d) o[d] *= sc;
                m = mx;
#pragma unroll
                for (int jj = 0; jj < 4; ++jj) { const float p = exp2f(s[jj] - mx); ls += p; const LAS float* vr = Vs + (jb * 4 + jj) * 64 + hf * 32;
#pragma unroll
                    for (int d = 0; d < 32; d += 4) { const f32x4 vv = *(const LAS f32x4*)(vr + d); o[d] += p * vv[0]; o[d + 1] += p * vv[1]; o[d + 2] += p * vv[2]; o[d + 3] += p * vv[3]; } }
            }
            __syncthreads();
        }
        const float inv = 1.f / ls;
        bf16_t* dst = CAT + trow * 1024 + 512 + h * 64 + hf * 32;
#pragma unroll
        for (int i = 0; i < 4; ++i) { u32x4 w; w.x = pack2(o[i * 8] * inv, o[i * 8 + 1] * inv); w.y = pack2(o[i * 8 + 2] * inv, o[i * 8 + 3] * inv); w.z = pack2(o[i * 8 + 4] * inv, o[i * 8 + 5] * inv); w.w = pack2(o[i * 8 + 6] * inv, o[i * 8 + 7] * inv);
            *(u32x4*)(dst + i * 8) = w; }
    }
}

__device__ __forceinline__ void ph_attn(const Frame& F) {
    constexpr int NK = SEQ + CTXL, NT = NK / 64;
    constexpr int KROWB = 208, VROWB = 144, KBYTES = 64 * KROWB, VBYTES = 64 * VROWB, BUFB = KBYTES + VBYTES;
    const bf16_t* Q = (const bf16_t*)(F.ws + WS_WMOE);
    const bf16_t* Kb = (const bf16_t*)(F.ws + WS_R2 + R2_K); const bf16_t* Vb = (const bf16_t*)(F.ws + WS_R2 + R2_V);
    bf16_t* CAT = (bf16_t*)(F.ws + WS_ACT);
    const int l31 = F.lane & 31, hh = F.lane >> 5;
    const int vcu = (F.G % 8 == 0) ? (F.bid % 8) * (F.G / 8) + F.bid / 8 : F.bid;
    const int kc0 = F.tid, kc1 = F.tid + 512;
    const unsigned kd0 = (unsigned)((kc0 / 12) * KROWB + (kc0 % 12) * 16), kd1 = (unsigned)((kc1 / 12) * KROWB + (kc1 % 12) * 16);
    const int vkey = F.tid >> 3, vpos = (vkey & ~12) | ((vkey & 4) << 1) | ((vkey & 8) >> 1);
    const unsigned vd = (unsigned)(((F.tid & 7) * 8) * VROWB + vpos * 2);
    for (int u = vcu; u < 2048; u += F.G) {
        const int bh = u >> 5, qblk = u & 31, b = bh >> 3, h = bh & 7;
        const size_t trow = (size_t)b * SEQ + qblk * 256 + F.wave * 32 + l31;
        s16x8 qf[6];
        { const bf16_t* qp = Q + trow * 768 + h * 96 + hh * 8;
#pragma unroll
          for (int ds = 0; ds < 6; ++ds) qf[ds] = *(const s16x8*)(qp + ds * 16); }
        f32x16 o0, o1;
#pragma unroll
        for (int i = 0; i < 16; ++i) { o0[i] = 0.f; o1[i] = 0.f; }
        float m = -1.0e30f, lsum = 0.f;
        const bf16_t* kg = Kb + (size_t)bh * NK * 96; const bf16_t* vg = Vb + (size_t)bh * NK * 64;
        u32x4 kr0, kr1 = {0u, 0u, 0u, 0u}, vr;
        kr0 = *(const u32x4*)(kg + (size_t)kc0 * 8); if (kc1 < 768) kr1 = *(const u32x4*)(kg + (size_t)kc1 * 8); vr = *(const u32x4*)(vg + (size_t)F.tid * 8);
        __syncthreads();
        for (int t = 0; t < NT; ++t) {
            { LAS unsigned char* kbuf = F.lds + (t & 1) * BUFB; LAS unsigned char* vbuf = kbuf + KBYTES;
              *(LAS u32x4*)(kbuf + kd0) = kr0; if (kc1 < 768) *(LAS u32x4*)(kbuf + kd1) = kr1;
              LAS unsigned short* vp = (LAS unsigned short*)(vbuf + vd);
              vp[0 * (VROWB / 2)] = (unsigned short)(vr.x & 0xffffu); vp[1 * (VROWB / 2)] = (unsigned short)(vr.x >> 16);
              vp[2 * (VROWB / 2)] = (unsigned short)(vr.y & 0xffffu); vp[3 * (VROWB / 2)] = (unsigned short)(vr.y >> 16);
              vp[4 * (VROWB / 2)] = (unsigned short)(vr.z & 0xffffu); vp[5 * (VROWB / 2)] = (unsigned short)(vr.z >> 16);
              vp[6 * (VROWB / 2)] = (unsigned short)(vr.w & 0xffffu); vp[7 * (VROWB / 2)] = (unsigned short)(vr.w >> 16); }
            __syncthreads();
            if (t + 1 < NT) { const bf16_t* kt = kg + (size_t)(t + 1) * 64 * 96; const bf16_t* vt = vg + (size_t)(t + 1) * 64 * 64;
                kr0 = *(const u32x4*)(kt + (size_t)kc0 * 8); if (kc1 < 768) kr1 = *(const u32x4*)(kt + (size_t)kc1 * 8); vr = *(const u32x4*)(vt + (size_t)F.tid * 8); }
            const LAS unsigned char* kbuf = F.lds + (t & 1) * BUFB; const LAS unsigned char* vbuf = kbuf + KBYTES;
            f32x16 s0, s1;
#pragma unroll
            for (int i = 0; i < 16; ++i) { s0[i] = 0.f; s1[i] = 0.f; }
#pragma unroll
            for (int ds = 0; ds < 6; ++ds) {
                const s16x8 a0 = *(const LAS s16x8*)(kbuf + l31 * KROWB + ds * 32 + hh * 16);
                const s16x8 a1 = *(const LAS s16x8*)(kbuf + (32 + l31) * KROWB + ds * 32 + hh * 16);
                s0 = __builtin_amdgcn_mfma_f32_32x32x16_bf16(a0, qf[ds], s0, 0, 0, 0);
                s1 = __builtin_amdgcn_mfma_f32_32x32x16_bf16(a1, qf[ds], s1, 0, 0, 0);
            }
            float mx = s0[0];
#pragma unroll
            for (int i = 1; i < 16; ++i) mx = fmaxf(mx, s0[i]);
#pragma unroll
            for (int i = 0; i < 16; ++i) mx = fmaxf(mx, s1[i]);
            mx = fmaxf(mx, __shfl_xor(mx, 32));
            const float mn = fmaxf(m, mx); const bool moved = __any(mn > m); const float alpha = __builtin_amdgcn_exp2f(m - mn); m = mn;
            float ps = 0.f;
#pragma unroll
            for (int i = 0; i < 16; ++i) { s0[i] = __builtin_amdgcn_exp2f(s0[i] - mn); s1[i] = __builtin_amdgcn_exp2f(s1[i] - mn); ps += s0[i] + s1[i]; }
            lsum = lsum * alpha + ps;
            if (moved) {
#pragma unroll
                for (int i = 0; i < 16; ++i) { o0[i] *= alpha; o1[i] *= alpha; } }
#pragma unroll
            for (int kb = 0; kb < 2; ++kb)
#pragma unroll
                for (int st = 0; st < 2; ++st) {
                    u32x4 pw;
                    if (kb == 0) { pw.x = pack2(s0[8 * st + 0], s0[8 * st + 1]); pw.y = pack2(s0[8 * st + 2], s0[8 * st + 3]); pw.z = pack2(s0[8 * st + 4], s0[8 * st + 5]); pw.w = pack2(s0[8 * st + 6], s0[8 * st + 7]); }
                    else         { pw.x = pack2(s1[8 * st + 0], s1[8 * st + 1]); pw.y = pack2(s1[8 * st + 2], s1[8 * st + 3]); pw.z = pack2(s1[8 * st + 4], s1[8 * st + 5]); pw.w = pack2(s1[8 * st + 6], s1[8 * st + 7]); }
                    const s16x8 pf = __builtin_bit_cast(s16x8, pw);
                    const int kof = (kb * 32 + 16 * st + 8 * hh) * 2;
                    o0 = __builtin_amdgcn_mfma_f32_32x32x16_bf16(*(const LAS s16x8*)(vbuf + l31 * VROWB + kof), pf, o0, 0, 0, 0);
                    o1 = __builtin_amdgcn_mfma_f32_32x32x16_bf16(*(const LAS s16x8*)(vbuf + (32 + l31) * VROWB + kof), pf, o1, 0, 0, 0);
                }
        }
        const float ltot = lsum + __shfl_xor(lsum, 32); const float inv = 1.f / ltot;
        bf16_t* dst = CAT + trow * 1024 + 512 + h * 64 + hh * 4;
#pragma unroll
        for (int g = 0; g < 4; ++g) { u32x2 w;
            w.x = pack2(o0[4 * g] * inv, o0[4 * g + 1] * inv); w.y = pack2(o0[4 * g + 2] * inv, o0[4 * g + 3] * inv); *(u32x2*)(dst + g * 8) = w;
            w.x = pack2(o1[4 * g] * inv, o1[4 * g + 1] * inv); w.y = pack2(o1[4 * g + 2] * inv, o1[4 * g + 3] * inv); *(u32x2*)(dst + 32 + g * 8) = w; }
    }
    __syncthreads();
}

__device__ __forceinline__ void ph_attn2(const Frame& F) {
    constexpr int NK = SEQ + CTXL, NT = NK / 64;
    constexpr int KROWB = 208, VROWB = 144, KBYTES = 64 * KROWB, VBYTES = 64 * VROWB, BUFB = KBYTES + VBYTES;
    const bf16_t* Q = (const bf16_t*)(F.ws + WS_WMOE);
    const bf16_t* Kb = (const bf16_t*)(F.ws + WS_R2 + R2_K); const bf16_t* Vb = (const bf16_t*)(F.ws + WS_R2 + R2_V);
    bf16_t* CAT = (bf16_t*)(F.ws + WS_ACT);
    const int l31 = F.lane & 31, hh = F.lane >> 5;
    const int vcu = (F.G % 8 == 0) ? (F.bid % 8) * (F.G / 8) + F.bid / 8 : F.bid;
    const int kc0 = F.tid, kc1 = F.tid + 512;
    const unsigned kd0 = (unsigned)((kc0 / 12) * KROWB + (kc0 % 12) * 16), kd1 = (unsigned)((kc1 / 12) * KROWB + (kc1 % 12) * 16);
    const int vkey = F.lane, vpos = (vkey & ~12) | ((vkey & 4) << 1) | ((vkey & 8) >> 1);
    const unsigned vd = (unsigned)((F.wave * 8) * VROWB + vpos * 2);
    const unsigned vgo = (unsigned)(F.lane * 64 + F.wave * 8);
    const bool grpB = F.wave >= 4;
    for (int u = vcu; u < 2048; u += F.G) {
        const int bh = u >> 5, qblk = u & 31, b = bh >> 3, h = bh & 7;
        const size_t trow = (size_t)b * SEQ + qblk * 256 + F.wave * 32 + l31;
        s16x8 qf[6];
        { const bf16_t* qp = Q + trow * 768 + h * 96 + hh * 8;
#pragma unroll
          for (int ds = 0; ds < 6; ++ds) qf[ds] = *(const s16x8*)(qp + ds * 16); }
        f32x16 o0, o1, s0, s1;
#pragma unroll
        for (int i = 0; i < 16; ++i) { o0[i] = 0.f; o1[i] = 0.f; }
        float m = 0.f, lsum = 0.f;
        const bf16_t* kg = Kb + (size_t)bh * NK * 96; const bf16_t* vg = Vb + (size_t)bh * NK * 64;
        u32x4 kr0, kr1 = {0u, 0u, 0u, 0u}, vr;
#define AT_LOADK(t) do { if ((t) < NT) { const bf16_t* kt_ = kg + (size_t)(t) * 64 * 96; kr0 = *(const u32x4*)(kt_ + (size_t)kc0 * 8); if (kc1 < 768) kr1 = *(const u32x4*)(kt_ + (size_t)kc1 * 8); } } while (0)
#define AT_LOADV(t) do { if ((t) < NT) vr = *(const u32x4*)(vg + (size_t)(t) * 64 * 64 + vgo); } while (0)
#define AT_PUTK(t) do { if ((t) < NT) { LAS unsigned char* kb_ = F.lds + ((t) % 3) * BUFB; *(LAS u32x4*)(kb_ + kd0) = kr0; if (kc1 < 768) *(LAS u32x4*)(kb_ + kd1) = kr1; } } while (0)
#define AT_PUTV(t) do { if ((t) < NT) { LAS unsigned short* vp = (LAS unsigned short*)(F.lds + ((t) % 3) * BUFB + KBYTES + vd); \
            vp[0 * (VROWB / 2)] = (unsigned short)(vr.x & 0xffffu); vp[1 * (VROWB / 2)] = (unsigned short)(vr.x >> 16); vp[2 * (VROWB / 2)] = (unsigned short)(vr.y & 0xffffu); vp[3 * (VROWB / 2)] = (unsigned short)(vr.y >> 16); \
            vp[4 * (VROWB / 2)] = (unsigned short)(vr.z & 0xffffu); vp[5 * (VROWB / 2)] = (unsigned short)(vr.z >> 16); vp[6 * (VROWB / 2)] = (unsigned short)(vr.w & 0xffffu); vp[7 * (VROWB / 2)] = (unsigned short)(vr.w >> 16); } } while (0)
#define AT_QK(t) do { const LAS unsigned char* kbuf = F.lds + ((t) % 3) * BUFB; s16x8 ka_[6], kb2_[6]; \
            _Pragma("unroll") for (int ds = 0; ds < 6; ++ds) { ka_[ds] = *(const LAS s16x8*)(kbuf + l31 * KROWB + ds * 32 + hh * 16); kb2_[ds] = *(const LAS s16x8*)(kbuf + (32 + l31) * KROWB + ds * 32 + hh * 16); } \
            _Pragma("unroll") for (int i = 0; i < 16; ++i) { s0[i] = -m; s1[i] = -m; } \
            _Pragma("unroll") for (int ds = 0; ds < 6; ++ds) { \
                s0 = __builtin_amdgcn_mfma_f32_32x32x16_bf16(ka_[ds], qf[ds], s0, 0, 0, 0); s1 = __builtin_amdgcn_mfma_f32_32x32x16_bf16(kb2_[ds], qf[ds], s1, 0, 0, 0); } } while (0)
#define AT_SMPV(t) do { const LAS unsigned char* vbuf = F.lds + ((t) % 3) * BUFB + KBYTES; s16x8 va_[4], vb2_[4]; \
            _Pragma("unroll") for (int q = 0; q < 4; ++q) { const int kof = ((q >> 1) * 32 + 16 * (q & 1) + 8 * hh) * 2; va_[q] = *(const LAS s16x8*)(vbuf + l31 * VROWB + kof); vb2_[q] = *(const LAS s16x8*)(vbuf + (32 + l31) * VROWB + kof); } \
            float mx = s0[0]; \
            _Pragma("unroll") for (int i = 1; i < 16; ++i) mx = fmaxf(mx, s0[i]); \
            _Pragma("unroll") for (int i = 0; i < 16; ++i) mx = fmaxf(mx, s1[i]); \
            { auto sw_ = __builtin_amdgcn_permlane32_swap(__float_as_uint(mx), __float_as_uint(mx), false, false); mx = fmaxf(__uint_as_float(sw_[0]), __uint_as_float(sw_[1])); } \
            if (__any(mx > 0.f)) { const float dl = fmaxf(mx, 0.f); const float alpha = __builtin_amdgcn_exp2f(-dl); m += dl; lsum *= alpha; \
                _Pragma("unroll") for (int i = 0; i < 16; ++i) { o0[i] *= alpha; o1[i] *= alpha; s0[i] -= dl; s1[i] -= dl; } } \
            float ps = 0.f; \
            _Pragma("unroll") for (int i = 0; i < 16; ++i) { s0[i] = __builtin_amdgcn_exp2f(s0[i]); s1[i] = __builtin_amdgcn_exp2f(s1[i]); ps += s0[i] + s1[i]; } \
            lsum += ps; \
            _Pragma("unroll") for (int q = 0; q < 4; ++q) { \
                const s16x8 pf = pack8((q >> 1) == 0 ? s0 : s1, 8 * (q & 1)); \
                o0 = __builtin_amdgcn_mfma_f32_32x32x16_bf16(va_[q], pf, o0, 0, 0, 0); \
                o1 = __builtin_amdgcn_mfma_f32_32x32x16_bf16(vb2_[q], pf, o1, 0, 0, 0); } } while (0)
        __syncthreads();
        AT_LOADK(0); AT_LOADV(0); AT_PUTK(0); AT_PUTV(0); AT_LOADK(1);
        __syncthreads();
        if (!grpB) {
            for (int t = 0; t < NT; ++t) {
                AT_LOADV(t + 1); AT_QK(t); AT_PUTK(t + 1);
                __syncthreads();
                AT_LOADK(t + 2); AT_SMPV(t); AT_PUTV(t + 1);
                __syncthreads();
            }
            __syncthreads();
        } else {
            AT_PUTK(1); AT_LOADV(1);
            __syncthreads();
            for (int t = 0; t < NT; ++t) {
                AT_LOADK(t + 2); AT_QK(t); AT_PUTV(t + 1);
                __syncthreads();
                AT_LOADV(t + 2); AT_SMPV(t); AT_PUTK(t + 2);
                __syncthreads();
            }
        }
#undef AT_LOADK
#undef AT_LOADV
#undef AT_PUTK
#undef AT_PUTV
#undef AT_QK
#undef AT_SMPV
        float ltot; { auto sw_ = __builtin_amdgcn_permlane32_swap(__float_as_uint(lsum), __float_as_uint(lsum), false, false); ltot = __uint_as_float(sw_[0]) + __uint_as_float(sw_[1]); }
        const float inv = 1.f / ltot;
        bf16_t* dst = CAT + trow * 1024 + 512 + h * 64 + hh * 4;
#pragma unroll
        for (int g = 0; g < 4; ++g) { u32x2 w;
            w.x = pack2(o0[4 * g] * inv, o0[4 * g + 1] * inv); w.y = pack2(o0[4 * g + 2] * inv, o0[4 * g + 3] * inv); *(u32x2*)(dst + g * 8) = w;
            w.x = pack2(o1[4 * g] * inv, o1[4 * g + 1] * inv); w.y = pack2(o1[4 * g + 2] * inv, o1[4 * g + 3] * inv); *(u32x2*)(dst + 32 + g * 8) = w; }
    }
    __syncthreads();
}

__device__ __forceinline__ void ph_attn3(const Frame& F) {
    constexpr int NK = SEQ + CTXL, NT = NK / 64;
    constexpr int KROWB = 208, VROWB = 192, KBYTES = 64 * KROWB, VBYTES = 64 * VROWB, BUFB = KBYTES + VBYTES;
    const bf16_t* Q = (const bf16_t*)(F.ws + WS_WMOE);
    const bf16_t* Kb = (const bf16_t*)(F.ws + WS_R2 + R2_K); const bf16_t* Vb = (const bf16_t*)(F.ws + WS_R2 + R2_V);
    bf16_t* CAT = (bf16_t*)(F.ws + WS_ACT);
    const int l31 = F.lane & 31, hh = F.lane >> 5;
    const int vcu = (F.G % 8 == 0) ? (F.bid % 8) * (F.G / 8) + F.bid / 8 : F.bid;
    const int kc0 = F.tid, kc1 = F.tid + 512;
    const unsigned kd0 = (unsigned)((kc0 / 12) * KROWB + (kc0 % 12) * 16), kd1 = (unsigned)((kc1 / 12) * KROWB + (kc1 % 12) * 16);
    const unsigned vd = (unsigned)((F.tid >> 3) * VROWB + (F.tid & 7) * 16);
    const unsigned vgo = (unsigned)(F.tid * 8);
    const unsigned trv = (unsigned)((4 * hh + ((F.lane >> 2) & 3)) * VROWB + (16 * ((F.lane >> 4) & 1) + 4 * (F.lane & 3)) * 2);
    const bool grpB = F.wave >= 4;
    for (int u = vcu; u < 1024; u += F.G) {
        const int bh = u >> 4, qblk = u & 15, b = bh >> 3, h = bh & 7;
        int lo_ = F.tid; asm volatile("" : "+v"(lo_));
        const int l31p = lo_ & 31, hhp = (lo_ >> 5) & 1;
        const int kc0 = lo_, kc1 = lo_ + 512; const unsigned vgo = (unsigned)(lo_ * 8);
        const size_t trow = (size_t)b * SEQ + qblk * 512 + F.wave * 64 + l31p;
        s16x8 qa[6];
        LAS unsigned char* qbl = F.lds + 3 * BUFB + F.wave * 6144 + F.lane * 16;
        { const bf16_t* qp = Q + trow * 768 + h * 96 + hhp * 8;
#pragma unroll
          for (int ds = 0; ds < 6; ++ds) { qa[ds] = *(const s16x8*)(qp + ds * 16); *(LAS s16x8*)(qbl + ds * 1024) = *(const s16x8*)(qp + (size_t)32 * 768 + ds * 16); } }
        f32x16 oa0, oa1, ob0, ob1, sa0, sa1, sb0, sb1;
        float zf_ = 0.f; asm volatile("" : "+v"(zf_));
#pragma unroll
        for (int i = 0; i < 16; ++i) { oa0[i] = zf_; oa1[i] = zf_; ob0[i] = zf_; ob1[i] = zf_; }
        float ma = zf_, mb = zf_, la = zf_, lb = zf_;
        const bf16_t* kg = Kb + (size_t)bh * NK * 96; const bf16_t* vg = Vb + (size_t)bh * NK * 64;
        u32x4 kr0, kr1 = {0u, 0u, 0u, 0u}, vr;
#define AT_LOADK(t) do { if ((t) < NT) { const bf16_t* kt_ = kg + (size_t)(t) * 64 * 96; kr0 = *(const u32x4*)(kt_ + (size_t)kc0 * 8); if (kc1 < 768) kr1 = *(const u32x4*)(kt_ + (size_t)kc1 * 8); } } while (0)
#define AT_LOADV(t) do { if ((t) < NT) vr = *(const u32x4*)(vg + (size_t)(t) * 64 * 64 + vgo); } while (0)
#define AT_PUTK(t) do { if ((t) < NT) { LAS unsigned char* kb_ = F.lds + ((t) % 3) * BUFB; *(LAS u32x4*)(kb_ + kd0) = kr0; if (kc1 < 768) *(LAS u32x4*)(kb_ + kd1) = kr1; } } while (0)
#define AT_PUTV(t) do { if ((t) < NT) *(LAS u32x4*)(F.lds + ((t) % 3) * BUFB + KBYTES + vd) = vr; } while (0)
#define AT_QK(t) do { const LAS unsigned char* kbuf = F.lds + ((t) % 3) * BUFB; \
            _Pragma("unroll") for (int i = 0; i < 16; ++i) { sa0[i] = -ma; sa1[i] = -ma; sb0[i] = -mb; sb1[i] = -mb; } \
            _Pragma("unroll") for (int ds = 0; ds < 6; ++ds) { \
                const s16x8 k0_ = *(const LAS s16x8*)(kbuf + l31 * KROWB + ds * 32 + hh * 16); const s16x8 k1_ = *(const LAS s16x8*)(kbuf + (32 + l31) * KROWB + ds * 32 + hh * 16); \
                const s16x8 qb_ = *(const LAS s16x8*)(qbl + ds * 1024); \
                sa0 = __builtin_amdgcn_mfma_f32_32x32x16_bf16(k0_, qa[ds], sa0, 0, 0, 0); sb0 = __builtin_amdgcn_mfma_f32_32x32x16_bf16(k0_, qb_, sb0, 0, 0, 0); \
                sa1 = __builtin_amdgcn_mfma_f32_32x32x16_bf16(k1_, qa[ds], sa1, 0, 0, 0); sb1 = __builtin_amdgcn_mfma_f32_32x32x16_bf16(k1_, qb_, sb1, 0, 0, 0); } } while (0)
#define AT_SM(s0, s1, o0, o1, m, lsum) do { \
            float mx = s0[0]; \
            _Pragma("unroll") for (int i = 1; i < 16; ++i) mx = fmaxf(mx, s0[i]); \
            _Pragma("unroll") for (int i = 0; i < 16; ++i) mx = fmaxf(mx, s1[i]); \
            { auto sw_ = __builtin_amdgcn_permlane32_swap(__float_as_uint(mx), __float_as_uint(mx), false, false); mx = fmaxf(__uint_as_float(sw_[0]), __uint_as_float(sw_[1])); } \
            if (__any(mx > 0.f)) { const float dl = fmaxf(mx, 0.f); const float alpha = __builtin_amdgcn_exp2f(-dl); m += dl; lsum *= alpha; \
                _Pragma("unroll") for (int i = 0; i < 16; ++i) { o0[i] *= alpha; o1[i] *= alpha; s0[i] -= dl; s1[i] -= dl; } } \
            float ps = 0.f; \
            _Pragma("unroll") for (int i = 0; i < 16; ++i) { s0[i] = __builtin_amdgcn_exp2f(s0[i]); s1[i] = __builtin_amdgcn_exp2f(s1[i]); ps += s0[i] + s1[i]; } \
            lsum += ps; } while (0)
#define AT_SMPV(t) do { const LAS unsigned char* vbuf = F.lds + ((t) % 3) * BUFB + KBYTES; \
            AT_SM(sa0, sa1, oa0, oa1, ma, la); AT_SM(sb0, sb1, ob0, ob1, mb, lb); \
            _Pragma("unroll") for (int q = 0; q < 4; ++q) { \
                const s16x8 v0_ = ldtr2(vbuf + trv + (16 * q) * VROWB, vbuf + trv + (16 * q + 8) * VROWB); const s16x8 v1_ = ldtr2(vbuf + trv + (16 * q) * VROWB + 64, vbuf + trv + (16 * q + 8) * VROWB + 64); \
                const s16x8 pa_ = pack8((q >> 1) == 0 ? sa0 : sa1, 8 * (q & 1)); const s16x8 pb_ = pack8((q >> 1) == 0 ? sb0 : sb1, 8 * (q & 1)); \
                oa0 = __builtin_amdgcn_mfma_f32_32x32x16_bf16(v0_, pa_, oa0, 0, 0, 0); ob0 = __builtin_amdgcn_mfma_f32_32x32x16_bf16(v0_, pb_, ob0, 0, 0, 0); \
                oa1 = __builtin_amdgcn_mfma_f32_32x32x16_bf16(v1_, pa_, oa1, 0, 0, 0); ob1 = __builtin_amdgcn_mfma_f32_32x32x16_bf16(v1_, pb_, ob1, 0, 0, 0); } } while (0)
        __syncthreads();
        AT_LOADK(0); AT_LOADV(0); AT_PUTK(0); AT_PUTV(0); AT_LOADK(1);
        __syncthreads();
        if (grpB) __builtin_amdgcn_s_setprio(1);
        if (!grpB) {
            for (int t = 0; t < NT; ++t) {
                AT_LOADV(t + 1); AT_QK(t); AT_PUTK(t + 1);
                __builtin_amdgcn_sched_barrier(0);
                AT_LOADK(t + 2); AT_SMPV(t); AT_PUTV(t + 1);
                __syncthreads();
            }
        } else {
            AT_PUTK(1); AT_LOADV(1);
            __builtin_amdgcn_sched_barrier(0);
            AT_LOADK(2); AT_QK(0); AT_PUTV(1);
            __syncthreads();
            for (int t = 0; t < NT; ++t) {
                AT_LOADV(t + 2); AT_SMPV(t); AT_PUTK(t + 2);
                __builtin_amdgcn_sched_barrier(0);
                if (t + 1 < NT) { AT_LOADK(t + 3); AT_QK(t + 1); AT_PUTV(t + 2); __syncthreads(); }
            }
        }
        __builtin_amdgcn_s_setprio(0);
#undef AT_LOADK
#undef AT_LOADV
#undef AT_PUTK
#undef AT_PUTV
#undef AT_QK
#undef AT_SM
#undef AT_SMPV
        int lo2_ = F.tid; asm volatile("" : "+v"(lo2_));
        const int hhq = (lo2_ >> 5) & 1;
        const size_t trow2 = (size_t)b * SEQ + qblk * 512 + F.wave * 64 + (lo2_ & 31);
        { float lt; { auto sw_ = __builtin_amdgcn_permlane32_swap(__float_as_uint(la), __float_as_uint(la), false, false); lt = __uint_as_float(sw_[0]) + __uint_as_float(sw_[1]); }
          const float inv = 1.f / lt; bf16_t* dst = CAT + trow2 * 1024 + 512 + h * 64 + hhq * 4;
#pragma unroll
          for (int g = 0; g < 4; ++g) { u32x2 w;
              w.x = pack2(oa0[4 * g] * inv, oa0[4 * g + 1] * inv); w.y = pack2(oa0[4 * g + 2] * inv, oa0[4 * g + 3] * inv); *(u32x2*)(dst + g * 8) = w;
              w.x = pack2(oa1[4 * g] * inv, oa1[4 * g + 1] * inv); w.y = pack2(oa1[4 * g + 2] * inv, oa1[4 * g + 3] * inv); *(u32x2*)(dst + 32 + g * 8) = w; } }
        { float lt; { auto sw_ = __builtin_amdgcn_permlane32_swap(__float_as_uint(lb), __float_as_uint(lb), false, false); lt = __uint_as_float(sw_[0]) + __uint_as_float(sw_[1]); }
          const float inv = 1.f / lt; bf16_t* dst = CAT + (trow2 + 32) * 1024 + 512 + h * 64 + hhq * 4;
#pragma unroll
          for (int g = 0; g < 4; ++g) { u32x2 w;
              w.x = pack2(ob0[4 * g] * inv, ob0[4 * g + 1] * inv); w.y = pack2(ob0[4 * g + 2] * inv, ob0[4 * g + 3] * inv); *(u32x2*)(dst + g * 8) = w;
              w.x = pack2(ob1[4 * g] * inv, ob1[4 * g + 1] * inv); w.y = pack2(ob1[4 * g + 2] * inv, ob1[4 * g + 3] * inv); *(u32x2*)(dst + 32 + g * 8) = w; } }
    }
    __syncthreads();
}

__device__ __forceinline__ void ph_gdn(const Frame& F) {
    const Params& P = *F.P;
    const bf16_t* PX = (const bf16_t*)(F.ws + WS_PX);
    LAS bf16_t* rq = (LAS bf16_t*)F.lds;
    LAS bf16_t* rk = rq + 36 * 128;
    LAS bf16_t* rv = rk + 36 * 128;
    LAS float* qc = (LAS float*)(F.lds + 24576);
    LAS float* kc = qc + 4096;
    LAS float* vc = kc + 4096;
    LAS float* os = vc + 1024;
    LAS float* ba = os + 1024;
    const int dg = F.lane & 15, el = F.wave * 4 + (F.lane >> 4);
    for (int it = F.bid; it < 256; it += F.G) {
        const int b = it >> 5, h = (it >> 3) & 3, dir = (it >> 2) & 1, sl = it & 3;
        bf16_t* O = dir ? (bf16_t*)(F.ws + WS_WMOE) : (bf16_t*)(F.ws + WS_GOF);
        const float a_neg = -__expf(P.in[I_ALOG][dir * 4 + h]), dtb = P.in[I_DTB][dir * 4 + h];
        float cwq[5], cwk[5], cwv[5];
        { const int d = F.tid & 127;
#pragma unroll
          for (int j = 0; j < 5; ++j) { cwq[j] = P.in[I_CONVW][j * 1536 + h * 128 + d]; cwk[j] = P.in[I_CONVW][j * 1536 + 512 + h * 128 + d]; cwv[j] = P.in[I_CONVW][j * 1536 + 1024 + h * 128 + sl * 32 + (F.tid & 31)]; } }
        float S[8];
#pragma unroll
        for (int i = 0; i < 8; ++i) S[i] = 0.f;
        u32x4 pr0, pr1, pr2; float pbeta = 0.f, pdec = 0.f;
        auto blk_geom = [&](int bi, int& len, size_t& rbase, int& p0) { const bool c = bi < 8; len = c ? CTXL : SEQ; rbase = c ? (size_t)TL + b * CTXL : (size_t)b * SEQ;
            const int nbk = len / 32, k = c ? bi : bi - 8; p0 = (dir ? (nbk - 1 - k) : k) * 32; };
        auto fetch = [&](int bi, int id) -> u32x4 { int len, p0; size_t rbase; blk_geom(bi, len, rbase, p0);
            u32x4 z = {0u, 0u, 0u, 0u}; if (id >= 1296) return z;
            int arr = 0, j = id; if (j >= 1152) { arr = 2; j -= 1152; } else if (j >= 576) { arr = 1; j -= 576; }
            const int rr = arr == 2 ? (j >> 2) : (j >> 4), part = arr == 2 ? (j & 3) : (j & 15); const int p = p0 - 2 + rr;
            if (p < 0 || p >= len) return z;
            const bf16_t* row = PX + (rbase + p) * ODD_PAD + (arr == 0 ? h * 128 : (arr == 1 ? 512 + h * 128 : 1024 + h * 128 + sl * 32)) + part * 8;
            return *(const u32x4*)row; };
        auto stash = [&](int id, u32x4 w) { if (id >= 1296) return; int arr = 0, j = id; if (j >= 1152) { arr = 2; j -= 1152; } else if (j >= 576) { arr = 1; j -= 576; }
            LAS bf16_t* d = arr == 0 ? rq + j * 8 : (arr == 1 ? rk + j * 8 : rv + j * 8); *(LAS u32x4*)d = w; };
        auto fetch_all = [&](int bi) { pr0 = fetch(bi, F.tid); pr1 = fetch(bi, F.tid + 512); pr2 = fetch(bi, F.tid + 1024);
            if (F.tid < 32) { int len, p0; size_t rbase; blk_geom(bi, len, rbase, p0); const bf16_t* row = PX + (rbase + p0 + F.tid) * ODD_PAD;
                pbeta = bf2f(row[2048 + dir * 4 + h]); pdec = bf2f(row[2056 + dir * 4 + h]); } };
        fetch_all(0);
        for (int bi = 0; bi < 264; ++bi) {
            __syncthreads();
            stash(F.tid, pr0); stash(F.tid + 512, pr1); stash(F.tid + 1024, pr2);
            if (F.tid < 32) { ba[F.tid] = sigmoid_f(pbeta); ba[32 + F.tid] = __expf(a_neg * softplus_f(pdec + dtb)); }
            __syncthreads();
            if (bi + 1 < 264) fetch_all(bi + 1);
            { const int d = F.tid & 127;
#pragma unroll
              for (int i = 0; i < 8; ++i) { const int s = (F.tid >> 7) + i * 4; float a = 0.f, c = 0.f;
#pragma unroll
                for (int j = 0; j < 5; ++j) { a += bf2f(rq[(s + j) * 128 + d]) * cwq[j]; c += bf2f(rk[(s + j) * 128 + d]) * cwk[j]; }
                qc[s * 128 + d] = silu_f(a); kc[s * 128 + d] = silu_f(c); }
#pragma unroll
              for (int i = 0; i < 2; ++i) { const int s = (F.tid >> 5) + i * 16, e = F.tid & 31; float a = 0.f;
#pragma unroll
                for (int j = 0; j < 5; ++j) a += bf2f(rv[(s + j) * 32 + e]) * cwv[j];
                vc[s * 32 + e] = silu_f(a); } }
            __syncthreads();
            { const int s = F.wave * 4 + (F.lane >> 4);
              LAS float* qp = qc + s * 128 + dg * 8; LAS float* kp = kc + s * 128 + dg * 8;
              f32x4 q0 = *(LAS f32x4*)qp, q1 = *(LAS f32x4*)(qp + 4), k0 = *(LAS f32x4*)kp, k1 = *(LAS f32x4*)(kp + 4);
              float sq = 0.f, sk = 0.f;
#pragma unroll
              for (int i = 0; i < 4; ++i) { sq += q0[i] * q0[i] + q1[i] * q1[i]; sk += k0[i] * k0[i] + k1[i] * k1[i]; }
              sq = sum16(sq); sk = sum16(sk);
              const float rq_ = rsqrtf(sq + EPS) * 0.08838834764831845f, rk_ = rsqrtf(sk + EPS);
              *(LAS f32x4*)qp = q0 * rq_; *(LAS f32x4*)(qp + 4) = q1 * rq_; *(LAS f32x4*)kp = k0 * rk_; *(LAS f32x4*)(kp + 4) = k1 * rk_; }
            __syncthreads();
#pragma unroll 2
            for (int ss = 0; ss < 32; ++ss) {
                const int st = dir ? 31 - ss : ss;
                const f32x4 ka = *(const LAS f32x4*)(kc + st * 128 + dg * 8), kb = *(const LAS f32x4*)(kc + st * 128 + dg * 8 + 4);
                const f32x4 qa = *(const LAS f32x4*)(qc + st * 128 + dg * 8), qb = *(const LAS f32x4*)(qc + st * 128 + dg * 8 + 4);
                const float v = vc[st * 32 + el], beta = ba[st], a = ba[32 + st];
                float r0 = 0.f, r1 = 0.f;
#pragma unroll
                for (int i = 0; i < 4; ++i) { r0 += ka[i] * S[i]; r1 += kb[i] * S[4 + i]; }
                const float r = sum16(r0 + r1);
                const float u = beta * (v - a * r);
                float p0 = 0.f, p1 = 0.f;
#pragma unroll
                for (int i = 0; i < 4; ++i) { S[i] = a * S[i] + ka[i] * u; p0 += qa[i] * S[i]; S[4 + i] = a * S[4 + i] + kb[i] * u; p1 += qb[i] * S[4 + i]; }
                const float o = sum16(p0 + p1);
                if (dg == 0) os[st * 32 + el] = o;
            }
            __syncthreads();
            { int len, p0; size_t rbase; blk_geom(bi, len, rbase, p0);
              const int s = F.tid >> 4, e2 = (F.tid & 15) * 2;
              *(unsigned*)(O + (rbase + p0 + s) * 512 + h * 128 + sl * 32 + e2) = pack2(os[s * 32 + e2], os[s * 32 + e2 + 1]); }
        }
        __syncthreads();
    }
}

constexpr int GR_KN = 0, GR_QN = 16384, GR_VT = 32768, GR_T = 49152, GR_QK = 65536, GR_SC = 81920, GR_BYTES = 83968;
__device__ __forceinline__ s16x8 ld2x64(const LAS unsigned char* p) {
    const u32x2 a = *(const LAS u32x2*)p, b = *(const LAS u32x2*)(p + 16); u32x4 v; v.x = a.x; v.y = a.y; v.z = b.x; v.w = b.y; return __builtin_bit_cast(s16x8, v);
}
__device__ __forceinline__ void st2x64(LAS unsigned char* p, u32x4 v) { u32x2 a, b; a.x = v.x; a.y = v.y; b.x = v.z; b.y = v.w; *(LAS u32x2*)p = a; *(LAS u32x2*)(p + 8) = b; }
__device__ __forceinline__ u32x4 ld2x64n(const LAS unsigned char* p) { const u32x2 a = *(const LAS u32x2*)p, b = *(const LAS u32x2*)(p + 8); u32x4 v; v.x = a.x; v.y = a.y; v.z = b.x; v.w = b.y; return v; }
__device__ __forceinline__ void gdn_unit_geom(int b, int ck, size_t& rbase, int& len, int& p0) {
    if (ck < 4) { rbase = (size_t)TL + b * CTXL; len = CTXL; p0 = ck * 64; } else { rbase = (size_t)b * SEQ; len = SEQ; p0 = (ck - 4) * 64; }
}
__device__ __forceinline__ void ph_gdn_prep(const Frame& F, int r0, int r1, int widx, int nw) {
    const Params& P = *F.P;
    const bf16_t* PX = (const bf16_t*)(F.ws + WS_PX);
    LAS unsigned char* L = F.lds;
    LAS bf16_t* RAW = (LAS bf16_t*)L;
    LAS unsigned char* KNI = L; LAS unsigned char* QNI = L + 16896;
    LAS float* qf = (LAS float*)(L + 52224);
    LAS float* kf = qf + 8192;
    LAS unsigned char* VTI = L + 52224 + 65536;
    LAS float* SCL = (LAS float*)(L + 52224 + 65536 + 17408);
    LAS float* XS = SCL + 384;
    u32x4 pf[7]; float ps0 = 0.f, ps1 = 0.f, ps2 = 0.f, ps3 = 0.f;
    auto fetch = [&](int u, int tid) { const int b = u / 528, h = (u % 528) / 132, ck = u % 132; size_t rbase; int len, p0; gdn_unit_geom(b, ck, rbase, len, p0);
#pragma unroll
        for (int k = 0; k < 7; ++k) { const int c = tid + 512 * k; u32x4 w = {0u, 0u, 0u, 0u};
            if (c < 68 * 48) { const int rr = c / 48, part = c % 48; const int p = p0 - 2 + rr;
                if (p >= 0 && p < len) w = *(const u32x4*)(PX + (rbase + p) * ODD_PAD + (part >> 4) * 512 + h * 128 + (part & 15) * 8); }
            pf[k] = w; }
        if (tid < 64) { const bf16_t* row = PX + (rbase + p0 + tid) * ODD_PAD; ps0 = bf2f(row[2048 + h]); ps1 = bf2f(row[2052 + h]); ps2 = bf2f(row[2056 + h]); ps3 = bf2f(row[2060 + h]); } };
    const int nitems = (r1 - r0) * 32;
    auto unit_of = [&](int j) -> int { const int rank = r0 + (j >> 5), bh = j & 31, m = rank - 4; const int ck = rank < 4 ? rank : ((m & 1) ? 131 - (m >> 1) : 4 + (m >> 1)); return bh * 132 + ck; };
    if (widx < nitems) fetch(unit_of(widx), F.tid);
    for (int j = widx; j < nitems; j += nw) {
        const int u = unit_of(j);
        const int b = u / 528, h = (u % 528) / 132, ck = u % 132;
        (void)b; (void)ck;
        int tid = F.tid; asm volatile("" : "+v"(tid));
        const int lane = tid & 63, l31 = lane & 31, hh = lane >> 5, l15 = lane & 15, kq = lane >> 4;
        unsigned char* rec = F.ws + WS_GREC + (size_t)u * GR_BYTES;
        float cwa[30];
#pragma unroll
        for (int q = 0; q < 30; ++q) cwa[q] = P.in[I_CONVW][((q % 10) >> 1) * 1536 + (q / 10) * 512 + h * 128 + 2 * (tid & 63) + (q & 1)];
        const float p_alf = P.in[I_ALOG][h], p_alb = P.in[I_ALOG][4 + h], p_dtf = P.in[I_DTB][h], p_dtb = P.in[I_DTB][4 + h];
#pragma unroll
        for (int k = 0; k < 7; ++k) { const int c = tid + 512 * k; if (c < 68 * 48) *(LAS u32x4*)(RAW + (c / 48) * 384 + (c % 48) * 8) = pf[k]; }
        if (tid < 64) { const float an_f = -__expf(p_alf), an_b = -__expf(p_alb);
            SCL[256 + tid] = sigmoid_f(ps0); SCL[320 + tid] = sigmoid_f(ps1);
            SCL[tid] = an_f * softplus_f(ps2 + p_dtf); SCL[64 + tid] = an_b * softplus_f(ps3 + p_dtb); }
        __syncthreads();
        if (j + nw < nitems) fetch(unit_of(j + nw), tid);
        { const int d2 = (tid & 63) * 2, rg = tid >> 6;
#pragma unroll
          for (int arr = 0; arr < 3; ++arr) {
              const LAS bf16_t* rp = RAW + (rg * 8) * 384 + arr * 128 + d2;
              unsigned u0 = *(const LAS unsigned*)rp, u1 = *(const LAS unsigned*)(rp + 384), u2 = *(const LAS unsigned*)(rp + 2 * 384), u3 = *(const LAS unsigned*)(rp + 3 * 384);
              float va[8], vb[8];
#pragma unroll
              for (int ii = 0; ii < 8; ++ii) { const int i = rg * 8 + ii; const unsigned u4 = *(const LAS unsigned*)(rp + (ii + 4) * 384);
                  const float oa = silu_f(lo2f(u0) * cwa[arr * 10 + 0] + lo2f(u1) * cwa[arr * 10 + 2] + lo2f(u2) * cwa[arr * 10 + 4] + lo2f(u3) * cwa[arr * 10 + 6] + lo2f(u4) * cwa[arr * 10 + 8]);
                  const float ob = silu_f(hi2f(u0) * cwa[arr * 10 + 1] + hi2f(u1) * cwa[arr * 10 + 3] + hi2f(u2) * cwa[arr * 10 + 5] + hi2f(u3) * cwa[arr * 10 + 7] + hi2f(u4) * cwa[arr * 10 + 9]);
                  if (arr == 0) { f32_2v o2 = {oa, ob}; *(LAS f32_2v*)(qf + i * 128 + d2) = o2; }
                  else if (arr == 1) { f32_2v o2 = {oa, ob}; *(LAS f32_2v*)(kf + i * 128 + d2) = o2; }
                  else { va[ii] = oa; vb[ii] = ob; }
                  u0 = u1; u1 = u2; u2 = u3; u3 = u4; }
              if (arr == 2) { u32x4 wa, wb; wa.x = pack2(va[0], va[1]); wa.y = pack2(va[2], va[3]); wa.z = pack2(va[4], va[5]); wa.w = pack2(va[6], va[7]);
                  wb.x = pack2(vb[0], vb[1]); wb.y = pack2(vb[2], vb[3]); wb.z = pack2(vb[4], vb[5]); wb.w = pack2(vb[6], vb[7]);
                  st2x64(VTI + d2 * 136 + rg * 16, wa); st2x64(VTI + (d2 + 1) * 136 + rg * 16, wb); } } }
        if (tid < 64) { float gf = SCL[tid], gb = SCL[64 + tid];
#pragma unroll
            for (int dlt = 1; dlt < 64; dlt <<= 1) { const float uf = __shfl_up(gf, dlt), ub = __shfl_down(gb, dlt); gf += (tid >= dlt) ? uf : 0.f; gb += (tid + dlt < 64) ? ub : 0.f; }
            SCL[128 + tid] = gf; SCL[192 + tid] = gb; }
        __syncthreads();
#pragma unroll
        for (int rr = 0; rr < 8; ++rr) { const int i = F.wave * 8 + rr;
            const float q0 = qf[i * 128 + lane], q1 = qf[i * 128 + 64 + lane], k0 = kf[i * 128 + lane], k1 = kf[i * 128 + 64 + lane];
            const float sq = wave_sum(q0 * q0 + q1 * q1), sk = wave_sum(k0 * k0 + k1 * k1);
            const float rq_ = rsqrtf(sq + EPS) * 0.08838834764831845f, rk_ = rsqrtf(sk + EPS);
            *(LAS bf16_t*)(QNI + i * 264 + lane * 2) = f2bf(q0 * rq_); *(LAS bf16_t*)(QNI + i * 264 + 128 + lane * 2) = f2bf(q1 * rq_);
            *(LAS bf16_t*)(KNI + i * 264 + lane * 2) = f2bf(k0 * rk_); *(LAS bf16_t*)(KNI + i * 264 + 128 + lane * 2) = f2bf(k1 * rk_); }
        __syncthreads();
        { const int mq = F.wave >> 2, ib = (F.wave >> 1) & 1, jb = F.wave & 1;
          const LAS unsigned char* Ai = (mq ? QNI : KNI) + (32 * ib + l31) * 264 + hh * 16; const LAS unsigned char* Bi = KNI + (32 * jb + l31) * 264 + hh * 16;
          f32x16 acc;
#pragma unroll
          for (int r = 0; r < 16; ++r) acc[r] = 0.f;
#pragma unroll
          for (int ds = 0; ds < 8; ++ds) acc = __builtin_amdgcn_mfma_f32_32x32x16_bf16(__builtin_bit_cast(s16x8, ld2x64n(Ai + ds * 32)), __builtin_bit_cast(s16x8, ld2x64n(Bi + ds * 32)), acc, 0, 0, 0);
          const int j = 32 * jb + l31; const float gfj = SCL[128 + j], gbj = SCL[192 + j];
          bf16_t* qkf = (bf16_t*)(rec + GR_QK); bf16_t* qkb = qkf + 4096;
#pragma unroll
          for (int r = 0; r < 16; ++r) { const int i = 32 * ib + (r & 3) + 8 * (r >> 2) + 4 * hh;
              const float ef = __expf(fminf(SCL[128 + i] - gfj, 0.f)), eb = __expf(fminf(SCL[192 + i] - gbj, 0.f));
              if (mq == 0) { qf[i * 64 + j] = (j < i) ? SCL[256 + i] * acc[r] * ef : 0.f; kf[(63 - i) * 64 + (63 - j)] = (j > i) ? SCL[320 + i] * acc[r] * eb : 0.f; }
              else { qkf[i * 64 + j] = f2bf((j <= i) ? acc[r] * ef : 0.f); qkb[i * 64 + j] = f2bf((j >= i) ? acc[r] * eb : 0.f); } }
          for (int c = tid; c < 2048; c += NTH) { const int m2 = c >> 10, o = c & 1023; *(LAS f32x4*)((m2 ? kf : qf) + 4096 + o * 4) = (f32x4){0.f, 0.f, 0.f, 0.f}; } }
        __syncthreads();
        if (F.wave < 2) {
            const LAS float* Am = F.wave == 0 ? qf : kf; LAS float* Tl = (F.wave == 0 ? qf : kf) + 4096;
            const int I = kq, c = l15; const LAS float* Ab = Am + (16 * I) * 64 + 16 * I;
            float t[16];
#pragma unroll
            for (int r = 0; r < 16; ++r) { float a = (c == r) ? 1.f : 0.f;
#pragma unroll
                for (int jg = 0; jg < (r + 3) / 4; ++jg) { const f32x4 m = *(const LAS f32x4*)(Ab + r * 64 + jg * 4);
#pragma unroll
                    for (int q = 0; q < 4; ++q) if (jg * 4 + q < r) a -= m[q] * t[jg * 4 + q]; }
                t[r] = a; Tl[(16 * I + r) * 64 + 16 * I + c] = a; }
        } else {
            const int t6 = tid - 128;
            for (int c = t6; c < 3072; c += 384) {
                u32x4 w; if (c < 2048) { const int cc = c & 1023, row = cc >> 4, part = cc & 15; w = ld2x64n((c < 1024 ? KNI : QNI) + row * 264 + part * 16); }
                else { const int cc = c - 2048, row = cc >> 3, part = cc & 7; w = ld2x64n(VTI + row * 136 + part * 16); }
                *(u32x4*)(rec + (size_t)c * 16) = w; }
            if (t6 < 64) { float* sc = (float*)(rec + GR_SC); const int i = t6;
                const float gf = SCL[128 + i], gb = SCL[192 + i], glf = SCL[128 + 63], glb = SCL[192 + 0];
                sc[i] = SCL[256 + i]; sc[64 + i] = __expf(gf); sc[128 + i] = __expf(glf - gf);
                sc[192 + i] = SCL[320 + i]; sc[256 + i] = __expf(gb); sc[320 + i] = __expf(glb - gb);
                if (i == 0) { sc[384] = __expf(glf); sc[385] = __expf(glb); } }
        }
        __syncthreads();
#pragma unroll
        for (int lev = 1; lev < 4; ++lev) {
            const int mtx = F.wave & 1, idx = F.wave >> 1;
            if (idx < 4 - lev) {
                const int I = idx + lev, J = idx;
                const LAS float* Am = mtx ? kf : qf; LAS float* Tl = (mtx ? kf : qf) + 4096; LAS float* xs = XS + F.wave * 256;
                f32x4 x = {0.f, 0.f, 0.f, 0.f};
                for (int K = J; K < I; ++K) {
#pragma unroll
                    for (int ks = 0; ks < 4; ++ks) x = __builtin_amdgcn_mfma_f32_16x16x4f32(Am[(16 * I + l15) * 64 + 16 * K + 4 * ks + kq], Tl[(16 * K + 4 * ks + kq) * 64 + 16 * J + l15], x, 0, 0, 0); }
#pragma unroll
                for (int rg = 0; rg < 4; ++rg) xs[(4 * kq + rg) * 16 + l15] = x[rg];
                asm volatile("s_waitcnt lgkmcnt(0)" ::: "memory");
                __builtin_amdgcn_wave_barrier();
                f32x4 y = {0.f, 0.f, 0.f, 0.f};
#pragma unroll
                for (int ks = 0; ks < 4; ++ks) y = __builtin_amdgcn_mfma_f32_16x16x4f32(Tl[(16 * I + l15) * 64 + 16 * I + 4 * ks + kq], xs[(4 * ks + kq) * 16 + l15], y, 0, 0, 0);
#pragma unroll
                for (int rg = 0; rg < 4; ++rg) Tl[(16 * I + 4 * kq + rg) * 64 + 16 * J + l15] = -y[rg];
            }
            __syncthreads();
        }
        { bf16_t* Tg = (bf16_t*)(rec + GR_T);
#pragma unroll
          for (int k = 0; k < 2; ++k) { const int o8 = tid * 8, i = o8 >> 6, c0 = o8 & 63;
              const LAS float* src = (k ? kf : qf) + 4096 + o8; const f32x4 v0 = *(const LAS f32x4*)src, v1 = *(const LAS f32x4*)(src + 4);
              u32x4 w;
              if (k == 0) { w.x = pack2(v0[0], v0[1]); w.y = pack2(v0[2], v0[3]); w.z = pack2(v1[0], v1[1]); w.w = pack2(v1[2], v1[3]); *(u32x4*)(Tg + i * 64 + c0) = w; }
              else { w.x = pack2(v1[3], v1[2]); w.y = pack2(v1[1], v1[0]); w.z = pack2(v0[3], v0[2]); w.w = pack2(v0[1], v0[0]); *(u32x4*)(Tg + 4096 + (63 - i) * 64 + (56 - c0)) = w; } } }
        __syncthreads();
    }
}

constexpr int GDN_RA = 72, GDN_R2 = 114, GDN_NB1 = GDN_RA / 2 + 1, GDN_NB2 = GDN_R2 / 2 + 1;
__device__ __forceinline__ void ph_gdn_scan(const Frame& F, const XcdBarrier& bar) {
    LAS unsigned char* L = F.lds;
    LAS unsigned char* KNI = L;
    LAS unsigned char* QNI = L + 16896;
    LAS unsigned char* VTI = L + 33792;
    LAS unsigned char* KTI = L + 51200;
    LAS unsigned char* TI = L + 68608;
    LAS unsigned char* QKI = L + 77312;
    LAS float* SC = (LAS float*)(L + 86016);
    LAS unsigned char* PK = L + 87040;
    const int l31 = F.lane & 31, hh = F.lane >> 5, w = F.wave;
    for (int it = F.bid; it < 64; it += F.G) {
        const int b = it >> 3, h = (it >> 1) & 3, dir = it & 1;
        bf16_t* O = dir ? (bf16_t*)(F.ws + WS_WMOE) : (bf16_t*)(F.ws + WS_GOF);
        f32x16 S0, S1, S2, S3;
#pragma unroll
        for (int r = 0; r < 16; ++r) { S0[r] = 0.f; S1[r] = 0.f; S2[r] = 0.f; S3[r] = 0.f; }
        u32x4 pre[16]; float psc = 0.f;
        const int t4base = F.tid - 256;
        auto ckof = [&](int n) -> int { return dir ? (n < 4 ? 3 - n : 135 - n) : n; };
        auto fetch = [&](int n, int t4) { const unsigned char* rec = F.ws + WS_GREC + (size_t)((b * 4 + h) * 132 + ckof(n)) * GR_BYTES;
#pragma unroll
            for (int k = 0; k < 12; ++k) pre[k] = *(const u32x4*)(rec + (size_t)(t4 + 256 * k) * 16);
#pragma unroll
            for (int k = 0; k < 2; ++k) { pre[12 + k] = *(const u32x4*)(rec + GR_T + dir * 8192 + (t4 + 256 * k) * 16); pre[14 + k] = *(const u32x4*)(rec + GR_QK + dir * 8192 + (t4 + 256 * k) * 16); }
            if (t4 < 193) psc = ((const float*)(rec + GR_SC))[t4 < 192 ? dir * 192 + t4 : 384 + dir]; };
        if (w >= 4) {
            fetch(0, t4base);
            for (int n = 0; n < 132; ++n) {
                if (n == GDN_NB1 || n == GDN_NB2) xcd_barrier(bar);
                int t4 = t4base; asm volatile("" : "+v"(t4));
                __syncthreads();
#pragma unroll
                for (int k = 0; k < 4; ++k) { const int c = t4 + 256 * k, row = c >> 4, part = c & 15; st2x64(KNI + row * 264 + part * 16, pre[k]); }
#pragma unroll
                for (int k = 4; k < 8; ++k) { const int c = t4 + 256 * (k - 4), row = c >> 4, part = c & 15; st2x64(QNI + row * 264 + part * 16, pre[k]); }
#pragma unroll
                for (int k = 8; k < 12; ++k) { const int c = t4 + 256 * (k - 8), row = c >> 3, part = c & 7; st2x64(VTI + row * 136 + part * 16, pre[k]); }
#pragma unroll
                for (int k = 0; k < 2; ++k) { const int c = t4 + 256 * k, row = c >> 3, part = c & 7; st2x64(TI + row * 136 + part * 16, pre[12 + k]); st2x64(QKI + row * 136 + part * 16, pre[14 + k]); }
                if (t4 < 193) SC[t4] = psc;
                __syncthreads();
                if (n + 1 < 132) fetch(n + 1, t4);
                __syncthreads();
                {
                    const int ws = w - 4; size_t rbase; int len, p0; gdn_unit_geom(b, ckof(n), rbase, len, p0);
                    const LAS unsigned char* pk = PK + ws * 12288 + F.lane * 16;
                    f32x16 T0, T1;
#pragma unroll
                    for (int r = 0; r < 16; ++r) { T0[r] = 0.f; T1[r] = 0.f; }
                    s16x8 fa[8], fb[8], sa[8], ga[4], gb[4], va[4];
#pragma unroll
                    for (int q = 0; q < 8; ++q) { const int co = (32 * (q >> 1) + 16 * (q & 1) + 4 * hh) * 2; fa[q] = ld2x64(QNI + l31 * 264 + co); fb[q] = ld2x64(QNI + (32 + l31) * 264 + co); sa[q] = *(const LAS s16x8*)(pk + q * 1024); }
#pragma unroll
                    for (int q = 0; q < 4; ++q) { const int co = (32 * (q >> 1) + 16 * (q & 1) + 4 * hh) * 2; ga[q] = ld2x64(QKI + l31 * 136 + co); gb[q] = ld2x64(QKI + (32 + l31) * 136 + co); va[q] = *(const LAS s16x8*)(pk + (8 + q) * 1024); }
                    const float e0 = SC[64 + l31], e1 = SC[64 + 32 + l31];
#pragma unroll
                    for (int q = 0; q < 8; ++q) { T0 = __builtin_amdgcn_mfma_f32_32x32x16_bf16(sa[q], fa[q], T0, 0, 0, 0); T1 = __builtin_amdgcn_mfma_f32_32x32x16_bf16(sa[q], fb[q], T1, 0, 0, 0); }
#pragma unroll
                    for (int r = 0; r < 16; ++r) { T0[r] *= e0; T1[r] *= e1; }
#pragma unroll
                    for (int q = 0; q < 4; ++q) { T0 = __builtin_amdgcn_mfma_f32_32x32x16_bf16(va[q], ga[q], T0, 0, 0, 0); T1 = __builtin_amdgcn_mfma_f32_32x32x16_bf16(va[q], gb[q], T1, 0, 0, 0); }
                    { bf16_t* o0 = O + (rbase + p0 + l31) * 512 + h * 128 + 32 * ws + 4 * hh; bf16_t* o1 = o0 + (size_t)32 * 512;
#pragma unroll
                      for (int gq = 0; gq < 4; ++gq) { u32x2 x; x.x = pack2(T0[4 * gq], T0[4 * gq + 1]); x.y = pack2(T0[4 * gq + 2], T0[4 * gq + 3]); *(u32x2*)(o0 + gq * 8) = x;
                          x.x = pack2(T1[4 * gq], T1[4 * gq + 1]); x.y = pack2(T1[4 * gq + 2], T1[4 * gq + 3]); *(u32x2*)(o1 + gq * 8) = x; } }
                }
            }
        } else
        for (int n = 0; n < 132; ++n) {
            if (n == GDN_NB1 || n == GDN_NB2) xcd_barrier(bar);
            const LAS unsigned char* trb = KNI + (4 * hh + ((F.lane >> 2) & 3)) * 264 + (16 * ((F.lane >> 4) & 1) + 4 * (F.lane & 3)) * 2;
            __syncthreads();
            __syncthreads();
            {
                size_t rbase; int len, p0; gdn_unit_geom(b, ckof(n), rbase, len, p0);
                const float alast = SC[192];
                f32x16 P0, P1;
#pragma unroll
                for (int r = 0; r < 16; ++r) { P0[r] = 0.f; P1[r] = 0.f; }
#pragma unroll
                for (int hq = 0; hq < 2; ++hq) { s16x8 fa[4], fb[4];
#pragma unroll
                  for (int q4 = 0; q4 < 4; ++q4) { const int q = hq * 4 + q4; const int co = (32 * (q >> 1) + 16 * (q & 1) + 4 * hh) * 2; fa[q4] = ld2x64(KNI + l31 * 264 + co); fb[q4] = ld2x64(KNI + (32 + l31) * 264 + co); }
#pragma unroll
                  for (int q4 = 0; q4 < 4; ++q4) { const int q = hq * 4 + q4; const int r = q >> 1; const s16x8 sb = pack8(r == 0 ? S0 : (r == 1 ? S1 : (r == 2 ? S2 : S3)), 8 * (q & 1));
                      P0 = __builtin_amdgcn_mfma_f32_32x32x16_bf16(fa[q4], sb, P0, 0, 0, 0); P1 = __builtin_amdgcn_mfma_f32_32x32x16_bf16(fb[q4], sb, P1, 0, 0, 0); } }
#pragma unroll
                for (int gq = 0; gq < 4; ++gq) {
#pragma unroll
                    for (int ib = 0; ib < 2; ++ib) { const int i0 = 32 * ib + 8 * gq + 4 * hh;
                        const f32x4 be = *(const LAS f32x4*)(SC + i0), eg = *(const LAS f32x4*)(SC + 64 + i0);
                        const u32x2 vv = *(const LAS u32x2*)(VTI + (32 * w + l31) * 136 + i0 * 2);
                        const float v0 = lo2f(vv.x), v1 = hi2f(vv.x), v2 = lo2f(vv.y), v3 = hi2f(vv.y);
                        if (ib == 0) { P0[4 * gq + 0] = be[0] * (v0 - eg[0] * P0[4 * gq + 0]); P0[4 * gq + 1] = be[1] * (v1 - eg[1] * P0[4 * gq + 1]); P0[4 * gq + 2] = be[2] * (v2 - eg[2] * P0[4 * gq + 2]); P0[4 * gq + 3] = be[3] * (v3 - eg[3] * P0[4 * gq + 3]); }
                        else         { P1[4 * gq + 0] = be[0] * (v0 - eg[0] * P1[4 * gq + 0]); P1[4 * gq + 1] = be[1] * (v1 - eg[1] * P1[4 * gq + 1]); P1[4 * gq + 2] = be[2] * (v2 - eg[2] * P1[4 * gq + 2]); P1[4 * gq + 3] = be[3] * (v3 - eg[3] * P1[4 * gq + 3]); } } }
                f32x16 V0, V1;
#pragma unroll
                for (int r = 0; r < 16; ++r) { V0[r] = 0.f; V1[r] = 0.f; }
#pragma unroll
                for (int jb = 0; jb < 2; ++jb)
#pragma unroll
                    for (int s = 0; s < 2; ++s) { const s16x8 pb = pack8(jb == 0 ? P0 : P1, 8 * s); const int co = (32 * jb + 16 * s + 4 * hh) * 2;
                        V0 = __builtin_amdgcn_mfma_f32_32x32x16_bf16(ld2x64(TI + l31 * 136 + co), pb, V0, 0, 0, 0);
                        V1 = __builtin_amdgcn_mfma_f32_32x32x16_bf16(ld2x64(TI + (32 + l31) * 136 + co), pb, V1, 0, 0, 0); }
                { LAS unsigned char* pk = PK + w * 12288 + F.lane * 16;
#pragma unroll
                  for (int q = 0; q < 8; ++q) { const int r = q >> 1; *(LAS s16x8*)(pk + q * 1024) = pack8(r == 0 ? S0 : (r == 1 ? S1 : (r == 2 ? S2 : S3)), 8 * (q & 1)); }
#pragma unroll
                  for (int q = 0; q < 4; ++q) *(LAS s16x8*)(pk + (8 + q) * 1024) = pack8((q >> 1) == 0 ? V0 : V1, 8 * (q & 1)); }
                __syncthreads();
#pragma unroll
                for (int gq = 0; gq < 4; ++gq) { const f32x4 c0 = *(const LAS f32x4*)(SC + 128 + 8 * gq + 4 * hh), c1 = *(const LAS f32x4*)(SC + 128 + 32 + 8 * gq + 4 * hh);
#pragma unroll
                    for (int q = 0; q < 4; ++q) { V0[4 * gq + q] *= c0[q]; V1[4 * gq + q] *= c1[q]; } }
#pragma unroll
                for (int r = 0; r < 16; ++r) { S0[r] *= alast; S1[r] *= alast; S2[r] *= alast; S3[r] *= alast; }
#pragma unroll
                for (int hq = 0; hq < 2; ++hq) { s16x8 fk[8];
#pragma unroll
                  for (int q2 = 0; q2 < 2; ++q2) { const int q = hq * 2 + q2;
#pragma unroll
                      for (int r = 0; r < 4; ++r) fk[q2 * 4 + r] = ldtr2(trb + (16 * q) * 264 + 64 * r, trb + (16 * q + 8) * 264 + 64 * r); }
#pragma unroll
                  for (int q2 = 0; q2 < 2; ++q2) { const int q = hq * 2 + q2; const s16x8 vb = pack8((q >> 1) == 0 ? V0 : V1, 8 * (q & 1));
                      S0 = __builtin_amdgcn_mfma_f32_32x32x16_bf16(fk[q2 * 4 + 0], vb, S0, 0, 0, 0); S1 = __builtin_amdgcn_mfma_f32_32x32x16_bf16(fk[q2 * 4 + 1], vb, S1, 0, 0, 0);
                      S2 = __builtin_amdgcn_mfma_f32_32x32x16_bf16(fk[q2 * 4 + 2], vb, S2, 0, 0, 0); S3 = __builtin_amdgcn_mfma_f32_32x32x16_bf16(fk[q2 * 4 + 3], vb, S3, 0, 0, 0); } }
            }
        }
        __syncthreads();
    }
}

#ifndef FAST_ATTN
#define FAST_ATTN 3
#endif
constexpr int NPHASES = 27;
__global__ void __launch_bounds__(NTH, 2) fwd(Params P) {
    extern __shared__ __attribute__((aligned(16))) unsigned char lds_raw[];
    Frame F; F.P = &P; F.ws = P.ws; F.lds = (LAS unsigned char*)lds_raw;
    F.tid = threadIdx.x; F.lane = F.tid & 63; F.wave = __builtin_amdgcn_readfirstlane(F.tid >> 6); F.G = gridDim.x; F.bid = blockIdx.x;
    F.mod = (float*)(P.ws + WS_CTRL + C_MOD); F.ctrl = (unsigned*)(P.ws + WS_CTRL);
    volatile LAS unsigned* xbw = (volatile LAS unsigned*)(F.lds + LDS_BYTES - 16);
    if (F.tid < 4) xbw[F.tid] = 0u;
    __syncthreads();
    const int lo = P.ph_lo, hi = P.ph_hi;
    const bool single = (hi - lo) > 1;
    XcdBarrier bar; bar.bar = F.ctrl; bar.x = 0; bar.st = xbw;
    if (single) bar = xcd_barrier_post(F.ctrl, xbw);
#ifndef PH_MASK
#define PH_MASK 0xffffffffu
#endif
#ifndef PROBE_MASK
#define PROBE_MASK 0u
#endif
    unsigned long long t_acc = 0ull, t_0 = 0ull;
#define TIC(k) do { if ((PROBE_MASK >> (k)) & 1u) t_0 = __builtin_amdgcn_s_memrealtime(); } while (0)
#define TOC(k) do { if ((PROBE_MASK >> (k)) & 1u) t_acc += __builtin_amdgcn_s_memrealtime() - t_0; } while (0)
#define IN(k) (((PH_MASK >> (k)) & 1u) && lo <= (k) && (k) < hi)
#define SEAM(k) do { if (IN(k) && IN((k) + 1)) xcd_barrier(bar); } while (0)
#ifndef DUP_MASK
#define DUP_MASK 0u
#endif
#define DUP(k) ((DUP_MASK >> (k)) & 1u)
    bf16_t* wsm = (bf16_t*)(P.ws + WS_WSM);
    bf16_t* ACT = (bf16_t*)(P.ws + WS_ACT); bf16_t* PX = (bf16_t*)(P.ws + WS_PX);
    float* XC = (float*)(P.ws + WS_XC);

    TIC(0);
    if (IN(0)) { ph_prologue(F); if (DUP(0)) { __syncthreads(); conv_moe_weights(F, 0, F.bid, F.G, 0, 3072); } xcd_barrier(bar); mod_reduce(F); } SEAM(0);
    TOC(0);
    TIC(1);
    if (IN(1)) { ph_rownorm(F, 0, TT, P.in[I_X], P.in[I_CTX], P.in[I_NMIX], 0); if (DUP(1)) ph_rownorm(F, 0, TT, P.in[I_X], P.in[I_CTX], P.in[I_NMIX], 0); } SEAM(1);
    TOC(1);
    TIC(2);
    if (IN(2)) { EpiStoreBf16P E{PX, EVEN_IN, 1024}; gemm_dense(F, ACT, wsm + W_EIN / 2, TT, EVEN_IN, 1024, E); if (DUP(2)) gemm_dense(F, ACT, wsm + W_EIN / 2, TT, EVEN_IN, 1024, E); } SEAM(2);
    TOC(2);
    TIC(3);
    if (IN(3)) { ph_gmlp_mfma(F); __syncthreads(); }
    TOC(3);
#ifndef CHUNKED_GLA
#define CHUNKED_GLA 1
#endif
    TIC(4);
    if (IN(4)) { if (CHUNKED_GLA) ph_gla_p1(F); else ph_gla(F); } SEAM(4);
    TOC(4);
    TIC(5);
    if (IN(5)) { if (CHUNKED_GLA) { ph_gla_p2(F); xcd_barrier(bar); ph_gla_p3(F); } else ph_merge(F, 0); } SEAM(5);
    TOC(5);
    TIC(6);
    if (IN(6)) { EpiResidual E{P.in[I_X], P.in[I_CTX], P.out, XC, F.mod, 2, (float*)(P.ws + WS_R2 + R2_RSS)}; gemm_dense(F, ACT, wsm + W_EOUT / 2, TT, 1024, 1024, E); } SEAM(6);
    TOC(6);
    TIC(7);
    if (IN(7)) { ph_router(F, 0, TT, P.out, XC, P.in[I_NFFN], 3); } SEAM(7);
    TOC(7);
    TIC(8);
    if (IN(8)) { ph_dispatch(F, 0, TT); } SEAM(8);
    TOC(8);
    TIC(9);
    if (IN(9)) { ph_moe_gemm1(F, 0); if (DUP(9)) ph_moe_gemm1(F, 0); } SEAM(9);
    TOC(9);
    TIC(10);
    if (IN(10)) { ph_moe_gemm2y(F, 0); } SEAM(10);
    TOC(10);
    TIC(11);
    if (IN(11)) { }
    TOC(11);
    TIC(12);
    if (IN(12)) { ph_moe_combine<true>(F, 0, TT, 1, P.in[I_NMIX] + 1024);
#ifdef DBG_ZERO
        { u32x4 z = {0u, 0u, 0u, 0u}; u32x4* p = (u32x4*)(P.ws + WS_GREC); const size_t n = (size_t)(990 - 585) * MiB / 16;
          for (size_t i = (size_t)gtid(F); i < n; i += (size_t)F.G * NTH) p[i] = z;
          u32x4* q = (u32x4*)(P.ws + WS_WMOE); const size_t m = (size_t)66 * MiB / 16;
          for (size_t i = (size_t)gtid(F); i < m; i += (size_t)F.G * NTH) q[i] = z; }
#endif
    } SEAM(12);
    TOC(12);
    TIC(13);
    if (IN(13)) { EpiStoreBf16P E{PX, ODD_PAD, 0}; gemm_dense(F, ACT, wsm + W_OIN / 2, TT, ODD_PAD, 1024, E); if (DUP(13)) gemm_dense(F, ACT, wsm + W_OIN / 2, TT, ODD_PAD, 1024, E); } SEAM(13);
    TOC(13);
#ifndef CHUNKED_GDN
#define CHUNKED_GDN 1
#endif
    TIC(14);
    if (IN(14) && IN(15)) {
#pragma unroll 1
        for (int part = 0; part < 3; ++part) {
            const int r0 = part == 0 ? 0 : (part == 1 ? GDN_RA : GDN_R2), r1 = part == 0 ? GDN_RA : (part == 1 ? GDN_R2 : 132);
            if (part == 0 || F.bid >= 64) ph_gdn_prep(F, r0, r1, part == 0 ? F.bid : F.bid - 64, part == 0 ? F.G : F.G - 64);
            xcd_barrier(bar);
            if (part == 0 && F.bid < 64) { ph_gdn_scan(F, bar); break; }
        }
        if (F.bid >= 64) { __syncthreads(); conv_moe_weights(F, 1, F.bid - 64, F.G - 64, 2048, 3072); }
    } SEAM(15);
    TOC(15);
    TIC(16);
    if (IN(16)) { ph_merge(F, 1); ph_mla_norm(F); } SEAM(16);
    TOC(16);
    TIC(17);
    if (IN(17)) { }
    TOC(17);
    TIC(18);
    if (IN(18)) { const bf16_t* cqn = (const bf16_t*)(P.ws + WS_R2 + R2_CQN);
                  EpiStoreBf16P E1{(bf16_t*)(P.ws + WS_WMOE), 768, 0}; gemm_dense(F, cqn, wsm + W_WQ / 2, TL, 768, 256, E1);
                  EpiStoreBf16P E2{(bf16_t*)(P.ws + WS_PX + PX_KVRAW), 1024, 0}; gemm_dense(F, cqn + (size_t)TL * 256, wsm + W_WKV / 2, TT, 1024, 256, E2); } SEAM(18);
    TOC(18);
    TIC(19);
    if (IN(19)) { ph_mla_final(F); } SEAM(19);
    TOC(19);
    TIC(20);
    if (IN(20)) { if (FAST_ATTN == 3) ph_attn3(F); else if (FAST_ATTN == 2) ph_attn2(F); else if (FAST_ATTN) ph_attn(F); else ph_attn_naive(F); if (DUP(20)) { __syncthreads(); ph_attn2(F); } } SEAM(20);
    TOC(20);
    TIC(21);
    if (IN(21)) { EpiResidual E{P.out, P.out, P.out, P.out, F.mod + 9 * 6144, 2, (float*)(P.ws + WS_R2 + R2_RSS)}; gemm_dense(F, ACT, wsm + W_OOUT / 2, TL, 1024, 1024, E); } SEAM(21);
    TOC(21);
    TIC(22);
    if (IN(22)) { ph_router(F, 1, TL, P.out, XC, P.in[I_NFFN] + 1024, 3); conv_moe_weights(F, 1, F.bid, F.G, 0, 2048); } SEAM(22);
    TOC(22);
    TIC(23);
    if (IN(23)) { ph_dispatch(F, 1, TL); } SEAM(23);
    TOC(23);
    TIC(24);
    if (IN(24)) { ph_moe_gemm1(F, 1); if (DUP(24)) ph_moe_gemm1(F, 1); } SEAM(24);
    TOC(24);
    TIC(25);
    if (IN(25)) { ph_moe_gemm2y(F, 1); } SEAM(25);
    TOC(25);
    TIC(26);
    if (IN(26)) { ph_moe_combine<false>(F, 1, TL, 1, nullptr); }
    TOC(26);
    if (PROBE_MASK) { const unsigned long long te = __builtin_amdgcn_s_memrealtime() + 10ull * t_acc; while (__builtin_amdgcn_s_memrealtime() < te) __builtin_amdgcn_s_sleep(8); }
#undef IN
#undef SEAM
}

#ifndef N_LAUNCH_MODE
#define N_LAUNCH_MODE 1
#endif
extern "C" void kernel_launch(void* const* d_in, const int* in_sizes, int n_in, void* d_out, int out_size, void* d_ws, size_t ws_size, hipStream_t stream) {
    static int grid = 0;
    if (grid == 0) {
        if (n_in != 34 || out_size != TL * DM || ws_size < WS_END) { fprintf(stderr, "kernel_launch: unexpected shapes (n_in %d out %d ws %zu)\n", n_in, out_size, ws_size); grid = -1; return; }
        int dev = 0, cus = 0;
        if (hipGetDevice(&dev) != hipSuccess || hipDeviceGetAttribute(&cus, hipDeviceAttributeMultiprocessorCount, dev) != hipSuccess) { grid = -1; return; }
        if (hipFuncSetAttribute((const void*)fwd, hipFuncAttributeMaxDynamicSharedMemorySize, LDS_BYTES) != hipSuccess) { fprintf(stderr, "kernel_launch: hipFuncSetAttribute failed\n"); grid = -1; return; }
        int per_cu = 0;
        (void)hipOccupancyMaxActiveBlocksPerMultiprocessor(&per_cu, (const void*)fwd, NTH, LDS_BYTES);
        (void)hipGetLastError();
        if (per_cu < 1) fprintf(stderr, "kernel_launch: occupancy query says %d\n", per_cu);
        grid = cus;
    }
    if (grid < 0) return;
    (void)hipMemsetAsync(d_ws, 0, MiB, stream);
    Params p{};
    for (int i = 0; i < 34; ++i) p.in[i] = (const float*)d_in[i];
    p.out = (float*)d_out; p.ws = (unsigned char*)d_ws;
#if N_LAUNCH_MODE == 1
    p.ph_lo = 0; p.ph_hi = NPHASES;
    hipLaunchKernelGGL(fwd, dim3(grid), dim3(NTH), LDS_BYTES, stream, p);
#else
    for (int k = 0; k < NPHASES; ++k) { p.ph_lo = k; p.ph_hi = k + 1; hipLaunchKernelGGL(fwd, dim3(grid), dim3(NTH), LDS_BYTES, stream, p); }
#endif
}
```
